# Optimizing an MI355X kernel written in HIP

```python
import math
import jax, jax.numpy as jnp
from jax import lax
import numpy as np

D_MODEL = 2048
BATCH = 2
SEQ = 4096
DEPTH = 1
DEC_BATCH = 8
DEC_SEQ = 64
PAST_LEN = 4096

CHUNK = 64
N_HEADS = 8
HEAD_DIM = 128
ATTN_W = N_HEADS * HEAD_DIM
CONV_GROUPS = 8
CONV_CH = D_MODEL - ATTN_W
CONV_WIDTH = 3
IN_COLS = 3 * ATTN_W + 3 * CONV_CH
D_FF = ((8 * D_MODEL + 3 * 256 - 1) // (3 * 256)) * 256
QBLOCK = 128
EPS = 1e-6

kernel_name = "stick_breaking_shortconv_hybrid_stream_step"


def rmsnorm(x, g):
    xf = x.astype(jnp.float32)
    y = xf * lax.rsqrt(jnp.mean(xf * xf, axis=-1, keepdims=True) + EPS) * g.astype(jnp.float32)
    return y.astype(x.dtype)


def stick_breaking(q, k, v, q_pos, k_pos):
    z = jnp.einsum('bqhd,bkhd->bhqk', q.astype(jnp.float32), k.astype(jnp.float32)) / math.sqrt(HEAD_DIM)
    mask = (k_pos[None, :] < q_pos[:, None])[None, None]
    log_1mb = jnp.where(mask, jax.nn.log_sigmoid(-z), 0.0)
    after = lax.cumsum(log_1mb, axis=3, reverse=True) - log_1mb
    w = jnp.where(mask, jnp.exp(jax.nn.log_sigmoid(z) + after), 0.0)
    return jnp.einsum('bhqk,bkhd->bqhd', w.astype(v.dtype), v)


def stick_breaking_blocks(q, k, v, q_offset):
    B, T, H, Dh = q.shape
    k_pos = jnp.arange(k.shape[1])
    if T <= QBLOCK:
        return stick_breaking(q, k, v, q_offset + jnp.arange(T), k_pos)
    nb = T // QBLOCK
    qb = q.reshape(B, nb, QBLOCK, H, Dh).transpose(1, 0, 2, 3, 4)
    starts = q_offset + jnp.arange(nb) * QBLOCK
    out = lax.map(lambda a: stick_breaking(a[0], k, v, a[1] + jnp.arange(QBLOCK), k_pos), (qb, starts))
    return out.transpose(1, 0, 2, 3, 4).reshape(B, T, H, Dh)


def hybrid_layer(x, k_past, v_past, conv_past, g_norm1, w_in, g_q, g_k, conv_w,
                 g_attn_out, g_conv_out, w_out, g_norm2, w_gate, w_up, w_down):
    B, T, _ = x.shape
    P = k_past.shape[1]
    hn = rmsnorm(x, g_norm1)
    proj = hn @ w_in
    q, k, v, gb, gc, hc = jnp.split(proj, [ATTN_W, 2 * ATTN_W, 3 * ATTN_W,
                                           3 * ATTN_W + CONV_CH, 3 * ATTN_W + 2 * CONV_CH], axis=-1)
    q = rmsnorm(q.reshape(B, T, N_HEADS, HEAD_DIM), g_q)
    k = rmsnorm(k.reshape(B, T, N_HEADS, HEAD_DIM), g_k)
    v = v.reshape(B, T, N_HEADS, HEAD_DIM)
    k_all = jnp.concatenate([k_past.astype(k.dtype), k], axis=1)
    v_all = jnp.concatenate([v_past.astype(v.dtype), v], axis=1)
    o_attn = stick_breaking_blocks(q, k_all, v_all, P).reshape(B, T, ATTN_W)
    u = gc * hc
    padded = jnp.concatenate([conv_past.astype(u.dtype), u], axis=1)
    conv = (conv_w[0] * padded[:, 0:T] + conv_w[1] * padded[:, 1:T + 1]
            + conv_w[2] * padded[:, 2:T + 2])
    o_conv = gb * conv
    new_conv = padded[:, -(CONV_WIDTH - 1):]
    mix = jnp.concatenate([rmsnorm(o_attn, g_attn_out), rmsnorm(o_conv, g_conv_out)], axis=-1)
    x = x + mix @ w_out
    h2 = rmsnorm(x, g_norm2)
    x = x + (jax.nn.silu(h2 @ w_gate) * (h2 @ w_up)) @ w_down
    return x, k, v, new_conv


def setup_inputs(seed: int = 0) -> dict:
    key = jax.random.key(seed)
    ks = jax.random.split(key, 20)
    f32 = jnp.float32
    nrm = lambda k, shape, s: jax.random.normal(k, shape, f32) * s
    return {
        "x_prompt": nrm(ks[0], (BATCH, SEQ, D_MODEL), 1.0),
        "x_sample": nrm(ks[1], (DEC_BATCH, DEC_SEQ, D_MODEL), 1.0),
        "cache_k": nrm(ks[2], (DEPTH, DEC_BATCH, PAST_LEN, N_HEADS, HEAD_DIM), 1.0),
        "cache_v": nrm(ks[3], (DEPTH, DEC_BATCH, PAST_LEN, N_HEADS, HEAD_DIM), 1.0),
        "state_conv": nrm(ks[4], (DEPTH, DEC_BATCH, CONV_WIDTH - 1, CONV_CH), 1.0),
        "g_norm1": 1.0 + nrm(ks[5], (DEPTH, D_MODEL), 0.01),
        "w_in": nrm(ks[6], (DEPTH, D_MODEL, IN_COLS), D_MODEL ** -0.5),
        "g_q": 1.0 + nrm(ks[7], (DEPTH, HEAD_DIM), 0.01),
        "g_k": 1.0 + nrm(ks[8], (DEPTH, HEAD_DIM), 0.01),
        "conv_w": nrm(ks[9], (DEPTH, CONV_WIDTH, CONV_CH), CONV_WIDTH ** -0.5),
        "g_attn_out": 1.0 + nrm(ks[10], (DEPTH, ATTN_W), 0.01),
        "g_conv_out": 1.0 + nrm(ks[11], (DEPTH, CONV_CH), 0.01),
        "w_out": nrm(ks[12], (DEPTH, D_MODEL, D_MODEL), D_MODEL ** -0.5),
        "g_norm2": 1.0 + nrm(ks[13], (DEPTH, D_MODEL), 0.01),
        "w_gate": nrm(ks[14], (DEPTH, D_MODEL, D_FF), D_MODEL ** -0.5),
        "w_up": nrm(ks[15], (DEPTH, D_MODEL, D_FF), D_MODEL ** -0.5),
        "w_down": nrm(ks[16], (DEPTH, D_FF, D_MODEL), D_FF ** -0.5),
    }


def reference(x_prompt, x_sample, cache_k, cache_v, state_conv, g_norm1, w_in, g_q, g_k,
              conv_w, g_attn_out, g_conv_out, w_out, g_norm2, w_gate, w_up, w_down):
    yp, ys = x_prompt, x_sample
    kp_l, vp_l, cp_l, ks_l, vs_l, cs_l = [], [], [], [], [], []
    for l in range(DEPTH):
        wts = (g_norm1[l], w_in[l], g_q[l], g_k[l], conv_w[l], g_attn_out[l], g_conv_out[l],
               w_out[l], g_norm2[l], w_gate[l], w_up[l], w_down[l])
        kp0 = jnp.zeros((yp.shape[0], 0, N_HEADS, HEAD_DIM), yp.dtype)
        cp0 = jnp.zeros((yp.shape[0], CONV_WIDTH - 1, CONV_CH), yp.dtype)
        yp, kp, vp, cp = hybrid_layer(yp, kp0, kp0, cp0, *wts)
        ys, kn, vn, cn = hybrid_layer(ys, cache_k[l], cache_v[l], state_conv[l], *wts)
        kp_l.append(kp); vp_l.append(vp); cp_l.append(cp)
        ks_l.append(kn); vs_l.append(vn); cs_l.append(cn)
    k_prompt = jnp.stack(kp_l); v_prompt = jnp.stack(vp_l); conv_prompt = jnp.stack(cp_l)
    k_sample = jnp.stack(ks_l); v_sample = jnp.stack(vs_l); conv_sample = jnp.stack(cs_l)
    return (yp, ys, k_prompt, v_prompt, conv_prompt, k_sample, v_sample, conv_sample)
```

```cpp
#include <hip/hip_runtime.h>
#include <hip/hip_cooperative_groups.h>
#include <cstdio>
#include <cstdint>
namespace cg = cooperative_groups;
namespace pg8 {
#define PG8_LAS __attribute__((address_space(3)))
typedef unsigned short bf16_t;
typedef short bf16x8 __attribute__((ext_vector_type(8)));
typedef float f32x4 __attribute__((ext_vector_type(4)));
typedef unsigned u32x4 __attribute__((ext_vector_type(4)));
constexpr int BM = 256, BK = 64, HALF = 128, HTB = HALF * BK * 2  , STAGE_BYTES = 8 * HTB, NXCD = 8, WGM = 8;

__host__ __device__ __forceinline__ int lds_byte(int r, int c) { const int st = (r >> 4) * 2 + (c >> 5), rr = r & 15, cc = c & 31, ob = rr * 64 + cc * 2; return st * 1024 + (ob ^ (((ob >> 9) & 1) << 5)); }
__host__ __device__ __forceinline__ void stage_rc(int b, int& R, int& C) { const int st = b / 1024, sb = b % 1024, swz = sb ^ (((sb >> 9) & 1) << 5); R = (st >> 1) * 16 + swz / 64; C = (st & 1) * 32 + (swz % 64) / 2; }
__host__ __device__ __forceinline__ int perm32(int rho) { const int n = rho >> 4, i = rho & 15; return 8 * (i >> 2) + 4 * n + (i & 3); }

struct Unit { int pm, pn, k0, nt, split; };
struct Gemm { const bf16_t* A; const bf16_t* Bt; int M, N, K; };

struct StaticOrder {
    int nM, nN, nwg, G, c, ntk;
    __host__ __device__ void init(int M, int N, int K, int G_, int c_) { nM = M / BM; nN = N / BM; nwg = nM * nN; G = G_; c = c_; ntk = K / BK; }
    __host__ __device__ bool next(int i, Unit& u) const {
        const long L = (long)i * G + c; if (L >= nwg) return false;
        int wgid = (int)L; { const int q = nwg / NXCD, r = nwg % NXCD, xcd = wgid % NXCD, off = wgid / NXCD; wgid = (xcd < r ? xcd * (q + 1) : r * (q + 1) + (xcd - r) * q) + off; }
        const int nig = WGM * nN, gid = wgid / nig, fm = gid * WGM, gsz = (nM - fm) < WGM ? (nM - fm) : WGM;
        u.pm = fm + ((wgid % nig) % gsz); u.pn = (wgid % nig) / gsz; u.k0 = 0; u.nt = ntk; u.split = 0; return true;
    }
    __device__ __forceinline__ void a_ready(const Unit&) const {}
    __device__ __forceinline__ void done(const Unit&) const {}
};

struct TailSplitOrder {
    StaticOrder so; int G, c;
    __host__ __device__ void init(int M, int N, int K, int G_, int c_) { so.init(M, N, K, G_, c_); G = G_; c = c_; }
    __host__ __device__ bool next(int i, Unit& u) const {
        if (G != 256 || so.nM != 34 || so.nN != 8 || so.ntk != 88) return so.next(i, u);
        if (i == 0) { const int x = c & 7, j = c >> 3; u.pm = 4 * x + (j & 3); u.pn = j >> 2; u.k0 = 0; u.nt = 88; u.split = 0; return true; }
        if (i == 1 && c < 128) { const int tu = c >> 3, s = c & 7; u.pm = 32 + (tu >> 3); u.pn = tu & 7; u.k0 = 11 * s + (s & 1); u.nt = 12 - 2 * (s & 1); u.split = 1; return true; }
        return false;
    }
    __device__ __forceinline__ void a_ready(const Unit&) const {}
    __device__ __forceinline__ void done(const Unit&) const {}
};

__device__ __forceinline__ unsigned cvt_pk_bf16(float lo, float hi) { unsigned r; asm volatile("v_cvt_pk_bf16_f32 %0, %1, %2" : "=v"(r) : "v"(lo), "v"(hi)); return r; }
typedef float f32x2 __attribute__((ext_vector_type(2)));
#define PG8_LBAR() asm volatile("s_waitcnt lgkmcnt(0)\n\ts_barrier" ::: "memory")
constexpr int NPROMPT = 8192;
__device__ __forceinline__ u32x4 pack8(const f32x4 a, const f32x4 b) { u32x4 w; w.x = cvt_pk_bf16(a[0], a[1]); w.y = cvt_pk_bf16(a[2], a[3]); w.z = cvt_pk_bf16(b[0], b[1]); w.w = cvt_pk_bf16(b[2], b[3]); return w; }

struct EpiIn {
    static constexpr bool PERM = true, AFTER_DRAIN = false;
    bf16_t *Q, *Kb, *Vb, *GB, *U; float* out; const float *gq, *gk; PG8_LAS float* red; float qscale;
    size_t off_kp, off_vp, off_cp, off_ks, off_vs, off_cs;
    __device__ __forceinline__ void operator()(const f32x4 (&acc)[2][2][4][2], const Unit& u, int wr, int wc, int fr, int fq) const {
        const int pn = u.pn, rowt = u.pm * BM, rl0 = wr * 64 + fr, cw = wc * 32 + 8 * fq;
        const bool prompt = rowt < NPROMPT;
        if (pn < 8) {
            const bool isq = pn < 4;
#pragma unroll
            for (int ai = 0; ai < 2; ++ai)
#pragma unroll
                for (int m = 0; m < 4; ++m)
#pragma unroll
                    for (int bj = 0; bj < 2; ++bj) {
                        const f32x4 a = acc[ai][bj][m][0], b = acc[ai][bj][m][1];
                        float s = (a[0] * a[0] + a[1] * a[1]) + (a[2] * a[2] + a[3] * a[3]) + (b[0] * b[0] + b[1] * b[1]) + (b[2] * b[2] + b[3] * b[3]);
                        s += __shfl_xor(s, 16); s += __shfl_xor(s, 32);
                        if (fq == 0) red[((ai * HALF + rl0 + m * 16) * 2 + bj) * 4 + wc] = s;
                    }
            PG8_LBAR();
            const float* g = isq ? gq : gk;
            const f32x4 g0 = *(const f32x4*)(g + cw), g1 = *(const f32x4*)(g + cw + 4);
#pragma unroll
            for (int ai = 0; ai < 2; ++ai)
#pragma unroll
                for (int m = 0; m < 4; ++m) {
                    const int rl = ai * HALF + rl0 + m * 16; const size_t row = (size_t)(rowt + rl);
#pragma unroll
                    for (int bj = 0; bj < 2; ++bj) {
                        const f32x4 p = *(const PG8_LAS f32x4*)(red + (rl * 2 + bj) * 4);
                        float rs = __builtin_amdgcn_rsqf(((p[0] + p[1]) + (p[2] + p[3])) * (1.0f / 128.0f) + 1e-6f);
                        if (isq) rs *= qscale;
                        const f32x4 v0 = acc[ai][bj][m][0] * rs * g0, v1 = acc[ai][bj][m][1] * rs * g1;
                        if (isq) { *(u32x4*)(Q + row * 1024 + pn * 256 + bj * HALF + cw) = pack8(v0, v1); }
                        else {
                            const int col = (pn - 4) * 256 + bj * HALF + cw;
                            float* o = prompt ? out + off_kp + row * 1024 + col : out + off_ks + (row - NPROMPT) * 1024 + col;
                            *(f32x4*)o = v0; *(f32x4*)(o + 4) = v1;
                            if (prompt) *(u32x4*)(Kb + row * 1024 + col) = pack8(v0, v1);
                        }
                    }
                }
        } else if (pn < 12) {
#pragma unroll
            for (int ai = 0; ai < 2; ++ai)
#pragma unroll
                for (int m = 0; m < 4; ++m) {
                    const size_t row = (size_t)(rowt + ai * HALF + rl0 + m * 16);
#pragma unroll
                    for (int bj = 0; bj < 2; ++bj) {
                        const int col = (pn - 8) * 256 + bj * HALF + cw; const f32x4 v0 = acc[ai][bj][m][0], v1 = acc[ai][bj][m][1];
                        float* o = prompt ? out + off_vp + row * 1024 + col : out + off_vs + (row - NPROMPT) * 1024 + col;
                        *(f32x4*)o = v0; *(f32x4*)(o + 4) = v1;
                        if (prompt) *(u32x4*)(Vb + row * 1024 + col) = pack8(v0, v1);
                    }
                }
        } else if (pn < 16) {
#pragma unroll
            for (int ai = 0; ai < 2; ++ai)
#pragma unroll
                for (int m = 0; m < 4; ++m) {
                    const size_t row = (size_t)(rowt + ai * HALF + rl0 + m * 16);
#pragma unroll
                    for (int bj = 0; bj < 2; ++bj) *(u32x4*)(GB + row * 1024 + (pn - 12) * 256 + bj * HALF + cw) = pack8(acc[ai][bj][m][0], acc[ai][bj][m][1]);
                }
        } else {
#pragma unroll
            for (int ai = 0; ai < 2; ++ai)
#pragma unroll
                for (int m = 0; m < 4; ++m) {
                    const int rowi = rowt + ai * HALF + rl0 + m * 16; const int ch = (pn - 16) * HALF + cw;
                    const f32x4 v0 = acc[ai][0][m][0] * acc[ai][1][m][0], v1 = acc[ai][0][m][1] * acc[ai][1][m][1];
                    *(u32x4*)(U + (size_t)rowi * 1024 + ch) = pack8(v0, v1);
                    if (prompt) { const int t = rowi & 4095; if (t >= 4094) { float* o = out + off_cp + ((rowi >> 12) * 2 + (t - 4094)) * 1024 + ch; *(f32x4*)o = v0; *(f32x4*)(o + 4) = v1; } }
                    else { const int rs_ = rowi - NPROMPT, t = rs_ & 63; if (t >= 62) { float* o = out + off_cs + ((rs_ >> 6) * 2 + (t - 62)) * 1024 + ch; *(f32x4*)o = v0; *(f32x4*)(o + 4) = v1; } }
                }
        }
    }
};

struct EpiOut {
    static constexpr bool PERM = true, AFTER_DRAIN = false;
    const float *xp, *xs; float* Y; bf16_t* X1; float* ssq; PG8_LAS float* red;
    __device__ __forceinline__ void operator()(const f32x4 (&acc)[2][2][4][2], const Unit& u, int wr, int wc, int fr, int fq) const {
        const int pn = u.pn, rowt = u.pm * BM, rl0 = wr * 64 + fr, cw = wc * 32 + 8 * fq;
        const float* xin = rowt < NPROMPT ? xp + (size_t)rowt * 2048 : xs + (size_t)(rowt - NPROMPT) * 2048;
#pragma unroll
        for (int ai = 0; ai < 2; ++ai)
#pragma unroll
            for (int m = 0; m < 4; ++m) {
                const int rl = ai * HALF + rl0 + m * 16; float s = 0.f;
#pragma unroll
                for (int bj = 0; bj < 2; ++bj) {
                    const int col = pn * 256 + bj * HALF + cw; const float* xi = xin + (size_t)rl * 2048 + col;
                    const f32x4 v0 = *(const f32x4*)xi + acc[ai][bj][m][0], v1 = *(const f32x4*)(xi + 4) + acc[ai][bj][m][1];
                    float* o = Y + (size_t)(rowt + rl) * 2048 + col; *(f32x4*)o = v0; *(f32x4*)(o + 4) = v1;
                    *(u32x4*)(X1 + (size_t)(rowt + rl) * 2048 + col) = pack8(v0, v1);
                    s += (v0[0] * v0[0] + v0[1] * v0[1]) + (v0[2] * v0[2] + v0[3] * v0[3]) + (v1[0] * v1[0] + v1[1] * v1[1]) + (v1[2] * v1[2] + v1[3] * v1[3]);
                }
                s += __shfl_xor(s, 16); s += __shfl_xor(s, 32);
                if (fq == 0) red[rl * 4 + wc] = s;
                asm volatile("" ::: "memory");
            }
        PG8_LBAR();
        if (threadIdx.x < 256) { const f32x4 p = *(const PG8_LAS f32x4*)(red + threadIdx.x * 4); ssq[(size_t)(rowt + threadIdx.x) * 8 + pn] = (p[0] + p[1]) + (p[2] + p[3]); }
        PG8_LBAR();
    }
};

struct EpiGU {
    static constexpr bool PERM = true, AFTER_DRAIN = false;
    bf16_t* H; const float* ssq;
    __device__ __forceinline__ void operator()(const f32x4 (&acc)[2][2][4][2], const Unit& u, int wr, int wc, int fr, int fq) const {
        const int pn = u.pn, rowt = u.pm * BM, rl0 = wr * 64 + fr, cw = wc * 32 + 8 * fq;
#pragma unroll
        for (int ai = 0; ai < 2; ++ai)
#pragma unroll
            for (int m = 0; m < 4; ++m) {
                const size_t row = (size_t)(rowt + ai * HALF + rl0 + m * 16);
                const f32x4 p0 = *(const f32x4*)(ssq + row * 8), p1 = *(const f32x4*)(ssq + row * 8 + 4);
                const float rs = __builtin_amdgcn_rsqf((((p0[0] + p0[1]) + (p0[2] + p0[3])) + ((p1[0] + p1[1]) + (p1[2] + p1[3]))) * (1.0f / 2048.0f) + 1e-6f);
                f32x4 h[2];
#pragma unroll
                for (int n = 0; n < 2; ++n) {
                    const f32x4 g = acc[ai][0][m][n] * rs, up = acc[ai][1][m][n] * rs;
#pragma unroll
                    for (int j = 0; j < 4; ++j) h[n][j] = g[j] * __builtin_amdgcn_rcpf(1.0f + __builtin_amdgcn_exp2f(-1.4426950408889634f * g[j])) * up[j];
                }
                *(u32x4*)(H + row * 5632 + pn * HALF + cw) = pack8(h[0], h[1]);
            }
    }
};

struct EpiDown {
    static constexpr bool PERM = true, AFTER_DRAIN = false;
    float* Y;
    __device__ __forceinline__ void operator()(const f32x4 (&acc)[2][2][4][2], const Unit& u, int wr, int wc, int fr, int fq) const {
        const int pn = u.pn, rowt = u.pm * BM, rl0 = wr * 64 + fr, cw = wc * 32 + 8 * fq;
#pragma unroll
        for (int ai = 0; ai < 2; ++ai)
#pragma unroll
            for (int m = 0; m < 4; ++m)
#pragma unroll
                for (int bj = 0; bj < 2; ++bj) {
                    float* o = Y + (size_t)(rowt + ai * HALF + rl0 + m * 16) * 2048 + pn * 256 + bj * HALF + cw;
                    if (u.split) {
#pragma unroll
                        for (int j = 0; j < 4; ++j) { __hip_atomic_fetch_add(o + j, acc[ai][bj][m][0][j], __ATOMIC_RELAXED, __HIP_MEMORY_SCOPE_AGENT); __hip_atomic_fetch_add(o + 4 + j, acc[ai][bj][m][1][j], __ATOMIC_RELAXED, __HIP_MEMORY_SCOPE_AGENT); }
                    } else {
                        const f32x4 v0 = *(const f32x4*)o + acc[ai][bj][m][0], v1 = *(const f32x4*)(o + 4) + acc[ai][bj][m][1];
                        *(f32x4*)o = v0; *(f32x4*)(o + 4) = v1;
                    }
                    if (bj) asm volatile("" ::: "memory");
                }
    }
};
template <class Epi, class Sched, bool ALIGN_EPI = false, bool SP2 = false>
__device__ __forceinline__ void gemm_phase(PG8_LAS unsigned char* lds, const Gemm g, const Sched& S, const Epi& E) {
    int tid_ = threadIdx.x; asm volatile("" : "+v"(tid_));
    const int tid = tid_, wid = __builtin_amdgcn_readfirstlane(tid >> 6), lane = tid & 63, wr = wid >> 2, wc = wid & 3, fr = lane & 15, fq = lane >> 4;
    const int K = g.K;
    unsigned voffA[2], voffB[2];
#pragma unroll
    for (int i = 0; i < 2; ++i) { int R, C; stage_rc(tid * 16 + i * 8192, R, C); const int Rb = Epi::PERM ? ((R & ~31) + perm32(R & 31)) : R;
        voffA[i] = (unsigned)(R * K + C) * 2u; voffB[i] = (unsigned)(Rb * K + C) * 2u; }
    const size_t kstep = (size_t)(BK * 2);
    const size_t hstep = (size_t)HALF * K * 2;
    const size_t tstep = 2 * hstep;
    const unsigned ldsw = (unsigned)wid * 1024u;
    const int aoff = lds_byte(wr * 64 + fr, fq * 8), boff = lds_byte(wc * 32 + fr, fq * 8);
#define PG8_SA(b, h) (((b) * 2 + (h)) * HTB)
#define PG8_SB(b, h) ((4 + (b) * 2 + (h)) * HTB)
#define PG8_STAGE(bufoff, gbase, voff) do { _Pragma("unroll") for (int _i = 0; _i < 2; ++_i) \
        __builtin_amdgcn_global_load_lds((const unsigned*)((const char*)(gbase) + (voff)[_i]), (PG8_LAS unsigned*)(lds + (bufoff) + ldsw + _i * 8192), 16, 0, 0); } while (0)
#define PG8_LDA(dst, b, h) do { _Pragma("unroll") for (int m = 0; m < 4; ++m) _Pragma("unroll") for (int k = 0; k < 2; ++k) dst[m][k] = *(const PG8_LAS bf16x8*)(lds + PG8_SA(b, h) + aoff + m * 2048 + k * 1024); } while (0)
#define PG8_LDB(dst, b, h) do { _Pragma("unroll") for (int n = 0; n < 2; ++n) _Pragma("unroll") for (int k = 0; k < 2; ++k) dst[n][k] = *(const PG8_LAS bf16x8*)(lds + PG8_SB(b, h) + boff + n * 2048 + k * 1024); } while (0)
#define PG8_MMA(ai, bj, At, Bt) do { __builtin_amdgcn_s_setprio(1); _Pragma("unroll") for (int m = 0; m < 4; ++m) _Pragma("unroll") for (int n = 0; n < 2; ++n) _Pragma("unroll") for (int k = 0; k < 2; ++k) \
        acc[ai][bj][m][n] = __builtin_amdgcn_mfma_f32_16x16x32_bf16(Bt[n][k], At[m][k], acc[ai][bj][m][n], 0, 0, 0); __builtin_amdgcn_s_setprio(0); } while (0)
#define PG8_WAIT_V(n) asm volatile("s_waitcnt vmcnt(" #n ")" ::: "memory")
#define PG8_WAIT_L(n) asm volatile("s_waitcnt lgkmcnt(" #n ")" ::: "memory")
#define PG8_BAR __builtin_amdgcn_s_barrier()
#define PG8_SCHED __builtin_amdgcn_sched_barrier(0)
    Unit cur, nxt; int ui = 0;
    if (!S.next(0, cur)) return;
    f32x4 acc[2][2][4][2];
#pragma unroll
    for (int a = 0; a < 2; ++a)
#pragma unroll
        for (int b = 0; b < 2; ++b)
#pragma unroll
            for (int m = 0; m < 4; ++m)
#pragma unroll
                for (int n = 0; n < 2; ++n) acc[a][b][m][n] = (f32x4){0.f, 0.f, 0.f, 0.f};
    bf16x8 At[4][2], B0[2][2], B1[2][2];
    const char* cA = (const char*)g.A + (size_t)cur.pm * tstep + (size_t)cur.k0 * kstep; const char* cB = (const char*)g.Bt + (size_t)cur.pn * tstep + (size_t)cur.k0 * kstep;
    S.a_ready(cur);
    if constexpr (SP2) {
        PG8_STAGE(PG8_SB(0, 0), cB, voffB); PG8_STAGE(PG8_SB(0, 1), cB + hstep, voffB); PG8_STAGE(PG8_SA(0, 0), cA, voffA); PG8_STAGE(PG8_SA(0, 1), cA + hstep, voffA);
        if (wr == 1) PG8_BAR;
        PG8_WAIT_V(2); PG8_BAR;
        PG8_STAGE(PG8_SB(1, 0), cB + kstep, voffB); PG8_STAGE(PG8_SA(1, 0), cA + kstep, voffA); PG8_STAGE(PG8_SB(1, 1), cB + hstep + kstep, voffB);
        PG8_WAIT_V(6); PG8_BAR;
    } else {
        PG8_STAGE(PG8_SB(0, 0), cB, voffB); PG8_STAGE(PG8_SA(0, 0), cA, voffA); PG8_STAGE(PG8_SB(0, 1), cB + hstep, voffB); PG8_STAGE(PG8_SA(0, 1), cA + hstep, voffA);
        if (wr == 1) PG8_BAR;
        PG8_WAIT_V(4); PG8_BAR;
        PG8_STAGE(PG8_SB(1, 0), cB + kstep, voffB); PG8_STAGE(PG8_SA(1, 0), cA + kstep, voffA); PG8_STAGE(PG8_SB(1, 1), cB + hstep + kstep, voffB);
        PG8_WAIT_V(6); PG8_BAR;
    }
    for (;;) {
        const bool has_next = S.next(ui + 1, nxt);
        const char* nA = has_next ? (const char*)g.A + (size_t)nxt.pm * tstep + (size_t)nxt.k0 * kstep : cA; const char* nB = has_next ? (const char*)g.Bt + (size_t)nxt.pn * tstep + (size_t)nxt.k0 * kstep : cB;
        const int nt = cur.nt;
        for (int t = 0; t < nt; t += 2) {
            const bool last = (t == nt - 2);
            const char* a1 = cA + (size_t)(t + 1) * kstep;
            const char* a2 = last ? nA : cA + (size_t)(t + 2) * kstep; const char* b2 = last ? nB : cB + (size_t)(t + 2) * kstep;
            const char* a3 = a2 + kstep; const char* b3 = b2 + kstep;
            if (last && has_next) S.a_ready(nxt);
            if constexpr (SP2) {
            PG8_LDB(B0, 0, 0); PG8_LDB(B1, 0, 1); PG8_SCHED; PG8_LDA(At, 0, 0); PG8_STAGE(PG8_SA(1, 1), a1 + hstep, voffA);
            PG8_WAIT_V(8); PG8_WAIT_L(0); PG8_BAR; PG8_MMA(0, 0, At, B0); PG8_MMA(0, 1, At, B1); PG8_BAR; PG8_SCHED;
            PG8_LDA(At, 0, 1); PG8_STAGE(PG8_SB(0, 0), b2, voffB); PG8_STAGE(PG8_SB(0, 1), b2 + hstep, voffB); PG8_STAGE(PG8_SA(0, 0), a2, voffA);
            PG8_WAIT_V(8); PG8_WAIT_L(0); PG8_BAR; PG8_MMA(1, 0, At, B0); PG8_MMA(1, 1, At, B1); PG8_BAR; PG8_SCHED;
            PG8_LDB(B0, 1, 0); PG8_LDB(B1, 1, 1); PG8_SCHED; PG8_LDA(At, 1, 0); PG8_STAGE(PG8_SA(0, 1), a2 + hstep, voffA);
            PG8_WAIT_V(8); PG8_WAIT_L(0); PG8_BAR; PG8_MMA(0, 0, At, B0); PG8_MMA(0, 1, At, B1); PG8_BAR; PG8_SCHED;
            PG8_LDA(At, 1, 1); PG8_STAGE(PG8_SB(1, 0), b3, voffB); PG8_STAGE(PG8_SB(1, 1), b3 + hstep, voffB); PG8_STAGE(PG8_SA(1, 0), a3, voffA);
            PG8_WAIT_V(8); PG8_WAIT_L(0); PG8_BAR; PG8_MMA(1, 0, At, B0); PG8_MMA(1, 1, At, B1); PG8_BAR; PG8_SCHED;
            } else {
            PG8_LDB(B0, 0, 0); PG8_SCHED; PG8_LDA(At, 0, 0); PG8_STAGE(PG8_SA(1, 1), a1 + hstep, voffA);
            PG8_WAIT_L(8); PG8_BAR; PG8_WAIT_L(0); PG8_MMA(0, 0, At, B0); PG8_BAR; PG8_SCHED;
            PG8_LDB(B1, 0, 1); PG8_STAGE(PG8_SB(0, 0), b2, voffB);
            PG8_BAR; PG8_WAIT_L(0); PG8_MMA(0, 1, At, B1); PG8_BAR;
            PG8_LDA(At, 0, 1); PG8_STAGE(PG8_SA(0, 0), a2, voffA);
            PG8_BAR; PG8_WAIT_L(0); PG8_MMA(1, 0, At, B0); PG8_BAR; PG8_SCHED;
            PG8_STAGE(PG8_SB(0, 1), b2 + hstep, voffB);
            PG8_WAIT_V(6); PG8_BAR; PG8_MMA(1, 1, At, B1); PG8_BAR;
            PG8_LDB(B0, 1, 0); PG8_SCHED; PG8_LDA(At, 1, 0); PG8_STAGE(PG8_SA(0, 1), a2 + hstep, voffA);
            PG8_WAIT_L(8); PG8_BAR; PG8_WAIT_L(0); PG8_MMA(0, 0, At, B0); PG8_BAR; PG8_SCHED;
            PG8_LDB(B1, 1, 1); PG8_STAGE(PG8_SB(1, 0), b3, voffB);
            PG8_BAR; PG8_WAIT_L(0); PG8_MMA(0, 1, At, B1); PG8_BAR;
            PG8_LDA(At, 1, 1); PG8_STAGE(PG8_SA(1, 0), a3, voffA);
            PG8_BAR; PG8_WAIT_L(0); PG8_MMA(1, 0, At, B0); PG8_BAR; PG8_SCHED;
            PG8_STAGE(PG8_SB(1, 1), b3 + hstep, voffB);
            PG8_WAIT_V(6); PG8_BAR; PG8_MMA(1, 1, At, B1); PG8_BAR;
            }
        }
        if constexpr (ALIGN_EPI) { if (wr == 0) PG8_BAR; }
        if constexpr (!Epi::AFTER_DRAIN) { E(acc, cur, wr, wc, fr, fq); S.done(cur); }
        if (!has_next) break;
#pragma unroll
        for (int a = 0; a < 2; ++a)
#pragma unroll
            for (int b = 0; b < 2; ++b)
#pragma unroll
                for (int m = 0; m < 4; ++m)
#pragma unroll
                    for (int n = 0; n < 2; ++n) acc[a][b][m][n] = (f32x4){0.f, 0.f, 0.f, 0.f};
        cur = nxt; cA = nA; cB = nB; ++ui;
        if constexpr (ALIGN_EPI) { if (wr == 1) PG8_BAR; }
    }
    PG8_WAIT_V(0);
    if constexpr (!ALIGN_EPI) { if (wr == 0) PG8_BAR; }
    PG8_BAR;
    if constexpr (Epi::AFTER_DRAIN) { E.fused(acc, cur, wr, wc, fr, fq, lds, wid, lane); S.done(cur); }
#undef PG8_SA
#undef PG8_SB
#undef PG8_STAGE
#undef PG8_LDA
#undef PG8_LDB
#undef PG8_MMA
#undef PG8_WAIT_V
#undef PG8_WAIT_L
#undef PG8_BAR
#undef PG8_SCHED
}
}
#define LAS __attribute__((address_space(3)))
typedef unsigned short bf16;
typedef float f32x4 __attribute__((ext_vector_type(4)));
typedef float f32x16 __attribute__((ext_vector_type(16)));
typedef short bf16x8 __attribute__((ext_vector_type(8)));
typedef short s16x4 __attribute__((ext_vector_type(4)));
typedef unsigned u32x4 __attribute__((ext_vector_type(4)));
typedef unsigned u32x2 __attribute__((ext_vector_type(2)));
constexpr int DM = 2048, SEQ = 4096, NP = 8192, NS = 512, MT = NP + NS, AW = 1024, CC = 1024, INC = 6144, DFF = 5632, PAST = 4096, DSEQ = 64;
constexpr float EPS = 1e-6f;
constexpr size_t OFF_Y = 0, OFF_KP = (size_t)MT * DM, OFF_VP = OFF_KP + (size_t)NP * AW, OFF_CP = OFF_VP + (size_t)NP * AW, OFF_KS = OFF_CP + 2 * 2 * CC,
                 OFF_VS = OFF_KS + (size_t)NS * AW, OFF_CS = OFF_VS + (size_t)NS * AW, OUT_TOTAL = OFF_CS + 8 * 2 * CC;
static_assert(OUT_TOTAL == 35672064, "output size");
constexpr size_t MiB = 1u << 20;
constexpr size_t WS_CTL = 0, WS_WIN = 1 * MiB, WS_WOUT = 25 * MiB, WS_WGU = 33 * MiB, WS_WDN = 77 * MiB, WS_HN = 99 * MiB, WS_Q = 133 * MiB, WS_K = 150 * MiB, WS_V = 166 * MiB,
                 WS_GB = 182 * MiB, WS_U = 199 * MiB, WS_MIX = 216 * MiB, WS_SSQ = 250 * MiB, WS_TP = 251 * MiB, WS_OP = 256 * MiB, WS_H = 256 * MiB;
constexpr int NSLOT = 1024 + 16 * 17;
constexpr size_t WS_END = WS_OP + (size_t)NSLOT * 131072;
constexpr int RING_BYTES = 131072, RED_OFF = RING_BYTES, MISC_OFF = RED_OFF + 8192, LDS_BYTES = 147456;
constexpr int NWAVES = 8;

struct ItemTab { int n; int v[1024]; };
constexpr int p_nsteps(int qb, int c) { int e = 1024 * (c + 1); const int lim = 256 * (qb + 1); if (e > lim) e = lim; return (e - 1024 * c) / 32; }
constexpr ItemTab make_items() {
    ItemTab t{}; t.n = 0;
    const int costs[6] = {32, 24, 16, 12, 8, 3};
    for (int ci = 0; ci < 6; ++ci) {
        const int cost = costs[ci];
        if (cost == 12 || cost == 3) {
            for (int b = 0; b < 8; ++b) for (int hg = 0; hg < 2; ++hg) for (int c = 0; c < 17; ++c) if ((c < 16) == (cost == 12)) t.v[t.n++] = 1 | (b << 1) | (hg << 4) | (c << 5);
        } else {
            for (int qb = 15; qb >= 0; --qb) for (int bh = 0; bh < 16; ++bh) for (int c = 0; c < qb / 4 + 1; ++c) if (p_nsteps(qb, c) == cost) t.v[t.n++] = (bh << 1) | (qb << 5) | (c << 9);
        }
    }
    return t;
}
__device__ const ItemTab g_items = make_items();

__device__ __forceinline__ unsigned f2bf(float f) { unsigned u = __builtin_bit_cast(unsigned, f); return (u + 0x7fffu + ((u >> 16) & 1u)) >> 16; }
__device__ __forceinline__ unsigned pk2(float lo, float hi) { return pg8::cvt_pk_bf16(lo, hi); }
__device__ __forceinline__ float bflo(unsigned w) { return __builtin_bit_cast(float, w << 16); }
__device__ __forceinline__ float bfhi(unsigned w) { return __builtin_bit_cast(float, w & 0xffff0000u); }
__device__ __forceinline__ int crow(int r, int hi) { return (r & 3) + 8 * (r >> 2) + 4 * hi; }
__device__ __forceinline__ float wave_sum(float v) {
#pragma unroll
    for (int o = 1; o < 64; o <<= 1) v += __shfl_xor(v, o);
    return v;
}

struct Args { const float* in[17]; float* out; unsigned char* ws; };

struct P0Item { const float* src; const float* gk; bf16* dst; int N, K, k0; };
__device__ __forceinline__ P0Item p0_decode(const Args& a, int it) {
    constexpr int I_IN = 32 * 192, I_OUT = 32 * 64, I_G = 32 * 176;
    unsigned char* ws = a.ws; P0Item r; int n0, kb, drow; r.gk = nullptr;
    if (it < I_IN) { kb = it / 192; n0 = 32 * (it % 192); drow = n0;
        if (n0 >= 5120) { const int ch = n0 - 5120; drow = 4096 + (ch >> 7) * 256 + 128 + (ch & 127); } else if (n0 >= 4096) { const int ch = n0 - 4096; drow = 4096 + (ch >> 7) * 256 + (ch & 127); }
        r.src = a.in[6]; r.N = INC; r.K = DM; r.dst = (bf16*)(ws + WS_WIN); }
    else if ((it -= I_IN) < I_OUT) { kb = it / 64; n0 = 32 * (it % 64); drow = n0; r.src = a.in[12]; r.N = DM; r.K = DM; r.dst = (bf16*)(ws + WS_WOUT); }
    else if ((it -= I_OUT) < 2 * I_G) { const int up = it >= I_G; if (up) it -= I_G; kb = it / 176; n0 = 32 * (it % 176); drow = (n0 >> 7) * 256 + up * 128 + (n0 & 127);
        r.src = a.in[up ? 15 : 14]; r.N = DFF; r.K = DM; r.dst = (bf16*)(ws + WS_WGU); r.gk = a.in[13]; }
    else { it -= 2 * I_G; kb = it / 64; n0 = 32 * (it % 64); drow = n0; r.src = a.in[16]; r.N = DM; r.K = DFF; r.dst = (bf16*)(ws + WS_WDN); }
    r.k0 = 64 * kb; r.src += (size_t)r.k0 * r.N + n0; r.dst += (size_t)drow * r.K + r.k0;
    return r;
}
__device__ __forceinline__ void p0_load(const P0Item& p, f32x4 (&v)[8], int lane) {
#pragma unroll
    for (int j = 0; j < 8; ++j) v[j] = __builtin_nontemporal_load((const f32x4*)(p.src + (size_t)(8 * j + (lane >> 3)) * p.N + 4 * (lane & 7)));
}
__device__ __forceinline__ void p0_finish(const P0Item& p, const f32x4 (&v)[8], LAS float* scr, int lane) {
#pragma unroll
    for (int j = 0; j < 8; ++j) { const int kk = 8 * j + (lane >> 3); const float g = p.gk ? p.gk[p.k0 + kk] : 1.0f; LAS float* s = scr + kk * 33 + 4 * (lane & 7);
        s[0] = v[j][0] * g; s[1] = v[j][1] * g; s[2] = v[j][2] * g; s[3] = v[j][3] * g; }
    asm volatile("s_waitcnt lgkmcnt(0)" ::: "memory");
    const int c = lane & 7;
#pragma unroll
    for (int j = 0; j < 4; ++j) { const int n = (lane >> 3) + 8 * j; const LAS float* s = scr + (8 * c) * 33 + n;
        u32x4 o; o.x = pk2(s[0 * 33], s[1 * 33]); o.y = pk2(s[2 * 33], s[3 * 33]); o.z = pk2(s[4 * 33], s[5 * 33]); o.w = pk2(s[6 * 33], s[7 * 33]);
        *(u32x4*)(p.dst + (size_t)n * p.K + 8 * c) = o; }
    asm volatile("s_waitcnt lgkmcnt(0)" ::: "memory");
}
__device__ __forceinline__ void p0_prologue(const Args& a, LAS unsigned char* lds, int gw, int NGW, int lane, int wave) {
    LAS float* scr = (LAS float*)(lds + wave * 16384);
    unsigned char* ws = a.ws;
    constexpr int NITEMS = 32 * 192 + 32 * 64 + 2 * 32 * 176 + 88 * 64;
    {
        int it = gw; f32x4 va[8], vb[8]; P0Item pa, pb;
        if (it < NITEMS) { pa = p0_decode(a, it); p0_load(pa, va, lane); }
        while (it < NITEMS) {
            const int itb = it + NGW;
            if (itb < NITEMS) { pb = p0_decode(a, itb); p0_load(pb, vb, lane); }
            p0_finish(pa, va, scr, lane);
            it = itb + NGW;
            if (itb >= NITEMS) break;
            if (it < NITEMS) { pa = p0_decode(a, it); p0_load(pa, va, lane); }
            p0_finish(pb, vb, scr, lane);
        }
    }
    const float* g1 = a.in[5];
    for (int m = gw; m < MT; m += NGW) {
        const float* xrow = m < NP ? a.in[0] + (size_t)m * DM : a.in[1] + (size_t)(m - NP) * DM;
        const f32x4* xr = (const f32x4*)xrow + lane; f32x4 v[8]; float s = 0.f;
#pragma unroll
        for (int j = 0; j < 8; ++j) { v[j] = xr[64 * j]; s += (v[j][0] * v[j][0] + v[j][1] * v[j][1]) + (v[j][2] * v[j][2] + v[j][3] * v[j][3]); }
        const float rs = __builtin_amdgcn_rsqf(wave_sum(s) * (1.0f / DM) + EPS);
        u32x2* o = (u32x2*)((bf16*)(ws + WS_HN) + (size_t)m * DM) + lane;
#pragma unroll
        for (int j = 0; j < 8; ++j) { const f32x4 g = *((const f32x4*)g1 + 64 * j + lane); u32x2 w; w.x = pk2(v[j][0] * rs * g[0], v[j][1] * rs * g[1]); w.y = pk2(v[j][2] * rs * g[2], v[j][3] * rs * g[3]); o[64 * j] = w; }
    }
}

template <bool SAMPLE>
__device__ __forceinline__ void attn_item(const Args& a, LAS unsigned char* lds, int code) {
    constexpr int NH = SAMPLE ? 4 : 1, KS = NH * 256 + 16, VS = NH * 256 + 32, K_OFF = 0, V_OFF = 32 * KS;
    int tid_ = threadIdx.x; asm volatile("" : "+v"(tid_));
    const int tid = tid_, lane = tid & 63, r32 = lane & 31, hi = lane >> 5; const int wid = __builtin_amdgcn_readfirstlane(tid >> 6);
    unsigned char* ws = a.ws;
    int slot, nsteps, kvpos0, qw, head, hl; size_t qrow;
    const bf16 *kgb = nullptr, *vgb = nullptr; const float *kgf = nullptr, *vgf = nullptr;
    if (SAMPLE) {
        const int b = (code >> 1) & 7, hg = (code >> 4) & 1, c = code >> 5;
        slot = 1024 + (b * 2 + hg) * 17 + c; hl = wid >> 1; head = hg * 4 + hl; const int rg = wid & 1;
        qw = PAST + 32 * rg; qrow = (size_t)NP + b * DSEQ + 32 * rg + r32;
        if (c < 16) { nsteps = 8; kvpos0 = 256 * c; kgf = a.in[2] + ((size_t)b * PAST + kvpos0 + (tid >> 7)) * AW + hg * 512 + 4 * (tid & 127); vgf = a.in[3] + ((size_t)b * PAST + kvpos0 + (tid >> 7)) * AW + hg * 512 + 4 * (tid & 127); }
        else { nsteps = 2; kvpos0 = PAST; kgf = a.out + OFF_KS + ((size_t)b * DSEQ + (tid >> 7)) * AW + hg * 512 + 4 * (tid & 127); vgf = a.out + OFF_VS + ((size_t)b * DSEQ + (tid >> 7)) * AW + hg * 512 + 4 * (tid & 127); }
    } else {
        const int bh = (code >> 1) & 15, qb = (code >> 5) & 15, c = (code >> 9) & 3, b = bh >> 3;
        head = bh & 7; hl = 0; slot = (bh * 16 + qb) * 4 + c; nsteps = p_nsteps(qb, c); kvpos0 = 1024 * c;
        qw = qb * 256 + 32 * wid; qrow = (size_t)b * SEQ + qw + r32;
        kgb = (const bf16*)(ws + WS_K) + ((size_t)b * SEQ + kvpos0 + (tid >> 4)) * AW + head * 128 + (tid & 15) * 8;
        vgb = (const bf16*)(ws + WS_V) + ((size_t)b * SEQ + kvpos0 + (tid >> 4)) * AW + head * 128 + (tid & 15) * 8;
    }
    const int qpos = qw + r32;
    constexpr int Q_OFF = 67584, QS = 272;
    const LAS unsigned char* qlp = lds + Q_OFF + wid * (32 * QS) + r32 * QS + hi * 16;
    { const bf16* qp = (const bf16*)(ws + WS_Q) + qrow * AW + head * 128 + hi * 8;
#pragma unroll
      for (int d0 = 0; d0 < 8; ++d0) *(LAS bf16x8*)(lds + Q_OFF + wid * (32 * QS) + r32 * QS + hi * 16 + d0 * 32) = *(const bf16x8*)(qp + 16 * d0); }
    f32x16 o[4];
#pragma unroll
    for (int i = 0; i < 4; ++i)
#pragma unroll
        for (int r = 0; r < 16; ++r) o[i][r] = 0.f;
    float R = 1.f;
    u32x4 kreg, vreg; f32x4 kf4[8], vf4[8];
#define ATT_LOADK(s_) do { if (SAMPLE) { _Pragma("unroll") for (int i_ = 0; i_ < 8; ++i_) kf4[i_] = *(const f32x4*)(kgf + (size_t)(s_) * 32 * AW + (size_t)i_ * 4 * AW); } \
        else { kreg = *(const u32x4*)(kgb + (size_t)(s_) * 32 * AW); } } while (0)
#define ATT_LOADV(s_) do { if (SAMPLE) { _Pragma("unroll") for (int i_ = 0; i_ < 8; ++i_) vf4[i_] = *(const f32x4*)(vgf + (size_t)(s_) * 32 * AW + (size_t)i_ * 4 * AW); } \
        else { vreg = *(const u32x4*)(vgb + (size_t)(s_) * 32 * AW); } } while (0)
#define ATT_STOREK() do { if (SAMPLE) { _Pragma("unroll") for (int i_ = 0; i_ < 8; ++i_) { const int key_ = (tid >> 7) + 4 * i_, f4_ = tid & 127; \
            u32x2 kw_; kw_.x = pk2(kf4[i_][0], kf4[i_][1]); kw_.y = pk2(kf4[i_][2], kf4[i_][3]); *(LAS u32x2*)(lds + K_OFF + key_ * KS + f4_ * 8) = kw_; } } \
        else { *(LAS u32x4*)(lds + K_OFF + (tid >> 4) * KS + (tid & 15) * 16) = kreg; } } while (0)
#define ATT_STOREV() do { if (SAMPLE) { _Pragma("unroll") for (int i_ = 0; i_ < 8; ++i_) { const int key_ = (tid >> 7) + 4 * i_, f4_ = tid & 127; \
            u32x2 vw_; vw_.x = pk2(vf4[i_][0], vf4[i_][1]); vw_.y = pk2(vf4[i_][2], vf4[i_][3]); *(LAS u32x2*)(lds + V_OFF + key_ * VS + f4_ * 8) = vw_; } } \
        else { *(LAS u32x4*)(lds + V_OFF + (tid >> 4) * VS + (tid & 15) * 16) = vreg; } } while (0)
    ATT_LOADK(nsteps - 1); ATT_LOADV(nsteps - 1);
    ATT_STOREK(); ATT_STOREV();
    __syncthreads();
    const LAS unsigned char* kp = lds + K_OFF + r32 * KS + hl * 256 + hi * 16;
    const LAS unsigned char* vp = lds + V_OFF + (4 * hi + ((lane & 15) >> 2)) * VS + hl * 256 + (16 * ((lane >> 4) & 1) + 4 * (lane & 3)) * 2;
    for (int s = nsteps - 1; s >= 0; --s) {
        if (s > 0) { ATT_LOADK(s - 1); if (!SAMPLE) ATT_LOADV(s - 1); }
        const int kb = kvpos0 + 32 * s;
        if (kb < qw + 32) {
            f32x16 p;
#pragma unroll
            for (int r = 0; r < 16; ++r) p[r] = 0.f;
#pragma unroll
            for (int d0 = 0; d0 < 8; ++d0) { const bf16x8 kf = *(const LAS bf16x8*)(kp + d0 * 32); const bf16x8 qf = *(const LAS bf16x8*)(qlp + d0 * 32); p = __builtin_amdgcn_mfma_f32_32x32x16_bf16(kf, qf, p, 0, 0, 0); }
            const bool need_mask = (kb + 31 >= qw);
            float e[16], sf[16];
#pragma unroll
            for (int r = 0; r < 16; ++r) {
                const float z = fminf(p[r], 100.f); float ee = __builtin_amdgcn_exp2f(z); float rr = __builtin_amdgcn_rcpf(1.0f + ee);
                if (need_mask) { const bool msk = (kb + crow(r, hi)) >= qpos; ee = msk ? 0.f : ee; rr = msk ? 1.f : rr; }
                e[r] = ee; sf[r] = rr;
            }
            float oth[4], PP[4];
#pragma unroll
            for (int g = 0; g < 4; ++g) { sf[4 * g + 2] *= sf[4 * g + 3]; sf[4 * g + 1] *= sf[4 * g + 2]; sf[4 * g] *= sf[4 * g + 1]; oth[g] = __shfl_xor(sf[4 * g], 32); PP[g] = sf[4 * g] * oth[g]; }
            const float SP3 = PP[3], SP2 = PP[2] * SP3, SP1 = PP[1] * SP2, SP0 = PP[0] * SP1;
            float A[4]; A[0] = R * SP1; A[1] = R * SP2; A[2] = R * SP3; A[3] = R;
#pragma unroll
            for (int g = 0; g < 4; ++g) A[g] = hi ? A[g] : A[g] * oth[g];
            R *= SP0;
            float w[16];
#pragma unroll
            for (int r = 0; r < 16; ++r) w[r] = (e[r] * sf[r]) * A[r >> 2];
#pragma unroll
            for (int s2 = 0; s2 < 2; ++s2) {
                u32x4 pw; pw.x = pk2(w[8 * s2 + 0], w[8 * s2 + 1]); pw.y = pk2(w[8 * s2 + 2], w[8 * s2 + 3]); pw.z = pk2(w[8 * s2 + 4], w[8 * s2 + 5]); pw.w = pk2(w[8 * s2 + 6], w[8 * s2 + 7]);
                const bf16x8 pa = __builtin_bit_cast(bf16x8, pw);
#pragma unroll
                for (int db = 0; db < 4; ++db) {
                    const s16x4 lo = __builtin_bit_cast(s16x4, __builtin_amdgcn_ds_read_tr16_b64_v4i16((LAS s16x4*)(vp + (16 * s2) * VS + db * 64)));
                    const s16x4 hh = __builtin_bit_cast(s16x4, __builtin_amdgcn_ds_read_tr16_b64_v4i16((LAS s16x4*)(vp + (16 * s2 + 8) * VS + db * 64)));
                    const bf16x8 vb = __builtin_shufflevector(lo, hh, 0, 1, 2, 3, 4, 5, 6, 7);
                    o[db] = __builtin_amdgcn_mfma_f32_32x32x16_bf16(pa, vb, o[db], 0, 0, 0);
                }
            }
        }
        __syncthreads();
        if (s > 0) { ATT_STOREK(); if (SAMPLE) ATT_LOADV(s - 1); ATT_STOREV(); }
        __syncthreads();
    }
#undef ATT_LOADK
#undef ATT_LOADV
#undef ATT_STOREK
#undef ATT_STOREV
    float* op = (float*)(ws + WS_OP) + ((size_t)(slot * 8 + wid) * 32) * 128;
#pragma unroll
    for (int db = 0; db < 4; ++db)
#pragma unroll
        for (int r = 0; r < 16; ++r) op[crow(r, hi) * 128 + db * 32 + r32] = o[db][r];
    if (hi == 0) ((float*)(ws + WS_TP))[(slot * 8 + wid) * 32 + r32] = R;
}

__device__ __forceinline__ void mix_rows(const Args& a, int gw, int NGW, int lane) {
    unsigned char* ws = a.ws;
    const float* OP = (const float*)(ws + WS_OP); const float* TP = (const float*)(ws + WS_TP);
    const bf16* U = (const bf16*)(ws + WS_U); const bf16* GB = (const bf16*)(ws + WS_GB); bf16* MIX = (bf16*)(ws + WS_MIX);
    const float* cw = a.in[9]; const float* ga = a.in[10]; const float* gc = a.in[11];
    for (int m = gw; m < MT; m += NGW) {
        const int h = lane >> 3, d0 = (lane & 7) * 16;
        int nparts, slot0, wid, q;
        if (m < NP) { const int b = m >> 12, t = m & 4095, qb = t >> 8; wid = (t & 255) >> 5; q = t & 31; nparts = (qb >> 2) + 1; slot0 = ((b * 8 + h) * 16 + qb) * 4; }
        else { const int r = m - NP, b = r >> 6, t = r & 63, rg = t >> 5; q = t & 31; wid = (h & 3) * 2 + rg; nparts = 17; slot0 = 1024 + (b * 2 + (h >> 2)) * 17; }
        f32x4 acc[4];
#pragma unroll
        for (int i = 0; i < 4; ++i) acc[i] = (f32x4){0.f, 0.f, 0.f, 0.f};
        float Rr = 1.f;
        for (int c = nparts - 1; c >= 0; --c) {
            const size_t base = (size_t)((slot0 + c) * 8 + wid) * 32 + q;
            const f32x4* p = (const f32x4*)(OP + base * 128 + d0);
#pragma unroll
            for (int i = 0; i < 4; ++i) acc[i] += p[i] * Rr;
            Rr *= TP[base];
        }
        float s = 0.f;
#pragma unroll
        for (int i = 0; i < 4; ++i) s += (acc[i][0] * acc[i][0] + acc[i][1] * acc[i][1]) + (acc[i][2] * acc[i][2] + acc[i][3] * acc[i][3]);
        float rs = __builtin_amdgcn_rsqf(wave_sum(s) * (1.0f / AW) + EPS);
        {
            const f32x4* g = (const f32x4*)(ga + h * 128 + d0); u32x4 w0, w1;
            f32x4 v0 = acc[0] * rs * g[0], v1 = acc[1] * rs * g[1], v2 = acc[2] * rs * g[2], v3 = acc[3] * rs * g[3];
            w0.x = pk2(v0[0], v0[1]); w0.y = pk2(v0[2], v0[3]); w0.z = pk2(v1[0], v1[1]); w0.w = pk2(v1[2], v1[3]);
            w1.x = pk2(v2[0], v2[1]); w1.y = pk2(v2[2], v2[3]); w1.z = pk2(v3[0], v3[1]); w1.w = pk2(v3[2], v3[3]);
            u32x4* o = (u32x4*)(MIX + (size_t)m * DM + h * 128 + d0); o[0] = w0; o[1] = w1;
        }
        const int c0 = lane * 16; int t, tb; const float* st = nullptr;
        if (m < NP) { t = m & 4095; tb = m - t; } else { const int r = m - NP; t = r & 63; tb = m - t; st = a.in[4] + (size_t)(r >> 6) * 2 * CC; }
        float u0[16], u1[16], u2[16];
        { const u32x4* p = (const u32x4*)(U + (size_t)m * CC + c0); const u32x4 x0 = p[0], x1 = p[1];
          const unsigned ww[8] = {x0.x, x0.y, x0.z, x0.w, x1.x, x1.y, x1.z, x1.w};
#pragma unroll
          for (int i = 0; i < 8; ++i) { u2[2 * i] = bflo(ww[i]); u2[2 * i + 1] = bfhi(ww[i]); } }
        if (t >= 1) { const u32x4* p = (const u32x4*)(U + (size_t)(m - 1) * CC + c0); const u32x4 x0 = p[0], x1 = p[1];
          const unsigned ww[8] = {x0.x, x0.y, x0.z, x0.w, x1.x, x1.y, x1.z, x1.w};
#pragma unroll
          for (int i = 0; i < 8; ++i) { u1[2 * i] = bflo(ww[i]); u1[2 * i + 1] = bfhi(ww[i]); } }
        else {
#pragma unroll
          for (int i = 0; i < 16; ++i) u1[i] = st ? st[CC + c0 + i] : 0.f; }
        if (t >= 2) { const u32x4* p = (const u32x4*)(U + (size_t)(m - 2) * CC + c0); const u32x4 x0 = p[0], x1 = p[1];
          const unsigned ww[8] = {x0.x, x0.y, x0.z, x0.w, x1.x, x1.y, x1.z, x1.w};
#pragma unroll
          for (int i = 0; i < 8; ++i) { u0[2 * i] = bflo(ww[i]); u0[2 * i + 1] = bfhi(ww[i]); } }
        else {
#pragma unroll
          for (int i = 0; i < 16; ++i) u0[i] = st ? st[(t == 0 ? 0 : CC) + c0 + i] : 0.f; }
        float oc[16]; float s2 = 0.f;
        { const u32x4* p = (const u32x4*)(GB + (size_t)m * CC + c0); const u32x4 x0 = p[0], x1 = p[1];
          const unsigned ww[8] = {x0.x, x0.y, x0.z, x0.w, x1.x, x1.y, x1.z, x1.w};
#pragma unroll
          for (int i = 0; i < 16; ++i) { const float gbv = (i & 1) ? bfhi(ww[i >> 1]) : bflo(ww[i >> 1]);
              oc[i] = gbv * (cw[c0 + i] * u0[i] + cw[CC + c0 + i] * u1[i] + cw[2 * CC + c0 + i] * u2[i]); s2 += oc[i] * oc[i]; } }
        rs = __builtin_amdgcn_rsqf(wave_sum(s2) * (1.0f / CC) + EPS);
        { u32x4 w0, w1; unsigned ww[8];
#pragma unroll
          for (int i = 0; i < 8; ++i) ww[i] = pk2(oc[2 * i] * rs * gc[c0 + 2 * i], oc[2 * i + 1] * rs * gc[c0 + 2 * i + 1]);
          w0.x = ww[0]; w0.y = ww[1]; w0.z = ww[2]; w0.w = ww[3]; w1.x = ww[4]; w1.y = ww[5]; w1.z = ww[6]; w1.w = ww[7];
          u32x4* o = (u32x4*)(MIX + (size_t)m * DM + AW + c0); o[0] = w0; o[1] = w1; }
        (void)tb;
    }
}
#ifndef REP_P0
#define REP_P0 1
#endif
#ifndef REP_P1
#define REP_P1 1
#endif
#ifndef REP_P3
#define REP_P3 1
#endif
#ifndef REP_P4
#define REP_P4 1
#endif
#ifndef REP_P5
#define REP_P5 1
#endif
__global__ void __launch_bounds__(NWAVES * 64, 2) fwd_megakernel(Args args) {
    extern __shared__ __attribute__((aligned(16))) unsigned char lds_raw[];
    cg::grid_group grid = cg::this_grid();
    LAS unsigned char* lds = (LAS unsigned char*)lds_raw;
    const int G = gridDim.x, bx = blockIdx.x, NGW = G * NWAVES;
#define PHASE_IDS() int tid = threadIdx.x; asm volatile("" : "+v"(tid)); const int lane = tid & 63; const int wave = __builtin_amdgcn_readfirstlane(tid >> 6); const int gw = bx * NWAVES + wave; (void)lane; (void)gw
    unsigned char* ws = args.ws;
    unsigned* ctl = (unsigned*)(ws + WS_CTL);
    LAS float* red = (LAS float*)(lds + RED_OFF);
    volatile LAS int* misc = (volatile LAS int*)(lds + MISC_OFF);

    { PHASE_IDS(); if (bx == 0 && tid == 0) { ctl[0] = 0u; ctl[64] = 0u; }
#ifndef NO_P0
    for (int rep_ = 0; rep_ < REP_P0; ++rep_) p0_prologue(args, lds, gw, NGW, lane, wave);
#endif
    }
    grid.sync();

#ifndef NO_P1
    for (int rep_ = 0; rep_ < REP_P1; ++rep_) {
        pg8::Gemm g{(const pg8::bf16_t*)(ws + WS_HN), (const pg8::bf16_t*)(ws + WS_WIN), MT, INC, DM}; pg8::StaticOrder S; S.init(MT, INC, DM, G, bx);
        pg8::EpiIn E{(bf16*)(ws + WS_Q), (bf16*)(ws + WS_K), (bf16*)(ws + WS_V), (bf16*)(ws + WS_GB), (bf16*)(ws + WS_U), args.out, args.in[7], args.in[8], red,
                     1.4426950408889634f * 0.08838834764831845f, OFF_KP, OFF_VP, OFF_CP, OFF_KS, OFF_VS, OFF_CS};
        pg8::gemm_phase<pg8::EpiIn, pg8::StaticOrder, true, true>(lds, g, S, E);
    }
#endif
    grid.sync();

#ifndef NO_P2
    {
        const int nitems = g_items.n;
        PHASE_IDS();
#ifdef DUP_P2
        for (int rep = 0; rep < 2; ++rep)
#else
        const int rep = 0;
#endif
        for (;;) {
            if (tid == 0) misc[0] = (int)atomicAdd(ctl + 64 * rep, 1u);
            __syncthreads();
            const int it = misc[0];
            __syncthreads();
            if (it >= nitems) break;
            const int code = g_items.v[it];
#if defined(ONLY_S)
            attn_item<true>(args, lds, code);
#elif defined(ONLY_P)
            attn_item<false>(args, lds, code);
#else
            if (code & 1) attn_item<true>(args, lds, code); else attn_item<false>(args, lds, code);
#endif
        }
    }
#endif
    grid.sync();

#ifndef NO_P3
    for (int rep_ = 0; rep_ < REP_P3; ++rep_) { PHASE_IDS(); mix_rows(args, gw, NGW, lane); }
#endif
    grid.sync();

#ifndef NO_P4
    for (int rep_ = 0; rep_ < REP_P4; ++rep_) {
        pg8::Gemm g{(const pg8::bf16_t*)(ws + WS_MIX), (const pg8::bf16_t*)(ws + WS_WOUT), MT, DM, DM}; pg8::StaticOrder S; S.init(MT, DM, DM, G, bx);
        pg8::EpiOut E{args.in[0], args.in[1], args.out + OFF_Y, (bf16*)(ws + WS_HN), (float*)(ws + WS_SSQ), red};
        pg8::gemm_phase<pg8::EpiOut, pg8::StaticOrder, true, true>(lds, g, S, E);
    }
#endif
    grid.sync();

#ifndef NO_P5
    for (int rep_ = 0; rep_ < REP_P5; ++rep_) {
        pg8::Gemm g{(const pg8::bf16_t*)(ws + WS_HN), (const pg8::bf16_t*)(ws + WS_WGU), MT, 2 * DFF, DM}; pg8::StaticOrder S; S.init(MT, 2 * DFF, DM, G, bx);
        pg8::EpiGU E{(bf16*)(ws + WS_H), (const float*)(ws + WS_SSQ)};
        pg8::gemm_phase<pg8::EpiGU, pg8::StaticOrder, true, true>(lds, g, S, E);
    }
#endif
    grid.sync();

#ifndef NO_P6
    {
        pg8::Gemm g{(const pg8::bf16_t*)(ws + WS_H), (const pg8::bf16_t*)(ws + WS_WDN), MT, DM, DFF}; pg8::TailSplitOrder S; S.init(MT, DM, DFF, G, bx);
        pg8::EpiDown E{args.out + OFF_Y};
        pg8::gemm_phase<pg8::EpiDown, pg8::TailSplitOrder, true, true>(lds, g, S, E);
    }
#endif
}

extern "C" void kernel_launch(void* const* d_in, const int* in_sizes, int n_in, void* d_out, int out_size, void* d_ws, size_t ws_size, hipStream_t stream) {
    static int grid = 0;
    if (grid == 0) {
        if (n_in != 17 || (size_t)out_size != OUT_TOTAL || ws_size < WS_END) { fprintf(stderr, "kernel_launch: unexpected shapes (n_in %d out %d ws %zu need %zu)\n", n_in, out_size, ws_size, (size_t)WS_END); grid = -1; return; }
        int dev = 0, cus = 0, per_cu = 0;
        hipGetDevice(&dev); hipDeviceGetAttribute(&cus, hipDeviceAttributeMultiprocessorCount, dev);
        hipFuncSetAttribute((const void*)fwd_megakernel, hipFuncAttributeMaxDynamicSharedMemorySize, LDS_BYTES);
        hipOccupancyMaxActiveBlocksPerMultiprocessor(&per_cu, (const void*)fwd_megakernel, NWAVES * 64, LDS_BYTES);
        if (per_cu < 1) { fprintf(stderr, "kernel_launch: occupancy query says %d blocks per CU\n", per_cu); per_cu = 1; }
        (void)hipGetLastError();
        grid = cus;
    }
    if (grid < 0) return;
    Args a{};
    for (int i = 0; i < 17; ++i) a.in[i] = (const float*)d_in[i];
    a.out = (float*)d_out; a.ws = (unsigned char*)d_ws;
    void* kargs[] = {&a};
    hipError_t e = hipLaunchCooperativeKernel((const void*)fwd_megakernel, dim3(grid), dim3(NWAVES * 64), kargs, LDS_BYTES, stream);
    if (e != hipSuccess) fprintf(stderr, "cooperative launch failed: %s (grid %d)\n", hipGetErrorString(e), grid);
}
```

```cpp
#include <hip/hip_runtime.h>
#include <hip/hip_cooperative_groups.h>
#include <cstdio>
#include <cstdint>
namespace cg = cooperative_groups;
namespace pg8 {
#define PG8_LAS __attribute__((address_space(3)))
typedef unsigned short bf16_t;
typedef short bf16x8 __attribute__((ext_vector_type(8)));
typedef float f32x4 __attribute__((ext_vector_type(4)));
typedef unsigned u32x4 __attribute__((ext_vector_type(4)));
constexpr int BM = 256, BK = 64, HALF = 128, HTB = HALF * BK * 2  , STAGE_BYTES = 8 * HTB, NXCD = 8, WGM = 8;

__host__ __device__ __forceinline__ int lds_byte(int r, int c) { const int st = (r >> 4) * 2 + (c >> 5), rr = r & 15, cc = c & 31, ob = rr * 64 + cc * 2; return st * 1024 + (ob ^ (((ob >> 9) & 1) << 5)); }
__host__ __device__ __forceinline__ void stage_rc(int b, int& R, int& C) { const int st = b / 1024, sb = b % 1024, swz = sb ^ (((sb >> 9) & 1) << 5); R = (st >> 1) * 16 + swz / 64; C = (st & 1) * 32 + (swz % 64) / 2; }
__host__ __device__ __forceinline__ int perm32(int rho) { const int n = rho >> 4, i = rho & 15; return 8 * (i >> 2) + 4 * n + (i & 3); }

struct Unit { int pm, pn, k0, nt, split; };
struct Gemm { const bf16_t* A; const bf16_t* Bt; int M, N, K; };

struct StaticOrder {
    int nM, nN, nwg, G, c, ntk;
    __host__ __device__ void init(int M, int N, int K, int G_, int c_) { nM = M / BM; nN = N / BM; nwg = nM * nN; G = G_; c = c_; ntk = K / BK; }
    __host__ __device__ bool next(int i, Unit& u) const {
        const long L = (long)i * G + c; if (L >= nwg) return false;
        int wgid = (int)L; { const int q = nwg / NXCD, r = nwg % NXCD, xcd = wgid % NXCD, off = wgid / NXCD; wgid = (xcd < r ? xcd * (q + 1) : r * (q + 1) + (xcd - r) * q) + off; }
        const int nig = WGM * nN, gid = wgid / nig, fm = gid * WGM, gsz = (nM - fm) < WGM ? (nM - fm) : WGM;
        u.pm = fm + ((wgid % nig) % gsz); u.pn = (wgid % nig) / gsz; u.k0 = 0; u.nt = ntk; u.split = 0; return true;
    }
    __device__ __forceinline__ void a_ready(const Unit&) const {}
    __device__ __forceinline__ void done(const Unit&) const {}
};

struct TailSplitOrder {
    StaticOrder so; int G, c;
    __host__ __device__ void init(int M, int N, int K, int G_, int c_) { so.init(M, N, K, G_, c_); G = G_; c = c_; }
    __host__ __device__ bool next(int i, Unit& u) const {
        if (G != 256 || so.nM != 34 || so.nN != 8 || so.ntk != 88) return so.next(i, u);
        if (i == 0) { const int x = c & 7, j = c >> 3; u.pm = 4 * x + (j & 3); u.pn = j >> 2; u.k0 = 0; u.nt = 88; u.split = 0; return true; }
        if (i == 1 && c < 128) { const int tu = c >> 3, s = c & 7; u.pm = 32 + (tu >> 3); u.pn = tu & 7; u.k0 = 11 * s + (s & 1); u.nt = 12 - 2 * (s & 1); u.split = 1; return true; }
        return false;
    }
    __device__ __forceinline__ void a_ready(const Unit&) const {}
    __device__ __forceinline__ void done(const Unit&) const {}
};

__device__ __forceinline__ unsigned cvt_pk_bf16(float lo, float hi) { unsigned r; asm volatile("v_cvt_pk_bf16_f32 %0, %1, %2" : "=v"(r) : "v"(lo), "v"(hi)); return r; }
typedef float f32x2 __attribute__((ext_vector_type(2)));
#define PG8_LBAR() asm volatile("s_waitcnt lgkmcnt(0)\n\ts_barrier" ::: "memory")
constexpr int NPROMPT = 8192;
__device__ __forceinline__ u32x4 pack8(const f32x4 a, const f32x4 b) { u32x4 w; w.x = cvt_pk_bf16(a[0], a[1]); w.y = cvt_pk_bf16(a[2], a[3]); w.z = cvt_pk_bf16(b[0], b[1]); w.w = cvt_pk_bf16(b[2], b[3]); return w; }

struct EpiIn {
    static constexpr bool PERM = true, AFTER_DRAIN = false;
    bf16_t *Q, *Kb, *Vb, *GB, *U; float* out; const float *gq, *gk; PG8_LAS float* red; float qscale;
    size_t off_kp, off_vp, off_cp, off_ks, off_vs, off_cs;
    __device__ __forceinline__ void operator()(const f32x4 (&acc)[2][2][4][2], const Unit& u, int wr, int wc, int fr, int fq) const {
        const int pn = u.pn, rowt = u.pm * BM, rl0 = wr * 64 + fr, cw = wc * 32 + 8 * fq;
        const bool prompt = rowt < NPROMPT;
        if (pn < 8) {
            const bool isq = pn < 4;
#pragma unroll
            for (int ai = 0; ai < 2; ++ai)
#pragma unroll
                for (int m = 0; m < 4; ++m)
#pragma unroll
                    for (int bj = 0; bj < 2; ++bj) {
                        const f32x4 a = acc[ai][bj][m][0], b = acc[ai][bj][m][1];
                        float s = (a[0] * a[0] + a[1] * a[1]) + (a[2] * a[2] + a[3] * a[3]) + (b[0] * b[0] + b[1] * b[1]) + (b[2] * b[2] + b[3] * b[3]);
                        s += __shfl_xor(s, 16); s += __shfl_xor(s, 32);
                        if (fq == 0) red[((ai * HALF + rl0 + m * 16) * 2 + bj) * 4 + wc] = s;
                    }
            PG8_LBAR();
            const float* g = isq ? gq : gk;
            const f32x4 g0 = *(const f32x4*)(g + cw), g1 = *(const f32x4*)(g + cw + 4);
#pragma unroll
            for (int ai = 0; ai < 2; ++ai)
#pragma unroll
                for (int m = 0; m < 4; ++m) {
                    const int rl = ai * HALF + rl0 + m * 16; const size_t row = (size_t)(rowt + rl);
#pragma unroll
                    for (int bj = 0; bj < 2; ++bj) {
                        const f32x4 p = *(const PG8_LAS f32x4*)(red + (rl * 2 + bj) * 4);
                        float rs = __builtin_amdgcn_rsqf(((p[0] + p[1]) + (p[2] + p[3])) * (1.0f / 128.0f) + 1e-6f);
                        if (isq) rs *= qscale;
                        const f32x4 v0 = acc[ai][bj][m][0] * rs * g0, v1 = acc[ai][bj][m][1] * rs * g1;
                        if (isq) { *(u32x4*)(Q + row * 1024 + pn * 256 + bj * HALF + cw) = pack8(v0, v1); }
                        else {
                            const int col = (pn - 4) * 256 + bj * HALF + cw;
                            float* o = prompt ? out + off_kp + row * 1024 + col : out + off_ks + (row - NPROMPT) * 1024 + col;
                            *(f32x4*)o = v0; *(f32x4*)(o + 4) = v1;
                            if (prompt) *(u32x4*)(Kb + row * 1024 + col) = pack8(v0, v1);
                        }
                    }
                }
        } else if (pn < 12) {
#pragma unroll
            for (int ai = 0; ai < 2; ++ai)
#pragma unroll
                for (int m = 0; m < 4; ++m) {
                    const size_t row = (size_t)(rowt + ai * HALF + rl0 + m * 16);
#pragma unroll
                    for (int bj = 0; bj < 2; ++bj) {
                        const int col = (pn - 8) * 256 + bj * HALF + cw; const f32x4 v0 = acc[ai][bj][m][0], v1 = acc[ai][bj][m][1];
                        float* o = prompt ? out + off_vp + row * 1024 + col : out + off_vs + (row - NPROMPT) * 1024 + col;
                        *(f32x4*)o = v0; *(f32x4*)(o + 4) = v1;
                        if (prompt) *(u32x4*)(Vb + row * 1024 + col) = pack8(v0, v1);
                    }
                }
        } else if (pn < 16) {
#pragma unroll
            for (int ai = 0; ai < 2; ++ai)
#pragma unroll
                for (int m = 0; m < 4; ++m) {
                    const size_t row = (size_t)(rowt + ai * HALF + rl0 + m * 16);
#pragma unroll
                    for (int bj = 0; bj < 2; ++bj) *(u32x4*)(GB + row * 1024 + (pn - 12) * 256 + bj * HALF + cw) = pack8(acc[ai][bj][m][0], acc[ai][bj][m][1]);
                }
        } else {
#pragma unroll
            for (int ai = 0; ai < 2; ++ai)
#pragma unroll
                for (int m = 0; m < 4; ++m) {
                    const int rowi = rowt + ai * HALF + rl0 + m * 16; const int ch = (pn - 16) * HALF + cw;
                    const f32x4 v0 = acc[ai][0][m][0] * acc[ai][1][m][0], v1 = acc[ai][0][m][1] * acc[ai][1][m][1];
                    *(u32x4*)(U + (size_t)rowi * 1024 + ch) = pack8(v0, v1);
                    if (prompt) { const int t = rowi & 4095; if (t >= 4094) { float* o = out + off_cp + ((rowi >> 12) * 2 + (t - 4094)) * 1024 + ch; *(f32x4*)o = v0; *(f32x4*)(o + 4) = v1; } }
                    else { const int rs_ = rowi - NPROMPT, t = rs_ & 63; if (t >= 62) { float* o = out + off_cs + ((rs_ >> 6) * 2 + (t - 62)) * 1024 + ch; *(f32x4*)o = v0; *(f32x4*)(o + 4) = v1; } }
                }
        }
    }
};

struct EpiOut {
    static constexpr bool PERM = true, AFTER_DRAIN = false;
    const float *xp, *xs; float* Y; bf16_t* X1; float* ssq; PG8_LAS float* red;
    __device__ __forceinline__ void operator()(const f32x4 (&acc)[2][2][4][2], const Unit& u, int wr, int wc, int fr, int fq) const {
        const int pn = u.pn, rowt = u.pm * BM, rl0 = wr * 64 + fr, cw = wc * 32 + 8 * fq;
        const float* xin = rowt < NPROMPT ? xp + (size_t)rowt * 2048 : xs + (size_t)(rowt - NPROMPT) * 2048;
#pragma unroll
        for (int ai = 0; ai < 2; ++ai)
#pragma unroll
            for (int m = 0; m < 4; ++m) {
                const int rl = ai * HALF + rl0 + m * 16; float s = 0.f;
#pragma unroll
                for (int bj = 0; bj < 2; ++bj) {
                    const int col = pn * 256 + bj * HALF + cw; const float* xi = xin + (size_t)rl * 2048 + col;
                    const f32x4 v0 = *(const f32x4*)xi + acc[ai][bj][m][0], v1 = *(const f32x4*)(xi + 4) + acc[ai][bj][m][1];
                    float* o = Y + (size_t)(rowt + rl) * 2048 + col; *(f32x4*)o = v0; *(f32x4*)(o + 4) = v1;
                    *(u32x4*)(X1 + (size_t)(rowt + rl) * 2048 + col) = pack8(v0, v1);
                    s += (v0[0] * v0[0] + v0[1] * v0[1]) + (v0[2] * v0[2] + v0[3] * v0[3]) + (v1[0] * v1[0] + v1[1] * v1[1]) + (v1[2] * v1[2] + v1[3] * v1[3]);
                }
                s += __shfl_xor(s, 16); s += __shfl_xor(s, 32);
                if (fq == 0) red[rl * 4 + wc] = s;
                asm volatile("" ::: "memory");
            }
        PG8_LBAR();
        if (threadIdx.x < 256) { const f32x4 p = *(const PG8_LAS f32x4*)(red + threadIdx.x * 4); ssq[(size_t)(rowt + threadIdx.x) * 8 + pn] = (p[0] + p[1]) + (p[2] + p[3]); }
        PG8_LBAR();
    }
};

struct EpiGU {
    static constexpr bool PERM = true, AFTER_DRAIN = false;
    bf16_t* H; const float* ssq;
    __device__ __forceinline__ void operator()(const f32x4 (&acc)[2][2][4][2], const Unit& u, int wr, int wc, int fr, int fq) const {
        const int pn = u.pn, rowt = u.pm * BM, rl0 = wr * 64 + fr, cw = wc * 32 + 8 * fq;
#pragma unroll
        for (int ai = 0; ai < 2; ++ai)
#pragma unroll
            for (int m = 0; m < 4; ++m) {
                const size_t row = (size_t)(rowt + ai * HALF + rl0 + m * 16);
                const f32x4 p0 = *(const f32x4*)(ssq + row * 8), p1 = *(const f32x4*)(ssq + row * 8 + 4);
                const float rs = __builtin_amdgcn_rsqf((((p0[0] + p0[1]) + (p0[2] + p0[3])) + ((p1[0] + p1[1]) + (p1[2] + p1[3]))) * (1.0f / 2048.0f) + 1e-6f);
                f32x4 h[2];
#pragma unroll
                for (int n = 0; n < 2; ++n) {
                    const f32x4 g = acc[ai][0][m][n] * rs, up = acc[ai][1][m][n] * rs;
#pragma unroll
                    for (int j = 0; j < 4; ++j) h[n][j] = g[j] * __builtin_amdgcn_rcpf(1.0f + __builtin_amdgcn_exp2f(-1.4426950408889634f * g[j])) * up[j];
                }
                *(u32x4*)(H + row * 5632 + pn * HALF + cw) = pack8(h[0], h[1]);
            }
    }
};

struct EpiDown {
    static constexpr bool PERM = true, AFTER_DRAIN = false;
    float* Y; float* part; unsigned* cnt; PG8_LAS float* red;
    __device__ __forceinline__ void operator()(const f32x4 (&acc)[2][2][4][2], const Unit& u, int wr, int wc, int fr, int fq) const {
        const int pn = u.pn, rowt = u.pm * BM, rl0 = wr * 64 + fr, cw = wc * 32 + 8 * fq;
        if (!u.split) {
#pragma unroll
            for (int ai = 0; ai < 2; ++ai)
#pragma unroll
                for (int m = 0; m < 4; ++m)
#pragma unroll
                    for (int bj = 0; bj < 2; ++bj) {
                        float* o = Y + (size_t)(rowt + ai * HALF + rl0 + m * 16) * 2048 + pn * 256 + bj * HALF + cw;
                        const f32x4 v0 = *(const f32x4*)o + acc[ai][bj][m][0], v1 = *(const f32x4*)(o + 4) + acc[ai][bj][m][1];
                        *(f32x4*)o = v0; *(f32x4*)(o + 4) = v1;
                        if (bj) asm volatile("" ::: "memory");
                    }
        } else {
            const int tu = (u.pm - 32) * 8 + pn, s = u.k0 / 11;
            float* pt = part + (size_t)(tu * 8 + s) * 65536;
#pragma unroll
            for (int ai = 0; ai < 2; ++ai)
#pragma unroll
                for (int m = 0; m < 4; ++m)
#pragma unroll
                    for (int bj = 0; bj < 2; ++bj) { float* o = pt + (ai * HALF + rl0 + m * 16) * 256 + bj * HALF + cw; *(f32x4*)o = acc[ai][bj][m][0]; *(f32x4*)(o + 4) = acc[ai][bj][m][1]; }
            __builtin_amdgcn_fence(__ATOMIC_RELEASE, "agent");
            asm volatile("s_waitcnt vmcnt(0)" ::: "memory");
            PG8_LBAR();
            if (threadIdx.x == 0) { const unsigned old = __hip_atomic_fetch_add(cnt + tu, 1u, __ATOMIC_RELAXED, __HIP_MEMORY_SCOPE_AGENT); ((PG8_LAS unsigned*)red)[0] = old; }
            PG8_LBAR();
            const bool last = ((const PG8_LAS unsigned*)red)[0] == 7u;
            if (last) {
                __builtin_amdgcn_fence(__ATOMIC_ACQUIRE, "agent");
                const float* p0 = part + (size_t)(tu * 8) * 65536;
#pragma unroll
                for (int ai = 0; ai < 2; ++ai)
#pragma unroll
                    for (int m = 0; m < 4; ++m)
#pragma unroll
                        for (int bj = 0; bj < 2; ++bj) {
                            const int off = (ai * HALF + rl0 + m * 16) * 256 + bj * HALF + cw;
                            float* o = Y + (size_t)(rowt + ai * HALF + rl0 + m * 16) * 2048 + pn * 256 + bj * HALF + cw;
                            f32x4 v0 = *(const f32x4*)o, v1 = *(const f32x4*)(o + 4);
#pragma unroll
                            for (int s2 = 0; s2 < 8; ++s2) { v0 += *(const f32x4*)(p0 + (size_t)s2 * 65536 + off); v1 += *(const f32x4*)(p0 + (size_t)s2 * 65536 + off + 4); }
                            *(f32x4*)o = v0; *(f32x4*)(o + 4) = v1;
                            asm volatile("" ::: "memory");
                        }
            }
            PG8_LBAR();
        }
    }
};

struct EpiNone {
    static constexpr bool PERM = true, AFTER_DRAIN = false;
    float* sink;
    __device__ __forceinline__ void operator()(const f32x4 (&acc)[2][2][4][2], const Unit& u, int wr, int wc, int fr, int fq) const {
        if (acc[0][0][0][0][0] == 12345.678f && acc[1][1][3][1][3] == -9876.5f) sink[0] = 1.f;
    }
};
template <class Epi, class Sched, bool ALIGN_EPI = false, bool SP2 = false>
__device__ __forceinline__ void gemm_phase(PG8_LAS unsigned char* lds, const Gemm g, const Sched& S, const Epi& E) {
    int tid_ = threadIdx.x; asm volatile("" : "+v"(tid_));
    const int tid = tid_, wid = __builtin_amdgcn_readfirstlane(tid >> 6), lane = tid & 63, wr = wid >> 2, wc = wid & 3, fr = lane & 15, fq = lane >> 4;
    const int K = g.K;
    unsigned voffA[2], voffB[2];
#pragma unroll
    for (int i = 0; i < 2; ++i) { int R, C; stage_rc(tid * 16 + i * 8192, R, C); const int Rb = Epi::PERM ? ((R & ~31) + perm32(R & 31)) : R;
        voffA[i] = (unsigned)(R * K + C) * 2u; voffB[i] = (unsigned)(Rb * K + C) * 2u; }
    const size_t kstep = (size_t)(BK * 2);
    const size_t hstep = (size_t)HALF * K * 2;
    const size_t tstep = 2 * hstep;
    const unsigned ldsw = (unsigned)wid * 1024u;
    const int aoff = lds_byte(wr * 64 + fr, fq * 8), boff = lds_byte(wc * 32 + fr, fq * 8);
#define PG8_SA(b, h) (((b) * 2 + (h)) * HTB)
#define PG8_SB(b, h) ((4 + (b) * 2 + (h)) * HTB)
#define PG8_STAGE(bufoff, gbase, voff) do { _Pragma("unroll") for (int _i = 0; _i < 2; ++_i) \
        __builtin_amdgcn_global_load_lds((const unsigned*)((const char*)(gbase) + (voff)[_i]), (PG8_LAS unsigned*)(lds + (bufoff) + ldsw + _i * 8192), 16, 0, 0); } while (0)
#define PG8_LDA(dst, b, h) do { _Pragma("unroll") for (int m = 0; m < 4; ++m) _Pragma("unroll") for (int k = 0; k < 2; ++k) dst[m][k] = *(const PG8_LAS bf16x8*)(lds + PG8_SA(b, h) + aoff + m * 2048 + k * 1024); } while (0)
#define PG8_LDB(dst, b, h) do { _Pragma("unroll") for (int n = 0; n < 2; ++n) _Pragma("unroll") for (int k = 0; k < 2; ++k) dst[n][k] = *(const PG8_LAS bf16x8*)(lds + PG8_SB(b, h) + boff + n * 2048 + k * 1024); } while (0)
#define PG8_MMA(ai, bj, At, Bt) do { __builtin_amdgcn_s_setprio(1); _Pragma("unroll") for (int m = 0; m < 4; ++m) _Pragma("unroll") for (int n = 0; n < 2; ++n) _Pragma("unroll") for (int k = 0; k < 2; ++k) \
        acc[ai][bj][m][n] = __builtin_amdgcn_mfma_f32_16x16x32_bf16(Bt[n][k], At[m][k], acc[ai][bj][m][n], 0, 0, 0); __builtin_amdgcn_s_setprio(0); } while (0)
#define PG8_WAIT_V(n) asm volatile("s_waitcnt vmcnt(" #n ")" ::: "memory")
#define PG8_WAIT_L(n) asm volatile("s_waitcnt lgkmcnt(" #n ")" ::: "memory")
#define PG8_BAR __builtin_amdgcn_s_barrier()
#define PG8_SCHED __builtin_amdgcn_sched_barrier(0)
    Unit cur, nxt; int ui = 0;
    if (!S.next(0, cur)) return;
    f32x4 acc[2][2][4][2];
#pragma unroll
    for (int a = 0; a < 2; ++a)
#pragma unroll
        for (int b = 0; b < 2; ++b)
#pragma unroll
            for (int m = 0; m < 4; ++m)
#pragma unroll
                for (int n = 0; n < 2; ++n) acc[a][b][m][n] = (f32x4){0.f, 0.f, 0.f, 0.f};
    bf16x8 At[4][2], B0[2][2], B1[2][2];
    const char* cA = (const char*)g.A + (size_t)cur.pm * tstep + (size_t)cur.k0 * kstep; const char* cB = (const char*)g.Bt + (size_t)cur.pn * tstep + (size_t)cur.k0 * kstep;
    S.a_ready(cur);
    if constexpr (SP2) {
        PG8_STAGE(PG8_SB(0, 0), cB, voffB); PG8_STAGE(PG8_SB(0, 1), cB + hstep, voffB); PG8_STAGE(PG8_SA(0, 0), cA, voffA); PG8_STAGE(PG8_SA(0, 1), cA + hstep, voffA);
        if (wr == 1) PG8_BAR;
        PG8_WAIT_V(2); PG8_BAR;
        PG8_STAGE(PG8_SB(1, 0), cB + kstep, voffB); PG8_STAGE(PG8_SA(1, 0), cA + kstep, voffA); PG8_STAGE(PG8_SB(1, 1), cB + hstep + kstep, voffB);
        PG8_WAIT_V(6); PG8_BAR;
    } else {
        PG8_STAGE(PG8_SB(0, 0), cB, voffB); PG8_STAGE(PG8_SA(0, 0), cA, voffA); PG8_STAGE(PG8_SB(0, 1), cB + hstep, voffB); PG8_STAGE(PG8_SA(0, 1), cA + hstep, voffA);
        if (wr == 1) PG8_BAR;
        PG8_WAIT_V(4); PG8_BAR;
        PG8_STAGE(PG8_SB(1, 0), cB + kstep, voffB); PG8_STAGE(PG8_SA(1, 0), cA + kstep, voffA); PG8_STAGE(PG8_SB(1, 1), cB + hstep + kstep, voffB);
        PG8_WAIT_V(6); PG8_BAR;
    }
    for (;;) {
        const bool has_next = S.next(ui + 1, nxt);
        const char* nA = has_next ? (const char*)g.A + (size_t)nxt.pm * tstep + (size_t)nxt.k0 * kstep : cA; const char* nB = has_next ? (const char*)g.Bt + (size_t)nxt.pn * tstep + (size_t)nxt.k0 * kstep : cB;
        const int nt = cur.nt;
        for (int t = 0; t < nt; t += 2) {
            const bool last = (t == nt - 2);
            const char* a1 = cA + (size_t)(t + 1) * kstep;
            const char* a2 = last ? nA : cA + (size_t)(t + 2) * kstep; const char* b2 = last ? nB : cB + (size_t)(t + 2) * kstep;
            const char* a3 = a2 + kstep; const char* b3 = b2 + kstep;
            if (last && has_next) S.a_ready(nxt);
            if constexpr (SP2) {
            PG8_LDB(B0, 0, 0); PG8_LDB(B1, 0, 1); PG8_SCHED; PG8_LDA(At, 0, 0); PG8_STAGE(PG8_SA(1, 1), a1 + hstep, voffA);
            PG8_WAIT_V(8); PG8_WAIT_L(0); PG8_BAR; PG8_MMA(0, 0, At, B0); PG8_MMA(0, 1, At, B1); PG8_BAR; PG8_SCHED;
            PG8_LDA(At, 0, 1); PG8_STAGE(PG8_SB(0, 0), b2, voffB); PG8_STAGE(PG8_SB(0, 1), b2 + hstep, voffB); PG8_STAGE(PG8_SA(0, 0), a2, voffA);
            PG8_WAIT_V(8); PG8_WAIT_L(0); PG8_BAR; PG8_MMA(1, 0, At, B0); PG8_MMA(1, 1, At, B1); PG8_BAR; PG8_SCHED;
            PG8_LDB(B0, 1, 0); PG8_LDB(B1, 1, 1); PG8_SCHED; PG8_LDA(At, 1, 0); PG8_STAGE(PG8_SA(0, 1), a2 + hstep, voffA);
            PG8_WAIT_V(8); PG8_WAIT_L(0); PG8_BAR; PG8_MMA(0, 0, At, B0); PG8_MMA(0, 1, At, B1); PG8_BAR; PG8_SCHED;
            PG8_LDA(At, 1, 1); PG8_STAGE(PG8_SB(1, 0), b3, voffB); PG8_STAGE(PG8_SB(1, 1), b3 + hstep, voffB); PG8_STAGE(PG8_SA(1, 0), a3, voffA);
            PG8_WAIT_V(8); PG8_WAIT_L(0); PG8_BAR; PG8_MMA(1, 0, At, B0); PG8_MMA(1, 1, At, B1); PG8_BAR; PG8_SCHED;
            } else {
            PG8_LDB(B0, 0, 0); PG8_SCHED; PG8_LDA(At, 0, 0); PG8_STAGE(PG8_SA(1, 1), a1 + hstep, voffA);
            PG8_WAIT_L(8); PG8_BAR; PG8_WAIT_L(0); PG8_MMA(0, 0, At, B0); PG8_BAR; PG8_SCHED;
            PG8_LDB(B1, 0, 1); PG8_STAGE(PG8_SB(0, 0), b2, voffB);
            PG8_BAR; PG8_WAIT_L(0); PG8_MMA(0, 1, At, B1); PG8_BAR;
            PG8_LDA(At, 0, 1); PG8_STAGE(PG8_SA(0, 0), a2, voffA);
            PG8_BAR; PG8_WAIT_L(0); PG8_MMA(1, 0, At, B0); PG8_BAR; PG8_SCHED;
            PG8_STAGE(PG8_SB(0, 1), b2 + hstep, voffB);
            PG8_WAIT_V(6); PG8_BAR; PG8_MMA(1, 1, At, B1); PG8_BAR;
            PG8_LDB(B0, 1, 0); PG8_SCHED; PG8_LDA(At, 1, 0); PG8_STAGE(PG8_SA(0, 1), a2 + hstep, voffA);
            PG8_WAIT_L(8); PG8_BAR; PG8_WAIT_L(0); PG8_MMA(0, 0, At, B0); PG8_BAR; PG8_SCHED;
            PG8_LDB(B1, 1, 1); PG8_STAGE(PG8_SB(1, 0), b3, voffB);
            PG8_BAR; PG8_WAIT_L(0); PG8_MMA(0, 1, At, B1); PG8_BAR;
            PG8_LDA(At, 1, 1); PG8_STAGE(PG8_SA(1, 0), a3, voffA);
            PG8_BAR; PG8_WAIT_L(0); PG8_MMA(1, 0, At, B0); PG8_BAR; PG8_SCHED;
            PG8_STAGE(PG8_SB(1, 1), b3 + hstep, voffB);
            PG8_WAIT_V(6); PG8_BAR; PG8_MMA(1, 1, At, B1); PG8_BAR;
            }
        }
        if constexpr (ALIGN_EPI) { if (wr == 0) PG8_BAR; }
        if constexpr (!Epi::AFTER_DRAIN) { E(acc, cur, wr, wc, fr, fq); S.done(cur); }
        if (!has_next) break;
#pragma unroll
        for (int a = 0; a < 2; ++a)
#pragma unroll
            for (int b = 0; b < 2; ++b)
#pragma unroll
                for (int m = 0; m < 4; ++m)
#pragma unroll
                    for (int n = 0; n < 2; ++n) acc[a][b][m][n] = (f32x4){0.f, 0.f, 0.f, 0.f};
        cur = nxt; cA = nA; cB = nB; ++ui;
        if constexpr (ALIGN_EPI) { if (wr == 1) PG8_BAR; }
    }
    PG8_WAIT_V(0);
    if constexpr (!ALIGN_EPI) { if (wr == 0) PG8_BAR; }
    PG8_BAR;
    if constexpr (Epi::AFTER_DRAIN) { E.fused(acc, cur, wr, wc, fr, fq, lds, wid, lane); S.done(cur); }
#undef PG8_SA
#undef PG8_SB
#undef PG8_STAGE
#undef PG8_LDA
#undef PG8_LDB
#undef PG8_MMA
#undef PG8_WAIT_V
#undef PG8_WAIT_L
#undef PG8_BAR
#undef PG8_SCHED
}
}
#define LAS __attribute__((address_space(3)))
typedef unsigned short bf16;
typedef float f32x4 __attribute__((ext_vector_type(4)));
typedef float f32x16 __attribute__((ext_vector_type(16)));
typedef short bf16x8 __attribute__((ext_vector_type(8)));
typedef short s16x4 __attribute__((ext_vector_type(4)));
typedef unsigned u32x4 __attribute__((ext_vector_type(4)));
typedef unsigned u32x2 __attribute__((ext_vector_type(2)));
constexpr int DM = 2048, SEQ = 4096, NP = 8192, NS = 512, MT = NP + NS, AW = 1024, CC = 1024, INC = 6144, DFF = 5632, PAST = 4096, DSEQ = 64;
constexpr float EPS = 1e-6f;
constexpr size_t OFF_Y = 0, OFF_KP = (size_t)MT * DM, OFF_VP = OFF_KP + (size_t)NP * AW, OFF_CP = OFF_VP + (size_t)NP * AW, OFF_KS = OFF_CP + 2 * 2 * CC,
                 OFF_VS = OFF_KS + (size_t)NS * AW, OFF_CS = OFF_VS + (size_t)NS * AW, OUT_TOTAL = OFF_CS + 8 * 2 * CC;
static_assert(OUT_TOTAL == 35672064, "output size");
constexpr size_t MiB = 1u << 20;
constexpr size_t WS_CTL = 0, WS_WIN = 1 * MiB, WS_WOUT = 25 * MiB, WS_WGU = 33 * MiB, WS_WDN = 77 * MiB, WS_HN = 99 * MiB, WS_Q = 133 * MiB, WS_K = 150 * MiB, WS_V = 166 * MiB,
                 WS_GB = 182 * MiB, WS_U = 199 * MiB, WS_MIX = 216 * MiB, WS_SSQ = 250 * MiB, WS_TP = 251 * MiB, WS_OP = 256 * MiB, WS_H = 256 * MiB, WS_PART = 133 * MiB  ;
constexpr int NSLOT = 1024 + 16 * 17;
constexpr size_t WS_END = WS_OP + (size_t)NSLOT * 131072;
constexpr int RING_BYTES = 131072, RED_OFF = RING_BYTES, MISC_OFF = RED_OFF + 8192, LDS_BYTES = 147456;
constexpr int NWAVES = 8;

#define XB_TMO      128
#define XB_XCNT(j)  (256  + 64 * (j))
#define XB_XSUB(j)  (1280 + 64 * (j))
#define XB_XGEN(j)  (2304 + 64 * (j))
#define XB_TOP      3328
#define XB_TOPGEN   3392
#define XCD_BAR_WORDS 3456
#define XB_SPIN_CAP (1u << 18)

__device__ __forceinline__ unsigned xb_ld(unsigned* p)              { return __hip_atomic_load(p, __ATOMIC_RELAXED, __HIP_MEMORY_SCOPE_AGENT); }
__device__ __forceinline__ unsigned xb_add(unsigned* p, unsigned v) { return __hip_atomic_fetch_add(p, v, __ATOMIC_RELAXED, __HIP_MEMORY_SCOPE_AGENT); }
__device__ __forceinline__ unsigned xb_xcc_id() { return (unsigned)__builtin_amdgcn_s_getreg((3 << 11) | 20) & 0xFu; }
#define XB_SPIN(cond, bar) do { unsigned _sp = 0; while (cond) { __builtin_amdgcn_s_sleep(1); \
    if ((++_sp & 255u) == 0u) { if (xb_ld(&(bar)[XB_TMO])) break; if (_sp > XB_SPIN_CAP) { atomicAdd(&(bar)[XB_TMO], 1u); break; } } } } while (0)

struct XcdBarrier {
    unsigned* bar; unsigned x;
    volatile LAS unsigned* st;
};

__device__ __forceinline__ XcdBarrier xcd_barrier_post(unsigned* bar, volatile LAS unsigned* st) {
    XcdBarrier b; b.bar = bar; b.x = xb_xcc_id(); b.st = st;
    if (threadIdx.x == 0) (void)xb_add(&bar[XB_XCNT(b.x)], 1u);
    return b;
}
__device__ __forceinline__ void xcd_barrier_complete(unsigned* bar, unsigned x, unsigned& nloc, unsigned& nx) {
    const unsigned G = gridDim.x * gridDim.y * gridDim.z;
    unsigned sum, cnt, mine, sp = 0u;
    for (;;) {
        sum = 0u; cnt = 0u; mine = 0u;
#pragma unroll
        for (unsigned j = 0; j < 16; ++j) { const unsigned c = xb_ld(&bar[XB_XCNT(j)]); sum += c; cnt += (c > 0u) ? 1u : 0u; mine = (j == x) ? c : mine; }
        if (sum == G) break;
        __builtin_amdgcn_s_sleep(1);
        if ((++sp & 255u) == 0u) { if (xb_ld(&bar[XB_TMO])) break; if (sp > XB_SPIN_CAP) { atomicAdd(&bar[XB_TMO], 1u); break; } }
    }
    nloc = mine > 0u ? mine : 1u; nx = cnt > 0u ? cnt : 1u;
}

__device__ __forceinline__ void xcd_barrier(const XcdBarrier& b) {
    asm volatile("s_waitcnt vmcnt(0)" ::: "memory");
    __syncthreads();
    if (threadIdx.x == 0) {
        unsigned* bar = b.bar;
        __builtin_amdgcn_s_waitcnt(0);
        unsigned nloc = b.st[0], nx = b.st[1];
        if (nloc == 0u) { xcd_barrier_complete(bar, b.x, nloc, nx); b.st[0] = nloc; b.st[1] = nx; }
        const unsigned old = xb_add(&bar[XB_XSUB(b.x)], 1u);
        const unsigned gen = old / nloc;
        if (old + 1u == (gen + 1u) * nloc) {
            __builtin_amdgcn_fence(__ATOMIC_RELEASE, "agent");
            asm volatile("s_waitcnt vmcnt(0)" ::: "memory");
            const unsigned og = xb_add(&bar[XB_TOP], 1u);
            const unsigned tg = og / nx;
            if (og + 1u == (tg + 1u) * nx) xb_add(&bar[XB_TOPGEN], 1u);
            else XB_SPIN(xb_ld(&bar[XB_TOPGEN]) == tg, bar);
            __builtin_amdgcn_fence(__ATOMIC_ACQUIRE, "agent");
            xb_add(&bar[XB_XGEN(b.x)], 1u);
            asm volatile("s_waitcnt vmcnt(0)" ::: "memory");
        } else {
            XB_SPIN(xb_ld(&bar[XB_XGEN(b.x)]) == gen, bar);
            __builtin_amdgcn_fence(__ATOMIC_ACQUIRE, "agent");
            asm volatile("s_waitcnt vmcnt(0)" ::: "memory");
        }
    }
    __syncthreads();
}

struct ItemTab { int n; int v[1024]; };
constexpr int p_nsteps(int qb, int c) { int e = 1024 * (c + 1); const int lim = 256 * (qb + 1); if (e > lim) e = lim; return (e - 1024 * c) / 32; }
constexpr ItemTab make_items() {
    ItemTab t{}; t.n = 0;
    const int costs[6] = {32, 24, 16, 12, 8, 3};
    for (int ci = 0; ci < 6; ++ci) {
        const int cost = costs[ci];
        if (cost == 12 || cost == 3) {
            for (int b = 0; b < 8; ++b) for (int hg = 0; hg < 2; ++hg) for (int c = 0; c < 17; ++c) if ((c < 16) == (cost == 12)) t.v[t.n++] = 1 | (b << 1) | (hg << 4) | (c << 5);
        } else {
            for (int qb = 15; qb >= 0; --qb) for (int bh = 0; bh < 16; ++bh) for (int c = 0; c < qb / 4 + 1; ++c) if (p_nsteps(qb, c) == cost) t.v[t.n++] = (bh << 1) | (qb << 5) | (c << 9);
        }
    }
    return t;
}
__device__ const ItemTab g_items = make_items();

__device__ __forceinline__ unsigned f2bf(float f) { unsigned u = __builtin_bit_cast(unsigned, f); return (u + 0x7fffu + ((u >> 16) & 1u)) >> 16; }
__device__ __forceinline__ unsigned pk2(float lo, float hi) { return pg8::cvt_pk_bf16(lo, hi); }
__device__ __forceinline__ float bflo(unsigned w) { return __builtin_bit_cast(float, w << 16); }
__device__ __forceinline__ float bfhi(unsigned w) { return __builtin_bit_cast(float, w & 0xffff0000u); }
__device__ __forceinline__ int crow(int r, int hi) { return (r & 3) + 8 * (r >> 2) + 4 * hi; }
__device__ __forceinline__ float wave_sum(float v) {
#pragma unroll
    for (int o = 1; o < 64; o <<= 1) v += __shfl_xor(v, o);
    return v;
}

struct Args { const float* in[17]; float* out; unsigned char* ws; };

struct P0Item { const float* src; const float* gk; bf16* dst; int N, K, k0; };
__device__ __forceinline__ P0Item p0_decode(const Args& a, int it) {
    constexpr int I_IN = 32 * 192, I_OUT = 32 * 64, I_G = 32 * 176;
    unsigned char* ws = a.ws; P0Item r; int n0, kb, drow; r.gk = nullptr;
    if (it < I_IN) { kb = it / 192; n0 = 32 * (it % 192); drow = n0;
        if (n0 >= 5120) { const int ch = n0 - 5120; drow = 4096 + (ch >> 7) * 256 + 128 + (ch & 127); } else if (n0 >= 4096) { const int ch = n0 - 4096; drow = 4096 + (ch >> 7) * 256 + (ch & 127); }
        r.src = a.in[6]; r.N = INC; r.K = DM; r.dst = (bf16*)(ws + WS_WIN); }
    else if ((it -= I_IN) < I_OUT) { kb = it / 64; n0 = 32 * (it % 64); drow = n0; r.src = a.in[12]; r.N = DM; r.K = DM; r.dst = (bf16*)(ws + WS_WOUT); }
    else if ((it -= I_OUT) < 2 * I_G) { const int up = it >= I_G; if (up) it -= I_G; kb = it / 176; n0 = 32 * (it % 176); drow = (n0 >> 7) * 256 + up * 128 + (n0 & 127);
        r.src = a.in[up ? 15 : 14]; r.N = DFF; r.K = DM; r.dst = (bf16*)(ws + WS_WGU); r.gk = a.in[13]; }
    else { it -= 2 * I_G; kb = it / 64; n0 = 32 * (it % 64); drow = n0; r.src = a.in[16]; r.N = DM; r.K = DFF; r.dst = (bf16*)(ws + WS_WDN); }
    r.k0 = 64 * kb; r.src += (size_t)r.k0 * r.N + n0; r.dst += (size_t)drow * r.K + r.k0;
    return r;
}
__device__ __forceinline__ void p0_load(const P0Item& p, f32x4 (&v)[8], int lane) {
#pragma unroll
    for (int j = 0; j < 8; ++j) v[j] = __builtin_nontemporal_load((const f32x4*)(p.src + (size_t)(8 * j + (lane >> 3)) * p.N + 4 * (lane & 7)));
}
__device__ __forceinline__ void p0_finish(const P0Item& p, const f32x4 (&v)[8], LAS float* scr, int lane) {
#pragma unroll
    for (int j = 0; j < 8; ++j) { const int kk = 8 * j + (lane >> 3); const float g = p.gk ? p.gk[p.k0 + kk] : 1.0f; LAS float* s = scr + kk * 33 + 4 * (lane & 7);
        s[0] = v[j][0] * g; s[1] = v[j][1] * g; s[2] = v[j][2] * g; s[3] = v[j][3] * g; }
    asm volatile("s_waitcnt lgkmcnt(0)" ::: "memory");
    const int c = lane & 7;
#pragma unroll
    for (int j = 0; j < 4; ++j) { const int n = (lane >> 3) + 8 * j; const LAS float* s = scr + (8 * c) * 33 + n;
        u32x4 o; o.x = pk2(s[0 * 33], s[1 * 33]); o.y = pk2(s[2 * 33], s[3 * 33]); o.z = pk2(s[4 * 33], s[5 * 33]); o.w = pk2(s[6 * 33], s[7 * 33]);
        *(u32x4*)(p.dst + (size_t)n * p.K + 8 * c) = o; }
    asm volatile("s_waitcnt lgkmcnt(0)" ::: "memory");
}
__device__ __forceinline__ void p0_prologue(const Args& a, LAS unsigned char* lds, int gw, int NGW, int lane, int wave) {
    LAS float* scr = (LAS float*)(lds + wave * 16384);
    unsigned char* ws = a.ws;
    constexpr int NITEMS = 32 * 192 + 32 * 64 + 2 * 32 * 176 + 88 * 64;
    {
        int it = gw; f32x4 va[8], vb[8]; P0Item pa, pb;
        if (it < NITEMS) { pa = p0_decode(a, it); p0_load(pa, va, lane); }
        while (it < NITEMS) {
            const int itb = it + NGW;
            if (itb < NITEMS) { pb = p0_decode(a, itb); p0_load(pb, vb, lane); }
            p0_finish(pa, va, scr, lane);
            it = itb + NGW;
            if (itb >= NITEMS) break;
            if (it < NITEMS) { pa = p0_decode(a, it); p0_load(pa, va, lane); }
            p0_finish(pb, vb, scr, lane);
        }
    }
    const float* g1 = a.in[5];
    for (int m = gw; m < MT; m += NGW) {
        const float* xrow = m < NP ? a.in[0] + (size_t)m * DM : a.in[1] + (size_t)(m - NP) * DM;
        const f32x4* xr = (const f32x4*)xrow + lane; f32x4 v[8]; float s = 0.f;
#pragma unroll
        for (int j = 0; j < 8; ++j) { v[j] = xr[64 * j]; s += (v[j][0] * v[j][0] + v[j][1] * v[j][1]) + (v[j][2] * v[j][2] + v[j][3] * v[j][3]); }
        const float rs = __builtin_amdgcn_rsqf(wave_sum(s) * (1.0f / DM) + EPS);
        u32x2* o = (u32x2*)((bf16*)(ws + WS_HN) + (size_t)m * DM) + lane;
#pragma unroll
        for (int j = 0; j < 8; ++j) { const f32x4 g = *((const f32x4*)g1 + 64 * j + lane); u32x2 w; w.x = pk2(v[j][0] * rs * g[0], v[j][1] * rs * g[1]); w.y = pk2(v[j][2] * rs * g[2], v[j][3] * rs * g[3]); o[64 * j] = w; }
    }
}

template <bool SAMPLE>
__device__ __forceinline__ void attn_item(const Args& a, LAS unsigned char* lds, int code) {
    constexpr int NH = SAMPLE ? 4 : 1, KS = NH * 256 + 16, VS = NH * 256 + 32, K_OFF = 0, V_OFF = 32 * KS;
    int tid_ = threadIdx.x; asm volatile("" : "+v"(tid_));
    const int tid = tid_, lane = tid & 63, r32 = lane & 31, hi = lane >> 5; const int wid = __builtin_amdgcn_readfirstlane(tid >> 6);
    unsigned char* ws = a.ws;
    int slot, nsteps, kvpos0, qw, head, hl; size_t qrow;
    const bf16 *kgb = nullptr, *vgb = nullptr; const float *kgf = nullptr, *vgf = nullptr;
    if (SAMPLE) {
        const int b = (code >> 1) & 7, hg = (code >> 4) & 1, c = code >> 5;
        slot = 1024 + (b * 2 + hg) * 17 + c; hl = wid >> 1; head = hg * 4 + hl; const int rg = wid & 1;
        qw = PAST + 32 * rg; qrow = (size_t)NP + b * DSEQ + 32 * rg + r32;
        if (c < 16) { nsteps = 8; kvpos0 = 256 * c; kgf = a.in[2] + ((size_t)b * PAST + kvpos0 + (tid >> 7)) * AW + hg * 512 + 4 * (tid & 127); vgf = a.in[3] + ((size_t)b * PAST + kvpos0 + (tid >> 7)) * AW + hg * 512 + 4 * (tid & 127); }
        else { nsteps = 2; kvpos0 = PAST; kgf = a.out + OFF_KS + ((size_t)b * DSEQ + (tid >> 7)) * AW + hg * 512 + 4 * (tid & 127); vgf = a.out + OFF_VS + ((size_t)b * DSEQ + (tid >> 7)) * AW + hg * 512 + 4 * (tid & 127); }
    } else {
        const int bh = (code >> 1) & 15, qb = (code >> 5) & 15, c = (code >> 9) & 3, b = bh >> 3;
        head = bh & 7; hl = 0; slot = (bh * 16 + qb) * 4 + c; nsteps = p_nsteps(qb, c); kvpos0 = 1024 * c;
        qw = qb * 256 + 32 * wid; qrow = (size_t)b * SEQ + qw + r32;
        kgb = (const bf16*)(ws + WS_K) + ((size_t)b * SEQ + kvpos0 + (tid >> 4)) * AW + head * 128 + (tid & 15) * 8;
        vgb = (const bf16*)(ws + WS_V) + ((size_t)b * SEQ + kvpos0 + (tid >> 4)) * AW + head * 128 + (tid & 15) * 8;
    }
    const int qpos = qw + r32;
    constexpr int Q_OFF = 67584, QS = 272;
    const LAS unsigned char* qlp = lds + Q_OFF + wid * (32 * QS) + r32 * QS + hi * 16;
    { const bf16* qp = (const bf16*)(ws + WS_Q) + qrow * AW + head * 128 + hi * 8;
#pragma unroll
      for (int d0 = 0; d0 < 8; ++d0) *(LAS bf16x8*)(lds + Q_OFF + wid * (32 * QS) + r32 * QS + hi * 16 + d0 * 32) = *(const bf16x8*)(qp + 16 * d0); }
    f32x16 o[4];
#pragma unroll
    for (int i = 0; i < 4; ++i)
#pragma unroll
        for (int r = 0; r < 16; ++r) o[i][r] = 0.f;
    float R = 1.f;
    u32x4 kreg, vreg; f32x4 kf4[8], vf4[8];
#define ATT_LOADK(s_) do { if (SAMPLE) { _Pragma("unroll") for (int i_ = 0; i_ < 8; ++i_) kf4[i_] = *(const f32x4*)(kgf + (size_t)(s_) * 32 * AW + (size_t)i_ * 4 * AW); } \
        else { kreg = *(const u32x4*)(kgb + (size_t)(s_) * 32 * AW); } } while (0)
#define ATT_LOADV(s_) do { if (SAMPLE) { _Pragma("unroll") for (int i_ = 0; i_ < 8; ++i_) vf4[i_] = *(const f32x4*)(vgf + (size_t)(s_) * 32 * AW + (size_t)i_ * 4 * AW); } \
        else { vreg = *(const u32x4*)(vgb + (size_t)(s_) * 32 * AW); } } while (0)
#define ATT_STOREK() do { if (SAMPLE) { _Pragma("unroll") for (int i_ = 0; i_ < 8; ++i_) { const int key_ = (tid >> 7) + 4 * i_, f4_ = tid & 127; \
            u32x2 kw_; kw_.x = pk2(kf4[i_][0], kf4[i_][1]); kw_.y = pk2(kf4[i_][2], kf4[i_][3]); *(LAS u32x2*)(lds + K_OFF + key_ * KS + f4_ * 8) = kw_; } } \
        else { *(LAS u32x4*)(lds + K_OFF + (tid >> 4) * KS + (tid & 15) * 16) = kreg; } } while (0)
#define ATT_STOREV() do { if (SAMPLE) { _Pragma("unroll") for (int i_ = 0; i_ < 8; ++i_) { const int key_ = (tid >> 7) + 4 * i_, f4_ = tid & 127; \
            u32x2 vw_; vw_.x = pk2(vf4[i_][0], vf4[i_][1]); vw_.y = pk2(vf4[i_][2], vf4[i_][3]); *(LAS u32x2*)(lds + V_OFF + key_ * VS + f4_ * 8) = vw_; } } \
        else { *(LAS u32x4*)(lds + V_OFF + (tid >> 4) * VS + (tid & 15) * 16) = vreg; } } while (0)
    ATT_LOADK(nsteps - 1); ATT_LOADV(nsteps - 1);
    ATT_STOREK(); ATT_STOREV();
    __syncthreads();
    const LAS unsigned char* kp = lds + K_OFF + r32 * KS + hl * 256 + hi * 16;
    const LAS unsigned char* vp = lds + V_OFF + (4 * hi + ((lane & 15) >> 2)) * VS + hl * 256 + (16 * ((lane >> 4) & 1) + 4 * (lane & 3)) * 2;
    for (int s = nsteps - 1; s >= 0; --s) {
        if (s > 0) { ATT_LOADK(s - 1); if (!SAMPLE) ATT_LOADV(s - 1); }
        const int kb = kvpos0 + 32 * s;
        if (kb < qw + 32) {
            f32x16 p;
#pragma unroll
            for (int r = 0; r < 16; ++r) p[r] = 0.f;
#pragma unroll
            for (int d0 = 0; d0 < 8; ++d0) { const bf16x8 kf = *(const LAS bf16x8*)(kp + d0 * 32); const bf16x8 qf = *(const LAS bf16x8*)(qlp + d0 * 32); p = __builtin_amdgcn_mfma_f32_32x32x16_bf16(kf, qf, p, 0, 0, 0); }
            const bool need_mask = (kb + 31 >= qw);
            float e[16], sf[16];
#pragma unroll
            for (int r = 0; r < 16; ++r) {
                const float z = fminf(p[r], 100.f); float ee = __builtin_amdgcn_exp2f(z); float rr = __builtin_amdgcn_rcpf(1.0f + ee);
                if (need_mask) { const bool msk = (kb + crow(r, hi)) >= qpos; ee = msk ? 0.f : ee; rr = msk ? 1.f : rr; }
                e[r] = ee; sf[r] = rr;
            }
            float oth[4], PP[4];
#pragma unroll
            for (int g = 0; g < 4; ++g) { sf[4 * g + 2] *= sf[4 * g + 3]; sf[4 * g + 1] *= sf[4 * g + 2]; sf[4 * g] *= sf[4 * g + 1]; oth[g] = __shfl_xor(sf[4 * g], 32); PP[g] = sf[4 * g] * oth[g]; }
            const float SP3 = PP[3], SP2 = PP[2] * SP3, SP1 = PP[1] * SP2, SP0 = PP[0] * SP1;
            float A[4]; A[0] = R * SP1; A[1] = R * SP2; A[2] = R * SP3; A[3] = R;
#pragma unroll
            for (int g = 0; g < 4; ++g) A[g] = hi ? A[g] : A[g] * oth[g];
            R *= SP0;
            float w[16];
#pragma unroll
            for (int r = 0; r < 16; ++r) w[r] = (e[r] * sf[r]) * A[r >> 2];
#pragma unroll
            for (int s2 = 0; s2 < 2; ++s2) {
                u32x4 pw; pw.x = pk2(w[8 * s2 + 0], w[8 * s2 + 1]); pw.y = pk2(w[8 * s2 + 2], w[8 * s2 + 3]); pw.z = pk2(w[8 * s2 + 4], w[8 * s2 + 5]); pw.w = pk2(w[8 * s2 + 6], w[8 * s2 + 7]);
                const bf16x8 pa = __builtin_bit_cast(bf16x8, pw);
#pragma unroll
                for (int db = 0; db < 4; ++db) {
                    const s16x4 lo = __builtin_bit_cast(s16x4, __builtin_amdgcn_ds_read_tr16_b64_v4i16((LAS s16x4*)(vp + (16 * s2) * VS + db * 64)));
                    const s16x4 hh = __builtin_bit_cast(s16x4, __builtin_amdgcn_ds_read_tr16_b64_v4i16((LAS s16x4*)(vp + (16 * s2 + 8) * VS + db * 64)));
                    const bf16x8 vb = __builtin_shufflevector(lo, hh, 0, 1, 2, 3, 4, 5, 6, 7);
                    o[db] = __builtin_amdgcn_mfma_f32_32x32x16_bf16(pa, vb, o[db], 0, 0, 0);
                }
            }
        }
        __syncthreads();
        if (s > 0) { ATT_STOREK(); if (SAMPLE) ATT_LOADV(s - 1); ATT_STOREV(); }
        __syncthreads();
    }
#undef ATT_LOADK
#undef ATT_LOADV
#undef ATT_STOREK
#undef ATT_STOREV
    float* op = (float*)(ws + WS_OP) + ((size_t)(slot * 8 + wid) * 32) * 128;
#pragma unroll
    for (int db = 0; db < 4; ++db)
#pragma unroll
        for (int r = 0; r < 16; ++r) op[crow(r, hi) * 128 + db * 32 + r32] = o[db][r];
    if (hi == 0) ((float*)(ws + WS_TP))[(slot * 8 + wid) * 32 + r32] = R;
}

__device__ __forceinline__ void mix_rows(const Args& a, int gw, int NGW, int lane) {
    unsigned char* ws = a.ws;
    const float* OP = (const float*)(ws + WS_OP); const float* TP = (const float*)(ws + WS_TP);
    const bf16* U = (const bf16*)(ws + WS_U); const bf16* GB = (const bf16*)(ws + WS_GB); bf16* MIX = (bf16*)(ws + WS_MIX);
    const float* cw = a.in[9]; const float* ga = a.in[10]; const float* gc = a.in[11];
    for (int m = gw; m < MT; m += NGW) {
        const int h = lane >> 3, d0 = (lane & 7) * 16;
        int nparts, slot0, wid, q;
        if (m < NP) { const int b = m >> 12, t = m & 4095, qb = t >> 8; wid = (t & 255) >> 5; q = t & 31; nparts = (qb >> 2) + 1; slot0 = ((b * 8 + h) * 16 + qb) * 4; }
        else { const int r = m - NP, b = r >> 6, t = r & 63, rg = t >> 5; q = t & 31; wid = (h & 3) * 2 + rg; nparts = 17; slot0 = 1024 + (b * 2 + (h >> 2)) * 17; }
        f32x4 acc[4];
#pragma unroll
        for (int i = 0; i < 4; ++i) acc[i] = (f32x4){0.f, 0.f, 0.f, 0.f};
        float Rr = 1.f;
        for (int c = nparts - 1; c >= 0; --c) {
            const size_t base = (size_t)((slot0 + c) * 8 + wid) * 32 + q;
            const f32x4* p = (const f32x4*)(OP + base * 128 + d0);
#pragma unroll
            for (int i = 0; i < 4; ++i) acc[i] += p[i] * Rr;
            Rr *= TP[base];
        }
        float s = 0.f;
#pragma unroll
        for (int i = 0; i < 4; ++i) s += (acc[i][0] * acc[i][0] + acc[i][1] * acc[i][1]) + (acc[i][2] * acc[i][2] + acc[i][3] * acc[i][3]);
        float rs = __builtin_amdgcn_rsqf(wave_sum(s) * (1.0f / AW) + EPS);
        {
            const f32x4* g = (const f32x4*)(ga + h * 128 + d0); u32x4 w0, w1;
            f32x4 v0 = acc[0] * rs * g[0], v1 = acc[1] * rs * g[1], v2 = acc[2] * rs * g[2], v3 = acc[3] * rs * g[3];
            w0.x = pk2(v0[0], v0[1]); w0.y = pk2(v0[2], v0[3]); w0.z = pk2(v1[0], v1[1]); w0.w = pk2(v1[2], v1[3]);
            w1.x = pk2(v2[0], v2[1]); w1.y = pk2(v2[2], v2[3]); w1.z = pk2(v3[0], v3[1]); w1.w = pk2(v3[2], v3[3]);
            u32x4* o = (u32x4*)(MIX + (size_t)m * DM + h * 128 + d0); o[0] = w0; o[1] = w1;
        }
        const int c0 = lane * 16; int t, tb; const float* st = nullptr;
        if (m < NP) { t = m & 4095; tb = m - t; } else { const int r = m - NP; t = r & 63; tb = m - t; st = a.in[4] + (size_t)(r >> 6) * 2 * CC; }
        float u0[16], u1[16], u2[16];
        { const u32x4* p = (const u32x4*)(U + (size_t)m * CC + c0); const u32x4 x0 = p[0], x1 = p[1];
          const unsigned ww[8] = {x0.x, x0.y, x0.z, x0.w, x1.x, x1.y, x1.z, x1.w};
#pragma unroll
          for (int i = 0; i < 8; ++i) { u2[2 * i] = bflo(ww[i]); u2[2 * i + 1] = bfhi(ww[i]); } }
        if (t >= 1) { const u32x4* p = (const u32x4*)(U + (size_t)(m - 1) * CC + c0); const u32x4 x0 = p[0], x1 = p[1];
          const unsigned ww[8] = {x0.x, x0.y, x0.z, x0.w, x1.x, x1.y, x1.z, x1.w};
#pragma unroll
          for (int i = 0; i < 8; ++i) { u1[2 * i] = bflo(ww[i]); u1[2 * i + 1] = bfhi(ww[i]); } }
        else {
#pragma unroll
          for (int i = 0; i < 16; ++i) u1[i] = st ? st[CC + c0 + i] : 0.f; }
        if (t >= 2) { const u32x4* p = (const u32x4*)(U + (size_t)(m - 2) * CC + c0); const u32x4 x0 = p[0], x1 = p[1];
          const unsigned ww[8] = {x0.x, x0.y, x0.z, x0.w, x1.x, x1.y, x1.z, x1.w};
#pragma unroll
          for (int i = 0; i < 8; ++i) { u0[2 * i] = bflo(ww[i]); u0[2 * i + 1] = bfhi(ww[i]); } }
        else {
#pragma unroll
          for (int i = 0; i < 16; ++i) u0[i] = st ? st[(t == 0 ? 0 : CC) + c0 + i] : 0.f; }
        float oc[16]; float s2 = 0.f;
        { const u32x4* p = (const u32x4*)(GB + (size_t)m * CC + c0); const u32x4 x0 = p[0], x1 = p[1];
          const unsigned ww[8] = {x0.x, x0.y, x0.z, x0.w, x1.x, x1.y, x1.z, x1.w};
#pragma unroll
          for (int i = 0; i < 16; ++i) { const float gbv = (i & 1) ? bfhi(ww[i >> 1]) : bflo(ww[i >> 1]);
              oc[i] = gbv * (cw[c0 + i] * u0[i] + cw[CC + c0 + i] * u1[i] + cw[2 * CC + c0 + i] * u2[i]); s2 += oc[i] * oc[i]; } }
        rs = __builtin_amdgcn_rsqf(wave_sum(s2) * (1.0f / CC) + EPS);
        { u32x4 w0, w1; unsigned ww[8];
#pragma unroll
          for (int i = 0; i < 8; ++i) ww[i] = pk2(oc[2 * i] * rs * gc[c0 + 2 * i], oc[2 * i + 1] * rs * gc[c0 + 2 * i + 1]);
          w0.x = ww[0]; w0.y = ww[1]; w0.z = ww[2]; w0.w = ww[3]; w1.x = ww[4]; w1.y = ww[5]; w1.z = ww[6]; w1.w = ww[7];
          u32x4* o = (u32x4*)(MIX + (size_t)m * DM + AW + c0); o[0] = w0; o[1] = w1; }
        (void)tb;
    }
}
#ifndef REP_P0
#define REP_P0 1
#endif
#ifndef REP_P1
#define REP_P1 1
#endif
#ifndef REP_P3
#define REP_P3 1
#endif
#ifndef REP_P4
#define REP_P4 1
#endif
#ifndef REP_P5
#define REP_P5 1
#endif
__global__ void __launch_bounds__(NWAVES * 64, 2) fwd_megakernel(Args args) {
    extern __shared__ __attribute__((aligned(16))) unsigned char lds_raw[];
    cg::grid_group grid = cg::this_grid();
    LAS unsigned char* lds = (LAS unsigned char*)lds_raw;
    const int G = gridDim.x, bx = blockIdx.x, NGW = G * NWAVES;
#define PHASE_IDS() int tid = threadIdx.x; asm volatile("" : "+v"(tid)); const int lane = tid & 63; const int wave = __builtin_amdgcn_readfirstlane(tid >> 6); const int gw = bx * NWAVES + wave; (void)lane; (void)gw
    unsigned char* ws = args.ws;
    unsigned* ctl = (unsigned*)(ws + WS_CTL);
    LAS float* red = (LAS float*)(lds + RED_OFF);
    volatile LAS int* misc = (volatile LAS int*)(lds + MISC_OFF);

    { PHASE_IDS(); if (bx == 0 && tid == 0) { ctl[0] = 0u; ctl[64] = 0u; for (int i = 0; i < 16; ++i) ctl[128 + i] = 0u; }
      if (bx == 0) for (int i = tid; i < XCD_BAR_WORDS; i += NWAVES * 64) ctl[4096 + i] = 0u;
      if (tid < 2) misc[8 + tid] = 0;
#ifndef NO_P0
    for (int rep_ = 0; rep_ < REP_P0; ++rep_) p0_prologue(args, lds, gw, NGW, lane, wave);
#endif
    }
    grid.sync();
    XcdBarrier xbar = xcd_barrier_post(ctl + 4096, (volatile LAS unsigned*)(lds + MISC_OFF) + 8);

#ifndef NO_P1
    for (int rep_ = 0; rep_ < REP_P1; ++rep_) {
        pg8::Gemm g{(const pg8::bf16_t*)(ws + WS_HN), (const pg8::bf16_t*)(ws + WS_WIN), MT, INC, DM}; pg8::StaticOrder S; S.init(MT, INC, DM, G, bx);
        pg8::EpiIn E{(bf16*)(ws + WS_Q), (bf16*)(ws + WS_K), (bf16*)(ws + WS_V), (bf16*)(ws + WS_GB), (bf16*)(ws + WS_U), args.out, args.in[7], args.in[8], red,
                     1.4426950408889634f * 0.08838834764831845f, OFF_KP, OFF_VP, OFF_CP, OFF_KS, OFF_VS, OFF_CS};
        pg8::gemm_phase<pg8::EpiIn, pg8::StaticOrder, true, true>(lds, g, S, E);
    }
#endif
    xcd_barrier(xbar);

#ifndef NO_P2
    {
        const int nitems = g_items.n;
        PHASE_IDS();
#ifdef DUP_P2
        for (int rep = 0; rep < 2; ++rep)
#else
        const int rep = 0;
#endif
        for (;;) {
            if (tid == 0) misc[0] = (int)atomicAdd(ctl + 64 * rep, 1u);
            __syncthreads();
            const int it = misc[0];
            __syncthreads();
            if (it >= nitems) break;
            const int code = g_items.v[it];
#if defined(ONLY_S)
            attn_item<true>(args, lds, code);
#elif defined(ONLY_P)
            attn_item<false>(args, lds, code);
#else
            if (code & 1) attn_item<true>(args, lds, code); else attn_item<false>(args, lds, code);
#endif
        }
    }
#endif
    xcd_barrier(xbar);

#ifndef NO_P3
    for (int rep_ = 0; rep_ < REP_P3; ++rep_) { PHASE_IDS(); mix_rows(args, gw, NGW, lane); }
#endif
    xcd_barrier(xbar);

#ifndef NO_P4
    for (int rep_ = 0; rep_ < REP_P4; ++rep_) {
        pg8::Gemm g{(const pg8::bf16_t*)(ws + WS_MIX), (const pg8::bf16_t*)(ws + WS_WOUT), MT, DM, DM}; pg8::StaticOrder S; S.init(MT, DM, DM, G, bx);
        pg8::EpiOut E{args.in[0], args.in[1], args.out + OFF_Y, (bf16*)(ws + WS_HN), (float*)(ws + WS_SSQ), red};
        pg8::gemm_phase<pg8::EpiOut, pg8::StaticOrder, true, true>(lds, g, S, E);
    }
#endif
    xcd_barrier(xbar);

#ifndef NO_P5
    for (int rep_ = 0; rep_ < REP_P5; ++rep_) {
        pg8::Gemm g{(const pg8::bf16_t*)(ws + WS_HN), (const pg8::bf16_t*)(ws + WS_WGU), MT, 2 * DFF, DM}; pg8::StaticOrder S; S.init(MT, 2 * DFF, DM, G, bx);
        pg8::EpiGU E{(bf16*)(ws + WS_H), (const float*)(ws + WS_SSQ)};
        pg8::gemm_phase<pg8::EpiGU, pg8::StaticOrder, true, true>(lds, g, S, E);
    }
#endif
    xcd_barrier(xbar);

#ifdef DRY_P6_STATIC
    { pg8::Gemm g{(const pg8::bf16_t*)(ws + WS_H), (const pg8::bf16_t*)(ws + WS_WDN), MT, DM, DFF}; pg8::StaticOrder S; S.init(MT, DM, DFF, G, bx);
      pg8::EpiDown E{(float*)(ws + WS_Q), (float*)(ws + WS_PART), ctl + 128, red}; pg8::gemm_phase<pg8::EpiDown, pg8::StaticOrder, true, true>(lds, g, S, E); }
#endif
#ifdef DRY_P6_SPLIT
    { pg8::Gemm g{(const pg8::bf16_t*)(ws + WS_H), (const pg8::bf16_t*)(ws + WS_WDN), MT, DM, DFF}; pg8::TailSplitOrder S; S.init(MT, DM, DFF, G, bx);
      pg8::EpiNone E{(float*)(ws + WS_SSQ)}; pg8::gemm_phase<pg8::EpiNone, pg8::TailSplitOrder, true, true>(lds, g, S, E); }
#endif
#ifndef NO_P6
    {
        pg8::Gemm g{(const pg8::bf16_t*)(ws + WS_H), (const pg8::bf16_t*)(ws + WS_WDN), MT, DM, DFF};
#ifdef P6_SPLIT
        pg8::TailSplitOrder S; S.init(MT, DM, DFF, G, bx);
        pg8::EpiDown E{args.out + OFF_Y, (float*)(ws + WS_PART), ctl + 128, red};
        pg8::gemm_phase<pg8::EpiDown, pg8::TailSplitOrder, true, true>(lds, g, S, E);
#else
        pg8::StaticOrder S; S.init(MT, DM, DFF, G, bx);
        pg8::EpiDown E{args.out + OFF_Y, (float*)(ws + WS_PART), ctl + 128, red};
        pg8::gemm_phase<pg8::EpiDown, pg8::StaticOrder, true, true>(lds, g, S, E);
#endif
    }
#endif
}

extern "C" void kernel_launch(void* const* d_in, const int* in_sizes, int n_in, void* d_out, int out_size, void* d_ws, size_t ws_size, hipStream_t stream) {
    static int grid = 0;
    if (grid == 0) {
        if (n_in != 17 || (size_t)out_size != OUT_TOTAL || ws_size < WS_END) { fprintf(stderr, "kernel_launch: unexpected shapes (n_in %d out %d ws %zu need %zu)\n", n_in, out_size, ws_size, (size_t)WS_END); grid = -1; return; }
        int dev = 0, cus = 0, per_cu = 0;
        hipGetDevice(&dev); hipDeviceGetAttribute(&cus, hipDeviceAttributeMultiprocessorCount, dev);
        hipFuncSetAttribute((const void*)fwd_megakernel, hipFuncAttributeMaxDynamicSharedMemorySize, LDS_BYTES);
        hipOccupancyMaxActiveBlocksPerMultiprocessor(&per_cu, (const void*)fwd_megakernel, NWAVES * 64, LDS_BYTES);
        if (per_cu < 1) { fprintf(stderr, "kernel_launch: occupancy query says %d blocks per CU\n", per_cu); per_cu = 1; }
        (void)hipGetLastError();
        grid = cus;
    }
    if (grid < 0) return;
    Args a{};
    for (int i = 0; i < 17; ++i) a.in[i] = (const float*)d_in[i];
    a.out = (float*)d_out; a.ws = (unsigned char*)d_ws;
    void* kargs[] = {&a};
    hipError_t e = hipLaunchCooperativeKernel((const void*)fwd_megakernel, dim3(grid), dim3(NWAVES * 64), kargs, LDS_BYTES, stream);
    if (e != hipSuccess) fprintf(stderr, "cooperative launch failed: %s (grid %d)\n", hipGetErrorString(e), grid);
}
```

```cpp
#include <hip/hip_runtime.h>
#include <hip/hip_cooperative_groups.h>
#include <cstdio>
#include <cstdint>
namespace cg = cooperative_groups;
namespace pg8 {
#define PG8_LAS __attribute__((address_space(3)))
typedef unsigned short bf16_t;
typedef short bf16x8 __attribute__((ext_vector_type(8)));
typedef float f32x4 __attribute__((ext_vector_type(4)));
typedef unsigned u32x4 __attribute__((ext_vector_type(4)));
constexpr int BM = 256, BK = 64, HALF = 128, HTB = HALF * BK * 2  , STAGE_BYTES = 8 * HTB, NXCD = 8, WGM = 8;

__host__ __device__ __forceinline__ int lds_byte(int r, int c) { const int st = (r >> 4) * 2 + (c >> 5), rr = r & 15, cc = c & 31, ob = rr * 64 + cc * 2; return st * 1024 + (ob ^ (((ob >> 9) & 1) << 5)); }
__host__ __device__ __forceinline__ void stage_rc(int b, int& R, int& C) { const int st = b / 1024, sb = b % 1024, swz = sb ^ (((sb >> 9) & 1) << 5); R = (st >> 1) * 16 + swz / 64; C = (st & 1) * 32 + (swz % 64) / 2; }
__host__ __device__ __forceinline__ int perm32(int rho) { const int n = rho >> 4, i = rho & 15; return 8 * (i >> 2) + 4 * n + (i & 3); }

struct Unit { int pm, pn, k0, nt, split; };
struct Gemm { const bf16_t* A; const bf16_t* Bt; int M, N, K; };

struct StaticOrder {
    int nM, nN, nwg, G, c, ntk;
    __host__ __device__ void init(int M, int N, int K, int G_, int c_) { nM = M / BM; nN = N / BM; nwg = nM * nN; G = G_; c = c_; ntk = K / BK; }
    __host__ __device__ bool next(int i, Unit& u) const {
        const long L = (long)i * G + c; if (L >= nwg) return false;
        int wgid = (int)L; { const int q = nwg / NXCD, r = nwg % NXCD, xcd = wgid % NXCD, off = wgid / NXCD; wgid = (xcd < r ? xcd * (q + 1) : r * (q + 1) + (xcd - r) * q) + off; }
        const int nig = WGM * nN, gid = wgid / nig, fm = gid * WGM, gsz = (nM - fm) < WGM ? (nM - fm) : WGM;
        u.pm = fm + ((wgid % nig) % gsz); u.pn = (wgid % nig) / gsz; u.k0 = 0; u.nt = ntk; u.split = 0; return true;
    }
    __device__ __forceinline__ void a_ready(const Unit&) const {}
    __device__ __forceinline__ void done(const Unit&) const {}
};

struct TailSplitOrder {
    StaticOrder so; int G, c;
    __host__ __device__ void init(int M, int N, int K, int G_, int c_) { so.init(M, N, K, G_, c_); G = G_; c = c_; }
    __host__ __device__ bool next(int i, Unit& u) const {
        if (G != 256 || so.nM != 34 || so.nN != 8 || so.ntk != 88) return so.next(i, u);
        if (i == 0) { const int x = c & 7, j = c >> 3; u.pm = 4 * x + (j & 3); u.pn = j >> 2; u.k0 = 0; u.nt = 88; u.split = 0; return true; }
        if (i == 1 && c < 128) { const int tu = c >> 3, s = c & 7; u.pm = 32 + (tu >> 3); u.pn = tu & 7; u.k0 = 11 * s + (s & 1); u.nt = 12 - 2 * (s & 1); u.split = 1; return true; }
        return false;
    }
    __device__ __forceinline__ void a_ready(const Unit&) const {}
    __device__ __forceinline__ void done(const Unit&) const {}
};

__device__ __forceinline__ unsigned cvt_pk_bf16(float lo, float hi) { unsigned r; asm volatile("v_cvt_pk_bf16_f32 %0, %1, %2" : "=v"(r) : "v"(lo), "v"(hi)); return r; }
typedef float f32x2 __attribute__((ext_vector_type(2)));
#define PG8_LBAR() asm volatile("s_waitcnt lgkmcnt(0)\n\ts_barrier" ::: "memory")
constexpr int NPROMPT = 8192;
__device__ __forceinline__ u32x4 pack8(const f32x4 a, const f32x4 b) { u32x4 w; w.x = cvt_pk_bf16(a[0], a[1]); w.y = cvt_pk_bf16(a[2], a[3]); w.z = cvt_pk_bf16(b[0], b[1]); w.w = cvt_pk_bf16(b[2], b[3]); return w; }

struct EpiIn {
    static constexpr bool PERM = true, AFTER_DRAIN = false;
    bf16_t *Q, *Kb, *Vb, *GB, *U; float* out; const float *gq, *gk; PG8_LAS float* red; float qscale;
    size_t off_kp, off_vp, off_cp, off_ks, off_vs, off_cs;
    __device__ __forceinline__ void operator()(const f32x4 (&acc)[2][2][4][2], const Unit& u, int wr, int wc, int fr, int fq) const {
        const int pn = u.pn, rowt = u.pm * BM, rl0 = wr * 64 + fr, cw = wc * 32 + 8 * fq;
        const bool prompt = rowt < NPROMPT;
        if (pn < 8) {
            const bool isq = pn < 4;
#pragma unroll
            for (int ai = 0; ai < 2; ++ai)
#pragma unroll
                for (int m = 0; m < 4; ++m)
#pragma unroll
                    for (int bj = 0; bj < 2; ++bj) {
                        const f32x4 a = acc[ai][bj][m][0], b = acc[ai][bj][m][1];
                        float s = (a[0] * a[0] + a[1] * a[1]) + (a[2] * a[2] + a[3] * a[3]) + (b[0] * b[0] + b[1] * b[1]) + (b[2] * b[2] + b[3] * b[3]);
                        s += __shfl_xor(s, 16); s += __shfl_xor(s, 32);
                        if (fq == 0) red[((ai * HALF + rl0 + m * 16) * 2 + bj) * 4 + wc] = s;
                    }
            PG8_LBAR();
            const float* g = isq ? gq : gk;
            const f32x4 g0 = *(const f32x4*)(g + cw), g1 = *(const f32x4*)(g + cw + 4);
#pragma unroll
            for (int ai = 0; ai < 2; ++ai)
#pragma unroll
                for (int m = 0; m < 4; ++m) {
                    const int rl = ai * HALF + rl0 + m * 16; const size_t row = (size_t)(rowt + rl);
#pragma unroll
                    for (int bj = 0; bj < 2; ++bj) {
                        const f32x4 p = *(const PG8_LAS f32x4*)(red + (rl * 2 + bj) * 4);
                        float rs = __builtin_amdgcn_rsqf(((p[0] + p[1]) + (p[2] + p[3])) * (1.0f / 128.0f) + 1e-6f);
                        if (isq) rs *= qscale;
                        const f32x4 v0 = acc[ai][bj][m][0] * rs * g0, v1 = acc[ai][bj][m][1] * rs * g1;
                        if (isq) { *(u32x4*)(Q + row * 1024 + pn * 256 + bj * HALF + cw) = pack8(v0, v1); }
                        else {
                            const int col = (pn - 4) * 256 + bj * HALF + cw;
                            float* o = prompt ? out + off_kp + row * 1024 + col : out + off_ks + (row - NPROMPT) * 1024 + col;
                            *(f32x4*)o = v0; *(f32x4*)(o + 4) = v1;
                            if (prompt) *(u32x4*)(Kb + row * 1024 + col) = pack8(v0, v1);
                        }
                    }
                }
        } else if (pn < 12) {
#pragma unroll
            for (int ai = 0; ai < 2; ++ai)
#pragma unroll
                for (int m = 0; m < 4; ++m) {
                    const size_t row = (size_t)(rowt + ai * HALF + rl0 + m * 16);
#pragma unroll
                    for (int bj = 0; bj < 2; ++bj) {
                        const int col = (pn - 8) * 256 + bj * HALF + cw; const f32x4 v0 = acc[ai][bj][m][0], v1 = acc[ai][bj][m][1];
                        float* o = prompt ? out + off_vp + row * 1024 + col : out + off_vs + (row - NPROMPT) * 1024 + col;
                        *(f32x4*)o = v0; *(f32x4*)(o + 4) = v1;
                        if (prompt) *(u32x4*)(Vb + row * 1024 + col) = pack8(v0, v1);
                    }
                }
        } else if (pn < 16) {
#pragma unroll
            for (int ai = 0; ai < 2; ++ai)
#pragma unroll
                for (int m = 0; m < 4; ++m) {
                    const size_t row = (size_t)(rowt + ai * HALF + rl0 + m * 16);
#pragma unroll
                    for (int bj = 0; bj < 2; ++bj) *(u32x4*)(GB + row * 1024 + (pn - 12) * 256 + bj * HALF + cw) = pack8(acc[ai][bj][m][0], acc[ai][bj][m][1]);
                }
        } else {
#pragma unroll
            for (int ai = 0; ai < 2; ++ai)
#pragma unroll
                for (int m = 0; m < 4; ++m) {
                    const int rowi = rowt + ai * HALF + rl0 + m * 16; const int ch = (pn - 16) * HALF + cw;
                    const f32x4 v0 = acc[ai][0][m][0] * acc[ai][1][m][0], v1 = acc[ai][0][m][1] * acc[ai][1][m][1];
                    *(u32x4*)(U + (size_t)rowi * 1024 + ch) = pack8(v0, v1);
                    if (prompt) { const int t = rowi & 4095; if (t >= 4094) { float* o = out + off_cp + ((rowi >> 12) * 2 + (t - 4094)) * 1024 + ch; *(f32x4*)o = v0; *(f32x4*)(o + 4) = v1; } }
                    else { const int rs_ = rowi - NPROMPT, t = rs_ & 63; if (t >= 62) { float* o = out + off_cs + ((rs_ >> 6) * 2 + (t - 62)) * 1024 + ch; *(f32x4*)o = v0; *(f32x4*)(o + 4) = v1; } }
                }
        }
    }
};

struct EpiOut {
    static constexpr bool PERM = true, AFTER_DRAIN = false;
    const float *xp, *xs; float* Y; bf16_t* X1; float* ssq; PG8_LAS float* red;
    __device__ __forceinline__ void operator()(const f32x4 (&acc)[2][2][4][2], const Unit& u, int wr, int wc, int fr, int fq) const {
        const int pn = u.pn, rowt = u.pm * BM, rl0 = wr * 64 + fr, cw = wc * 32 + 8 * fq;
        const float* xin = rowt < NPROMPT ? xp + (size_t)rowt * 2048 : xs + (size_t)(rowt - NPROMPT) * 2048;
#pragma unroll
        for (int ai = 0; ai < 2; ++ai)
#pragma unroll
            for (int m = 0; m < 4; ++m) {
                const int rl = ai * HALF + rl0 + m * 16; float s = 0.f;
#pragma unroll
                for (int bj = 0; bj < 2; ++bj) {
                    const int col = pn * 256 + bj * HALF + cw; const float* xi = xin + (size_t)rl * 2048 + col;
                    const f32x4 v0 = *(const f32x4*)xi + acc[ai][bj][m][0], v1 = *(const f32x4*)(xi + 4) + acc[ai][bj][m][1];
                    float* o = Y + (size_t)(rowt + rl) * 2048 + col; *(f32x4*)o = v0; *(f32x4*)(o + 4) = v1;
                    *(u32x4*)(X1 + (size_t)(rowt + rl) * 2048 + col) = pack8(v0, v1);
                    s += (v0[0] * v0[0] + v0[1] * v0[1]) + (v0[2] * v0[2] + v0[3] * v0[3]) + (v1[0] * v1[0] + v1[1] * v1[1]) + (v1[2] * v1[2] + v1[3] * v1[3]);
                }
                s += __shfl_xor(s, 16); s += __shfl_xor(s, 32);
                if (fq == 0) red[rl * 4 + wc] = s;
                asm volatile("" ::: "memory");
            }
        PG8_LBAR();
        if (threadIdx.x < 256) { const f32x4 p = *(const PG8_LAS f32x4*)(red + threadIdx.x * 4); ssq[(size_t)(rowt + threadIdx.x) * 8 + pn] = (p[0] + p[1]) + (p[2] + p[3]); }
        PG8_LBAR();
    }
};

struct EpiGU {
    static constexpr bool PERM = true, AFTER_DRAIN = false;
    bf16_t* H; const float* ssq;
    __device__ __forceinline__ void operator()(const f32x4 (&acc)[2][2][4][2], const Unit& u, int wr, int wc, int fr, int fq) const {
        const int pn = u.pn, rowt = u.pm * BM, rl0 = wr * 64 + fr, cw = wc * 32 + 8 * fq;
#pragma unroll
        for (int ai = 0; ai < 2; ++ai)
#pragma unroll
            for (int m = 0; m < 4; ++m) {
                const size_t row = (size_t)(rowt + ai * HALF + rl0 + m * 16);
                const f32x4 p0 = *(const f32x4*)(ssq + row * 8), p1 = *(const f32x4*)(ssq + row * 8 + 4);
                const float rs = __builtin_amdgcn_rsqf((((p0[0] + p0[1]) + (p0[2] + p0[3])) + ((p1[0] + p1[1]) + (p1[2] + p1[3]))) * (1.0f / 2048.0f) + 1e-6f);
                f32x4 h[2];
#pragma unroll
                for (int n = 0; n < 2; ++n) {
                    const f32x4 g = acc[ai][0][m][n] * rs, up = acc[ai][1][m][n] * rs;
#pragma unroll
                    for (int j = 0; j < 4; ++j) h[n][j] = g[j] * __builtin_amdgcn_rcpf(1.0f + __builtin_amdgcn_exp2f(-1.4426950408889634f * g[j])) * up[j];
                }
                *(u32x4*)(H + row * 5632 + pn * HALF + cw) = pack8(h[0], h[1]);
            }
    }
};

struct EpiDown {
    static constexpr bool PERM = true, AFTER_DRAIN = false;
    float* Y; float* part; unsigned* cnt; PG8_LAS float* red;
    __device__ __forceinline__ void operator()(const f32x4 (&acc)[2][2][4][2], const Unit& u, int wr, int wc, int fr, int fq) const {
        const int pn = u.pn, rowt = u.pm * BM, rl0 = wr * 64 + fr, cw = wc * 32 + 8 * fq;
        if (!u.split) {
#pragma unroll
            for (int ai = 0; ai < 2; ++ai)
#pragma unroll
                for (int m = 0; m < 4; ++m)
#pragma unroll
                    for (int bj = 0; bj < 2; ++bj) {
                        float* o = Y + (size_t)(rowt + ai * HALF + rl0 + m * 16) * 2048 + pn * 256 + bj * HALF + cw;
                        const f32x4 v0 = *(const f32x4*)o + acc[ai][bj][m][0], v1 = *(const f32x4*)(o + 4) + acc[ai][bj][m][1];
                        *(f32x4*)o = v0; *(f32x4*)(o + 4) = v1;
                        if (bj) asm volatile("" ::: "memory");
                    }
        } else {
            const int tu = (u.pm - 32) * 8 + pn, s = u.k0 / 11;
            float* pt = part + (size_t)(tu * 8 + s) * 65536;
#pragma unroll
            for (int ai = 0; ai < 2; ++ai)
#pragma unroll
                for (int m = 0; m < 4; ++m)
#pragma unroll
                    for (int bj = 0; bj < 2; ++bj) { float* o = pt + (ai * HALF + rl0 + m * 16) * 256 + bj * HALF + cw;
                        asm volatile("global_store_dwordx4 %0, %1, off sc0 sc1" :: "v"(o), "v"(acc[ai][bj][m][0]) : "memory");
                        asm volatile("global_store_dwordx4 %0, %1, off sc0 sc1" :: "v"(o + 4), "v"(acc[ai][bj][m][1]) : "memory"); }
            asm volatile("s_waitcnt vmcnt(0)" ::: "memory");
            PG8_LBAR();
            if (threadIdx.x == 0) { const unsigned old = __hip_atomic_fetch_add(cnt + tu, 1u, __ATOMIC_RELAXED, __HIP_MEMORY_SCOPE_AGENT); ((PG8_LAS unsigned*)red)[0] = old; }
            PG8_LBAR();
            const bool last = ((const PG8_LAS unsigned*)red)[0] == 7u;
            if (last) {
                __builtin_amdgcn_fence(__ATOMIC_ACQUIRE, "agent");
                const float* p0 = part + (size_t)(tu * 8) * 65536;
#pragma unroll
                for (int ai = 0; ai < 2; ++ai)
#pragma unroll
                    for (int m = 0; m < 4; ++m)
#pragma unroll
                        for (int bj = 0; bj < 2; ++bj) {
                            const int off = (ai * HALF + rl0 + m * 16) * 256 + bj * HALF + cw;
                            float* o = Y + (size_t)(rowt + ai * HALF + rl0 + m * 16) * 2048 + pn * 256 + bj * HALF + cw;
                            f32x4 v0 = *(const f32x4*)o, v1 = *(const f32x4*)(o + 4);
#pragma unroll
                            for (int s2 = 0; s2 < 8; ++s2) { v0 += *(const f32x4*)(p0 + (size_t)s2 * 65536 + off); v1 += *(const f32x4*)(p0 + (size_t)s2 * 65536 + off + 4); }
                            *(f32x4*)o = v0; *(f32x4*)(o + 4) = v1;
                            asm volatile("" ::: "memory");
                        }
            }
            PG8_LBAR();
        }
    }
};

struct EpiNone {
    static constexpr bool PERM = true, AFTER_DRAIN = false;
    float* sink;
    __device__ __forceinline__ void operator()(const f32x4 (&acc)[2][2][4][2], const Unit& u, int wr, int wc, int fr, int fq) const {
        if (acc[0][0][0][0][0] == 12345.678f && acc[1][1][3][1][3] == -9876.5f) sink[0] = 1.f;
    }
};
template <class Epi, class Sched, bool ALIGN_EPI = false, bool SP2 = false>
__device__ __forceinline__ void gemm_phase(PG8_LAS unsigned char* lds, const Gemm g, const Sched& S, const Epi& E) {
    int tid_ = threadIdx.x; asm volatile("" : "+v"(tid_));
    const int tid = tid_, wid = __builtin_amdgcn_readfirstlane(tid >> 6), lane = tid & 63, wr = wid >> 2, wc = wid & 3, fr = lane & 15, fq = lane >> 4;
    const int K = g.K;
    unsigned voffA[2], voffB[2];
#pragma unroll
    for (int i = 0; i < 2; ++i) { int R, C; stage_rc(tid * 16 + i * 8192, R, C); const int Rb = Epi::PERM ? ((R & ~31) + perm32(R & 31)) : R;
        voffA[i] = (unsigned)(R * K + C) * 2u; voffB[i] = (unsigned)(Rb * K + C) * 2u; }
    const size_t kstep = (size_t)(BK * 2);
    const size_t hstep = (size_t)HALF * K * 2;
    const size_t tstep = 2 * hstep;
    const unsigned ldsw = (unsigned)wid * 1024u;
    const int aoff = lds_byte(wr * 64 + fr, fq * 8), boff = lds_byte(wc * 32 + fr, fq * 8);
#define PG8_SA(b, h) (((b) * 2 + (h)) * HTB)
#define PG8_SB(b, h) ((4 + (b) * 2 + (h)) * HTB)
#define PG8_STAGE(bufoff, gbase, voff) do { _Pragma("unroll") for (int _i = 0; _i < 2; ++_i) \
        __builtin_amdgcn_global_load_lds((const unsigned*)((const char*)(gbase) + (voff)[_i]), (PG8_LAS unsigned*)(lds + (bufoff) + ldsw + _i * 8192), 16, 0, 0); } while (0)
#define PG8_LDA(dst, b, h) do { _Pragma("unroll") for (int m = 0; m < 4; ++m) _Pragma("unroll") for (int k = 0; k < 2; ++k) dst[m][k] = *(const PG8_LAS bf16x8*)(lds + PG8_SA(b, h) + aoff + m * 2048 + k * 1024); } while (0)
#define PG8_LDB(dst, b, h) do { _Pragma("unroll") for (int n = 0; n < 2; ++n) _Pragma("unroll") for (int k = 0; k < 2; ++k) dst[n][k] = *(const PG8_LAS bf16x8*)(lds + PG8_SB(b, h) + boff + n * 2048 + k * 1024); } while (0)
#define PG8_MMA(ai, bj, At, Bt) do { __builtin_amdgcn_s_setprio(1); _Pragma("unroll") for (int m = 0; m < 4; ++m) _Pragma("unroll") for (int n = 0; n < 2; ++n) _Pragma("unroll") for (int k = 0; k < 2; ++k) \
        acc[ai][bj][m][n] = __builtin_amdgcn_mfma_f32_16x16x32_bf16(Bt[n][k], At[m][k], acc[ai][bj][m][n], 0, 0, 0); __builtin_amdgcn_s_setprio(0); } while (0)
#define PG8_WAIT_V(n) asm volatile("s_waitcnt vmcnt(" #n ")" ::: "memory")
#define PG8_WAIT_L(n) asm volatile("s_waitcnt lgkmcnt(" #n ")" ::: "memory")
#define PG8_BAR __builtin_amdgcn_s_barrier()
#define PG8_SCHED __builtin_amdgcn_sched_barrier(0)
    Unit cur, nxt; int ui = 0;
    if (!S.next(0, cur)) return;
    f32x4 acc[2][2][4][2];
#pragma unroll
    for (int a = 0; a < 2; ++a)
#pragma unroll
        for (int b = 0; b < 2; ++b)
#pragma unroll
            for (int m = 0; m < 4; ++m)
#pragma unroll
                for (int n = 0; n < 2; ++n) acc[a][b][m][n] = (f32x4){0.f, 0.f, 0.f, 0.f};
    bf16x8 At[4][2], B0[2][2], B1[2][2];
    const char* cA = (const char*)g.A + (size_t)cur.pm * tstep + (size_t)cur.k0 * kstep; const char* cB = (const char*)g.Bt + (size_t)cur.pn * tstep + (size_t)cur.k0 * kstep;
    S.a_ready(cur);
    if constexpr (SP2) {
        PG8_STAGE(PG8_SB(0, 0), cB, voffB); PG8_STAGE(PG8_SB(0, 1), cB + hstep, voffB); PG8_STAGE(PG8_SA(0, 0), cA, voffA); PG8_STAGE(PG8_SA(0, 1), cA + hstep, voffA);
        if (wr == 1) PG8_BAR;
        PG8_WAIT_V(2); PG8_BAR;
        PG8_STAGE(PG8_SB(1, 0), cB + kstep, voffB); PG8_STAGE(PG8_SA(1, 0), cA + kstep, voffA); PG8_STAGE(PG8_SB(1, 1), cB + hstep + kstep, voffB);
        PG8_WAIT_V(6); PG8_BAR;
    } else {
        PG8_STAGE(PG8_SB(0, 0), cB, voffB); PG8_STAGE(PG8_SA(0, 0), cA, voffA); PG8_STAGE(PG8_SB(0, 1), cB + hstep, voffB); PG8_STAGE(PG8_SA(0, 1), cA + hstep, voffA);
        if (wr == 1) PG8_BAR;
        PG8_WAIT_V(4); PG8_BAR;
        PG8_STAGE(PG8_SB(1, 0), cB + kstep, voffB); PG8_STAGE(PG8_SA(1, 0), cA + kstep, voffA); PG8_STAGE(PG8_SB(1, 1), cB + hstep + kstep, voffB);
        PG8_WAIT_V(6); PG8_BAR;
    }
    for (;;) {
        const bool has_next = S.next(ui + 1, nxt);
        const char* nA = has_next ? (const char*)g.A + (size_t)nxt.pm * tstep + (size_t)nxt.k0 * kstep : cA; const char* nB = has_next ? (const char*)g.Bt + (size_t)nxt.pn * tstep + (size_t)nxt.k0 * kstep : cB;
        const int nt = cur.nt;
        for (int t = 0; t < nt; t += 2) {
            const bool last = (t == nt - 2);
            const char* a1 = cA + (size_t)(t + 1) * kstep;
            const char* a2 = last ? nA : cA + (size_t)(t + 2) * kstep; const char* b2 = last ? nB : cB + (size_t)(t + 2) * kstep;
            const char* a3 = a2 + kstep; const char* b3 = b2 + kstep;
            if (last && has_next) S.a_ready(nxt);
            if constexpr (SP2) {
            PG8_LDB(B0, 0, 0); PG8_LDB(B1, 0, 1); PG8_SCHED; PG8_LDA(At, 0, 0); PG8_STAGE(PG8_SA(1, 1), a1 + hstep, voffA);
            PG8_WAIT_V(8); PG8_WAIT_L(0); PG8_BAR; PG8_MMA(0, 0, At, B0); PG8_MMA(0, 1, At, B1); PG8_BAR; PG8_SCHED;
            PG8_LDA(At, 0, 1); PG8_STAGE(PG8_SB(0, 0), b2, voffB); PG8_STAGE(PG8_SB(0, 1), b2 + hstep, voffB); PG8_STAGE(PG8_SA(0, 0), a2, voffA);
            PG8_WAIT_V(8); PG8_WAIT_L(0); PG8_BAR; PG8_MMA(1, 0, At, B0); PG8_MMA(1, 1, At, B1); PG8_BAR; PG8_SCHED;
            PG8_LDB(B0, 1, 0); PG8_LDB(B1, 1, 1); PG8_SCHED; PG8_LDA(At, 1, 0); PG8_STAGE(PG8_SA(0, 1), a2 + hstep, voffA);
            PG8_WAIT_V(8); PG8_WAIT_L(0); PG8_BAR; PG8_MMA(0, 0, At, B0); PG8_MMA(0, 1, At, B1); PG8_BAR; PG8_SCHED;
            PG8_LDA(At, 1, 1); PG8_STAGE(PG8_SB(1, 0), b3, voffB); PG8_STAGE(PG8_SB(1, 1), b3 + hstep, voffB); PG8_STAGE(PG8_SA(1, 0), a3, voffA);
            PG8_WAIT_V(8); PG8_WAIT_L(0); PG8_BAR; PG8_MMA(1, 0, At, B0); PG8_MMA(1, 1, At, B1); PG8_BAR; PG8_SCHED;
            } else {
            PG8_LDB(B0, 0, 0); PG8_SCHED; PG8_LDA(At, 0, 0); PG8_STAGE(PG8_SA(1, 1), a1 + hstep, voffA);
            PG8_WAIT_L(8); PG8_BAR; PG8_WAIT_L(0); PG8_MMA(0, 0, At, B0); PG8_BAR; PG8_SCHED;
            PG8_LDB(B1, 0, 1); PG8_STAGE(PG8_SB(0, 0), b2, voffB);
            PG8_BAR; PG8_WAIT_L(0); PG8_MMA(0, 1, At, B1); PG8_BAR;
            PG8_LDA(At, 0, 1); PG8_STAGE(PG8_SA(0, 0), a2, voffA);
            PG8_BAR; PG8_WAIT_L(0); PG8_MMA(1, 0, At, B0); PG8_BAR; PG8_SCHED;
            PG8_STAGE(PG8_SB(0, 1), b2 + hstep, voffB);
            PG8_WAIT_V(6); PG8_BAR; PG8_MMA(1, 1, At, B1); PG8_BAR;
            PG8_LDB(B0, 1, 0); PG8_SCHED; PG8_LDA(At, 1, 0); PG8_STAGE(PG8_SA(0, 1), a2 + hstep, voffA);
            PG8_WAIT_L(8); PG8_BAR; PG8_WAIT_L(0); PG8_MMA(0, 0, At, B0); PG8_BAR; PG8_SCHED;
            PG8_LDB(B1, 1, 1); PG8_STAGE(PG8_SB(1, 0), b3, voffB);
            PG8_BAR; PG8_WAIT_L(0); PG8_MMA(0, 1, At, B1); PG8_BAR;
            PG8_LDA(At, 1, 1); PG8_STAGE(PG8_SA(1, 0), a3, voffA);
            PG8_BAR; PG8_WAIT_L(0); PG8_MMA(1, 0, At, B0); PG8_BAR; PG8_SCHED;
            PG8_STAGE(PG8_SB(1, 1), b3 + hstep, voffB);
            PG8_WAIT_V(6); PG8_BAR; PG8_MMA(1, 1, At, B1); PG8_BAR;
            }
        }
        if constexpr (ALIGN_EPI) { if (wr == 0) PG8_BAR; }
        if constexpr (!Epi::AFTER_DRAIN) { E(acc, cur, wr, wc, fr, fq); S.done(cur); }
        if (!has_next) break;
#pragma unroll
        for (int a = 0; a < 2; ++a)
#pragma unroll
            for (int b = 0; b < 2; ++b)
#pragma unroll
                for (int m = 0; m < 4; ++m)
#pragma unroll
                    for (int n = 0; n < 2; ++n) acc[a][b][m][n] = (f32x4){0.f, 0.f, 0.f, 0.f};
        cur = nxt; cA = nA; cB = nB; ++ui;
        if constexpr (ALIGN_EPI) { if (wr == 1) PG8_BAR; }
    }
    PG8_WAIT_V(0);
    if constexpr (!ALIGN_EPI) { if (wr == 0) PG8_BAR; }
    PG8_BAR;
    if constexpr (Epi::AFTER_DRAIN) { E.fused(acc, cur, wr, wc, fr, fq, lds, wid, lane); S.done(cur); }
#undef PG8_SA
#undef PG8_SB
#undef PG8_STAGE
#undef PG8_LDA
#undef PG8_LDB
#undef PG8_MMA
#undef PG8_WAIT_V
#undef PG8_WAIT_L
#undef PG8_BAR
#undef PG8_SCHED
}
}
#define LAS __attribute__((address_space(3)))
typedef unsigned short bf16;
typedef float f32x4 __attribute__((ext_vector_type(4)));
typedef float f32x16 __attribute__((ext_vector_type(16)));
typedef short bf16x8 __attribute__((ext_vector_type(8)));
typedef short s16x4 __attribute__((ext_vector_type(4)));
typedef unsigned u32x4 __attribute__((ext_vector_type(4)));
typedef unsigned u32x2 __attribute__((ext_vector_type(2)));
constexpr int DM = 2048, SEQ = 4096, NP = 8192, NS = 512, MT = NP + NS, AW = 1024, CC = 1024, INC = 6144, DFF = 5632, PAST = 4096, DSEQ = 64;
constexpr float EPS = 1e-6f;
constexpr size_t OFF_Y = 0, OFF_KP = (size_t)MT * DM, OFF_VP = OFF_KP + (size_t)NP * AW, OFF_CP = OFF_VP + (size_t)NP * AW, OFF_KS = OFF_CP + 2 * 2 * CC,
                 OFF_VS = OFF_KS + (size_t)NS * AW, OFF_CS = OFF_VS + (size_t)NS * AW, OUT_TOTAL = OFF_CS + 8 * 2 * CC;
static_assert(OUT_TOTAL == 35672064, "output size");
constexpr size_t MiB = 1u << 20;
constexpr size_t WS_CTL = 0, WS_WIN = 1 * MiB, WS_WOUT = 25 * MiB, WS_WGU = 33 * MiB, WS_WDN = 77 * MiB, WS_HN = 99 * MiB, WS_Q = 133 * MiB, WS_K = 150 * MiB, WS_V = 166 * MiB,
                 WS_GB = 182 * MiB, WS_U = 199 * MiB, WS_MIX = 216 * MiB, WS_SSQ = 250 * MiB, WS_TP = 251 * MiB, WS_OP = 256 * MiB, WS_H = 256 * MiB, WS_PART = 133 * MiB  ;
constexpr int NSLOT = 256 + 16;
constexpr size_t WS_END = WS_OP + (size_t)NSLOT * 131072;
constexpr int RING_BYTES = 131072, RED_OFF = RING_BYTES, MISC_OFF = RED_OFF + 8192, LDS_BYTES = 147456;
constexpr int NWAVES = 8;

#define XB_TMO      128
#define XB_XCNT(j)  (256  + 64 * (j))
#define XB_XSUB(j)  (1280 + 64 * (j))
#define XB_XGEN(j)  (2304 + 64 * (j))
#define XB_TOP      3328
#define XB_TOPGEN   3392
#define XCD_BAR_WORDS 3456
#define XB_SPIN_CAP (1u << 18)

__device__ __forceinline__ unsigned xb_ld(unsigned* p)              { return __hip_atomic_load(p, __ATOMIC_RELAXED, __HIP_MEMORY_SCOPE_AGENT); }
__device__ __forceinline__ unsigned xb_add(unsigned* p, unsigned v) { return __hip_atomic_fetch_add(p, v, __ATOMIC_RELAXED, __HIP_MEMORY_SCOPE_AGENT); }
__device__ __forceinline__ unsigned xb_xcc_id() { return (unsigned)__builtin_amdgcn_s_getreg((3 << 11) | 20) & 0xFu; }
#define XB_SPIN(cond, bar) do { unsigned _sp = 0; while (cond) { __builtin_amdgcn_s_sleep(1); \
    if ((++_sp & 255u) == 0u) { if (xb_ld(&(bar)[XB_TMO])) break; if (_sp > XB_SPIN_CAP) { atomicAdd(&(bar)[XB_TMO], 1u); break; } } } } while (0)

struct XcdBarrier {
    unsigned* bar; unsigned x;
    volatile LAS unsigned* st;
};

__device__ __forceinline__ XcdBarrier xcd_barrier_post(unsigned* bar, volatile LAS unsigned* st) {
    XcdBarrier b; b.bar = bar; b.x = xb_xcc_id(); b.st = st;
    if (threadIdx.x == 0) (void)xb_add(&bar[XB_XCNT(b.x)], 1u);
    return b;
}
__device__ __forceinline__ void xcd_barrier_complete(unsigned* bar, unsigned x, unsigned& nloc, unsigned& nx) {
    const unsigned G = gridDim.x * gridDim.y * gridDim.z;
    unsigned sum, cnt, mine, sp = 0u;
    for (;;) {
        sum = 0u; cnt = 0u; mine = 0u;
#pragma unroll
        for (unsigned j = 0; j < 16; ++j) { const unsigned c = xb_ld(&bar[XB_XCNT(j)]); sum += c; cnt += (c > 0u) ? 1u : 0u; mine = (j == x) ? c : mine; }
        if (sum == G) break;
        __builtin_amdgcn_s_sleep(1);
        if ((++sp & 255u) == 0u) { if (xb_ld(&bar[XB_TMO])) break; if (sp > XB_SPIN_CAP) { atomicAdd(&bar[XB_TMO], 1u); break; } }
    }
    nloc = mine > 0u ? mine : 1u; nx = cnt > 0u ? cnt : 1u;
}

__device__ __forceinline__ void xcd_barrier(const XcdBarrier& b) {
    asm volatile("s_waitcnt vmcnt(0)" ::: "memory");
    __syncthreads();
    if (threadIdx.x == 0) {
        unsigned* bar = b.bar;
        __builtin_amdgcn_s_waitcnt(0);
        unsigned nloc = b.st[0], nx = b.st[1];
        if (nloc == 0u) { xcd_barrier_complete(bar, b.x, nloc, nx); b.st[0] = nloc; b.st[1] = nx; }
        const unsigned old = xb_add(&bar[XB_XSUB(b.x)], 1u);
        const unsigned gen = old / nloc;
        if (old + 1u == (gen + 1u) * nloc) {
            __builtin_amdgcn_fence(__ATOMIC_RELEASE, "agent");
            asm volatile("s_waitcnt vmcnt(0)" ::: "memory");
            const unsigned og = xb_add(&bar[XB_TOP], 1u);
            const unsigned tg = og / nx;
            if (og + 1u == (tg + 1u) * nx) xb_add(&bar[XB_TOPGEN], 1u);
            else XB_SPIN(xb_ld(&bar[XB_TOPGEN]) == tg, bar);
            __builtin_amdgcn_fence(__ATOMIC_ACQUIRE, "agent");
            xb_add(&bar[XB_XGEN(b.x)], 1u);
            asm volatile("s_waitcnt vmcnt(0)" ::: "memory");
        } else {
            XB_SPIN(xb_ld(&bar[XB_XGEN(b.x)]) == gen, bar);
            __builtin_amdgcn_fence(__ATOMIC_ACQUIRE, "agent");
            asm volatile("s_waitcnt vmcnt(0)" ::: "memory");
        }
    }
    __syncthreads();
}

struct ItemTab { int n; int v[272]; };
constexpr int p_nsteps(int qb, int c) { return 8 * (qb + 1); }
constexpr ItemTab make_items() {
    ItemTab t{}; t.n = 0;
    for (int b = 0; b < 8; ++b) for (int hg = 0; hg < 2; ++hg) t.v[t.n++] = 1 | (b << 1) | (hg << 4);
    for (int qb = 15; qb >= 0; --qb) for (int bh = 0; bh < 16; ++bh) t.v[t.n++] = (bh << 1) | (qb << 5);
    return t;
}
__device__ const ItemTab g_items = make_items();

__device__ __forceinline__ unsigned f2bf(float f) { unsigned u = __builtin_bit_cast(unsigned, f); return (u + 0x7fffu + ((u >> 16) & 1u)) >> 16; }
__device__ __forceinline__ unsigned pk2(float lo, float hi) { return pg8::cvt_pk_bf16(lo, hi); }
__device__ __forceinline__ float bflo(unsigned w) { return __builtin_bit_cast(float, w << 16); }
__device__ __forceinline__ float bfhi(unsigned w) { return __builtin_bit_cast(float, w & 0xffff0000u); }
__device__ __forceinline__ int crow(int r, int hi) { return (r & 3) + 8 * (r >> 2) + 4 * hi; }
__device__ __forceinline__ float wave_sum(float v) {
#pragma unroll
    for (int o = 1; o < 64; o <<= 1) v += __shfl_xor(v, o);
    return v;
}

struct Args { const float* in[17]; float* out; unsigned char* ws; };

struct P0Item { const float* src; const float* gk; bf16* dst; int N, K, k0; };
__device__ __forceinline__ P0Item p0_decode(const Args& a, int it) {
    constexpr int I_IN = 32 * 192, I_OUT = 32 * 64, I_G = 32 * 176;
    unsigned char* ws = a.ws; P0Item r; int n0, kb, drow; r.gk = nullptr;
    if (it < I_IN) { kb = it / 192; n0 = 32 * (it % 192); drow = n0;
        if (n0 >= 5120) { const int ch = n0 - 5120; drow = 4096 + (ch >> 7) * 256 + 128 + (ch & 127); } else if (n0 >= 4096) { const int ch = n0 - 4096; drow = 4096 + (ch >> 7) * 256 + (ch & 127); }
        r.src = a.in[6]; r.N = INC; r.K = DM; r.dst = (bf16*)(ws + WS_WIN); }
    else if ((it -= I_IN) < I_OUT) { kb = it / 64; n0 = 32 * (it % 64); drow = n0; r.src = a.in[12]; r.N = DM; r.K = DM; r.dst = (bf16*)(ws + WS_WOUT); }
    else if ((it -= I_OUT) < 2 * I_G) { const int up = it >= I_G; if (up) it -= I_G; kb = it / 176; n0 = 32 * (it % 176); drow = (n0 >> 7) * 256 + up * 128 + (n0 & 127);
        r.src = a.in[up ? 15 : 14]; r.N = DFF; r.K = DM; r.dst = (bf16*)(ws + WS_WGU); r.gk = a.in[13]; }
    else { it -= 2 * I_G; kb = it / 64; n0 = 32 * (it % 64); drow = n0; r.src = a.in[16]; r.N = DM; r.K = DFF; r.dst = (bf16*)(ws + WS_WDN); }
    r.k0 = 64 * kb; r.src += (size_t)r.k0 * r.N + n0; r.dst += (size_t)drow * r.K + r.k0;
    return r;
}
__device__ __forceinline__ void p0_load(const P0Item& p, f32x4 (&v)[8], int lane) {
#pragma unroll
    for (int j = 0; j < 8; ++j) v[j] = __builtin_nontemporal_load((const f32x4*)(p.src + (size_t)(8 * j + (lane >> 3)) * p.N + 4 * (lane & 7)));
}
__device__ __forceinline__ void p0_finish(const P0Item& p, const f32x4 (&v)[8], LAS float* scr, int lane) {
#pragma unroll
    for (int j = 0; j < 8; ++j) { const int kk = 8 * j + (lane >> 3); const float g = p.gk ? p.gk[p.k0 + kk] : 1.0f; LAS float* s = scr + kk * 33 + 4 * (lane & 7);
        s[0] = v[j][0] * g; s[1] = v[j][1] * g; s[2] = v[j][2] * g; s[3] = v[j][3] * g; }
    asm volatile("s_waitcnt lgkmcnt(0)" ::: "memory");
    const int c = lane & 7;
#pragma unroll
    for (int j = 0; j < 4; ++j) { const int n = (lane >> 3) + 8 * j; const LAS float* s = scr + (8 * c) * 33 + n;
        u32x4 o; o.x = pk2(s[0 * 33], s[1 * 33]); o.y = pk2(s[2 * 33], s[3 * 33]); o.z = pk2(s[4 * 33], s[5 * 33]); o.w = pk2(s[6 * 33], s[7 * 33]);
        *(u32x4*)(p.dst + (size_t)n * p.K + 8 * c) = o; }
    asm volatile("s_waitcnt lgkmcnt(0)" ::: "memory");
}
__device__ __forceinline__ void p0_prologue(const Args& a, LAS unsigned char* lds, int gw, int NGW, int lane, int wave) {
    LAS float* scr = (LAS float*)(lds + wave * 16384);
    unsigned char* ws = a.ws;
    constexpr int NITEMS = 32 * 192 + 32 * 64 + 2 * 32 * 176 + 88 * 64;
    {
        int it = gw; f32x4 va[8], vb[8]; P0Item pa, pb;
        if (it < NITEMS) { pa = p0_decode(a, it); p0_load(pa, va, lane); }
        while (it < NITEMS) {
            const int itb = it + NGW;
            if (itb < NITEMS) { pb = p0_decode(a, itb); p0_load(pb, vb, lane); }
            p0_finish(pa, va, scr, lane);
            it = itb + NGW;
            if (itb >= NITEMS) break;
            if (it < NITEMS) { pa = p0_decode(a, it); p0_load(pa, va, lane); }
            p0_finish(pb, vb, scr, lane);
        }
    }
    const float* g1 = a.in[5];
    for (int m = gw; m < MT; m += NGW) {
        const float* xrow = m < NP ? a.in[0] + (size_t)m * DM : a.in[1] + (size_t)(m - NP) * DM;
        const f32x4* xr = (const f32x4*)xrow + lane; f32x4 v[8]; float s = 0.f;
#pragma unroll
        for (int j = 0; j < 8; ++j) { v[j] = xr[64 * j]; s += (v[j][0] * v[j][0] + v[j][1] * v[j][1]) + (v[j][2] * v[j][2] + v[j][3] * v[j][3]); }
        const float rs = __builtin_amdgcn_rsqf(wave_sum(s) * (1.0f / DM) + EPS);
        u32x2* o = (u32x2*)((bf16*)(ws + WS_HN) + (size_t)m * DM) + lane;
#pragma unroll
        for (int j = 0; j < 8; ++j) { const f32x4 g = *((const f32x4*)g1 + 64 * j + lane); u32x2 w; w.x = pk2(v[j][0] * rs * g[0], v[j][1] * rs * g[1]); w.y = pk2(v[j][2] * rs * g[2], v[j][3] * rs * g[3]); o[64 * j] = w; }
    }
}


template <int VS, bool QREG>
__device__ __forceinline__ void sb_block(f32x16 (&o)[4], float& R, const LAS unsigned char* kp, const LAS unsigned char* vp, const bf16x8 (&qreg)[8], const LAS unsigned char* qlp, int kb, int qw, int qpos, int hi) {
            f32x16 p;
#pragma unroll
            for (int r = 0; r < 16; ++r) p[r] = 0.f;
#pragma unroll
            for (int d0 = 0; d0 < 8; ++d0) { const bf16x8 kf = *(const LAS bf16x8*)(kp + d0 * 32); const bf16x8 qf = QREG ? qreg[d0] : *(const LAS bf16x8*)(qlp + d0 * 32); p = __builtin_amdgcn_mfma_f32_32x32x16_bf16(kf, qf, p, 0, 0, 0); }
            const bool need_mask = (kb + 31 >= qw);
            float e[16], sf[16];
#pragma unroll
            for (int r = 0; r < 16; ++r) {
                const float z = fminf(p[r], 100.f); float ee = __builtin_amdgcn_exp2f(z); float rr = __builtin_amdgcn_rcpf(1.0f + ee);
                if (need_mask) { const bool msk = (kb + crow(r, hi)) >= qpos; ee = msk ? 0.f : ee; rr = msk ? 1.f : rr; }
                e[r] = ee; sf[r] = rr;
            }
            float oth[4], PP[4];
#pragma unroll
            for (int g = 0; g < 4; ++g) { sf[4 * g + 2] *= sf[4 * g + 3]; sf[4 * g + 1] *= sf[4 * g + 2]; sf[4 * g] *= sf[4 * g + 1]; oth[g] = __shfl_xor(sf[4 * g], 32); PP[g] = sf[4 * g] * oth[g]; }
            const float SP3 = PP[3], SP2 = PP[2] * SP3, SP1 = PP[1] * SP2, SP0 = PP[0] * SP1;
            float A[4]; A[0] = R * SP1; A[1] = R * SP2; A[2] = R * SP3; A[3] = R;
#pragma unroll
            for (int g = 0; g < 4; ++g) A[g] = hi ? A[g] : A[g] * oth[g];
            R *= SP0;
            float w[16];
#pragma unroll
            for (int r = 0; r < 16; ++r) w[r] = (e[r] * sf[r]) * A[r >> 2];
#pragma unroll
            for (int s2 = 0; s2 < 2; ++s2) {
                u32x4 pw; pw.x = pk2(w[8 * s2 + 0], w[8 * s2 + 1]); pw.y = pk2(w[8 * s2 + 2], w[8 * s2 + 3]); pw.z = pk2(w[8 * s2 + 4], w[8 * s2 + 5]); pw.w = pk2(w[8 * s2 + 6], w[8 * s2 + 7]);
                const bf16x8 pa = __builtin_bit_cast(bf16x8, pw);
#pragma unroll
                for (int db = 0; db < 4; ++db) {
                    const s16x4 lo = __builtin_bit_cast(s16x4, __builtin_amdgcn_ds_read_tr16_b64_v4i16((LAS s16x4*)(vp + (16 * s2) * VS + db * 64)));
                    const s16x4 hh = __builtin_bit_cast(s16x4, __builtin_amdgcn_ds_read_tr16_b64_v4i16((LAS s16x4*)(vp + (16 * s2 + 8) * VS + db * 64)));
                    const bf16x8 vb = __builtin_shufflevector(lo, hh, 0, 1, 2, 3, 4, 5, 6, 7);
                    o[db] = __builtin_amdgcn_mfma_f32_32x32x16_bf16(pa, vb, o[db], 0, 0, 0);
                }
            }
}

template <bool SAMPLE>
__device__ __forceinline__ void attn_item(const Args& a, LAS unsigned char* lds, int code) {
    constexpr int NH = SAMPLE ? 4 : 1, KS = NH * 256 + 16, VS = NH * 256 + 32, K_OFF = 0, V_OFF = 32 * KS;
    int tid_ = threadIdx.x; asm volatile("" : "+v"(tid_));
    const int tid = tid_, lane = tid & 63, r32 = lane & 31, hi = lane >> 5; const int wid = __builtin_amdgcn_readfirstlane(tid >> 6);
    unsigned char* ws = a.ws;
    int slot, nsteps, kvpos0, qw, head, hl; size_t qrow;
    const bf16 *kgb = nullptr, *vgb = nullptr; const float *kgf = nullptr, *vgf = nullptr, *kgn = nullptr, *vgn = nullptr;
    if (SAMPLE) {
        const int b = (code >> 1) & 7, hg = (code >> 4) & 1;
        slot = 256 + b * 2 + hg; hl = wid >> 1; head = hg * 4 + hl; const int rg = wid & 1;
        qw = PAST + 32 * rg; qrow = (size_t)NP + b * DSEQ + 32 * rg + r32;
        nsteps = 130; kvpos0 = 0;
        kgf = a.in[2] + ((size_t)b * PAST + (tid >> 7)) * AW + hg * 512 + 4 * (tid & 127); vgf = a.in[3] + ((size_t)b * PAST + (tid >> 7)) * AW + hg * 512 + 4 * (tid & 127);
        kgn = a.out + OFF_KS + ((size_t)b * DSEQ + (tid >> 7)) * AW + hg * 512 + 4 * (tid & 127); vgn = a.out + OFF_VS + ((size_t)b * DSEQ + (tid >> 7)) * AW + hg * 512 + 4 * (tid & 127);
    } else {
        const int bh = (code >> 1) & 15, qb = (code >> 5) & 15, c = (code >> 9) & 3, b = bh >> 3;
        head = bh & 7; hl = 0; slot = bh * 16 + qb + 0 * c; nsteps = p_nsteps(qb, c); kvpos0 = 0;
        qw = qb * 256 + 32 * wid; qrow = (size_t)b * SEQ + qw + r32;
        kgb = (const bf16*)(ws + WS_K) + ((size_t)b * SEQ + kvpos0 + (tid >> 4)) * AW + head * 128 + (tid & 15) * 8;
        vgb = (const bf16*)(ws + WS_V) + ((size_t)b * SEQ + kvpos0 + (tid >> 4)) * AW + head * 128 + (tid & 15) * 8;
    }
    const int qpos = qw + r32;
    constexpr int Q_OFF = 67584, QS = 272;
    const LAS unsigned char* qlp = lds + Q_OFF + wid * (32 * QS) + r32 * QS + hi * 16;
    { const bf16* qp = (const bf16*)(ws + WS_Q) + qrow * AW + head * 128 + hi * 8;
#pragma unroll
      for (int d0 = 0; d0 < 8; ++d0) *(LAS bf16x8*)(lds + Q_OFF + wid * (32 * QS) + r32 * QS + hi * 16 + d0 * 32) = *(const bf16x8*)(qp + 16 * d0); }
    f32x16 o[4];
#pragma unroll
    for (int i = 0; i < 4; ++i)
#pragma unroll
        for (int r = 0; r < 16; ++r) o[i][r] = 0.f;
    float R = 1.f;
    u32x4 kreg, vreg; f32x4 kf4[8], vf4[8];
#define ATT_LOADK(s_) do { if (SAMPLE) { _Pragma("unroll") for (int i_ = 0; i_ < 8; ++i_) kf4[i_] = *(const f32x4*)(((s_) >= 128 ? kgn + (size_t)((s_) - 128) * 32 * AW : kgf + (size_t)(s_) * 32 * AW) + (size_t)i_ * 4 * AW); } \
        else { kreg = *(const u32x4*)(kgb + (size_t)(s_) * 32 * AW); } } while (0)
#define ATT_LOADV(s_) do { if (SAMPLE) { _Pragma("unroll") for (int i_ = 0; i_ < 8; ++i_) vf4[i_] = *(const f32x4*)(((s_) >= 128 ? vgn + (size_t)((s_) - 128) * 32 * AW : vgf + (size_t)(s_) * 32 * AW) + (size_t)i_ * 4 * AW); } \
        else { vreg = *(const u32x4*)(vgb + (size_t)(s_) * 32 * AW); } } while (0)
#define ATT_STOREK() do { if (SAMPLE) { _Pragma("unroll") for (int i_ = 0; i_ < 8; ++i_) { const int key_ = (tid >> 7) + 4 * i_, f4_ = tid & 127; \
            u32x2 kw_; kw_.x = pk2(kf4[i_][0], kf4[i_][1]); kw_.y = pk2(kf4[i_][2], kf4[i_][3]); *(LAS u32x2*)(lds + K_OFF + key_ * KS + f4_ * 8) = kw_; } } \
        else { *(LAS u32x4*)(lds + K_OFF + (tid >> 4) * KS + (tid & 15) * 16) = kreg; } } while (0)
#define ATT_STOREV() do { if (SAMPLE) { _Pragma("unroll") for (int i_ = 0; i_ < 8; ++i_) { const int key_ = (tid >> 7) + 4 * i_, f4_ = tid & 127; \
            u32x2 vw_; vw_.x = pk2(vf4[i_][0], vf4[i_][1]); vw_.y = pk2(vf4[i_][2], vf4[i_][3]); *(LAS u32x2*)(lds + V_OFF + key_ * VS + f4_ * 8) = vw_; } } \
        else { *(LAS u32x4*)(lds + V_OFF + (tid >> 4) * VS + (tid & 15) * 16) = vreg; } } while (0)
    volatile LAS int* flg = (volatile LAS int*)(lds + MISC_OFF + 64);
    ATT_LOADK(nsteps - 1); ATT_LOADV(nsteps - 1);
    ATT_STOREK(); ATT_STOREV();
    __syncthreads();
    const LAS unsigned char* kp = lds + K_OFF + r32 * KS + hl * 256 + hi * 16;
    const LAS unsigned char* vp = lds + V_OFF + (4 * hi + ((lane & 15) >> 2)) * VS + hl * 256 + (16 * ((lane >> 4) & 1) + 4 * (lane & 3)) * 2;
    for (int s = nsteps - 1; s >= 0; --s) {
        if (s > 0) { ATT_LOADK(s - 1); if (!SAMPLE) ATT_LOADV(s - 1); }
        const int kb = kvpos0 + 32 * s;
        if (kb < qw + 32 && !__all(R == 0.f)) { const bf16x8 qdummy[8] = {}; sb_block<VS, false>(o, R, kp, vp, qdummy, qlp, kb, qw, qpos, hi); }
        if (lane == 0) flg[wid] = __all(R == 0.f) ? 1 : 0;
        __syncthreads();
        const bool alldone = (flg[0] & flg[1] & flg[2] & flg[3] & flg[4] & flg[5] & flg[6] & flg[7]) != 0;
        if (alldone) { __syncthreads(); break; }
        if (s > 0) { ATT_STOREK(); if (SAMPLE) ATT_LOADV(s - 1); ATT_STOREV(); }
        __syncthreads();
    }
#undef ATT_LOADK
#undef ATT_LOADV
#undef ATT_STOREK
#undef ATT_STOREV
    float* op = (float*)(ws + WS_OP) + ((size_t)(slot * 8 + wid) * 32) * 128;
#pragma unroll
    for (int db = 0; db < 4; ++db)
#pragma unroll
        for (int r = 0; r < 16; ++r) op[crow(r, hi) * 128 + db * 32 + r32] = o[db][r];
    if (hi == 0) ((float*)(ws + WS_TP))[(slot * 8 + wid) * 32 + r32] = R;
}


__device__ __forceinline__ void attn_item_p(const Args& a, LAS unsigned char* lds, int code) {
    constexpr int KS = 272, VS = 288, TILE_K = 64 * KS, BUF = TILE_K + 64 * VS;
    int tid_ = threadIdx.x; asm volatile("" : "+v"(tid_));
    const int tid = tid_, lane = tid & 63, r32 = lane & 31, hi = lane >> 5; const int wid = __builtin_amdgcn_readfirstlane(tid >> 6);
    unsigned char* ws = a.ws;
    const int bh = (code >> 1) & 15, qb = (code >> 5) & 15, c = (code >> 9) & 3, b = bh >> 3, head = bh & 7;
    const int slot = bh * 16 + qb + 0 * c, nst = p_nsteps(qb, c) >> 1, kvpos0 = 0;
    const int qw = qb * 256 + 32 * wid, qpos = qw + r32; const size_t qrow = (size_t)b * SEQ + qpos;
    const bf16* kgb = (const bf16*)(ws + WS_K) + ((size_t)b * SEQ + kvpos0 + (tid >> 4)) * AW + head * 128 + (tid & 15) * 8;
    const bf16* vgb = (const bf16*)(ws + WS_V) + ((size_t)b * SEQ + kvpos0 + (tid >> 4)) * AW + head * 128 + (tid & 15) * 8;
    bf16x8 qf[8];
    { const bf16* qp = (const bf16*)(ws + WS_Q) + qrow * AW + head * 128 + hi * 8;
#pragma unroll
      for (int d0 = 0; d0 < 8; ++d0) qf[d0] = *(const bf16x8*)(qp + 16 * d0); }
    f32x16 o[4];
#pragma unroll
    for (int i = 0; i < 4; ++i)
#pragma unroll
        for (int r = 0; r < 16; ++r) o[i][r] = 0.f;
    float R = 1.f;
    u32x4 kreg[2], vreg[2];
#define PLOAD(s_) do { _Pragma("unroll") for (int i_ = 0; i_ < 2; ++i_) { kreg[i_] = *(const u32x4*)(kgb + (size_t)((s_) * 64 + 32 * i_) * AW); vreg[i_] = *(const u32x4*)(vgb + (size_t)((s_) * 64 + 32 * i_) * AW); } } while (0)
#define PSTORE(buf_) do { _Pragma("unroll") for (int i_ = 0; i_ < 2; ++i_) { *(LAS u32x4*)(lds + (buf_) * BUF + ((tid >> 4) + 32 * i_) * KS + (tid & 15) * 16) = kreg[i_]; \
        *(LAS u32x4*)(lds + (buf_) * BUF + TILE_K + ((tid >> 4) + 32 * i_) * VS + (tid & 15) * 16) = vreg[i_]; } } while (0)
    volatile LAS int* flg = (volatile LAS int*)(lds + MISC_OFF + 64);
    PLOAD(nst - 1);
    PSTORE(0);
    __syncthreads();
    const LAS unsigned char* kp = lds + r32 * KS + hi * 16;
    const LAS unsigned char* vp = lds + TILE_K + (4 * hi + ((lane & 15) >> 2)) * VS + (16 * ((lane >> 4) & 1) + 4 * (lane & 3)) * 2;
    int cur = 0;
    for (int s = nst - 1; s >= 0; --s) {
        if (s > 0) PLOAD(s - 1);
#pragma unroll
        for (int blk = 1; blk >= 0; --blk) {
            const int kb = kvpos0 + 64 * s + 32 * blk;
            if (kb < qw + 32 && !__all(R == 0.f)) sb_block<VS, true>(o, R, kp + cur * BUF + blk * 32 * KS, vp + cur * BUF + blk * 32 * VS, qf, kp, kb, qw, qpos, hi);
        }
        volatile LAS int* fl = flg + 8 * (s & 1);
        if (lane == 0) fl[wid] = __all(R == 0.f) ? 1 : 0;
        if (s > 0) PSTORE(cur ^ 1);
        __syncthreads();
        if ((fl[0] & fl[1] & fl[2] & fl[3] & fl[4] & fl[5] & fl[6] & fl[7]) != 0) break;
        cur ^= 1;
    }
#undef PLOAD
#undef PSTORE
    float* op = (float*)(ws + WS_OP) + ((size_t)(slot * 8 + wid) * 32) * 128;
#pragma unroll
    for (int db = 0; db < 4; ++db)
#pragma unroll
        for (int r = 0; r < 16; ++r) op[crow(r, hi) * 128 + db * 32 + r32] = o[db][r];
    if (hi == 0) ((float*)(ws + WS_TP))[(slot * 8 + wid) * 32 + r32] = R;
}

__device__ __forceinline__ void mix_rows(const Args& a, int gw, int NGW, int lane) {
    unsigned char* ws = a.ws;
    const float* OP = (const float*)(ws + WS_OP); const float* TP = (const float*)(ws + WS_TP);
    const bf16* U = (const bf16*)(ws + WS_U); const bf16* GB = (const bf16*)(ws + WS_GB); bf16* MIX = (bf16*)(ws + WS_MIX);
    const float* cw = a.in[9]; const float* ga = a.in[10]; const float* gc = a.in[11];
    for (int m = gw; m < MT; m += NGW) {
        const int h = lane >> 3, d0 = (lane & 7) * 16;
        int nparts, slot0, wid, q;
        if (m < NP) { const int b = m >> 12, t = m & 4095, qb = t >> 8; wid = (t & 255) >> 5; q = t & 31; nparts = 1; slot0 = (b * 8 + h) * 16 + qb; }
        else { const int r = m - NP, b = r >> 6, t = r & 63, rg = t >> 5; q = t & 31; wid = (h & 3) * 2 + rg; nparts = 1; slot0 = 256 + b * 2 + (h >> 2); }
        f32x4 acc[4];
#pragma unroll
        for (int i = 0; i < 4; ++i) acc[i] = (f32x4){0.f, 0.f, 0.f, 0.f};
        float Rr = 1.f;
        for (int c = nparts - 1; c >= 0; --c) {
            const size_t base = (size_t)((slot0 + c) * 8 + wid) * 32 + q;
            const f32x4* p = (const f32x4*)(OP + base * 128 + d0);
#pragma unroll
            for (int i = 0; i < 4; ++i) acc[i] += p[i] * Rr;
            Rr *= TP[base];
        }
        float s = 0.f;
#pragma unroll
        for (int i = 0; i < 4; ++i) s += (acc[i][0] * acc[i][0] + acc[i][1] * acc[i][1]) + (acc[i][2] * acc[i][2] + acc[i][3] * acc[i][3]);
        float rs = __builtin_amdgcn_rsqf(wave_sum(s) * (1.0f / AW) + EPS);
        {
            const f32x4* g = (const f32x4*)(ga + h * 128 + d0); u32x4 w0, w1;
            f32x4 v0 = acc[0] * rs * g[0], v1 = acc[1] * rs * g[1], v2 = acc[2] * rs * g[2], v3 = acc[3] * rs * g[3];
            w0.x = pk2(v0[0], v0[1]); w0.y = pk2(v0[2], v0[3]); w0.z = pk2(v1[0], v1[1]); w0.w = pk2(v1[2], v1[3]);
            w1.x = pk2(v2[0], v2[1]); w1.y = pk2(v2[2], v2[3]); w1.z = pk2(v3[0], v3[1]); w1.w = pk2(v3[2], v3[3]);
            u32x4* o = (u32x4*)(MIX + (size_t)m * DM + h * 128 + d0); o[0] = w0; o[1] = w1;
        }
        const int c0 = lane * 16; int t, tb; const float* st = nullptr;
        if (m < NP) { t = m & 4095; tb = m - t; } else { const int r = m - NP; t = r & 63; tb = m - t; st = a.in[4] + (size_t)(r >> 6) * 2 * CC; }
        float u0[16], u1[16], u2[16];
        { const u32x4* p = (const u32x4*)(U + (size_t)m * CC + c0); const u32x4 x0 = p[0], x1 = p[1];
          const unsigned ww[8] = {x0.x, x0.y, x0.z, x0.w, x1.x, x1.y, x1.z, x1.w};
#pragma unroll
          for (int i = 0; i < 8; ++i) { u2[2 * i] = bflo(ww[i]); u2[2 * i + 1] = bfhi(ww[i]); } }
        if (t >= 1) { const u32x4* p = (const u32x4*)(U + (size_t)(m - 1) * CC + c0); const u32x4 x0 = p[0], x1 = p[1];
          const unsigned ww[8] = {x0.x, x0.y, x0.z, x0.w, x1.x, x1.y, x1.z, x1.w};
#pragma unroll
          for (int i = 0; i < 8; ++i) { u1[2 * i] = bflo(ww[i]); u1[2 * i + 1] = bfhi(ww[i]); } }
        else {
#pragma unroll
          for (int i = 0; i < 16; ++i) u1[i] = st ? st[CC + c0 + i] : 0.f; }
        if (t >= 2) { const u32x4* p = (const u32x4*)(U + (size_t)(m - 2) * CC + c0); const u32x4 x0 = p[0], x1 = p[1];
          const unsigned ww[8] = {x0.x, x0.y, x0.z, x0.w, x1.x, x1.y, x1.z, x1.w};
#pragma unroll
          for (int i = 0; i < 8; ++i) { u0[2 * i] = bflo(ww[i]); u0[2 * i + 1] = bfhi(ww[i]); } }
        else {
#pragma unroll
          for (int i = 0; i < 16; ++i) u0[i] = st ? st[(t == 0 ? 0 : CC) + c0 + i] : 0.f; }
        float oc[16]; float s2 = 0.f;
        { const u32x4* p = (const u32x4*)(GB + (size_t)m * CC + c0); const u32x4 x0 = p[0], x1 = p[1];
          const unsigned ww[8] = {x0.x, x0.y, x0.z, x0.w, x1.x, x1.y, x1.z, x1.w};
#pragma unroll
          for (int i = 0; i < 16; ++i) { const float gbv = (i & 1) ? bfhi(ww[i >> 1]) : bflo(ww[i >> 1]);
              oc[i] = gbv * (cw[c0 + i] * u0[i] + cw[CC + c0 + i] * u1[i] + cw[2 * CC + c0 + i] * u2[i]); s2 += oc[i] * oc[i]; } }
        rs = __builtin_amdgcn_rsqf(wave_sum(s2) * (1.0f / CC) + EPS);
        { u32x4 w0, w1; unsigned ww[8];
#pragma unroll
          for (int i = 0; i < 8; ++i) ww[i] = pk2(oc[2 * i] * rs * gc[c0 + 2 * i], oc[2 * i + 1] * rs * gc[c0 + 2 * i + 1]);
          w0.x = ww[0]; w0.y = ww[1]; w0.z = ww[2]; w0.w = ww[3]; w1.x = ww[4]; w1.y = ww[5]; w1.z = ww[6]; w1.w = ww[7];
          u32x4* o = (u32x4*)(MIX + (size_t)m * DM + AW + c0); o[0] = w0; o[1] = w1; }
        (void)tb;
    }
}
#ifndef REP_P0
#define REP_P0 1
#endif
#ifndef REP_P1
#define REP_P1 1
#endif
#ifndef REP_P3
#define REP_P3 1
#endif
#ifndef REP_P4
#define REP_P4 1
#endif
#ifndef REP_P5
#define REP_P5 1
#endif
__global__ void __launch_bounds__(NWAVES * 64, 2) fwd_megakernel(Args args) {
    extern __shared__ __attribute__((aligned(16))) unsigned char lds_raw[];
    cg::grid_group grid = cg::this_grid();
    LAS unsigned char* lds = (LAS unsigned char*)lds_raw;
    const int G = gridDim.x, bx = blockIdx.x, NGW = G * NWAVES;
#define PHASE_IDS() int tid = threadIdx.x; asm volatile("" : "+v"(tid)); const int lane = tid & 63; const int wave = __builtin_amdgcn_readfirstlane(tid >> 6); const int gw = bx * NWAVES + wave; (void)lane; (void)gw
    unsigned char* ws = args.ws;
    unsigned* ctl = (unsigned*)(ws + WS_CTL);
    LAS float* red = (LAS float*)(lds + RED_OFF);
    volatile LAS int* misc = (volatile LAS int*)(lds + MISC_OFF);

    { PHASE_IDS(); if (bx == 0 && tid == 0) { ctl[0] = 0u; ctl[64] = 0u; for (int i = 0; i < 16; ++i) ctl[128 + i] = 0u; }
      if (bx == 0) for (int i = tid; i < XCD_BAR_WORDS; i += NWAVES * 64) ctl[4096 + i] = 0u;
      if (tid < 2) misc[8 + tid] = 0;
#ifndef NO_P0
    for (int rep_ = 0; rep_ < REP_P0; ++rep_) p0_prologue(args, lds, gw, NGW, lane, wave);
#endif
    }
    grid.sync();
    XcdBarrier xbar = xcd_barrier_post(ctl + 4096, (volatile LAS unsigned*)(lds + MISC_OFF) + 8);

#ifndef NO_P1
    for (int rep_ = 0; rep_ < REP_P1; ++rep_) {
        pg8::Gemm g{(const pg8::bf16_t*)(ws + WS_HN), (const pg8::bf16_t*)(ws + WS_WIN), MT, INC, DM}; pg8::StaticOrder S; S.init(MT, INC, DM, G, bx);
        pg8::EpiIn E{(bf16*)(ws + WS_Q), (bf16*)(ws + WS_K), (bf16*)(ws + WS_V), (bf16*)(ws + WS_GB), (bf16*)(ws + WS_U), args.out, args.in[7], args.in[8], red,
                     1.4426950408889634f * 0.08838834764831845f, OFF_KP, OFF_VP, OFF_CP, OFF_KS, OFF_VS, OFF_CS};
        pg8::gemm_phase<pg8::EpiIn, pg8::StaticOrder, true, true>(lds, g, S, E);
    }
#endif
    xcd_barrier(xbar);

#ifndef NO_P2
    {
        const int nitems = g_items.n;
        PHASE_IDS();
#ifdef DUP_P2
        for (int rep = 0; rep < 2; ++rep)
#else
        const int rep = 0;
#endif
        for (;;) {
            if (tid == 0) misc[0] = (int)atomicAdd(ctl + 64 * rep, 1u);
            __syncthreads();
            const int it = misc[0];
            __syncthreads();
            if (it >= nitems) break;
            const int code = g_items.v[it];
#if defined(ONLY_S)
            attn_item<true>(args, lds, code);
#elif defined(ONLY_P)
            attn_item_p(args, lds, code);
#else
            if (code & 1) attn_item<true>(args, lds, code); else attn_item_p(args, lds, code);
#endif
        }
    }
#endif
    xcd_barrier(xbar);

#ifndef NO_P3
    for (int rep_ = 0; rep_ < REP_P3; ++rep_) { PHASE_IDS(); mix_rows(args, gw, NGW, lane); }
#endif
    xcd_barrier(xbar);

#ifndef NO_P4
    for (int rep_ = 0; rep_ < REP_P4; ++rep_) {
        pg8::Gemm g{(const pg8::bf16_t*)(ws + WS_MIX), (const pg8::bf16_t*)(ws + WS_WOUT), MT, DM, DM}; pg8::StaticOrder S; S.init(MT, DM, DM, G, bx);
        pg8::EpiOut E{args.in[0], args.in[1], args.out + OFF_Y, (bf16*)(ws + WS_HN), (float*)(ws + WS_SSQ), red};
        pg8::gemm_phase<pg8::EpiOut, pg8::StaticOrder, true, true>(lds, g, S, E);
    }
#endif
    xcd_barrier(xbar);

#ifndef NO_P5
    for (int rep_ = 0; rep_ < REP_P5; ++rep_) {
        pg8::Gemm g{(const pg8::bf16_t*)(ws + WS_HN), (const pg8::bf16_t*)(ws + WS_WGU), MT, 2 * DFF, DM}; pg8::StaticOrder S; S.init(MT, 2 * DFF, DM, G, bx);
        pg8::EpiGU E{(bf16*)(ws + WS_H), (const float*)(ws + WS_SSQ)};
        pg8::gemm_phase<pg8::EpiGU, pg8::StaticOrder, true, true>(lds, g, S, E);
    }
#endif
    xcd_barrier(xbar);

#ifdef DRY_P6_STATIC
    { pg8::Gemm g{(const pg8::bf16_t*)(ws + WS_H), (const pg8::bf16_t*)(ws + WS_WDN), MT, DM, DFF}; pg8::StaticOrder S; S.init(MT, DM, DFF, G, bx);
      pg8::EpiDown E{(float*)(ws + WS_Q), (float*)(ws + WS_PART), ctl + 128, red}; pg8::gemm_phase<pg8::EpiDown, pg8::StaticOrder, true, true>(lds, g, S, E); }
#endif
#ifdef DRY_P6_SPLIT
    { pg8::Gemm g{(const pg8::bf16_t*)(ws + WS_H), (const pg8::bf16_t*)(ws + WS_WDN), MT, DM, DFF}; pg8::TailSplitOrder S; S.init(MT, DM, DFF, G, bx);
      pg8::EpiNone E{(float*)(ws + WS_SSQ)}; pg8::gemm_phase<pg8::EpiNone, pg8::TailSplitOrder, true, true>(lds, g, S, E); }
#endif
#ifndef NO_P6
    {
        pg8::Gemm g{(const pg8::bf16_t*)(ws + WS_H), (const pg8::bf16_t*)(ws + WS_WDN), MT, DM, DFF};
#ifdef P6_SPLIT
        pg8::TailSplitOrder S; S.init(MT, DM, DFF, G, bx);
        pg8::EpiDown E{args.out + OFF_Y, (float*)(ws + WS_PART), ctl + 128, red};
        pg8::gemm_phase<pg8::EpiDown, pg8::TailSplitOrder, true, true>(lds, g, S, E);
#else
        pg8::StaticOrder S; S.init(MT, DM, DFF, G, bx);
        pg8::EpiDown E{args.out + OFF_Y, (float*)(ws + WS_PART), ctl + 128, red};
        pg8::gemm_phase<pg8::EpiDown, pg8::StaticOrder, true, true>(lds, g, S, E);
#endif
    }
#endif
}

extern "C" void kernel_launch(void* const* d_in, const int* in_sizes, int n_in, void* d_out, int out_size, void* d_ws, size_t ws_size, hipStream_t stream) {
    static int grid = 0;
    if (grid == 0) {
        if (n_in != 17 || (size_t)out_size != OUT_TOTAL || ws_size < WS_END) { fprintf(stderr, "kernel_launch: unexpected shapes (n_in %d out %d ws %zu need %zu)\n", n_in, out_size, ws_size, (size_t)WS_END); grid = -1; return; }
        int dev = 0, cus = 0, per_cu = 0;
        hipGetDevice(&dev); hipDeviceGetAttribute(&cus, hipDeviceAttributeMultiprocessorCount, dev);
        hipFuncSetAttribute((const void*)fwd_megakernel, hipFuncAttributeMaxDynamicSharedMemorySize, LDS_BYTES);
        hipOccupancyMaxActiveBlocksPerMultiprocessor(&per_cu, (const void*)fwd_megakernel, NWAVES * 64, LDS_BYTES);
        if (per_cu < 1) { fprintf(stderr, "kernel_launch: occupancy query says %d blocks per CU\n", per_cu); per_cu = 1; }
        (void)hipGetLastError();
        grid = cus;
    }
    if (grid < 0) return;
    Args a{};
    for (int i = 0; i < 17; ++i) a.in[i] = (const float*)d_in[i];
    a.out = (float*)d_out; a.ws = (unsigned char*)d_ws;
    void* kargs[] = {&a};
    hipError_t e = hipLaunchCooperativeKernel((const void*)fwd_megakernel, dim3(grid), dim3(NWAVES * 64), kargs, LDS_BYTES, stream);
    if (e != hipSuccess) fprintf(stderr, "cooperative launch failed: %s (grid %d)\n", hipGetErrorString(e), grid);
}
```

```cpp
#include <hip/hip_runtime.h>
#include <hip/hip_cooperative_groups.h>
#include <cstdio>
#include <cstdint>
namespace cg = cooperative_groups;
namespace pg8 {
#define PG8_LAS __attribute__((address_space(3)))
typedef unsigned short bf16_t;
typedef short bf16x8 __attribute__((ext_vector_type(8)));
typedef float f32x4 __attribute__((ext_vector_type(4)));
typedef unsigned u32x4 __attribute__((ext_vector_type(4)));
constexpr int BM = 256, BK = 64, HALF = 128, HTB = HALF * BK * 2  , STAGE_BYTES = 8 * HTB, NXCD = 8, WGM = 8;

__host__ __device__ __forceinline__ int lds_byte(int r, int c) { const int st = (r >> 4) * 2 + (c >> 5), rr = r & 15, cc = c & 31, ob = rr * 64 + cc * 2; return st * 1024 + (ob ^ (((ob >> 9) & 1) << 5)); }
__host__ __device__ __forceinline__ void stage_rc(int b, int& R, int& C) { const int st = b / 1024, sb = b % 1024, swz = sb ^ (((sb >> 9) & 1) << 5); R = (st >> 1) * 16 + swz / 64; C = (st & 1) * 32 + (swz % 64) / 2; }
__host__ __device__ __forceinline__ int perm32(int rho) { const int n = rho >> 4, i = rho & 15; return 8 * (i >> 2) + 4 * n + (i & 3); }

struct Unit { int pm, pn, k0, nt, split, tu, sp; };
struct Gemm { const bf16_t* A; const bf16_t* Bt; int M, N, K; };

template <int NM, int NN, int NTK> struct StaticOrderT {
    static constexpr int nM = NM, nN = NN, nwg = NM * NN, ntk = NTK;
    int G, c;
    __host__ __device__ void init(int G_, int c_) { G = G_; c = c_; }
    __host__ __device__ bool next(int i, Unit& u) const { const int L = i * G + c; if (L >= nwg) return false; unit(L, u); return true; }
    __host__ __device__ static void unit(int L, Unit& u) {
        int wgid = L; { constexpr int q = nwg / NXCD, r = nwg % NXCD; const int xcd = wgid % NXCD, off = wgid / NXCD; wgid = (xcd < r ? xcd * (q + 1) : r * (q + 1) + (xcd - r) * q) + off; }
        constexpr int nig = WGM * nN; const int gid = wgid / nig, fm = gid * WGM, gsz = (nM - fm) < WGM ? (nM - fm) : WGM;
        u.pm = fm + ((wgid % nig) % gsz); u.pn = (wgid % nig) / gsz; u.k0 = 0; u.nt = ntk; u.split = 0; u.tu = 0; u.sp = 0;
    }
    __device__ __forceinline__ void a_ready(const Unit&) const {}
    __device__ __forceinline__ void done(const Unit&) const {}
};
template <int NM, int NN, int NTK, int NSPLIT> struct TailOrderT {
    typedef StaticOrderT<NM, NN, NTK> SO;
    int G, c, full, rem;
    __host__ __device__ void init(int G_, int c_) { G = G_; c = c_; full = SO::nwg / G; rem = SO::nwg - full * G; if (rem * NSPLIT > G || NTK < 2 * NSPLIT) { full = 1 << 24; rem = 0; } }
    __host__ __device__ static int kstart(int s) { return s >= NSPLIT ? NTK : ((s * NTK / NSPLIT) & ~1); }
    __host__ __device__ bool next(int i, Unit& u) const {
        if (i < full) { const int L = i * G + c; if (L >= SO::nwg) return false; SO::unit(L, u); return true; }
        if (i > full || c >= rem * NSPLIT) return false;
        const int tu = c / NSPLIT, sp = c % NSPLIT; SO::unit(full * G + tu, u); u.k0 = kstart(sp); u.nt = kstart(sp + 1) - u.k0; u.split = 1; u.tu = tu; u.sp = sp; return true;
    }
    __device__ __forceinline__ void a_ready(const Unit&) const {}
    __device__ __forceinline__ void done(const Unit&) const {}
};

__device__ __forceinline__ unsigned cvt_pk_bf16(float lo, float hi) { unsigned r; asm volatile("v_cvt_pk_bf16_f32 %0, %1, %2" : "=v"(r) : "v"(lo), "v"(hi)); return r; }
typedef float f32x2 __attribute__((ext_vector_type(2)));
#define PG8_LBAR() asm volatile("s_waitcnt lgkmcnt(0)\n\ts_barrier" ::: "memory")
constexpr int NPROMPT = 8192;
__device__ __forceinline__ u32x4 pack8(const f32x4 a, const f32x4 b) { u32x4 w; w.x = cvt_pk_bf16(a[0], a[1]); w.y = cvt_pk_bf16(a[2], a[3]); w.z = cvt_pk_bf16(b[0], b[1]); w.w = cvt_pk_bf16(b[2], b[3]); return w; }


__device__ __forceinline__ void store_partial(float* part, int nsplit, const f32x4 (&acc)[2][2][4][2], const Unit& u, int wr, int wc, int fr, int fq) {
    float* pt = part + (size_t)(u.tu * nsplit + u.sp) * 65536; int rl0 = wr * 64 + fr, cw = wc * 32 + 8 * fq; asm volatile("" : "+v"(rl0), "+v"(cw));
#pragma unroll
    for (int ai = 0; ai < 2; ++ai)
#pragma unroll
        for (int m = 0; m < 4; ++m)
#pragma unroll
            for (int bj = 0; bj < 2; ++bj) { float* o = pt + (ai * HALF + rl0 + m * 16) * 256 + bj * HALF + cw; *(f32x4*)o = acc[ai][bj][m][0]; *(f32x4*)(o + 4) = acc[ai][bj][m][1]; }
}

struct EpiIn {
    static constexpr bool PERM = true, AFTER_DRAIN = false;
    bf16_t *Q, *Kb, *Vb, *GB, *U; float* out; const float *gq, *gk; PG8_LAS float* red; float qscale;
    size_t off_kp, off_vp, off_cp, off_ks, off_vs, off_cs;
    __device__ __forceinline__ void operator()(const f32x4 (&acc)[2][2][4][2], const Unit& u, int wr, int wc, int fr, int fq) const {
        int rl0 = wr * 64 + fr, cw = wc * 32 + 8 * fq; asm volatile("" : "+v"(rl0), "+v"(cw));
        const int pn = u.pn, rowt = u.pm * BM;
        const bool prompt = rowt < NPROMPT;
        if (pn < 8) {
            const bool isq = pn < 4;
#pragma unroll
            for (int ai = 0; ai < 2; ++ai)
#pragma unroll
                for (int m = 0; m < 4; ++m)
#pragma unroll
                    for (int bj = 0; bj < 2; ++bj) {
                        const f32x4 a = acc[ai][bj][m][0], b = acc[ai][bj][m][1];
                        float s = (a[0] * a[0] + a[1] * a[1]) + (a[2] * a[2] + a[3] * a[3]) + (b[0] * b[0] + b[1] * b[1]) + (b[2] * b[2] + b[3] * b[3]);
                        s += __shfl_xor(s, 16); s += __shfl_xor(s, 32);
                        if (fq == 0) red[((ai * HALF + rl0 + m * 16) * 2 + bj) * 4 + wc] = s;
                    }
            PG8_LBAR();
            const float* g = isq ? gq : gk;
            const f32x4 g0 = *(const f32x4*)(g + cw), g1 = *(const f32x4*)(g + cw + 4);
#pragma unroll
            for (int ai = 0; ai < 2; ++ai)
#pragma unroll
                for (int m = 0; m < 4; ++m) {
                    const int rl = ai * HALF + rl0 + m * 16; const size_t row = (size_t)(rowt + rl);
#pragma unroll
                    for (int bj = 0; bj < 2; ++bj) {
                        const f32x4 p = *(const PG8_LAS f32x4*)(red + (rl * 2 + bj) * 4);
                        float rs = __builtin_amdgcn_rsqf(((p[0] + p[1]) + (p[2] + p[3])) * (1.0f / 128.0f) + 1e-6f);
                        if (isq) rs *= qscale;
                        const f32x4 v0 = acc[ai][bj][m][0] * rs * g0, v1 = acc[ai][bj][m][1] * rs * g1;
                        if (isq) { *(u32x4*)(Q + row * 1024 + pn * 256 + bj * HALF + cw) = pack8(v0, v1); }
                        else {
                            const int col = (pn - 4) * 256 + bj * HALF + cw;
                            float* o = prompt ? out + off_kp + row * 1024 + col : out + off_ks + (row - NPROMPT) * 1024 + col;
                            *(f32x4*)o = v0; *(f32x4*)(o + 4) = v1;
                            if (prompt) *(u32x4*)(Kb + row * 1024 + col) = pack8(v0, v1);
                        }
                    }
                }
        } else if (pn < 12) {
#pragma unroll
            for (int ai = 0; ai < 2; ++ai)
#pragma unroll
                for (int m = 0; m < 4; ++m) {
                    const size_t row = (size_t)(rowt + ai * HALF + rl0 + m * 16);
#pragma unroll
                    for (int bj = 0; bj < 2; ++bj) {
                        const int col = (pn - 8) * 256 + bj * HALF + cw; const f32x4 v0 = acc[ai][bj][m][0], v1 = acc[ai][bj][m][1];
                        float* o = prompt ? out + off_vp + row * 1024 + col : out + off_vs + (row - NPROMPT) * 1024 + col;
                        *(f32x4*)o = v0; *(f32x4*)(o + 4) = v1;
                        if (prompt) *(u32x4*)(Vb + row * 1024 + col) = pack8(v0, v1);
                    }
                }
        } else if (pn < 16) {
#pragma unroll
            for (int ai = 0; ai < 2; ++ai)
#pragma unroll
                for (int m = 0; m < 4; ++m) {
                    const size_t row = (size_t)(rowt + ai * HALF + rl0 + m * 16);
#pragma unroll
                    for (int bj = 0; bj < 2; ++bj) *(u32x4*)(GB + row * 1024 + (pn - 12) * 256 + bj * HALF + cw) = pack8(acc[ai][bj][m][0], acc[ai][bj][m][1]);
                }
        } else {
#pragma unroll
            for (int ai = 0; ai < 2; ++ai)
#pragma unroll
                for (int m = 0; m < 4; ++m) {
                    const int rowi = rowt + ai * HALF + rl0 + m * 16; const int ch = (pn - 16) * HALF + cw;
                    const f32x4 v0 = acc[ai][0][m][0] * acc[ai][1][m][0], v1 = acc[ai][0][m][1] * acc[ai][1][m][1];
                    *(u32x4*)(U + (size_t)rowi * 1024 + ch) = pack8(v0, v1);
                    if (prompt) { const int t = rowi & 4095; if (t >= 4094) { float* o = out + off_cp + ((rowi >> 12) * 2 + (t - 4094)) * 1024 + ch; *(f32x4*)o = v0; *(f32x4*)(o + 4) = v1; } }
                    else { const int rs_ = rowi - NPROMPT, t = rs_ & 63; if (t >= 62) { float* o = out + off_cs + ((rs_ >> 6) * 2 + (t - 62)) * 1024 + ch; *(f32x4*)o = v0; *(f32x4*)(o + 4) = v1; } }
                }
        }
    }
};

struct EpiOut {
    static constexpr bool PERM = true, AFTER_DRAIN = false;
    const float *xp, *xs; float* Y; bf16_t* X1; float* ssq; PG8_LAS float* red; float* part;
    __device__ __forceinline__ void operator()(const f32x4 (&acc)[2][2][4][2], const Unit& u, int wr, int wc, int fr, int fq) const {
        if (u.split) { store_partial(part, 8, acc, u, wr, wc, fr, fq); return; }
        int rl0 = wr * 64 + fr, cw = wc * 32 + 8 * fq; asm volatile("" : "+v"(rl0), "+v"(cw));
        const int pn = u.pn, rowt = u.pm * BM;
        const float* xin = rowt < NPROMPT ? xp + (size_t)rowt * 2048 : xs + (size_t)(rowt - NPROMPT) * 2048;
#pragma unroll
        for (int ai = 0; ai < 2; ++ai)
#pragma unroll
            for (int m = 0; m < 4; ++m) {
                const int rl = ai * HALF + rl0 + m * 16; float s = 0.f;
#pragma unroll
                for (int bj = 0; bj < 2; ++bj) {
                    const int col = pn * 256 + bj * HALF + cw; const float* xi = xin + (size_t)rl * 2048 + col;
                    const f32x4 v0 = *(const f32x4*)xi + acc[ai][bj][m][0], v1 = *(const f32x4*)(xi + 4) + acc[ai][bj][m][1];
                    float* o = Y + (size_t)(rowt + rl) * 2048 + col; *(f32x4*)o = v0; *(f32x4*)(o + 4) = v1;
                    *(u32x4*)(X1 + (size_t)(rowt + rl) * 2048 + col) = pack8(v0, v1);
                    s += (v0[0] * v0[0] + v0[1] * v0[1]) + (v0[2] * v0[2] + v0[3] * v0[3]) + (v1[0] * v1[0] + v1[1] * v1[1]) + (v1[2] * v1[2] + v1[3] * v1[3]);
                    asm volatile("" ::: "memory");
                }
                s += __shfl_xor(s, 16); s += __shfl_xor(s, 32);
                if (fq == 0) red[rl * 4 + wc] = s;
                asm volatile("" ::: "memory");
            }
        PG8_LBAR();
        if (threadIdx.x < 256) { const f32x4 p = *(const PG8_LAS f32x4*)(red + threadIdx.x * 4); ssq[(size_t)(rowt + threadIdx.x) * 8 + pn] = (p[0] + p[1]) + (p[2] + p[3]); }
        PG8_LBAR();
    }
};

struct EpiGU {
    static constexpr bool PERM = true, AFTER_DRAIN = false;
    bf16_t* H; const float* ssq;
    __device__ __forceinline__ void operator()(const f32x4 (&acc)[2][2][4][2], const Unit& u, int wr, int wc, int fr, int fq) const {
        int rl0 = wr * 64 + fr, cw = wc * 32 + 8 * fq; asm volatile("" : "+v"(rl0), "+v"(cw));
        const int pn = u.pn, rowt = u.pm * BM;
#pragma unroll
        for (int ai = 0; ai < 2; ++ai)
#pragma unroll
            for (int m = 0; m < 4; ++m) {
                const size_t row = (size_t)(rowt + ai * HALF + rl0 + m * 16);
                const f32x4 p0 = *(const f32x4*)(ssq + row * 8), p1 = *(const f32x4*)(ssq + row * 8 + 4);
                const float rs = __builtin_amdgcn_rsqf((((p0[0] + p0[1]) + (p0[2] + p0[3])) + ((p1[0] + p1[1]) + (p1[2] + p1[3]))) * (1.0f / 2048.0f) + 1e-6f);
                f32x4 h[2];
#pragma unroll
                for (int n = 0; n < 2; ++n) {
                    const f32x4 g = acc[ai][0][m][n] * rs, up = acc[ai][1][m][n] * rs;
#pragma unroll
                    for (int j = 0; j < 4; ++j) h[n][j] = g[j] * __builtin_amdgcn_rcpf(1.0f + __builtin_amdgcn_exp2f(-1.4426950408889634f * g[j])) * up[j];
                }
                *(u32x4*)(H + row * 5632 + pn * HALF + cw) = pack8(h[0], h[1]);
            }
    }
};

struct EpiDown {
    static constexpr bool PERM = true, AFTER_DRAIN = false;
    float* Y; float* part;
    __device__ __forceinline__ void operator()(const f32x4 (&acc)[2][2][4][2], const Unit& u, int wr, int wc, int fr, int fq) const {
        if (u.split) { store_partial(part, 8, acc, u, wr, wc, fr, fq); return; }
        int rl0 = wr * 64 + fr, cw = wc * 32 + 8 * fq; asm volatile("" : "+v"(rl0), "+v"(cw));
        const int pn = u.pn, rowt = u.pm * BM;
#pragma unroll
        for (int ai = 0; ai < 2; ++ai)
#pragma unroll
            for (int m = 0; m < 4; ++m)
#pragma unroll
                for (int bj = 0; bj < 2; ++bj) {
                    float* o = Y + (size_t)(rowt + ai * HALF + rl0 + m * 16) * 2048 + pn * 256 + bj * HALF + cw;
                    const f32x4 v0 = *(const f32x4*)o + acc[ai][bj][m][0], v1 = *(const f32x4*)(o + 4) + acc[ai][bj][m][1];
                    *(f32x4*)o = v0; *(f32x4*)(o + 4) = v1;
                    if (bj) asm volatile("" ::: "memory");
                }
    }
};

struct EpiNone {
    static constexpr bool PERM = true, AFTER_DRAIN = false;
    float* sink;
    __device__ __forceinline__ void operator()(const f32x4 (&acc)[2][2][4][2], const Unit& u, int wr, int wc, int fr, int fq) const {
        if (acc[0][0][0][0][0] == 12345.678f && acc[1][1][3][1][3] == -9876.5f) sink[0] = 1.f;
    }
};
template <class Epi, class Sched, bool ALIGN_EPI = false, bool SP2 = false>
__device__ __forceinline__ void gemm_phase(PG8_LAS unsigned char* lds, const Gemm g, const Sched& S, const Epi& E) {
    int tid_ = threadIdx.x; asm volatile("" : "+v"(tid_));
    const int tid = tid_, wid = __builtin_amdgcn_readfirstlane(tid >> 6), lane = tid & 63, wr = wid >> 2, wc = wid & 3, fr = lane & 15, fq = lane >> 4;
    const int K = g.K;
    unsigned voffA[2], voffB[2];
#pragma unroll
    for (int i = 0; i < 2; ++i) { int R, C; stage_rc(tid * 16 + i * 8192, R, C); const int Rb = Epi::PERM ? ((R & ~31) + perm32(R & 31)) : R;
        voffA[i] = (unsigned)(R * K + C) * 2u; voffB[i] = (unsigned)(Rb * K + C) * 2u; }
    const size_t kstep = (size_t)(BK * 2);
    const size_t hstep = (size_t)HALF * K * 2;
    const size_t tstep = 2 * hstep;
    const unsigned ldsw = (unsigned)wid * 1024u;
    const int aoff = lds_byte(wr * 64 + fr, fq * 8), boff = lds_byte(wc * 32 + fr, fq * 8);
#define PG8_SA(b, h) (((b) * 2 + (h)) * HTB)
#define PG8_SB(b, h) ((4 + (b) * 2 + (h)) * HTB)
#define PG8_STAGE(bufoff, gbase, voff) do { _Pragma("unroll") for (int _i = 0; _i < 2; ++_i) \
        __builtin_amdgcn_global_load_lds((const unsigned*)((const char*)(gbase) + (voff)[_i]), (PG8_LAS unsigned*)(lds + (bufoff) + ldsw + _i * 8192), 16, 0, 0); } while (0)
#define PG8_LDA(dst, b, h) do { _Pragma("unroll") for (int m = 0; m < 4; ++m) _Pragma("unroll") for (int k = 0; k < 2; ++k) dst[m][k] = *(const PG8_LAS bf16x8*)(lds + PG8_SA(b, h) + aoff + m * 2048 + k * 1024); } while (0)
#define PG8_LDB(dst, b, h) do { _Pragma("unroll") for (int n = 0; n < 2; ++n) _Pragma("unroll") for (int k = 0; k < 2; ++k) dst[n][k] = *(const PG8_LAS bf16x8*)(lds + PG8_SB(b, h) + boff + n * 2048 + k * 1024); } while (0)
#define PG8_MMA(ai, bj, At, Bt) do { __builtin_amdgcn_s_setprio(1); _Pragma("unroll") for (int m = 0; m < 4; ++m) _Pragma("unroll") for (int n = 0; n < 2; ++n) _Pragma("unroll") for (int k = 0; k < 2; ++k) \
        acc[ai][bj][m][n] = __builtin_amdgcn_mfma_f32_16x16x32_bf16(Bt[n][k], At[m][k], acc[ai][bj][m][n], 0, 0, 0); __builtin_amdgcn_s_setprio(0); } while (0)
#define PG8_WAIT_V(n) asm volatile("s_waitcnt vmcnt(" #n ")" ::: "memory")
#define PG8_WAIT_L(n) asm volatile("s_waitcnt lgkmcnt(" #n ")" ::: "memory")
#define PG8_BAR __builtin_amdgcn_s_barrier()
#define PG8_SCHED __builtin_amdgcn_sched_barrier(0)
    Unit cur, nxt; int ui = 0;
    if (!S.next(0, cur)) return;
    f32x4 acc[2][2][4][2];
#pragma unroll
    for (int a = 0; a < 2; ++a)
#pragma unroll
        for (int b = 0; b < 2; ++b)
#pragma unroll
            for (int m = 0; m < 4; ++m)
#pragma unroll
                for (int n = 0; n < 2; ++n) acc[a][b][m][n] = (f32x4){0.f, 0.f, 0.f, 0.f};
    bf16x8 At[4][2], B0[2][2], B1[2][2];
    const char* cA = (const char*)g.A + (size_t)cur.pm * tstep + (size_t)cur.k0 * kstep; const char* cB = (const char*)g.Bt + (size_t)cur.pn * tstep + (size_t)cur.k0 * kstep;
    S.a_ready(cur);
    if constexpr (SP2) {
        PG8_STAGE(PG8_SB(0, 0), cB, voffB); PG8_STAGE(PG8_SB(0, 1), cB + hstep, voffB); PG8_STAGE(PG8_SA(0, 0), cA, voffA); PG8_STAGE(PG8_SA(0, 1), cA + hstep, voffA);
        if (wr == 1) PG8_BAR;
        PG8_WAIT_V(2); PG8_BAR;
        PG8_STAGE(PG8_SB(1, 0), cB + kstep, voffB); PG8_STAGE(PG8_SA(1, 0), cA + kstep, voffA); PG8_STAGE(PG8_SB(1, 1), cB + hstep + kstep, voffB);
        PG8_WAIT_V(6); PG8_BAR;
    } else {
        PG8_STAGE(PG8_SB(0, 0), cB, voffB); PG8_STAGE(PG8_SA(0, 0), cA, voffA); PG8_STAGE(PG8_SB(0, 1), cB + hstep, voffB); PG8_STAGE(PG8_SA(0, 1), cA + hstep, voffA);
        if (wr == 1) PG8_BAR;
        PG8_WAIT_V(4); PG8_BAR;
        PG8_STAGE(PG8_SB(1, 0), cB + kstep, voffB); PG8_STAGE(PG8_SA(1, 0), cA + kstep, voffA); PG8_STAGE(PG8_SB(1, 1), cB + hstep + kstep, voffB);
        PG8_WAIT_V(6); PG8_BAR;
    }
    for (;;) {
        const bool has_next = S.next(ui + 1, nxt);
        const char* nA = has_next ? (const char*)g.A + (size_t)nxt.pm * tstep + (size_t)nxt.k0 * kstep : cA; const char* nB = has_next ? (const char*)g.Bt + (size_t)nxt.pn * tstep + (size_t)nxt.k0 * kstep : cB;
        const int nt = cur.nt;
        for (int t = 0; t < nt; t += 2) {
            const bool last = (t == nt - 2);
            const char* a1 = cA + (size_t)(t + 1) * kstep;
            const char* a2 = last ? nA : cA + (size_t)(t + 2) * kstep; const char* b2 = last ? nB : cB + (size_t)(t + 2) * kstep;
            const char* a3 = a2 + kstep; const char* b3 = b2 + kstep;
            if (last && has_next) S.a_ready(nxt);
            if constexpr (SP2) {
            PG8_LDB(B0, 0, 0); PG8_LDB(B1, 0, 1); PG8_SCHED; PG8_LDA(At, 0, 0); PG8_STAGE(PG8_SA(1, 1), a1 + hstep, voffA);
            PG8_WAIT_V(8); PG8_WAIT_L(0); PG8_BAR; PG8_MMA(0, 0, At, B0); PG8_MMA(0, 1, At, B1); PG8_BAR; PG8_SCHED;
            PG8_LDA(At, 0, 1); PG8_STAGE(PG8_SB(0, 0), b2, voffB); PG8_STAGE(PG8_SB(0, 1), b2 + hstep, voffB); PG8_STAGE(PG8_SA(0, 0), a2, voffA);
            PG8_WAIT_V(8); PG8_WAIT_L(0); PG8_BAR; PG8_MMA(1, 0, At, B0); PG8_MMA(1, 1, At, B1); PG8_BAR; PG8_SCHED;
            PG8_LDB(B0, 1, 0); PG8_LDB(B1, 1, 1); PG8_SCHED; PG8_LDA(At, 1, 0); PG8_STAGE(PG8_SA(0, 1), a2 + hstep, voffA);
            PG8_WAIT_V(8); PG8_WAIT_L(0); PG8_BAR; PG8_MMA(0, 0, At, B0); PG8_MMA(0, 1, At, B1); PG8_BAR; PG8_SCHED;
            PG8_LDA(At, 1, 1); PG8_STAGE(PG8_SB(1, 0), b3, voffB); PG8_STAGE(PG8_SB(1, 1), b3 + hstep, voffB); PG8_STAGE(PG8_SA(1, 0), a3, voffA);
            PG8_WAIT_V(8); PG8_WAIT_L(0); PG8_BAR; PG8_MMA(1, 0, At, B0); PG8_MMA(1, 1, At, B1); PG8_BAR; PG8_SCHED;
            } else {
            PG8_LDB(B0, 0, 0); PG8_SCHED; PG8_LDA(At, 0, 0); PG8_STAGE(PG8_SA(1, 1), a1 + hstep, voffA);
            PG8_WAIT_L(8); PG8_BAR; PG8_WAIT_L(0); PG8_MMA(0, 0, At, B0); PG8_BAR; PG8_SCHED;
            PG8_LDB(B1, 0, 1); PG8_STAGE(PG8_SB(0, 0), b2, voffB);
            PG8_BAR; PG8_WAIT_L(0); PG8_MMA(0, 1, At, B1); PG8_BAR;
            PG8_LDA(At, 0, 1); PG8_STAGE(PG8_SA(0, 0), a2, voffA);
            PG8_BAR; PG8_WAIT_L(0); PG8_MMA(1, 0, At, B0); PG8_BAR; PG8_SCHED;
            PG8_STAGE(PG8_SB(0, 1), b2 + hstep, voffB);
            PG8_WAIT_V(6); PG8_BAR; PG8_MMA(1, 1, At, B1); PG8_BAR;
            PG8_LDB(B0, 1, 0); PG8_SCHED; PG8_LDA(At, 1, 0); PG8_STAGE(PG8_SA(0, 1), a2 + hstep, voffA);
            PG8_WAIT_L(8); PG8_BAR; PG8_WAIT_L(0); PG8_MMA(0, 0, At, B0); PG8_BAR; PG8_SCHED;
            PG8_LDB(B1, 1, 1); PG8_STAGE(PG8_SB(1, 0), b3, voffB);
            PG8_BAR; PG8_WAIT_L(0); PG8_MMA(0, 1, At, B1); PG8_BAR;
            PG8_LDA(At, 1, 1); PG8_STAGE(PG8_SA(1, 0), a3, voffA);
            PG8_BAR; PG8_WAIT_L(0); PG8_MMA(1, 0, At, B0); PG8_BAR; PG8_SCHED;
            PG8_STAGE(PG8_SB(1, 1), b3 + hstep, voffB);
            PG8_WAIT_V(6); PG8_BAR; PG8_MMA(1, 1, At, B1); PG8_BAR;
            }
        }
        if constexpr (ALIGN_EPI) { if (wr == 0) PG8_BAR; }
        if constexpr (!Epi::AFTER_DRAIN) { E(acc, cur, wr, wc, fr, fq); S.done(cur); }
        if (!has_next) break;
#pragma unroll
        for (int a = 0; a < 2; ++a)
#pragma unroll
            for (int b = 0; b < 2; ++b)
#pragma unroll
                for (int m = 0; m < 4; ++m)
#pragma unroll
                    for (int n = 0; n < 2; ++n) acc[a][b][m][n] = (f32x4){0.f, 0.f, 0.f, 0.f};
        cur = nxt; cA = nA; cB = nB; ++ui;
        if constexpr (ALIGN_EPI) { if (wr == 1) PG8_BAR; }
    }
    PG8_WAIT_V(0);
    if constexpr (!ALIGN_EPI) { if (wr == 0) PG8_BAR; }
    PG8_BAR;
    if constexpr (Epi::AFTER_DRAIN) { E.fused(acc, cur, wr, wc, fr, fq, lds, wid, lane); S.done(cur); }
#undef PG8_SA
#undef PG8_SB
#undef PG8_STAGE
#undef PG8_LDA
#undef PG8_LDB
#undef PG8_MMA
#undef PG8_WAIT_V
#undef PG8_WAIT_L
#undef PG8_BAR
#undef PG8_SCHED
}
}
#define LAS __attribute__((address_space(3)))
typedef unsigned short bf16;
typedef float f32x4 __attribute__((ext_vector_type(4)));
typedef float f32x16 __attribute__((ext_vector_type(16)));
typedef short bf16x8 __attribute__((ext_vector_type(8)));
typedef short s16x4 __attribute__((ext_vector_type(4)));
typedef unsigned u32x4 __attribute__((ext_vector_type(4)));
typedef unsigned u32x2 __attribute__((ext_vector_type(2)));
constexpr int DM = 2048, SEQ = 4096, NP = 8192, NS = 512, MT = NP + NS, AW = 1024, CC = 1024, INC = 6144, DFF = 5632, PAST = 4096, DSEQ = 64;
constexpr float EPS = 1e-6f;
constexpr size_t OFF_Y = 0, OFF_KP = (size_t)MT * DM, OFF_VP = OFF_KP + (size_t)NP * AW, OFF_CP = OFF_VP + (size_t)NP * AW, OFF_KS = OFF_CP + 2 * 2 * CC,
                 OFF_VS = OFF_KS + (size_t)NS * AW, OFF_CS = OFF_VS + (size_t)NS * AW, OUT_TOTAL = OFF_CS + 8 * 2 * CC;
static_assert(OUT_TOTAL == 35672064, "output size");
constexpr size_t MiB = 1u << 20;
constexpr size_t WS_CTL = 0, WS_WIN = 1 * MiB, WS_WOUT = 25 * MiB, WS_WGU = 33 * MiB, WS_WDN = 77 * MiB, WS_HN = 99 * MiB, WS_Q = 133 * MiB, WS_K = 150 * MiB, WS_V = 166 * MiB,
                 WS_GB = 182 * MiB, WS_U = 199 * MiB, WS_MIX = 216 * MiB, WS_SSQ = 250 * MiB, WS_TP = 251 * MiB, WS_OP = 256 * MiB, WS_H = 256 * MiB, WS_PART = 133 * MiB  ;
constexpr int NSLOT = 256 + 16;
constexpr size_t WS_END = WS_OP + (size_t)NSLOT * 131072;
constexpr int RING_BYTES = 131072, RED_OFF = RING_BYTES, MISC_OFF = RED_OFF + 8192, LDS_BYTES = 147456;
constexpr int NWAVES = 8;

#define XB_TMO      128
#define XB_XCNT(j)  (256  + 64 * (j))
#define XB_XSUB(j)  (1280 + 64 * (j))
#define XB_XGEN(j)  (2304 + 64 * (j))
#define XB_TOP      3328
#define XB_TOPGEN   3392
#define XCD_BAR_WORDS 3456
#define XB_SPIN_CAP (1u << 18)

__device__ __forceinline__ unsigned xb_ld(unsigned* p)              { return __hip_atomic_load(p, __ATOMIC_RELAXED, __HIP_MEMORY_SCOPE_AGENT); }
__device__ __forceinline__ unsigned xb_add(unsigned* p, unsigned v) { return __hip_atomic_fetch_add(p, v, __ATOMIC_RELAXED, __HIP_MEMORY_SCOPE_AGENT); }
__device__ __forceinline__ unsigned xb_xcc_id() { return (unsigned)__builtin_amdgcn_s_getreg((3 << 11) | 20) & 0xFu; }
#define XB_SPIN(cond, bar) do { unsigned _sp = 0; while (cond) { __builtin_amdgcn_s_sleep(1); \
    if ((++_sp & 255u) == 0u) { if (xb_ld(&(bar)[XB_TMO])) break; if (_sp > XB_SPIN_CAP) { atomicAdd(&(bar)[XB_TMO], 1u); break; } } } } while (0)

struct XcdBarrier {
    unsigned* bar; unsigned x;
    volatile LAS unsigned* st;
};

__device__ __forceinline__ XcdBarrier xcd_barrier_post(unsigned* bar, volatile LAS unsigned* st) {
    XcdBarrier b; b.bar = bar; b.x = xb_xcc_id(); b.st = st;
    if (threadIdx.x == 0) (void)xb_add(&bar[XB_XCNT(b.x)], 1u);
    return b;
}
__device__ __forceinline__ void xcd_barrier_complete(unsigned* bar, unsigned x, unsigned& nloc, unsigned& nx) {
    const unsigned G = gridDim.x * gridDim.y * gridDim.z;
    unsigned sum, cnt, mine, sp = 0u;
    for (;;) {
        sum = 0u; cnt = 0u; mine = 0u;
#pragma unroll
        for (unsigned j = 0; j < 16; ++j) { const unsigned c = xb_ld(&bar[XB_XCNT(j)]); sum += c; cnt += (c > 0u) ? 1u : 0u; mine = (j == x) ? c : mine; }
        if (sum == G) break;
        __builtin_amdgcn_s_sleep(1);
        if ((++sp & 255u) == 0u) { if (xb_ld(&bar[XB_TMO])) break; if (sp > XB_SPIN_CAP) { atomicAdd(&bar[XB_TMO], 1u); break; } }
    }
    nloc = mine > 0u ? mine : 1u; nx = cnt > 0u ? cnt : 1u;
}

__device__ __forceinline__ void xcd_barrier(const XcdBarrier& b) {
    asm volatile("s_waitcnt vmcnt(0)" ::: "memory");
    __syncthreads();
    if (threadIdx.x == 0) {
        unsigned* bar = b.bar;
        __builtin_amdgcn_s_waitcnt(0);
        unsigned nloc = b.st[0], nx = b.st[1];
        if (nloc == 0u) { xcd_barrier_complete(bar, b.x, nloc, nx); b.st[0] = nloc; b.st[1] = nx; }
        const unsigned old = xb_add(&bar[XB_XSUB(b.x)], 1u);
        const unsigned gen = old / nloc;
        if (old + 1u == (gen + 1u) * nloc) {
            __builtin_amdgcn_fence(__ATOMIC_RELEASE, "agent");
            asm volatile("s_waitcnt vmcnt(0)" ::: "memory");
            const unsigned og = xb_add(&bar[XB_TOP], 1u);
            const unsigned tg = og / nx;
            if (og + 1u == (tg + 1u) * nx) xb_add(&bar[XB_TOPGEN], 1u);
            else XB_SPIN(xb_ld(&bar[XB_TOPGEN]) == tg, bar);
            __builtin_amdgcn_fence(__ATOMIC_ACQUIRE, "agent");
            xb_add(&bar[XB_XGEN(b.x)], 1u);
            asm volatile("s_waitcnt vmcnt(0)" ::: "memory");
        } else {
            XB_SPIN(xb_ld(&bar[XB_XGEN(b.x)]) == gen, bar);
            __builtin_amdgcn_fence(__ATOMIC_ACQUIRE, "agent");
            asm volatile("s_waitcnt vmcnt(0)" ::: "memory");
        }
    }
    __syncthreads();
}

struct ItemTab { int n; int v[272]; };
constexpr int p_nsteps(int qb, int c) { return 8 * (qb + 1); }
constexpr ItemTab make_items() {
    ItemTab t{}; t.n = 0;
    for (int b = 0; b < 8; ++b) for (int hg = 0; hg < 2; ++hg) t.v[t.n++] = 1 | (b << 1) | (hg << 4);
    for (int qb = 15; qb >= 0; --qb) for (int bh = 0; bh < 16; ++bh) t.v[t.n++] = (bh << 1) | (qb << 5);
    return t;
}
__device__ const ItemTab g_items = make_items();

__device__ __forceinline__ unsigned f2bf(float f) { unsigned u = __builtin_bit_cast(unsigned, f); return (u + 0x7fffu + ((u >> 16) & 1u)) >> 16; }
__device__ __forceinline__ unsigned pk2(float lo, float hi) { return pg8::cvt_pk_bf16(lo, hi); }
__device__ __forceinline__ float bflo(unsigned w) { return __builtin_bit_cast(float, w << 16); }
__device__ __forceinline__ float bfhi(unsigned w) { return __builtin_bit_cast(float, w & 0xffff0000u); }
__device__ __forceinline__ int crow(int r, int hi) { return (r & 3) + 8 * (r >> 2) + 4 * hi; }
__device__ __forceinline__ float wave_sum(float v) {
#pragma unroll
    for (int o = 1; o < 64; o <<= 1) v += __shfl_xor(v, o);
    return v;
}

struct Args { const float* in[17]; float* out; unsigned char* ws; };

struct P0Item { const float* src; const float* gk; bf16* dst; int N, K, k0; };
__device__ __forceinline__ P0Item p0_decode(const Args& a, int it) {
    constexpr int I_IN = 32 * 192, I_OUT = 32 * 64, I_G = 32 * 176;
    unsigned char* ws = a.ws; P0Item r; int n0, kb, drow; r.gk = nullptr;
    if (it < I_IN) { kb = it / 192; n0 = 32 * (it % 192); drow = n0;
        if (n0 >= 5120) { const int ch = n0 - 5120; drow = 4096 + (ch >> 7) * 256 + 128 + (ch & 127); } else if (n0 >= 4096) { const int ch = n0 - 4096; drow = 4096 + (ch >> 7) * 256 + (ch & 127); }
        r.src = a.in[6]; r.N = INC; r.K = DM; r.dst = (bf16*)(ws + WS_WIN); }
    else if ((it -= I_IN) < I_OUT) { kb = it / 64; n0 = 32 * (it % 64); drow = n0; r.src = a.in[12]; r.N = DM; r.K = DM; r.dst = (bf16*)(ws + WS_WOUT); }
    else if ((it -= I_OUT) < 2 * I_G) { const int up = it >= I_G; if (up) it -= I_G; kb = it / 176; n0 = 32 * (it % 176); drow = (n0 >> 7) * 256 + up * 128 + (n0 & 127);
        r.src = a.in[up ? 15 : 14]; r.N = DFF; r.K = DM; r.dst = (bf16*)(ws + WS_WGU); r.gk = a.in[13]; }
    else { it -= 2 * I_G; kb = it / 64; n0 = 32 * (it % 64); drow = n0; r.src = a.in[16]; r.N = DM; r.K = DFF; r.dst = (bf16*)(ws + WS_WDN); }
    r.k0 = 64 * kb; r.src += (size_t)r.k0 * r.N + n0; r.dst += (size_t)drow * r.K + r.k0;
    return r;
}
__device__ __forceinline__ void p0_load(const P0Item& p, f32x4 (&v)[8], int lane) {
#pragma unroll
    for (int j = 0; j < 8; ++j) v[j] = __builtin_nontemporal_load((const f32x4*)(p.src + (size_t)(8 * j + (lane >> 3)) * p.N + 4 * (lane & 7)));
}
__device__ __forceinline__ void p0_finish(const P0Item& p, const f32x4 (&v)[8], LAS float* scr, int lane) {
#pragma unroll
    for (int j = 0; j < 8; ++j) { const int kk = 8 * j + (lane >> 3); const float g = p.gk ? p.gk[p.k0 + kk] : 1.0f; LAS float* s = scr + kk * 33 + 4 * (lane & 7);
        s[0] = v[j][0] * g; s[1] = v[j][1] * g; s[2] = v[j][2] * g; s[3] = v[j][3] * g; }
    asm volatile("s_waitcnt lgkmcnt(0)" ::: "memory");
    const int c = lane & 7;
#pragma unroll
    for (int j = 0; j < 4; ++j) { const int n = (lane >> 3) + 8 * j; const LAS float* s = scr + (8 * c) * 33 + n;
        u32x4 o; o.x = pk2(s[0 * 33], s[1 * 33]); o.y = pk2(s[2 * 33], s[3 * 33]); o.z = pk2(s[4 * 33], s[5 * 33]); o.w = pk2(s[6 * 33], s[7 * 33]);
        *(u32x4*)(p.dst + (size_t)n * p.K + 8 * c) = o; }
    asm volatile("s_waitcnt lgkmcnt(0)" ::: "memory");
}
__device__ __forceinline__ void p0_prologue(const Args& a, LAS unsigned char* lds, int gw, int NGW, int lane, int wave) {
    LAS float* scr = (LAS float*)(lds + wave * 16384);
    unsigned char* ws = a.ws;
    constexpr int NITEMS = 32 * 192 + 32 * 64 + 2 * 32 * 176 + 88 * 64;
    {
        int it = gw; f32x4 va[8], vb[8]; P0Item pa, pb;
        if (it < NITEMS) { pa = p0_decode(a, it); p0_load(pa, va, lane); }
        while (it < NITEMS) {
            const int itb = it + NGW;
            if (itb < NITEMS) { pb = p0_decode(a, itb); p0_load(pb, vb, lane); }
            p0_finish(pa, va, scr, lane);
            it = itb + NGW;
            if (itb >= NITEMS) break;
            if (it < NITEMS) { pa = p0_decode(a, it); p0_load(pa, va, lane); }
            p0_finish(pb, vb, scr, lane);
        }
    }
    const float* g1 = a.in[5];
    for (int m = gw; m < MT; m += NGW) {
        const float* xrow = m < NP ? a.in[0] + (size_t)m * DM : a.in[1] + (size_t)(m - NP) * DM;
        const f32x4* xr = (const f32x4*)xrow + lane; f32x4 v[8]; float s = 0.f;
#pragma unroll
        for (int j = 0; j < 8; ++j) { v[j] = xr[64 * j]; s += (v[j][0] * v[j][0] + v[j][1] * v[j][1]) + (v[j][2] * v[j][2] + v[j][3] * v[j][3]); }
        const float rs = __builtin_amdgcn_rsqf(wave_sum(s) * (1.0f / DM) + EPS);
        u32x2* o = (u32x2*)((bf16*)(ws + WS_HN) + (size_t)m * DM) + lane;
#pragma unroll
        for (int j = 0; j < 8; ++j) { const f32x4 g = *((const f32x4*)g1 + 64 * j + lane); u32x2 w; w.x = pk2(v[j][0] * rs * g[0], v[j][1] * rs * g[1]); w.y = pk2(v[j][2] * rs * g[2], v[j][3] * rs * g[3]); o[64 * j] = w; }
    }
}


template <int VS, bool QREG>
__device__ __forceinline__ void sb_block(f32x16 (&o)[4], float& R, const LAS unsigned char* kp, const LAS unsigned char* vp, const bf16x8 (&qreg)[8], const LAS unsigned char* qlp, int kb, int qw, int qpos, int hi) {
            f32x16 p;
#pragma unroll
            for (int r = 0; r < 16; ++r) p[r] = 0.f;
#pragma unroll
            for (int d0 = 0; d0 < 8; ++d0) { const bf16x8 kf = *(const LAS bf16x8*)(kp + d0 * 32); const bf16x8 qf = QREG ? qreg[d0] : *(const LAS bf16x8*)(qlp + d0 * 32); p = __builtin_amdgcn_mfma_f32_32x32x16_bf16(kf, qf, p, 0, 0, 0); }
            const bool need_mask = (kb + 31 >= qw);
            float e[16], sf[16];
#pragma unroll
            for (int r = 0; r < 16; ++r) {
                const float z = fminf(p[r], 100.f); float ee = __builtin_amdgcn_exp2f(z); float rr = __builtin_amdgcn_rcpf(1.0f + ee);
                if (need_mask) { const bool msk = (kb + crow(r, hi)) >= qpos; ee = msk ? 0.f : ee; rr = msk ? 1.f : rr; }
                e[r] = ee; sf[r] = rr;
            }
            float oth[4], PP[4];
#pragma unroll
            for (int g = 0; g < 4; ++g) { sf[4 * g + 2] *= sf[4 * g + 3]; sf[4 * g + 1] *= sf[4 * g + 2]; sf[4 * g] *= sf[4 * g + 1]; oth[g] = __shfl_xor(sf[4 * g], 32); PP[g] = sf[4 * g] * oth[g]; }
            const float SP3 = PP[3], SP2 = PP[2] * SP3, SP1 = PP[1] * SP2, SP0 = PP[0] * SP1;
            float A[4]; A[0] = R * SP1; A[1] = R * SP2; A[2] = R * SP3; A[3] = R;
#pragma unroll
            for (int g = 0; g < 4; ++g) A[g] = hi ? A[g] : A[g] * oth[g];
            R *= SP0;
            float w[16];
#pragma unroll
            for (int r = 0; r < 16; ++r) w[r] = (e[r] * sf[r]) * A[r >> 2];
#pragma unroll
            for (int s2 = 0; s2 < 2; ++s2) {
                u32x4 pw; pw.x = pk2(w[8 * s2 + 0], w[8 * s2 + 1]); pw.y = pk2(w[8 * s2 + 2], w[8 * s2 + 3]); pw.z = pk2(w[8 * s2 + 4], w[8 * s2 + 5]); pw.w = pk2(w[8 * s2 + 6], w[8 * s2 + 7]);
                const bf16x8 pa = __builtin_bit_cast(bf16x8, pw);
#pragma unroll
                for (int db = 0; db < 4; ++db) {
                    const s16x4 lo = __builtin_bit_cast(s16x4, __builtin_amdgcn_ds_read_tr16_b64_v4i16((LAS s16x4*)(vp + (16 * s2) * VS + db * 64)));
                    const s16x4 hh = __builtin_bit_cast(s16x4, __builtin_amdgcn_ds_read_tr16_b64_v4i16((LAS s16x4*)(vp + (16 * s2 + 8) * VS + db * 64)));
                    const bf16x8 vb = __builtin_shufflevector(lo, hh, 0, 1, 2, 3, 4, 5, 6, 7);
                    o[db] = __builtin_amdgcn_mfma_f32_32x32x16_bf16(pa, vb, o[db], 0, 0, 0);
                }
            }
}

template <bool SAMPLE>
__device__ __forceinline__ void attn_item(const Args& a, LAS unsigned char* lds, int code) {
    constexpr int NH = SAMPLE ? 4 : 1, KS = NH * 256 + 16, VS = NH * 256 + 32, K_OFF = 0, V_OFF = 32 * KS;
    int tid_ = threadIdx.x; asm volatile("" : "+v"(tid_));
    const int tid = tid_, lane = tid & 63, r32 = lane & 31, hi = lane >> 5; const int wid = __builtin_amdgcn_readfirstlane(tid >> 6);
    unsigned char* ws = a.ws;
    int slot, nsteps, kvpos0, qw, head, hl; size_t qrow;
    const bf16 *kgb = nullptr, *vgb = nullptr; const float *kgf = nullptr, *vgf = nullptr, *kgn = nullptr, *vgn = nullptr;
    if (SAMPLE) {
        const int b = (code >> 1) & 7, hg = (code >> 4) & 1;
        slot = 256 + b * 2 + hg; hl = wid >> 1; head = hg * 4 + hl; const int rg = wid & 1;
        qw = PAST + 32 * rg; qrow = (size_t)NP + b * DSEQ + 32 * rg + r32;
        nsteps = 130; kvpos0 = 0;
        kgf = a.in[2] + ((size_t)b * PAST + (tid >> 7)) * AW + hg * 512 + 4 * (tid & 127); vgf = a.in[3] + ((size_t)b * PAST + (tid >> 7)) * AW + hg * 512 + 4 * (tid & 127);
        kgn = a.out + OFF_KS + ((size_t)b * DSEQ + (tid >> 7)) * AW + hg * 512 + 4 * (tid & 127); vgn = a.out + OFF_VS + ((size_t)b * DSEQ + (tid >> 7)) * AW + hg * 512 + 4 * (tid & 127);
    } else {
        const int bh = (code >> 1) & 15, qb = (code >> 5) & 15, c = (code >> 9) & 3, b = bh >> 3;
        head = bh & 7; hl = 0; slot = bh * 16 + qb + 0 * c; nsteps = p_nsteps(qb, c); kvpos0 = 0;
        qw = qb * 256 + 32 * wid; qrow = (size_t)b * SEQ + qw + r32;
        kgb = (const bf16*)(ws + WS_K) + ((size_t)b * SEQ + kvpos0 + (tid >> 4)) * AW + head * 128 + (tid & 15) * 8;
        vgb = (const bf16*)(ws + WS_V) + ((size_t)b * SEQ + kvpos0 + (tid >> 4)) * AW + head * 128 + (tid & 15) * 8;
    }
    const int qpos = qw + r32;
    constexpr int Q_OFF = 67584, QS = 272;
    const LAS unsigned char* qlp = lds + Q_OFF + wid * (32 * QS) + r32 * QS + hi * 16;
    { const bf16* qp = (const bf16*)(ws + WS_Q) + qrow * AW + head * 128 + hi * 8;
#pragma unroll
      for (int d0 = 0; d0 < 8; ++d0) *(LAS bf16x8*)(lds + Q_OFF + wid * (32 * QS) + r32 * QS + hi * 16 + d0 * 32) = *(const bf16x8*)(qp + 16 * d0); }
    f32x16 o[4];
#pragma unroll
    for (int i = 0; i < 4; ++i)
#pragma unroll
        for (int r = 0; r < 16; ++r) o[i][r] = 0.f;
    float R = 1.f;
    u32x4 kreg, vreg; f32x4 kf4[8], vf4[8];
#define ATT_LOADK(s_) do { if (SAMPLE) { _Pragma("unroll") for (int i_ = 0; i_ < 8; ++i_) kf4[i_] = *(const f32x4*)(((s_) >= 128 ? kgn + (size_t)((s_) - 128) * 32 * AW : kgf + (size_t)(s_) * 32 * AW) + (size_t)i_ * 4 * AW); } \
        else { kreg = *(const u32x4*)(kgb + (size_t)(s_) * 32 * AW); } } while (0)
#define ATT_LOADV(s_) do { if (SAMPLE) { _Pragma("unroll") for (int i_ = 0; i_ < 8; ++i_) vf4[i_] = *(const f32x4*)(((s_) >= 128 ? vgn + (size_t)((s_) - 128) * 32 * AW : vgf + (size_t)(s_) * 32 * AW) + (size_t)i_ * 4 * AW); } \
        else { vreg = *(const u32x4*)(vgb + (size_t)(s_) * 32 * AW); } } while (0)
#define ATT_STOREK() do { if (SAMPLE) { _Pragma("unroll") for (int i_ = 0; i_ < 8; ++i_) { const int key_ = (tid >> 7) + 4 * i_, f4_ = tid & 127; \
            u32x2 kw_; kw_.x = pk2(kf4[i_][0], kf4[i_][1]); kw_.y = pk2(kf4[i_][2], kf4[i_][3]); *(LAS u32x2*)(lds + K_OFF + key_ * KS + f4_ * 8) = kw_; } } \
        else { *(LAS u32x4*)(lds + K_OFF + (tid >> 4) * KS + (tid & 15) * 16) = kreg; } } while (0)
#define ATT_STOREV() do { if (SAMPLE) { _Pragma("unroll") for (int i_ = 0; i_ < 8; ++i_) { const int key_ = (tid >> 7) + 4 * i_, f4_ = tid & 127; \
            u32x2 vw_; vw_.x = pk2(vf4[i_][0], vf4[i_][1]); vw_.y = pk2(vf4[i_][2], vf4[i_][3]); *(LAS u32x2*)(lds + V_OFF + key_ * VS + f4_ * 8) = vw_; } } \
        else { *(LAS u32x4*)(lds + V_OFF + (tid >> 4) * VS + (tid & 15) * 16) = vreg; } } while (0)
    volatile LAS int* flg = (volatile LAS int*)(lds + MISC_OFF + 64);
    ATT_LOADK(nsteps - 1); ATT_LOADV(nsteps - 1);
    ATT_STOREK(); ATT_STOREV();
    __syncthreads();
    const LAS unsigned char* kp = lds + K_OFF + r32 * KS + hl * 256 + hi * 16;
    const LAS unsigned char* vp = lds + V_OFF + (4 * hi + ((lane & 15) >> 2)) * VS + hl * 256 + (16 * ((lane >> 4) & 1) + 4 * (lane & 3)) * 2;
    for (int s = nsteps - 1; s >= 0; --s) {
        if (s > 0) { ATT_LOADK(s - 1); if (!SAMPLE) ATT_LOADV(s - 1); }
        const int kb = kvpos0 + 32 * s;
        if (kb < qw + 32 && !__all(R == 0.f)) { const bf16x8 qdummy[8] = {}; sb_block<VS, false>(o, R, kp, vp, qdummy, qlp, kb, qw, qpos, hi); }
        if (lane == 0) flg[wid] = __all(R == 0.f) ? 1 : 0;
        __syncthreads();
        const bool alldone = (flg[0] & flg[1] & flg[2] & flg[3] & flg[4] & flg[5] & flg[6] & flg[7]) != 0;
        if (alldone) { __syncthreads(); break; }
        if (s > 0) { ATT_STOREK(); if (SAMPLE) ATT_LOADV(s - 1); ATT_STOREV(); }
        __syncthreads();
    }
#undef ATT_LOADK
#undef ATT_LOADV
#undef ATT_STOREK
#undef ATT_STOREV
    float* op = (float*)(ws + WS_OP) + ((size_t)(slot * 8 + wid) * 32) * 128;
#pragma unroll
    for (int db = 0; db < 4; ++db)
#pragma unroll
        for (int r = 0; r < 16; ++r) op[crow(r, hi) * 128 + db * 32 + r32] = o[db][r];
    if (hi == 0) ((float*)(ws + WS_TP))[(slot * 8 + wid) * 32 + r32] = R;
}


__device__ __forceinline__ void attn_item_p(const Args& a, LAS unsigned char* lds, int code) {
    constexpr int KS = 272, VS = 288, TILE_K = 64 * KS, BUF = TILE_K + 64 * VS;
    int tid_ = threadIdx.x; asm volatile("" : "+v"(tid_));
    const int tid = tid_, lane = tid & 63, r32 = lane & 31, hi = lane >> 5; const int wid = __builtin_amdgcn_readfirstlane(tid >> 6);
    unsigned char* ws = a.ws;
    const int bh = (code >> 1) & 15, qb = (code >> 5) & 15, c = (code >> 9) & 3, b = bh >> 3, head = bh & 7;
    const int slot = bh * 16 + qb + 0 * c, nst = p_nsteps(qb, c) >> 1, kvpos0 = 0;
    const int qw = qb * 256 + 32 * wid, qpos = qw + r32; const size_t qrow = (size_t)b * SEQ + qpos;
    const bf16* kgb = (const bf16*)(ws + WS_K) + ((size_t)b * SEQ + kvpos0 + (tid >> 4)) * AW + head * 128 + (tid & 15) * 8;
    const bf16* vgb = (const bf16*)(ws + WS_V) + ((size_t)b * SEQ + kvpos0 + (tid >> 4)) * AW + head * 128 + (tid & 15) * 8;
    bf16x8 qf[8];
    { const bf16* qp = (const bf16*)(ws + WS_Q) + qrow * AW + head * 128 + hi * 8;
#pragma unroll
      for (int d0 = 0; d0 < 8; ++d0) qf[d0] = *(const bf16x8*)(qp + 16 * d0); }
    f32x16 o[4];
#pragma unroll
    for (int i = 0; i < 4; ++i)
#pragma unroll
        for (int r = 0; r < 16; ++r) o[i][r] = 0.f;
    float R = 1.f;
    u32x4 kreg[2], vreg[2];
#define PLOAD(s_) do { _Pragma("unroll") for (int i_ = 0; i_ < 2; ++i_) { kreg[i_] = *(const u32x4*)(kgb + (size_t)((s_) * 64 + 32 * i_) * AW); vreg[i_] = *(const u32x4*)(vgb + (size_t)((s_) * 64 + 32 * i_) * AW); } } while (0)
#define PSTORE(buf_) do { _Pragma("unroll") for (int i_ = 0; i_ < 2; ++i_) { *(LAS u32x4*)(lds + (buf_) * BUF + ((tid >> 4) + 32 * i_) * KS + (tid & 15) * 16) = kreg[i_]; \
        *(LAS u32x4*)(lds + (buf_) * BUF + TILE_K + ((tid >> 4) + 32 * i_) * VS + (tid & 15) * 16) = vreg[i_]; } } while (0)
    volatile LAS int* flg = (volatile LAS int*)(lds + MISC_OFF + 64);
    PLOAD(nst - 1);
    PSTORE(0);
    __syncthreads();
    const LAS unsigned char* kp = lds + r32 * KS + hi * 16;
    const LAS unsigned char* vp = lds + TILE_K + (4 * hi + ((lane & 15) >> 2)) * VS + (16 * ((lane >> 4) & 1) + 4 * (lane & 3)) * 2;
    int cur = 0;
    for (int s = nst - 1; s >= 0; --s) {
        if (s > 0) PLOAD(s - 1);
#pragma unroll
        for (int blk = 1; blk >= 0; --blk) {
            const int kb = kvpos0 + 64 * s + 32 * blk;
            if (kb < qw + 32 && !__all(R == 0.f)) sb_block<VS, true>(o, R, kp + cur * BUF + blk * 32 * KS, vp + cur * BUF + blk * 32 * VS, qf, kp, kb, qw, qpos, hi);
        }
        volatile LAS int* fl = flg + 8 * (s & 1);
        if (lane == 0) fl[wid] = __all(R == 0.f) ? 1 : 0;
        if (s > 0) PSTORE(cur ^ 1);
        __syncthreads();
        if ((fl[0] & fl[1] & fl[2] & fl[3] & fl[4] & fl[5] & fl[6] & fl[7]) != 0) break;
        cur ^= 1;
    }
#undef PLOAD
#undef PSTORE
    float* op = (float*)(ws + WS_OP) + ((size_t)(slot * 8 + wid) * 32) * 128;
#pragma unroll
    for (int db = 0; db < 4; ++db)
#pragma unroll
        for (int r = 0; r < 16; ++r) op[crow(r, hi) * 128 + db * 32 + r32] = o[db][r];
    if (hi == 0) ((float*)(ws + WS_TP))[(slot * 8 + wid) * 32 + r32] = R;
}

__device__ __forceinline__ void mix_rows(const Args& a, int gw, int NGW, int lane) {
    unsigned char* ws = a.ws;
    const float* OP = (const float*)(ws + WS_OP); const float* TP = (const float*)(ws + WS_TP);
    const bf16* U = (const bf16*)(ws + WS_U); const bf16* GB = (const bf16*)(ws + WS_GB); bf16* MIX = (bf16*)(ws + WS_MIX);
    const float* cw = a.in[9]; const float* ga = a.in[10]; const float* gc = a.in[11];
    for (int m = gw; m < MT; m += NGW) {
        const int h = lane >> 3, d0 = (lane & 7) * 16;
        int nparts, slot0, wid, q;
        if (m < NP) { const int b = m >> 12, t = m & 4095, qb = t >> 8; wid = (t & 255) >> 5; q = t & 31; nparts = 1; slot0 = (b * 8 + h) * 16 + qb; }
        else { const int r = m - NP, b = r >> 6, t = r & 63, rg = t >> 5; q = t & 31; wid = (h & 3) * 2 + rg; nparts = 1; slot0 = 256 + b * 2 + (h >> 2); }
        f32x4 acc[4];
#pragma unroll
        for (int i = 0; i < 4; ++i) acc[i] = (f32x4){0.f, 0.f, 0.f, 0.f};
        float Rr = 1.f;
        for (int c = nparts - 1; c >= 0; --c) {
            const size_t base = (size_t)((slot0 + c) * 8 + wid) * 32 + q;
            const f32x4* p = (const f32x4*)(OP + base * 128 + d0);
#pragma unroll
            for (int i = 0; i < 4; ++i) acc[i] += p[i] * Rr;
            Rr *= TP[base];
        }
        float s = 0.f;
#pragma unroll
        for (int i = 0; i < 4; ++i) s += (acc[i][0] * acc[i][0] + acc[i][1] * acc[i][1]) + (acc[i][2] * acc[i][2] + acc[i][3] * acc[i][3]);
        float rs = __builtin_amdgcn_rsqf(wave_sum(s) * (1.0f / AW) + EPS);
        {
            const f32x4* g = (const f32x4*)(ga + h * 128 + d0); u32x4 w0, w1;
            f32x4 v0 = acc[0] * rs * g[0], v1 = acc[1] * rs * g[1], v2 = acc[2] * rs * g[2], v3 = acc[3] * rs * g[3];
            w0.x = pk2(v0[0], v0[1]); w0.y = pk2(v0[2], v0[3]); w0.z = pk2(v1[0], v1[1]); w0.w = pk2(v1[2], v1[3]);
            w1.x = pk2(v2[0], v2[1]); w1.y = pk2(v2[2], v2[3]); w1.z = pk2(v3[0], v3[1]); w1.w = pk2(v3[2], v3[3]);
            u32x4* o = (u32x4*)(MIX + (size_t)m * DM + h * 128 + d0); o[0] = w0; o[1] = w1;
        }
        const int c0 = lane * 16; int t, tb; const float* st = nullptr;
        if (m < NP) { t = m & 4095; tb = m - t; } else { const int r = m - NP; t = r & 63; tb = m - t; st = a.in[4] + (size_t)(r >> 6) * 2 * CC; }
        float u0[16], u1[16], u2[16];
        { const u32x4* p = (const u32x4*)(U + (size_t)m * CC + c0); const u32x4 x0 = p[0], x1 = p[1];
          const unsigned ww[8] = {x0.x, x0.y, x0.z, x0.w, x1.x, x1.y, x1.z, x1.w};
#pragma unroll
          for (int i = 0; i < 8; ++i) { u2[2 * i] = bflo(ww[i]); u2[2 * i + 1] = bfhi(ww[i]); } }
        if (t >= 1) { const u32x4* p = (const u32x4*)(U + (size_t)(m - 1) * CC + c0); const u32x4 x0 = p[0], x1 = p[1];
          const unsigned ww[8] = {x0.x, x0.y, x0.z, x0.w, x1.x, x1.y, x1.z, x1.w};
#pragma unroll
          for (int i = 0; i < 8; ++i) { u1[2 * i] = bflo(ww[i]); u1[2 * i + 1] = bfhi(ww[i]); } }
        else {
#pragma unroll
          for (int i = 0; i < 16; ++i) u1[i] = st ? st[CC + c0 + i] : 0.f; }
        if (t >= 2) { const u32x4* p = (const u32x4*)(U + (size_t)(m - 2) * CC + c0); const u32x4 x0 = p[0], x1 = p[1];
          const unsigned ww[8] = {x0.x, x0.y, x0.z, x0.w, x1.x, x1.y, x1.z, x1.w};
#pragma unroll
          for (int i = 0; i < 8; ++i) { u0[2 * i] = bflo(ww[i]); u0[2 * i + 1] = bfhi(ww[i]); } }
        else {
#pragma unroll
          for (int i = 0; i < 16; ++i) u0[i] = st ? st[(t == 0 ? 0 : CC) + c0 + i] : 0.f; }
        float oc[16]; float s2 = 0.f;
        { const u32x4* p = (const u32x4*)(GB + (size_t)m * CC + c0); const u32x4 x0 = p[0], x1 = p[1];
          const unsigned ww[8] = {x0.x, x0.y, x0.z, x0.w, x1.x, x1.y, x1.z, x1.w};
#pragma unroll
          for (int i = 0; i < 16; ++i) { const float gbv = (i & 1) ? bfhi(ww[i >> 1]) : bflo(ww[i >> 1]);
              oc[i] = gbv * (cw[c0 + i] * u0[i] + cw[CC + c0 + i] * u1[i] + cw[2 * CC + c0 + i] * u2[i]); s2 += oc[i] * oc[i]; } }
        rs = __builtin_amdgcn_rsqf(wave_sum(s2) * (1.0f / CC) + EPS);
        { u32x4 w0, w1; unsigned ww[8];
#pragma unroll
          for (int i = 0; i < 8; ++i) ww[i] = pk2(oc[2 * i] * rs * gc[c0 + 2 * i], oc[2 * i + 1] * rs * gc[c0 + 2 * i + 1]);
          w0.x = ww[0]; w0.y = ww[1]; w0.z = ww[2]; w0.w = ww[3]; w1.x = ww[4]; w1.y = ww[5]; w1.z = ww[6]; w1.w = ww[7];
          u32x4* o = (u32x4*)(MIX + (size_t)m * DM + AW + c0); o[0] = w0; o[1] = w1; }
        (void)tb;
    }
}
#ifndef REP_P0
#define REP_P0 1
#endif
#ifndef REP_P1
#define REP_P1 1
#endif
#ifndef REP_P3
#define REP_P3 1
#endif
#ifndef REP_P4
#define REP_P4 1
#endif
#ifndef REP_P5
#define REP_P5 1
#endif
__global__ void __launch_bounds__(NWAVES * 64, 2) fwd_megakernel(Args args) {
    extern __shared__ __attribute__((aligned(16))) unsigned char lds_raw[];
    cg::grid_group grid = cg::this_grid();
    LAS unsigned char* lds = (LAS unsigned char*)lds_raw;
    const int G = gridDim.x, bx = blockIdx.x, NGW = G * NWAVES;
#define PHASE_IDS() int tid = threadIdx.x; asm volatile("" : "+v"(tid)); const int lane = tid & 63; const int wave = __builtin_amdgcn_readfirstlane(tid >> 6); const int gw = bx * NWAVES + wave; (void)lane; (void)gw
    unsigned char* ws = args.ws;
    unsigned* ctl = (unsigned*)(ws + WS_CTL);
    LAS float* red = (LAS float*)(lds + RED_OFF);
    volatile LAS int* misc = (volatile LAS int*)(lds + MISC_OFF);

    { PHASE_IDS(); if (bx == 0 && tid == 0) { ctl[0] = 0u; ctl[64] = 0u; for (int i = 0; i < 16; ++i) ctl[128 + i] = 0u; }
      if (bx == 0) for (int i = tid; i < XCD_BAR_WORDS; i += NWAVES * 64) ctl[4096 + i] = 0u;
      if (tid < 2) misc[8 + tid] = 0;
#ifndef NO_P0
    for (int rep_ = 0; rep_ < REP_P0; ++rep_) p0_prologue(args, lds, gw, NGW, lane, wave);
#endif
    }
    grid.sync();
    XcdBarrier xbar = xcd_barrier_post(ctl + 4096, (volatile LAS unsigned*)(lds + MISC_OFF) + 8);

#ifndef NO_P1
    for (int rep_ = 0; rep_ < REP_P1; ++rep_) {
        pg8::Gemm g{(const pg8::bf16_t*)(ws + WS_HN), (const pg8::bf16_t*)(ws + WS_WIN), MT, INC, DM}; typedef pg8::StaticOrderT<MT / 256, INC / 256, DM / 64> Ord; Ord S; S.init(G, bx);
        pg8::EpiIn E{(bf16*)(ws + WS_Q), (bf16*)(ws + WS_K), (bf16*)(ws + WS_V), (bf16*)(ws + WS_GB), (bf16*)(ws + WS_U), args.out, args.in[7], args.in[8], red,
                     1.4426950408889634f * 0.08838834764831845f, OFF_KP, OFF_VP, OFF_CP, OFF_KS, OFF_VS, OFF_CS};
        pg8::gemm_phase<pg8::EpiIn, Ord, true, true>(lds, g, S, E);
    }
#endif
    xcd_barrier(xbar);

#ifndef NO_P2
    {
        const int nitems = g_items.n;
        PHASE_IDS();
#ifdef DUP_P2
        for (int rep = 0; rep < 2; ++rep)
#else
        const int rep = 0;
#endif
        for (;;) {
            if (tid == 0) misc[0] = (int)atomicAdd(ctl + 64 * rep, 1u);
            __syncthreads();
            const int it = misc[0];
            __syncthreads();
            if (it >= nitems) break;
            const int code = g_items.v[it];
#if defined(ONLY_S)
            attn_item<true>(args, lds, code);
#elif defined(ONLY_P)
            attn_item_p(args, lds, code);
#else
            if (code & 1) attn_item<true>(args, lds, code); else attn_item_p(args, lds, code);
#endif
        }
    }
#endif
    xcd_barrier(xbar);

#ifndef NO_P3
    for (int rep_ = 0; rep_ < REP_P3; ++rep_) { PHASE_IDS(); mix_rows(args, gw, NGW, lane); }
#endif
    xcd_barrier(xbar);

#ifndef NO_P4
    for (int rep_ = 0; rep_ < REP_P4; ++rep_) {
        pg8::Gemm g{(const pg8::bf16_t*)(ws + WS_MIX), (const pg8::bf16_t*)(ws + WS_WOUT), MT, DM, DM}; typedef pg8::TailOrderT<MT / 256, DM / 256, DM / 64, 8> Ord; Ord S; S.init(G, bx);
        pg8::EpiOut E{args.in[0], args.in[1], args.out + OFF_Y, (bf16*)(ws + WS_HN), (float*)(ws + WS_SSQ), red, (float*)(ws + WS_PART)};
        pg8::gemm_phase<pg8::EpiOut, Ord, true, true>(lds, g, S, E);
        if (S.rem > 0) {
            xcd_barrier(xbar);
            PHASE_IDS();
            for (int w = gw; w < S.rem * 256; w += NGW) {
                const int tu = w >> 8, r = w & 255; pg8::Unit u; Ord::SO::unit(S.full * G + tu, u);
                const size_t row = (size_t)u.pm * 256 + r; const int col = u.pn * 256 + 4 * lane;
                const float* xin = row < NP ? args.in[0] + row * DM : args.in[1] + (row - NP) * DM;
                f32x4 v = *(const f32x4*)(xin + col);
                const float* p = (const float*)(ws + WS_PART) + (size_t)(tu * 8) * 65536 + r * 256 + 4 * lane;
#pragma unroll
                for (int s = 0; s < 8; ++s) v += *(const f32x4*)(p + (size_t)s * 65536);
                *(f32x4*)(args.out + OFF_Y + row * DM + col) = v;
                u32x2 pk; pk.x = pk2(v[0], v[1]); pk.y = pk2(v[2], v[3]); *(u32x2*)((bf16*)(ws + WS_HN) + row * DM + col) = pk;
                const float ss = wave_sum((v[0] * v[0] + v[1] * v[1]) + (v[2] * v[2] + v[3] * v[3]));
                if (lane == 0) ((float*)(ws + WS_SSQ))[row * 8 + u.pn] = ss;
            }
        }
    }
#endif
    xcd_barrier(xbar);

#ifndef NO_P5
    for (int rep_ = 0; rep_ < REP_P5; ++rep_) {
        pg8::Gemm g{(const pg8::bf16_t*)(ws + WS_HN), (const pg8::bf16_t*)(ws + WS_WGU), MT, 2 * DFF, DM}; typedef pg8::StaticOrderT<MT / 256, 2 * DFF / 256, DM / 64> Ord; Ord S; S.init(G, bx);
        pg8::EpiGU E{(bf16*)(ws + WS_H), (const float*)(ws + WS_SSQ)};
        pg8::gemm_phase<pg8::EpiGU, Ord, true, true>(lds, g, S, E);
    }
#endif
    xcd_barrier(xbar);

#ifndef NO_P6
    {
        pg8::Gemm g{(const pg8::bf16_t*)(ws + WS_H), (const pg8::bf16_t*)(ws + WS_WDN), MT, DM, DFF};
        typedef pg8::TailOrderT<MT / 256, DM / 256, DFF / 64, 8> Ord; Ord S; S.init(G, bx);
        pg8::EpiDown E{args.out + OFF_Y, (float*)(ws + WS_PART)};
        pg8::gemm_phase<pg8::EpiDown, Ord, true, true>(lds, g, S, E);
        if (S.rem > 0) {
            xcd_barrier(xbar);
            PHASE_IDS();
            for (int w = gw; w < S.rem * 256; w += NGW) {
                const int tu = w >> 8, r = w & 255; pg8::Unit u; Ord::SO::unit(S.full * G + tu, u);
                float* y = args.out + OFF_Y + ((size_t)u.pm * 256 + r) * DM + u.pn * 256 + 4 * lane;
                f32x4 v = *(const f32x4*)y;
                const float* p = (const float*)(ws + WS_PART) + (size_t)(tu * 8) * 65536 + r * 256 + 4 * lane;
#pragma unroll
                for (int s = 0; s < 8; ++s) v += *(const f32x4*)(p + (size_t)s * 65536);
                *(f32x4*)y = v;
            }
        }
    }
#endif
}

extern "C" void kernel_launch(void* const* d_in, const int* in_sizes, int n_in, void* d_out, int out_size, void* d_ws, size_t ws_size, hipStream_t stream) {
    static int grid = 0;
    if (grid == 0) {
        if (n_in != 17 || (size_t)out_size != OUT_TOTAL || ws_size < WS_END) { fprintf(stderr, "kernel_launch: unexpected shapes (n_in %d out %d ws %zu need %zu)\n", n_in, out_size, ws_size, (size_t)WS_END); grid = -1; return; }
        int dev = 0, cus = 0, per_cu = 0;
        hipGetDevice(&dev); hipDeviceGetAttribute(&cus, hipDeviceAttributeMultiprocessorCount, dev);
        hipFuncSetAttribute((const void*)fwd_megakernel, hipFuncAttributeMaxDynamicSharedMemorySize, LDS_BYTES);
        hipOccupancyMaxActiveBlocksPerMultiprocessor(&per_cu, (const void*)fwd_megakernel, NWAVES * 64, LDS_BYTES);
        if (per_cu < 1) { fprintf(stderr, "kernel_launch: occupancy query says %d blocks per CU\n", per_cu); per_cu = 1; }
        (void)hipGetLastError();
        grid = cus;
    }
    if (grid < 0) return;
    Args a{};
    for (int i = 0; i < 17; ++i) a.in[i] = (const float*)d_in[i];
    a.out = (float*)d_out; a.ws = (unsigned char*)d_ws;
    void* kargs[] = {&a};
    hipError_t e = hipLaunchCooperativeKernel((const void*)fwd_megakernel, dim3(grid), dim3(NWAVES * 64), kargs, LDS_BYTES, stream);
    if (e != hipSuccess) fprintf(stderr, "cooperative launch failed: %s (grid %d)\n", hipGetErrorString(e), grid);
}
```

```cpp
#include <hip/hip_runtime.h>
#include <hip/hip_cooperative_groups.h>
#include <cstdio>
#include <cstdint>
namespace cg = cooperative_groups;
namespace pg8 {
#define PG8_LAS __attribute__((address_space(3)))
typedef unsigned short bf16_t;
typedef short bf16x8 __attribute__((ext_vector_type(8)));
typedef float f32x4 __attribute__((ext_vector_type(4)));
typedef unsigned u32x4 __attribute__((ext_vector_type(4)));
constexpr int BM = 256, BK = 64, HALF = 128, HTB = HALF * BK * 2  , STAGE_BYTES = 8 * HTB, NXCD = 8, WGM = 8;

__host__ __device__ __forceinline__ int lds_byte(int r, int c) { const int st = (r >> 4) * 2 + (c >> 5), rr = r & 15, cc = c & 31, ob = rr * 64 + cc * 2; return st * 1024 + (ob ^ (((ob >> 9) & 1) << 5)); }
__host__ __device__ __forceinline__ void stage_rc(int b, int& R, int& C) { const int st = b / 1024, sb = b % 1024, swz = sb ^ (((sb >> 9) & 1) << 5); R = (st >> 1) * 16 + swz / 64; C = (st & 1) * 32 + (swz % 64) / 2; }
__host__ __device__ __forceinline__ int perm32(int rho) { const int n = rho >> 4, i = rho & 15; return 8 * (i >> 2) + 4 * n + (i & 3); }

struct Unit { int pm, pn, k0, nt, split, tu, sp; };
struct Gemm { const bf16_t* A; const bf16_t* Bt; int M, N, K; };

template <int NM, int NN, int NTK> struct StaticOrderT {
    static constexpr int nM = NM, nN = NN, nwg = NM * NN, ntk = NTK;
    int G, c;
    __host__ __device__ __forceinline__ void init(int G_, int c_) { G = G_; c = c_; }
    __host__ __device__ __forceinline__ bool next(int i, Unit& u) const { const int L = i * G + c; if (L >= nwg) return false; unit(L, u); return true; }
    __host__ __device__ __forceinline__ static void unit(int L, Unit& u) {
        int wgid = L; { constexpr int q = nwg / NXCD, r = nwg % NXCD; const int xcd = wgid % NXCD, off = wgid / NXCD; wgid = (xcd < r ? xcd * (q + 1) : r * (q + 1) + (xcd - r) * q) + off; }
        constexpr int nig = WGM * nN; const int gid = wgid / nig, fm = gid * WGM, gsz = (nM - fm) < WGM ? (nM - fm) : WGM;
        u.pm = fm + ((wgid % nig) % gsz); u.pn = (wgid % nig) / gsz; u.k0 = 0; u.nt = ntk; u.split = 0; u.tu = 0; u.sp = 0;
    }
    __device__ __forceinline__ void a_ready(const Unit&) const {}
    __device__ __forceinline__ void done(const Unit&) const {}
};
template <int NM, int NN, int NTK, int NSPLIT> struct TailOrderT {
    typedef StaticOrderT<NM, NN, NTK> SO;
    int G, c, full, rem;
    __host__ __device__ __forceinline__ void init(int G_, int c_) { G = G_; c = c_; full = SO::nwg / G; rem = SO::nwg - full * G; if (rem * NSPLIT > G || NTK < 2 * NSPLIT) { full = 1 << 24; rem = 0; } }
    __host__ __device__ __forceinline__ static int kstart(int s) { return s >= NSPLIT ? NTK : ((s * NTK / NSPLIT) & ~1); }
    __host__ __device__ __forceinline__ bool next(int i, Unit& u) const {
        if (i < full) { const int L = i * G + c; if (L >= SO::nwg) return false; SO::unit(L, u); return true; }
        if (i > full || c >= rem * NSPLIT) return false;
        const int tu = c / NSPLIT, sp = c % NSPLIT; SO::unit(full * G + tu, u); u.k0 = kstart(sp); u.nt = kstart(sp + 1) - u.k0; u.split = 1; u.tu = tu; u.sp = sp; return true;
    }
    __device__ __forceinline__ void a_ready(const Unit&) const {}
    __device__ __forceinline__ void done(const Unit&) const {}
};

struct InProjOrder {
    typedef StaticOrderT<30, 24, 32> SO;
    int G, c;
    __host__ __device__ __forceinline__ void init(int G_, int c_) { G = G_; c = c_; }
    __host__ __device__ __forceinline__ bool next(int i, Unit& u) const {
        const int L = i * G + c; if (L >= 768) return false;
        if (L < 720) { SO::unit(L, u); return true; }
        const int j = L - 720; u.pm = 30 + (j & 3); u.pn = j >> 2; u.k0 = 0; u.nt = 32; u.split = 0; u.tu = 0; u.sp = 0; return true;
    }
    __device__ __forceinline__ void a_ready(const Unit&) const {}
    __device__ __forceinline__ void done(const Unit&) const {}
};
struct OneUnit {
    Unit u0;
    __host__ __device__ __forceinline__ bool next(int i, Unit& u) const { if (i != 0) return false; u = u0; return true; }
    __device__ __forceinline__ void a_ready(const Unit&) const {}
    __device__ __forceinline__ void done(const Unit&) const {}
};

__device__ __forceinline__ unsigned cvt_pk_bf16(float lo, float hi) { unsigned r; asm volatile("v_cvt_pk_bf16_f32 %0, %1, %2" : "=v"(r) : "v"(lo), "v"(hi)); return r; }
typedef float f32x2 __attribute__((ext_vector_type(2)));
#define PG8_LBAR() asm volatile("s_waitcnt lgkmcnt(0)\n\ts_barrier" ::: "memory")
constexpr int NPROMPT = 8192;
__device__ __forceinline__ u32x4 pack8(const f32x4 a, const f32x4 b) { u32x4 w; w.x = cvt_pk_bf16(a[0], a[1]); w.y = cvt_pk_bf16(a[2], a[3]); w.z = cvt_pk_bf16(b[0], b[1]); w.w = cvt_pk_bf16(b[2], b[3]); return w; }


__device__ __forceinline__ void store_partial(float* part, int nsplit, const f32x4 (&acc)[2][2][4][2], const Unit& u, int wr, int wc, int fr, int fq) {
    float* pt = part + (size_t)(u.tu * nsplit + u.sp) * 65536; int rl0 = wr * 64 + fr, cw = wc * 32 + 8 * fq; asm volatile("" : "+v"(rl0), "+v"(cw));
#pragma unroll
    for (int ai = 0; ai < 2; ++ai)
#pragma unroll
        for (int m = 0; m < 4; ++m)
#pragma unroll
            for (int bj = 0; bj < 2; ++bj) { float* o = pt + (ai * HALF + rl0 + m * 16) * 256 + bj * HALF + cw; *(f32x4*)o = acc[ai][bj][m][0]; *(f32x4*)(o + 4) = acc[ai][bj][m][1]; }
}

struct EpiIn {
    static constexpr bool PERM = true, AFTER_DRAIN = false;
    bf16_t *Q, *Kb, *Vb, *GB, *U; float* out; const float *gq, *gk; PG8_LAS float* red; float qscale;
    size_t off_kp, off_vp, off_cp, off_ks, off_vs, off_cs;
    __device__ __forceinline__ void operator()(const f32x4 (&acc)[2][2][4][2], const Unit& u, int wr, int wc, int fr, int fq) const {
        int rl0 = wr * 64 + fr, cw = wc * 32 + 8 * fq; asm volatile("" : "+v"(rl0), "+v"(cw));
        const int pn = u.pn, rowt = u.pm * BM;
        const bool prompt = rowt < NPROMPT;
        if (pn < 8) {
            const bool isq = pn < 4;
#pragma unroll
            for (int ai = 0; ai < 2; ++ai)
#pragma unroll
                for (int m = 0; m < 4; ++m)
#pragma unroll
                    for (int bj = 0; bj < 2; ++bj) {
                        const f32x4 a = acc[ai][bj][m][0], b = acc[ai][bj][m][1];
                        float s = (a[0] * a[0] + a[1] * a[1]) + (a[2] * a[2] + a[3] * a[3]) + (b[0] * b[0] + b[1] * b[1]) + (b[2] * b[2] + b[3] * b[3]);
                        s += __shfl_xor(s, 16); s += __shfl_xor(s, 32);
                        if (fq == 0) red[((ai * HALF + rl0 + m * 16) * 2 + bj) * 4 + wc] = s;
                    }
            PG8_LBAR();
            const float* g = isq ? gq : gk;
            const f32x4 g0 = *(const f32x4*)(g + cw), g1 = *(const f32x4*)(g + cw + 4);
#pragma unroll
            for (int ai = 0; ai < 2; ++ai)
#pragma unroll
                for (int m = 0; m < 4; ++m) {
                    const int rl = ai * HALF + rl0 + m * 16; const size_t row = (size_t)(rowt + rl);
#pragma unroll
                    for (int bj = 0; bj < 2; ++bj) {
                        const f32x4 p = *(const PG8_LAS f32x4*)(red + (rl * 2 + bj) * 4);
                        float rs = __builtin_amdgcn_rsqf(((p[0] + p[1]) + (p[2] + p[3])) * (1.0f / 128.0f) + 1e-6f);
                        if (isq) rs *= qscale;
                        const f32x4 v0 = acc[ai][bj][m][0] * rs * g0, v1 = acc[ai][bj][m][1] * rs * g1;
                        if (isq) { *(u32x4*)(Q + row * 1024 + pn * 256 + bj * HALF + cw) = pack8(v0, v1); }
                        else {
                            const int col = (pn - 4) * 256 + bj * HALF + cw;
                            float* o = prompt ? out + off_kp + row * 1024 + col : out + off_ks + (row - NPROMPT) * 1024 + col;
                            *(f32x4*)o = v0; *(f32x4*)(o + 4) = v1;
                            if (prompt) *(u32x4*)(Kb + row * 1024 + col) = pack8(v0, v1);
                        }
                    }
                }
        } else if (pn < 12) {
#pragma unroll
            for (int ai = 0; ai < 2; ++ai)
#pragma unroll
                for (int m = 0; m < 4; ++m) {
                    const size_t row = (size_t)(rowt + ai * HALF + rl0 + m * 16);
#pragma unroll
                    for (int bj = 0; bj < 2; ++bj) {
                        const int col = (pn - 8) * 256 + bj * HALF + cw; const f32x4 v0 = acc[ai][bj][m][0], v1 = acc[ai][bj][m][1];
                        float* o = prompt ? out + off_vp + row * 1024 + col : out + off_vs + (row - NPROMPT) * 1024 + col;
                        *(f32x4*)o = v0; *(f32x4*)(o + 4) = v1;
                        if (prompt) *(u32x4*)(Vb + row * 1024 + col) = pack8(v0, v1);
                    }
                }
        } else if (pn < 16) {
#pragma unroll
            for (int ai = 0; ai < 2; ++ai)
#pragma unroll
                for (int m = 0; m < 4; ++m) {
                    const size_t row = (size_t)(rowt + ai * HALF + rl0 + m * 16);
#pragma unroll
                    for (int bj = 0; bj < 2; ++bj) *(u32x4*)(GB + row * 1024 + (pn - 12) * 256 + bj * HALF + cw) = pack8(acc[ai][bj][m][0], acc[ai][bj][m][1]);
                }
        } else {
#pragma unroll
            for (int ai = 0; ai < 2; ++ai)
#pragma unroll
                for (int m = 0; m < 4; ++m) {
                    const int rowi = rowt + ai * HALF + rl0 + m * 16; const int ch = (pn - 16) * HALF + cw;
                    const f32x4 v0 = acc[ai][0][m][0] * acc[ai][1][m][0], v1 = acc[ai][0][m][1] * acc[ai][1][m][1];
                    *(u32x4*)(U + (size_t)rowi * 1024 + ch) = pack8(v0, v1);
                    if (prompt) { const int t = rowi & 4095; if (t >= 4094) { float* o = out + off_cp + ((rowi >> 12) * 2 + (t - 4094)) * 1024 + ch; *(f32x4*)o = v0; *(f32x4*)(o + 4) = v1; } }
                    else { const int rs_ = rowi - NPROMPT, t = rs_ & 63; if (t >= 62) { float* o = out + off_cs + ((rs_ >> 6) * 2 + (t - 62)) * 1024 + ch; *(f32x4*)o = v0; *(f32x4*)(o + 4) = v1; } }
                }
        }
    }
};

struct EpiOut {
    static constexpr bool PERM = true, AFTER_DRAIN = false;
    const float *xp, *xs; float* Y; bf16_t* X1; float* ssq; PG8_LAS float* red; float* part;
    __device__ __forceinline__ void operator()(const f32x4 (&acc)[2][2][4][2], const Unit& u, int wr, int wc, int fr, int fq) const {
        if (u.split) { store_partial(part, 8, acc, u, wr, wc, fr, fq); return; }
        int rl0 = wr * 64 + fr, cw = wc * 32 + 8 * fq; asm volatile("" : "+v"(rl0), "+v"(cw));
        const int pn = u.pn, rowt = u.pm * BM;
        const float* xin = rowt < NPROMPT ? xp + (size_t)rowt * 2048 : xs + (size_t)(rowt - NPROMPT) * 2048;
#pragma unroll
        for (int ai = 0; ai < 2; ++ai)
#pragma unroll
            for (int m = 0; m < 4; ++m) {
                const int rl = ai * HALF + rl0 + m * 16; float s = 0.f;
#pragma unroll
                for (int bj = 0; bj < 2; ++bj) {
                    const int col = pn * 256 + bj * HALF + cw; const float* xi = xin + (size_t)rl * 2048 + col;
                    const f32x4 v0 = *(const f32x4*)xi + acc[ai][bj][m][0], v1 = *(const f32x4*)(xi + 4) + acc[ai][bj][m][1];
                    float* o = Y + (size_t)(rowt + rl) * 2048 + col; *(f32x4*)o = v0; *(f32x4*)(o + 4) = v1;
                    *(u32x4*)(X1 + (size_t)(rowt + rl) * 2048 + col) = pack8(v0, v1);
                    s += (v0[0] * v0[0] + v0[1] * v0[1]) + (v0[2] * v0[2] + v0[3] * v0[3]) + (v1[0] * v1[0] + v1[1] * v1[1]) + (v1[2] * v1[2] + v1[3] * v1[3]);
                    asm volatile("" ::: "memory");
                }
                s += __shfl_xor(s, 16); s += __shfl_xor(s, 32);
                if (fq == 0) red[rl * 4 + wc] = s;
                asm volatile("" ::: "memory");
            }
        PG8_LBAR();
        if (threadIdx.x < 256) { const f32x4 p = *(const PG8_LAS f32x4*)(red + threadIdx.x * 4); ssq[(size_t)(rowt + threadIdx.x) * 8 + pn] = (p[0] + p[1]) + (p[2] + p[3]); }
        PG8_LBAR();
    }
};

struct EpiGU {
    static constexpr bool PERM = true, AFTER_DRAIN = false;
    bf16_t* H; const float* ssq;
    __device__ __forceinline__ void operator()(const f32x4 (&acc)[2][2][4][2], const Unit& u, int wr, int wc, int fr, int fq) const {
        int rl0 = wr * 64 + fr, cw = wc * 32 + 8 * fq; asm volatile("" : "+v"(rl0), "+v"(cw));
        const int pn = u.pn, rowt = u.pm * BM;
#pragma unroll
        for (int ai = 0; ai < 2; ++ai)
#pragma unroll
            for (int m = 0; m < 4; ++m) {
                const size_t row = (size_t)(rowt + ai * HALF + rl0 + m * 16);
                const f32x4 p0 = *(const f32x4*)(ssq + row * 8), p1 = *(const f32x4*)(ssq + row * 8 + 4);
                const float rs = __builtin_amdgcn_rsqf((((p0[0] + p0[1]) + (p0[2] + p0[3])) + ((p1[0] + p1[1]) + (p1[2] + p1[3]))) * (1.0f / 2048.0f) + 1e-6f);
                f32x4 h[2];
#pragma unroll
                for (int n = 0; n < 2; ++n) {
                    const f32x4 g = acc[ai][0][m][n] * rs, up = acc[ai][1][m][n] * rs;
#pragma unroll
                    for (int j = 0; j < 4; ++j) h[n][j] = g[j] * __builtin_amdgcn_rcpf(1.0f + __builtin_amdgcn_exp2f(-1.4426950408889634f * g[j])) * up[j];
                }
                *(u32x4*)(H + row * 5632 + pn * HALF + cw) = pack8(h[0], h[1]);
            }
    }
};

struct EpiDown {
    static constexpr bool PERM = true, AFTER_DRAIN = false;
    float* Y; float* part;
    __device__ __forceinline__ void operator()(const f32x4 (&acc)[2][2][4][2], const Unit& u, int wr, int wc, int fr, int fq) const {
        if (u.split) { store_partial(part, 8, acc, u, wr, wc, fr, fq); return; }
        int rl0 = wr * 64 + fr, cw = wc * 32 + 8 * fq; asm volatile("" : "+v"(rl0), "+v"(cw));
        const int pn = u.pn, rowt = u.pm * BM;
#pragma unroll
        for (int ai = 0; ai < 2; ++ai)
#pragma unroll
            for (int m = 0; m < 4; ++m)
#pragma unroll
                for (int bj = 0; bj < 2; ++bj) {
                    float* o = Y + (size_t)(rowt + ai * HALF + rl0 + m * 16) * 2048 + pn * 256 + bj * HALF + cw;
                    const f32x4 v0 = *(const f32x4*)o + acc[ai][bj][m][0], v1 = *(const f32x4*)(o + 4) + acc[ai][bj][m][1];
                    *(f32x4*)o = v0; *(f32x4*)(o + 4) = v1;
                    if (bj) asm volatile("" ::: "memory");
                }
    }
};

struct EpiNone {
    static constexpr bool PERM = true, AFTER_DRAIN = false;
    float* sink;
    __device__ __forceinline__ void operator()(const f32x4 (&acc)[2][2][4][2], const Unit& u, int wr, int wc, int fr, int fq) const {
        if (acc[0][0][0][0][0] == 12345.678f && acc[1][1][3][1][3] == -9876.5f) sink[0] = 1.f;
    }
};
template <class Epi, class Sched, bool ALIGN_EPI = false, bool SP2 = false>
__device__ __forceinline__ void gemm_phase(PG8_LAS unsigned char* lds, const Gemm g, const Sched& S, const Epi& E) {
    int tid_ = threadIdx.x; asm volatile("" : "+v"(tid_));
    const int tid = tid_, wid = __builtin_amdgcn_readfirstlane(tid >> 6), lane = tid & 63, wr = wid >> 2, wc = wid & 3, fr = lane & 15, fq = lane >> 4;
    const int K = g.K;
    unsigned voffA[2], voffB[2];
#pragma unroll
    for (int i = 0; i < 2; ++i) { int R, C; stage_rc(tid * 16 + i * 8192, R, C); const int Rb = Epi::PERM ? ((R & ~31) + perm32(R & 31)) : R;
        voffA[i] = (unsigned)(R * K + C) * 2u; voffB[i] = (unsigned)(Rb * K + C) * 2u; }
    const size_t kstep = (size_t)(BK * 2);
    const size_t hstep = (size_t)HALF * K * 2;
    const size_t tstep = 2 * hstep;
    const unsigned ldsw = (unsigned)wid * 1024u;
    const int aoff = lds_byte(wr * 64 + fr, fq * 8), boff = lds_byte(wc * 32 + fr, fq * 8);
#define PG8_SA(b, h) (((b) * 2 + (h)) * HTB)
#define PG8_SB(b, h) ((4 + (b) * 2 + (h)) * HTB)
#define PG8_STAGE(bufoff, gbase, voff) do { _Pragma("unroll") for (int _i = 0; _i < 2; ++_i) \
        __builtin_amdgcn_global_load_lds((const unsigned*)((const char*)(gbase) + (voff)[_i]), (PG8_LAS unsigned*)(lds + (bufoff) + ldsw + _i * 8192), 16, 0, 0); } while (0)
#define PG8_LDA(dst, b, h) do { _Pragma("unroll") for (int m = 0; m < 4; ++m) _Pragma("unroll") for (int k = 0; k < 2; ++k) dst[m][k] = *(const PG8_LAS bf16x8*)(lds + PG8_SA(b, h) + aoff + m * 2048 + k * 1024); } while (0)
#define PG8_LDB(dst, b, h) do { _Pragma("unroll") for (int n = 0; n < 2; ++n) _Pragma("unroll") for (int k = 0; k < 2; ++k) dst[n][k] = *(const PG8_LAS bf16x8*)(lds + PG8_SB(b, h) + boff + n * 2048 + k * 1024); } while (0)
#define PG8_MMA(ai, bj, At, Bt) do { __builtin_amdgcn_s_setprio(1); _Pragma("unroll") for (int m = 0; m < 4; ++m) _Pragma("unroll") for (int n = 0; n < 2; ++n) _Pragma("unroll") for (int k = 0; k < 2; ++k) \
        acc[ai][bj][m][n] = __builtin_amdgcn_mfma_f32_16x16x32_bf16(Bt[n][k], At[m][k], acc[ai][bj][m][n], 0, 0, 0); __builtin_amdgcn_s_setprio(0); } while (0)
#define PG8_WAIT_V(n) asm volatile("s_waitcnt vmcnt(" #n ")" ::: "memory")
#define PG8_WAIT_L(n) asm volatile("s_waitcnt lgkmcnt(" #n ")" ::: "memory")
#define PG8_BAR __builtin_amdgcn_s_barrier()
#define PG8_SCHED __builtin_amdgcn_sched_barrier(0)
    Unit cur, nxt; int ui = 0;
    if (!S.next(0, cur)) return;
    f32x4 acc[2][2][4][2];
#pragma unroll
    for (int a = 0; a < 2; ++a)
#pragma unroll
        for (int b = 0; b < 2; ++b)
#pragma unroll
            for (int m = 0; m < 4; ++m)
#pragma unroll
                for (int n = 0; n < 2; ++n) acc[a][b][m][n] = (f32x4){0.f, 0.f, 0.f, 0.f};
    bf16x8 At[4][2], B0[2][2], B1[2][2];
    const char* cA = (const char*)g.A + (size_t)cur.pm * tstep + (size_t)cur.k0 * kstep; const char* cB = (const char*)g.Bt + (size_t)cur.pn * tstep + (size_t)cur.k0 * kstep;
    S.a_ready(cur);
    if constexpr (SP2) {
        PG8_STAGE(PG8_SB(0, 0), cB, voffB); PG8_STAGE(PG8_SB(0, 1), cB + hstep, voffB); PG8_STAGE(PG8_SA(0, 0), cA, voffA); PG8_STAGE(PG8_SA(0, 1), cA + hstep, voffA);
        if (wr == 1) PG8_BAR;
        PG8_WAIT_V(2); PG8_BAR;
        PG8_STAGE(PG8_SB(1, 0), cB + kstep, voffB); PG8_STAGE(PG8_SA(1, 0), cA + kstep, voffA); PG8_STAGE(PG8_SB(1, 1), cB + hstep + kstep, voffB);
        PG8_WAIT_V(6); PG8_BAR;
    } else {
        PG8_STAGE(PG8_SB(0, 0), cB, voffB); PG8_STAGE(PG8_SA(0, 0), cA, voffA); PG8_STAGE(PG8_SB(0, 1), cB + hstep, voffB); PG8_STAGE(PG8_SA(0, 1), cA + hstep, voffA);
        if (wr == 1) PG8_BAR;
        PG8_WAIT_V(4); PG8_BAR;
        PG8_STAGE(PG8_SB(1, 0), cB + kstep, voffB); PG8_STAGE(PG8_SA(1, 0), cA + kstep, voffA); PG8_STAGE(PG8_SB(1, 1), cB + hstep + kstep, voffB);
        PG8_WAIT_V(6); PG8_BAR;
    }
    for (;;) {
        const bool has_next = S.next(ui + 1, nxt);
        const char* nA = has_next ? (const char*)g.A + (size_t)nxt.pm * tstep + (size_t)nxt.k0 * kstep : cA; const char* nB = has_next ? (const char*)g.Bt + (size_t)nxt.pn * tstep + (size_t)nxt.k0 * kstep : cB;
        const int nt = cur.nt;
        for (int t = 0; t < nt; t += 2) {
            const bool last = (t == nt - 2);
            const char* a1 = cA + (size_t)(t + 1) * kstep;
            const char* a2 = last ? nA : cA + (size_t)(t + 2) * kstep; const char* b2 = last ? nB : cB + (size_t)(t + 2) * kstep;
            const char* a3 = a2 + kstep; const char* b3 = b2 + kstep;
            if (last && has_next) S.a_ready(nxt);
            if constexpr (SP2) {
            PG8_LDB(B0, 0, 0); PG8_LDB(B1, 0, 1); PG8_SCHED; PG8_LDA(At, 0, 0); PG8_STAGE(PG8_SA(1, 1), a1 + hstep, voffA);
            PG8_WAIT_V(8); PG8_WAIT_L(0); PG8_BAR; PG8_MMA(0, 0, At, B0); PG8_MMA(0, 1, At, B1); PG8_BAR; PG8_SCHED;
            PG8_LDA(At, 0, 1); PG8_STAGE(PG8_SB(0, 0), b2, voffB); PG8_STAGE(PG8_SB(0, 1), b2 + hstep, voffB); PG8_STAGE(PG8_SA(0, 0), a2, voffA);
            PG8_WAIT_V(8); PG8_WAIT_L(0); PG8_BAR; PG8_MMA(1, 0, At, B0); PG8_MMA(1, 1, At, B1); PG8_BAR; PG8_SCHED;
            PG8_LDB(B0, 1, 0); PG8_LDB(B1, 1, 1); PG8_SCHED; PG8_LDA(At, 1, 0); PG8_STAGE(PG8_SA(0, 1), a2 + hstep, voffA);
            PG8_WAIT_V(8); PG8_WAIT_L(0); PG8_BAR; PG8_MMA(0, 0, At, B0); PG8_MMA(0, 1, At, B1); PG8_BAR; PG8_SCHED;
            PG8_LDA(At, 1, 1); PG8_STAGE(PG8_SB(1, 0), b3, voffB); PG8_STAGE(PG8_SB(1, 1), b3 + hstep, voffB); PG8_STAGE(PG8_SA(1, 0), a3, voffA);
            PG8_WAIT_V(8); PG8_WAIT_L(0); PG8_BAR; PG8_MMA(1, 0, At, B0); PG8_MMA(1, 1, At, B1); PG8_BAR; PG8_SCHED;
            } else {
            PG8_LDB(B0, 0, 0); PG8_SCHED; PG8_LDA(At, 0, 0); PG8_STAGE(PG8_SA(1, 1), a1 + hstep, voffA);
            PG8_WAIT_L(8); PG8_BAR; PG8_WAIT_L(0); PG8_MMA(0, 0, At, B0); PG8_BAR; PG8_SCHED;
            PG8_LDB(B1, 0, 1); PG8_STAGE(PG8_SB(0, 0), b2, voffB);
            PG8_BAR; PG8_WAIT_L(0); PG8_MMA(0, 1, At, B1); PG8_BAR;
            PG8_LDA(At, 0, 1); PG8_STAGE(PG8_SA(0, 0), a2, voffA);
            PG8_BAR; PG8_WAIT_L(0); PG8_MMA(1, 0, At, B0); PG8_BAR; PG8_SCHED;
            PG8_STAGE(PG8_SB(0, 1), b2 + hstep, voffB);
            PG8_WAIT_V(6); PG8_BAR; PG8_MMA(1, 1, At, B1); PG8_BAR;
            PG8_LDB(B0, 1, 0); PG8_SCHED; PG8_LDA(At, 1, 0); PG8_STAGE(PG8_SA(0, 1), a2 + hstep, voffA);
            PG8_WAIT_L(8); PG8_BAR; PG8_WAIT_L(0); PG8_MMA(0, 0, At, B0); PG8_BAR; PG8_SCHED;
            PG8_LDB(B1, 1, 1); PG8_STAGE(PG8_SB(1, 0), b3, voffB);
            PG8_BAR; PG8_WAIT_L(0); PG8_MMA(0, 1, At, B1); PG8_BAR;
            PG8_LDA(At, 1, 1); PG8_STAGE(PG8_SA(1, 0), a3, voffA);
            PG8_BAR; PG8_WAIT_L(0); PG8_MMA(1, 0, At, B0); PG8_BAR; PG8_SCHED;
            PG8_STAGE(PG8_SB(1, 1), b3 + hstep, voffB);
            PG8_WAIT_V(6); PG8_BAR; PG8_MMA(1, 1, At, B1); PG8_BAR;
            }
        }
        if constexpr (ALIGN_EPI) { if (wr == 0) PG8_BAR; }
        if constexpr (!Epi::AFTER_DRAIN) { E(acc, cur, wr, wc, fr, fq); S.done(cur); }
        if (!has_next) break;
#pragma unroll
        for (int a = 0; a < 2; ++a)
#pragma unroll
            for (int b = 0; b < 2; ++b)
#pragma unroll
                for (int m = 0; m < 4; ++m)
#pragma unroll
                    for (int n = 0; n < 2; ++n) acc[a][b][m][n] = (f32x4){0.f, 0.f, 0.f, 0.f};
        cur = nxt; cA = nA; cB = nB; ++ui;
        if constexpr (ALIGN_EPI) { if (wr == 1) PG8_BAR; }
    }
    PG8_WAIT_V(0);
    if constexpr (!ALIGN_EPI) { if (wr == 0) PG8_BAR; }
    PG8_BAR;
    if constexpr (Epi::AFTER_DRAIN) { E.fused(acc, cur, wr, wc, fr, fq, lds, wid, lane); S.done(cur); }
#undef PG8_SA
#undef PG8_SB
#undef PG8_STAGE
#undef PG8_LDA
#undef PG8_LDB
#undef PG8_MMA
#undef PG8_WAIT_V
#undef PG8_WAIT_L
#undef PG8_BAR
#undef PG8_SCHED
}
}
#define LAS __attribute__((address_space(3)))
typedef unsigned short bf16;
typedef float f32x4 __attribute__((ext_vector_type(4)));
typedef float f32x16 __attribute__((ext_vector_type(16)));
typedef short bf16x8 __attribute__((ext_vector_type(8)));
typedef short s16x4 __attribute__((ext_vector_type(4)));
typedef unsigned u32x4 __attribute__((ext_vector_type(4)));
typedef unsigned u32x2 __attribute__((ext_vector_type(2)));
constexpr int DM = 2048, SEQ = 4096, NP = 8192, NS = 512, MT = NP + NS, AW = 1024, CC = 1024, INC = 6144, DFF = 5632, PAST = 4096, DSEQ = 64;
constexpr float EPS = 1e-6f;
constexpr size_t OFF_Y = 0, OFF_KP = (size_t)MT * DM, OFF_VP = OFF_KP + (size_t)NP * AW, OFF_CP = OFF_VP + (size_t)NP * AW, OFF_KS = OFF_CP + 2 * 2 * CC,
                 OFF_VS = OFF_KS + (size_t)NS * AW, OFF_CS = OFF_VS + (size_t)NS * AW, OUT_TOTAL = OFF_CS + 8 * 2 * CC;
static_assert(OUT_TOTAL == 35672064, "output size");
constexpr size_t MiB = 1u << 20;
constexpr size_t WS_CTL = 0, WS_WIN = 1 * MiB, WS_WOUT = 25 * MiB, WS_WGU = 33 * MiB, WS_WDN = 77 * MiB, WS_HN = 99 * MiB, WS_Q = 133 * MiB, WS_K = 150 * MiB, WS_V = 166 * MiB,
                 WS_GB = 182 * MiB, WS_U = 199 * MiB, WS_MIX = 216 * MiB, WS_SSQ = 250 * MiB, WS_TP = 251 * MiB, WS_OP = 256 * MiB, WS_H = 256 * MiB, WS_PART = 133 * MiB  ;
constexpr int NSLOT = 256 + 16;
constexpr size_t WS_END = WS_OP + (size_t)NSLOT * 131072;
constexpr int RING_BYTES = 131072, RED_OFF = RING_BYTES, MISC_OFF = RED_OFF + 8192, LDS_BYTES = 147456;
constexpr int NWAVES = 8;

#define XB_TMO      128
#define XB_XCNT(j)  (256  + 64 * (j))
#define XB_XSUB(j)  (1280 + 64 * (j))
#define XB_XGEN(j)  (2304 + 64 * (j))
#define XB_TOP      3328
#define XB_TOPGEN   3392
#define XCD_BAR_WORDS 3456
#define XB_SPIN_CAP (1u << 18)

__device__ __forceinline__ unsigned xb_ld(unsigned* p)              { return __hip_atomic_load(p, __ATOMIC_RELAXED, __HIP_MEMORY_SCOPE_AGENT); }
__device__ __forceinline__ unsigned xb_add(unsigned* p, unsigned v) { return __hip_atomic_fetch_add(p, v, __ATOMIC_RELAXED, __HIP_MEMORY_SCOPE_AGENT); }
__device__ __forceinline__ unsigned xb_xcc_id() { return (unsigned)__builtin_amdgcn_s_getreg((3 << 11) | 20) & 0xFu; }
#define XB_SPIN(cond, bar) do { unsigned _sp = 0; while (cond) { __builtin_amdgcn_s_sleep(1); \
    if ((++_sp & 255u) == 0u) { if (xb_ld(&(bar)[XB_TMO])) break; if (_sp > XB_SPIN_CAP) { atomicAdd(&(bar)[XB_TMO], 1u); break; } } } } while (0)

struct XcdBarrier {
    unsigned* bar; unsigned x;
    volatile LAS unsigned* st;
};

__device__ __forceinline__ XcdBarrier xcd_barrier_post(unsigned* bar, volatile LAS unsigned* st) {
    XcdBarrier b; b.bar = bar; b.x = xb_xcc_id(); b.st = st;
    if (threadIdx.x == 0) (void)xb_add(&bar[XB_XCNT(b.x)], 1u);
    return b;
}
__device__ __forceinline__ void xcd_barrier_complete(unsigned* bar, unsigned x, unsigned& nloc, unsigned& nx) {
    const unsigned G = gridDim.x * gridDim.y * gridDim.z;
    unsigned sum, cnt, mine, sp = 0u;
    for (;;) {
        sum = 0u; cnt = 0u; mine = 0u;
#pragma unroll
        for (unsigned j = 0; j < 16; ++j) { const unsigned c = xb_ld(&bar[XB_XCNT(j)]); sum += c; cnt += (c > 0u) ? 1u : 0u; mine = (j == x) ? c : mine; }
        if (sum == G) break;
        __builtin_amdgcn_s_sleep(1);
        if ((++sp & 255u) == 0u) { if (xb_ld(&bar[XB_TMO])) break; if (sp > XB_SPIN_CAP) { atomicAdd(&bar[XB_TMO], 1u); break; } }
    }
    nloc = mine > 0u ? mine : 1u; nx = cnt > 0u ? cnt : 1u;
}

__device__ __forceinline__ void xcd_barrier(const XcdBarrier& b) {
    asm volatile("s_waitcnt vmcnt(0)" ::: "memory");
    __syncthreads();
    if (threadIdx.x == 0) {
        unsigned* bar = b.bar;
        __builtin_amdgcn_s_waitcnt(0);
        unsigned nloc = b.st[0], nx = b.st[1];
        if (nloc == 0u) { xcd_barrier_complete(bar, b.x, nloc, nx); b.st[0] = nloc; b.st[1] = nx; }
        const unsigned old = xb_add(&bar[XB_XSUB(b.x)], 1u);
        const unsigned gen = old / nloc;
        if (old + 1u == (gen + 1u) * nloc) {
            __builtin_amdgcn_fence(__ATOMIC_RELEASE, "agent");
            asm volatile("s_waitcnt vmcnt(0)" ::: "memory");
            const unsigned og = xb_add(&bar[XB_TOP], 1u);
            const unsigned tg = og / nx;
            if (og + 1u == (tg + 1u) * nx) xb_add(&bar[XB_TOPGEN], 1u);
            else XB_SPIN(xb_ld(&bar[XB_TOPGEN]) == tg, bar);
            __builtin_amdgcn_fence(__ATOMIC_ACQUIRE, "agent");
            xb_add(&bar[XB_XGEN(b.x)], 1u);
            asm volatile("s_waitcnt vmcnt(0)" ::: "memory");
        } else {
            XB_SPIN(xb_ld(&bar[XB_XGEN(b.x)]) == gen, bar);
            __builtin_amdgcn_fence(__ATOMIC_ACQUIRE, "agent");
            asm volatile("s_waitcnt vmcnt(0)" ::: "memory");
        }
    }
    __syncthreads();
}

struct ItemTab { int n; int v[272]; };
constexpr int p_nsteps(int qb, int c) { return 8 * (qb + 1); }
constexpr ItemTab make_items() {
    ItemTab t{}; t.n = 0;
    for (int b = 0; b < 8; ++b) for (int hg = 0; hg < 2; ++hg) t.v[t.n++] = 1 | (b << 1) | (hg << 4);
    for (int qb = 15; qb >= 0; --qb) for (int bh = 0; bh < 16; ++bh) t.v[t.n++] = (bh << 1) | (qb << 5);
    return t;
}
__device__ const ItemTab g_items = make_items();

__device__ __forceinline__ unsigned f2bf(float f) { unsigned u = __builtin_bit_cast(unsigned, f); return (u + 0x7fffu + ((u >> 16) & 1u)) >> 16; }
__device__ __forceinline__ unsigned pk2(float lo, float hi) { return pg8::cvt_pk_bf16(lo, hi); }
__device__ __forceinline__ float bflo(unsigned w) { return __builtin_bit_cast(float, w << 16); }
__device__ __forceinline__ float bfhi(unsigned w) { return __builtin_bit_cast(float, w & 0xffff0000u); }
__device__ __forceinline__ int crow(int r, int hi) { return (r & 3) + 8 * (r >> 2) + 4 * hi; }
__device__ __forceinline__ float wave_sum(float v) {
#pragma unroll
    for (int o = 1; o < 64; o <<= 1) v += __shfl_xor(v, o);
    return v;
}

struct Args { const float* in[17]; float* out; unsigned char* ws; };

struct P0Item { const float* src; const float* gk; bf16* dst; int N, K, k0; };
__device__ __forceinline__ P0Item p0_decode(const Args& a, int it) {
    constexpr int I_IN = 32 * 192, I_OUT = 32 * 64, I_G = 32 * 176;
    unsigned char* ws = a.ws; P0Item r; int n0, kb, drow; r.gk = nullptr;
    if (it < I_IN) { kb = it / 192; n0 = 32 * (it % 192); drow = n0;
        if (n0 >= 5120) { const int ch = n0 - 5120; drow = 4096 + (ch >> 7) * 256 + 128 + (ch & 127); } else if (n0 >= 4096) { const int ch = n0 - 4096; drow = 4096 + (ch >> 7) * 256 + (ch & 127); }
        r.src = a.in[6]; r.N = INC; r.K = DM; r.dst = (bf16*)(ws + WS_WIN); }
    else if ((it -= I_IN) < I_OUT) { kb = it / 64; n0 = 32 * (it % 64); drow = n0; r.src = a.in[12]; r.N = DM; r.K = DM; r.dst = (bf16*)(ws + WS_WOUT); }
    else if ((it -= I_OUT) < 2 * I_G) { const int up = it >= I_G; if (up) it -= I_G; kb = it / 176; n0 = 32 * (it % 176); drow = (n0 >> 7) * 256 + up * 128 + (n0 & 127);
        r.src = a.in[up ? 15 : 14]; r.N = DFF; r.K = DM; r.dst = (bf16*)(ws + WS_WGU); r.gk = a.in[13]; }
    else { it -= 2 * I_G; kb = it / 64; n0 = 32 * (it % 64); drow = n0; r.src = a.in[16]; r.N = DM; r.K = DFF; r.dst = (bf16*)(ws + WS_WDN); }
    r.k0 = 64 * kb; r.src += (size_t)r.k0 * r.N + n0; r.dst += (size_t)drow * r.K + r.k0;
    return r;
}
__device__ __forceinline__ void p0_load(const P0Item& p, f32x4 (&v)[8], int lane) {
#pragma unroll
    for (int j = 0; j < 8; ++j) v[j] = __builtin_nontemporal_load((const f32x4*)(p.src + (size_t)(8 * j + (lane >> 3)) * p.N + 4 * (lane & 7)));
}
__device__ __forceinline__ void p0_finish(const P0Item& p, const f32x4 (&v)[8], LAS float* scr, int lane) {
#pragma unroll
    for (int j = 0; j < 8; ++j) { const int kk = 8 * j + (lane >> 3); const float g = p.gk ? p.gk[p.k0 + kk] : 1.0f; LAS float* s = scr + kk * 33 + 4 * (lane & 7);
        s[0] = v[j][0] * g; s[1] = v[j][1] * g; s[2] = v[j][2] * g; s[3] = v[j][3] * g; }
    asm volatile("s_waitcnt lgkmcnt(0)" ::: "memory");
    const int c = lane & 7;
#pragma unroll
    for (int j = 0; j < 4; ++j) { const int n = (lane >> 3) + 8 * j; const LAS float* s = scr + (8 * c) * 33 + n;
        u32x4 o; o.x = pk2(s[0 * 33], s[1 * 33]); o.y = pk2(s[2 * 33], s[3 * 33]); o.z = pk2(s[4 * 33], s[5 * 33]); o.w = pk2(s[6 * 33], s[7 * 33]);
        *(u32x4*)(p.dst + (size_t)n * p.K + 8 * c) = o; }
    asm volatile("s_waitcnt lgkmcnt(0)" ::: "memory");
}
constexpr int P0_EARLY_ITEMS = 32 * 192 + 32 * 64, P0_ALL_ITEMS = 32 * 192 + 32 * 64 + 2 * 32 * 176 + 88 * 64, P0_CHUNK = 32, P0_LATE_CHUNKS = (P0_ALL_ITEMS - P0_EARLY_ITEMS) / P0_CHUNK;
static_assert((P0_ALL_ITEMS - P0_EARLY_ITEMS) % P0_CHUNK == 0, "late conversion items come in whole chunks");
__device__ __forceinline__ void p0_run_range(const Args& a, LAS float* scr, int first, int n, int lane) {
    f32x4 va[8], vb[8]; P0Item pa, pb;
    pa = p0_decode(a, first); p0_load(pa, va, lane);
    for (int i = 0; i < n; i += 2) {
        if (i + 1 < n) { pb = p0_decode(a, first + i + 1); p0_load(pb, vb, lane); }
        p0_finish(pa, va, scr, lane);
        if (i + 1 >= n) break;
        if (i + 2 < n) { pa = p0_decode(a, first + i + 2); p0_load(pa, va, lane); }
        p0_finish(pb, vb, scr, lane);
    }
}
__device__ __forceinline__ void p0_prologue(const Args& a, LAS unsigned char* lds, int gw, int NGW, int lane, int wave) {
    LAS float* scr = (LAS float*)(lds + wave * 16384);
    unsigned char* ws = a.ws;
    constexpr int NITEMS = P0_EARLY_ITEMS;
    {
        int it = gw; f32x4 va[8], vb[8]; P0Item pa, pb;
        if (it < NITEMS) { pa = p0_decode(a, it); p0_load(pa, va, lane); }
        while (it < NITEMS) {
            const int itb = it + NGW;
            if (itb < NITEMS) { pb = p0_decode(a, itb); p0_load(pb, vb, lane); }
            p0_finish(pa, va, scr, lane);
            it = itb + NGW;
            if (itb >= NITEMS) break;
            if (it < NITEMS) { pa = p0_decode(a, it); p0_load(pa, va, lane); }
            p0_finish(pb, vb, scr, lane);
        }
    }
    const float* g1 = a.in[5];
    for (int m = gw; m < MT; m += NGW) {
        const float* xrow = m < NP ? a.in[0] + (size_t)m * DM : a.in[1] + (size_t)(m - NP) * DM;
        const f32x4* xr = (const f32x4*)xrow + lane; f32x4 v[8]; float s = 0.f;
#pragma unroll
        for (int j = 0; j < 8; ++j) { v[j] = xr[64 * j]; s += (v[j][0] * v[j][0] + v[j][1] * v[j][1]) + (v[j][2] * v[j][2] + v[j][3] * v[j][3]); }
        const float rs = __builtin_amdgcn_rsqf(wave_sum(s) * (1.0f / DM) + EPS);
        u32x2* o = (u32x2*)((bf16*)(ws + WS_HN) + (size_t)m * DM) + lane;
#pragma unroll
        for (int j = 0; j < 8; ++j) { const f32x4 g = *((const f32x4*)g1 + 64 * j + lane); u32x2 w; w.x = pk2(v[j][0] * rs * g[0], v[j][1] * rs * g[1]); w.y = pk2(v[j][2] * rs * g[2], v[j][3] * rs * g[3]); o[64 * j] = w; }
    }
}


template <int VS, bool QREG>
__device__ __forceinline__ void sb_block(f32x16 (&o)[4], float& R, const LAS unsigned char* kp, const LAS unsigned char* vp, const bf16x8 (&qreg)[8], const LAS unsigned char* qlp, int kb, int qw, int qpos, int hi) {
            f32x16 p;
#pragma unroll
            for (int r = 0; r < 16; ++r) p[r] = 0.f;
#pragma unroll
            for (int d0 = 0; d0 < 8; ++d0) { const bf16x8 kf = *(const LAS bf16x8*)(kp + d0 * 32); const bf16x8 qf = QREG ? qreg[d0] : *(const LAS bf16x8*)(qlp + d0 * 32); p = __builtin_amdgcn_mfma_f32_32x32x16_bf16(kf, qf, p, 0, 0, 0); }
            const bool need_mask = (kb + 31 >= qw);
            float e[16], sf[16];
#pragma unroll
            for (int r = 0; r < 16; ++r) {
                const float z = fminf(p[r], 100.f); float ee = __builtin_amdgcn_exp2f(z); float rr = __builtin_amdgcn_rcpf(1.0f + ee);
                if (need_mask) { const bool msk = (kb + crow(r, hi)) >= qpos; ee = msk ? 0.f : ee; rr = msk ? 1.f : rr; }
                e[r] = ee; sf[r] = rr;
            }
            float oth[4], PP[4];
#pragma unroll
            for (int g = 0; g < 4; ++g) { sf[4 * g + 2] *= sf[4 * g + 3]; sf[4 * g + 1] *= sf[4 * g + 2]; sf[4 * g] *= sf[4 * g + 1]; oth[g] = __shfl_xor(sf[4 * g], 32); PP[g] = sf[4 * g] * oth[g]; }
            const float SP3 = PP[3], SP2 = PP[2] * SP3, SP1 = PP[1] * SP2, SP0 = PP[0] * SP1;
            float A[4]; A[0] = R * SP1; A[1] = R * SP2; A[2] = R * SP3; A[3] = R;
#pragma unroll
            for (int g = 0; g < 4; ++g) A[g] = hi ? A[g] : A[g] * oth[g];
            R *= SP0;
            float w[16];
#pragma unroll
            for (int r = 0; r < 16; ++r) w[r] = (e[r] * sf[r]) * A[r >> 2];
#pragma unroll
            for (int s2 = 0; s2 < 2; ++s2) {
                u32x4 pw; pw.x = pk2(w[8 * s2 + 0], w[8 * s2 + 1]); pw.y = pk2(w[8 * s2 + 2], w[8 * s2 + 3]); pw.z = pk2(w[8 * s2 + 4], w[8 * s2 + 5]); pw.w = pk2(w[8 * s2 + 6], w[8 * s2 + 7]);
                const bf16x8 pa = __builtin_bit_cast(bf16x8, pw);
#pragma unroll
                for (int db = 0; db < 4; ++db) {
                    const s16x4 lo = __builtin_bit_cast(s16x4, __builtin_amdgcn_ds_read_tr16_b64_v4i16((LAS s16x4*)(vp + (16 * s2) * VS + db * 64)));
                    const s16x4 hh = __builtin_bit_cast(s16x4, __builtin_amdgcn_ds_read_tr16_b64_v4i16((LAS s16x4*)(vp + (16 * s2 + 8) * VS + db * 64)));
                    const bf16x8 vb = __builtin_shufflevector(lo, hh, 0, 1, 2, 3, 4, 5, 6, 7);
                    o[db] = __builtin_amdgcn_mfma_f32_32x32x16_bf16(pa, vb, o[db], 0, 0, 0);
                }
            }
}

template <bool SAMPLE>
__device__ __forceinline__ void attn_item(const Args& a, LAS unsigned char* lds, int code) {
    constexpr int NH = SAMPLE ? 4 : 1, KS = NH * 256 + 16, VS = NH * 256 + 32, K_OFF = 0, V_OFF = 32 * KS;
    int tid_ = threadIdx.x; asm volatile("" : "+v"(tid_));
    const int tid = tid_, lane = tid & 63, r32 = lane & 31, hi = lane >> 5; const int wid = __builtin_amdgcn_readfirstlane(tid >> 6);
    unsigned char* ws = a.ws;
    int slot, nsteps, kvpos0, qw, head, hl; size_t qrow;
    const bf16 *kgb = nullptr, *vgb = nullptr; const float *kgf = nullptr, *vgf = nullptr, *kgn = nullptr, *vgn = nullptr;
    if (SAMPLE) {
        const int b = (code >> 1) & 7, hg = (code >> 4) & 1;
        slot = 256 + b * 2 + hg; hl = wid >> 1; head = hg * 4 + hl; const int rg = wid & 1;
        qw = PAST + 32 * rg; qrow = (size_t)NP + b * DSEQ + 32 * rg + r32;
        nsteps = 130; kvpos0 = 0;
        kgf = a.in[2] + ((size_t)b * PAST + (tid >> 7)) * AW + hg * 512 + 4 * (tid & 127); vgf = a.in[3] + ((size_t)b * PAST + (tid >> 7)) * AW + hg * 512 + 4 * (tid & 127);
        kgn = a.out + OFF_KS + ((size_t)b * DSEQ + (tid >> 7)) * AW + hg * 512 + 4 * (tid & 127); vgn = a.out + OFF_VS + ((size_t)b * DSEQ + (tid >> 7)) * AW + hg * 512 + 4 * (tid & 127);
    } else {
        const int bh = (code >> 1) & 15, qb = (code >> 5) & 15, c = (code >> 9) & 3, b = bh >> 3;
        head = bh & 7; hl = 0; slot = bh * 16 + qb + 0 * c; nsteps = p_nsteps(qb, c); kvpos0 = 0;
        qw = qb * 256 + 32 * wid; qrow = (size_t)b * SEQ + qw + r32;
        kgb = (const bf16*)(ws + WS_K) + ((size_t)b * SEQ + kvpos0 + (tid >> 4)) * AW + head * 128 + (tid & 15) * 8;
        vgb = (const bf16*)(ws + WS_V) + ((size_t)b * SEQ + kvpos0 + (tid >> 4)) * AW + head * 128 + (tid & 15) * 8;
    }
    const int qpos = qw + r32;
    constexpr int Q_OFF = 67584, QS = 272;
    const LAS unsigned char* qlp = lds + Q_OFF + wid * (32 * QS) + r32 * QS + hi * 16;
    { const bf16* qp = (const bf16*)(ws + WS_Q) + qrow * AW + head * 128 + hi * 8;
#pragma unroll
      for (int d0 = 0; d0 < 8; ++d0) *(LAS bf16x8*)(lds + Q_OFF + wid * (32 * QS) + r32 * QS + hi * 16 + d0 * 32) = *(const bf16x8*)(qp + 16 * d0); }
    f32x16 o[4];
#pragma unroll
    for (int i = 0; i < 4; ++i)
#pragma unroll
        for (int r = 0; r < 16; ++r) o[i][r] = 0.f;
    float R = 1.f;
    u32x4 kreg, vreg; f32x4 kf4[8], vf4[8];
#define ATT_LOADK(s_) do { if (SAMPLE) { _Pragma("unroll") for (int i_ = 0; i_ < 8; ++i_) kf4[i_] = *(const f32x4*)(((s_) >= 128 ? kgn + (size_t)((s_) - 128) * 32 * AW : kgf + (size_t)(s_) * 32 * AW) + (size_t)i_ * 4 * AW); } \
        else { kreg = *(const u32x4*)(kgb + (size_t)(s_) * 32 * AW); } } while (0)
#define ATT_LOADV(s_) do { if (SAMPLE) { _Pragma("unroll") for (int i_ = 0; i_ < 8; ++i_) vf4[i_] = *(const f32x4*)(((s_) >= 128 ? vgn + (size_t)((s_) - 128) * 32 * AW : vgf + (size_t)(s_) * 32 * AW) + (size_t)i_ * 4 * AW); } \
        else { vreg = *(const u32x4*)(vgb + (size_t)(s_) * 32 * AW); } } while (0)
#define ATT_STOREK() do { if (SAMPLE) { _Pragma("unroll") for (int i_ = 0; i_ < 8; ++i_) { const int key_ = (tid >> 7) + 4 * i_, f4_ = tid & 127; \
            u32x2 kw_; kw_.x = pk2(kf4[i_][0], kf4[i_][1]); kw_.y = pk2(kf4[i_][2], kf4[i_][3]); *(LAS u32x2*)(lds + K_OFF + key_ * KS + f4_ * 8) = kw_; } } \
        else { *(LAS u32x4*)(lds + K_OFF + (tid >> 4) * KS + (tid & 15) * 16) = kreg; } } while (0)
#define ATT_STOREV() do { if (SAMPLE) { _Pragma("unroll") for (int i_ = 0; i_ < 8; ++i_) { const int key_ = (tid >> 7) + 4 * i_, f4_ = tid & 127; \
            u32x2 vw_; vw_.x = pk2(vf4[i_][0], vf4[i_][1]); vw_.y = pk2(vf4[i_][2], vf4[i_][3]); *(LAS u32x2*)(lds + V_OFF + key_ * VS + f4_ * 8) = vw_; } } \
        else { *(LAS u32x4*)(lds + V_OFF + (tid >> 4) * VS + (tid & 15) * 16) = vreg; } } while (0)
    volatile LAS int* flg = (volatile LAS int*)(lds + MISC_OFF + 64);
    ATT_LOADK(nsteps - 1); ATT_LOADV(nsteps - 1);
    ATT_STOREK(); ATT_STOREV();
    __syncthreads();
    const LAS unsigned char* kp = lds + K_OFF + r32 * KS + hl * 256 + hi * 16;
    const LAS unsigned char* vp = lds + V_OFF + (4 * hi + ((lane & 15) >> 2)) * VS + hl * 256 + (16 * ((lane >> 4) & 1) + 4 * (lane & 3)) * 2;
    for (int s = nsteps - 1; s >= 0; --s) {
        if (s > 0) { ATT_LOADK(s - 1); if (!SAMPLE) ATT_LOADV(s - 1); }
        const int kb = kvpos0 + 32 * s;
        if (kb < qw + 32 && !__all(R == 0.f)) { const bf16x8 qdummy[8] = {}; sb_block<VS, false>(o, R, kp, vp, qdummy, qlp, kb, qw, qpos, hi); }
        if (lane == 0) flg[wid] = __all(R == 0.f) ? 1 : 0;
        __syncthreads();
        const bool alldone = (flg[0] & flg[1] & flg[2] & flg[3] & flg[4] & flg[5] & flg[6] & flg[7]) != 0;
        if (alldone) { __syncthreads(); break; }
        if (s > 0) { ATT_STOREK(); if (SAMPLE) ATT_LOADV(s - 1); ATT_STOREV(); }
        __syncthreads();
    }
#undef ATT_LOADK
#undef ATT_LOADV
#undef ATT_STOREK
#undef ATT_STOREV
    float* op = (float*)(ws + WS_OP) + ((size_t)(slot * 8 + wid) * 32) * 128;
#pragma unroll
    for (int db = 0; db < 4; ++db)
#pragma unroll
        for (int r = 0; r < 16; ++r) op[crow(r, hi) * 128 + db * 32 + r32] = o[db][r];
    if (hi == 0) ((float*)(ws + WS_TP))[(slot * 8 + wid) * 32 + r32] = R;
}


__device__ __forceinline__ void attn_item_p(const Args& a, LAS unsigned char* lds, int code) {
    constexpr int KS = 272, VS = 288, TILE_K = 64 * KS, BUF = TILE_K + 64 * VS;
    int tid_ = threadIdx.x; asm volatile("" : "+v"(tid_));
    const int tid = tid_, lane = tid & 63, r32 = lane & 31, hi = lane >> 5; const int wid = __builtin_amdgcn_readfirstlane(tid >> 6);
    unsigned char* ws = a.ws;
    const int bh = (code >> 1) & 15, qb = (code >> 5) & 15, c = (code >> 9) & 3, b = bh >> 3, head = bh & 7;
    const int slot = bh * 16 + qb + 0 * c, nst = p_nsteps(qb, c) >> 1, kvpos0 = 0;
    const int qw = qb * 256 + 32 * wid, qpos = qw + r32; const size_t qrow = (size_t)b * SEQ + qpos;
    const bf16* kgb = (const bf16*)(ws + WS_K) + ((size_t)b * SEQ + kvpos0 + (tid >> 4)) * AW + head * 128 + (tid & 15) * 8;
    const bf16* vgb = (const bf16*)(ws + WS_V) + ((size_t)b * SEQ + kvpos0 + (tid >> 4)) * AW + head * 128 + (tid & 15) * 8;
    bf16x8 qf[8];
    { const bf16* qp = (const bf16*)(ws + WS_Q) + qrow * AW + head * 128 + hi * 8;
#pragma unroll
      for (int d0 = 0; d0 < 8; ++d0) qf[d0] = *(const bf16x8*)(qp + 16 * d0); }
    f32x16 o[4];
#pragma unroll
    for (int i = 0; i < 4; ++i)
#pragma unroll
        for (int r = 0; r < 16; ++r) o[i][r] = 0.f;
    float R = 1.f;
    u32x4 kreg[2], vreg[2];
#define PLOAD(s_) do { _Pragma("unroll") for (int i_ = 0; i_ < 2; ++i_) { kreg[i_] = *(const u32x4*)(kgb + (size_t)((s_) * 64 + 32 * i_) * AW); vreg[i_] = *(const u32x4*)(vgb + (size_t)((s_) * 64 + 32 * i_) * AW); } } while (0)
#define PSTORE(buf_) do { _Pragma("unroll") for (int i_ = 0; i_ < 2; ++i_) { *(LAS u32x4*)(lds + (buf_) * BUF + ((tid >> 4) + 32 * i_) * KS + (tid & 15) * 16) = kreg[i_]; \
        *(LAS u32x4*)(lds + (buf_) * BUF + TILE_K + ((tid >> 4) + 32 * i_) * VS + (tid & 15) * 16) = vreg[i_]; } } while (0)
    volatile LAS int* flg = (volatile LAS int*)(lds + MISC_OFF + 64);
    PLOAD(nst - 1);
    PSTORE(0);
    __syncthreads();
    const LAS unsigned char* kp = lds + r32 * KS + hi * 16;
    const LAS unsigned char* vp = lds + TILE_K + (4 * hi + ((lane & 15) >> 2)) * VS + (16 * ((lane >> 4) & 1) + 4 * (lane & 3)) * 2;
    int cur = 0;
    for (int s = nst - 1; s >= 0; --s) {
        if (s > 0) PLOAD(s - 1);
#pragma unroll
        for (int blk = 1; blk >= 0; --blk) {
            const int kb = kvpos0 + 64 * s + 32 * blk;
            if (kb < qw + 32 && !__all(R == 0.f)) sb_block<VS, true>(o, R, kp + cur * BUF + blk * 32 * KS, vp + cur * BUF + blk * 32 * VS, qf, kp, kb, qw, qpos, hi);
        }
        volatile LAS int* fl = flg + 8 * (s & 1);
        if (lane == 0) fl[wid] = __all(R == 0.f) ? 1 : 0;
        if (s > 0) PSTORE(cur ^ 1);
        __syncthreads();
        if ((fl[0] & fl[1] & fl[2] & fl[3] & fl[4] & fl[5] & fl[6] & fl[7]) != 0) break;
        cur ^= 1;
    }
#undef PLOAD
#undef PSTORE
    float* op = (float*)(ws + WS_OP) + ((size_t)(slot * 8 + wid) * 32) * 128;
#pragma unroll
    for (int db = 0; db < 4; ++db)
#pragma unroll
        for (int r = 0; r < 16; ++r) op[crow(r, hi) * 128 + db * 32 + r32] = o[db][r];
    if (hi == 0) ((float*)(ws + WS_TP))[(slot * 8 + wid) * 32 + r32] = R;
}

__device__ __forceinline__ void mix_rows(const Args& a, int gw, int NGW, int lane) {
    unsigned char* ws = a.ws;
    const float* OP = (const float*)(ws + WS_OP); const float* TP = (const float*)(ws + WS_TP);
    const bf16* U = (const bf16*)(ws + WS_U); const bf16* GB = (const bf16*)(ws + WS_GB); bf16* MIX = (bf16*)(ws + WS_MIX);
    const float* cw = a.in[9]; const float* ga = a.in[10]; const float* gc = a.in[11];
    for (int m = gw; m < MT; m += NGW) {
        const int h = lane >> 3, d0 = (lane & 7) * 16;
        int nparts, slot0, wid, q;
        if (m < NP) { const int b = m >> 12, t = m & 4095, qb = t >> 8; wid = (t & 255) >> 5; q = t & 31; nparts = 1; slot0 = (b * 8 + h) * 16 + qb; }
        else { const int r = m - NP, b = r >> 6, t = r & 63, rg = t >> 5; q = t & 31; wid = (h & 3) * 2 + rg; nparts = 1; slot0 = 256 + b * 2 + (h >> 2); }
        f32x4 acc[4];
#pragma unroll
        for (int i = 0; i < 4; ++i) acc[i] = (f32x4){0.f, 0.f, 0.f, 0.f};
        float Rr = 1.f;
        for (int c = nparts - 1; c >= 0; --c) {
            const size_t base = (size_t)((slot0 + c) * 8 + wid) * 32 + q;
            const f32x4* p = (const f32x4*)(OP + base * 128 + d0);
#pragma unroll
            for (int i = 0; i < 4; ++i) acc[i] += p[i] * Rr;
            Rr *= TP[base];
        }
        float s = 0.f;
#pragma unroll
        for (int i = 0; i < 4; ++i) s += (acc[i][0] * acc[i][0] + acc[i][1] * acc[i][1]) + (acc[i][2] * acc[i][2] + acc[i][3] * acc[i][3]);
        float rs = __builtin_amdgcn_rsqf(wave_sum(s) * (1.0f / AW) + EPS);
        {
            const f32x4* g = (const f32x4*)(ga + h * 128 + d0); u32x4 w0, w1;
            f32x4 v0 = acc[0] * rs * g[0], v1 = acc[1] * rs * g[1], v2 = acc[2] * rs * g[2], v3 = acc[3] * rs * g[3];
            w0.x = pk2(v0[0], v0[1]); w0.y = pk2(v0[2], v0[3]); w0.z = pk2(v1[0], v1[1]); w0.w = pk2(v1[2], v1[3]);
            w1.x = pk2(v2[0], v2[1]); w1.y = pk2(v2[2], v2[3]); w1.z = pk2(v3[0], v3[1]); w1.w = pk2(v3[2], v3[3]);
            u32x4* o = (u32x4*)(MIX + (size_t)m * DM + h * 128 + d0); o[0] = w0; o[1] = w1;
        }
        const int c0 = lane * 16; int t, tb; const float* st = nullptr;
        if (m < NP) { t = m & 4095; tb = m - t; } else { const int r = m - NP; t = r & 63; tb = m - t; st = a.in[4] + (size_t)(r >> 6) * 2 * CC; }
        float u0[16], u1[16], u2[16];
        { const u32x4* p = (const u32x4*)(U + (size_t)m * CC + c0); const u32x4 x0 = p[0], x1 = p[1];
          const unsigned ww[8] = {x0.x, x0.y, x0.z, x0.w, x1.x, x1.y, x1.z, x1.w};
#pragma unroll
          for (int i = 0; i < 8; ++i) { u2[2 * i] = bflo(ww[i]); u2[2 * i + 1] = bfhi(ww[i]); } }
        if (t >= 1) { const u32x4* p = (const u32x4*)(U + (size_t)(m - 1) * CC + c0); const u32x4 x0 = p[0], x1 = p[1];
          const unsigned ww[8] = {x0.x, x0.y, x0.z, x0.w, x1.x, x1.y, x1.z, x1.w};
#pragma unroll
          for (int i = 0; i < 8; ++i) { u1[2 * i] = bflo(ww[i]); u1[2 * i + 1] = bfhi(ww[i]); } }
        else {
#pragma unroll
          for (int i = 0; i < 16; ++i) u1[i] = st ? st[CC + c0 + i] : 0.f; }
        if (t >= 2) { const u32x4* p = (const u32x4*)(U + (size_t)(m - 2) * CC + c0); const u32x4 x0 = p[0], x1 = p[1];
          const unsigned ww[8] = {x0.x, x0.y, x0.z, x0.w, x1.x, x1.y, x1.z, x1.w};
#pragma unroll
          for (int i = 0; i < 8; ++i) { u0[2 * i] = bflo(ww[i]); u0[2 * i + 1] = bfhi(ww[i]); } }
        else {
#pragma unroll
          for (int i = 0; i < 16; ++i) u0[i] = st ? st[(t == 0 ? 0 : CC) + c0 + i] : 0.f; }
        float oc[16]; float s2 = 0.f;
        { const u32x4* p = (const u32x4*)(GB + (size_t)m * CC + c0); const u32x4 x0 = p[0], x1 = p[1];
          const unsigned ww[8] = {x0.x, x0.y, x0.z, x0.w, x1.x, x1.y, x1.z, x1.w};
#pragma unroll
          for (int i = 0; i < 16; ++i) { const float gbv = (i & 1) ? bfhi(ww[i >> 1]) : bflo(ww[i >> 1]);
              oc[i] = gbv * (cw[c0 + i] * u0[i] + cw[CC + c0 + i] * u1[i] + cw[2 * CC + c0 + i] * u2[i]); s2 += oc[i] * oc[i]; } }
        rs = __builtin_amdgcn_rsqf(wave_sum(s2) * (1.0f / CC) + EPS);
        { u32x4 w0, w1; unsigned ww[8];
#pragma unroll
          for (int i = 0; i < 8; ++i) ww[i] = pk2(oc[2 * i] * rs * gc[c0 + 2 * i], oc[2 * i + 1] * rs * gc[c0 + 2 * i + 1]);
          w0.x = ww[0]; w0.y = ww[1]; w0.z = ww[2]; w0.w = ww[3]; w1.x = ww[4]; w1.y = ww[5]; w1.z = ww[6]; w1.w = ww[7];
          u32x4* o = (u32x4*)(MIX + (size_t)m * DM + AW + c0); o[0] = w0; o[1] = w1; }
        (void)tb;
    }
}
#ifndef REP_P0
#define REP_P0 1
#endif
#ifndef REP_P1
#define REP_P1 1
#endif
#ifndef REP_P3
#define REP_P3 1
#endif
#ifndef REP_P4
#define REP_P4 1
#endif
#ifndef REP_P5
#define REP_P5 1
#endif
__global__ void __launch_bounds__(NWAVES * 64, 2) fwd_megakernel(Args args) {
    extern __shared__ __attribute__((aligned(16))) unsigned char lds_raw[];
    cg::grid_group grid = cg::this_grid();
    LAS unsigned char* lds = (LAS unsigned char*)lds_raw;
    const int G = gridDim.x, bx = blockIdx.x, NGW = G * NWAVES;
#define PHASE_IDS() int tid = threadIdx.x; asm volatile("" : "+v"(tid)); const int lane = tid & 63; const int wave = __builtin_amdgcn_readfirstlane(tid >> 6); const int gw = bx * NWAVES + wave; (void)lane; (void)gw
    unsigned char* ws = args.ws;
    unsigned* ctl = (unsigned*)(ws + WS_CTL);
    LAS float* red = (LAS float*)(lds + RED_OFF);
    volatile LAS int* misc = (volatile LAS int*)(lds + MISC_OFF);

    { PHASE_IDS(); if (bx == 0 && tid == 0) { ctl[0] = 0u; ctl[64] = 0u; for (int i = 0; i < 16; ++i) ctl[128 + i] = 0u; }
      if (bx == 0) for (int i = tid; i < XCD_BAR_WORDS; i += NWAVES * 64) ctl[4096 + i] = 0u;
      if (tid < 2) misc[8 + tid] = 0;
#ifndef NO_P0
    for (int rep_ = 0; rep_ < REP_P0; ++rep_) p0_prologue(args, lds, gw, NGW, lane, wave);
#endif
    }
    grid.sync();
    XcdBarrier xbar = xcd_barrier_post(ctl + 4096, (volatile LAS unsigned*)(lds + MISC_OFF) + 8);

#ifndef NO_P1
    for (int rep_ = 0; rep_ < REP_P1; ++rep_) {
        pg8::Gemm g{(const pg8::bf16_t*)(ws + WS_HN), (const pg8::bf16_t*)(ws + WS_WIN), MT, INC, DM}; typedef pg8::InProjOrder Ord; Ord S; S.init(G, bx);
        pg8::EpiIn E{(bf16*)(ws + WS_Q), (bf16*)(ws + WS_K), (bf16*)(ws + WS_V), (bf16*)(ws + WS_GB), (bf16*)(ws + WS_U), args.out, args.in[7], args.in[8], red,
                     1.4426950408889634f * 0.08838834764831845f, OFF_KP, OFF_VP, OFF_CP, OFF_KS, OFF_VS, OFF_CS};
        pg8::gemm_phase<pg8::EpiIn, Ord, true, true>(lds, g, S, E);
    }
#endif
    xcd_barrier(xbar);

#ifndef NO_P2
    {
        const int nitems = g_items.n;
        PHASE_IDS();
#ifdef DUP_P2
        for (int rep = 0; rep < 2; ++rep)
#else
        const int rep = 0;
#endif
        for (;;) {
            if (tid == 0) misc[0] = (int)atomicAdd(ctl + 64 * rep, 1u);
            __syncthreads();
            int it = misc[0];
            __syncthreads();
            if (it < 48) {
                pg8::Gemm g{(const pg8::bf16_t*)(ws + WS_HN), (const pg8::bf16_t*)(ws + WS_WIN), MT, INC, DM};
                pg8::OneUnit S1; S1.u0.pm = 30 + (it & 3); S1.u0.pn = 12 + (it >> 2); S1.u0.k0 = 0; S1.u0.nt = 32; S1.u0.split = 0; S1.u0.tu = 0; S1.u0.sp = 0;
                pg8::EpiIn E{(bf16*)(ws + WS_Q), (bf16*)(ws + WS_K), (bf16*)(ws + WS_V), (bf16*)(ws + WS_GB), (bf16*)(ws + WS_U), args.out, args.in[7], args.in[8], red,
                             1.4426950408889634f * 0.08838834764831845f, OFF_KP, OFF_VP, OFF_CP, OFF_KS, OFF_VS, OFF_CS};
                pg8::gemm_phase<pg8::EpiIn, pg8::OneUnit, true, true>(lds, g, S1, E);
                __syncthreads();
                continue;
            }
            it -= 48;
            if (it >= nitems) {
                const int ch = it - nitems; if (ch >= P0_LATE_CHUNKS) break;
                p0_run_range(args, (LAS float*)(lds + wave * 16384), P0_EARLY_ITEMS + ch * P0_CHUNK + wave * (P0_CHUNK / NWAVES), P0_CHUNK / NWAVES, lane);
                continue;
            }
            const int code = g_items.v[it];
#if defined(ONLY_S)
            attn_item<true>(args, lds, code);
#elif defined(ONLY_P)
            attn_item_p(args, lds, code);
#else
            if (code & 1) attn_item<true>(args, lds, code); else attn_item_p(args, lds, code);
#endif
        }
    }
#endif
    xcd_barrier(xbar);

#ifndef NO_P3
    for (int rep_ = 0; rep_ < REP_P3; ++rep_) { PHASE_IDS(); mix_rows(args, gw, NGW, lane); }
#endif
    xcd_barrier(xbar);

#ifndef NO_P4
    for (int rep_ = 0; rep_ < REP_P4; ++rep_) {
        pg8::Gemm g{(const pg8::bf16_t*)(ws + WS_MIX), (const pg8::bf16_t*)(ws + WS_WOUT), MT, DM, DM}; typedef pg8::TailOrderT<MT / 256, DM / 256, DM / 64, 8> Ord; Ord S; S.init(G, bx);
        pg8::EpiOut E{args.in[0], args.in[1], args.out + OFF_Y, (bf16*)(ws + WS_HN), (float*)(ws + WS_SSQ), red, (float*)(ws + WS_PART)};
        pg8::gemm_phase<pg8::EpiOut, Ord, true, true>(lds, g, S, E);
        if (S.rem > 0) {
            xcd_barrier(xbar);
            PHASE_IDS();
            for (int w = gw; w < S.rem * 256; w += NGW) {
                const int tu = w >> 8, r = w & 255; pg8::Unit u; Ord::SO::unit(S.full * G + tu, u);
                const size_t row = (size_t)u.pm * 256 + r; const int col = u.pn * 256 + 4 * lane;
                const float* xin = row < NP ? args.in[0] + row * DM : args.in[1] + (row - NP) * DM;
                f32x4 v = *(const f32x4*)(xin + col);
                const float* p = (const float*)(ws + WS_PART) + (size_t)(tu * 8) * 65536 + r * 256 + 4 * lane;
#pragma unroll
                for (int s = 0; s < 8; ++s) v += *(const f32x4*)(p + (size_t)s * 65536);
                *(f32x4*)(args.out + OFF_Y + row * DM + col) = v;
                u32x2 pk; pk.x = pk2(v[0], v[1]); pk.y = pk2(v[2], v[3]); *(u32x2*)((bf16*)(ws + WS_HN) + row * DM + col) = pk;
                const float ss = wave_sum((v[0] * v[0] + v[1] * v[1]) + (v[2] * v[2] + v[3] * v[3]));
                if (lane == 0) ((float*)(ws + WS_SSQ))[row * 8 + u.pn] = ss;
            }
        }
    }
#endif
    xcd_barrier(xbar);

#ifndef NO_P5
    for (int rep_ = 0; rep_ < REP_P5; ++rep_) {
        pg8::Gemm g{(const pg8::bf16_t*)(ws + WS_HN), (const pg8::bf16_t*)(ws + WS_WGU), MT, 2 * DFF, DM}; typedef pg8::StaticOrderT<MT / 256, 2 * DFF / 256, DM / 64> Ord; Ord S; S.init(G, bx);
        pg8::EpiGU E{(bf16*)(ws + WS_H), (const float*)(ws + WS_SSQ)};
        pg8::gemm_phase<pg8::EpiGU, Ord, true, true>(lds, g, S, E);
    }
#endif
    xcd_barrier(xbar);

#ifndef NO_P6
    {
        pg8::Gemm g{(const pg8::bf16_t*)(ws + WS_H), (const pg8::bf16_t*)(ws + WS_WDN), MT, DM, DFF};
        typedef pg8::TailOrderT<MT / 256, DM / 256, DFF / 64, 8> Ord; Ord S; S.init(G, bx);
        pg8::EpiDown E{args.out + OFF_Y, (float*)(ws + WS_PART)};
        pg8::gemm_phase<pg8::EpiDown, Ord, true, true>(lds, g, S, E);
        if (S.rem > 0) {
            xcd_barrier(xbar);
            PHASE_IDS();
            for (int w = gw; w < S.rem * 256; w += NGW) {
                const int tu = w >> 8, r = w & 255; pg8::Unit u; Ord::SO::unit(S.full * G + tu, u);
                float* y = args.out + OFF_Y + ((size_t)u.pm * 256 + r) * DM + u.pn * 256 + 4 * lane;
                f32x4 v = *(const f32x4*)y;
                const float* p = (const float*)(ws + WS_PART) + (size_t)(tu * 8) * 65536 + r * 256 + 4 * lane;
#pragma unroll
                for (int s = 0; s < 8; ++s) v += *(const f32x4*)(p + (size_t)s * 65536);
                *(f32x4*)y = v;
            }
        }
    }
#endif
}

extern "C" void kernel_launch(void* const* d_in, const int* in_sizes, int n_in, void* d_out, int out_size, void* d_ws, size_t ws_size, hipStream_t stream) {
    static int grid = 0;
    if (grid == 0) {
        if (n_in != 17 || (size_t)out_size != OUT_TOTAL || ws_size < WS_END) { fprintf(stderr, "kernel_launch: unexpected shapes (n_in %d out %d ws %zu need %zu)\n", n_in, out_size, ws_size, (size_t)WS_END); grid = -1; return; }
        int dev = 0, cus = 0, per_cu = 0;
        hipGetDevice(&dev); hipDeviceGetAttribute(&cus, hipDeviceAttributeMultiprocessorCount, dev);
        hipFuncSetAttribute((const void*)fwd_megakernel, hipFuncAttributeMaxDynamicSharedMemorySize, LDS_BYTES);
        hipOccupancyMaxActiveBlocksPerMultiprocessor(&per_cu, (const void*)fwd_megakernel, NWAVES * 64, LDS_BYTES);
        if (per_cu < 1) { fprintf(stderr, "kernel_launch: occupancy query says %d blocks per CU\n", per_cu); per_cu = 1; }
        (void)hipGetLastError();
        grid = cus;
    }
    if (grid < 0) return;
    Args a{};
    for (int i = 0; i < 17; ++i) a.in[i] = (const float*)d_in[i];
    a.out = (float*)d_out; a.ws = (unsigned char*)d_ws;
    void* kargs[] = {&a};
    hipError_t e = hipLaunchCooperativeKernel((const void*)fwd_megakernel, dim3(grid), dim3(NWAVES * 64), kargs, LDS_BYTES, stream);
    if (e != hipSuccess) fprintf(stderr, "cooperative launch failed: %s (grid %d)\n", hipGetErrorString(e), grid);
}
```

```cpp
#include <hip/hip_runtime.h>
#include <hip/hip_cooperative_groups.h>
#include <cstdio>
#include <cstdint>
namespace cg = cooperative_groups;
namespace pg8 {
#define PG8_LAS __attribute__((address_space(3)))
typedef unsigned short bf16_t;
typedef short bf16x8 __attribute__((ext_vector_type(8)));
typedef float f32x4 __attribute__((ext_vector_type(4)));
typedef unsigned u32x4 __attribute__((ext_vector_type(4)));
constexpr int BM = 256, BK = 64, HALF = 128, HTB = HALF * BK * 2  , STAGE_BYTES = 8 * HTB, NXCD = 8, WGM = 8;

__host__ __device__ __forceinline__ int lds_byte(int r, int c) { const int st = (r >> 4) * 2 + (c >> 5), rr = r & 15, cc = c & 31, ob = rr * 64 + cc * 2; return st * 1024 + (ob ^ (((ob >> 9) & 1) << 5)); }
__host__ __device__ __forceinline__ void stage_rc(int b, int& R, int& C) { const int st = b / 1024, sb = b % 1024, swz = sb ^ (((sb >> 9) & 1) << 5); R = (st >> 1) * 16 + swz / 64; C = (st & 1) * 32 + (swz % 64) / 2; }
__host__ __device__ __forceinline__ int perm32(int rho) { const int n = rho >> 4, i = rho & 15; return 8 * (i >> 2) + 4 * n + (i & 3); }

struct Unit { int pm, pn, k0, nt, split, tu, sp; };
struct Gemm { const bf16_t* A; const bf16_t* Bt; int M, N, K; };

template <int NM, int NN, int NTK> struct StaticOrderT {
    static constexpr int nM = NM, nN = NN, nwg = NM * NN, ntk = NTK;
    int G, c;
    __host__ __device__ __forceinline__ void init(int G_, int c_) { G = G_; c = c_; }
    __host__ __device__ __forceinline__ bool next(int i, Unit& u) const { const int L = i * G + c; if (L >= nwg) return false; unit(L, u); return true; }
    __host__ __device__ __forceinline__ static void unit(int L, Unit& u) {
        int wgid = L; { constexpr int q = nwg / NXCD, r = nwg % NXCD; const int xcd = wgid % NXCD, off = wgid / NXCD; wgid = (xcd < r ? xcd * (q + 1) : r * (q + 1) + (xcd - r) * q) + off; }
        constexpr int nig = WGM * nN; const int gid = wgid / nig, fm = gid * WGM, gsz = (nM - fm) < WGM ? (nM - fm) : WGM;
        u.pm = fm + ((wgid % nig) % gsz); u.pn = (wgid % nig) / gsz; u.k0 = 0; u.nt = ntk; u.split = 0; u.tu = 0; u.sp = 0;
    }
    __device__ __forceinline__ void a_ready(const Unit&) const {}
    __device__ __forceinline__ void done(const Unit&) const {}
};
template <int NM, int NN, int NTK, int NSPLIT> struct TailOrderT {
    typedef StaticOrderT<NM, NN, NTK> SO;
    int G, c, full, rem;
    __host__ __device__ __forceinline__ void init(int G_, int c_) { G = G_; c = c_; full = SO::nwg / G; rem = SO::nwg - full * G; if (rem * NSPLIT > G || NTK < 2 * NSPLIT) { full = 1 << 24; rem = 0; } }
    __host__ __device__ __forceinline__ static int kstart(int s) { return s >= NSPLIT ? NTK : ((s * NTK / NSPLIT) & ~1); }
    __host__ __device__ __forceinline__ bool next(int i, Unit& u) const {
        if (i < full) { const int L = i * G + c; if (L >= SO::nwg) return false; SO::unit(L, u); return true; }
        if (i > full || c >= rem * NSPLIT) return false;
        const int tu = c / NSPLIT, sp = c % NSPLIT; SO::unit(full * G + tu, u); u.k0 = kstart(sp); u.nt = kstart(sp + 1) - u.k0; u.split = 1; u.tu = tu; u.sp = sp; return true;
    }
    __device__ __forceinline__ void a_ready(const Unit&) const {}
    __device__ __forceinline__ void done(const Unit&) const {}
};

struct InProjOrder {
    typedef StaticOrderT<30, 24, 32> SO;
    int G, c;
    __host__ __device__ __forceinline__ void init(int G_, int c_) { G = G_; c = c_; }
    __host__ __device__ __forceinline__ bool next(int i, Unit& u) const {
        const int L = i * G + c; if (L >= 768) return false;
        if (L < 720) { SO::unit(L, u); return true; }
        const int j = L - 720; u.pm = 30 + (j & 3); u.pn = j >> 2; u.k0 = 0; u.nt = 32; u.split = 0; u.tu = 0; u.sp = 0; return true;
    }
    __device__ __forceinline__ void a_ready(const Unit&) const {}
    __device__ __forceinline__ void done(const Unit&) const {}
};
struct OneUnit {
    Unit u0;
    __host__ __device__ __forceinline__ bool next(int i, Unit& u) const { if (i != 0) return false; u = u0; return true; }
    __device__ __forceinline__ void a_ready(const Unit&) const {}
    __device__ __forceinline__ void done(const Unit&) const {}
};

__device__ __forceinline__ unsigned cvt_pk_bf16(float lo, float hi) { unsigned r; asm volatile("v_cvt_pk_bf16_f32 %0, %1, %2" : "=v"(r) : "v"(lo), "v"(hi)); return r; }
typedef float f32x2 __attribute__((ext_vector_type(2)));
#define PG8_LBAR() asm volatile("s_waitcnt lgkmcnt(0)\n\ts_barrier" ::: "memory")
constexpr int NPROMPT = 8192;
__device__ __forceinline__ u32x4 pack8(const f32x4 a, const f32x4 b) { u32x4 w; w.x = cvt_pk_bf16(a[0], a[1]); w.y = cvt_pk_bf16(a[2], a[3]); w.z = cvt_pk_bf16(b[0], b[1]); w.w = cvt_pk_bf16(b[2], b[3]); return w; }


__device__ __forceinline__ void store_partial(float* part, int nsplit, const f32x4 (&acc)[2][2][4][2], const Unit& u, int wr, int wc, int fr, int fq) {
    float* pt = part + (size_t)(u.tu * nsplit + u.sp) * 65536; int rl0 = wr * 64 + fr, cw = wc * 32 + 8 * fq; asm volatile("" : "+v"(rl0), "+v"(cw));
#pragma unroll
    for (int ai = 0; ai < 2; ++ai)
#pragma unroll
        for (int m = 0; m < 4; ++m)
#pragma unroll
            for (int bj = 0; bj < 2; ++bj) { float* o = pt + (ai * HALF + rl0 + m * 16) * 256 + bj * HALF + cw; *(f32x4*)o = acc[ai][bj][m][0]; *(f32x4*)(o + 4) = acc[ai][bj][m][1]; }
}

struct EpiIn {
    static constexpr bool PERM = true, AFTER_DRAIN = false;
    bf16_t *Q, *Kb, *Vb, *GB, *U; float* out; const float *gq, *gk; PG8_LAS float* red; float qscale;
    size_t off_kp, off_vp, off_cp, off_ks, off_vs, off_cs;
    __device__ __forceinline__ void operator()(const f32x4 (&acc)[2][2][4][2], const Unit& u, int wr, int wc, int fr, int fq) const {
        int rl0 = wr * 64 + fr, cw = wc * 32 + 8 * fq; asm volatile("" : "+v"(rl0), "+v"(cw));
        const int pn = u.pn, rowt = u.pm * BM;
        const bool prompt = rowt < NPROMPT;
        if (pn < 8) {
            const bool isq = pn < 4;
#pragma unroll
            for (int ai = 0; ai < 2; ++ai)
#pragma unroll
                for (int m = 0; m < 4; ++m)
#pragma unroll
                    for (int bj = 0; bj < 2; ++bj) {
                        const f32x4 a = acc[ai][bj][m][0], b = acc[ai][bj][m][1];
                        float s = (a[0] * a[0] + a[1] * a[1]) + (a[2] * a[2] + a[3] * a[3]) + (b[0] * b[0] + b[1] * b[1]) + (b[2] * b[2] + b[3] * b[3]);
                        s += __shfl_xor(s, 16); s += __shfl_xor(s, 32);
                        if (fq == 0) red[((ai * HALF + rl0 + m * 16) * 2 + bj) * 4 + wc] = s;
                    }
            PG8_LBAR();
            const float* g = isq ? gq : gk;
            const f32x4 g0 = *(const f32x4*)(g + cw), g1 = *(const f32x4*)(g + cw + 4);
#pragma unroll
            for (int ai = 0; ai < 2; ++ai)
#pragma unroll
                for (int m = 0; m < 4; ++m) {
                    const int rl = ai * HALF + rl0 + m * 16; const size_t row = (size_t)(rowt + rl);
#pragma unroll
                    for (int bj = 0; bj < 2; ++bj) {
                        const f32x4 p = *(const PG8_LAS f32x4*)(red + (rl * 2 + bj) * 4);
                        float rs = __builtin_amdgcn_rsqf(((p[0] + p[1]) + (p[2] + p[3])) * (1.0f / 128.0f) + 1e-6f);
                        if (isq) rs *= qscale;
                        const f32x4 v0 = acc[ai][bj][m][0] * rs * g0, v1 = acc[ai][bj][m][1] * rs * g1;
                        if (isq) { *(u32x4*)(Q + row * 1024 + pn * 256 + bj * HALF + cw) = pack8(v0, v1); }
                        else {
                            const int col = (pn - 4) * 256 + bj * HALF + cw;
                            float* o = prompt ? out + off_kp + row * 1024 + col : out + off_ks + (row - NPROMPT) * 1024 + col;
                            *(f32x4*)o = v0; *(f32x4*)(o + 4) = v1;
                            if (prompt) *(u32x4*)(Kb + row * 1024 + col) = pack8(v0, v1);
                        }
                    }
                }
        } else if (pn < 12) {
#pragma unroll
            for (int ai = 0; ai < 2; ++ai)
#pragma unroll
                for (int m = 0; m < 4; ++m) {
                    const size_t row = (size_t)(rowt + ai * HALF + rl0 + m * 16);
#pragma unroll
                    for (int bj = 0; bj < 2; ++bj) {
                        const int col = (pn - 8) * 256 + bj * HALF + cw; const f32x4 v0 = acc[ai][bj][m][0], v1 = acc[ai][bj][m][1];
                        float* o = prompt ? out + off_vp + row * 1024 + col : out + off_vs + (row - NPROMPT) * 1024 + col;
                        *(f32x4*)o = v0; *(f32x4*)(o + 4) = v1;
                        if (prompt) *(u32x4*)(Vb + row * 1024 + col) = pack8(v0, v1);
                    }
                }
        } else if (pn < 16) {
#pragma unroll
            for (int ai = 0; ai < 2; ++ai)
#pragma unroll
                for (int m = 0; m < 4; ++m) {
                    const size_t row = (size_t)(rowt + ai * HALF + rl0 + m * 16);
#pragma unroll
                    for (int bj = 0; bj < 2; ++bj) *(u32x4*)(GB + row * 1024 + (pn - 12) * 256 + bj * HALF + cw) = pack8(acc[ai][bj][m][0], acc[ai][bj][m][1]);
                }
        } else {
#pragma unroll
            for (int ai = 0; ai < 2; ++ai)
#pragma unroll
                for (int m = 0; m < 4; ++m) {
                    const int rowi = rowt + ai * HALF + rl0 + m * 16; const int ch = (pn - 16) * HALF + cw;
                    const f32x4 v0 = acc[ai][0][m][0] * acc[ai][1][m][0], v1 = acc[ai][0][m][1] * acc[ai][1][m][1];
                    *(u32x4*)(U + (size_t)rowi * 1024 + ch) = pack8(v0, v1);
                    if (prompt) { const int t = rowi & 4095; if (t >= 4094) { float* o = out + off_cp + ((rowi >> 12) * 2 + (t - 4094)) * 1024 + ch; *(f32x4*)o = v0; *(f32x4*)(o + 4) = v1; } }
                    else { const int rs_ = rowi - NPROMPT, t = rs_ & 63; if (t >= 62) { float* o = out + off_cs + ((rs_ >> 6) * 2 + (t - 62)) * 1024 + ch; *(f32x4*)o = v0; *(f32x4*)(o + 4) = v1; } }
                }
        }
    }
};

struct EpiOut {
    static constexpr bool PERM = true, AFTER_DRAIN = false;
    const float *xp, *xs; float* Y; bf16_t* X1; float* ssq; PG8_LAS float* red; float* part;
    __device__ __forceinline__ void operator()(const f32x4 (&acc)[2][2][4][2], const Unit& u, int wr, int wc, int fr, int fq) const {
        if (u.split) { store_partial(part, 8, acc, u, wr, wc, fr, fq); return; }
        int rl0 = wr * 64 + fr, cw = wc * 32 + 8 * fq; asm volatile("" : "+v"(rl0), "+v"(cw));
        const int pn = u.pn, rowt = u.pm * BM;
        const float* xin = rowt < NPROMPT ? xp + (size_t)rowt * 2048 : xs + (size_t)(rowt - NPROMPT) * 2048;
#pragma unroll
        for (int ai = 0; ai < 2; ++ai)
#pragma unroll
            for (int m = 0; m < 4; ++m) {
                const int rl = ai * HALF + rl0 + m * 16; float s = 0.f;
#pragma unroll
                for (int bj = 0; bj < 2; ++bj) {
                    const int col = pn * 256 + bj * HALF + cw; const float* xi = xin + (size_t)rl * 2048 + col;
                    const f32x4 v0 = *(const f32x4*)xi + acc[ai][bj][m][0], v1 = *(const f32x4*)(xi + 4) + acc[ai][bj][m][1];
                    *(u32x4*)(X1 + (size_t)(rowt + rl) * 2048 + col) = pack8(v0, v1);
                    s += (v0[0] * v0[0] + v0[1] * v0[1]) + (v0[2] * v0[2] + v0[3] * v0[3]) + (v1[0] * v1[0] + v1[1] * v1[1]) + (v1[2] * v1[2] + v1[3] * v1[3]);
                    asm volatile("" ::: "memory");
                }
                s += __shfl_xor(s, 16); s += __shfl_xor(s, 32);
                if (fq == 0) red[rl * 4 + wc] = s;
                asm volatile("" ::: "memory");
            }
        PG8_LBAR();
        if (threadIdx.x < 256) { const f32x4 p = *(const PG8_LAS f32x4*)(red + threadIdx.x * 4); ssq[(size_t)(rowt + threadIdx.x) * 8 + pn] = (p[0] + p[1]) + (p[2] + p[3]); }
        PG8_LBAR();
    }
};

struct EpiGU {
    static constexpr bool PERM = true, AFTER_DRAIN = false;
    bf16_t* H; const float* ssq;
    __device__ __forceinline__ void operator()(const f32x4 (&acc)[2][2][4][2], const Unit& u, int wr, int wc, int fr, int fq) const {
        int rl0 = wr * 64 + fr, cw = wc * 32 + 8 * fq; asm volatile("" : "+v"(rl0), "+v"(cw));
        const int pn = u.pn, rowt = u.pm * BM;
#pragma unroll
        for (int ai = 0; ai < 2; ++ai)
#pragma unroll
            for (int m = 0; m < 4; ++m) {
                const size_t row = (size_t)(rowt + ai * HALF + rl0 + m * 16);
                const f32x4 p0 = *(const f32x4*)(ssq + row * 8), p1 = *(const f32x4*)(ssq + row * 8 + 4);
                const float rs = __builtin_amdgcn_rsqf((((p0[0] + p0[1]) + (p0[2] + p0[3])) + ((p1[0] + p1[1]) + (p1[2] + p1[3]))) * (1.0f / 2048.0f) + 1e-6f);
                f32x4 h[2];
#pragma unroll
                for (int n = 0; n < 2; ++n) {
                    const f32x4 g = acc[ai][0][m][n] * rs, up = acc[ai][1][m][n] * rs;
#pragma unroll
                    for (int j = 0; j < 4; ++j) h[n][j] = g[j] * __builtin_amdgcn_rcpf(1.0f + __builtin_amdgcn_exp2f(-1.4426950408889634f * g[j])) * up[j];
                }
                *(u32x4*)(H + row * 5632 + pn * HALF + cw) = pack8(h[0], h[1]);
            }
    }
};

struct EpiDown {
    static constexpr bool PERM = true, AFTER_DRAIN = false;
    float* Y; float* part; const bf16_t* X1;
    __device__ __forceinline__ void operator()(const f32x4 (&acc)[2][2][4][2], const Unit& u, int wr, int wc, int fr, int fq) const {
        if (u.split) { store_partial(part, 8, acc, u, wr, wc, fr, fq); return; }
        int rl0 = wr * 64 + fr, cw = wc * 32 + 8 * fq; asm volatile("" : "+v"(rl0), "+v"(cw));
        const int pn = u.pn, rowt = u.pm * BM;
#pragma unroll
        for (int ai = 0; ai < 2; ++ai)
#pragma unroll
            for (int m = 0; m < 4; ++m)
#pragma unroll
                for (int bj = 0; bj < 2; ++bj) {
                    const size_t off = (size_t)(rowt + ai * HALF + rl0 + m * 16) * 2048 + pn * 256 + bj * HALF + cw;
                    const u32x4 xb = *(const u32x4*)(X1 + off);
                    f32x4 b0, b1; b0[0] = __builtin_bit_cast(float, xb.x << 16); b0[1] = __builtin_bit_cast(float, xb.x & 0xffff0000u); b0[2] = __builtin_bit_cast(float, xb.y << 16); b0[3] = __builtin_bit_cast(float, xb.y & 0xffff0000u);
                    b1[0] = __builtin_bit_cast(float, xb.z << 16); b1[1] = __builtin_bit_cast(float, xb.z & 0xffff0000u); b1[2] = __builtin_bit_cast(float, xb.w << 16); b1[3] = __builtin_bit_cast(float, xb.w & 0xffff0000u);
                    float* o = Y + off; *(f32x4*)o = b0 + acc[ai][bj][m][0]; *(f32x4*)(o + 4) = b1 + acc[ai][bj][m][1];
                    if (bj) asm volatile("" ::: "memory");
                }
    }
};

struct EpiNone {
    static constexpr bool PERM = true, AFTER_DRAIN = false;
    float* sink;
    __device__ __forceinline__ void operator()(const f32x4 (&acc)[2][2][4][2], const Unit& u, int wr, int wc, int fr, int fq) const {
        if (acc[0][0][0][0][0] == 12345.678f && acc[1][1][3][1][3] == -9876.5f) sink[0] = 1.f;
    }
};
template <class Epi, class Sched, bool ALIGN_EPI = false, bool SP2 = false>
__device__ __forceinline__ void gemm_phase(PG8_LAS unsigned char* lds, const Gemm g, const Sched& S, const Epi& E) {
    int tid_ = threadIdx.x; asm volatile("" : "+v"(tid_));
    const int tid = tid_, wid = __builtin_amdgcn_readfirstlane(tid >> 6), lane = tid & 63, wr = wid >> 2, wc = wid & 3, fr = lane & 15, fq = lane >> 4;
    const int K = g.K;
    unsigned voffA[2], voffB[2];
#pragma unroll
    for (int i = 0; i < 2; ++i) { int R, C; stage_rc(tid * 16 + i * 8192, R, C); const int Rb = Epi::PERM ? ((R & ~31) + perm32(R & 31)) : R;
        voffA[i] = (unsigned)(R * K + C) * 2u; voffB[i] = (unsigned)(Rb * K + C) * 2u; }
    const size_t kstep = (size_t)(BK * 2);
    const size_t hstep = (size_t)HALF * K * 2;
    const size_t tstep = 2 * hstep;
    const unsigned ldsw = (unsigned)wid * 1024u;
    const int aoff = lds_byte(wr * 64 + fr, fq * 8), boff = lds_byte(wc * 32 + fr, fq * 8);
#define PG8_SA(b, h) (((b) * 2 + (h)) * HTB)
#define PG8_SB(b, h) ((4 + (b) * 2 + (h)) * HTB)
#define PG8_STAGE(bufoff, gbase, voff) do { _Pragma("unroll") for (int _i = 0; _i < 2; ++_i) \
        __builtin_amdgcn_global_load_lds((const unsigned*)((const char*)(gbase) + (voff)[_i]), (PG8_LAS unsigned*)(lds + (bufoff) + ldsw + _i * 8192), 16, 0, 0); } while (0)
#define PG8_LDA(dst, b, h) do { _Pragma("unroll") for (int m = 0; m < 4; ++m) _Pragma("unroll") for (int k = 0; k < 2; ++k) dst[m][k] = *(const PG8_LAS bf16x8*)(lds + PG8_SA(b, h) + aoff + m * 2048 + k * 1024); } while (0)
#define PG8_LDB(dst, b, h) do { _Pragma("unroll") for (int n = 0; n < 2; ++n) _Pragma("unroll") for (int k = 0; k < 2; ++k) dst[n][k] = *(const PG8_LAS bf16x8*)(lds + PG8_SB(b, h) + boff + n * 2048 + k * 1024); } while (0)
#define PG8_MMA(ai, bj, At, Bt) do { __builtin_amdgcn_s_setprio(1); _Pragma("unroll") for (int m = 0; m < 4; ++m) _Pragma("unroll") for (int n = 0; n < 2; ++n) _Pragma("unroll") for (int k = 0; k < 2; ++k) \
        acc[ai][bj][m][n] = __builtin_amdgcn_mfma_f32_16x16x32_bf16(Bt[n][k], At[m][k], acc[ai][bj][m][n], 0, 0, 0); __builtin_amdgcn_s_setprio(0); } while (0)
#define PG8_WAIT_V(n) asm volatile("s_waitcnt vmcnt(" #n ")" ::: "memory")
#define PG8_WAIT_L(n) asm volatile("s_waitcnt lgkmcnt(" #n ")" ::: "memory")
#define PG8_BAR __builtin_amdgcn_s_barrier()
#define PG8_SCHED __builtin_amdgcn_sched_barrier(0)
    Unit cur, nxt; int ui = 0;
    if (!S.next(0, cur)) return;
    f32x4 acc[2][2][4][2];
#pragma unroll
    for (int a = 0; a < 2; ++a)
#pragma unroll
        for (int b = 0; b < 2; ++b)
#pragma unroll
            for (int m = 0; m < 4; ++m)
#pragma unroll
                for (int n = 0; n < 2; ++n) acc[a][b][m][n] = (f32x4){0.f, 0.f, 0.f, 0.f};
    bf16x8 At[4][2], B0[2][2], B1[2][2];
    const char* cA = (const char*)g.A + (size_t)cur.pm * tstep + (size_t)cur.k0 * kstep; const char* cB = (const char*)g.Bt + (size_t)cur.pn * tstep + (size_t)cur.k0 * kstep;
    S.a_ready(cur);
    if constexpr (SP2) {
        PG8_STAGE(PG8_SB(0, 0), cB, voffB); PG8_STAGE(PG8_SB(0, 1), cB + hstep, voffB); PG8_STAGE(PG8_SA(0, 0), cA, voffA); PG8_STAGE(PG8_SA(0, 1), cA + hstep, voffA);
        if (wr == 1) PG8_BAR;
        PG8_WAIT_V(2); PG8_BAR;
        PG8_STAGE(PG8_SB(1, 0), cB + kstep, voffB); PG8_STAGE(PG8_SA(1, 0), cA + kstep, voffA); PG8_STAGE(PG8_SB(1, 1), cB + hstep + kstep, voffB);
        PG8_WAIT_V(6); PG8_BAR;
    } else {
        PG8_STAGE(PG8_SB(0, 0), cB, voffB); PG8_STAGE(PG8_SA(0, 0), cA, voffA); PG8_STAGE(PG8_SB(0, 1), cB + hstep, voffB); PG8_STAGE(PG8_SA(0, 1), cA + hstep, voffA);
        if (wr == 1) PG8_BAR;
        PG8_WAIT_V(4); PG8_BAR;
        PG8_STAGE(PG8_SB(1, 0), cB + kstep, voffB); PG8_STAGE(PG8_SA(1, 0), cA + kstep, voffA); PG8_STAGE(PG8_SB(1, 1), cB + hstep + kstep, voffB);
        PG8_WAIT_V(6); PG8_BAR;
    }
    for (;;) {
        const bool has_next = S.next(ui + 1, nxt);
        const char* nA = has_next ? (const char*)g.A + (size_t)nxt.pm * tstep + (size_t)nxt.k0 * kstep : cA; const char* nB = has_next ? (const char*)g.Bt + (size_t)nxt.pn * tstep + (size_t)nxt.k0 * kstep : cB;
        const int nt = cur.nt;
        for (int t = 0; t < nt; t += 2) {
            const bool last = (t == nt - 2);
            const char* a1 = cA + (size_t)(t + 1) * kstep;
            const char* a2 = last ? nA : cA + (size_t)(t + 2) * kstep; const char* b2 = last ? nB : cB + (size_t)(t + 2) * kstep;
            const char* a3 = a2 + kstep; const char* b3 = b2 + kstep;
            if (last && has_next) S.a_ready(nxt);
            if constexpr (SP2) {
            PG8_LDB(B0, 0, 0); PG8_LDB(B1, 0, 1); PG8_SCHED; PG8_LDA(At, 0, 0); PG8_STAGE(PG8_SA(1, 1), a1 + hstep, voffA);
            PG8_WAIT_V(8); PG8_WAIT_L(0); PG8_BAR; PG8_MMA(0, 0, At, B0); PG8_MMA(0, 1, At, B1); PG8_BAR; PG8_SCHED;
            PG8_LDA(At, 0, 1); PG8_STAGE(PG8_SB(0, 0), b2, voffB); PG8_STAGE(PG8_SB(0, 1), b2 + hstep, voffB); PG8_STAGE(PG8_SA(0, 0), a2, voffA);
            PG8_WAIT_V(8); PG8_WAIT_L(0); PG8_BAR; PG8_MMA(1, 0, At, B0); PG8_MMA(1, 1, At, B1); PG8_BAR; PG8_SCHED;
            PG8_LDB(B0, 1, 0); PG8_LDB(B1, 1, 1); PG8_SCHED; PG8_LDA(At, 1, 0); PG8_STAGE(PG8_SA(0, 1), a2 + hstep, voffA);
            PG8_WAIT_V(8); PG8_WAIT_L(0); PG8_BAR; PG8_MMA(0, 0, At, B0); PG8_MMA(0, 1, At, B1); PG8_BAR; PG8_SCHED;
            PG8_LDA(At, 1, 1); PG8_STAGE(PG8_SB(1, 0), b3, voffB); PG8_STAGE(PG8_SB(1, 1), b3 + hstep, voffB); PG8_STAGE(PG8_SA(1, 0), a3, voffA);
            PG8_WAIT_V(8); PG8_WAIT_L(0); PG8_BAR; PG8_MMA(1, 0, At, B0); PG8_MMA(1, 1, At, B1); PG8_BAR; PG8_SCHED;
            } else {
            PG8_LDB(B0, 0, 0); PG8_SCHED; PG8_LDA(At, 0, 0); PG8_STAGE(PG8_SA(1, 1), a1 + hstep, voffA);
            PG8_WAIT_L(8); PG8_BAR; PG8_WAIT_L(0); PG8_MMA(0, 0, At, B0); PG8_BAR; PG8_SCHED;
            PG8_LDB(B1, 0, 1); PG8_STAGE(PG8_SB(0, 0), b2, voffB);
            PG8_BAR; PG8_WAIT_L(0); PG8_MMA(0, 1, At, B1); PG8_BAR;
            PG8_LDA(At, 0, 1); PG8_STAGE(PG8_SA(0, 0), a2, voffA);
            PG8_BAR; PG8_WAIT_L(0); PG8_MMA(1, 0, At, B0); PG8_BAR; PG8_SCHED;
            PG8_STAGE(PG8_SB(0, 1), b2 + hstep, voffB);
            PG8_WAIT_V(6); PG8_BAR; PG8_MMA(1, 1, At, B1); PG8_BAR;
            PG8_LDB(B0, 1, 0); PG8_SCHED; PG8_LDA(At, 1, 0); PG8_STAGE(PG8_SA(0, 1), a2 + hstep, voffA);
            PG8_WAIT_L(8); PG8_BAR; PG8_WAIT_L(0); PG8_MMA(0, 0, At, B0); PG8_BAR; PG8_SCHED;
            PG8_LDB(B1, 1, 1); PG8_STAGE(PG8_SB(1, 0), b3, voffB);
            PG8_BAR; PG8_WAIT_L(0); PG8_MMA(0, 1, At, B1); PG8_BAR;
            PG8_LDA(At, 1, 1); PG8_STAGE(PG8_SA(1, 0), a3, voffA);
            PG8_BAR; PG8_WAIT_L(0); PG8_MMA(1, 0, At, B0); PG8_BAR; PG8_SCHED;
            PG8_STAGE(PG8_SB(1, 1), b3 + hstep, voffB);
            PG8_WAIT_V(6); PG8_BAR; PG8_MMA(1, 1, At, B1); PG8_BAR;
            }
        }
        if constexpr (ALIGN_EPI) { if (wr == 0) PG8_BAR; }
        if constexpr (!Epi::AFTER_DRAIN) { E(acc, cur, wr, wc, fr, fq); S.done(cur); }
        if (!has_next) break;
#pragma unroll
        for (int a = 0; a < 2; ++a)
#pragma unroll
            for (int b = 0; b < 2; ++b)
#pragma unroll
                for (int m = 0; m < 4; ++m)
#pragma unroll
                    for (int n = 0; n < 2; ++n) acc[a][b][m][n] = (f32x4){0.f, 0.f, 0.f, 0.f};
        cur = nxt; cA = nA; cB = nB; ++ui;
        if constexpr (ALIGN_EPI) { if (wr == 1) PG8_BAR; }
    }
    PG8_WAIT_V(0);
    if constexpr (!ALIGN_EPI) { if (wr == 0) PG8_BAR; }
    PG8_BAR;
    if constexpr (Epi::AFTER_DRAIN) { E.fused(acc, cur, wr, wc, fr, fq, lds, wid, lane); S.done(cur); }
#undef PG8_SA
#undef PG8_SB
#undef PG8_STAGE
#undef PG8_LDA
#undef PG8_LDB
#undef PG8_MMA
#undef PG8_WAIT_V
#undef PG8_WAIT_L
#undef PG8_BAR
#undef PG8_SCHED
}
}
#define LAS __attribute__((address_space(3)))
typedef unsigned short bf16;
typedef float f32x4 __attribute__((ext_vector_type(4)));
typedef float f32x16 __attribute__((ext_vector_type(16)));
typedef short bf16x8 __attribute__((ext_vector_type(8)));
typedef short s16x4 __attribute__((ext_vector_type(4)));
typedef unsigned u32x4 __attribute__((ext_vector_type(4)));
typedef unsigned u32x2 __attribute__((ext_vector_type(2)));
constexpr int DM = 2048, SEQ = 4096, NP = 8192, NS = 512, MT = NP + NS, AW = 1024, CC = 1024, INC = 6144, DFF = 5632, PAST = 4096, DSEQ = 64;
constexpr float EPS = 1e-6f;
constexpr size_t OFF_Y = 0, OFF_KP = (size_t)MT * DM, OFF_VP = OFF_KP + (size_t)NP * AW, OFF_CP = OFF_VP + (size_t)NP * AW, OFF_KS = OFF_CP + 2 * 2 * CC,
                 OFF_VS = OFF_KS + (size_t)NS * AW, OFF_CS = OFF_VS + (size_t)NS * AW, OUT_TOTAL = OFF_CS + 8 * 2 * CC;
static_assert(OUT_TOTAL == 35672064, "output size");
constexpr size_t MiB = 1u << 20;
constexpr size_t WS_CTL = 0, WS_WIN = 1 * MiB, WS_WOUT = 25 * MiB, WS_WGU = 33 * MiB, WS_WDN = 77 * MiB, WS_HN = 99 * MiB, WS_Q = 133 * MiB, WS_K = 150 * MiB, WS_V = 166 * MiB,
                 WS_GB = 182 * MiB, WS_U = 199 * MiB, WS_MIX = 216 * MiB, WS_SSQ = 250 * MiB, WS_TP = 251 * MiB, WS_OP = 256 * MiB, WS_H = 256 * MiB, WS_PART = 133 * MiB  ;
constexpr int NSLOT = 256 + 16;
constexpr size_t WS_END = WS_OP + (size_t)NSLOT * 131072;
constexpr int RING_BYTES = 131072, RED_OFF = RING_BYTES, MISC_OFF = RED_OFF + 8192, LDS_BYTES = 147456;
constexpr int NWAVES = 8;

#define XB_TMO      128
#define XB_XCNT(j)  (256  + 64 * (j))
#define XB_XSUB(j)  (1280 + 64 * (j))
#define XB_XGEN(j)  (2304 + 64 * (j))
#define XB_TOP      3328
#define XB_TOPGEN   3392
#define XCD_BAR_WORDS 3456
#define XB_SPIN_CAP (1u << 18)

__device__ __forceinline__ unsigned xb_ld(unsigned* p)              { return __hip_atomic_load(p, __ATOMIC_RELAXED, __HIP_MEMORY_SCOPE_AGENT); }
__device__ __forceinline__ unsigned xb_add(unsigned* p, unsigned v) { return __hip_atomic_fetch_add(p, v, __ATOMIC_RELAXED, __HIP_MEMORY_SCOPE_AGENT); }
__device__ __forceinline__ unsigned xb_xcc_id() { return (unsigned)__builtin_amdgcn_s_getreg((3 << 11) | 20) & 0xFu; }
#define XB_SPIN(cond, bar) do { unsigned _sp = 0; while (cond) { __builtin_amdgcn_s_sleep(1); \
    if ((++_sp & 255u) == 0u) { if (xb_ld(&(bar)[XB_TMO])) break; if (_sp > XB_SPIN_CAP) { atomicAdd(&(bar)[XB_TMO], 1u); break; } } } } while (0)

struct XcdBarrier {
    unsigned* bar; unsigned x;
    volatile LAS unsigned* st;
};

__device__ __forceinline__ XcdBarrier xcd_barrier_post(unsigned* bar, volatile LAS unsigned* st) {
    XcdBarrier b; b.bar = bar; b.x = xb_xcc_id(); b.st = st;
    if (threadIdx.x == 0) (void)xb_add(&bar[XB_XCNT(b.x)], 1u);
    return b;
}
__device__ __forceinline__ void xcd_barrier_complete(unsigned* bar, unsigned x, unsigned& nloc, unsigned& nx) {
    const unsigned G = gridDim.x * gridDim.y * gridDim.z;
    unsigned sum, cnt, mine, sp = 0u;
    for (;;) {
        sum = 0u; cnt = 0u; mine = 0u;
#pragma unroll
        for (unsigned j = 0; j < 16; ++j) { const unsigned c = xb_ld(&bar[XB_XCNT(j)]); sum += c; cnt += (c > 0u) ? 1u : 0u; mine = (j == x) ? c : mine; }
        if (sum == G) break;
        __builtin_amdgcn_s_sleep(1);
        if ((++sp & 255u) == 0u) { if (xb_ld(&bar[XB_TMO])) break; if (sp > XB_SPIN_CAP) { atomicAdd(&bar[XB_TMO], 1u); break; } }
    }
    nloc = mine > 0u ? mine : 1u; nx = cnt > 0u ? cnt : 1u;
}

__device__ __forceinline__ void xcd_barrier(const XcdBarrier& b) {
    asm volatile("s_waitcnt vmcnt(0)" ::: "memory");
    __syncthreads();
    if (threadIdx.x == 0) {
        unsigned* bar = b.bar;
        __builtin_amdgcn_s_waitcnt(0);
        unsigned nloc = b.st[0], nx = b.st[1];
        if (nloc == 0u) { xcd_barrier_complete(bar, b.x, nloc, nx); b.st[0] = nloc; b.st[1] = nx; }
        const unsigned old = xb_add(&bar[XB_XSUB(b.x)], 1u);
        const unsigned gen = old / nloc;
        if (old + 1u == (gen + 1u) * nloc) {
            __builtin_amdgcn_fence(__ATOMIC_RELEASE, "agent");
            asm volatile("s_waitcnt vmcnt(0)" ::: "memory");
            const unsigned og = xb_add(&bar[XB_TOP], 1u);
            const unsigned tg = og / nx;
            if (og + 1u == (tg + 1u) * nx) xb_add(&bar[XB_TOPGEN], 1u);
            else XB_SPIN(xb_ld(&bar[XB_TOPGEN]) == tg, bar);
            __builtin_amdgcn_fence(__ATOMIC_ACQUIRE, "agent");
            xb_add(&bar[XB_XGEN(b.x)], 1u);
            asm volatile("s_waitcnt vmcnt(0)" ::: "memory");
        } else {
            XB_SPIN(xb_ld(&bar[XB_XGEN(b.x)]) == gen, bar);
            __builtin_amdgcn_fence(__ATOMIC_ACQUIRE, "agent");
            asm volatile("s_waitcnt vmcnt(0)" ::: "memory");
        }
    }
    __syncthreads();
}

struct ItemTab { int n; int v[272]; };
constexpr int p_nsteps(int qb, int c) { return 8 * (qb + 1); }
constexpr ItemTab make_items() {
    ItemTab t{}; t.n = 0;
    for (int b = 0; b < 8; ++b) for (int hg = 0; hg < 2; ++hg) t.v[t.n++] = 1 | (b << 1) | (hg << 4);
    for (int qb = 15; qb >= 0; --qb) for (int bh = 0; bh < 16; ++bh) t.v[t.n++] = (bh << 1) | (qb << 5);
    return t;
}
__device__ const ItemTab g_items = make_items();

__device__ __forceinline__ unsigned f2bf(float f) { unsigned u = __builtin_bit_cast(unsigned, f); return (u + 0x7fffu + ((u >> 16) & 1u)) >> 16; }
__device__ __forceinline__ unsigned pk2(float lo, float hi) { return pg8::cvt_pk_bf16(lo, hi); }
__device__ __forceinline__ float bflo(unsigned w) { return __builtin_bit_cast(float, w << 16); }
__device__ __forceinline__ float bfhi(unsigned w) { return __builtin_bit_cast(float, w & 0xffff0000u); }
__device__ __forceinline__ int crow(int r, int hi) { return (r & 3) + 8 * (r >> 2) + 4 * hi; }
__device__ __forceinline__ float wave_sum(float v) {
#pragma unroll
    for (int o = 1; o < 64; o <<= 1) v += __shfl_xor(v, o);
    return v;
}

struct Args { const float* in[17]; float* out; unsigned char* ws; };

struct P0Item { const float* src; const float* gk; bf16* dst; int N, K, k0; };
__device__ __forceinline__ P0Item p0_decode(const Args& a, int it) {
    constexpr int I_IN = 32 * 192, I_OUT = 32 * 64, I_G = 32 * 176;
    unsigned char* ws = a.ws; P0Item r; int n0, kb, drow; r.gk = nullptr;
    if (it < I_IN) { kb = it / 192; n0 = 32 * (it % 192); drow = n0;
        if (n0 >= 5120) { const int ch = n0 - 5120; drow = 4096 + (ch >> 7) * 256 + 128 + (ch & 127); } else if (n0 >= 4096) { const int ch = n0 - 4096; drow = 4096 + (ch >> 7) * 256 + (ch & 127); }
        r.src = a.in[6]; r.N = INC; r.K = DM; r.dst = (bf16*)(ws + WS_WIN); }
    else if ((it -= I_IN) < I_OUT) { kb = it / 64; n0 = 32 * (it % 64); drow = n0; r.src = a.in[12]; r.N = DM; r.K = DM; r.dst = (bf16*)(ws + WS_WOUT); }
    else if ((it -= I_OUT) < 2 * I_G) { const int up = it >= I_G; if (up) it -= I_G; kb = it / 176; n0 = 32 * (it % 176); drow = (n0 >> 7) * 256 + up * 128 + (n0 & 127);
        r.src = a.in[up ? 15 : 14]; r.N = DFF; r.K = DM; r.dst = (bf16*)(ws + WS_WGU); r.gk = a.in[13]; }
    else { it -= 2 * I_G; kb = it / 64; n0 = 32 * (it % 64); drow = n0; r.src = a.in[16]; r.N = DM; r.K = DFF; r.dst = (bf16*)(ws + WS_WDN); }
    r.k0 = 64 * kb; r.src += (size_t)r.k0 * r.N + n0; r.dst += (size_t)drow * r.K + r.k0;
    return r;
}
__device__ __forceinline__ void p0_load(const P0Item& p, f32x4 (&v)[8], int lane) {
#pragma unroll
    for (int j = 0; j < 8; ++j) v[j] = __builtin_nontemporal_load((const f32x4*)(p.src + (size_t)(8 * j + (lane >> 3)) * p.N + 4 * (lane & 7)));
}
__device__ __forceinline__ void p0_finish(const P0Item& p, const f32x4 (&v)[8], LAS float* scr, int lane) {
#pragma unroll
    for (int j = 0; j < 8; ++j) { const int kk = 8 * j + (lane >> 3); const float g = p.gk ? p.gk[p.k0 + kk] : 1.0f; LAS float* s = scr + kk * 33 + 4 * (lane & 7);
        s[0] = v[j][0] * g; s[1] = v[j][1] * g; s[2] = v[j][2] * g; s[3] = v[j][3] * g; }
    asm volatile("s_waitcnt lgkmcnt(0)" ::: "memory");
    const int c = lane & 7;
#pragma unroll
    for (int j = 0; j < 4; ++j) { const int n = (lane >> 3) + 8 * j; const LAS float* s = scr + (8 * c) * 33 + n;
        u32x4 o; o.x = pk2(s[0 * 33], s[1 * 33]); o.y = pk2(s[2 * 33], s[3 * 33]); o.z = pk2(s[4 * 33], s[5 * 33]); o.w = pk2(s[6 * 33], s[7 * 33]);
        *(u32x4*)(p.dst + (size_t)n * p.K + 8 * c) = o; }
    asm volatile("s_waitcnt lgkmcnt(0)" ::: "memory");
}
constexpr int P0_EARLY_ITEMS = 32 * 192 + 32 * 64, P0_ALL_ITEMS = 32 * 192 + 32 * 64 + 2 * 32 * 176 + 88 * 64, P0_CHUNK = 32, P0_LATE_CHUNKS = (P0_ALL_ITEMS - P0_EARLY_ITEMS) / P0_CHUNK;
static_assert((P0_ALL_ITEMS - P0_EARLY_ITEMS) % P0_CHUNK == 0, "late conversion items come in whole chunks");
__device__ __forceinline__ void p0_run_range(const Args& a, LAS float* scr, int first, int n, int lane) {
    f32x4 va[8], vb[8]; P0Item pa, pb;
    pa = p0_decode(a, first); p0_load(pa, va, lane);
    for (int i = 0; i < n; i += 2) {
        if (i + 1 < n) { pb = p0_decode(a, first + i + 1); p0_load(pb, vb, lane); }
        p0_finish(pa, va, scr, lane);
        if (i + 1 >= n) break;
        if (i + 2 < n) { pa = p0_decode(a, first + i + 2); p0_load(pa, va, lane); }
        p0_finish(pb, vb, scr, lane);
    }
}
__device__ __forceinline__ void p0_prologue(const Args& a, LAS unsigned char* lds, int gw, int NGW, int lane, int wave) {
    LAS float* scr = (LAS float*)(lds + wave * 16384);
    unsigned char* ws = a.ws;
    constexpr int NITEMS = P0_EARLY_ITEMS;
    {
        int it = gw; f32x4 va[8], vb[8]; P0Item pa, pb;
        if (it < NITEMS) { pa = p0_decode(a, it); p0_load(pa, va, lane); }
        while (it < NITEMS) {
            const int itb = it + NGW;
            if (itb < NITEMS) { pb = p0_decode(a, itb); p0_load(pb, vb, lane); }
            p0_finish(pa, va, scr, lane);
            it = itb + NGW;
            if (itb >= NITEMS) break;
            if (it < NITEMS) { pa = p0_decode(a, it); p0_load(pa, va, lane); }
            p0_finish(pb, vb, scr, lane);
        }
    }
    const float* g1 = a.in[5];
    for (int m = gw; m < MT; m += NGW) {
        const float* xrow = m < NP ? a.in[0] + (size_t)m * DM : a.in[1] + (size_t)(m - NP) * DM;
        const f32x4* xr = (const f32x4*)xrow + lane; f32x4 v[8]; float s = 0.f;
#pragma unroll
        for (int j = 0; j < 8; ++j) { v[j] = xr[64 * j]; s += (v[j][0] * v[j][0] + v[j][1] * v[j][1]) + (v[j][2] * v[j][2] + v[j][3] * v[j][3]); }
        const float rs = __builtin_amdgcn_rsqf(wave_sum(s) * (1.0f / DM) + EPS);
        u32x2* o = (u32x2*)((bf16*)(ws + WS_HN) + (size_t)m * DM) + lane;
#pragma unroll
        for (int j = 0; j < 8; ++j) { const f32x4 g = *((const f32x4*)g1 + 64 * j + lane); u32x2 w; w.x = pk2(v[j][0] * rs * g[0], v[j][1] * rs * g[1]); w.y = pk2(v[j][2] * rs * g[2], v[j][3] * rs * g[3]); o[64 * j] = w; }
    }
}


template <int VS, bool QREG>
__device__ __forceinline__ void sb_block(f32x16 (&o)[4], float& R, const LAS unsigned char* kp, const LAS unsigned char* vp, const bf16x8 (&qreg)[8], const LAS unsigned char* qlp, int kb, int qw, int qpos, int hi) {
            f32x16 p;
#pragma unroll
            for (int r = 0; r < 16; ++r) p[r] = 0.f;
#pragma unroll
            for (int d0 = 0; d0 < 8; ++d0) { const bf16x8 kf = *(const LAS bf16x8*)(kp + d0 * 32); const bf16x8 qf = QREG ? qreg[d0] : *(const LAS bf16x8*)(qlp + d0 * 32); p = __builtin_amdgcn_mfma_f32_32x32x16_bf16(kf, qf, p, 0, 0, 0); }
            const bool need_mask = (kb + 31 >= qw);
            float e[16], sf[16];
#pragma unroll
            for (int r = 0; r < 16; ++r) {
                const float z = fminf(p[r], 100.f); float ee = __builtin_amdgcn_exp2f(z); float rr = __builtin_amdgcn_rcpf(1.0f + ee);
                if (need_mask) { const bool msk = (kb + crow(r, hi)) >= qpos; ee = msk ? 0.f : ee; rr = msk ? 1.f : rr; }
                e[r] = ee; sf[r] = rr;
            }
            float oth[4], PP[4];
#pragma unroll
            for (int g = 0; g < 4; ++g) { sf[4 * g + 2] *= sf[4 * g + 3]; sf[4 * g + 1] *= sf[4 * g + 2]; sf[4 * g] *= sf[4 * g + 1]; oth[g] = __shfl_xor(sf[4 * g], 32); PP[g] = sf[4 * g] * oth[g]; }
            const float SP3 = PP[3], SP2 = PP[2] * SP3, SP1 = PP[1] * SP2, SP0 = PP[0] * SP1;
            float A[4]; A[0] = R * SP1; A[1] = R * SP2; A[2] = R * SP3; A[3] = R;
#pragma unroll
            for (int g = 0; g < 4; ++g) A[g] = hi ? A[g] : A[g] * oth[g];
            R *= SP0;
            float w[16];
#pragma unroll
            for (int r = 0; r < 16; ++r) w[r] = (e[r] * sf[r]) * A[r >> 2];
#pragma unroll
            for (int s2 = 0; s2 < 2; ++s2) {
                u32x4 pw; pw.x = pk2(w[8 * s2 + 0], w[8 * s2 + 1]); pw.y = pk2(w[8 * s2 + 2], w[8 * s2 + 3]); pw.z = pk2(w[8 * s2 + 4], w[8 * s2 + 5]); pw.w = pk2(w[8 * s2 + 6], w[8 * s2 + 7]);
                const bf16x8 pa = __builtin_bit_cast(bf16x8, pw);
#pragma unroll
                for (int db = 0; db < 4; ++db) {
                    const s16x4 lo = __builtin_bit_cast(s16x4, __builtin_amdgcn_ds_read_tr16_b64_v4i16((LAS s16x4*)(vp + (16 * s2) * VS + db * 64)));
                    const s16x4 hh = __builtin_bit_cast(s16x4, __builtin_amdgcn_ds_read_tr16_b64_v4i16((LAS s16x4*)(vp + (16 * s2 + 8) * VS + db * 64)));
                    const bf16x8 vb = __builtin_shufflevector(lo, hh, 0, 1, 2, 3, 4, 5, 6, 7);
                    o[db] = __builtin_amdgcn_mfma_f32_32x32x16_bf16(pa, vb, o[db], 0, 0, 0);
                }
            }
}

template <bool SAMPLE>
__device__ __forceinline__ void attn_item(const Args& a, LAS unsigned char* lds, int code) {
    constexpr int NH = SAMPLE ? 4 : 1, KS = NH * 256 + 16, VS = NH * 256 + 32, K_OFF = 0, V_OFF = 32 * KS;
    int tid_ = threadIdx.x; asm volatile("" : "+v"(tid_));
    const int tid = tid_, lane = tid & 63, r32 = lane & 31, hi = lane >> 5; const int wid = __builtin_amdgcn_readfirstlane(tid >> 6);
    unsigned char* ws = a.ws;
    int slot, nsteps, kvpos0, qw, head, hl; size_t qrow;
    const bf16 *kgb = nullptr, *vgb = nullptr; const float *kgf = nullptr, *vgf = nullptr, *kgn = nullptr, *vgn = nullptr;
    if (SAMPLE) {
        const int b = (code >> 1) & 7, hg = (code >> 4) & 1;
        slot = 256 + b * 2 + hg; hl = wid >> 1; head = hg * 4 + hl; const int rg = wid & 1;
        qw = PAST + 32 * rg; qrow = (size_t)NP + b * DSEQ + 32 * rg + r32;
        nsteps = 130; kvpos0 = 0;
        kgf = a.in[2] + ((size_t)b * PAST + (tid >> 7)) * AW + hg * 512 + 4 * (tid & 127); vgf = a.in[3] + ((size_t)b * PAST + (tid >> 7)) * AW + hg * 512 + 4 * (tid & 127);
        kgn = a.out + OFF_KS + ((size_t)b * DSEQ + (tid >> 7)) * AW + hg * 512 + 4 * (tid & 127); vgn = a.out + OFF_VS + ((size_t)b * DSEQ + (tid >> 7)) * AW + hg * 512 + 4 * (tid & 127);
    } else {
        const int bh = (code >> 1) & 15, qb = (code >> 5) & 15, c = (code >> 9) & 3, b = bh >> 3;
        head = bh & 7; hl = 0; slot = bh * 16 + qb + 0 * c; nsteps = p_nsteps(qb, c); kvpos0 = 0;
        qw = qb * 256 + 32 * wid; qrow = (size_t)b * SEQ + qw + r32;
        kgb = (const bf16*)(ws + WS_K) + ((size_t)b * SEQ + kvpos0 + (tid >> 4)) * AW + head * 128 + (tid & 15) * 8;
        vgb = (const bf16*)(ws + WS_V) + ((size_t)b * SEQ + kvpos0 + (tid >> 4)) * AW + head * 128 + (tid & 15) * 8;
    }
    const int qpos = qw + r32;
    constexpr int Q_OFF = 67584, QS = 272;
    const LAS unsigned char* qlp = lds + Q_OFF + wid * (32 * QS) + r32 * QS + hi * 16;
    { const bf16* qp = (const bf16*)(ws + WS_Q) + qrow * AW + head * 128 + hi * 8;
#pragma unroll
      for (int d0 = 0; d0 < 8; ++d0) *(LAS bf16x8*)(lds + Q_OFF + wid * (32 * QS) + r32 * QS + hi * 16 + d0 * 32) = *(const bf16x8*)(qp + 16 * d0); }
    f32x16 o[4];
#pragma unroll
    for (int i = 0; i < 4; ++i)
#pragma unroll
        for (int r = 0; r < 16; ++r) o[i][r] = 0.f;
    float R = 1.f;
    u32x4 kreg, vreg; f32x4 kf4[8], vf4[8];
#define ATT_LOADK(s_) do { if (SAMPLE) { _Pragma("unroll") for (int i_ = 0; i_ < 8; ++i_) kf4[i_] = *(const f32x4*)(((s_) >= 128 ? kgn + (size_t)((s_) - 128) * 32 * AW : kgf + (size_t)(s_) * 32 * AW) + (size_t)i_ * 4 * AW); } \
        else { kreg = *(const u32x4*)(kgb + (size_t)(s_) * 32 * AW); } } while (0)
#define ATT_LOADV(s_) do { if (SAMPLE) { _Pragma("unroll") for (int i_ = 0; i_ < 8; ++i_) vf4[i_] = *(const f32x4*)(((s_) >= 128 ? vgn + (size_t)((s_) - 128) * 32 * AW : vgf + (size_t)(s_) * 32 * AW) + (size_t)i_ * 4 * AW); } \
        else { vreg = *(const u32x4*)(vgb + (size_t)(s_) * 32 * AW); } } while (0)
#define ATT_STOREK() do { if (SAMPLE) { _Pragma("unroll") for (int i_ = 0; i_ < 8; ++i_) { const int key_ = (tid >> 7) + 4 * i_, f4_ = tid & 127; \
            u32x2 kw_; kw_.x = pk2(kf4[i_][0], kf4[i_][1]); kw_.y = pk2(kf4[i_][2], kf4[i_][3]); *(LAS u32x2*)(lds + K_OFF + key_ * KS + f4_ * 8) = kw_; } } \
        else { *(LAS u32x4*)(lds + K_OFF + (tid >> 4) * KS + (tid & 15) * 16) = kreg; } } while (0)
#define ATT_STOREV() do { if (SAMPLE) { _Pragma("unroll") for (int i_ = 0; i_ < 8; ++i_) { const int key_ = (tid >> 7) + 4 * i_, f4_ = tid & 127; \
            u32x2 vw_; vw_.x = pk2(vf4[i_][0], vf4[i_][1]); vw_.y = pk2(vf4[i_][2], vf4[i_][3]); *(LAS u32x2*)(lds + V_OFF + key_ * VS + f4_ * 8) = vw_; } } \
        else { *(LAS u32x4*)(lds + V_OFF + (tid >> 4) * VS + (tid & 15) * 16) = vreg; } } while (0)
    volatile LAS int* flg = (volatile LAS int*)(lds + MISC_OFF + 64);
    ATT_LOADK(nsteps - 1); ATT_LOADV(nsteps - 1);
    ATT_STOREK(); ATT_STOREV();
    __syncthreads();
    const LAS unsigned char* kp = lds + K_OFF + r32 * KS + hl * 256 + hi * 16;
    const LAS unsigned char* vp = lds + V_OFF + (4 * hi + ((lane & 15) >> 2)) * VS + hl * 256 + (16 * ((lane >> 4) & 1) + 4 * (lane & 3)) * 2;
    for (int s = nsteps - 1; s >= 0; --s) {
        if (s > 0) { ATT_LOADK(s - 1); if (!SAMPLE) ATT_LOADV(s - 1); }
        const int kb = kvpos0 + 32 * s;
        if (kb < qw + 32 && !__all(R == 0.f)) { const bf16x8 qdummy[8] = {}; sb_block<VS, false>(o, R, kp, vp, qdummy, qlp, kb, qw, qpos, hi); }
        if (lane == 0) flg[wid] = __all(R == 0.f) ? 1 : 0;
        __syncthreads();
        const bool alldone = (flg[0] & flg[1] & flg[2] & flg[3] & flg[4] & flg[5] & flg[6] & flg[7]) != 0;
        if (alldone) { __syncthreads(); break; }
        if (s > 0) { ATT_STOREK(); if (SAMPLE) ATT_LOADV(s - 1); ATT_STOREV(); }
        __syncthreads();
    }
#undef ATT_LOADK
#undef ATT_LOADV
#undef ATT_STOREK
#undef ATT_STOREV
    float* op = (float*)(ws + WS_OP) + ((size_t)(slot * 8 + wid) * 32) * 128;
#pragma unroll
    for (int db = 0; db < 4; ++db)
#pragma unroll
        for (int r = 0; r < 16; ++r) op[crow(r, hi) * 128 + db * 32 + r32] = o[db][r];
    if (hi == 0) ((float*)(ws + WS_TP))[(slot * 8 + wid) * 32 + r32] = R;
}


__device__ __forceinline__ void attn_item_p(const Args& a, LAS unsigned char* lds, int code) {
    constexpr int KS = 272, VS = 288, TILE_K = 64 * KS, BUF = TILE_K + 64 * VS;
    int tid_ = threadIdx.x; asm volatile("" : "+v"(tid_));
    const int tid = tid_, lane = tid & 63, r32 = lane & 31, hi = lane >> 5; const int wid = __builtin_amdgcn_readfirstlane(tid >> 6);
    unsigned char* ws = a.ws;
    const int bh = (code >> 1) & 15, qb = (code >> 5) & 15, c = (code >> 9) & 3, b = bh >> 3, head = bh & 7;
    const int slot = bh * 16 + qb + 0 * c, nst = p_nsteps(qb, c) >> 1, kvpos0 = 0;
    const int qw = qb * 256 + 32 * wid, qpos = qw + r32; const size_t qrow = (size_t)b * SEQ + qpos;
    const bf16* kgb = (const bf16*)(ws + WS_K) + ((size_t)b * SEQ + kvpos0 + (tid >> 4)) * AW + head * 128 + (tid & 15) * 8;
    const bf16* vgb = (const bf16*)(ws + WS_V) + ((size_t)b * SEQ + kvpos0 + (tid >> 4)) * AW + head * 128 + (tid & 15) * 8;
    bf16x8 qf[8];
    { const bf16* qp = (const bf16*)(ws + WS_Q) + qrow * AW + head * 128 + hi * 8;
#pragma unroll
      for (int d0 = 0; d0 < 8; ++d0) qf[d0] = *(const bf16x8*)(qp + 16 * d0); }
    f32x16 o[4];
#pragma unroll
    for (int i = 0; i < 4; ++i)
#pragma unroll
        for (int r = 0; r < 16; ++r) o[i][r] = 0.f;
    float R = 1.f;
    u32x4 kreg[2], vreg[2];
#define PLOAD(s_) do { _Pragma("unroll") for (int i_ = 0; i_ < 2; ++i_) { kreg[i_] = *(const u32x4*)(kgb + (size_t)((s_) * 64 + 32 * i_) * AW); vreg[i_] = *(const u32x4*)(vgb + (size_t)((s_) * 64 + 32 * i_) * AW); } } while (0)
#define PSTORE(buf_) do { _Pragma("unroll") for (int i_ = 0; i_ < 2; ++i_) { *(LAS u32x4*)(lds + (buf_) * BUF + ((tid >> 4) + 32 * i_) * KS + (tid & 15) * 16) = kreg[i_]; \
        *(LAS u32x4*)(lds + (buf_) * BUF + TILE_K + ((tid >> 4) + 32 * i_) * VS + (tid & 15) * 16) = vreg[i_]; } } while (0)
    volatile LAS int* flg = (volatile LAS int*)(lds + MISC_OFF + 64);
    PLOAD(nst - 1);
    PSTORE(0);
    __syncthreads();
    const LAS unsigned char* kp = lds + r32 * KS + hi * 16;
    const LAS unsigned char* vp = lds + TILE_K + (4 * hi + ((lane & 15) >> 2)) * VS + (16 * ((lane >> 4) & 1) + 4 * (lane & 3)) * 2;
    int cur = 0;
    for (int s = nst - 1; s >= 0; --s) {
        if (s > 0) PLOAD(s - 1);
#pragma unroll
        for (int blk = 1; blk >= 0; --blk) {
            const int kb = kvpos0 + 64 * s + 32 * blk;
            if (kb < qw + 32 && !__all(R == 0.f)) sb_block<VS, true>(o, R, kp + cur * BUF + blk * 32 * KS, vp + cur * BUF + blk * 32 * VS, qf, kp, kb, qw, qpos, hi);
        }
        volatile LAS int* fl = flg + 8 * (s & 1);
        if (lane == 0) fl[wid] = __all(R == 0.f) ? 1 : 0;
        if (s > 0) PSTORE(cur ^ 1);
        __syncthreads();
        if ((fl[0] & fl[1] & fl[2] & fl[3] & fl[4] & fl[5] & fl[6] & fl[7]) != 0) break;
        cur ^= 1;
    }
#undef PLOAD
#undef PSTORE
    float* op = (float*)(ws + WS_OP) + ((size_t)(slot * 8 + wid) * 32) * 128;
#pragma unroll
    for (int db = 0; db < 4; ++db)
#pragma unroll
        for (int r = 0; r < 16; ++r) op[crow(r, hi) * 128 + db * 32 + r32] = o[db][r];
    if (hi == 0) ((float*)(ws + WS_TP))[(slot * 8 + wid) * 32 + r32] = R;
}

__device__ __forceinline__ void mix_rows(const Args& a, int gw, int NGW, int lane) {
    unsigned char* ws = a.ws;
    const float* OP = (const float*)(ws + WS_OP); const float* TP = (const float*)(ws + WS_TP);
    const bf16* U = (const bf16*)(ws + WS_U); const bf16* GB = (const bf16*)(ws + WS_GB); bf16* MIX = (bf16*)(ws + WS_MIX);
    const float* cw = a.in[9]; const float* ga = a.in[10]; const float* gc = a.in[11];
    for (int m = gw; m < MT; m += NGW) {
        const int h = lane >> 3, d0 = (lane & 7) * 16;
        int nparts, slot0, wid, q;
        if (m < NP) { const int b = m >> 12, t = m & 4095, qb = t >> 8; wid = (t & 255) >> 5; q = t & 31; nparts = 1; slot0 = (b * 8 + h) * 16 + qb; }
        else { const int r = m - NP, b = r >> 6, t = r & 63, rg = t >> 5; q = t & 31; wid = (h & 3) * 2 + rg; nparts = 1; slot0 = 256 + b * 2 + (h >> 2); }
        f32x4 acc[4];
#pragma unroll
        for (int i = 0; i < 4; ++i) acc[i] = (f32x4){0.f, 0.f, 0.f, 0.f};
        float Rr = 1.f;
        for (int c = nparts - 1; c >= 0; --c) {
            const size_t base = (size_t)((slot0 + c) * 8 + wid) * 32 + q;
            const f32x4* p = (const f32x4*)(OP + base * 128 + d0);
#pragma unroll
            for (int i = 0; i < 4; ++i) acc[i] += p[i] * Rr;
            Rr *= TP[base];
        }
        float s = 0.f;
#pragma unroll
        for (int i = 0; i < 4; ++i) s += (acc[i][0] * acc[i][0] + acc[i][1] * acc[i][1]) + (acc[i][2] * acc[i][2] + acc[i][3] * acc[i][3]);
        float rs = __builtin_amdgcn_rsqf(wave_sum(s) * (1.0f / AW) + EPS);
        {
            const f32x4* g = (const f32x4*)(ga + h * 128 + d0); u32x4 w0, w1;
            f32x4 v0 = acc[0] * rs * g[0], v1 = acc[1] * rs * g[1], v2 = acc[2] * rs * g[2], v3 = acc[3] * rs * g[3];
            w0.x = pk2(v0[0], v0[1]); w0.y = pk2(v0[2], v0[3]); w0.z = pk2(v1[0], v1[1]); w0.w = pk2(v1[2], v1[3]);
            w1.x = pk2(v2[0], v2[1]); w1.y = pk2(v2[2], v2[3]); w1.z = pk2(v3[0], v3[1]); w1.w = pk2(v3[2], v3[3]);
            u32x4* o = (u32x4*)(MIX + (size_t)m * DM + h * 128 + d0); o[0] = w0; o[1] = w1;
        }
        const int c0 = lane * 16; int t, tb; const float* st = nullptr;
        if (m < NP) { t = m & 4095; tb = m - t; } else { const int r = m - NP; t = r & 63; tb = m - t; st = a.in[4] + (size_t)(r >> 6) * 2 * CC; }
        float u0[16], u1[16], u2[16];
        { const u32x4* p = (const u32x4*)(U + (size_t)m * CC + c0); const u32x4 x0 = p[0], x1 = p[1];
          const unsigned ww[8] = {x0.x, x0.y, x0.z, x0.w, x1.x, x1.y, x1.z, x1.w};
#pragma unroll
          for (int i = 0; i < 8; ++i) { u2[2 * i] = bflo(ww[i]); u2[2 * i + 1] = bfhi(ww[i]); } }
        if (t >= 1) { const u32x4* p = (const u32x4*)(U + (size_t)(m - 1) * CC + c0); const u32x4 x0 = p[0], x1 = p[1];
          const unsigned ww[8] = {x0.x, x0.y, x0.z, x0.w, x1.x, x1.y, x1.z, x1.w};
#pragma unroll
          for (int i = 0; i < 8; ++i) { u1[2 * i] = bflo(ww[i]); u1[2 * i + 1] = bfhi(ww[i]); } }
        else {
#pragma unroll
          for (int i = 0; i < 16; ++i) u1[i] = st ? st[CC + c0 + i] : 0.f; }
        if (t >= 2) { const u32x4* p = (const u32x4*)(U + (size_t)(m - 2) * CC + c0); const u32x4 x0 = p[0], x1 = p[1];
          const unsigned ww[8] = {x0.x, x0.y, x0.z, x0.w, x1.x, x1.y, x1.z, x1.w};
#pragma unroll
          for (int i = 0; i < 8; ++i) { u0[2 * i] = bflo(ww[i]); u0[2 * i + 1] = bfhi(ww[i]); } }
        else {
#pragma unroll
          for (int i = 0; i < 16; ++i) u0[i] = st ? st[(t == 0 ? 0 : CC) + c0 + i] : 0.f; }
        float oc[16]; float s2 = 0.f;
        { const u32x4* p = (const u32x4*)(GB + (size_t)m * CC + c0); const u32x4 x0 = p[0], x1 = p[1];
          const unsigned ww[8] = {x0.x, x0.y, x0.z, x0.w, x1.x, x1.y, x1.z, x1.w};
#pragma unroll
          for (int i = 0; i < 16; ++i) { const float gbv = (i & 1) ? bfhi(ww[i >> 1]) : bflo(ww[i >> 1]);
              oc[i] = gbv * (cw[c0 + i] * u0[i] + cw[CC + c0 + i] * u1[i] + cw[2 * CC + c0 + i] * u2[i]); s2 += oc[i] * oc[i]; } }
        rs = __builtin_amdgcn_rsqf(wave_sum(s2) * (1.0f / CC) + EPS);
        { u32x4 w0, w1; unsigned ww[8];
#pragma unroll
          for (int i = 0; i < 8; ++i) ww[i] = pk2(oc[2 * i] * rs * gc[c0 + 2 * i], oc[2 * i + 1] * rs * gc[c0 + 2 * i + 1]);
          w0.x = ww[0]; w0.y = ww[1]; w0.z = ww[2]; w0.w = ww[3]; w1.x = ww[4]; w1.y = ww[5]; w1.z = ww[6]; w1.w = ww[7];
          u32x4* o = (u32x4*)(MIX + (size_t)m * DM + AW + c0); o[0] = w0; o[1] = w1; }
        (void)tb;
    }
}
#ifndef REP_P0
#define REP_P0 1
#endif
#ifndef REP_P1
#define REP_P1 1
#endif
#ifndef REP_P3
#define REP_P3 1
#endif
#ifndef REP_P4
#define REP_P4 1
#endif
#ifndef REP_P5
#define REP_P5 1
#endif
__global__ void __launch_bounds__(NWAVES * 64, 2) fwd_megakernel(Args args) {
    extern __shared__ __attribute__((aligned(16))) unsigned char lds_raw[];
    cg::grid_group grid = cg::this_grid();
    LAS unsigned char* lds = (LAS unsigned char*)lds_raw;
    const int G = gridDim.x, bx = blockIdx.x, NGW = G * NWAVES;
#define PHASE_IDS() int tid = threadIdx.x; asm volatile("" : "+v"(tid)); const int lane = tid & 63; const int wave = __builtin_amdgcn_readfirstlane(tid >> 6); const int gw = bx * NWAVES + wave; (void)lane; (void)gw
    unsigned char* ws = args.ws;
    unsigned* ctl = (unsigned*)(ws + WS_CTL);
    LAS float* red = (LAS float*)(lds + RED_OFF);
    volatile LAS int* misc = (volatile LAS int*)(lds + MISC_OFF);

    { PHASE_IDS(); if (bx == 0 && tid == 0) { ctl[0] = 0u; ctl[64] = 0u; for (int i = 0; i < 16; ++i) ctl[128 + i] = 0u; }
      if (bx == 0) for (int i = tid; i < XCD_BAR_WORDS; i += NWAVES * 64) ctl[4096 + i] = 0u;
      if (tid < 2) misc[8 + tid] = 0;
#ifndef NO_P0
    for (int rep_ = 0; rep_ < REP_P0; ++rep_) p0_prologue(args, lds, gw, NGW, lane, wave);
#endif
    }
    grid.sync();
    XcdBarrier xbar = xcd_barrier_post(ctl + 4096, (volatile LAS unsigned*)(lds + MISC_OFF) + 8);

#ifndef NO_P1
    for (int rep_ = 0; rep_ < REP_P1; ++rep_) {
        pg8::Gemm g{(const pg8::bf16_t*)(ws + WS_HN), (const pg8::bf16_t*)(ws + WS_WIN), MT, INC, DM}; typedef pg8::InProjOrder Ord; Ord S; S.init(G, bx);
        pg8::EpiIn E{(bf16*)(ws + WS_Q), (bf16*)(ws + WS_K), (bf16*)(ws + WS_V), (bf16*)(ws + WS_GB), (bf16*)(ws + WS_U), args.out, args.in[7], args.in[8], red,
                     1.4426950408889634f * 0.08838834764831845f, OFF_KP, OFF_VP, OFF_CP, OFF_KS, OFF_VS, OFF_CS};
        pg8::gemm_phase<pg8::EpiIn, Ord, true, true>(lds, g, S, E);
    }
#endif
    xcd_barrier(xbar);

#ifndef NO_P2
    {
        const int nitems = g_items.n;
        PHASE_IDS();
#ifdef DUP_P2
        for (int rep = 0; rep < 2; ++rep)
#else
        const int rep = 0;
#endif
        for (;;) {
            if (tid == 0) misc[0] = (int)atomicAdd(ctl + 64 * rep, 1u);
            __syncthreads();
            int it = misc[0];
            __syncthreads();
            if (it < 48) {
                pg8::Gemm g{(const pg8::bf16_t*)(ws + WS_HN), (const pg8::bf16_t*)(ws + WS_WIN), MT, INC, DM};
                pg8::OneUnit S1; S1.u0.pm = 30 + (it & 3); S1.u0.pn = 12 + (it >> 2); S1.u0.k0 = 0; S1.u0.nt = 32; S1.u0.split = 0; S1.u0.tu = 0; S1.u0.sp = 0;
                pg8::EpiIn E{(bf16*)(ws + WS_Q), (bf16*)(ws + WS_K), (bf16*)(ws + WS_V), (bf16*)(ws + WS_GB), (bf16*)(ws + WS_U), args.out, args.in[7], args.in[8], red,
                             1.4426950408889634f * 0.08838834764831845f, OFF_KP, OFF_VP, OFF_CP, OFF_KS, OFF_VS, OFF_CS};
                pg8::gemm_phase<pg8::EpiIn, pg8::OneUnit, true, true>(lds, g, S1, E);
                __syncthreads();
                continue;
            }
            it -= 48;
            if (it >= nitems) {
                const int ch = it - nitems; if (ch >= P0_LATE_CHUNKS) break;
                p0_run_range(args, (LAS float*)(lds + wave * 16384), P0_EARLY_ITEMS + ch * P0_CHUNK + wave * (P0_CHUNK / NWAVES), P0_CHUNK / NWAVES, lane);
                continue;
            }
            const int code = g_items.v[it];
#if defined(ONLY_S)
            attn_item<true>(args, lds, code);
#elif defined(ONLY_P)
            attn_item_p(args, lds, code);
#else
            if (code & 1) attn_item<true>(args, lds, code); else attn_item_p(args, lds, code);
#endif
        }
    }
#endif
    xcd_barrier(xbar);

#ifndef NO_P3
    for (int rep_ = 0; rep_ < REP_P3; ++rep_) { PHASE_IDS(); mix_rows(args, gw, NGW, lane); }
#endif
    xcd_barrier(xbar);

#ifndef NO_P4
    for (int rep_ = 0; rep_ < REP_P4; ++rep_) {
        pg8::Gemm g{(const pg8::bf16_t*)(ws + WS_MIX), (const pg8::bf16_t*)(ws + WS_WOUT), MT, DM, DM}; typedef pg8::TailOrderT<MT / 256, DM / 256, DM / 64, 8> Ord; Ord S; S.init(G, bx);
        pg8::EpiOut E{args.in[0], args.in[1], args.out + OFF_Y, (bf16*)(ws + WS_HN), (float*)(ws + WS_SSQ), red, (float*)(ws + WS_PART)};
        pg8::gemm_phase<pg8::EpiOut, Ord, true, true>(lds, g, S, E);
        if (S.rem > 0) {
            xcd_barrier(xbar);
            PHASE_IDS();
            for (int w = gw; w < S.rem * 256; w += NGW) {
                const int tu = w >> 8, r = w & 255; pg8::Unit u; Ord::SO::unit(S.full * G + tu, u);
                const size_t row = (size_t)u.pm * 256 + r; const int col = u.pn * 256 + 4 * lane;
                const float* xin = row < NP ? args.in[0] + row * DM : args.in[1] + (row - NP) * DM;
                f32x4 v = *(const f32x4*)(xin + col);
                const float* p = (const float*)(ws + WS_PART) + (size_t)(tu * 8) * 65536 + r * 256 + 4 * lane;
#pragma unroll
                for (int s = 0; s < 8; ++s) v += *(const f32x4*)(p + (size_t)s * 65536);
                *(f32x4*)(args.out + OFF_Y + row * DM + col) = v;
                u32x2 pk; pk.x = pk2(v[0], v[1]); pk.y = pk2(v[2], v[3]); *(u32x2*)((bf16*)(ws + WS_HN) + row * DM + col) = pk;
                const float ss = wave_sum((v[0] * v[0] + v[1] * v[1]) + (v[2] * v[2] + v[3] * v[3]));
                if (lane == 0) ((float*)(ws + WS_SSQ))[row * 8 + u.pn] = ss;
            }
        }
    }
#endif
    xcd_barrier(xbar);

#ifndef NO_P5
    for (int rep_ = 0; rep_ < REP_P5; ++rep_) {
        pg8::Gemm g{(const pg8::bf16_t*)(ws + WS_HN), (const pg8::bf16_t*)(ws + WS_WGU), MT, 2 * DFF, DM}; typedef pg8::StaticOrderT<MT / 256, 2 * DFF / 256, DM / 64> Ord; Ord S; S.init(G, bx);
        pg8::EpiGU E{(bf16*)(ws + WS_H), (const float*)(ws + WS_SSQ)};
        pg8::gemm_phase<pg8::EpiGU, Ord, true, true>(lds, g, S, E);
    }
#endif
    xcd_barrier(xbar);

#ifndef NO_P6
    {
        pg8::Gemm g{(const pg8::bf16_t*)(ws + WS_H), (const pg8::bf16_t*)(ws + WS_WDN), MT, DM, DFF};
        typedef pg8::TailOrderT<MT / 256, DM / 256, DFF / 64, 8> Ord; Ord S; S.init(G, bx);
        pg8::EpiDown E{args.out + OFF_Y, (float*)(ws + WS_PART), (const pg8::bf16_t*)(ws + WS_HN)};
        pg8::gemm_phase<pg8::EpiDown, Ord, true, true>(lds, g, S, E);
        if (S.rem > 0) {
            xcd_barrier(xbar);
            PHASE_IDS();
            for (int w = gw; w < S.rem * 256; w += NGW) {
                const int tu = w >> 8, r = w & 255; pg8::Unit u; Ord::SO::unit(S.full * G + tu, u);
                float* y = args.out + OFF_Y + ((size_t)u.pm * 256 + r) * DM + u.pn * 256 + 4 * lane;
                f32x4 v = *(const f32x4*)y;
                const float* p = (const float*)(ws + WS_PART) + (size_t)(tu * 8) * 65536 + r * 256 + 4 * lane;
#pragma unroll
                for (int s = 0; s < 8; ++s) v += *(const f32x4*)(p + (size_t)s * 65536);
                *(f32x4*)y = v;
            }
        }
    }
#endif
}

extern "C" void kernel_launch(void* const* d_in, const int* in_sizes, int n_in, void* d_out, int out_size, void* d_ws, size_t ws_size, hipStream_t stream) {
    static int grid = 0;
    if (grid == 0) {
        if (n_in != 17 || (size_t)out_size != OUT_TOTAL || ws_size < WS_END) { fprintf(stderr, "kernel_launch: unexpected shapes (n_in %d out %d ws %zu need %zu)\n", n_in, out_size, ws_size, (size_t)WS_END); grid = -1; return; }
        int dev = 0, cus = 0, per_cu = 0;
        hipGetDevice(&dev); hipDeviceGetAttribute(&cus, hipDeviceAttributeMultiprocessorCount, dev);
        hipFuncSetAttribute((const void*)fwd_megakernel, hipFuncAttributeMaxDynamicSharedMemorySize, LDS_BYTES);
        hipOccupancyMaxActiveBlocksPerMultiprocessor(&per_cu, (const void*)fwd_megakernel, NWAVES * 64, LDS_BYTES);
        if (per_cu < 1) { fprintf(stderr, "kernel_launch: occupancy query says %d blocks per CU\n", per_cu); per_cu = 1; }
        (void)hipGetLastError();
        grid = cus;
    }
    if (grid < 0) return;
    Args a{};
    for (int i = 0; i < 17; ++i) a.in[i] = (const float*)d_in[i];
    a.out = (float*)d_out; a.ws = (unsigned char*)d_ws;
    void* kargs[] = {&a};
    hipError_t e = hipLaunchCooperativeKernel((const void*)fwd_megakernel, dim3(grid), dim3(NWAVES * 64), kargs, LDS_BYTES, stream);
    if (e != hipSuccess) fprintf(stderr, "cooperative launch failed: %s (grid %d)\n", hipGetErrorString(e), grid);
}
```

```cpp
#include <hip/hip_runtime.h>
#include <hip/hip_cooperative_groups.h>
#include <cstdio>
#include <cstdint>
namespace cg = cooperative_groups;
namespace pg8 {
#define PG8_LAS __attribute__((address_space(3)))
typedef unsigned short bf16_t;
typedef short bf16x8 __attribute__((ext_vector_type(8)));
typedef float f32x4 __attribute__((ext_vector_type(4)));
typedef unsigned u32x4 __attribute__((ext_vector_type(4)));
constexpr int BM = 256, BK = 64, HALF = 128, HTB = HALF * BK * 2  , STAGE_BYTES = 8 * HTB, NXCD = 8, WGM = 8;

__host__ __device__ __forceinline__ int lds_byte(int r, int c) { const int st = (r >> 4) * 2 + (c >> 5), rr = r & 15, cc = c & 31, ob = rr * 64 + cc * 2; return st * 1024 + (ob ^ (((ob >> 9) & 1) << 5)); }
__host__ __device__ __forceinline__ void stage_rc(int b, int& R, int& C) { const int st = b / 1024, sb = b % 1024, swz = sb ^ (((sb >> 9) & 1) << 5); R = (st >> 1) * 16 + swz / 64; C = (st & 1) * 32 + (swz % 64) / 2; }
__host__ __device__ __forceinline__ int perm32(int rho) { const int n = rho >> 4, i = rho & 15; return 8 * (i >> 2) + 4 * n + (i & 3); }

struct Unit { int pm, pn, k0, nt, split, tu, sp; };
struct Gemm { const bf16_t* A; const bf16_t* Bt; int M, N, K; };

template <int NM, int NN, int NTK> struct StaticOrderT {
    static constexpr int nM = NM, nN = NN, nwg = NM * NN, ntk = NTK;
    int G, c;
    __host__ __device__ __forceinline__ void init(int G_, int c_) { G = G_; c = c_; }
    __host__ __device__ __forceinline__ bool next(int i, Unit& u) const { const int L = i * G + c; if (L >= nwg) return false; unit(L, u); return true; }
    __host__ __device__ __forceinline__ static void unit(int L, Unit& u) {
        int wgid = L; { constexpr int q = nwg / NXCD, r = nwg % NXCD; const int xcd = wgid % NXCD, off = wgid / NXCD; wgid = (xcd < r ? xcd * (q + 1) : r * (q + 1) + (xcd - r) * q) + off; }
        constexpr int nig = WGM * nN; const int gid = wgid / nig, fm = gid * WGM, gsz = (nM - fm) < WGM ? (nM - fm) : WGM;
        u.pm = fm + ((wgid % nig) % gsz); u.pn = (wgid % nig) / gsz; u.k0 = 0; u.nt = ntk; u.split = 0; u.tu = 0; u.sp = 0;
    }
    __device__ __forceinline__ void a_ready(const Unit&) const {}
    __device__ __forceinline__ void done(const Unit&) const {}
};
template <int NM, int NN, int NTK, int NSPLIT> struct TailOrderT {
    typedef StaticOrderT<NM, NN, NTK> SO;
    int G, c, full, rem;
    __host__ __device__ __forceinline__ void init(int G_, int c_) { G = G_; c = c_; full = SO::nwg / G; rem = SO::nwg - full * G; if (rem * NSPLIT > G || NTK < 2 * NSPLIT) { full = 1 << 24; rem = 0; } }
    __host__ __device__ __forceinline__ static int kstart(int s) { return s >= NSPLIT ? NTK : ((s * NTK / NSPLIT) & ~1); }
    __host__ __device__ __forceinline__ bool next(int i, Unit& u) const {
        if (i < full) { const int L = i * G + c; if (L >= SO::nwg) return false; SO::unit(L, u); return true; }
        if (i > full || c >= rem * NSPLIT) return false;
        const int tu = c / NSPLIT, sp = c % NSPLIT; SO::unit(full * G + tu, u); u.k0 = kstart(sp); u.nt = kstart(sp + 1) - u.k0; u.split = 1; u.tu = tu; u.sp = sp; return true;
    }
    __device__ __forceinline__ void a_ready(const Unit&) const {}
    __device__ __forceinline__ void done(const Unit&) const {}
};

struct InProjOrder {
    typedef StaticOrderT<30, 24, 32> SO;
    int G, c;
    __host__ __device__ __forceinline__ void init(int G_, int c_) { G = G_; c = c_; }
    __host__ __device__ __forceinline__ bool next(int i, Unit& u) const {
        const int L = i * G + c; if (L >= 768) return false;
        if (L < 720) { SO::unit(L, u); return true; }
        const int j = L - 720; u.pm = 30 + (j & 3); u.pn = j >> 2; u.k0 = 0; u.nt = 32; u.split = 0; u.tu = 0; u.sp = 0; return true;
    }
    __device__ __forceinline__ void a_ready(const Unit&) const {}
    __device__ __forceinline__ void done(const Unit&) const {}
};
struct OneUnit {
    Unit u0;
    __host__ __device__ __forceinline__ bool next(int i, Unit& u) const { if (i != 0) return false; u = u0; return true; }
    __device__ __forceinline__ void a_ready(const Unit&) const {}
    __device__ __forceinline__ void done(const Unit&) const {}
};

__device__ __forceinline__ unsigned cvt_pk_bf16(float lo, float hi) { unsigned r; asm volatile("v_cvt_pk_bf16_f32 %0, %1, %2" : "=v"(r) : "v"(lo), "v"(hi)); return r; }
typedef float f32x2 __attribute__((ext_vector_type(2)));
#define PG8_LBAR() asm volatile("s_waitcnt lgkmcnt(0)\n\ts_barrier" ::: "memory")
constexpr int NPROMPT = 8192;
__device__ __forceinline__ u32x4 pack8(const f32x4 a, const f32x4 b) { u32x4 w; w.x = cvt_pk_bf16(a[0], a[1]); w.y = cvt_pk_bf16(a[2], a[3]); w.z = cvt_pk_bf16(b[0], b[1]); w.w = cvt_pk_bf16(b[2], b[3]); return w; }


__device__ __forceinline__ void store_partial(float* part, int nsplit, const f32x4 (&acc)[2][2][4][2], const Unit& u, int wr, int wc, int fr, int fq) {
    float* pt = part + (size_t)(u.tu * nsplit + u.sp) * 65536; int rl0 = wr * 64 + fr, cw = wc * 32 + 8 * fq; asm volatile("" : "+v"(rl0), "+v"(cw));
#pragma unroll
    for (int ai = 0; ai < 2; ++ai)
#pragma unroll
        for (int m = 0; m < 4; ++m)
#pragma unroll
            for (int bj = 0; bj < 2; ++bj) { float* o = pt + (ai * HALF + rl0 + m * 16) * 256 + bj * HALF + cw; *(f32x4*)o = acc[ai][bj][m][0]; *(f32x4*)(o + 4) = acc[ai][bj][m][1]; }
}

struct EpiIn {
    static constexpr bool PERM = true, AFTER_DRAIN = false;
    bf16_t *Q, *Kb, *Vb, *GB, *U; float* out; const float *gq, *gk; PG8_LAS float* red; float qscale;
    size_t off_kp, off_vp, off_cp, off_ks, off_vs, off_cs;
    __device__ __forceinline__ void operator()(const f32x4 (&acc)[2][2][4][2], const Unit& u, int wr, int wc, int fr, int fq) const {
        int rl0 = wr * 64 + fr, cw = wc * 32 + 8 * fq; asm volatile("" : "+v"(rl0), "+v"(cw));
        const int pn = u.pn, rowt = u.pm * BM;
        const bool prompt = rowt < NPROMPT;
        if (pn < 8) {
            const bool isq = pn < 4;
#pragma unroll
            for (int ai = 0; ai < 2; ++ai)
#pragma unroll
                for (int m = 0; m < 4; ++m)
#pragma unroll
                    for (int bj = 0; bj < 2; ++bj) {
                        const f32x4 a = acc[ai][bj][m][0], b = acc[ai][bj][m][1];
                        float s = (a[0] * a[0] + a[1] * a[1]) + (a[2] * a[2] + a[3] * a[3]) + (b[0] * b[0] + b[1] * b[1]) + (b[2] * b[2] + b[3] * b[3]);
                        s += __shfl_xor(s, 16); s += __shfl_xor(s, 32);
                        if (fq == 0) red[((ai * HALF + rl0 + m * 16) * 2 + bj) * 4 + wc] = s;
                    }
            PG8_LBAR();
            const float* g = isq ? gq : gk;
            const f32x4 g0 = *(const f32x4*)(g + cw), g1 = *(const f32x4*)(g + cw + 4);
#pragma unroll
            for (int ai = 0; ai < 2; ++ai)
#pragma unroll
                for (int m = 0; m < 4; ++m) {
                    const int rl = ai * HALF + rl0 + m * 16; const size_t row = (size_t)(rowt + rl);
#pragma unroll
                    for (int bj = 0; bj < 2; ++bj) {
                        const f32x4 p = *(const PG8_LAS f32x4*)(red + (rl * 2 + bj) * 4);
                        float rs = __builtin_amdgcn_rsqf(((p[0] + p[1]) + (p[2] + p[3])) * (1.0f / 128.0f) + 1e-6f);
                        if (isq) rs *= qscale;
                        const f32x4 v0 = acc[ai][bj][m][0] * rs * g0, v1 = acc[ai][bj][m][1] * rs * g1;
                        if (isq) { *(u32x4*)(Q + row * 1024 + pn * 256 + bj * HALF + cw) = pack8(v0, v1); }
                        else {
                            const int col = (pn - 4) * 256 + bj * HALF + cw;
                            float* o = prompt ? out + off_kp + row * 1024 + col : out + off_ks + (row - NPROMPT) * 1024 + col;
                            *(f32x4*)o = v0; *(f32x4*)(o + 4) = v1;
                            if (prompt) *(u32x4*)(Kb + row * 1024 + col) = pack8(v0, v1);
                        }
                    }
                }
        } else if (pn < 12) {
#pragma unroll
            for (int ai = 0; ai < 2; ++ai)
#pragma unroll
                for (int m = 0; m < 4; ++m) {
                    const size_t row = (size_t)(rowt + ai * HALF + rl0 + m * 16);
#pragma unroll
                    for (int bj = 0; bj < 2; ++bj) {
                        const int col = (pn - 8) * 256 + bj * HALF + cw; const f32x4 v0 = acc[ai][bj][m][0], v1 = acc[ai][bj][m][1];
                        float* o = prompt ? out + off_vp + row * 1024 + col : out + off_vs + (row - NPROMPT) * 1024 + col;
                        *(f32x4*)o = v0; *(f32x4*)(o + 4) = v1;
                        if (prompt) *(u32x4*)(Vb + row * 1024 + col) = pack8(v0, v1);
                    }
                }
        } else if (pn < 16) {
#pragma unroll
            for (int ai = 0; ai < 2; ++ai)
#pragma unroll
                for (int m = 0; m < 4; ++m) {
                    const size_t row = (size_t)(rowt + ai * HALF + rl0 + m * 16);
#pragma unroll
                    for (int bj = 0; bj < 2; ++bj) *(u32x4*)(GB + row * 1024 + (pn - 12) * 256 + bj * HALF + cw) = pack8(acc[ai][bj][m][0], acc[ai][bj][m][1]);
                }
        } else {
#pragma unroll
            for (int ai = 0; ai < 2; ++ai)
#pragma unroll
                for (int m = 0; m < 4; ++m) {
                    const int rowi = rowt + ai * HALF + rl0 + m * 16; const int ch = (pn - 16) * HALF + cw;
                    const f32x4 v0 = acc[ai][0][m][0] * acc[ai][1][m][0], v1 = acc[ai][0][m][1] * acc[ai][1][m][1];
                    *(u32x4*)(U + (size_t)rowi * 1024 + ch) = pack8(v0, v1);
                    if (prompt) { const int t = rowi & 4095; if (t >= 4094) { float* o = out + off_cp + ((rowi >> 12) * 2 + (t - 4094)) * 1024 + ch; *(f32x4*)o = v0; *(f32x4*)(o + 4) = v1; } }
                    else { const int rs_ = rowi - NPROMPT, t = rs_ & 63; if (t >= 62) { float* o = out + off_cs + ((rs_ >> 6) * 2 + (t - 62)) * 1024 + ch; *(f32x4*)o = v0; *(f32x4*)(o + 4) = v1; } }
                }
        }
    }
};

struct EpiOut {
    static constexpr bool PERM = true, AFTER_DRAIN = false;
    const float *xp, *xs; float* Y; bf16_t* X1; float* ssq; PG8_LAS float* red; float* part;
    __device__ __forceinline__ void operator()(const f32x4 (&acc)[2][2][4][2], const Unit& u, int wr, int wc, int fr, int fq) const {
        if (u.split) { store_partial(part, 8, acc, u, wr, wc, fr, fq); return; }
        int rl0 = wr * 64 + fr, cw = wc * 32 + 8 * fq; asm volatile("" : "+v"(rl0), "+v"(cw));
        const int pn = u.pn, rowt = u.pm * BM;
        const float* xin = rowt < NPROMPT ? xp + (size_t)rowt * 2048 : xs + (size_t)(rowt - NPROMPT) * 2048;
#pragma unroll
        for (int ai = 0; ai < 2; ++ai) {
            f32x4 xv[4][2][2];
#pragma unroll
            for (int m = 0; m < 4; ++m)
#pragma unroll
                for (int bj = 0; bj < 2; ++bj) { const float* xi = xin + (size_t)(ai * HALF + rl0 + m * 16) * 2048 + pn * 256 + bj * HALF + cw; xv[m][bj][0] = *(const f32x4*)xi; xv[m][bj][1] = *(const f32x4*)(xi + 4); }
#pragma unroll
            for (int m = 0; m < 4; ++m) {
                const int rl = ai * HALF + rl0 + m * 16; float s = 0.f;
#pragma unroll
                for (int bj = 0; bj < 2; ++bj) {
                    const int col = pn * 256 + bj * HALF + cw;
                    const f32x4 v0 = xv[m][bj][0] + acc[ai][bj][m][0], v1 = xv[m][bj][1] + acc[ai][bj][m][1];
                    *(u32x4*)(X1 + (size_t)(rowt + rl) * 2048 + col) = pack8(v0, v1);
                    s += (v0[0] * v0[0] + v0[1] * v0[1]) + (v0[2] * v0[2] + v0[3] * v0[3]) + (v1[0] * v1[0] + v1[1] * v1[1]) + (v1[2] * v1[2] + v1[3] * v1[3]);
                }
                s += __shfl_xor(s, 16); s += __shfl_xor(s, 32);
                if (fq == 0) red[rl * 4 + wc] = s;
            }
            asm volatile("" ::: "memory");
        }
        PG8_LBAR();
        if (threadIdx.x < 256) { const f32x4 p = *(const PG8_LAS f32x4*)(red + threadIdx.x * 4); ssq[(size_t)(rowt + threadIdx.x) * 8 + pn] = (p[0] + p[1]) + (p[2] + p[3]); }
        PG8_LBAR();
    }
};

struct EpiGU {
    static constexpr bool PERM = true, AFTER_DRAIN = false;
    bf16_t* H; const float* ssq;
    __device__ __forceinline__ void operator()(const f32x4 (&acc)[2][2][4][2], const Unit& u, int wr, int wc, int fr, int fq) const {
        int rl0 = wr * 64 + fr, cw = wc * 32 + 8 * fq; asm volatile("" : "+v"(rl0), "+v"(cw));
        const int pn = u.pn, rowt = u.pm * BM;
        f32x4 pa[2][4], pb[2][4];
#pragma unroll
        for (int ai = 0; ai < 2; ++ai)
#pragma unroll
            for (int m = 0; m < 4; ++m) { const float* p = ssq + (size_t)(rowt + ai * HALF + rl0 + m * 16) * 8; pa[ai][m] = *(const f32x4*)p; pb[ai][m] = *(const f32x4*)(p + 4); }
#pragma unroll
        for (int ai = 0; ai < 2; ++ai)
#pragma unroll
            for (int m = 0; m < 4; ++m) {
                const size_t row = (size_t)(rowt + ai * HALF + rl0 + m * 16);
                const f32x4 p0 = pa[ai][m], p1 = pb[ai][m];
                const float rs = __builtin_amdgcn_rsqf((((p0[0] + p0[1]) + (p0[2] + p0[3])) + ((p1[0] + p1[1]) + (p1[2] + p1[3]))) * (1.0f / 2048.0f) + 1e-6f);
                f32x4 h[2];
#pragma unroll
                for (int n = 0; n < 2; ++n) {
                    const f32x4 g = acc[ai][0][m][n] * rs, up = acc[ai][1][m][n] * rs;
#pragma unroll
                    for (int j = 0; j < 4; ++j) h[n][j] = g[j] * __builtin_amdgcn_rcpf(1.0f + __builtin_amdgcn_exp2f(-1.4426950408889634f * g[j])) * up[j];
                }
                *(u32x4*)(H + row * 5632 + pn * HALF + cw) = pack8(h[0], h[1]);
            }
    }
};

struct EpiDown {
    static constexpr bool PERM = true, AFTER_DRAIN = false;
    float* Y; float* part; const bf16_t* X1;
    __device__ __forceinline__ void operator()(const f32x4 (&acc)[2][2][4][2], const Unit& u, int wr, int wc, int fr, int fq) const {
        if (u.split) { store_partial(part, 8, acc, u, wr, wc, fr, fq); return; }
        int rl0 = wr * 64 + fr, cw = wc * 32 + 8 * fq; asm volatile("" : "+v"(rl0), "+v"(cw));
        const int pn = u.pn, rowt = u.pm * BM;
        u32x4 xb[2][4][2];
#pragma unroll
        for (int ai = 0; ai < 2; ++ai)
#pragma unroll
            for (int m = 0; m < 4; ++m)
#pragma unroll
                for (int bj = 0; bj < 2; ++bj) xb[ai][m][bj] = *(const u32x4*)(X1 + (size_t)(rowt + ai * HALF + rl0 + m * 16) * 2048 + pn * 256 + bj * HALF + cw);
#pragma unroll
        for (int ai = 0; ai < 2; ++ai)
#pragma unroll
            for (int m = 0; m < 4; ++m)
#pragma unroll
                for (int bj = 0; bj < 2; ++bj) {
                    const size_t off = (size_t)(rowt + ai * HALF + rl0 + m * 16) * 2048 + pn * 256 + bj * HALF + cw;
                    const u32x4 x = xb[ai][m][bj];
                    f32x4 b0, b1; b0[0] = __builtin_bit_cast(float, x.x << 16); b0[1] = __builtin_bit_cast(float, x.x & 0xffff0000u); b0[2] = __builtin_bit_cast(float, x.y << 16); b0[3] = __builtin_bit_cast(float, x.y & 0xffff0000u);
                    b1[0] = __builtin_bit_cast(float, x.z << 16); b1[1] = __builtin_bit_cast(float, x.z & 0xffff0000u); b1[2] = __builtin_bit_cast(float, x.w << 16); b1[3] = __builtin_bit_cast(float, x.w & 0xffff0000u);
                    float* o = Y + off; *(f32x4*)o = b0 + acc[ai][bj][m][0]; *(f32x4*)(o + 4) = b1 + acc[ai][bj][m][1];
                }
    }
};

struct EpiNone {
    static constexpr bool PERM = true, AFTER_DRAIN = false;
    float* sink;
    __device__ __forceinline__ void operator()(const f32x4 (&acc)[2][2][4][2], const Unit& u, int wr, int wc, int fr, int fq) const {
        if (acc[0][0][0][0][0] == 12345.678f && acc[1][1][3][1][3] == -9876.5f) sink[0] = 1.f;
    }
};
template <class Epi, class Sched, bool ALIGN_EPI = false, bool SP2 = false>
__device__ __forceinline__ void gemm_phase(PG8_LAS unsigned char* lds, const Gemm g, const Sched& S, const Epi& E) {
    int tid_ = threadIdx.x; asm volatile("" : "+v"(tid_));
    const int tid = tid_, wid = __builtin_amdgcn_readfirstlane(tid >> 6), lane = tid & 63, wr = wid >> 2, wc = wid & 3, fr = lane & 15, fq = lane >> 4;
    const int K = g.K;
    unsigned voffA[2], voffB[2];
#pragma unroll
    for (int i = 0; i < 2; ++i) { int R, C; stage_rc(tid * 16 + i * 8192, R, C); const int Rb = Epi::PERM ? ((R & ~31) + perm32(R & 31)) : R;
        voffA[i] = (unsigned)(R * K + C) * 2u; voffB[i] = (unsigned)(Rb * K + C) * 2u; }
    const size_t kstep = (size_t)(BK * 2);
    const size_t hstep = (size_t)HALF * K * 2;
    const size_t tstep = 2 * hstep;
    const unsigned ldsw = (unsigned)wid * 1024u;
    const int aoff = lds_byte(wr * 64 + fr, fq * 8), boff = lds_byte(wc * 32 + fr, fq * 8);
#define PG8_SA(b, h) (((b) * 2 + (h)) * HTB)
#define PG8_SB(b, h) ((4 + (b) * 2 + (h)) * HTB)
#define PG8_STAGE(bufoff, gbase, voff) do { _Pragma("unroll") for (int _i = 0; _i < 2; ++_i) \
        __builtin_amdgcn_global_load_lds((const unsigned*)((const char*)(gbase) + (voff)[_i]), (PG8_LAS unsigned*)(lds + (bufoff) + ldsw + _i * 8192), 16, 0, 0); } while (0)
#define PG8_LDA(dst, b, h) do { _Pragma("unroll") for (int m = 0; m < 4; ++m) _Pragma("unroll") for (int k = 0; k < 2; ++k) dst[m][k] = *(const PG8_LAS bf16x8*)(lds + PG8_SA(b, h) + aoff + m * 2048 + k * 1024); } while (0)
#define PG8_LDB(dst, b, h) do { _Pragma("unroll") for (int n = 0; n < 2; ++n) _Pragma("unroll") for (int k = 0; k < 2; ++k) dst[n][k] = *(const PG8_LAS bf16x8*)(lds + PG8_SB(b, h) + boff + n * 2048 + k * 1024); } while (0)
#define PG8_MMA(ai, bj, At, Bt) do { __builtin_amdgcn_s_setprio(1); _Pragma("unroll") for (int m = 0; m < 4; ++m) _Pragma("unroll") for (int n = 0; n < 2; ++n) _Pragma("unroll") for (int k = 0; k < 2; ++k) \
        acc[ai][bj][m][n] = __builtin_amdgcn_mfma_f32_16x16x32_bf16(Bt[n][k], At[m][k], acc[ai][bj][m][n], 0, 0, 0); __builtin_amdgcn_s_setprio(0); } while (0)
#define PG8_WAIT_V(n) asm volatile("s_waitcnt vmcnt(" #n ")" ::: "memory")
#define PG8_WAIT_L(n) asm volatile("s_waitcnt lgkmcnt(" #n ")" ::: "memory")
#define PG8_BAR __builtin_amdgcn_s_barrier()
#define PG8_SCHED __builtin_amdgcn_sched_barrier(0)
    Unit cur, nxt; int ui = 0;
    if (!S.next(0, cur)) return;
    f32x4 acc[2][2][4][2];
#pragma unroll
    for (int a = 0; a < 2; ++a)
#pragma unroll
        for (int b = 0; b < 2; ++b)
#pragma unroll
            for (int m = 0; m < 4; ++m)
#pragma unroll
                for (int n = 0; n < 2; ++n) acc[a][b][m][n] = (f32x4){0.f, 0.f, 0.f, 0.f};
    bf16x8 At[4][2], B0[2][2], B1[2][2];
    const char* cA = (const char*)g.A + (size_t)cur.pm * tstep + (size_t)cur.k0 * kstep; const char* cB = (const char*)g.Bt + (size_t)cur.pn * tstep + (size_t)cur.k0 * kstep;
    S.a_ready(cur);
    if constexpr (SP2) {
        PG8_STAGE(PG8_SB(0, 0), cB, voffB); PG8_STAGE(PG8_SB(0, 1), cB + hstep, voffB); PG8_STAGE(PG8_SA(0, 0), cA, voffA); PG8_STAGE(PG8_SA(0, 1), cA + hstep, voffA);
        if (wr == 1) PG8_BAR;
        PG8_WAIT_V(2); PG8_BAR;
        PG8_STAGE(PG8_SB(1, 0), cB + kstep, voffB); PG8_STAGE(PG8_SA(1, 0), cA + kstep, voffA); PG8_STAGE(PG8_SB(1, 1), cB + hstep + kstep, voffB);
        PG8_WAIT_V(6); PG8_BAR;
    } else {
        PG8_STAGE(PG8_SB(0, 0), cB, voffB); PG8_STAGE(PG8_SA(0, 0), cA, voffA); PG8_STAGE(PG8_SB(0, 1), cB + hstep, voffB); PG8_STAGE(PG8_SA(0, 1), cA + hstep, voffA);
        if (wr == 1) PG8_BAR;
        PG8_WAIT_V(4); PG8_BAR;
        PG8_STAGE(PG8_SB(1, 0), cB + kstep, voffB); PG8_STAGE(PG8_SA(1, 0), cA + kstep, voffA); PG8_STAGE(PG8_SB(1, 1), cB + hstep + kstep, voffB);
        PG8_WAIT_V(6); PG8_BAR;
    }
    for (;;) {
        const bool has_next = S.next(ui + 1, nxt);
        const char* nA = has_next ? (const char*)g.A + (size_t)nxt.pm * tstep + (size_t)nxt.k0 * kstep : cA; const char* nB = has_next ? (const char*)g.Bt + (size_t)nxt.pn * tstep + (size_t)nxt.k0 * kstep : cB;
        const int nt = cur.nt;
        for (int t = 0; t < nt; t += 2) {
            const bool last = (t == nt - 2);
            const char* a1 = cA + (size_t)(t + 1) * kstep;
            const char* a2 = last ? nA : cA + (size_t)(t + 2) * kstep; const char* b2 = last ? nB : cB + (size_t)(t + 2) * kstep;
            const char* a3 = a2 + kstep; const char* b3 = b2 + kstep;
            if (last && has_next) S.a_ready(nxt);
            if constexpr (SP2) {
            PG8_LDB(B0, 0, 0); PG8_LDB(B1, 0, 1); PG8_SCHED; PG8_LDA(At, 0, 0); PG8_STAGE(PG8_SA(1, 1), a1 + hstep, voffA);
            PG8_WAIT_V(8); PG8_WAIT_L(0); PG8_BAR; PG8_MMA(0, 0, At, B0); PG8_MMA(0, 1, At, B1); PG8_BAR; PG8_SCHED;
            PG8_LDA(At, 0, 1); PG8_STAGE(PG8_SB(0, 0), b2, voffB); PG8_STAGE(PG8_SB(0, 1), b2 + hstep, voffB); PG8_STAGE(PG8_SA(0, 0), a2, voffA);
            PG8_WAIT_V(8); PG8_WAIT_L(0); PG8_BAR; PG8_MMA(1, 0, At, B0); PG8_MMA(1, 1, At, B1); PG8_BAR; PG8_SCHED;
            PG8_LDB(B0, 1, 0); PG8_LDB(B1, 1, 1); PG8_SCHED; PG8_LDA(At, 1, 0); PG8_STAGE(PG8_SA(0, 1), a2 + hstep, voffA);
            PG8_WAIT_V(8); PG8_WAIT_L(0); PG8_BAR; PG8_MMA(0, 0, At, B0); PG8_MMA(0, 1, At, B1); PG8_BAR; PG8_SCHED;
            PG8_LDA(At, 1, 1); PG8_STAGE(PG8_SB(1, 0), b3, voffB); PG8_STAGE(PG8_SB(1, 1), b3 + hstep, voffB); PG8_STAGE(PG8_SA(1, 0), a3, voffA);
            PG8_WAIT_V(8); PG8_WAIT_L(0); PG8_BAR; PG8_MMA(1, 0, At, B0); PG8_MMA(1, 1, At, B1); PG8_BAR; PG8_SCHED;
            } else {
            PG8_LDB(B0, 0, 0); PG8_SCHED; PG8_LDA(At, 0, 0); PG8_STAGE(PG8_SA(1, 1), a1 + hstep, voffA);
            PG8_WAIT_L(8); PG8_BAR; PG8_WAIT_L(0); PG8_MMA(0, 0, At, B0); PG8_BAR; PG8_SCHED;
            PG8_LDB(B1, 0, 1); PG8_STAGE(PG8_SB(0, 0), b2, voffB);
            PG8_BAR; PG8_WAIT_L(0); PG8_MMA(0, 1, At, B1); PG8_BAR;
            PG8_LDA(At, 0, 1); PG8_STAGE(PG8_SA(0, 0), a2, voffA);
            PG8_BAR; PG8_WAIT_L(0); PG8_MMA(1, 0, At, B0); PG8_BAR; PG8_SCHED;
            PG8_STAGE(PG8_SB(0, 1), b2 + hstep, voffB);
            PG8_WAIT_V(6); PG8_BAR; PG8_MMA(1, 1, At, B1); PG8_BAR;
            PG8_LDB(B0, 1, 0); PG8_SCHED; PG8_LDA(At, 1, 0); PG8_STAGE(PG8_SA(0, 1), a2 + hstep, voffA);
            PG8_WAIT_L(8); PG8_BAR; PG8_WAIT_L(0); PG8_MMA(0, 0, At, B0); PG8_BAR; PG8_SCHED;
            PG8_LDB(B1, 1, 1); PG8_STAGE(PG8_SB(1, 0), b3, voffB);
            PG8_BAR; PG8_WAIT_L(0); PG8_MMA(0, 1, At, B1); PG8_BAR;
            PG8_LDA(At, 1, 1); PG8_STAGE(PG8_SA(1, 0), a3, voffA);
            PG8_BAR; PG8_WAIT_L(0); PG8_MMA(1, 0, At, B0); PG8_BAR; PG8_SCHED;
            PG8_STAGE(PG8_SB(1, 1), b3 + hstep, voffB);
            PG8_WAIT_V(6); PG8_BAR; PG8_MMA(1, 1, At, B1); PG8_BAR;
            }
        }
        if constexpr (ALIGN_EPI) { if (wr == 0) PG8_BAR; }
        if constexpr (!Epi::AFTER_DRAIN) { E(acc, cur, wr, wc, fr, fq); S.done(cur); }
        if (!has_next) break;
#pragma unroll
        for (int a = 0; a < 2; ++a)
#pragma unroll
            for (int b = 0; b < 2; ++b)
#pragma unroll
                for (int m = 0; m < 4; ++m)
#pragma unroll
                    for (int n = 0; n < 2; ++n) acc[a][b][m][n] = (f32x4){0.f, 0.f, 0.f, 0.f};
        cur = nxt; cA = nA; cB = nB; ++ui;
        if constexpr (ALIGN_EPI) { if (wr == 1) PG8_BAR; }
    }
    PG8_WAIT_V(0);
    if constexpr (!ALIGN_EPI) { if (wr == 0) PG8_BAR; }
    PG8_BAR;
    if constexpr (Epi::AFTER_DRAIN) { E.fused(acc, cur, wr, wc, fr, fq, lds, wid, lane); S.done(cur); }
#undef PG8_SA
#undef PG8_SB
#undef PG8_STAGE
#undef PG8_LDA
#undef PG8_LDB
#undef PG8_MMA
#undef PG8_WAIT_V
#undef PG8_WAIT_L
#undef PG8_BAR
#undef PG8_SCHED
}
}
#define LAS __attribute__((address_space(3)))
typedef unsigned short bf16;
typedef float f32x4 __attribute__((ext_vector_type(4)));
typedef float f32x16 __attribute__((ext_vector_type(16)));
typedef short bf16x8 __attribute__((ext_vector_type(8)));
typedef short s16x4 __attribute__((ext_vector_type(4)));
typedef unsigned u32x4 __attribute__((ext_vector_type(4)));
typedef unsigned u32x2 __attribute__((ext_vector_type(2)));
constexpr int DM = 2048, SEQ = 4096, NP = 8192, NS = 512, MT = NP + NS, AW = 1024, CC = 1024, INC = 6144, DFF = 5632, PAST = 4096, DSEQ = 64;
constexpr float EPS = 1e-6f;
constexpr size_t OFF_Y = 0, OFF_KP = (size_t)MT * DM, OFF_VP = OFF_KP + (size_t)NP * AW, OFF_CP = OFF_VP + (size_t)NP * AW, OFF_KS = OFF_CP + 2 * 2 * CC,
                 OFF_VS = OFF_KS + (size_t)NS * AW, OFF_CS = OFF_VS + (size_t)NS * AW, OUT_TOTAL = OFF_CS + 8 * 2 * CC;
static_assert(OUT_TOTAL == 35672064, "output size");
constexpr size_t MiB = 1u << 20;
constexpr size_t WS_CTL = 0, WS_WIN = 1 * MiB, WS_WOUT = 25 * MiB, WS_WGU = 33 * MiB, WS_WDN = 77 * MiB, WS_HN = 99 * MiB, WS_Q = 133 * MiB, WS_K = 150 * MiB, WS_V = 166 * MiB,
                 WS_GB = 182 * MiB, WS_U = 199 * MiB, WS_MIX = 216 * MiB, WS_SSQ = 250 * MiB, WS_TP = 251 * MiB, WS_OP = 256 * MiB, WS_H = 256 * MiB, WS_PART = 133 * MiB  ;
constexpr int NSLOT = 256 + 16;
constexpr size_t WS_END = WS_OP + (size_t)NSLOT * 131072;
constexpr int RING_BYTES = 131072, RED_OFF = RING_BYTES, MISC_OFF = RED_OFF + 8192, LDS_BYTES = 147456;
constexpr int NWAVES = 8;

#define XB_TMO      128
#define XB_XCNT(j)  (256  + 64 * (j))
#define XB_XSUB(j)  (1280 + 64 * (j))
#define XB_XGEN(j)  (2304 + 64 * (j))
#define XB_TOP      3328
#define XB_TOPGEN   3392
#define XCD_BAR_WORDS 3456
#define XB_SPIN_CAP (1u << 18)

__device__ __forceinline__ unsigned xb_ld(unsigned* p)              { return __hip_atomic_load(p, __ATOMIC_RELAXED, __HIP_MEMORY_SCOPE_AGENT); }
__device__ __forceinline__ unsigned xb_add(unsigned* p, unsigned v) { return __hip_atomic_fetch_add(p, v, __ATOMIC_RELAXED, __HIP_MEMORY_SCOPE_AGENT); }
__device__ __forceinline__ unsigned xb_xcc_id() { return (unsigned)__builtin_amdgcn_s_getreg((3 << 11) | 20) & 0xFu; }
#define XB_SPIN(cond, bar) do { unsigned _sp = 0; while (cond) { __builtin_amdgcn_s_sleep(1); \
    if ((++_sp & 255u) == 0u) { if (xb_ld(&(bar)[XB_TMO])) break; if (_sp > XB_SPIN_CAP) { atomicAdd(&(bar)[XB_TMO], 1u); break; } } } } while (0)

struct XcdBarrier {
    unsigned* bar; unsigned x;
    volatile LAS unsigned* st;
};

__device__ __forceinline__ XcdBarrier xcd_barrier_post(unsigned* bar, volatile LAS unsigned* st) {
    XcdBarrier b; b.bar = bar; b.x = xb_xcc_id(); b.st = st;
    if (threadIdx.x == 0) (void)xb_add(&bar[XB_XCNT(b.x)], 1u);
    return b;
}
__device__ __forceinline__ void xcd_barrier_complete(unsigned* bar, unsigned x, unsigned& nloc, unsigned& nx) {
    const unsigned G = gridDim.x * gridDim.y * gridDim.z;
    unsigned sum, cnt, mine, sp = 0u;
    for (;;) {
        sum = 0u; cnt = 0u; mine = 0u;
#pragma unroll
        for (unsigned j = 0; j < 16; ++j) { const unsigned c = xb_ld(&bar[XB_XCNT(j)]); sum += c; cnt += (c > 0u) ? 1u : 0u; mine = (j == x) ? c : mine; }
        if (sum == G) break;
        __builtin_amdgcn_s_sleep(1);
        if ((++sp & 255u) == 0u) { if (xb_ld(&bar[XB_TMO])) break; if (sp > XB_SPIN_CAP) { atomicAdd(&bar[XB_TMO], 1u); break; } }
    }
    nloc = mine > 0u ? mine : 1u; nx = cnt > 0u ? cnt : 1u;
}

__device__ __forceinline__ void xcd_barrier(const XcdBarrier& b) {
    asm volatile("s_waitcnt vmcnt(0)" ::: "memory");
    __syncthreads();
    if (threadIdx.x == 0) {
        unsigned* bar = b.bar;
        __builtin_amdgcn_s_waitcnt(0);
        unsigned nloc = b.st[0], nx = b.st[1];
        if (nloc == 0u) { xcd_barrier_complete(bar, b.x, nloc, nx); b.st[0] = nloc; b.st[1] = nx; }
        const unsigned old = xb_add(&bar[XB_XSUB(b.x)], 1u);
        const unsigned gen = old / nloc;
        if (old + 1u == (gen + 1u) * nloc) {
            __builtin_amdgcn_fence(__ATOMIC_RELEASE, "agent");
            asm volatile("s_waitcnt vmcnt(0)" ::: "memory");
            const unsigned og = xb_add(&bar[XB_TOP], 1u);
            const unsigned tg = og / nx;
            if (og + 1u == (tg + 1u) * nx) xb_add(&bar[XB_TOPGEN], 1u);
            else XB_SPIN(xb_ld(&bar[XB_TOPGEN]) == tg, bar);
            __builtin_amdgcn_fence(__ATOMIC_ACQUIRE, "agent");
            xb_add(&bar[XB_XGEN(b.x)], 1u);
            asm volatile("s_waitcnt vmcnt(0)" ::: "memory");
        } else {
            XB_SPIN(xb_ld(&bar[XB_XGEN(b.x)]) == gen, bar);
            __builtin_amdgcn_fence(__ATOMIC_ACQUIRE, "agent");
            asm volatile("s_waitcnt vmcnt(0)" ::: "memory");
        }
    }
    __syncthreads();
}

struct ItemTab { int n; int v[272]; };
constexpr int p_nsteps(int qb, int c) { return 8 * (qb + 1); }
constexpr ItemTab make_items() {
    ItemTab t{}; t.n = 0;
    for (int b = 0; b < 8; ++b) for (int hg = 0; hg < 2; ++hg) t.v[t.n++] = 1 | (b << 1) | (hg << 4);
    for (int qb = 15; qb >= 0; --qb) for (int bh = 0; bh < 16; ++bh) t.v[t.n++] = (bh << 1) | (qb << 5);
    return t;
}
__device__ const ItemTab g_items = make_items();

__device__ __forceinline__ unsigned f2bf(float f) { unsigned u = __builtin_bit_cast(unsigned, f); return (u + 0x7fffu + ((u >> 16) & 1u)) >> 16; }
__device__ __forceinline__ unsigned pk2(float lo, float hi) { return pg8::cvt_pk_bf16(lo, hi); }
__device__ __forceinline__ float bflo(unsigned w) { return __builtin_bit_cast(float, w << 16); }
__device__ __forceinline__ float bfhi(unsigned w) { return __builtin_bit_cast(float, w & 0xffff0000u); }
__device__ __forceinline__ int crow(int r, int hi) { return (r & 3) + 8 * (r >> 2) + 4 * hi; }
__device__ __forceinline__ float wave_sum(float v) {
#pragma unroll
    for (int o = 1; o < 64; o <<= 1) v += __shfl_xor(v, o);
    return v;
}

struct Args { const float* in[17]; float* out; unsigned char* ws; };

struct P0Item { const float* src; const float* gk; bf16* dst; int N, K, k0; };
__device__ __forceinline__ P0Item p0_decode(const Args& a, int it) {
    constexpr int I_IN = 32 * 192, I_OUT = 32 * 64, I_G = 32 * 176;
    unsigned char* ws = a.ws; P0Item r; int n0, kb, drow; r.gk = nullptr;
    if (it < I_IN) { kb = it / 192; n0 = 32 * (it % 192); drow = n0;
        if (n0 >= 5120) { const int ch = n0 - 5120; drow = 4096 + (ch >> 7) * 256 + 128 + (ch & 127); } else if (n0 >= 4096) { const int ch = n0 - 4096; drow = 4096 + (ch >> 7) * 256 + (ch & 127); }
        r.src = a.in[6]; r.N = INC; r.K = DM; r.dst = (bf16*)(ws + WS_WIN); }
    else if ((it -= I_IN) < I_OUT) { kb = it / 64; n0 = 32 * (it % 64); drow = n0; r.src = a.in[12]; r.N = DM; r.K = DM; r.dst = (bf16*)(ws + WS_WOUT); }
    else if ((it -= I_OUT) < 2 * I_G) { const int up = it >= I_G; if (up) it -= I_G; kb = it / 176; n0 = 32 * (it % 176); drow = (n0 >> 7) * 256 + up * 128 + (n0 & 127);
        r.src = a.in[up ? 15 : 14]; r.N = DFF; r.K = DM; r.dst = (bf16*)(ws + WS_WGU); r.gk = a.in[13]; }
    else { it -= 2 * I_G; kb = it / 64; n0 = 32 * (it % 64); drow = n0; r.src = a.in[16]; r.N = DM; r.K = DFF; r.dst = (bf16*)(ws + WS_WDN); }
    r.k0 = 64 * kb; r.src += (size_t)r.k0 * r.N + n0; r.dst += (size_t)drow * r.K + r.k0;
    return r;
}
__device__ __forceinline__ void p0_load(const P0Item& p, f32x4 (&v)[8], int lane) {
#pragma unroll
    for (int j = 0; j < 8; ++j) v[j] = __builtin_nontemporal_load((const f32x4*)(p.src + (size_t)(8 * j + (lane >> 3)) * p.N + 4 * (lane & 7)));
}
__device__ __forceinline__ void p0_finish(const P0Item& p, const f32x4 (&v)[8], LAS float* scr, int lane) {
#pragma unroll
    for (int j = 0; j < 8; ++j) { const int kk = 8 * j + (lane >> 3); const float g = p.gk ? p.gk[p.k0 + kk] : 1.0f; LAS float* s = scr + kk * 33 + 4 * (lane & 7);
        s[0] = v[j][0] * g; s[1] = v[j][1] * g; s[2] = v[j][2] * g; s[3] = v[j][3] * g; }
    asm volatile("s_waitcnt lgkmcnt(0)" ::: "memory");
    const int c = lane & 7;
#pragma unroll
    for (int j = 0; j < 4; ++j) { const int n = (lane >> 3) + 8 * j; const LAS float* s = scr + (8 * c) * 33 + n;
        u32x4 o; o.x = pk2(s[0 * 33], s[1 * 33]); o.y = pk2(s[2 * 33], s[3 * 33]); o.z = pk2(s[4 * 33], s[5 * 33]); o.w = pk2(s[6 * 33], s[7 * 33]);
        *(u32x4*)(p.dst + (size_t)n * p.K + 8 * c) = o; }
    asm volatile("s_waitcnt lgkmcnt(0)" ::: "memory");
}
constexpr int P0_EARLY_ITEMS = 32 * 192 + 32 * 64, P0_ALL_ITEMS = 32 * 192 + 32 * 64 + 2 * 32 * 176 + 88 * 64, P0_CHUNK = 32, P0_LATE_CHUNKS = (P0_ALL_ITEMS - P0_EARLY_ITEMS) / P0_CHUNK;
static_assert((P0_ALL_ITEMS - P0_EARLY_ITEMS) % P0_CHUNK == 0, "late conversion items come in whole chunks");
__device__ __forceinline__ void p0_run_range(const Args& a, LAS float* scr, int first, int n, int lane) {
    f32x4 va[8], vb[8]; P0Item pa, pb;
    pa = p0_decode(a, first); p0_load(pa, va, lane);
    for (int i = 0; i < n; i += 2) {
        if (i + 1 < n) { pb = p0_decode(a, first + i + 1); p0_load(pb, vb, lane); }
        p0_finish(pa, va, scr, lane);
        if (i + 1 >= n) break;
        if (i + 2 < n) { pa = p0_decode(a, first + i + 2); p0_load(pa, va, lane); }
        p0_finish(pb, vb, scr, lane);
    }
}
__device__ __forceinline__ void p0_prologue(const Args& a, LAS unsigned char* lds, int gw, int NGW, int lane, int wave) {
    LAS float* scr = (LAS float*)(lds + wave * 16384);
    unsigned char* ws = a.ws;
    constexpr int NITEMS = P0_EARLY_ITEMS;
    {
        int it = gw; f32x4 va[8], vb[8]; P0Item pa, pb;
        if (it < NITEMS) { pa = p0_decode(a, it); p0_load(pa, va, lane); }
        while (it < NITEMS) {
            const int itb = it + NGW;
            if (itb < NITEMS) { pb = p0_decode(a, itb); p0_load(pb, vb, lane); }
            p0_finish(pa, va, scr, lane);
            it = itb + NGW;
            if (itb >= NITEMS) break;
            if (it < NITEMS) { pa = p0_decode(a, it); p0_load(pa, va, lane); }
            p0_finish(pb, vb, scr, lane);
        }
    }
    const float* g1 = a.in[5];
    for (int m = gw; m < MT; m += NGW) {
        const float* xrow = m < NP ? a.in[0] + (size_t)m * DM : a.in[1] + (size_t)(m - NP) * DM;
        const f32x4* xr = (const f32x4*)xrow + lane; f32x4 v[8]; float s = 0.f;
#pragma unroll
        for (int j = 0; j < 8; ++j) { v[j] = xr[64 * j]; s += (v[j][0] * v[j][0] + v[j][1] * v[j][1]) + (v[j][2] * v[j][2] + v[j][3] * v[j][3]); }
        const float rs = __builtin_amdgcn_rsqf(wave_sum(s) * (1.0f / DM) + EPS);
        u32x2* o = (u32x2*)((bf16*)(ws + WS_HN) + (size_t)m * DM) + lane;
#pragma unroll
        for (int j = 0; j < 8; ++j) { const f32x4 g = *((const f32x4*)g1 + 64 * j + lane); u32x2 w; w.x = pk2(v[j][0] * rs * g[0], v[j][1] * rs * g[1]); w.y = pk2(v[j][2] * rs * g[2], v[j][3] * rs * g[3]); o[64 * j] = w; }
    }
}


template <int VS, bool QREG>
__device__ __forceinline__ void sb_block(f32x16 (&o)[4], float& R, const LAS unsigned char* kp, const LAS unsigned char* vp, const bf16x8 (&qreg)[8], const LAS unsigned char* qlp, int kb, int qw, int qpos, int hi) {
            f32x16 p;
#pragma unroll
            for (int r = 0; r < 16; ++r) p[r] = 0.f;
#pragma unroll
            for (int d0 = 0; d0 < 8; ++d0) { const bf16x8 kf = *(const LAS bf16x8*)(kp + d0 * 32); const bf16x8 qf = QREG ? qreg[d0] : *(const LAS bf16x8*)(qlp + d0 * 32); p = __builtin_amdgcn_mfma_f32_32x32x16_bf16(kf, qf, p, 0, 0, 0); }
            const bool need_mask = (kb + 31 >= qw);
            float e[16], sf[16];
#pragma unroll
            for (int r = 0; r < 16; ++r) {
                const float z = fminf(p[r], 100.f); float ee = __builtin_amdgcn_exp2f(z); float rr = __builtin_amdgcn_rcpf(1.0f + ee);
                if (need_mask) { const bool msk = (kb + crow(r, hi)) >= qpos; ee = msk ? 0.f : ee; rr = msk ? 1.f : rr; }
                e[r] = ee; sf[r] = rr;
            }
            float oth[4], PP[4];
#pragma unroll
            for (int g = 0; g < 4; ++g) { sf[4 * g + 2] *= sf[4 * g + 3]; sf[4 * g + 1] *= sf[4 * g + 2]; sf[4 * g] *= sf[4 * g + 1]; oth[g] = __shfl_xor(sf[4 * g], 32); PP[g] = sf[4 * g] * oth[g]; }
            const float SP3 = PP[3], SP2 = PP[2] * SP3, SP1 = PP[1] * SP2, SP0 = PP[0] * SP1;
            float A[4]; A[0] = R * SP1; A[1] = R * SP2; A[2] = R * SP3; A[3] = R;
#pragma unroll
            for (int g = 0; g < 4; ++g) A[g] = hi ? A[g] : A[g] * oth[g];
            R *= SP0;
            float w[16];
#pragma unroll
            for (int r = 0; r < 16; ++r) w[r] = (e[r] * sf[r]) * A[r >> 2];
#pragma unroll
            for (int s2 = 0; s2 < 2; ++s2) {
                u32x4 pw; pw.x = pk2(w[8 * s2 + 0], w[8 * s2 + 1]); pw.y = pk2(w[8 * s2 + 2], w[8 * s2 + 3]); pw.z = pk2(w[8 * s2 + 4], w[8 * s2 + 5]); pw.w = pk2(w[8 * s2 + 6], w[8 * s2 + 7]);
                const bf16x8 pa = __builtin_bit_cast(bf16x8, pw);
#pragma unroll
                for (int db = 0; db < 4; ++db) {
                    const s16x4 lo = __builtin_bit_cast(s16x4, __builtin_amdgcn_ds_read_tr16_b64_v4i16((LAS s16x4*)(vp + (16 * s2) * VS + db * 64)));
                    const s16x4 hh = __builtin_bit_cast(s16x4, __builtin_amdgcn_ds_read_tr16_b64_v4i16((LAS s16x4*)(vp + (16 * s2 + 8) * VS + db * 64)));
                    const bf16x8 vb = __builtin_shufflevector(lo, hh, 0, 1, 2, 3, 4, 5, 6, 7);
                    o[db] = __builtin_amdgcn_mfma_f32_32x32x16_bf16(pa, vb, o[db], 0, 0, 0);
                }
            }
}

template <bool SAMPLE>
__device__ __forceinline__ void attn_item(const Args& a, LAS unsigned char* lds, int code) {
    constexpr int NH = SAMPLE ? 4 : 1, KS = NH * 256 + 16, VS = NH * 256 + 32, K_OFF = 0, V_OFF = 32 * KS;
    int tid_ = threadIdx.x; asm volatile("" : "+v"(tid_));
    const int tid = tid_, lane = tid & 63, r32 = lane & 31, hi = lane >> 5; const int wid = __builtin_amdgcn_readfirstlane(tid >> 6);
    unsigned char* ws = a.ws;
    int slot, nsteps, kvpos0, qw, head, hl; size_t qrow;
    const bf16 *kgb = nullptr, *vgb = nullptr; const float *kgf = nullptr, *vgf = nullptr, *kgn = nullptr, *vgn = nullptr;
    if (SAMPLE) {
        const int b = (code >> 1) & 7, hg = (code >> 4) & 1;
        slot = 256 + b * 2 + hg; hl = wid >> 1; head = hg * 4 + hl; const int rg = wid & 1;
        qw = PAST + 32 * rg; qrow = (size_t)NP + b * DSEQ + 32 * rg + r32;
        nsteps = 130; kvpos0 = 0;
        kgf = a.in[2] + ((size_t)b * PAST + (tid >> 7)) * AW + hg * 512 + 4 * (tid & 127); vgf = a.in[3] + ((size_t)b * PAST + (tid >> 7)) * AW + hg * 512 + 4 * (tid & 127);
        kgn = a.out + OFF_KS + ((size_t)b * DSEQ + (tid >> 7)) * AW + hg * 512 + 4 * (tid & 127); vgn = a.out + OFF_VS + ((size_t)b * DSEQ + (tid >> 7)) * AW + hg * 512 + 4 * (tid & 127);
    } else {
        const int bh = (code >> 1) & 15, qb = (code >> 5) & 15, c = (code >> 9) & 3, b = bh >> 3;
        head = bh & 7; hl = 0; slot = bh * 16 + qb + 0 * c; nsteps = p_nsteps(qb, c); kvpos0 = 0;
        qw = qb * 256 + 32 * wid; qrow = (size_t)b * SEQ + qw + r32;
        kgb = (const bf16*)(ws + WS_K) + ((size_t)b * SEQ + kvpos0 + (tid >> 4)) * AW + head * 128 + (tid & 15) * 8;
        vgb = (const bf16*)(ws + WS_V) + ((size_t)b * SEQ + kvpos0 + (tid >> 4)) * AW + head * 128 + (tid & 15) * 8;
    }
    const int qpos = qw + r32;
    constexpr int Q_OFF = 67584, QS = 272;
    const LAS unsigned char* qlp = lds + Q_OFF + wid * (32 * QS) + r32 * QS + hi * 16;
    { const bf16* qp = (const bf16*)(ws + WS_Q) + qrow * AW + head * 128 + hi * 8;
#pragma unroll
      for (int d0 = 0; d0 < 8; ++d0) *(LAS bf16x8*)(lds + Q_OFF + wid * (32 * QS) + r32 * QS + hi * 16 + d0 * 32) = *(const bf16x8*)(qp + 16 * d0); }
    f32x16 o[4];
#pragma unroll
    for (int i = 0; i < 4; ++i)
#pragma unroll
        for (int r = 0; r < 16; ++r) o[i][r] = 0.f;
    float R = 1.f;
    u32x4 kreg, vreg; f32x4 kf4[8], vf4[8];
#define ATT_LOADK(s_) do { if (SAMPLE) { _Pragma("unroll") for (int i_ = 0; i_ < 8; ++i_) kf4[i_] = *(const f32x4*)(((s_) >= 128 ? kgn + (size_t)((s_) - 128) * 32 * AW : kgf + (size_t)(s_) * 32 * AW) + (size_t)i_ * 4 * AW); } \
        else { kreg = *(const u32x4*)(kgb + (size_t)(s_) * 32 * AW); } } while (0)
#define ATT_LOADV(s_) do { if (SAMPLE) { _Pragma("unroll") for (int i_ = 0; i_ < 8; ++i_) vf4[i_] = *(const f32x4*)(((s_) >= 128 ? vgn + (size_t)((s_) - 128) * 32 * AW : vgf + (size_t)(s_) * 32 * AW) + (size_t)i_ * 4 * AW); } \
        else { vreg = *(const u32x4*)(vgb + (size_t)(s_) * 32 * AW); } } while (0)
#define ATT_STOREK() do { if (SAMPLE) { _Pragma("unroll") for (int i_ = 0; i_ < 8; ++i_) { const int key_ = (tid >> 7) + 4 * i_, f4_ = tid & 127; \
            u32x2 kw_; kw_.x = pk2(kf4[i_][0], kf4[i_][1]); kw_.y = pk2(kf4[i_][2], kf4[i_][3]); *(LAS u32x2*)(lds + K_OFF + key_ * KS + f4_ * 8) = kw_; } } \
        else { *(LAS u32x4*)(lds + K_OFF + (tid >> 4) * KS + (tid & 15) * 16) = kreg; } } while (0)
#define ATT_STOREV() do { if (SAMPLE) { _Pragma("unroll") for (int i_ = 0; i_ < 8; ++i_) { const int key_ = (tid >> 7) + 4 * i_, f4_ = tid & 127; \
            u32x2 vw_; vw_.x = pk2(vf4[i_][0], vf4[i_][1]); vw_.y = pk2(vf4[i_][2], vf4[i_][3]); *(LAS u32x2*)(lds + V_OFF + key_ * VS + f4_ * 8) = vw_; } } \
        else { *(LAS u32x4*)(lds + V_OFF + (tid >> 4) * VS + (tid & 15) * 16) = vreg; } } while (0)
    volatile LAS int* flg = (volatile LAS int*)(lds + MISC_OFF + 64);
    ATT_LOADK(nsteps - 1); ATT_LOADV(nsteps - 1);
    ATT_STOREK(); ATT_STOREV();
    __syncthreads();
    const LAS unsigned char* kp = lds + K_OFF + r32 * KS + hl * 256 + hi * 16;
    const LAS unsigned char* vp = lds + V_OFF + (4 * hi + ((lane & 15) >> 2)) * VS + hl * 256 + (16 * ((lane >> 4) & 1) + 4 * (lane & 3)) * 2;
    for (int s = nsteps - 1; s >= 0; --s) {
        if (s > 0) { ATT_LOADK(s - 1); if (!SAMPLE) ATT_LOADV(s - 1); }
        const int kb = kvpos0 + 32 * s;
        if (kb < qw + 32 && !__all(R == 0.f)) { const bf16x8 qdummy[8] = {}; sb_block<VS, false>(o, R, kp, vp, qdummy, qlp, kb, qw, qpos, hi); }
        if (lane == 0) flg[wid] = __all(R == 0.f) ? 1 : 0;
        __syncthreads();
        const bool alldone = (flg[0] & flg[1] & flg[2] & flg[3] & flg[4] & flg[5] & flg[6] & flg[7]) != 0;
        if (alldone) { __syncthreads(); break; }
        if (s > 0) { ATT_STOREK(); if (SAMPLE) ATT_LOADV(s - 1); ATT_STOREV(); }
        __syncthreads();
    }
#undef ATT_LOADK
#undef ATT_LOADV
#undef ATT_STOREK
#undef ATT_STOREV
    float* op = (float*)(ws + WS_OP) + ((size_t)(slot * 8 + wid) * 32) * 128;
#pragma unroll
    for (int db = 0; db < 4; ++db)
#pragma unroll
        for (int r = 0; r < 16; ++r) op[crow(r, hi) * 128 + db * 32 + r32] = o[db][r];
    if (hi == 0) ((float*)(ws + WS_TP))[(slot * 8 + wid) * 32 + r32] = R;
}


__device__ __forceinline__ void attn_item_p(const Args& a, LAS unsigned char* lds, int code) {
    constexpr int KS = 272, VS = 288, TILE_K = 64 * KS, BUF = TILE_K + 64 * VS;
    int tid_ = threadIdx.x; asm volatile("" : "+v"(tid_));
    const int tid = tid_, lane = tid & 63, r32 = lane & 31, hi = lane >> 5; const int wid = __builtin_amdgcn_readfirstlane(tid >> 6);
    unsigned char* ws = a.ws;
    const int bh = (code >> 1) & 15, qb = (code >> 5) & 15, c = (code >> 9) & 3, b = bh >> 3, head = bh & 7;
    const int slot = bh * 16 + qb + 0 * c, nst = p_nsteps(qb, c) >> 1, kvpos0 = 0;
    const int qw = qb * 256 + 32 * wid, qpos = qw + r32; const size_t qrow = (size_t)b * SEQ + qpos;
    const bf16* kgb = (const bf16*)(ws + WS_K) + ((size_t)b * SEQ + kvpos0 + (tid >> 4)) * AW + head * 128 + (tid & 15) * 8;
    const bf16* vgb = (const bf16*)(ws + WS_V) + ((size_t)b * SEQ + kvpos0 + (tid >> 4)) * AW + head * 128 + (tid & 15) * 8;
    bf16x8 qf[8];
    { const bf16* qp = (const bf16*)(ws + WS_Q) + qrow * AW + head * 128 + hi * 8;
#pragma unroll
      for (int d0 = 0; d0 < 8; ++d0) qf[d0] = *(const bf16x8*)(qp + 16 * d0); }
    f32x16 o[4];
#pragma unroll
    for (int i = 0; i < 4; ++i)
#pragma unroll
        for (int r = 0; r < 16; ++r) o[i][r] = 0.f;
    float R = 1.f;
    u32x4 kreg[2], vreg[2];
#define PLOAD(s_) do { _Pragma("unroll") for (int i_ = 0; i_ < 2; ++i_) { kreg[i_] = *(const u32x4*)(kgb + (size_t)((s_) * 64 + 32 * i_) * AW); vreg[i_] = *(const u32x4*)(vgb + (size_t)((s_) * 64 + 32 * i_) * AW); } } while (0)
#define PSTORE(buf_) do { _Pragma("unroll") for (int i_ = 0; i_ < 2; ++i_) { *(LAS u32x4*)(lds + (buf_) * BUF + ((tid >> 4) + 32 * i_) * KS + (tid & 15) * 16) = kreg[i_]; \
        *(LAS u32x4*)(lds + (buf_) * BUF + TILE_K + ((tid >> 4) + 32 * i_) * VS + (tid & 15) * 16) = vreg[i_]; } } while (0)
    volatile LAS int* flg = (volatile LAS int*)(lds + MISC_OFF + 64);
    PLOAD(nst - 1);
    PSTORE(0);
    __syncthreads();
    const LAS unsigned char* kp = lds + r32 * KS + hi * 16;
    const LAS unsigned char* vp = lds + TILE_K + (4 * hi + ((lane & 15) >> 2)) * VS + (16 * ((lane >> 4) & 1) + 4 * (lane & 3)) * 2;
    int cur = 0;
    for (int s = nst - 1; s >= 0; --s) {
        if (s > 0) PLOAD(s - 1);
#pragma unroll
        for (int blk = 1; blk >= 0; --blk) {
            const int kb = kvpos0 + 64 * s + 32 * blk;
            if (kb < qw + 32 && !__all(R == 0.f)) sb_block<VS, true>(o, R, kp + cur * BUF + blk * 32 * KS, vp + cur * BUF + blk * 32 * VS, qf, kp, kb, qw, qpos, hi);
        }
        volatile LAS int* fl = flg + 8 * (s & 1);
        if (lane == 0) fl[wid] = __all(R == 0.f) ? 1 : 0;
        if (s > 0) PSTORE(cur ^ 1);
        __syncthreads();
        if ((fl[0] & fl[1] & fl[2] & fl[3] & fl[4] & fl[5] & fl[6] & fl[7]) != 0) break;
        cur ^= 1;
    }
#undef PLOAD
#undef PSTORE
    float* op = (float*)(ws + WS_OP) + ((size_t)(slot * 8 + wid) * 32) * 128;
#pragma unroll
    for (int db = 0; db < 4; ++db)
#pragma unroll
        for (int r = 0; r < 16; ++r) op[crow(r, hi) * 128 + db * 32 + r32] = o[db][r];
    if (hi == 0) ((float*)(ws + WS_TP))[(slot * 8 + wid) * 32 + r32] = R;
}

__device__ __forceinline__ void mix_rows(const Args& a, int gw, int NGW, int lane) {
    unsigned char* ws = a.ws;
    const float* OP = (const float*)(ws + WS_OP); const float* TP = (const float*)(ws + WS_TP);
    const bf16* U = (const bf16*)(ws + WS_U); const bf16* GB = (const bf16*)(ws + WS_GB); bf16* MIX = (bf16*)(ws + WS_MIX);
    const float* cw = a.in[9]; const float* ga = a.in[10]; const float* gc = a.in[11];
    for (int m = gw; m < MT; m += NGW) {
        const int h = lane >> 3, d0 = (lane & 7) * 16;
        int nparts, slot0, wid, q;
        if (m < NP) { const int b = m >> 12, t = m & 4095, qb = t >> 8; wid = (t & 255) >> 5; q = t & 31; nparts = 1; slot0 = (b * 8 + h) * 16 + qb; }
        else { const int r = m - NP, b = r >> 6, t = r & 63, rg = t >> 5; q = t & 31; wid = (h & 3) * 2 + rg; nparts = 1; slot0 = 256 + b * 2 + (h >> 2); }
        f32x4 acc[4];
#pragma unroll
        for (int i = 0; i < 4; ++i) acc[i] = (f32x4){0.f, 0.f, 0.f, 0.f};
        float Rr = 1.f;
        for (int c = nparts - 1; c >= 0; --c) {
            const size_t base = (size_t)((slot0 + c) * 8 + wid) * 32 + q;
            const f32x4* p = (const f32x4*)(OP + base * 128 + d0);
#pragma unroll
            for (int i = 0; i < 4; ++i) acc[i] += p[i] * Rr;
            Rr *= TP[base];
        }
        float s = 0.f;
#pragma unroll
        for (int i = 0; i < 4; ++i) s += (acc[i][0] * acc[i][0] + acc[i][1] * acc[i][1]) + (acc[i][2] * acc[i][2] + acc[i][3] * acc[i][3]);
        float rs = __builtin_amdgcn_rsqf(wave_sum(s) * (1.0f / AW) + EPS);
        {
            const f32x4* g = (const f32x4*)(ga + h * 128 + d0); u32x4 w0, w1;
            f32x4 v0 = acc[0] * rs * g[0], v1 = acc[1] * rs * g[1], v2 = acc[2] * rs * g[2], v3 = acc[3] * rs * g[3];
            w0.x = pk2(v0[0], v0[1]); w0.y = pk2(v0[2], v0[3]); w0.z = pk2(v1[0], v1[1]); w0.w = pk2(v1[2], v1[3]);
            w1.x = pk2(v2[0], v2[1]); w1.y = pk2(v2[2], v2[3]); w1.z = pk2(v3[0], v3[1]); w1.w = pk2(v3[2], v3[3]);
            u32x4* o = (u32x4*)(MIX + (size_t)m * DM + h * 128 + d0); o[0] = w0; o[1] = w1;
        }
        const int c0 = lane * 16; int t, tb; const float* st = nullptr;
        if (m < NP) { t = m & 4095; tb = m - t; } else { const int r = m - NP; t = r & 63; tb = m - t; st = a.in[4] + (size_t)(r >> 6) * 2 * CC; }
        float u0[16], u1[16], u2[16];
        { const u32x4* p = (const u32x4*)(U + (size_t)m * CC + c0); const u32x4 x0 = p[0], x1 = p[1];
          const unsigned ww[8] = {x0.x, x0.y, x0.z, x0.w, x1.x, x1.y, x1.z, x1.w};
#pragma unroll
          for (int i = 0; i < 8; ++i) { u2[2 * i] = bflo(ww[i]); u2[2 * i + 1] = bfhi(ww[i]); } }
        if (t >= 1) { const u32x4* p = (const u32x4*)(U + (size_t)(m - 1) * CC + c0); const u32x4 x0 = p[0], x1 = p[1];
          const unsigned ww[8] = {x0.x, x0.y, x0.z, x0.w, x1.x, x1.y, x1.z, x1.w};
#pragma unroll
          for (int i = 0; i < 8; ++i) { u1[2 * i] = bflo(ww[i]); u1[2 * i + 1] = bfhi(ww[i]); } }
        else {
#pragma unroll
          for (int i = 0; i < 16; ++i) u1[i] = st ? st[CC + c0 + i] : 0.f; }
        if (t >= 2) { const u32x4* p = (const u32x4*)(U + (size_t)(m - 2) * CC + c0); const u32x4 x0 = p[0], x1 = p[1];
          const unsigned ww[8] = {x0.x, x0.y, x0.z, x0.w, x1.x, x1.y, x1.z, x1.w};
#pragma unroll
          for (int i = 0; i < 8; ++i) { u0[2 * i] = bflo(ww[i]); u0[2 * i + 1] = bfhi(ww[i]); } }
        else {
#pragma unroll
          for (int i = 0; i < 16; ++i) u0[i] = st ? st[(t == 0 ? 0 : CC) + c0 + i] : 0.f; }
        float oc[16]; float s2 = 0.f;
        { const u32x4* p = (const u32x4*)(GB + (size_t)m * CC + c0); const u32x4 x0 = p[0], x1 = p[1];
          const unsigned ww[8] = {x0.x, x0.y, x0.z, x0.w, x1.x, x1.y, x1.z, x1.w};
#pragma unroll
          for (int i = 0; i < 16; ++i) { const float gbv = (i & 1) ? bfhi(ww[i >> 1]) : bflo(ww[i >> 1]);
              oc[i] = gbv * (cw[c0 + i] * u0[i] + cw[CC + c0 + i] * u1[i] + cw[2 * CC + c0 + i] * u2[i]); s2 += oc[i] * oc[i]; } }
        rs = __builtin_amdgcn_rsqf(wave_sum(s2) * (1.0f / CC) + EPS);
        { u32x4 w0, w1; unsigned ww[8];
#pragma unroll
          for (int i = 0; i < 8; ++i) ww[i] = pk2(oc[2 * i] * rs * gc[c0 + 2 * i], oc[2 * i + 1] * rs * gc[c0 + 2 * i + 1]);
          w0.x = ww[0]; w0.y = ww[1]; w0.z = ww[2]; w0.w = ww[3]; w1.x = ww[4]; w1.y = ww[5]; w1.z = ww[6]; w1.w = ww[7];
          u32x4* o = (u32x4*)(MIX + (size_t)m * DM + AW + c0); o[0] = w0; o[1] = w1; }
        (void)tb;
    }
}
#ifndef REP_P0
#define REP_P0 1
#endif
#ifndef REP_P1
#define REP_P1 1
#endif
#ifndef REP_P3
#define REP_P3 1
#endif
#ifndef REP_P4
#define REP_P4 1
#endif
#ifndef REP_P5
#define REP_P5 1
#endif
__global__ void __launch_bounds__(NWAVES * 64, 2) fwd_megakernel(Args args) {
    extern __shared__ __attribute__((aligned(16))) unsigned char lds_raw[];
    cg::grid_group grid = cg::this_grid();
    LAS unsigned char* lds = (LAS unsigned char*)lds_raw;
    const int G = gridDim.x, bx = blockIdx.x, NGW = G * NWAVES;
#define PHASE_IDS() int tid = threadIdx.x; asm volatile("" : "+v"(tid)); const int lane = tid & 63; const int wave = __builtin_amdgcn_readfirstlane(tid >> 6); const int gw = bx * NWAVES + wave; (void)lane; (void)gw
    unsigned char* ws = args.ws;
    unsigned* ctl = (unsigned*)(ws + WS_CTL);
    LAS float* red = (LAS float*)(lds + RED_OFF);
    volatile LAS int* misc = (volatile LAS int*)(lds + MISC_OFF);

    { PHASE_IDS(); if (bx == 0 && tid == 0) { ctl[0] = 0u; ctl[64] = 0u; for (int i = 0; i < 16; ++i) ctl[128 + i] = 0u; }
      if (bx == 0) for (int i = tid; i < XCD_BAR_WORDS; i += NWAVES * 64) ctl[4096 + i] = 0u;
      if (tid < 2) misc[8 + tid] = 0;
#ifndef NO_P0
    for (int rep_ = 0; rep_ < REP_P0; ++rep_) p0_prologue(args, lds, gw, NGW, lane, wave);
#endif
    }
    grid.sync();
    XcdBarrier xbar = xcd_barrier_post(ctl + 4096, (volatile LAS unsigned*)(lds + MISC_OFF) + 8);

#ifndef NO_P1
    for (int rep_ = 0; rep_ < REP_P1; ++rep_) {
        pg8::Gemm g{(const pg8::bf16_t*)(ws + WS_HN), (const pg8::bf16_t*)(ws + WS_WIN), MT, INC, DM}; typedef pg8::InProjOrder Ord; Ord S; S.init(G, bx);
        pg8::EpiIn E{(bf16*)(ws + WS_Q), (bf16*)(ws + WS_K), (bf16*)(ws + WS_V), (bf16*)(ws + WS_GB), (bf16*)(ws + WS_U), args.out, args.in[7], args.in[8], red,
                     1.4426950408889634f * 0.08838834764831845f, OFF_KP, OFF_VP, OFF_CP, OFF_KS, OFF_VS, OFF_CS};
        pg8::gemm_phase<pg8::EpiIn, Ord, true, true>(lds, g, S, E);
    }
#endif
    xcd_barrier(xbar);

#ifndef NO_P2
    {
        const int nitems = g_items.n;
        PHASE_IDS();
#ifdef DUP_P2
        for (int rep = 0; rep < 2; ++rep)
#else
        const int rep = 0;
#endif
        for (;;) {
            if (tid == 0) misc[0] = (int)atomicAdd(ctl + 64 * rep, 1u);
            __syncthreads();
            int it = misc[0];
            __syncthreads();
            if (it < 48) {
                pg8::Gemm g{(const pg8::bf16_t*)(ws + WS_HN), (const pg8::bf16_t*)(ws + WS_WIN), MT, INC, DM};
                pg8::OneUnit S1; S1.u0.pm = 30 + (it & 3); S1.u0.pn = 12 + (it >> 2); S1.u0.k0 = 0; S1.u0.nt = 32; S1.u0.split = 0; S1.u0.tu = 0; S1.u0.sp = 0;
                pg8::EpiIn E{(bf16*)(ws + WS_Q), (bf16*)(ws + WS_K), (bf16*)(ws + WS_V), (bf16*)(ws + WS_GB), (bf16*)(ws + WS_U), args.out, args.in[7], args.in[8], red,
                             1.4426950408889634f * 0.08838834764831845f, OFF_KP, OFF_VP, OFF_CP, OFF_KS, OFF_VS, OFF_CS};
                pg8::gemm_phase<pg8::EpiIn, pg8::OneUnit, true, true>(lds, g, S1, E);
                __syncthreads();
                continue;
            }
            it -= 48;
            if (it >= nitems) {
                const int ch = it - nitems; if (ch >= P0_LATE_CHUNKS) break;
                p0_run_range(args, (LAS float*)(lds + wave * 16384), P0_EARLY_ITEMS + ch * P0_CHUNK + wave * (P0_CHUNK / NWAVES), P0_CHUNK / NWAVES, lane);
                continue;
            }
            const int code = g_items.v[it];
#if defined(ONLY_S)
            attn_item<true>(args, lds, code);
#elif defined(ONLY_P)
            attn_item_p(args, lds, code);
#else
            if (code & 1) attn_item<true>(args, lds, code); else attn_item_p(args, lds, code);
#endif
        }
    }
#endif
    xcd_barrier(xbar);

#ifndef NO_P3
    for (int rep_ = 0; rep_ < REP_P3; ++rep_) { PHASE_IDS(); mix_rows(args, gw, NGW, lane); }
#endif
    xcd_barrier(xbar);

#ifndef NO_P4
    for (int rep_ = 0; rep_ < REP_P4; ++rep_) {
        pg8::Gemm g{(const pg8::bf16_t*)(ws + WS_MIX), (const pg8::bf16_t*)(ws + WS_WOUT), MT, DM, DM}; typedef pg8::TailOrderT<MT / 256, DM / 256, DM / 64, 8> Ord; Ord S; S.init(G, bx);
        pg8::EpiOut E{args.in[0], args.in[1], args.out + OFF_Y, (bf16*)(ws + WS_HN), (float*)(ws + WS_SSQ), red, (float*)(ws + WS_PART)};
        pg8::gemm_phase<pg8::EpiOut, Ord, true, true>(lds, g, S, E);
        if (S.rem > 0) {
            xcd_barrier(xbar);
            PHASE_IDS();
            for (int w = gw; w < S.rem * 256; w += NGW) {
                const int tu = w >> 8, r = w & 255; pg8::Unit u; Ord::SO::unit(S.full * G + tu, u);
                const size_t row = (size_t)u.pm * 256 + r; const int col = u.pn * 256 + 4 * lane;
                const float* xin = row < NP ? args.in[0] + row * DM : args.in[1] + (row - NP) * DM;
                f32x4 v = *(const f32x4*)(xin + col);
                const float* p = (const float*)(ws + WS_PART) + (size_t)(tu * 8) * 65536 + r * 256 + 4 * lane;
#pragma unroll
                for (int s = 0; s < 8; ++s) v += *(const f32x4*)(p + (size_t)s * 65536);
                *(f32x4*)(args.out + OFF_Y + row * DM + col) = v;
                u32x2 pk; pk.x = pk2(v[0], v[1]); pk.y = pk2(v[2], v[3]); *(u32x2*)((bf16*)(ws + WS_HN) + row * DM + col) = pk;
                const float ss = wave_sum((v[0] * v[0] + v[1] * v[1]) + (v[2] * v[2] + v[3] * v[3]));
                if (lane == 0) ((float*)(ws + WS_SSQ))[row * 8 + u.pn] = ss;
            }
        }
    }
#endif
    xcd_barrier(xbar);

#ifndef NO_P5
    for (int rep_ = 0; rep_ < REP_P5; ++rep_) {
        pg8::Gemm g{(const pg8::bf16_t*)(ws + WS_HN), (const pg8::bf16_t*)(ws + WS_WGU), MT, 2 * DFF, DM}; typedef pg8::StaticOrderT<MT / 256, 2 * DFF / 256, DM / 64> Ord; Ord S; S.init(G, bx);
        pg8::EpiGU E{(bf16*)(ws + WS_H), (const float*)(ws + WS_SSQ)};
        pg8::gemm_phase<pg8::EpiGU, Ord, true, true>(lds, g, S, E);
    }
#endif
    xcd_barrier(xbar);

#ifndef NO_P6
    {
        pg8::Gemm g{(const pg8::bf16_t*)(ws + WS_H), (const pg8::bf16_t*)(ws + WS_WDN), MT, DM, DFF};
        typedef pg8::TailOrderT<MT / 256, DM / 256, DFF / 64, 8> Ord; Ord S; S.init(G, bx);
        pg8::EpiDown E{args.out + OFF_Y, (float*)(ws + WS_PART), (const pg8::bf16_t*)(ws + WS_HN)};
        pg8::gemm_phase<pg8::EpiDown, Ord, true, true>(lds, g, S, E);
        if (S.rem > 0) {
            xcd_barrier(xbar);
            PHASE_IDS();
            for (int w = gw; w < S.rem * 256; w += NGW) {
                const int tu = w >> 8, r = w & 255; pg8::Unit u; Ord::SO::unit(S.full * G + tu, u);
                float* y = args.out + OFF_Y + ((size_t)u.pm * 256 + r) * DM + u.pn * 256 + 4 * lane;
                f32x4 v = *(const f32x4*)y;
                const float* p = (const float*)(ws + WS_PART) + (size_t)(tu * 8) * 65536 + r * 256 + 4 * lane;
#pragma unroll
                for (int s = 0; s < 8; ++s) v += *(const f32x4*)(p + (size_t)s * 65536);
                *(f32x4*)y = v;
            }
        }
    }
#endif
}

extern "C" void kernel_launch(void* const* d_in, const int* in_sizes, int n_in, void* d_out, int out_size, void* d_ws, size_t ws_size, hipStream_t stream) {
    static int grid = 0;
    if (grid == 0) {
        if (n_in != 17 || (size_t)out_size != OUT_TOTAL || ws_size < WS_END) { fprintf(stderr, "kernel_launch: unexpected shapes (n_in %d out %d ws %zu need %zu)\n", n_in, out_size, ws_size, (size_t)WS_END); grid = -1; return; }
        int dev = 0, cus = 0, per_cu = 0;
        hipGetDevice(&dev); hipDeviceGetAttribute(&cus, hipDeviceAttributeMultiprocessorCount, dev);
        hipFuncSetAttribute((const void*)fwd_megakernel, hipFuncAttributeMaxDynamicSharedMemorySize, LDS_BYTES);
        hipOccupancyMaxActiveBlocksPerMultiprocessor(&per_cu, (const void*)fwd_megakernel, NWAVES * 64, LDS_BYTES);
        if (per_cu < 1) { fprintf(stderr, "kernel_launch: occupancy query says %d blocks per CU\n", per_cu); per_cu = 1; }
        (void)hipGetLastError();
        grid = cus;
    }
    if (grid < 0) return;
    Args a{};
    for (int i = 0; i < 17; ++i) a.in[i] = (const float*)d_in[i];
    a.out = (float*)d_out; a.ws = (unsigned char*)d_ws;
    void* kargs[] = {&a};
    hipError_t e = hipLaunchCooperativeKernel((const void*)fwd_megakernel, dim3(grid), dim3(NWAVES * 64), kargs, LDS_BYTES, stream);
    if (e != hipSuccess) fprintf(stderr, "cooperative launch failed: %s (grid %d)\n", hipGetErrorString(e), grid);
}
```

```cpp
#include <hip/hip_runtime.h>
#include <hip/hip_cooperative_groups.h>
#include <cstdio>
#include <cstdint>
namespace cg = cooperative_groups;
namespace pg8 {
#define PG8_LAS __attribute__((address_space(3)))
typedef unsigned short bf16_t;
typedef short bf16x8 __attribute__((ext_vector_type(8)));
typedef float f32x4 __attribute__((ext_vector_type(4)));
typedef unsigned u32x4 __attribute__((ext_vector_type(4)));
constexpr int BM = 256, BK = 64, HALF = 128, HTB = HALF * BK * 2  , STAGE_BYTES = 8 * HTB, NXCD = 8, WGM = 8;

__host__ __device__ __forceinline__ int lds_byte(int r, int c) { const int st = (r >> 4) * 2 + (c >> 5), rr = r & 15, cc = c & 31, ob = rr * 64 + cc * 2; return st * 1024 + (ob ^ (((ob >> 9) & 1) << 5)); }
__host__ __device__ __forceinline__ void stage_rc(int b, int& R, int& C) { const int st = b / 1024, sb = b % 1024, swz = sb ^ (((sb >> 9) & 1) << 5); R = (st >> 1) * 16 + swz / 64; C = (st & 1) * 32 + (swz % 64) / 2; }
__host__ __device__ __forceinline__ int perm32(int rho) { const int n = rho >> 4, i = rho & 15; return 8 * (i >> 2) + 4 * n + (i & 3); }

struct Unit { int pm, pn, k0, nt, split, tu, sp; };
struct Gemm { const bf16_t* A; const bf16_t* Bt; int M, N, K; };

template <int NM, int NN, int NTK> struct StaticOrderT {
    static constexpr int nM = NM, nN = NN, nwg = NM * NN, ntk = NTK;
    int G, c;
    __host__ __device__ __forceinline__ void init(int G_, int c_) { G = G_; c = c_; }
    __host__ __device__ __forceinline__ bool next(int i, Unit& u) const { const int L = i * G + c; if (L >= nwg) return false; unit(L, u); return true; }
    __host__ __device__ __forceinline__ static void unit(int L, Unit& u) {
        int wgid = L; { constexpr int q = nwg / NXCD, r = nwg % NXCD; const int xcd = wgid % NXCD, off = wgid / NXCD; wgid = (xcd < r ? xcd * (q + 1) : r * (q + 1) + (xcd - r) * q) + off; }
        constexpr int nig = WGM * nN; const int gid = wgid / nig, fm = gid * WGM, gsz = (nM - fm) < WGM ? (nM - fm) : WGM;
        u.pm = fm + ((wgid % nig) % gsz); u.pn = (wgid % nig) / gsz; u.k0 = 0; u.nt = ntk; u.split = 0; u.tu = 0; u.sp = 0;
    }
    __device__ __forceinline__ void a_ready(const Unit&) const {}
    __device__ __forceinline__ void done(const Unit&) const {}
};
template <int NM, int NN, int NTK, int NSPLIT> struct TailOrderT {
    typedef StaticOrderT<NM, NN, NTK> SO;
    int G, c, full, rem;
    __host__ __device__ __forceinline__ void init(int G_, int c_) { G = G_; c = c_; full = SO::nwg / G; rem = SO::nwg - full * G; if (rem * NSPLIT > G || NTK < 2 * NSPLIT) { full = 1 << 24; rem = 0; } }
    __host__ __device__ __forceinline__ static int kstart(int s) { return s >= NSPLIT ? NTK : ((s * NTK / NSPLIT) & ~1); }
    __host__ __device__ __forceinline__ bool next(int i, Unit& u) const {
        if (i < full) { const int L = i * G + c; if (L >= SO::nwg) return false; SO::unit(L, u); return true; }
        if (i > full || c >= rem * NSPLIT) return false;
        const int tu = c / NSPLIT, sp = c % NSPLIT; SO::unit(full * G + tu, u); u.k0 = kstart(sp); u.nt = kstart(sp + 1) - u.k0; u.split = 1; u.tu = tu; u.sp = sp; return true;
    }
    __device__ __forceinline__ void a_ready(const Unit&) const {}
    __device__ __forceinline__ void done(const Unit&) const {}
};

struct InProjOrder {
    typedef StaticOrderT<30, 24, 32> SO;
    int G, c;
    __host__ __device__ __forceinline__ void init(int G_, int c_) { G = G_; c = c_; }
    __host__ __device__ __forceinline__ bool next(int i, Unit& u) const {
        const int L = i * G + c; if (L >= 768) return false;
        if (L < 720) { SO::unit(L, u); return true; }
        const int j = L - 720; u.pm = 30 + (j & 3); u.pn = j >> 2; u.k0 = 0; u.nt = 32; u.split = 0; u.tu = 0; u.sp = 0; return true;
    }
    __device__ __forceinline__ void a_ready(const Unit&) const {}
    __device__ __forceinline__ void done(const Unit&) const {}
};
struct OneUnit {
    Unit u0;
    __host__ __device__ __forceinline__ bool next(int i, Unit& u) const { if (i != 0) return false; u = u0; return true; }
    __device__ __forceinline__ void a_ready(const Unit&) const {}
    __device__ __forceinline__ void done(const Unit&) const {}
};

__device__ __forceinline__ unsigned cvt_pk_bf16(float lo, float hi) { unsigned r; asm volatile("v_cvt_pk_bf16_f32 %0, %1, %2" : "=v"(r) : "v"(lo), "v"(hi)); return r; }
typedef float f32x2 __attribute__((ext_vector_type(2)));
#define PG8_LBAR() asm volatile("s_waitcnt lgkmcnt(0)\n\ts_barrier" ::: "memory")
constexpr int NPROMPT = 8192;
__device__ __forceinline__ u32x4 pack8(const f32x4 a, const f32x4 b) { u32x4 w; w.x = cvt_pk_bf16(a[0], a[1]); w.y = cvt_pk_bf16(a[2], a[3]); w.z = cvt_pk_bf16(b[0], b[1]); w.w = cvt_pk_bf16(b[2], b[3]); return w; }


__device__ __forceinline__ void store_partial(float* part, int nsplit, const f32x4 (&acc)[2][2][4][2], const Unit& u, int wr, int wc, int fr, int fq) {
    float* pt = part + (size_t)(u.tu * nsplit + u.sp) * 65536; int rl0 = wr * 64 + fr, cw = wc * 32 + 8 * fq; asm volatile("" : "+v"(rl0), "+v"(cw));
#pragma unroll
    for (int ai = 0; ai < 2; ++ai)
#pragma unroll
        for (int m = 0; m < 4; ++m)
#pragma unroll
            for (int bj = 0; bj < 2; ++bj) { float* o = pt + (ai * HALF + rl0 + m * 16) * 256 + bj * HALF + cw; *(f32x4*)o = acc[ai][bj][m][0]; *(f32x4*)(o + 4) = acc[ai][bj][m][1]; }
}

struct EpiIn {
    static constexpr bool PERM = true, AFTER_DRAIN = false;
    bf16_t *Q, *Kb, *Vb, *GB, *U; float* out; const float *gq, *gk; PG8_LAS float* red; float qscale;
    size_t off_kp, off_vp, off_cp, off_ks, off_vs, off_cs;
    __device__ __forceinline__ void operator()(const f32x4 (&acc)[2][2][4][2], const Unit& u, int wr, int wc, int fr, int fq) const {
        int rl0 = wr * 64 + fr, cw = wc * 32 + 8 * fq; asm volatile("" : "+v"(rl0), "+v"(cw));
        const int pn = u.pn, rowt = u.pm * BM;
        const bool prompt = rowt < NPROMPT;
        if (pn < 8) {
            const bool isq = pn < 4;
#pragma unroll
            for (int ai = 0; ai < 2; ++ai)
#pragma unroll
                for (int m = 0; m < 4; ++m)
#pragma unroll
                    for (int bj = 0; bj < 2; ++bj) {
                        const f32x4 a = acc[ai][bj][m][0], b = acc[ai][bj][m][1];
                        float s = (a[0] * a[0] + a[1] * a[1]) + (a[2] * a[2] + a[3] * a[3]) + (b[0] * b[0] + b[1] * b[1]) + (b[2] * b[2] + b[3] * b[3]);
                        s += __shfl_xor(s, 16); s += __shfl_xor(s, 32);
                        if (fq == 0) red[((ai * HALF + rl0 + m * 16) * 2 + bj) * 4 + wc] = s;
                    }
            PG8_LBAR();
            const float* g = isq ? gq : gk;
            const f32x4 g0 = *(const f32x4*)(g + cw), g1 = *(const f32x4*)(g + cw + 4);
#pragma unroll
            for (int ai = 0; ai < 2; ++ai)
#pragma unroll
                for (int m = 0; m < 4; ++m) {
                    const int rl = ai * HALF + rl0 + m * 16; const size_t row = (size_t)(rowt + rl);
#pragma unroll
                    for (int bj = 0; bj < 2; ++bj) {
                        const f32x4 p = *(const PG8_LAS f32x4*)(red + (rl * 2 + bj) * 4);
                        float rs = __builtin_amdgcn_rsqf(((p[0] + p[1]) + (p[2] + p[3])) * (1.0f / 128.0f) + 1e-6f);
                        if (isq) rs *= qscale;
                        const f32x4 v0 = acc[ai][bj][m][0] * rs * g0, v1 = acc[ai][bj][m][1] * rs * g1;
                        if (isq) { *(u32x4*)(Q + row * 1024 + pn * 256 + bj * HALF + cw) = pack8(v0, v1); }
                        else {
                            const int col = (pn - 4) * 256 + bj * HALF + cw;
                            float* o = prompt ? out + off_kp + row * 1024 + col : out + off_ks + (row - NPROMPT) * 1024 + col;
                            *(f32x4*)o = v0; *(f32x4*)(o + 4) = v1;
                            if (prompt) *(u32x4*)(Kb + row * 1024 + col) = pack8(v0, v1);
                        }
                    }
                }
        } else if (pn < 12) {
#pragma unroll
            for (int ai = 0; ai < 2; ++ai)
#pragma unroll
                for (int m = 0; m < 4; ++m) {
                    const size_t row = (size_t)(rowt + ai * HALF + rl0 + m * 16);
#pragma unroll
                    for (int bj = 0; bj < 2; ++bj) {
                        const int col = (pn - 8) * 256 + bj * HALF + cw; const f32x4 v0 = acc[ai][bj][m][0], v1 = acc[ai][bj][m][1];
                        float* o = prompt ? out + off_vp + row * 1024 + col : out + off_vs + (row - NPROMPT) * 1024 + col;
                        *(f32x4*)o = v0; *(f32x4*)(o + 4) = v1;
                        if (prompt) *(u32x4*)(Vb + row * 1024 + col) = pack8(v0, v1);
                    }
                }
        } else if (pn < 16) {
#pragma unroll
            for (int ai = 0; ai < 2; ++ai)
#pragma unroll
                for (int m = 0; m < 4; ++m) {
                    const size_t row = (size_t)(rowt + ai * HALF + rl0 + m * 16);
#pragma unroll
                    for (int bj = 0; bj < 2; ++bj) *(u32x4*)(GB + row * 1024 + (pn - 12) * 256 + bj * HALF + cw) = pack8(acc[ai][bj][m][0], acc[ai][bj][m][1]);
                }
        } else {
#pragma unroll
            for (int ai = 0; ai < 2; ++ai)
#pragma unroll
                for (int m = 0; m < 4; ++m) {
                    const int rowi = rowt + ai * HALF + rl0 + m * 16; const int ch = (pn - 16) * HALF + cw;
                    const f32x4 v0 = acc[ai][0][m][0] * acc[ai][1][m][0], v1 = acc[ai][0][m][1] * acc[ai][1][m][1];
                    *(u32x4*)(U + (size_t)rowi * 1024 + ch) = pack8(v0, v1);
                    if (prompt) { const int t = rowi & 4095; if (t >= 4094) { float* o = out + off_cp + ((rowi >> 12) * 2 + (t - 4094)) * 1024 + ch; *(f32x4*)o = v0; *(f32x4*)(o + 4) = v1; } }
                    else { const int rs_ = rowi - NPROMPT, t = rs_ & 63; if (t >= 62) { float* o = out + off_cs + ((rs_ >> 6) * 2 + (t - 62)) * 1024 + ch; *(f32x4*)o = v0; *(f32x4*)(o + 4) = v1; } }
                }
        }
    }
};

struct EpiOut {
    static constexpr bool PERM = true, AFTER_DRAIN = false;
    const float *xp, *xs; float* Y; bf16_t* X1; float* ssq; PG8_LAS float* red; float* part;
    __device__ __forceinline__ void operator()(const f32x4 (&acc)[2][2][4][2], const Unit& u, int wr, int wc, int fr, int fq) const {
        if (u.split) { store_partial(part, 8, acc, u, wr, wc, fr, fq); return; }
        int rl0 = wr * 64 + fr, cw = wc * 32 + 8 * fq; asm volatile("" : "+v"(rl0), "+v"(cw));
        const int pn = u.pn, rowt = u.pm * BM;
        const float* xin = rowt < NPROMPT ? xp + (size_t)rowt * 2048 : xs + (size_t)(rowt - NPROMPT) * 2048;
#pragma unroll
        for (int ai = 0; ai < 2; ++ai) {
            f32x4 xv[4][2][2];
#pragma unroll
            for (int m = 0; m < 4; ++m)
#pragma unroll
                for (int bj = 0; bj < 2; ++bj) { const float* xi = xin + (size_t)(ai * HALF + rl0 + m * 16) * 2048 + pn * 256 + bj * HALF + cw; xv[m][bj][0] = *(const f32x4*)xi; xv[m][bj][1] = *(const f32x4*)(xi + 4); }
#pragma unroll
            for (int m = 0; m < 4; ++m) {
                const int rl = ai * HALF + rl0 + m * 16; float s = 0.f;
#pragma unroll
                for (int bj = 0; bj < 2; ++bj) {
                    const int col = pn * 256 + bj * HALF + cw;
                    const f32x4 v0 = xv[m][bj][0] + acc[ai][bj][m][0], v1 = xv[m][bj][1] + acc[ai][bj][m][1];
                    *(u32x4*)(X1 + (size_t)(rowt + rl) * 2048 + col) = pack8(v0, v1);
                    s += (v0[0] * v0[0] + v0[1] * v0[1]) + (v0[2] * v0[2] + v0[3] * v0[3]) + (v1[0] * v1[0] + v1[1] * v1[1]) + (v1[2] * v1[2] + v1[3] * v1[3]);
                }
                s += __shfl_xor(s, 16); s += __shfl_xor(s, 32);
                if (fq == 0) red[rl * 4 + wc] = s;
            }
            asm volatile("" ::: "memory");
        }
        PG8_LBAR();
        if (threadIdx.x < 256) { const f32x4 p = *(const PG8_LAS f32x4*)(red + threadIdx.x * 4); ssq[(size_t)(rowt + threadIdx.x) * 8 + pn] = (p[0] + p[1]) + (p[2] + p[3]); }
        PG8_LBAR();
    }
};

struct EpiGU {
    static constexpr bool PERM = true, AFTER_DRAIN = false;
    bf16_t* H; const float* ssq;
    __device__ __forceinline__ void operator()(const f32x4 (&acc)[2][2][4][2], const Unit& u, int wr, int wc, int fr, int fq) const {
        int rl0 = wr * 64 + fr, cw = wc * 32 + 8 * fq; asm volatile("" : "+v"(rl0), "+v"(cw));
        const int pn = u.pn, rowt = u.pm * BM;
        f32x4 pa[2][4], pb[2][4];
#pragma unroll
        for (int ai = 0; ai < 2; ++ai)
#pragma unroll
            for (int m = 0; m < 4; ++m) { const float* p = ssq + (size_t)(rowt + ai * HALF + rl0 + m * 16) * 8; pa[ai][m] = *(const f32x4*)p; pb[ai][m] = *(const f32x4*)(p + 4); }
#pragma unroll
        for (int ai = 0; ai < 2; ++ai)
#pragma unroll
            for (int m = 0; m < 4; ++m) {
                const size_t row = (size_t)(rowt + ai * HALF + rl0 + m * 16);
                const f32x4 p0 = pa[ai][m], p1 = pb[ai][m];
                const float rs = __builtin_amdgcn_rsqf((((p0[0] + p0[1]) + (p0[2] + p0[3])) + ((p1[0] + p1[1]) + (p1[2] + p1[3]))) * (1.0f / 2048.0f) + 1e-6f);
                f32x4 h[2];
#pragma unroll
                for (int n = 0; n < 2; ++n) {
                    const f32x4 g = acc[ai][0][m][n] * rs, up = acc[ai][1][m][n] * rs;
#pragma unroll
                    for (int j = 0; j < 4; ++j) h[n][j] = g[j] * __builtin_amdgcn_rcpf(1.0f + __builtin_amdgcn_exp2f(-1.4426950408889634f * g[j])) * up[j];
                }
                *(u32x4*)(H + row * 5632 + pn * HALF + cw) = pack8(h[0], h[1]);
            }
    }
};

struct EpiDown {
    static constexpr bool PERM = true, AFTER_DRAIN = false;
    float* Y; float* part; const bf16_t* X1;
    __device__ __forceinline__ void operator()(const f32x4 (&acc)[2][2][4][2], const Unit& u, int wr, int wc, int fr, int fq) const {
        if (u.split) { store_partial(part, 8, acc, u, wr, wc, fr, fq); return; }
        int rl0 = wr * 64 + fr, cw = wc * 32 + 8 * fq; asm volatile("" : "+v"(rl0), "+v"(cw));
        const int pn = u.pn, rowt = u.pm * BM;
        u32x4 xb[2][4][2];
#pragma unroll
        for (int ai = 0; ai < 2; ++ai)
#pragma unroll
            for (int m = 0; m < 4; ++m)
#pragma unroll
                for (int bj = 0; bj < 2; ++bj) xb[ai][m][bj] = *(const u32x4*)(X1 + (size_t)(rowt + ai * HALF + rl0 + m * 16) * 2048 + pn * 256 + bj * HALF + cw);
#pragma unroll
        for (int ai = 0; ai < 2; ++ai)
#pragma unroll
            for (int m = 0; m < 4; ++m)
#pragma unroll
                for (int bj = 0; bj < 2; ++bj) {
                    const size_t off = (size_t)(rowt + ai * HALF + rl0 + m * 16) * 2048 + pn * 256 + bj * HALF + cw;
                    const u32x4 x = xb[ai][m][bj];
                    f32x4 b0, b1; b0[0] = __builtin_bit_cast(float, x.x << 16); b0[1] = __builtin_bit_cast(float, x.x & 0xffff0000u); b0[2] = __builtin_bit_cast(float, x.y << 16); b0[3] = __builtin_bit_cast(float, x.y & 0xffff0000u);
                    b1[0] = __builtin_bit_cast(float, x.z << 16); b1[1] = __builtin_bit_cast(float, x.z & 0xffff0000u); b1[2] = __builtin_bit_cast(float, x.w << 16); b1[3] = __builtin_bit_cast(float, x.w & 0xffff0000u);
                    float* o = Y + off; *(f32x4*)o = b0 + acc[ai][bj][m][0]; *(f32x4*)(o + 4) = b1 + acc[ai][bj][m][1];
                }
    }
};

struct EpiNone {
    static constexpr bool PERM = true, AFTER_DRAIN = false;
    float* sink;
    __device__ __forceinline__ void operator()(const f32x4 (&acc)[2][2][4][2], const Unit& u, int wr, int wc, int fr, int fq) const {
        if (acc[0][0][0][0][0] == 12345.678f && acc[1][1][3][1][3] == -9876.5f) sink[0] = 1.f;
    }
};
template <class Epi, class Sched, bool ALIGN_EPI = false, bool SP2 = false>
__device__ __forceinline__ void gemm_phase(PG8_LAS unsigned char* lds, const Gemm g, const Sched& S, const Epi& E) {
    int tid_ = threadIdx.x; asm volatile("" : "+v"(tid_));
    const int tid = tid_, wid = __builtin_amdgcn_readfirstlane(tid >> 6), lane = tid & 63, wr = wid >> 2, wc = wid & 3, fr = lane & 15, fq = lane >> 4;
    const int K = g.K;
    unsigned voffA[2], voffB[2];
#pragma unroll
    for (int i = 0; i < 2; ++i) { int R, C; stage_rc(tid * 16 + i * 8192, R, C); const int Rb = Epi::PERM ? ((R & ~31) + perm32(R & 31)) : R;
        voffA[i] = (unsigned)(R * K + C) * 2u; voffB[i] = (unsigned)(Rb * K + C) * 2u; }
    const size_t kstep = (size_t)(BK * 2);
    const size_t hstep = (size_t)HALF * K * 2;
    const size_t tstep = 2 * hstep;
    const unsigned ldsw = (unsigned)wid * 1024u;
    const int aoff = lds_byte(wr * 64 + fr, fq * 8), boff = lds_byte(wc * 32 + fr, fq * 8);
#define PG8_SA(b, h) (((b) * 2 + (h)) * HTB)
#define PG8_SB(b, h) ((4 + (b) * 2 + (h)) * HTB)
#define PG8_STAGE(bufoff, gbase, voff) do { _Pragma("unroll") for (int _i = 0; _i < 2; ++_i) \
        __builtin_amdgcn_global_load_lds((const unsigned*)((const char*)(gbase) + (voff)[_i]), (PG8_LAS unsigned*)(lds + (bufoff) + ldsw + _i * 8192), 16, 0, 0); } while (0)
#define PG8_LDA(dst, b, h) do { _Pragma("unroll") for (int m = 0; m < 4; ++m) _Pragma("unroll") for (int k = 0; k < 2; ++k) dst[m][k] = *(const PG8_LAS bf16x8*)(lds + PG8_SA(b, h) + aoff + m * 2048 + k * 1024); } while (0)
#define PG8_LDB(dst, b, h) do { _Pragma("unroll") for (int n = 0; n < 2; ++n) _Pragma("unroll") for (int k = 0; k < 2; ++k) dst[n][k] = *(const PG8_LAS bf16x8*)(lds + PG8_SB(b, h) + boff + n * 2048 + k * 1024); } while (0)
#define PG8_MMA(ai, bj, At, Bt) do { __builtin_amdgcn_s_setprio(1); _Pragma("unroll") for (int m = 0; m < 4; ++m) _Pragma("unroll") for (int n = 0; n < 2; ++n) _Pragma("unroll") for (int k = 0; k < 2; ++k) \
        acc[ai][bj][m][n] = __builtin_amdgcn_mfma_f32_16x16x32_bf16(Bt[n][k], At[m][k], acc[ai][bj][m][n], 0, 0, 0); __builtin_amdgcn_s_setprio(0); } while (0)
#define PG8_WAIT_V(n) asm volatile("s_waitcnt vmcnt(" #n ")" ::: "memory")
#define PG8_WAIT_L(n) asm volatile("s_waitcnt lgkmcnt(" #n ")" ::: "memory")
#define PG8_BAR __builtin_amdgcn_s_barrier()
#define PG8_SCHED __builtin_amdgcn_sched_barrier(0)
    Unit cur, nxt; int ui = 0;
    if (!S.next(0, cur)) return;
    f32x4 acc[2][2][4][2];
#pragma unroll
    for (int a = 0; a < 2; ++a)
#pragma unroll
        for (int b = 0; b < 2; ++b)
#pragma unroll
            for (int m = 0; m < 4; ++m)
#pragma unroll
                for (int n = 0; n < 2; ++n) acc[a][b][m][n] = (f32x4){0.f, 0.f, 0.f, 0.f};
    bf16x8 At[4][2], B0[2][2], B1[2][2];
    const char* cA = (const char*)g.A + (size_t)cur.pm * tstep + (size_t)cur.k0 * kstep; const char* cB = (const char*)g.Bt + (size_t)cur.pn * tstep + (size_t)cur.k0 * kstep;
    S.a_ready(cur);
    if constexpr (SP2) {
        PG8_STAGE(PG8_SB(0, 0), cB, voffB); PG8_STAGE(PG8_SB(0, 1), cB + hstep, voffB); PG8_STAGE(PG8_SA(0, 0), cA, voffA); PG8_STAGE(PG8_SA(0, 1), cA + hstep, voffA);
        if (wr == 1) PG8_BAR;
        PG8_WAIT_V(2); PG8_BAR;
        PG8_STAGE(PG8_SB(1, 0), cB + kstep, voffB); PG8_STAGE(PG8_SA(1, 0), cA + kstep, voffA); PG8_STAGE(PG8_SB(1, 1), cB + hstep + kstep, voffB);
        PG8_WAIT_V(6); PG8_BAR;
    } else {
        PG8_STAGE(PG8_SB(0, 0), cB, voffB); PG8_STAGE(PG8_SA(0, 0), cA, voffA); PG8_STAGE(PG8_SB(0, 1), cB + hstep, voffB); PG8_STAGE(PG8_SA(0, 1), cA + hstep, voffA);
        if (wr == 1) PG8_BAR;
        PG8_WAIT_V(4); PG8_BAR;
        PG8_STAGE(PG8_SB(1, 0), cB + kstep, voffB); PG8_STAGE(PG8_SA(1, 0), cA + kstep, voffA); PG8_STAGE(PG8_SB(1, 1), cB + hstep + kstep, voffB);
        PG8_WAIT_V(6); PG8_BAR;
    }
    for (;;) {
        const bool has_next = S.next(ui + 1, nxt);
        const char* nA = has_next ? (const char*)g.A + (size_t)nxt.pm * tstep + (size_t)nxt.k0 * kstep : cA; const char* nB = has_next ? (const char*)g.Bt + (size_t)nxt.pn * tstep + (size_t)nxt.k0 * kstep : cB;
        const int nt = cur.nt;
        for (int t = 0; t < nt; t += 2) {
            const bool last = (t == nt - 2);
            const char* a1 = cA + (size_t)(t + 1) * kstep;
            const char* a2 = last ? nA : cA + (size_t)(t + 2) * kstep; const char* b2 = last ? nB : cB + (size_t)(t + 2) * kstep;
            const char* a3 = a2 + kstep; const char* b3 = b2 + kstep;
            if (last && has_next) S.a_ready(nxt);
            if constexpr (SP2) {
            PG8_LDB(B0, 0, 0); PG8_LDB(B1, 0, 1); PG8_SCHED; PG8_LDA(At, 0, 0); PG8_STAGE(PG8_SA(1, 1), a1 + hstep, voffA);
            PG8_WAIT_V(8); PG8_WAIT_L(0); PG8_BAR; PG8_MMA(0, 0, At, B0); PG8_MMA(0, 1, At, B1); PG8_BAR; PG8_SCHED;
            PG8_LDA(At, 0, 1); PG8_STAGE(PG8_SB(0, 0), b2, voffB); PG8_STAGE(PG8_SB(0, 1), b2 + hstep, voffB); PG8_STAGE(PG8_SA(0, 0), a2, voffA);
            PG8_WAIT_V(8); PG8_WAIT_L(0); PG8_BAR; PG8_MMA(1, 0, At, B0); PG8_MMA(1, 1, At, B1); PG8_BAR; PG8_SCHED;
            PG8_LDB(B0, 1, 0); PG8_LDB(B1, 1, 1); PG8_SCHED; PG8_LDA(At, 1, 0); PG8_STAGE(PG8_SA(0, 1), a2 + hstep, voffA);
            PG8_WAIT_V(8); PG8_WAIT_L(0); PG8_BAR; PG8_MMA(0, 0, At, B0); PG8_MMA(0, 1, At, B1); PG8_BAR; PG8_SCHED;
            PG8_LDA(At, 1, 1); PG8_STAGE(PG8_SB(1, 0), b3, voffB); PG8_STAGE(PG8_SB(1, 1), b3 + hstep, voffB); PG8_STAGE(PG8_SA(1, 0), a3, voffA);
            PG8_WAIT_V(8); PG8_WAIT_L(0); PG8_BAR; PG8_MMA(1, 0, At, B0); PG8_MMA(1, 1, At, B1); PG8_BAR; PG8_SCHED;
            } else {
            PG8_LDB(B0, 0, 0); PG8_SCHED; PG8_LDA(At, 0, 0); PG8_STAGE(PG8_SA(1, 1), a1 + hstep, voffA);
            PG8_WAIT_L(8); PG8_BAR; PG8_WAIT_L(0); PG8_MMA(0, 0, At, B0); PG8_BAR; PG8_SCHED;
            PG8_LDB(B1, 0, 1); PG8_STAGE(PG8_SB(0, 0), b2, voffB);
            PG8_BAR; PG8_WAIT_L(0); PG8_MMA(0, 1, At, B1); PG8_BAR;
            PG8_LDA(At, 0, 1); PG8_STAGE(PG8_SA(0, 0), a2, voffA);
            PG8_BAR; PG8_WAIT_L(0); PG8_MMA(1, 0, At, B0); PG8_BAR; PG8_SCHED;
            PG8_STAGE(PG8_SB(0, 1), b2 + hstep, voffB);
            PG8_WAIT_V(6); PG8_BAR; PG8_MMA(1, 1, At, B1); PG8_BAR;
            PG8_LDB(B0, 1, 0); PG8_SCHED; PG8_LDA(At, 1, 0); PG8_STAGE(PG8_SA(0, 1), a2 + hstep, voffA);
            PG8_WAIT_L(8); PG8_BAR; PG8_WAIT_L(0); PG8_MMA(0, 0, At, B0); PG8_BAR; PG8_SCHED;
            PG8_LDB(B1, 1, 1); PG8_STAGE(PG8_SB(1, 0), b3, voffB);
            PG8_BAR; PG8_WAIT_L(0); PG8_MMA(0, 1, At, B1); PG8_BAR;
            PG8_LDA(At, 1, 1); PG8_STAGE(PG8_SA(1, 0), a3, voffA);
            PG8_BAR; PG8_WAIT_L(0); PG8_MMA(1, 0, At, B0); PG8_BAR; PG8_SCHED;
            PG8_STAGE(PG8_SB(1, 1), b3 + hstep, voffB);
            PG8_WAIT_V(6); PG8_BAR; PG8_MMA(1, 1, At, B1); PG8_BAR;
            }
        }
        if constexpr (ALIGN_EPI) { if (wr == 0) PG8_BAR; }
        if constexpr (!Epi::AFTER_DRAIN) { E(acc, cur, wr, wc, fr, fq); S.done(cur); }
        if (!has_next) break;
#pragma unroll
        for (int a = 0; a < 2; ++a)
#pragma unroll
            for (int b = 0; b < 2; ++b)
#pragma unroll
                for (int m = 0; m < 4; ++m)
#pragma unroll
                    for (int n = 0; n < 2; ++n) acc[a][b][m][n] = (f32x4){0.f, 0.f, 0.f, 0.f};
        cur = nxt; cA = nA; cB = nB; ++ui;
        if constexpr (ALIGN_EPI) { if (wr == 1) PG8_BAR; }
    }
    PG8_WAIT_V(0);
    if constexpr (!ALIGN_EPI) { if (wr == 0) PG8_BAR; }
    PG8_BAR;
    if constexpr (Epi::AFTER_DRAIN) { E.fused(acc, cur, wr, wc, fr, fq, lds, wid, lane); S.done(cur); }
#undef PG8_SA
#undef PG8_SB
#undef PG8_STAGE
#undef PG8_LDA
#undef PG8_LDB
#undef PG8_MMA
#undef PG8_WAIT_V
#undef PG8_WAIT_L
#undef PG8_BAR
#undef PG8_SCHED
}
}
#define LAS __attribute__((address_space(3)))
typedef unsigned short bf16;
typedef float f32x4 __attribute__((ext_vector_type(4)));
typedef float f32x16 __attribute__((ext_vector_type(16)));
typedef short bf16x8 __attribute__((ext_vector_type(8)));
typedef short s16x4 __attribute__((ext_vector_type(4)));
typedef unsigned u32x4 __attribute__((ext_vector_type(4)));
typedef unsigned u32x2 __attribute__((ext_vector_type(2)));
constexpr int DM = 2048, SEQ = 4096, NP = 8192, NS = 512, MT = NP + NS, AW = 1024, CC = 1024, INC = 6144, DFF = 5632, PAST = 4096, DSEQ = 64;
constexpr float EPS = 1e-6f;
constexpr size_t OFF_Y = 0, OFF_KP = (size_t)MT * DM, OFF_VP = OFF_KP + (size_t)NP * AW, OFF_CP = OFF_VP + (size_t)NP * AW, OFF_KS = OFF_CP + 2 * 2 * CC,
                 OFF_VS = OFF_KS + (size_t)NS * AW, OFF_CS = OFF_VS + (size_t)NS * AW, OUT_TOTAL = OFF_CS + 8 * 2 * CC;
static_assert(OUT_TOTAL == 35672064, "output size");
constexpr size_t MiB = 1u << 20;
constexpr size_t WS_CTL = 0, WS_WIN = 1 * MiB, WS_WOUT = 25 * MiB, WS_WGU = 33 * MiB, WS_WDN = 77 * MiB, WS_HN = 99 * MiB, WS_Q = 133 * MiB, WS_K = 150 * MiB, WS_V = 166 * MiB,
                 WS_GB = 182 * MiB, WS_U = 199 * MiB, WS_MIX = 216 * MiB, WS_SSQ = 250 * MiB, WS_TP = 251 * MiB, WS_OP = 256 * MiB, WS_H = 256 * MiB, WS_PART = 133 * MiB  ;
constexpr int NSLOT = 256 + 16;
constexpr size_t WS_END = WS_OP + (size_t)NSLOT * 131072;
constexpr int RING_BYTES = 131072, RED_OFF = RING_BYTES, MISC_OFF = RED_OFF + 8192, LDS_BYTES = 147456;
constexpr int NWAVES = 8;

#define XB_TMO      128
#define XB_XCNT(j)  (256  + 64 * (j))
#define XB_XSUB(j)  (1280 + 64 * (j))
#define XB_XGEN(j)  (2304 + 64 * (j))
#define XB_TOP      3328
#define XB_TOPGEN   3392
#define XCD_BAR_WORDS 3456
#define XB_SPIN_CAP (1u << 18)

__device__ __forceinline__ unsigned xb_ld(unsigned* p)              { return __hip_atomic_load(p, __ATOMIC_RELAXED, __HIP_MEMORY_SCOPE_AGENT); }
__device__ __forceinline__ unsigned xb_add(unsigned* p, unsigned v) { return __hip_atomic_fetch_add(p, v, __ATOMIC_RELAXED, __HIP_MEMORY_SCOPE_AGENT); }
__device__ __forceinline__ unsigned xb_xcc_id() { return (unsigned)__builtin_amdgcn_s_getreg((3 << 11) | 20) & 0xFu; }
#define XB_SPIN(cond, bar) do { unsigned _sp = 0; while (cond) { __builtin_amdgcn_s_sleep(1); \
    if ((++_sp & 255u) == 0u) { if (xb_ld(&(bar)[XB_TMO])) break; if (_sp > XB_SPIN_CAP) { atomicAdd(&(bar)[XB_TMO], 1u); break; } } } } while (0)

struct XcdBarrier {
    unsigned* bar; unsigned x;
    volatile LAS unsigned* st;
};

__device__ __forceinline__ XcdBarrier xcd_barrier_post(unsigned* bar, volatile LAS unsigned* st) {
    XcdBarrier b; b.bar = bar; b.x = xb_xcc_id(); b.st = st;
    if (threadIdx.x == 0) (void)xb_add(&bar[XB_XCNT(b.x)], 1u);
    return b;
}
__device__ __forceinline__ void xcd_barrier_complete(unsigned* bar, unsigned x, unsigned& nloc, unsigned& nx) {
    const unsigned G = gridDim.x * gridDim.y * gridDim.z;
    unsigned sum, cnt, mine, sp = 0u;
    for (;;) {
        sum = 0u; cnt = 0u; mine = 0u;
#pragma unroll
        for (unsigned j = 0; j < 16; ++j) { const unsigned c = xb_ld(&bar[XB_XCNT(j)]); sum += c; cnt += (c > 0u) ? 1u : 0u; mine = (j == x) ? c : mine; }
        if (sum == G) break;
        __builtin_amdgcn_s_sleep(1);
        if ((++sp & 255u) == 0u) { if (xb_ld(&bar[XB_TMO])) break; if (sp > XB_SPIN_CAP) { atomicAdd(&bar[XB_TMO], 1u); break; } }
    }
    nloc = mine > 0u ? mine : 1u; nx = cnt > 0u ? cnt : 1u;
}

__device__ __forceinline__ void xcd_barrier(const XcdBarrier& b) {
    asm volatile("s_waitcnt vmcnt(0)" ::: "memory");
    __syncthreads();
    if (threadIdx.x == 0) {
        unsigned* bar = b.bar;
        __builtin_amdgcn_s_waitcnt(0);
        unsigned nloc = b.st[0], nx = b.st[1];
        if (nloc == 0u) { xcd_barrier_complete(bar, b.x, nloc, nx); b.st[0] = nloc; b.st[1] = nx; }
        const unsigned old = xb_add(&bar[XB_XSUB(b.x)], 1u);
        const unsigned gen = old / nloc;
        if (old + 1u == (gen + 1u) * nloc) {
            __builtin_amdgcn_fence(__ATOMIC_RELEASE, "agent");
            asm volatile("s_waitcnt vmcnt(0)" ::: "memory");
            const unsigned og = xb_add(&bar[XB_TOP], 1u);
            const unsigned tg = og / nx;
            if (og + 1u == (tg + 1u) * nx) xb_add(&bar[XB_TOPGEN], 1u);
            else XB_SPIN(xb_ld(&bar[XB_TOPGEN]) == tg, bar);
            __builtin_amdgcn_fence(__ATOMIC_ACQUIRE, "agent");
            xb_add(&bar[XB_XGEN(b.x)], 1u);
            asm volatile("s_waitcnt vmcnt(0)" ::: "memory");
        } else {
            XB_SPIN(xb_ld(&bar[XB_XGEN(b.x)]) == gen, bar);
            __builtin_amdgcn_fence(__ATOMIC_ACQUIRE, "agent");
            asm volatile("s_waitcnt vmcnt(0)" ::: "memory");
        }
    }
    __syncthreads();
}

struct ItemTab { int n; int v[272]; };
constexpr int p_nsteps(int qb, int c) { return 8 * (qb + 1); }
constexpr ItemTab make_items() {
    ItemTab t{}; t.n = 0;
    for (int b = 0; b < 8; ++b) for (int hg = 0; hg < 2; ++hg) t.v[t.n++] = 1 | (b << 1) | (hg << 4);
    for (int qb = 15; qb >= 0; --qb) for (int bh = 0; bh < 16; ++bh) t.v[t.n++] = (bh << 1) | (qb << 5);
    return t;
}
__device__ const ItemTab g_items = make_items();

__device__ __forceinline__ unsigned f2bf(float f) { unsigned u = __builtin_bit_cast(unsigned, f); return (u + 0x7fffu + ((u >> 16) & 1u)) >> 16; }
__device__ __forceinline__ unsigned pk2(float lo, float hi) { return pg8::cvt_pk_bf16(lo, hi); }
__device__ __forceinline__ float bflo(unsigned w) { return __builtin_bit_cast(float, w << 16); }
__device__ __forceinline__ float bfhi(unsigned w) { return __builtin_bit_cast(float, w & 0xffff0000u); }
__device__ __forceinline__ int crow(int r, int hi) { return (r & 3) + 8 * (r >> 2) + 4 * hi; }
__device__ __forceinline__ float wave_sum(float v) {
#pragma unroll
    for (int o = 1; o < 64; o <<= 1) v += __shfl_xor(v, o);
    return v;
}

struct Args { const float* in[17]; float* out; unsigned char* ws; };

struct P0Item { const float* src; const float* gk; bf16* dst; int N, K, k0; };
__device__ __forceinline__ P0Item p0_decode(const Args& a, int it) {
    constexpr int I_IN = 32 * 192, I_OUT = 32 * 64, I_G = 32 * 176;
    unsigned char* ws = a.ws; P0Item r; int n0, kb, drow; r.gk = nullptr;
    if (it < I_IN) { kb = it / 192; n0 = 32 * (it % 192); drow = n0;
        if (n0 >= 5120) { const int ch = n0 - 5120; drow = 4096 + (ch >> 7) * 256 + 128 + (ch & 127); } else if (n0 >= 4096) { const int ch = n0 - 4096; drow = 4096 + (ch >> 7) * 256 + (ch & 127); }
        r.src = a.in[6]; r.N = INC; r.K = DM; r.dst = (bf16*)(ws + WS_WIN); }
    else if ((it -= I_IN) < I_OUT) { kb = it / 64; n0 = 32 * (it % 64); drow = n0; r.src = a.in[12]; r.N = DM; r.K = DM; r.dst = (bf16*)(ws + WS_WOUT); }
    else if ((it -= I_OUT) < 2 * I_G) { const int up = it >= I_G; if (up) it -= I_G; kb = it / 176; n0 = 32 * (it % 176); drow = (n0 >> 7) * 256 + up * 128 + (n0 & 127);
        r.src = a.in[up ? 15 : 14]; r.N = DFF; r.K = DM; r.dst = (bf16*)(ws + WS_WGU); r.gk = a.in[13]; }
    else { it -= 2 * I_G; kb = it / 64; n0 = 32 * (it % 64); drow = n0; r.src = a.in[16]; r.N = DM; r.K = DFF; r.dst = (bf16*)(ws + WS_WDN); }
    r.k0 = 64 * kb; r.src += (size_t)r.k0 * r.N + n0; r.dst += (size_t)drow * r.K + r.k0;
    return r;
}
__device__ __forceinline__ void p0_load(const P0Item& p, f32x4 (&v)[8], int lane) {
#pragma unroll
    for (int j = 0; j < 8; ++j) v[j] = __builtin_nontemporal_load((const f32x4*)(p.src + (size_t)(8 * j + (lane >> 3)) * p.N + 4 * (lane & 7)));
}
__device__ __forceinline__ void p0_finish(const P0Item& p, const f32x4 (&v)[8], LAS float* scr, int lane) {
#pragma unroll
    for (int j = 0; j < 8; ++j) { const int kk = 8 * j + (lane >> 3); const float g = p.gk ? p.gk[p.k0 + kk] : 1.0f; LAS float* s = scr + kk * 33 + 4 * (lane & 7);
        s[0] = v[j][0] * g; s[1] = v[j][1] * g; s[2] = v[j][2] * g; s[3] = v[j][3] * g; }
    asm volatile("s_waitcnt lgkmcnt(0)" ::: "memory");
    const int c = lane & 7;
#pragma unroll
    for (int j = 0; j < 4; ++j) { const int n = (lane >> 3) + 8 * j; const LAS float* s = scr + (8 * c) * 33 + n;
        u32x4 o; o.x = pk2(s[0 * 33], s[1 * 33]); o.y = pk2(s[2 * 33], s[3 * 33]); o.z = pk2(s[4 * 33], s[5 * 33]); o.w = pk2(s[6 * 33], s[7 * 33]);
        *(u32x4*)(p.dst + (size_t)n * p.K + 8 * c) = o; }
    asm volatile("s_waitcnt lgkmcnt(0)" ::: "memory");
}
constexpr int P0_EARLY_ITEMS = 32 * 192 + 32 * 64, P0_ALL_ITEMS = 32 * 192 + 32 * 64 + 2 * 32 * 176 + 88 * 64, P0_CHUNK = 32, P0_LATE_CHUNKS = (P0_ALL_ITEMS - P0_EARLY_ITEMS) / P0_CHUNK;
static_assert((P0_ALL_ITEMS - P0_EARLY_ITEMS) % P0_CHUNK == 0, "late conversion items come in whole chunks");
__device__ __forceinline__ void p0_run_range(const Args& a, LAS float* scr, int first, int n, int lane) {
    f32x4 va[8], vb[8]; P0Item pa, pb;
    pa = p0_decode(a, first); p0_load(pa, va, lane);
    for (int i = 0; i < n; i += 2) {
        if (i + 1 < n) { pb = p0_decode(a, first + i + 1); p0_load(pb, vb, lane); }
        p0_finish(pa, va, scr, lane);
        if (i + 1 >= n) break;
        if (i + 2 < n) { pa = p0_decode(a, first + i + 2); p0_load(pa, va, lane); }
        p0_finish(pb, vb, scr, lane);
    }
}
__device__ __forceinline__ void p0_prologue(const Args& a, LAS unsigned char* lds, int gw, int NGW, int lane, int wave) {
    LAS float* scr = (LAS float*)(lds + wave * 16384);
    unsigned char* ws = a.ws;
    constexpr int NITEMS = P0_EARLY_ITEMS;
    {
        int it = gw; f32x4 va[8], vb[8]; P0Item pa, pb;
        if (it < NITEMS) { pa = p0_decode(a, it); p0_load(pa, va, lane); }
        while (it < NITEMS) {
            const int itb = it + NGW;
            if (itb < NITEMS) { pb = p0_decode(a, itb); p0_load(pb, vb, lane); }
            p0_finish(pa, va, scr, lane);
            it = itb + NGW;
            if (itb >= NITEMS) break;
            if (it < NITEMS) { pa = p0_decode(a, it); p0_load(pa, va, lane); }
            p0_finish(pb, vb, scr, lane);
        }
    }
    const float* g1 = a.in[5];
    for (int m = gw; m < MT; m += NGW) {
        const float* xrow = m < NP ? a.in[0] + (size_t)m * DM : a.in[1] + (size_t)(m - NP) * DM;
        const f32x4* xr = (const f32x4*)xrow + lane; f32x4 v[8]; float s = 0.f;
#pragma unroll
        for (int j = 0; j < 8; ++j) { v[j] = xr[64 * j]; s += (v[j][0] * v[j][0] + v[j][1] * v[j][1]) + (v[j][2] * v[j][2] + v[j][3] * v[j][3]); }
        const float rs = __builtin_amdgcn_rsqf(wave_sum(s) * (1.0f / DM) + EPS);
        u32x2* o = (u32x2*)((bf16*)(ws + WS_HN) + (size_t)m * DM) + lane;
#pragma unroll
        for (int j = 0; j < 8; ++j) { const f32x4 g = *((const f32x4*)g1 + 64 * j + lane); u32x2 w; w.x = pk2(v[j][0] * rs * g[0], v[j][1] * rs * g[1]); w.y = pk2(v[j][2] * rs * g[2], v[j][3] * rs * g[3]); o[64 * j] = w; }
    }
}


template <int VS, bool QREG>
__device__ __forceinline__ void sb_block(f32x16 (&o)[4], float& R, const LAS unsigned char* kp, const LAS unsigned char* vp, const bf16x8 (&qreg)[8], const LAS unsigned char* qlp, int kb, int qw, int qpos, int hi) {
            f32x16 p;
#pragma unroll
            for (int r = 0; r < 16; ++r) p[r] = 0.f;
#pragma unroll
            for (int d0 = 0; d0 < 8; ++d0) { const bf16x8 kf = *(const LAS bf16x8*)(kp + d0 * 32); const bf16x8 qf = QREG ? qreg[d0] : *(const LAS bf16x8*)(qlp + d0 * 32); p = __builtin_amdgcn_mfma_f32_32x32x16_bf16(kf, qf, p, 0, 0, 0); }
            const bool need_mask = (kb + 31 >= qw);
            float e[16], sf[16];
#pragma unroll
            for (int r = 0; r < 16; ++r) {
                const float z = fminf(p[r], 100.f); float ee = __builtin_amdgcn_exp2f(z); float rr = __builtin_amdgcn_rcpf(1.0f + ee);
                if (need_mask) { const bool msk = (kb + crow(r, hi)) >= qpos; ee = msk ? 0.f : ee; rr = msk ? 1.f : rr; }
                e[r] = ee; sf[r] = rr;
            }
            float oth[4], PP[4];
#pragma unroll
            for (int g = 0; g < 4; ++g) { sf[4 * g + 2] *= sf[4 * g + 3]; sf[4 * g + 1] *= sf[4 * g + 2]; sf[4 * g] *= sf[4 * g + 1]; oth[g] = __shfl_xor(sf[4 * g], 32); PP[g] = sf[4 * g] * oth[g]; }
            const float SP3 = PP[3], SP2 = PP[2] * SP3, SP1 = PP[1] * SP2, SP0 = PP[0] * SP1;
            float A[4]; A[0] = R * SP1; A[1] = R * SP2; A[2] = R * SP3; A[3] = R;
#pragma unroll
            for (int g = 0; g < 4; ++g) A[g] = hi ? A[g] : A[g] * oth[g];
            R *= SP0;
            float w[16];
#pragma unroll
            for (int r = 0; r < 16; ++r) w[r] = (e[r] * sf[r]) * A[r >> 2];
#pragma unroll
            for (int s2 = 0; s2 < 2; ++s2) {
                u32x4 pw; pw.x = pk2(w[8 * s2 + 0], w[8 * s2 + 1]); pw.y = pk2(w[8 * s2 + 2], w[8 * s2 + 3]); pw.z = pk2(w[8 * s2 + 4], w[8 * s2 + 5]); pw.w = pk2(w[8 * s2 + 6], w[8 * s2 + 7]);
                const bf16x8 pa = __builtin_bit_cast(bf16x8, pw);
#pragma unroll
                for (int db = 0; db < 4; ++db) {
                    const s16x4 lo = __builtin_bit_cast(s16x4, __builtin_amdgcn_ds_read_tr16_b64_v4i16((LAS s16x4*)(vp + (16 * s2) * VS + db * 64)));
                    const s16x4 hh = __builtin_bit_cast(s16x4, __builtin_amdgcn_ds_read_tr16_b64_v4i16((LAS s16x4*)(vp + (16 * s2 + 8) * VS + db * 64)));
                    const bf16x8 vb = __builtin_shufflevector(lo, hh, 0, 1, 2, 3, 4, 5, 6, 7);
                    o[db] = __builtin_amdgcn_mfma_f32_32x32x16_bf16(pa, vb, o[db], 0, 0, 0);
                }
            }
}

template <bool SAMPLE>
__device__ __forceinline__ void attn_item(const Args& a, LAS unsigned char* lds, int code) {
    constexpr int NH = SAMPLE ? 4 : 1, KS = NH * 256 + 16, VS = NH * 256 + 32, K_OFF = 0, V_OFF = 32 * KS;
    int tid_ = threadIdx.x; asm volatile("" : "+v"(tid_));
    const int tid = tid_, lane = tid & 63, r32 = lane & 31, hi = lane >> 5; const int wid = __builtin_amdgcn_readfirstlane(tid >> 6);
    unsigned char* ws = a.ws;
    int slot, nsteps, kvpos0, qw, head, hl; size_t qrow;
    const bf16 *kgb = nullptr, *vgb = nullptr; const float *kgf = nullptr, *vgf = nullptr, *kgn = nullptr, *vgn = nullptr;
    if (SAMPLE) {
        const int b = (code >> 1) & 7, hg = (code >> 4) & 1;
        slot = 256 + b * 2 + hg; hl = wid >> 1; head = hg * 4 + hl; const int rg = wid & 1;
        qw = PAST + 32 * rg; qrow = (size_t)NP + b * DSEQ + 32 * rg + r32;
        nsteps = 130; kvpos0 = 0;
        kgf = a.in[2] + ((size_t)b * PAST + (tid >> 7)) * AW + hg * 512 + 4 * (tid & 127); vgf = a.in[3] + ((size_t)b * PAST + (tid >> 7)) * AW + hg * 512 + 4 * (tid & 127);
        kgn = a.out + OFF_KS + ((size_t)b * DSEQ + (tid >> 7)) * AW + hg * 512 + 4 * (tid & 127); vgn = a.out + OFF_VS + ((size_t)b * DSEQ + (tid >> 7)) * AW + hg * 512 + 4 * (tid & 127);
    } else {
        const int bh = (code >> 1) & 15, qb = (code >> 5) & 15, c = (code >> 9) & 3, b = bh >> 3;
        head = bh & 7; hl = 0; slot = bh * 16 + qb + 0 * c; nsteps = p_nsteps(qb, c); kvpos0 = 0;
        qw = qb * 256 + 32 * wid; qrow = (size_t)b * SEQ + qw + r32;
        kgb = (const bf16*)(ws + WS_K) + ((size_t)b * SEQ + kvpos0 + (tid >> 4)) * AW + head * 128 + (tid & 15) * 8;
        vgb = (const bf16*)(ws + WS_V) + ((size_t)b * SEQ + kvpos0 + (tid >> 4)) * AW + head * 128 + (tid & 15) * 8;
    }
    const int qpos = qw + r32;
    constexpr int Q_OFF = 67584, QS = 272;
    const LAS unsigned char* qlp = lds + Q_OFF + wid * (32 * QS) + r32 * QS + hi * 16;
    { const bf16* qp = (const bf16*)(ws + WS_Q) + qrow * AW + head * 128 + hi * 8;
#pragma unroll
      for (int d0 = 0; d0 < 8; ++d0) *(LAS bf16x8*)(lds + Q_OFF + wid * (32 * QS) + r32 * QS + hi * 16 + d0 * 32) = *(const bf16x8*)(qp + 16 * d0); }
    f32x16 o[4];
#pragma unroll
    for (int i = 0; i < 4; ++i)
#pragma unroll
        for (int r = 0; r < 16; ++r) o[i][r] = 0.f;
    float R = 1.f;
    u32x4 kreg, vreg; f32x4 kf4[8], vf4[8];
#define ATT_LOADK(s_) do { if (SAMPLE) { _Pragma("unroll") for (int i_ = 0; i_ < 8; ++i_) kf4[i_] = *(const f32x4*)(((s_) >= 128 ? kgn + (size_t)((s_) - 128) * 32 * AW : kgf + (size_t)(s_) * 32 * AW) + (size_t)i_ * 4 * AW); } \
        else { kreg = *(const u32x4*)(kgb + (size_t)(s_) * 32 * AW); } } while (0)
#define ATT_LOADV(s_) do { if (SAMPLE) { _Pragma("unroll") for (int i_ = 0; i_ < 8; ++i_) vf4[i_] = *(const f32x4*)(((s_) >= 128 ? vgn + (size_t)((s_) - 128) * 32 * AW : vgf + (size_t)(s_) * 32 * AW) + (size_t)i_ * 4 * AW); } \
        else { vreg = *(const u32x4*)(vgb + (size_t)(s_) * 32 * AW); } } while (0)
#define ATT_STOREK() do { if (SAMPLE) { _Pragma("unroll") for (int i_ = 0; i_ < 8; ++i_) { const int key_ = (tid >> 7) + 4 * i_, f4_ = tid & 127; \
            u32x2 kw_; kw_.x = pk2(kf4[i_][0], kf4[i_][1]); kw_.y = pk2(kf4[i_][2], kf4[i_][3]); *(LAS u32x2*)(lds + K_OFF + key_ * KS + f4_ * 8) = kw_; } } \
        else { *(LAS u32x4*)(lds + K_OFF + (tid >> 4) * KS + (tid & 15) * 16) = kreg; } } while (0)
#define ATT_STOREV() do { if (SAMPLE) { _Pragma("unroll") for (int i_ = 0; i_ < 8; ++i_) { const int key_ = (tid >> 7) + 4 * i_, f4_ = tid & 127; \
            u32x2 vw_; vw_.x = pk2(vf4[i_][0], vf4[i_][1]); vw_.y = pk2(vf4[i_][2], vf4[i_][3]); *(LAS u32x2*)(lds + V_OFF + key_ * VS + f4_ * 8) = vw_; } } \
        else { *(LAS u32x4*)(lds + V_OFF + (tid >> 4) * VS + (tid & 15) * 16) = vreg; } } while (0)
    volatile LAS int* flg = (volatile LAS int*)(lds + MISC_OFF + 64);
    ATT_LOADK(nsteps - 1); ATT_LOADV(nsteps - 1);
    ATT_STOREK(); ATT_STOREV();
    __syncthreads();
    const LAS unsigned char* kp = lds + K_OFF + r32 * KS + hl * 256 + hi * 16;
    const LAS unsigned char* vp = lds + V_OFF + (4 * hi + ((lane & 15) >> 2)) * VS + hl * 256 + (16 * ((lane >> 4) & 1) + 4 * (lane & 3)) * 2;
    for (int s = nsteps - 1; s >= 0; --s) {
        if (s > 0) { ATT_LOADK(s - 1); if (!SAMPLE) ATT_LOADV(s - 1); }
        const int kb = kvpos0 + 32 * s;
        if (kb < qw + 32 && !__all(R == 0.f)) { const bf16x8 qdummy[8] = {}; sb_block<VS, false>(o, R, kp, vp, qdummy, qlp, kb, qw, qpos, hi); }
        if (lane == 0) flg[wid] = __all(R == 0.f) ? 1 : 0;
        __syncthreads();
        const bool alldone = (flg[0] & flg[1] & flg[2] & flg[3] & flg[4] & flg[5] & flg[6] & flg[7]) != 0;
        if (alldone) { __syncthreads(); break; }
        if (s > 0) { ATT_STOREK(); if (SAMPLE) ATT_LOADV(s - 1); ATT_STOREV(); }
        __syncthreads();
    }
#undef ATT_LOADK
#undef ATT_LOADV
#undef ATT_STOREK
#undef ATT_STOREV
    float* op = (float*)(ws + WS_OP) + ((size_t)(slot * 8 + wid) * 32) * 128;
#pragma unroll
    for (int db = 0; db < 4; ++db)
#pragma unroll
        for (int r = 0; r < 16; ++r) op[crow(r, hi) * 128 + db * 32 + r32] = o[db][r];
    if (hi == 0) ((float*)(ws + WS_TP))[(slot * 8 + wid) * 32 + r32] = R;
}


__device__ __forceinline__ void attn_item_p(const Args& a, LAS unsigned char* lds, int code) {
    constexpr int KS = 272, VS = 288, TILE_K = 64 * KS, BUF = TILE_K + 64 * VS;
    int tid_ = threadIdx.x; asm volatile("" : "+v"(tid_));
    const int tid = tid_, lane = tid & 63, r32 = lane & 31, hi = lane >> 5; const int wid = __builtin_amdgcn_readfirstlane(tid >> 6);
    unsigned char* ws = a.ws;
    const int bh = (code >> 1) & 15, qb = (code >> 5) & 15, c = (code >> 9) & 3, b = bh >> 3, head = bh & 7;
    const int slot = bh * 16 + qb + 0 * c, nst = p_nsteps(qb, c) >> 1, kvpos0 = 0;
    const int qw = qb * 256 + 32 * wid, qpos = qw + r32; const size_t qrow = (size_t)b * SEQ + qpos;
    const bf16* kgb = (const bf16*)(ws + WS_K) + ((size_t)b * SEQ + kvpos0 + (tid >> 4)) * AW + head * 128 + (tid & 15) * 8;
    const bf16* vgb = (const bf16*)(ws + WS_V) + ((size_t)b * SEQ + kvpos0 + (tid >> 4)) * AW + head * 128 + (tid & 15) * 8;
    bf16x8 qf[8];
    { const bf16* qp = (const bf16*)(ws + WS_Q) + qrow * AW + head * 128 + hi * 8;
#pragma unroll
      for (int d0 = 0; d0 < 8; ++d0) qf[d0] = *(const bf16x8*)(qp + 16 * d0); }
    f32x16 o[4];
#pragma unroll
    for (int i = 0; i < 4; ++i)
#pragma unroll
        for (int r = 0; r < 16; ++r) o[i][r] = 0.f;
    float R = 1.f;
    u32x4 kreg[2], vreg[2];
#define PLOAD(s_) do { _Pragma("unroll") for (int i_ = 0; i_ < 2; ++i_) { kreg[i_] = *(const u32x4*)(kgb + (size_t)((s_) * 64 + 32 * i_) * AW); vreg[i_] = *(const u32x4*)(vgb + (size_t)((s_) * 64 + 32 * i_) * AW); } } while (0)
#define PSTORE(buf_) do { _Pragma("unroll") for (int i_ = 0; i_ < 2; ++i_) { *(LAS u32x4*)(lds + (buf_) * BUF + ((tid >> 4) + 32 * i_) * KS + (tid & 15) * 16) = kreg[i_]; \
        *(LAS u32x4*)(lds + (buf_) * BUF + TILE_K + ((tid >> 4) + 32 * i_) * VS + (tid & 15) * 16) = vreg[i_]; } } while (0)
    volatile LAS int* flg = (volatile LAS int*)(lds + MISC_OFF + 64);
    PLOAD(nst - 1);
    PSTORE(0);
    __syncthreads();
    const LAS unsigned char* kp = lds + r32 * KS + hi * 16;
    const LAS unsigned char* vp = lds + TILE_K + (4 * hi + ((lane & 15) >> 2)) * VS + (16 * ((lane >> 4) & 1) + 4 * (lane & 3)) * 2;
    int cur = 0;
    for (int s = nst - 1; s >= 0; --s) {
        if (s > 0) PLOAD(s - 1);
#pragma unroll
        for (int blk = 1; blk >= 0; --blk) {
            const int kb = kvpos0 + 64 * s + 32 * blk;
            if (kb < qw + 32 && !__all(R == 0.f)) sb_block<VS, true>(o, R, kp + cur * BUF + blk * 32 * KS, vp + cur * BUF + blk * 32 * VS, qf, kp, kb, qw, qpos, hi);
        }
        volatile LAS int* fl = flg + 8 * (s & 1);
        if (lane == 0) fl[wid] = __all(R == 0.f) ? 1 : 0;
        if (s > 0) PSTORE(cur ^ 1);
        __syncthreads();
        if ((fl[0] & fl[1] & fl[2] & fl[3] & fl[4] & fl[5] & fl[6] & fl[7]) != 0) break;
        cur ^= 1;
    }
#undef PLOAD
#undef PSTORE
    float* op = (float*)(ws + WS_OP) + ((size_t)(slot * 8 + wid) * 32) * 128;
#pragma unroll
    for (int db = 0; db < 4; ++db)
#pragma unroll
        for (int r = 0; r < 16; ++r) op[crow(r, hi) * 128 + db * 32 + r32] = o[db][r];
    if (hi == 0) ((float*)(ws + WS_TP))[(slot * 8 + wid) * 32 + r32] = R;
}

struct MixRow { int m, t; const float* st; f32x4 op[4]; u32x4 u2[2], u1[2], u0[2], gb[2]; };
__device__ __forceinline__ void mix_load(const Args& a, MixRow& R, int m, int lane) {
    unsigned char* ws = a.ws;
    const float* OP = (const float*)(ws + WS_OP); const bf16* U = (const bf16*)(ws + WS_U); const bf16* GB = (const bf16*)(ws + WS_GB);
    const int h = lane >> 3, d0 = (lane & 7) * 16, c0 = lane * 16;
    int slot0, wid, q;
    if (m < NP) { const int b = m >> 12, t = m & 4095, qb = t >> 8; wid = (t & 255) >> 5; q = t & 31; slot0 = (b * 8 + h) * 16 + qb; R.t = t; R.st = nullptr; }
    else { const int r = m - NP, b = r >> 6, t = r & 63, rg = t >> 5; q = t & 31; wid = (h & 3) * 2 + rg; slot0 = 256 + b * 2 + (h >> 2); R.t = t; R.st = a.in[4] + (size_t)b * 2 * CC; }
    R.m = m;
    const f32x4* p = (const f32x4*)(OP + ((size_t)(slot0 * 8 + wid) * 32 + q) * 128 + d0);
#pragma unroll
    for (int i = 0; i < 4; ++i) R.op[i] = p[i];
    { const u32x4* pu = (const u32x4*)(U + (size_t)m * CC + c0); R.u2[0] = pu[0]; R.u2[1] = pu[1]; }
    if (R.t >= 1) { const u32x4* pu = (const u32x4*)(U + (size_t)(m - 1) * CC + c0); R.u1[0] = pu[0]; R.u1[1] = pu[1]; }
    if (R.t >= 2) { const u32x4* pu = (const u32x4*)(U + (size_t)(m - 2) * CC + c0); R.u0[0] = pu[0]; R.u0[1] = pu[1]; }
    { const u32x4* pg = (const u32x4*)(GB + (size_t)m * CC + c0); R.gb[0] = pg[0]; R.gb[1] = pg[1]; }
}
__device__ __forceinline__ void unpack16(const u32x4 (&x)[2], float (&o)[16]) {
    const unsigned ww[8] = {x[0].x, x[0].y, x[0].z, x[0].w, x[1].x, x[1].y, x[1].z, x[1].w};
#pragma unroll
    for (int i = 0; i < 8; ++i) { o[2 * i] = bflo(ww[i]); o[2 * i + 1] = bfhi(ww[i]); }
}
__device__ __forceinline__ void mix_finish(const Args& a, const MixRow& R, const float (&ga16)[16], const float (&gc16)[16], const float (&w0c)[16], const float (&w1c)[16], const float (&w2c)[16], int lane) {
    bf16* MIX = (bf16*)(a.ws + WS_MIX);
    const int h = lane >> 3, d0 = (lane & 7) * 16, c0 = lane * 16, m = R.m;
    float s = 0.f;
#pragma unroll
    for (int i = 0; i < 4; ++i) s += (R.op[i][0] * R.op[i][0] + R.op[i][1] * R.op[i][1]) + (R.op[i][2] * R.op[i][2] + R.op[i][3] * R.op[i][3]);
    float rs = __builtin_amdgcn_rsqf(wave_sum(s) * (1.0f / AW) + EPS);
    { unsigned ww[8];
#pragma unroll
      for (int i = 0; i < 8; ++i) ww[i] = pk2(R.op[i >> 1][(2 * i) & 3] * rs * ga16[2 * i], R.op[i >> 1][(2 * i + 1) & 3] * rs * ga16[2 * i + 1]);
      u32x4 w0, w1; w0.x = ww[0]; w0.y = ww[1]; w0.z = ww[2]; w0.w = ww[3]; w1.x = ww[4]; w1.y = ww[5]; w1.z = ww[6]; w1.w = ww[7];
      u32x4* o = (u32x4*)(MIX + (size_t)m * DM + h * 128 + d0); o[0] = w0; o[1] = w1; }
    float u0[16], u1[16], u2[16], gbv[16];
    unpack16(R.u2, u2); unpack16(R.gb, gbv);
    if (R.t >= 1) unpack16(R.u1, u1); else {
#pragma unroll
        for (int i = 0; i < 16; ++i) u1[i] = R.st ? R.st[CC + c0 + i] : 0.f; }
    if (R.t >= 2) unpack16(R.u0, u0); else {
#pragma unroll
        for (int i = 0; i < 16; ++i) u0[i] = R.st ? R.st[(R.t == 0 ? 0 : CC) + c0 + i] : 0.f; }
    float oc[16]; float s2 = 0.f;
#pragma unroll
    for (int i = 0; i < 16; ++i) { oc[i] = gbv[i] * (w0c[i] * u0[i] + w1c[i] * u1[i] + w2c[i] * u2[i]); s2 += oc[i] * oc[i]; }
    rs = __builtin_amdgcn_rsqf(wave_sum(s2) * (1.0f / CC) + EPS);
    { unsigned ww[8];
#pragma unroll
      for (int i = 0; i < 8; ++i) ww[i] = pk2(oc[2 * i] * rs * gc16[2 * i], oc[2 * i + 1] * rs * gc16[2 * i + 1]);
      u32x4 w0, w1; w0.x = ww[0]; w0.y = ww[1]; w0.z = ww[2]; w0.w = ww[3]; w1.x = ww[4]; w1.y = ww[5]; w1.z = ww[6]; w1.w = ww[7];
      u32x4* o = (u32x4*)(MIX + (size_t)m * DM + AW + c0); o[0] = w0; o[1] = w1; }
}
__device__ __forceinline__ void mix_rows(const Args& a, int gw, int NGW, int lane) {
    const float* cw = a.in[9]; const float* ga = a.in[10]; const float* gc = a.in[11];
    const int h = lane >> 3, d0 = (lane & 7) * 16, c0 = lane * 16;
    float ga16[16], gc16[16], w0c[16], w1c[16], w2c[16];
#pragma unroll
    for (int i = 0; i < 4; ++i) {
        const f32x4 x0 = *(const f32x4*)(ga + h * 128 + d0 + 4 * i), x1 = *(const f32x4*)(gc + c0 + 4 * i), x2 = *(const f32x4*)(cw + c0 + 4 * i), x3 = *(const f32x4*)(cw + CC + c0 + 4 * i), x4 = *(const f32x4*)(cw + 2 * CC + c0 + 4 * i);
#pragma unroll
        for (int j = 0; j < 4; ++j) { ga16[4 * i + j] = x0[j]; gc16[4 * i + j] = x1[j]; w0c[4 * i + j] = x2[j]; w1c[4 * i + j] = x3[j]; w2c[4 * i + j] = x4[j]; }
    }
    for (int m = gw; m < MT; m += 2 * NGW) {
        MixRow A, B; const bool hasB = m + NGW < MT;
        mix_load(a, A, m, lane);
        if (hasB) mix_load(a, B, m + NGW, lane);
        mix_finish(a, A, ga16, gc16, w0c, w1c, w2c, lane);
        if (hasB) mix_finish(a, B, ga16, gc16, w0c, w1c, w2c, lane);
    }
}
#ifndef REP_P0
#define REP_P0 1
#endif
#ifndef REP_P1
#define REP_P1 1
#endif
#ifndef REP_P3
#define REP_P3 1
#endif
#ifndef REP_P4
#define REP_P4 1
#endif
#ifndef REP_P5
#define REP_P5 1
#endif
__global__ void __launch_bounds__(NWAVES * 64, 2) fwd_megakernel(Args args) {
    extern __shared__ __attribute__((aligned(16))) unsigned char lds_raw[];
    cg::grid_group grid = cg::this_grid();
    LAS unsigned char* lds = (LAS unsigned char*)lds_raw;
    const int G = gridDim.x, bx = blockIdx.x, NGW = G * NWAVES;
#define PHASE_IDS() int tid = threadIdx.x; asm volatile("" : "+v"(tid)); const int lane = tid & 63; const int wave = __builtin_amdgcn_readfirstlane(tid >> 6); const int gw = bx * NWAVES + wave; (void)lane; (void)gw
    unsigned char* ws = args.ws;
    unsigned* ctl = (unsigned*)(ws + WS_CTL);
    LAS float* red = (LAS float*)(lds + RED_OFF);
    volatile LAS int* misc = (volatile LAS int*)(lds + MISC_OFF);

    { PHASE_IDS(); if (bx == 0 && tid == 0) { ctl[0] = 0u; ctl[64] = 0u; for (int i = 0; i < 16; ++i) ctl[128 + i] = 0u; }
      if (bx == 0) for (int i = tid; i < XCD_BAR_WORDS; i += NWAVES * 64) ctl[4096 + i] = 0u;
      if (tid < 2) misc[8 + tid] = 0;
#ifndef NO_P0
    for (int rep_ = 0; rep_ < REP_P0; ++rep_) p0_prologue(args, lds, gw, NGW, lane, wave);
#endif
    }
    grid.sync();
    XcdBarrier xbar = xcd_barrier_post(ctl + 4096, (volatile LAS unsigned*)(lds + MISC_OFF) + 8);

#ifndef NO_P1
    for (int rep_ = 0; rep_ < REP_P1; ++rep_) {
        pg8::Gemm g{(const pg8::bf16_t*)(ws + WS_HN), (const pg8::bf16_t*)(ws + WS_WIN), MT, INC, DM}; typedef pg8::InProjOrder Ord; Ord S; S.init(G, bx);
        pg8::EpiIn E{(bf16*)(ws + WS_Q), (bf16*)(ws + WS_K), (bf16*)(ws + WS_V), (bf16*)(ws + WS_GB), (bf16*)(ws + WS_U), args.out, args.in[7], args.in[8], red,
                     1.4426950408889634f * 0.08838834764831845f, OFF_KP, OFF_VP, OFF_CP, OFF_KS, OFF_VS, OFF_CS};
        pg8::gemm_phase<pg8::EpiIn, Ord, true, true>(lds, g, S, E);
    }
#endif
    xcd_barrier(xbar);

#ifndef NO_P2
    {
        const int nitems = g_items.n;
        PHASE_IDS();
#ifdef DUP_P2
        for (int rep = 0; rep < 2; ++rep)
#else
        const int rep = 0;
#endif
        for (;;) {
            if (tid == 0) misc[0] = (int)atomicAdd(ctl + 64 * rep, 1u);
            __syncthreads();
            int it = misc[0];
            __syncthreads();
            if (it < 48) {
                pg8::Gemm g{(const pg8::bf16_t*)(ws + WS_HN), (const pg8::bf16_t*)(ws + WS_WIN), MT, INC, DM};
                pg8::OneUnit S1; S1.u0.pm = 30 + (it & 3); S1.u0.pn = 12 + (it >> 2); S1.u0.k0 = 0; S1.u0.nt = 32; S1.u0.split = 0; S1.u0.tu = 0; S1.u0.sp = 0;
                pg8::EpiIn E{(bf16*)(ws + WS_Q), (bf16*)(ws + WS_K), (bf16*)(ws + WS_V), (bf16*)(ws + WS_GB), (bf16*)(ws + WS_U), args.out, args.in[7], args.in[8], red,
                             1.4426950408889634f * 0.08838834764831845f, OFF_KP, OFF_VP, OFF_CP, OFF_KS, OFF_VS, OFF_CS};
                pg8::gemm_phase<pg8::EpiIn, pg8::OneUnit, true, true>(lds, g, S1, E);
                __syncthreads();
                continue;
            }
            it -= 48;
            if (it >= nitems) {
                const int ch = it - nitems; if (ch >= P0_LATE_CHUNKS) break;
                p0_run_range(args, (LAS float*)(lds + wave * 16384), P0_EARLY_ITEMS + ch * P0_CHUNK + wave * (P0_CHUNK / NWAVES), P0_CHUNK / NWAVES, lane);
                continue;
            }
            const int code = g_items.v[it];
#if defined(ONLY_S)
            attn_item<true>(args, lds, code);
#elif defined(ONLY_P)
            attn_item_p(args, lds, code);
#else
            if (code & 1) attn_item<true>(args, lds, code); else attn_item_p(args, lds, code);
#endif
        }
    }
#endif
    xcd_barrier(xbar);

#ifndef NO_P3
    for (int rep_ = 0; rep_ < REP_P3; ++rep_) { PHASE_IDS(); mix_rows(args, gw, NGW, lane); }
#endif
    xcd_barrier(xbar);

#ifndef NO_P4
    for (int rep_ = 0; rep_ < REP_P4; ++rep_) {
        pg8::Gemm g{(const pg8::bf16_t*)(ws + WS_MIX), (const pg8::bf16_t*)(ws + WS_WOUT), MT, DM, DM}; typedef pg8::TailOrderT<MT / 256, DM / 256, DM / 64, 8> Ord; Ord S; S.init(G, bx);
        pg8::EpiOut E{args.in[0], args.in[1], args.out + OFF_Y, (bf16*)(ws + WS_HN), (float*)(ws + WS_SSQ), red, (float*)(ws + WS_PART)};
        pg8::gemm_phase<pg8::EpiOut, Ord, true, true>(lds, g, S, E);
        if (S.rem > 0) {
            xcd_barrier(xbar);
            PHASE_IDS();
            for (int w = gw; w < S.rem * 256; w += NGW) {
                const int tu = w >> 8, r = w & 255; pg8::Unit u; Ord::SO::unit(S.full * G + tu, u);
                const size_t row = (size_t)u.pm * 256 + r; const int col = u.pn * 256 + 4 * lane;
                const float* xin = row < NP ? args.in[0] + row * DM : args.in[1] + (row - NP) * DM;
                f32x4 v = *(const f32x4*)(xin + col);
                const float* p = (const float*)(ws + WS_PART) + (size_t)(tu * 8) * 65536 + r * 256 + 4 * lane;
#pragma unroll
                for (int s = 0; s < 8; ++s) v += *(const f32x4*)(p + (size_t)s * 65536);
                *(f32x4*)(args.out + OFF_Y + row * DM + col) = v;
                u32x2 pk; pk.x = pk2(v[0], v[1]); pk.y = pk2(v[2], v[3]); *(u32x2*)((bf16*)(ws + WS_HN) + row * DM + col) = pk;
                const float ss = wave_sum((v[0] * v[0] + v[1] * v[1]) + (v[2] * v[2] + v[3] * v[3]));
                if (lane == 0) ((float*)(ws + WS_SSQ))[row * 8 + u.pn] = ss;
            }
        }
    }
#endif
    xcd_barrier(xbar);

#ifndef NO_P5
    for (int rep_ = 0; rep_ < REP_P5; ++rep_) {
        pg8::Gemm g{(const pg8::bf16_t*)(ws + WS_HN), (const pg8::bf16_t*)(ws + WS_WGU), MT, 2 * DFF, DM}; typedef pg8::StaticOrderT<MT / 256, 2 * DFF / 256, DM / 64> Ord; Ord S; S.init(G, bx);
        pg8::EpiGU E{(bf16*)(ws + WS_H), (const float*)(ws + WS_SSQ)};
        pg8::gemm_phase<pg8::EpiGU, Ord, true, true>(lds, g, S, E);
    }
#endif
    xcd_barrier(xbar);

#ifndef NO_P6
    {
        pg8::Gemm g{(const pg8::bf16_t*)(ws + WS_H), (const pg8::bf16_t*)(ws + WS_WDN), MT, DM, DFF};
        typedef pg8::TailOrderT<MT / 256, DM / 256, DFF / 64, 8> Ord; Ord S; S.init(G, bx);
        pg8::EpiDown E{args.out + OFF_Y, (float*)(ws + WS_PART), (const pg8::bf16_t*)(ws + WS_HN)};
        pg8::gemm_phase<pg8::EpiDown, Ord, true, true>(lds, g, S, E);
        if (S.rem > 0) {
            xcd_barrier(xbar);
            PHASE_IDS();
            for (int w = gw; w < S.rem * 256; w += NGW) {
                const int tu = w >> 8, r = w & 255; pg8::Unit u; Ord::SO::unit(S.full * G + tu, u);
                float* y = args.out + OFF_Y + ((size_t)u.pm * 256 + r) * DM + u.pn * 256 + 4 * lane;
                f32x4 v = *(const f32x4*)y;
                const float* p = (const float*)(ws + WS_PART) + (size_t)(tu * 8) * 65536 + r * 256 + 4 * lane;
#pragma unroll
                for (int s = 0; s < 8; ++s) v += *(const f32x4*)(p + (size_t)s * 65536);
                *(f32x4*)y = v;
            }
        }
    }
#endif
}

extern "C" void kernel_launch(void* const* d_in, const int* in_sizes, int n_in, void* d_out, int out_size, void* d_ws, size_t ws_size, hipStream_t stream) {
    static int grid = 0;
    if (grid == 0) {
        if (n_in != 17 || (size_t)out_size != OUT_TOTAL || ws_size < WS_END) { fprintf(stderr, "kernel_launch: unexpected shapes (n_in %d out %d ws %zu need %zu)\n", n_in, out_size, ws_size, (size_t)WS_END); grid = -1; return; }
        int dev = 0, cus = 0, per_cu = 0;
        hipGetDevice(&dev); hipDeviceGetAttribute(&cus, hipDeviceAttributeMultiprocessorCount, dev);
        hipFuncSetAttribute((const void*)fwd_megakernel, hipFuncAttributeMaxDynamicSharedMemorySize, LDS_BYTES);
        hipOccupancyMaxActiveBlocksPerMultiprocessor(&per_cu, (const void*)fwd_megakernel, NWAVES * 64, LDS_BYTES);
        if (per_cu < 1) { fprintf(stderr, "kernel_launch: occupancy query says %d blocks per CU\n", per_cu); per_cu = 1; }
        (void)hipGetLastError();
        grid = cus;
    }
    if (grid < 0) return;
    Args a{};
    for (int i = 0; i < 17; ++i) a.in[i] = (const float*)d_in[i];
    a.out = (float*)d_out; a.ws = (unsigned char*)d_ws;
    void* kargs[] = {&a};
    hipError_t e = hipLaunchCooperativeKernel((const void*)fwd_megakernel, dim3(grid), dim3(NWAVES * 64), kargs, LDS_BYTES, stream);
    if (e != hipSuccess) fprintf(stderr, "cooperative launch failed: %s (grid %d)\n", hipGetErrorString(e), grid);
}
```

```cpp
#include <hip/hip_runtime.h>
#include <hip/hip_cooperative_groups.h>
#include <cstdio>
#include <cstdint>
namespace cg = cooperative_groups;
namespace pg8 {
#define PG8_LAS __attribute__((address_space(3)))
typedef unsigned short bf16_t;
typedef short bf16x8 __attribute__((ext_vector_type(8)));
typedef float f32x4 __attribute__((ext_vector_type(4)));
typedef unsigned u32x4 __attribute__((ext_vector_type(4)));
constexpr int BM = 256, BK = 64, HALF = 128, HTB = HALF * BK * 2  , STAGE_BYTES = 8 * HTB, NXCD = 8, WGM = 8;

__host__ __device__ __forceinline__ int lds_byte(int r, int c) { const int st = (r >> 4) * 2 + (c >> 5), rr = r & 15, cc = c & 31, ob = rr * 64 + cc * 2; return st * 1024 + (ob ^ (((ob >> 9) & 1) << 5)); }
__host__ __device__ __forceinline__ void stage_rc(int b, int& R, int& C) { const int st = b / 1024, sb = b % 1024, swz = sb ^ (((sb >> 9) & 1) << 5); R = (st >> 1) * 16 + swz / 64; C = (st & 1) * 32 + (swz % 64) / 2; }
__host__ __device__ __forceinline__ int perm32(int rho) { const int n = rho >> 4, i = rho & 15; return 8 * (i >> 2) + 4 * n + (i & 3); }

struct Unit { int pm, pn, k0, nt, split, tu, sp; };
struct Gemm { const bf16_t* A; const bf16_t* Bt; int M, N, K; };

template <int NM, int NN, int NTK> struct StaticOrderT {
    static constexpr int nM = NM, nN = NN, nwg = NM * NN, ntk = NTK;
    int G, c;
    __host__ __device__ __forceinline__ void init(int G_, int c_) { G = G_; c = c_; }
    __host__ __device__ __forceinline__ bool next(int i, Unit& u) const { const int L = i * G + c; if (L >= nwg) return false; unit(L, u); return true; }
    __host__ __device__ __forceinline__ static void unit(int L, Unit& u) {
        int wgid = L; { constexpr int q = nwg / NXCD, r = nwg % NXCD; const int xcd = wgid % NXCD, off = wgid / NXCD; wgid = (xcd < r ? xcd * (q + 1) : r * (q + 1) + (xcd - r) * q) + off; }
        constexpr int nig = WGM * nN; const int gid = wgid / nig, fm = gid * WGM, gsz = (nM - fm) < WGM ? (nM - fm) : WGM;
        u.pm = fm + ((wgid % nig) % gsz); u.pn = (wgid % nig) / gsz; u.k0 = 0; u.nt = ntk; u.split = 0; u.tu = 0; u.sp = 0;
    }
    __device__ __forceinline__ void a_ready(const Unit&) const {}
    __device__ __forceinline__ void done(const Unit&) const {}
};
template <int NM, int NN, int NTK, int NSPLIT> struct TailOrderT {
    typedef StaticOrderT<NM, NN, NTK> SO;
    int G, c, full, rem;
    __host__ __device__ __forceinline__ void init(int G_, int c_) { G = G_; c = c_; full = SO::nwg / G; rem = SO::nwg - full * G; if (rem * NSPLIT > G || NTK < 2 * NSPLIT) { full = 1 << 24; rem = 0; } }
    __host__ __device__ __forceinline__ static int kstart(int s) { return s >= NSPLIT ? NTK : ((s * NTK / NSPLIT) & ~1); }
    __host__ __device__ __forceinline__ bool next(int i, Unit& u) const {
        if (i < full) { const int L = i * G + c; if (L >= SO::nwg) return false; SO::unit(L, u); return true; }
        if (i > full || c >= rem * NSPLIT) return false;
        const int tu = c / NSPLIT, sp = c % NSPLIT; SO::unit(full * G + tu, u); u.k0 = kstart(sp); u.nt = kstart(sp + 1) - u.k0; u.split = 1; u.tu = tu; u.sp = sp; return true;
    }
    __device__ __forceinline__ void a_ready(const Unit&) const {}
    __device__ __forceinline__ void done(const Unit&) const {}
};

struct InProjOrder {
    typedef StaticOrderT<30, 24, 32> SO;
    int G, c;
    __host__ __device__ __forceinline__ void init(int G_, int c_) { G = G_; c = c_; }
    __host__ __device__ __forceinline__ bool next(int i, Unit& u) const {
        const int L = i * G + c; if (L >= 768) return false;
        if (L < 720) { SO::unit(L, u); return true; }
        const int j = L - 720; u.pm = 30 + (j & 3); u.pn = j >> 2; u.k0 = 0; u.nt = 32; u.split = 0; u.tu = 0; u.sp = 0; return true;
    }
    __device__ __forceinline__ void a_ready(const Unit&) const {}
    __device__ __forceinline__ void done(const Unit&) const {}
};
struct OneUnit {
    Unit u0;
    __host__ __device__ __forceinline__ bool next(int i, Unit& u) const { if (i != 0) return false; u = u0; return true; }
    __device__ __forceinline__ void a_ready(const Unit&) const {}
    __device__ __forceinline__ void done(const Unit&) const {}
};

__device__ __forceinline__ unsigned cvt_pk_bf16(float lo, float hi) { unsigned r; asm volatile("v_cvt_pk_bf16_f32 %0, %1, %2" : "=v"(r) : "v"(lo), "v"(hi)); return r; }
typedef float f32x2 __attribute__((ext_vector_type(2)));
#define PG8_LBAR() asm volatile("s_waitcnt lgkmcnt(0)\n\ts_barrier" ::: "memory")
constexpr int NPROMPT = 8192;
__device__ __forceinline__ u32x4 pack8(const f32x4 a, const f32x4 b) { u32x4 w; w.x = cvt_pk_bf16(a[0], a[1]); w.y = cvt_pk_bf16(a[2], a[3]); w.z = cvt_pk_bf16(b[0], b[1]); w.w = cvt_pk_bf16(b[2], b[3]); return w; }


__device__ __forceinline__ void store_partial(float* part, int nsplit, const f32x4 (&acc)[2][2][4][2], const Unit& u, int wr, int wc, int fr, int fq) {
    float* pt = part + (size_t)(u.tu * nsplit + u.sp) * 65536; int rl0 = wr * 64 + fr, cw = wc * 32 + 8 * fq; asm volatile("" : "+v"(rl0), "+v"(cw));
#pragma unroll
    for (int ai = 0; ai < 2; ++ai)
#pragma unroll
        for (int m = 0; m < 4; ++m)
#pragma unroll
            for (int bj = 0; bj < 2; ++bj) { float* o = pt + (ai * HALF + rl0 + m * 16) * 256 + bj * HALF + cw; *(f32x4*)o = acc[ai][bj][m][0]; *(f32x4*)(o + 4) = acc[ai][bj][m][1]; }
}

struct EpiIn {
    static constexpr bool PERM = true, AFTER_DRAIN = false;
    bf16_t *Q, *Kb, *Vb, *GB, *U; float* out; const float *gq, *gk; PG8_LAS float* red; float qscale;
    size_t off_kp, off_vp, off_cp, off_ks, off_vs, off_cs;
    __device__ __forceinline__ void operator()(const f32x4 (&acc)[2][2][4][2], const Unit& u, int wr, int wc, int fr, int fq) const {
        int rl0 = wr * 64 + fr, cw = wc * 32 + 8 * fq; asm volatile("" : "+v"(rl0), "+v"(cw));
        const int pn = u.pn, rowt = u.pm * BM;
        const bool prompt = rowt < NPROMPT;
        if (pn < 8) {
            const bool isq = pn < 4;
#pragma unroll
            for (int ai = 0; ai < 2; ++ai)
#pragma unroll
                for (int m = 0; m < 4; ++m)
#pragma unroll
                    for (int bj = 0; bj < 2; ++bj) {
                        const f32x4 a = acc[ai][bj][m][0], b = acc[ai][bj][m][1];
                        float s = (a[0] * a[0] + a[1] * a[1]) + (a[2] * a[2] + a[3] * a[3]) + (b[0] * b[0] + b[1] * b[1]) + (b[2] * b[2] + b[3] * b[3]);
                        s += __shfl_xor(s, 16); s += __shfl_xor(s, 32);
                        if (fq == 0) red[((ai * HALF + rl0 + m * 16) * 2 + bj) * 4 + wc] = s;
                    }
            PG8_LBAR();
            const float* g = isq ? gq : gk;
            const f32x4 g0 = *(const f32x4*)(g + cw), g1 = *(const f32x4*)(g + cw + 4);
#pragma unroll
            for (int ai = 0; ai < 2; ++ai)
#pragma unroll
                for (int m = 0; m < 4; ++m) {
                    const int rl = ai * HALF + rl0 + m * 16; const size_t row = (size_t)(rowt + rl);
#pragma unroll
                    for (int bj = 0; bj < 2; ++bj) {
                        const f32x4 p = *(const PG8_LAS f32x4*)(red + (rl * 2 + bj) * 4);
                        float rs = __builtin_amdgcn_rsqf(((p[0] + p[1]) + (p[2] + p[3])) * (1.0f / 128.0f) + 1e-6f);
                        if (isq) rs *= qscale;
                        const f32x4 v0 = acc[ai][bj][m][0] * rs * g0, v1 = acc[ai][bj][m][1] * rs * g1;
                        if (isq) { *(u32x4*)(Q + row * 1024 + pn * 256 + bj * HALF + cw) = pack8(v0, v1); }
                        else {
                            const int col = (pn - 4) * 256 + bj * HALF + cw;
                            float* o = prompt ? out + off_kp + row * 1024 + col : out + off_ks + (row - NPROMPT) * 1024 + col;
                            *(f32x4*)o = v0; *(f32x4*)(o + 4) = v1;
                            if (prompt) *(u32x4*)(Kb + row * 1024 + col) = pack8(v0, v1);
                        }
                    }
                }
        } else if (pn < 12) {
#pragma unroll
            for (int ai = 0; ai < 2; ++ai)
#pragma unroll
                for (int m = 0; m < 4; ++m) {
                    const size_t row = (size_t)(rowt + ai * HALF + rl0 + m * 16);
#pragma unroll
                    for (int bj = 0; bj < 2; ++bj) {
                        const int col = (pn - 8) * 256 + bj * HALF + cw; const f32x4 v0 = acc[ai][bj][m][0], v1 = acc[ai][bj][m][1];
                        float* o = prompt ? out + off_vp + row * 1024 + col : out + off_vs + (row - NPROMPT) * 1024 + col;
                        *(f32x4*)o = v0; *(f32x4*)(o + 4) = v1;
                        if (prompt) *(u32x4*)(Vb + row * 1024 + col) = pack8(v0, v1);
                    }
                }
        } else if (pn < 16) {
#pragma unroll
            for (int ai = 0; ai < 2; ++ai)
#pragma unroll
                for (int m = 0; m < 4; ++m) {
                    const size_t row = (size_t)(rowt + ai * HALF + rl0 + m * 16);
#pragma unroll
                    for (int bj = 0; bj < 2; ++bj) *(u32x4*)(GB + row * 1024 + (pn - 12) * 256 + bj * HALF + cw) = pack8(acc[ai][bj][m][0], acc[ai][bj][m][1]);
                }
        } else {
#pragma unroll
            for (int ai = 0; ai < 2; ++ai)
#pragma unroll
                for (int m = 0; m < 4; ++m) {
                    const int rowi = rowt + ai * HALF + rl0 + m * 16; const int ch = (pn - 16) * HALF + cw;
                    const f32x4 v0 = acc[ai][0][m][0] * acc[ai][1][m][0], v1 = acc[ai][0][m][1] * acc[ai][1][m][1];
                    *(u32x4*)(U + (size_t)rowi * 1024 + ch) = pack8(v0, v1);
                    if (prompt) { const int t = rowi & 4095; if (t >= 4094) { float* o = out + off_cp + ((rowi >> 12) * 2 + (t - 4094)) * 1024 + ch; *(f32x4*)o = v0; *(f32x4*)(o + 4) = v1; } }
                    else { const int rs_ = rowi - NPROMPT, t = rs_ & 63; if (t >= 62) { float* o = out + off_cs + ((rs_ >> 6) * 2 + (t - 62)) * 1024 + ch; *(f32x4*)o = v0; *(f32x4*)(o + 4) = v1; } }
                }
        }
    }
};

struct EpiOut {
    static constexpr bool PERM = true, AFTER_DRAIN = false;
    const float *xp, *xs; float* Y; bf16_t* X1; float* ssq; PG8_LAS float* red; float* part;
    __device__ __forceinline__ void operator()(const f32x4 (&acc)[2][2][4][2], const Unit& u, int wr, int wc, int fr, int fq) const {
        if (u.split) { store_partial(part, 8, acc, u, wr, wc, fr, fq); return; }
        int rl0 = wr * 64 + fr, cw = wc * 32 + 8 * fq; asm volatile("" : "+v"(rl0), "+v"(cw));
        const int pn = u.pn, rowt = u.pm * BM;
        const float* xin = rowt < NPROMPT ? xp + (size_t)rowt * 2048 : xs + (size_t)(rowt - NPROMPT) * 2048;
#pragma unroll
        for (int ai = 0; ai < 2; ++ai) {
            f32x4 xv[4][2][2];
#pragma unroll
            for (int m = 0; m < 4; ++m)
#pragma unroll
                for (int bj = 0; bj < 2; ++bj) { const float* xi = xin + (size_t)(ai * HALF + rl0 + m * 16) * 2048 + pn * 256 + bj * HALF + cw; xv[m][bj][0] = *(const f32x4*)xi; xv[m][bj][1] = *(const f32x4*)(xi + 4); }
#pragma unroll
            for (int m = 0; m < 4; ++m) {
                const int rl = ai * HALF + rl0 + m * 16; float s = 0.f;
#pragma unroll
                for (int bj = 0; bj < 2; ++bj) {
                    const int col = pn * 256 + bj * HALF + cw;
                    const f32x4 v0 = xv[m][bj][0] + acc[ai][bj][m][0], v1 = xv[m][bj][1] + acc[ai][bj][m][1];
                    *(u32x4*)(X1 + (size_t)(rowt + rl) * 2048 + col) = pack8(v0, v1);
                    s += (v0[0] * v0[0] + v0[1] * v0[1]) + (v0[2] * v0[2] + v0[3] * v0[3]) + (v1[0] * v1[0] + v1[1] * v1[1]) + (v1[2] * v1[2] + v1[3] * v1[3]);
                }
                s += __shfl_xor(s, 16); s += __shfl_xor(s, 32);
                if (fq == 0) red[rl * 4 + wc] = s;
            }
            asm volatile("" ::: "memory");
        }
        PG8_LBAR();
        if (threadIdx.x < 256) { const f32x4 p = *(const PG8_LAS f32x4*)(red + threadIdx.x * 4); ssq[(size_t)(rowt + threadIdx.x) * 8 + pn] = (p[0] + p[1]) + (p[2] + p[3]); }
        PG8_LBAR();
    }
};

struct EpiGU {
    static constexpr bool PERM = true, AFTER_DRAIN = false;
    bf16_t* H; const float* ssq;
    __device__ __forceinline__ void operator()(const f32x4 (&acc)[2][2][4][2], const Unit& u, int wr, int wc, int fr, int fq) const {
        int rl0 = wr * 64 + fr, cw = wc * 32 + 8 * fq; asm volatile("" : "+v"(rl0), "+v"(cw));
        const int pn = u.pn, rowt = u.pm * BM;
        f32x4 pa[2][4], pb[2][4];
#pragma unroll
        for (int ai = 0; ai < 2; ++ai)
#pragma unroll
            for (int m = 0; m < 4; ++m) { const float* p = ssq + (size_t)(rowt + ai * HALF + rl0 + m * 16) * 8; pa[ai][m] = *(const f32x4*)p; pb[ai][m] = *(const f32x4*)(p + 4); }
#pragma unroll
        for (int ai = 0; ai < 2; ++ai)
#pragma unroll
            for (int m = 0; m < 4; ++m) {
                const size_t row = (size_t)(rowt + ai * HALF + rl0 + m * 16);
                const f32x4 p0 = pa[ai][m], p1 = pb[ai][m];
                const float rs = __builtin_amdgcn_rsqf((((p0[0] + p0[1]) + (p0[2] + p0[3])) + ((p1[0] + p1[1]) + (p1[2] + p1[3]))) * (1.0f / 2048.0f) + 1e-6f);
                f32x4 h[2];
#pragma unroll
                for (int n = 0; n < 2; ++n) {
                    const f32x4 g = acc[ai][0][m][n] * rs, up = acc[ai][1][m][n] * rs;
#pragma unroll
                    for (int j = 0; j < 4; ++j) h[n][j] = g[j] * __builtin_amdgcn_rcpf(1.0f + __builtin_amdgcn_exp2f(-1.4426950408889634f * g[j])) * up[j];
                }
                *(u32x4*)(H + row * 5632 + pn * HALF + cw) = pack8(h[0], h[1]);
            }
    }
};

struct EpiDown {
    static constexpr bool PERM = true, AFTER_DRAIN = false;
    float* Y; float* part; const bf16_t* X1;
    __device__ __forceinline__ void operator()(const f32x4 (&acc)[2][2][4][2], const Unit& u, int wr, int wc, int fr, int fq) const {
        if (u.split) { store_partial(part, 8, acc, u, wr, wc, fr, fq); return; }
        int rl0 = wr * 64 + fr, cw = wc * 32 + 8 * fq; asm volatile("" : "+v"(rl0), "+v"(cw));
        const int pn = u.pn, rowt = u.pm * BM;
        u32x4 xb[2][4][2];
#pragma unroll
        for (int ai = 0; ai < 2; ++ai)
#pragma unroll
            for (int m = 0; m < 4; ++m)
#pragma unroll
                for (int bj = 0; bj < 2; ++bj) xb[ai][m][bj] = *(const u32x4*)(X1 + (size_t)(rowt + ai * HALF + rl0 + m * 16) * 2048 + pn * 256 + bj * HALF + cw);
#pragma unroll
        for (int ai = 0; ai < 2; ++ai)
#pragma unroll
            for (int m = 0; m < 4; ++m)
#pragma unroll
                for (int bj = 0; bj < 2; ++bj) {
                    const size_t off = (size_t)(rowt + ai * HALF + rl0 + m * 16) * 2048 + pn * 256 + bj * HALF + cw;
                    const u32x4 x = xb[ai][m][bj];
                    f32x4 b0, b1; b0[0] = __builtin_bit_cast(float, x.x << 16); b0[1] = __builtin_bit_cast(float, x.x & 0xffff0000u); b0[2] = __builtin_bit_cast(float, x.y << 16); b0[3] = __builtin_bit_cast(float, x.y & 0xffff0000u);
                    b1[0] = __builtin_bit_cast(float, x.z << 16); b1[1] = __builtin_bit_cast(float, x.z & 0xffff0000u); b1[2] = __builtin_bit_cast(float, x.w << 16); b1[3] = __builtin_bit_cast(float, x.w & 0xffff0000u);
                    float* o = Y + off; *(f32x4*)o = b0 + acc[ai][bj][m][0]; *(f32x4*)(o + 4) = b1 + acc[ai][bj][m][1];
                }
    }
};

struct EpiNone {
    static constexpr bool PERM = true, AFTER_DRAIN = false;
    float* sink;
    __device__ __forceinline__ void operator()(const f32x4 (&acc)[2][2][4][2], const Unit& u, int wr, int wc, int fr, int fq) const {
        if (acc[0][0][0][0][0] == 12345.678f && acc[1][1][3][1][3] == -9876.5f) sink[0] = 1.f;
    }
};
template <class Epi, class Sched, bool ALIGN_EPI = false, bool SP2 = false>
__device__ __forceinline__ void gemm_phase(PG8_LAS unsigned char* lds, const Gemm g, const Sched& S, const Epi& E) {
    int tid_ = threadIdx.x; asm volatile("" : "+v"(tid_));
    const int tid = tid_, wid = __builtin_amdgcn_readfirstlane(tid >> 6), lane = tid & 63, wr = wid >> 2, wc = wid & 3, fr = lane & 15, fq = lane >> 4;
    const int K = g.K;
    unsigned voffA[2], voffB[2];
#pragma unroll
    for (int i = 0; i < 2; ++i) { int R, C; stage_rc(tid * 16 + i * 8192, R, C); const int Rb = Epi::PERM ? ((R & ~31) + perm32(R & 31)) : R;
        voffA[i] = (unsigned)(R * K + C) * 2u; voffB[i] = (unsigned)(Rb * K + C) * 2u; }
    const size_t kstep = (size_t)(BK * 2);
    const size_t hstep = (size_t)HALF * K * 2;
    const size_t tstep = 2 * hstep;
    const unsigned ldsw = (unsigned)wid * 1024u;
    const int aoff = lds_byte(wr * 64 + fr, fq * 8), boff = lds_byte(wc * 32 + fr, fq * 8);
#define PG8_SA(b, h) (((b) * 2 + (h)) * HTB)
#define PG8_SB(b, h) ((4 + (b) * 2 + (h)) * HTB)
#define PG8_STAGE(bufoff, gbase, voff) do { _Pragma("unroll") for (int _i = 0; _i < 2; ++_i) \
        __builtin_amdgcn_global_load_lds((const unsigned*)((const char*)(gbase) + (voff)[_i]), (PG8_LAS unsigned*)(lds + (bufoff) + ldsw + _i * 8192), 16, 0, 0); } while (0)
#define PG8_LDA(dst, b, h) do { _Pragma("unroll") for (int m = 0; m < 4; ++m) _Pragma("unroll") for (int k = 0; k < 2; ++k) dst[m][k] = *(const PG8_LAS bf16x8*)(lds + PG8_SA(b, h) + aoff + m * 2048 + k * 1024); } while (0)
#define PG8_LDB(dst, b, h) do { _Pragma("unroll") for (int n = 0; n < 2; ++n) _Pragma("unroll") for (int k = 0; k < 2; ++k) dst[n][k] = *(const PG8_LAS bf16x8*)(lds + PG8_SB(b, h) + boff + n * 2048 + k * 1024); } while (0)
#define PG8_MMA(ai, bj, At, Bt) do { __builtin_amdgcn_s_setprio(1); _Pragma("unroll") for (int m = 0; m < 4; ++m) _Pragma("unroll") for (int n = 0; n < 2; ++n) _Pragma("unroll") for (int k = 0; k < 2; ++k) \
        acc[ai][bj][m][n] = __builtin_amdgcn_mfma_f32_16x16x32_bf16(Bt[n][k], At[m][k], acc[ai][bj][m][n], 0, 0, 0); __builtin_amdgcn_s_setprio(0); } while (0)
#define PG8_WAIT_V(n) asm volatile("s_waitcnt vmcnt(" #n ")" ::: "memory")
#define PG8_WAIT_L(n) asm volatile("s_waitcnt lgkmcnt(" #n ")" ::: "memory")
#define PG8_BAR __builtin_amdgcn_s_barrier()
#define PG8_SCHED __builtin_amdgcn_sched_barrier(0)
    Unit cur, nxt; int ui = 0;
    if (!S.next(0, cur)) return;
    f32x4 acc[2][2][4][2];
#pragma unroll
    for (int a = 0; a < 2; ++a)
#pragma unroll
        for (int b = 0; b < 2; ++b)
#pragma unroll
            for (int m = 0; m < 4; ++m)
#pragma unroll
                for (int n = 0; n < 2; ++n) acc[a][b][m][n] = (f32x4){0.f, 0.f, 0.f, 0.f};
    bf16x8 At[4][2], B0[2][2], B1[2][2];
    const char* cA = (const char*)g.A + (size_t)cur.pm * tstep + (size_t)cur.k0 * kstep; const char* cB = (const char*)g.Bt + (size_t)cur.pn * tstep + (size_t)cur.k0 * kstep;
    S.a_ready(cur);
    if constexpr (SP2) {
        PG8_STAGE(PG8_SB(0, 0), cB, voffB); PG8_STAGE(PG8_SB(0, 1), cB + hstep, voffB); PG8_STAGE(PG8_SA(0, 0), cA, voffA); PG8_STAGE(PG8_SA(0, 1), cA + hstep, voffA);
        if (wr == 1) PG8_BAR;
        PG8_WAIT_V(2); PG8_BAR;
        PG8_STAGE(PG8_SB(1, 0), cB + kstep, voffB); PG8_STAGE(PG8_SA(1, 0), cA + kstep, voffA); PG8_STAGE(PG8_SB(1, 1), cB + hstep + kstep, voffB);
        PG8_WAIT_V(6); PG8_BAR;
    } else {
        PG8_STAGE(PG8_SB(0, 0), cB, voffB); PG8_STAGE(PG8_SA(0, 0), cA, voffA); PG8_STAGE(PG8_SB(0, 1), cB + hstep, voffB); PG8_STAGE(PG8_SA(0, 1), cA + hstep, voffA);
        if (wr == 1) PG8_BAR;
        PG8_WAIT_V(4); PG8_BAR;
        PG8_STAGE(PG8_SB(1, 0), cB + kstep, voffB); PG8_STAGE(PG8_SA(1, 0), cA + kstep, voffA); PG8_STAGE(PG8_SB(1, 1), cB + hstep + kstep, voffB);
        PG8_WAIT_V(6); PG8_BAR;
    }
    for (;;) {
        const bool has_next = S.next(ui + 1, nxt);
        const char* nA = has_next ? (const char*)g.A + (size_t)nxt.pm * tstep + (size_t)nxt.k0 * kstep : cA; const char* nB = has_next ? (const char*)g.Bt + (size_t)nxt.pn * tstep + (size_t)nxt.k0 * kstep : cB;
        const int nt = cur.nt;
        for (int t = 0; t < nt; t += 2) {
            const bool last = (t == nt - 2);
            const char* a1 = cA + (size_t)(t + 1) * kstep;
            const char* a2 = last ? nA : cA + (size_t)(t + 2) * kstep; const char* b2 = last ? nB : cB + (size_t)(t + 2) * kstep;
            const char* a3 = a2 + kstep; const char* b3 = b2 + kstep;
            if (last && has_next) S.a_ready(nxt);
            if constexpr (SP2) {
            PG8_LDB(B0, 0, 0); PG8_LDB(B1, 0, 1); PG8_SCHED; PG8_LDA(At, 0, 0); PG8_STAGE(PG8_SA(1, 1), a1 + hstep, voffA);
            PG8_WAIT_V(8); PG8_WAIT_L(0); PG8_BAR; PG8_MMA(0, 0, At, B0); PG8_MMA(0, 1, At, B1); PG8_BAR; PG8_SCHED;
            PG8_LDA(At, 0, 1); PG8_STAGE(PG8_SB(0, 0), b2, voffB); PG8_STAGE(PG8_SB(0, 1), b2 + hstep, voffB); PG8_STAGE(PG8_SA(0, 0), a2, voffA);
            PG8_WAIT_V(8); PG8_WAIT_L(0); PG8_BAR; PG8_MMA(1, 0, At, B0); PG8_MMA(1, 1, At, B1); PG8_BAR; PG8_SCHED;
            PG8_LDB(B0, 1, 0); PG8_LDB(B1, 1, 1); PG8_SCHED; PG8_LDA(At, 1, 0); PG8_STAGE(PG8_SA(0, 1), a2 + hstep, voffA);
            PG8_WAIT_V(8); PG8_WAIT_L(0); PG8_BAR; PG8_MMA(0, 0, At, B0); PG8_MMA(0, 1, At, B1); PG8_BAR; PG8_SCHED;
            PG8_LDA(At, 1, 1); PG8_STAGE(PG8_SB(1, 0), b3, voffB); PG8_STAGE(PG8_SB(1, 1), b3 + hstep, voffB); PG8_STAGE(PG8_SA(1, 0), a3, voffA);
            PG8_WAIT_V(8); PG8_WAIT_L(0); PG8_BAR; PG8_MMA(1, 0, At, B0); PG8_MMA(1, 1, At, B1); PG8_BAR; PG8_SCHED;
            } else {
            PG8_LDB(B0, 0, 0); PG8_SCHED; PG8_LDA(At, 0, 0); PG8_STAGE(PG8_SA(1, 1), a1 + hstep, voffA);
            PG8_WAIT_L(8); PG8_BAR; PG8_WAIT_L(0); PG8_MMA(0, 0, At, B0); PG8_BAR; PG8_SCHED;
            PG8_LDB(B1, 0, 1); PG8_STAGE(PG8_SB(0, 0), b2, voffB);
            PG8_BAR; PG8_WAIT_L(0); PG8_MMA(0, 1, At, B1); PG8_BAR;
            PG8_LDA(At, 0, 1); PG8_STAGE(PG8_SA(0, 0), a2, voffA);
            PG8_BAR; PG8_WAIT_L(0); PG8_MMA(1, 0, At, B0); PG8_BAR; PG8_SCHED;
            PG8_STAGE(PG8_SB(0, 1), b2 + hstep, voffB);
            PG8_WAIT_V(6); PG8_BAR; PG8_MMA(1, 1, At, B1); PG8_BAR;
            PG8_LDB(B0, 1, 0); PG8_SCHED; PG8_LDA(At, 1, 0); PG8_STAGE(PG8_SA(0, 1), a2 + hstep, voffA);
            PG8_WAIT_L(8); PG8_BAR; PG8_WAIT_L(0); PG8_MMA(0, 0, At, B0); PG8_BAR; PG8_SCHED;
            PG8_LDB(B1, 1, 1); PG8_STAGE(PG8_SB(1, 0), b3, voffB);
            PG8_BAR; PG8_WAIT_L(0); PG8_MMA(0, 1, At, B1); PG8_BAR;
            PG8_LDA(At, 1, 1); PG8_STAGE(PG8_SA(1, 0), a3, voffA);
            PG8_BAR; PG8_WAIT_L(0); PG8_MMA(1, 0, At, B0); PG8_BAR; PG8_SCHED;
            PG8_STAGE(PG8_SB(1, 1), b3 + hstep, voffB);
            PG8_WAIT_V(6); PG8_BAR; PG8_MMA(1, 1, At, B1); PG8_BAR;
            }
        }
        if constexpr (ALIGN_EPI) { if (wr == 0) PG8_BAR; }
        if constexpr (!Epi::AFTER_DRAIN) { E(acc, cur, wr, wc, fr, fq); S.done(cur); }
        if (!has_next) break;
#pragma unroll
        for (int a = 0; a < 2; ++a)
#pragma unroll
            for (int b = 0; b < 2; ++b)
#pragma unroll
                for (int m = 0; m < 4; ++m)
#pragma unroll
                    for (int n = 0; n < 2; ++n) acc[a][b][m][n] = (f32x4){0.f, 0.f, 0.f, 0.f};
        cur = nxt; cA = nA; cB = nB; ++ui;
        if constexpr (ALIGN_EPI) { if (wr == 1) PG8_BAR; }
    }
    PG8_WAIT_V(0);
    if constexpr (!ALIGN_EPI) { if (wr == 0) PG8_BAR; }
    PG8_BAR;
    if constexpr (Epi::AFTER_DRAIN) { E.fused(acc, cur, wr, wc, fr, fq, lds, wid, lane); S.done(cur); }
#undef PG8_SA
#undef PG8_SB
#undef PG8_STAGE
#undef PG8_LDA
#undef PG8_LDB
#undef PG8_MMA
#undef PG8_WAIT_V
#undef PG8_WAIT_L
#undef PG8_BAR
#undef PG8_SCHED
}
}
#define LAS __attribute__((address_space(3)))
typedef unsigned short bf16;
typedef float f32x4 __attribute__((ext_vector_type(4)));
typedef float f32x16 __attribute__((ext_vector_type(16)));
typedef short bf16x8 __attribute__((ext_vector_type(8)));
typedef short s16x4 __attribute__((ext_vector_type(4)));
typedef unsigned u32x4 __attribute__((ext_vector_type(4)));
typedef unsigned u32x2 __attribute__((ext_vector_type(2)));
constexpr int DM = 2048, SEQ = 4096, NP = 8192, NS = 512, MT = NP + NS, AW = 1024, CC = 1024, INC = 6144, DFF = 5632, PAST = 4096, DSEQ = 64;
constexpr float EPS = 1e-6f;
constexpr size_t OFF_Y = 0, OFF_KP = (size_t)MT * DM, OFF_VP = OFF_KP + (size_t)NP * AW, OFF_CP = OFF_VP + (size_t)NP * AW, OFF_KS = OFF_CP + 2 * 2 * CC,
                 OFF_VS = OFF_KS + (size_t)NS * AW, OFF_CS = OFF_VS + (size_t)NS * AW, OUT_TOTAL = OFF_CS + 8 * 2 * CC;
static_assert(OUT_TOTAL == 35672064, "output size");
constexpr size_t MiB = 1u << 20;
constexpr size_t WS_CTL = 0, WS_WIN = 1 * MiB, WS_WOUT = 25 * MiB, WS_WGU = 33 * MiB, WS_WDN = 77 * MiB, WS_HN = 99 * MiB, WS_Q = 133 * MiB, WS_K = 150 * MiB, WS_V = 166 * MiB,
                 WS_GB = 182 * MiB, WS_U = 199 * MiB, WS_MIX = 216 * MiB, WS_SSQ = 250 * MiB, WS_TP = 251 * MiB, WS_OP = 256 * MiB, WS_H = 256 * MiB, WS_PART = 133 * MiB  ;
constexpr int NSLOT = 256 + 16;
constexpr size_t WS_END = WS_OP + (size_t)NSLOT * 131072;
constexpr int RING_BYTES = 131072, RED_OFF = RING_BYTES, MISC_OFF = RED_OFF + 8192, LDS_BYTES = 147456;
constexpr int NWAVES = 8;

#define XB_TMO      128
#define XB_XCNT(j)  (256  + 64 * (j))
#define XB_XSUB(j)  (1280 + 64 * (j))
#define XB_XGEN(j)  (2304 + 64 * (j))
#define XB_TOP      3328
#define XB_TOPGEN   3392
#define XCD_BAR_WORDS 3456
#define XB_SPIN_CAP (1u << 18)

__device__ __forceinline__ unsigned xb_ld(unsigned* p)              { return __hip_atomic_load(p, __ATOMIC_RELAXED, __HIP_MEMORY_SCOPE_AGENT); }
__device__ __forceinline__ unsigned xb_add(unsigned* p, unsigned v) { return __hip_atomic_fetch_add(p, v, __ATOMIC_RELAXED, __HIP_MEMORY_SCOPE_AGENT); }
__device__ __forceinline__ unsigned xb_xcc_id() { return (unsigned)__builtin_amdgcn_s_getreg((3 << 11) | 20) & 0xFu; }
#define XB_SPIN(cond, bar) do { unsigned _sp = 0; while (cond) { __builtin_amdgcn_s_sleep(1); \
    if ((++_sp & 255u) == 0u) { if (xb_ld(&(bar)[XB_TMO])) break; if (_sp > XB_SPIN_CAP) { atomicAdd(&(bar)[XB_TMO], 1u); break; } } } } while (0)

struct XcdBarrier {
    unsigned* bar; unsigned x;
    volatile LAS unsigned* st;
};

__device__ __forceinline__ XcdBarrier xcd_barrier_post(unsigned* bar, volatile LAS unsigned* st) {
    XcdBarrier b; b.bar = bar; b.x = xb_xcc_id(); b.st = st;
    if (threadIdx.x == 0) (void)xb_add(&bar[XB_XCNT(b.x)], 1u);
    return b;
}
__device__ __forceinline__ void xcd_barrier_complete(unsigned* bar, unsigned x, unsigned& nloc, unsigned& nx) {
    const unsigned G = gridDim.x * gridDim.y * gridDim.z;
    unsigned sum, cnt, mine, sp = 0u;
    for (;;) {
        sum = 0u; cnt = 0u; mine = 0u;
#pragma unroll
        for (unsigned j = 0; j < 16; ++j) { const unsigned c = xb_ld(&bar[XB_XCNT(j)]); sum += c; cnt += (c > 0u) ? 1u : 0u; mine = (j == x) ? c : mine; }
        if (sum == G) break;
        __builtin_amdgcn_s_sleep(1);
        if ((++sp & 255u) == 0u) { if (xb_ld(&bar[XB_TMO])) break; if (sp > XB_SPIN_CAP) { atomicAdd(&bar[XB_TMO], 1u); break; } }
    }
    nloc = mine > 0u ? mine : 1u; nx = cnt > 0u ? cnt : 1u;
}

__device__ __forceinline__ void xcd_barrier(const XcdBarrier& b) {
    asm volatile("s_waitcnt vmcnt(0)" ::: "memory");
    __syncthreads();
    if (threadIdx.x == 0) {
        unsigned* bar = b.bar;
        __builtin_amdgcn_s_waitcnt(0);
        unsigned nloc = b.st[0], nx = b.st[1];
        if (nloc == 0u) { xcd_barrier_complete(bar, b.x, nloc, nx); b.st[0] = nloc; b.st[1] = nx; }
        const unsigned old = xb_add(&bar[XB_XSUB(b.x)], 1u);
        const unsigned gen = old / nloc;
        if (old + 1u == (gen + 1u) * nloc) {
            __builtin_amdgcn_fence(__ATOMIC_RELEASE, "agent");
            asm volatile("s_waitcnt vmcnt(0)" ::: "memory");
            const unsigned og = xb_add(&bar[XB_TOP], 1u);
            const unsigned tg = og / nx;
            if (og + 1u == (tg + 1u) * nx) xb_add(&bar[XB_TOPGEN], 1u);
            else XB_SPIN(xb_ld(&bar[XB_TOPGEN]) == tg, bar);
            __builtin_amdgcn_fence(__ATOMIC_ACQUIRE, "agent");
            xb_add(&bar[XB_XGEN(b.x)], 1u);
            asm volatile("s_waitcnt vmcnt(0)" ::: "memory");
        } else {
            XB_SPIN(xb_ld(&bar[XB_XGEN(b.x)]) == gen, bar);
            __builtin_amdgcn_fence(__ATOMIC_ACQUIRE, "agent");
            asm volatile("s_waitcnt vmcnt(0)" ::: "memory");
        }
    }
    __syncthreads();
}

struct ItemTab { int n; int v[272]; };
constexpr int p_nsteps(int qb, int c) { return 8 * (qb + 1); }
constexpr ItemTab make_items() {
    ItemTab t{}; t.n = 0;
    for (int b = 0; b < 8; ++b) for (int hg = 0; hg < 2; ++hg) t.v[t.n++] = 1 | (b << 1) | (hg << 4);
    for (int qb = 15; qb >= 0; --qb) for (int bh = 0; bh < 16; ++bh) t.v[t.n++] = (bh << 1) | (qb << 5);
    return t;
}
__device__ const ItemTab g_items = make_items();

__device__ __forceinline__ unsigned f2bf(float f) { unsigned u = __builtin_bit_cast(unsigned, f); return (u + 0x7fffu + ((u >> 16) & 1u)) >> 16; }
__device__ __forceinline__ unsigned pk2(float lo, float hi) { return pg8::cvt_pk_bf16(lo, hi); }
__device__ __forceinline__ float bflo(unsigned w) { return __builtin_bit_cast(float, w << 16); }
__device__ __forceinline__ float bfhi(unsigned w) { return __builtin_bit_cast(float, w & 0xffff0000u); }
__device__ __forceinline__ int crow(int r, int hi) { return (r & 3) + 8 * (r >> 2) + 4 * hi; }
__device__ __forceinline__ float wave_sum(float v) {
#pragma unroll
    for (int o = 1; o < 64; o <<= 1) v += __shfl_xor(v, o);
    return v;
}

struct Args { const float* in[17]; float* out; unsigned char* ws; };

struct P0Item { const float* src; const float* gk; bf16* dst; int N, K, k0; };
__device__ __forceinline__ P0Item p0_decode(const Args& a, int it) {
    constexpr int I_IN = 32 * 192, I_OUT = 32 * 64, I_G = 32 * 176;
    unsigned char* ws = a.ws; P0Item r; int n0, kb, drow; r.gk = nullptr;
    if (it < I_IN) { kb = it / 192; n0 = 32 * (it % 192); drow = n0;
        if (n0 >= 5120) { const int ch = n0 - 5120; drow = 4096 + (ch >> 7) * 256 + 128 + (ch & 127); } else if (n0 >= 4096) { const int ch = n0 - 4096; drow = 4096 + (ch >> 7) * 256 + (ch & 127); }
        r.src = a.in[6]; r.N = INC; r.K = DM; r.dst = (bf16*)(ws + WS_WIN); }
    else if ((it -= I_IN) < I_OUT) { kb = it / 64; n0 = 32 * (it % 64); drow = n0; r.src = a.in[12]; r.N = DM; r.K = DM; r.dst = (bf16*)(ws + WS_WOUT); }
    else if ((it -= I_OUT) < 2 * I_G) { const int up = it >= I_G; if (up) it -= I_G; kb = it / 176; n0 = 32 * (it % 176); drow = (n0 >> 7) * 256 + up * 128 + (n0 & 127);
        r.src = a.in[up ? 15 : 14]; r.N = DFF; r.K = DM; r.dst = (bf16*)(ws + WS_WGU); r.gk = a.in[13]; }
    else { it -= 2 * I_G; kb = it / 64; n0 = 32 * (it % 64); drow = n0; r.src = a.in[16]; r.N = DM; r.K = DFF; r.dst = (bf16*)(ws + WS_WDN); }
    r.k0 = 64 * kb; r.src += (size_t)r.k0 * r.N + n0; r.dst += (size_t)drow * r.K + r.k0;
    return r;
}
__device__ __forceinline__ void p0_load(const P0Item& p, f32x4 (&v)[8], int lane) {
#pragma unroll
    for (int j = 0; j < 8; ++j) v[j] = __builtin_nontemporal_load((const f32x4*)(p.src + (size_t)(8 * j + (lane >> 3)) * p.N + 4 * (lane & 7)));
}
__device__ __forceinline__ void p0_finish(const P0Item& p, const f32x4 (&v)[8], LAS float* scr, int lane) {
#pragma unroll
    for (int j = 0; j < 8; ++j) { const int kk = 8 * j + (lane >> 3); const float g = p.gk ? p.gk[p.k0 + kk] : 1.0f; LAS float* s = scr + kk * 33 + 4 * (lane & 7);
        s[0] = v[j][0] * g; s[1] = v[j][1] * g; s[2] = v[j][2] * g; s[3] = v[j][3] * g; }
    asm volatile("s_waitcnt lgkmcnt(0)" ::: "memory");
    const int c = lane & 7;
#pragma unroll
    for (int j = 0; j < 4; ++j) { const int n = (lane >> 3) + 8 * j; const LAS float* s = scr + (8 * c) * 33 + n;
        u32x4 o; o.x = pk2(s[0 * 33], s[1 * 33]); o.y = pk2(s[2 * 33], s[3 * 33]); o.z = pk2(s[4 * 33], s[5 * 33]); o.w = pk2(s[6 * 33], s[7 * 33]);
        *(u32x4*)(p.dst + (size_t)n * p.K + 8 * c) = o; }
    asm volatile("s_waitcnt lgkmcnt(0)" ::: "memory");
}
constexpr int P0_EARLY_ITEMS = 32 * 192 + 32 * 64, P0_ALL_ITEMS = 32 * 192 + 32 * 64 + 2 * 32 * 176 + 88 * 64, P0_CHUNK = 32, P0_LATE_CHUNKS = (P0_ALL_ITEMS - P0_EARLY_ITEMS) / P0_CHUNK;
static_assert((P0_ALL_ITEMS - P0_EARLY_ITEMS) % P0_CHUNK == 0, "late conversion items come in whole chunks");
__device__ __forceinline__ void p0_run_range(const Args& a, LAS float* scr, int first, int n, int lane) {
    f32x4 va[8], vb[8]; P0Item pa, pb;
    pa = p0_decode(a, first); p0_load(pa, va, lane);
    for (int i = 0; i < n; i += 2) {
        if (i + 1 < n) { pb = p0_decode(a, first + i + 1); p0_load(pb, vb, lane); }
        p0_finish(pa, va, scr, lane);
        if (i + 1 >= n) break;
        if (i + 2 < n) { pa = p0_decode(a, first + i + 2); p0_load(pa, va, lane); }
        p0_finish(pb, vb, scr, lane);
    }
}
__device__ __forceinline__ void p0_prologue(const Args& a, LAS unsigned char* lds, int gw, int NGW, int lane, int wave) {
    LAS float* scr = (LAS float*)(lds + wave * 16384);
    unsigned char* ws = a.ws;
    constexpr int NITEMS = P0_EARLY_ITEMS;
    {
        int it = gw; f32x4 va[8], vb[8]; P0Item pa, pb;
        if (it < NITEMS) { pa = p0_decode(a, it); p0_load(pa, va, lane); }
        while (it < NITEMS) {
            const int itb = it + NGW;
            if (itb < NITEMS) { pb = p0_decode(a, itb); p0_load(pb, vb, lane); }
            p0_finish(pa, va, scr, lane);
            it = itb + NGW;
            if (itb >= NITEMS) break;
            if (it < NITEMS) { pa = p0_decode(a, it); p0_load(pa, va, lane); }
            p0_finish(pb, vb, scr, lane);
        }
    }
    const float* g1 = a.in[5];
    f32x4 gv[8];
#pragma unroll
    for (int j = 0; j < 8; ++j) gv[j] = *((const f32x4*)g1 + 64 * j + lane);
    for (int m = gw; m < MT; m += 2 * NGW) {
        const int m2 = m + NGW; const bool has2 = m2 < MT;
        const float* xa = m < NP ? a.in[0] + (size_t)m * DM : a.in[1] + (size_t)(m - NP) * DM;
        const float* xb = has2 ? (m2 < NP ? a.in[0] + (size_t)m2 * DM : a.in[1] + (size_t)(m2 - NP) * DM) : xa;
        f32x4 va[8], vb[8];
#pragma unroll
        for (int j = 0; j < 8; ++j) va[j] = __builtin_nontemporal_load((const f32x4*)xa + 64 * j + lane);
        if (has2) {
#pragma unroll
            for (int j = 0; j < 8; ++j) vb[j] = __builtin_nontemporal_load((const f32x4*)xb + 64 * j + lane);
        }
        {
            float s = 0.f;
#pragma unroll
            for (int j = 0; j < 8; ++j) s += (va[j][0] * va[j][0] + va[j][1] * va[j][1]) + (va[j][2] * va[j][2] + va[j][3] * va[j][3]);
            const float rs = __builtin_amdgcn_rsqf(wave_sum(s) * (1.0f / DM) + EPS);
            u32x2* o = (u32x2*)((bf16*)(ws + WS_HN) + (size_t)m * DM) + lane;
#pragma unroll
            for (int j = 0; j < 8; ++j) { u32x2 w; w.x = pk2(va[j][0] * rs * gv[j][0], va[j][1] * rs * gv[j][1]); w.y = pk2(va[j][2] * rs * gv[j][2], va[j][3] * rs * gv[j][3]); o[64 * j] = w; }
        }
        if (has2) {
            float s = 0.f;
#pragma unroll
            for (int j = 0; j < 8; ++j) s += (vb[j][0] * vb[j][0] + vb[j][1] * vb[j][1]) + (vb[j][2] * vb[j][2] + vb[j][3] * vb[j][3]);
            const float rs = __builtin_amdgcn_rsqf(wave_sum(s) * (1.0f / DM) + EPS);
            u32x2* o = (u32x2*)((bf16*)(ws + WS_HN) + (size_t)m2 * DM) + lane;
#pragma unroll
            for (int j = 0; j < 8; ++j) { u32x2 w; w.x = pk2(vb[j][0] * rs * gv[j][0], vb[j][1] * rs * gv[j][1]); w.y = pk2(vb[j][2] * rs * gv[j][2], vb[j][3] * rs * gv[j][3]); o[64 * j] = w; }
        }
    }
}


template <int VS, bool QREG>
__device__ __forceinline__ void sb_block(f32x16 (&o)[4], float& R, const LAS unsigned char* kp, const LAS unsigned char* vp, const bf16x8 (&qreg)[8], const LAS unsigned char* qlp, int kb, int qw, int qpos, int hi) {
            f32x16 p;
#pragma unroll
            for (int r = 0; r < 16; ++r) p[r] = 0.f;
#pragma unroll
            for (int d0 = 0; d0 < 8; ++d0) { const bf16x8 kf = *(const LAS bf16x8*)(kp + d0 * 32); const bf16x8 qf = QREG ? qreg[d0] : *(const LAS bf16x8*)(qlp + d0 * 32); p = __builtin_amdgcn_mfma_f32_32x32x16_bf16(kf, qf, p, 0, 0, 0); }
            const bool need_mask = (kb + 31 >= qw);
            float e[16], sf[16];
#pragma unroll
            for (int r = 0; r < 16; ++r) {
                const float z = fminf(p[r], 100.f); float ee = __builtin_amdgcn_exp2f(z); float rr = __builtin_amdgcn_rcpf(1.0f + ee);
                if (need_mask) { const bool msk = (kb + crow(r, hi)) >= qpos; ee = msk ? 0.f : ee; rr = msk ? 1.f : rr; }
                e[r] = ee; sf[r] = rr;
            }
            float oth[4], PP[4];
#pragma unroll
            for (int g = 0; g < 4; ++g) { sf[4 * g + 2] *= sf[4 * g + 3]; sf[4 * g + 1] *= sf[4 * g + 2]; sf[4 * g] *= sf[4 * g + 1]; oth[g] = __shfl_xor(sf[4 * g], 32); PP[g] = sf[4 * g] * oth[g]; }
            const float SP3 = PP[3], SP2 = PP[2] * SP3, SP1 = PP[1] * SP2, SP0 = PP[0] * SP1;
            float A[4]; A[0] = R * SP1; A[1] = R * SP2; A[2] = R * SP3; A[3] = R;
#pragma unroll
            for (int g = 0; g < 4; ++g) A[g] = hi ? A[g] : A[g] * oth[g];
            R *= SP0;
            float w[16];
#pragma unroll
            for (int r = 0; r < 16; ++r) w[r] = (e[r] * sf[r]) * A[r >> 2];
#pragma unroll
            for (int s2 = 0; s2 < 2; ++s2) {
                u32x4 pw; pw.x = pk2(w[8 * s2 + 0], w[8 * s2 + 1]); pw.y = pk2(w[8 * s2 + 2], w[8 * s2 + 3]); pw.z = pk2(w[8 * s2 + 4], w[8 * s2 + 5]); pw.w = pk2(w[8 * s2 + 6], w[8 * s2 + 7]);
                const bf16x8 pa = __builtin_bit_cast(bf16x8, pw);
#pragma unroll
                for (int db = 0; db < 4; ++db) {
                    const s16x4 lo = __builtin_bit_cast(s16x4, __builtin_amdgcn_ds_read_tr16_b64_v4i16((LAS s16x4*)(vp + (16 * s2) * VS + db * 64)));
                    const s16x4 hh = __builtin_bit_cast(s16x4, __builtin_amdgcn_ds_read_tr16_b64_v4i16((LAS s16x4*)(vp + (16 * s2 + 8) * VS + db * 64)));
                    const bf16x8 vb = __builtin_shufflevector(lo, hh, 0, 1, 2, 3, 4, 5, 6, 7);
                    o[db] = __builtin_amdgcn_mfma_f32_32x32x16_bf16(pa, vb, o[db], 0, 0, 0);
                }
            }
}

template <bool SAMPLE>
__device__ __forceinline__ void attn_item(const Args& a, LAS unsigned char* lds, int code) {
    constexpr int NH = SAMPLE ? 4 : 1, KS = NH * 256 + 16, VS = NH * 256 + 32, K_OFF = 0, V_OFF = 32 * KS;
    int tid_ = threadIdx.x; asm volatile("" : "+v"(tid_));
    const int tid = tid_, lane = tid & 63, r32 = lane & 31, hi = lane >> 5; const int wid = __builtin_amdgcn_readfirstlane(tid >> 6);
    unsigned char* ws = a.ws;
    int slot, nsteps, kvpos0, qw, head, hl; size_t qrow;
    const bf16 *kgb = nullptr, *vgb = nullptr; const float *kgf = nullptr, *vgf = nullptr, *kgn = nullptr, *vgn = nullptr;
    if (SAMPLE) {
        const int b = (code >> 1) & 7, hg = (code >> 4) & 1;
        slot = 256 + b * 2 + hg; hl = wid >> 1; head = hg * 4 + hl; const int rg = wid & 1;
        qw = PAST + 32 * rg; qrow = (size_t)NP + b * DSEQ + 32 * rg + r32;
        nsteps = 130; kvpos0 = 0;
        kgf = a.in[2] + ((size_t)b * PAST + (tid >> 7)) * AW + hg * 512 + 4 * (tid & 127); vgf = a.in[3] + ((size_t)b * PAST + (tid >> 7)) * AW + hg * 512 + 4 * (tid & 127);
        kgn = a.out + OFF_KS + ((size_t)b * DSEQ + (tid >> 7)) * AW + hg * 512 + 4 * (tid & 127); vgn = a.out + OFF_VS + ((size_t)b * DSEQ + (tid >> 7)) * AW + hg * 512 + 4 * (tid & 127);
    } else {
        const int bh = (code >> 1) & 15, qb = (code >> 5) & 15, c = (code >> 9) & 3, b = bh >> 3;
        head = bh & 7; hl = 0; slot = bh * 16 + qb + 0 * c; nsteps = p_nsteps(qb, c); kvpos0 = 0;
        qw = qb * 256 + 32 * wid; qrow = (size_t)b * SEQ + qw + r32;
        kgb = (const bf16*)(ws + WS_K) + ((size_t)b * SEQ + kvpos0 + (tid >> 4)) * AW + head * 128 + (tid & 15) * 8;
        vgb = (const bf16*)(ws + WS_V) + ((size_t)b * SEQ + kvpos0 + (tid >> 4)) * AW + head * 128 + (tid & 15) * 8;
    }
    const int qpos = qw + r32;
    constexpr int Q_OFF = 67584, QS = 272;
    const LAS unsigned char* qlp = lds + Q_OFF + wid * (32 * QS) + r32 * QS + hi * 16;
    { const bf16* qp = (const bf16*)(ws + WS_Q) + qrow * AW + head * 128 + hi * 8;
#pragma unroll
      for (int d0 = 0; d0 < 8; ++d0) *(LAS bf16x8*)(lds + Q_OFF + wid * (32 * QS) + r32 * QS + hi * 16 + d0 * 32) = *(const bf16x8*)(qp + 16 * d0); }
    f32x16 o[4];
#pragma unroll
    for (int i = 0; i < 4; ++i)
#pragma unroll
        for (int r = 0; r < 16; ++r) o[i][r] = 0.f;
    float R = 1.f;
    u32x4 kreg, vreg; f32x4 kf4[8], vf4[8];
#define ATT_LOADK(s_) do { if (SAMPLE) { _Pragma("unroll") for (int i_ = 0; i_ < 8; ++i_) kf4[i_] = *(const f32x4*)(((s_) >= 128 ? kgn + (size_t)((s_) - 128) * 32 * AW : kgf + (size_t)(s_) * 32 * AW) + (size_t)i_ * 4 * AW); } \
        else { kreg = *(const u32x4*)(kgb + (size_t)(s_) * 32 * AW); } } while (0)
#define ATT_LOADV(s_) do { if (SAMPLE) { _Pragma("unroll") for (int i_ = 0; i_ < 8; ++i_) vf4[i_] = *(const f32x4*)(((s_) >= 128 ? vgn + (size_t)((s_) - 128) * 32 * AW : vgf + (size_t)(s_) * 32 * AW) + (size_t)i_ * 4 * AW); } \
        else { vreg = *(const u32x4*)(vgb + (size_t)(s_) * 32 * AW); } } while (0)
#define ATT_STOREK() do { if (SAMPLE) { _Pragma("unroll") for (int i_ = 0; i_ < 8; ++i_) { const int key_ = (tid >> 7) + 4 * i_, f4_ = tid & 127; \
            u32x2 kw_; kw_.x = pk2(kf4[i_][0], kf4[i_][1]); kw_.y = pk2(kf4[i_][2], kf4[i_][3]); *(LAS u32x2*)(lds + K_OFF + key_ * KS + f4_ * 8) = kw_; } } \
        else { *(LAS u32x4*)(lds + K_OFF + (tid >> 4) * KS + (tid & 15) * 16) = kreg; } } while (0)
#define ATT_STOREV() do { if (SAMPLE) { _Pragma("unroll") for (int i_ = 0; i_ < 8; ++i_) { const int key_ = (tid >> 7) + 4 * i_, f4_ = tid & 127; \
            u32x2 vw_; vw_.x = pk2(vf4[i_][0], vf4[i_][1]); vw_.y = pk2(vf4[i_][2], vf4[i_][3]); *(LAS u32x2*)(lds + V_OFF + key_ * VS + f4_ * 8) = vw_; } } \
        else { *(LAS u32x4*)(lds + V_OFF + (tid >> 4) * VS + (tid & 15) * 16) = vreg; } } while (0)
    volatile LAS int* flg = (volatile LAS int*)(lds + MISC_OFF + 64);
    ATT_LOADK(nsteps - 1); ATT_LOADV(nsteps - 1);
    ATT_STOREK(); ATT_STOREV();
    __syncthreads();
    const LAS unsigned char* kp = lds + K_OFF + r32 * KS + hl * 256 + hi * 16;
    const LAS unsigned char* vp = lds + V_OFF + (4 * hi + ((lane & 15) >> 2)) * VS + hl * 256 + (16 * ((lane >> 4) & 1) + 4 * (lane & 3)) * 2;
    for (int s = nsteps - 1; s >= 0; --s) {
        if (s > 0) { ATT_LOADK(s - 1); if (!SAMPLE) ATT_LOADV(s - 1); }
        const int kb = kvpos0 + 32 * s;
        if (kb < qw + 32 && !__all(R == 0.f)) { const bf16x8 qdummy[8] = {}; sb_block<VS, false>(o, R, kp, vp, qdummy, qlp, kb, qw, qpos, hi); }
        if (lane == 0) flg[wid] = __all(R == 0.f) ? 1 : 0;
        __syncthreads();
        const bool alldone = (flg[0] & flg[1] & flg[2] & flg[3] & flg[4] & flg[5] & flg[6] & flg[7]) != 0;
        if (alldone) { __syncthreads(); break; }
        if (s > 0) { ATT_STOREK(); if (SAMPLE) ATT_LOADV(s - 1); ATT_STOREV(); }
        __syncthreads();
    }
#undef ATT_LOADK
#undef ATT_LOADV
#undef ATT_STOREK
#undef ATT_STOREV
    float* op = (float*)(ws + WS_OP) + ((size_t)(slot * 8 + wid) * 32) * 128;
#pragma unroll
    for (int db = 0; db < 4; ++db)
#pragma unroll
        for (int r = 0; r < 16; ++r) op[crow(r, hi) * 128 + db * 32 + r32] = o[db][r];
    if (hi == 0) ((float*)(ws + WS_TP))[(slot * 8 + wid) * 32 + r32] = R;
}


__device__ __forceinline__ void attn_item_p(const Args& a, LAS unsigned char* lds, int code) {
    constexpr int KS = 272, VS = 288, TILE_K = 64 * KS, BUF = TILE_K + 64 * VS;
    int tid_ = threadIdx.x; asm volatile("" : "+v"(tid_));
    const int tid = tid_, lane = tid & 63, r32 = lane & 31, hi = lane >> 5; const int wid = __builtin_amdgcn_readfirstlane(tid >> 6);
    unsigned char* ws = a.ws;
    const int bh = (code >> 1) & 15, qb = (code >> 5) & 15, c = (code >> 9) & 3, b = bh >> 3, head = bh & 7;
    const int slot = bh * 16 + qb + 0 * c, nst = p_nsteps(qb, c) >> 1, kvpos0 = 0;
    const int qw = qb * 256 + 32 * wid, qpos = qw + r32; const size_t qrow = (size_t)b * SEQ + qpos;
    const bf16* kgb = (const bf16*)(ws + WS_K) + ((size_t)b * SEQ + kvpos0 + (tid >> 4)) * AW + head * 128 + (tid & 15) * 8;
    const bf16* vgb = (const bf16*)(ws + WS_V) + ((size_t)b * SEQ + kvpos0 + (tid >> 4)) * AW + head * 128 + (tid & 15) * 8;
    bf16x8 qf[8];
    { const bf16* qp = (const bf16*)(ws + WS_Q) + qrow * AW + head * 128 + hi * 8;
#pragma unroll
      for (int d0 = 0; d0 < 8; ++d0) qf[d0] = *(const bf16x8*)(qp + 16 * d0); }
    f32x16 o[4];
#pragma unroll
    for (int i = 0; i < 4; ++i)
#pragma unroll
        for (int r = 0; r < 16; ++r) o[i][r] = 0.f;
    float R = 1.f;
    u32x4 kreg[2], vreg[2];
#define PLOAD(s_) do { _Pragma("unroll") for (int i_ = 0; i_ < 2; ++i_) { kreg[i_] = *(const u32x4*)(kgb + (size_t)((s_) * 64 + 32 * i_) * AW); vreg[i_] = *(const u32x4*)(vgb + (size_t)((s_) * 64 + 32 * i_) * AW); } } while (0)
#define PSTORE(buf_) do { _Pragma("unroll") for (int i_ = 0; i_ < 2; ++i_) { *(LAS u32x4*)(lds + (buf_) * BUF + ((tid >> 4) + 32 * i_) * KS + (tid & 15) * 16) = kreg[i_]; \
        *(LAS u32x4*)(lds + (buf_) * BUF + TILE_K + ((tid >> 4) + 32 * i_) * VS + (tid & 15) * 16) = vreg[i_]; } } while (0)
    volatile LAS int* flg = (volatile LAS int*)(lds + MISC_OFF + 64);
    PLOAD(nst - 1);
    PSTORE(0);
    __syncthreads();
    const LAS unsigned char* kp = lds + r32 * KS + hi * 16;
    const LAS unsigned char* vp = lds + TILE_K + (4 * hi + ((lane & 15) >> 2)) * VS + (16 * ((lane >> 4) & 1) + 4 * (lane & 3)) * 2;
    int cur = 0;
    for (int s = nst - 1; s >= 0; --s) {
        if (s > 0) PLOAD(s - 1);
#pragma unroll
        for (int blk = 1; blk >= 0; --blk) {
            const int kb = kvpos0 + 64 * s + 32 * blk;
            if (kb < qw + 32 && !__all(R == 0.f)) sb_block<VS, true>(o, R, kp + cur * BUF + blk * 32 * KS, vp + cur * BUF + blk * 32 * VS, qf, kp, kb, qw, qpos, hi);
        }
        volatile LAS int* fl = flg + 8 * (s & 1);
        if (lane == 0) fl[wid] = __all(R == 0.f) ? 1 : 0;
        if (s > 0) PSTORE(cur ^ 1);
        __syncthreads();
        if ((fl[0] & fl[1] & fl[2] & fl[3] & fl[4] & fl[5] & fl[6] & fl[7]) != 0) break;
        cur ^= 1;
    }
#undef PLOAD
#undef PSTORE
    float* op = (float*)(ws + WS_OP) + ((size_t)(slot * 8 + wid) * 32) * 128;
#pragma unroll
    for (int db = 0; db < 4; ++db)
#pragma unroll
        for (int r = 0; r < 16; ++r) op[crow(r, hi) * 128 + db * 32 + r32] = o[db][r];
    if (hi == 0) ((float*)(ws + WS_TP))[(slot * 8 + wid) * 32 + r32] = R;
}

struct MixRow { int m, t; const float* st; f32x4 op[4]; u32x4 u2[2], u1[2], u0[2], gb[2]; };
__device__ __forceinline__ void mix_load(const Args& a, MixRow& R, int m, int lane) {
    unsigned char* ws = a.ws;
    const float* OP = (const float*)(ws + WS_OP); const bf16* U = (const bf16*)(ws + WS_U); const bf16* GB = (const bf16*)(ws + WS_GB);
    const int h = lane >> 3, d0 = (lane & 7) * 16, c0 = lane * 16;
    int slot0, wid, q;
    if (m < NP) { const int b = m >> 12, t = m & 4095, qb = t >> 8; wid = (t & 255) >> 5; q = t & 31; slot0 = (b * 8 + h) * 16 + qb; R.t = t; R.st = nullptr; }
    else { const int r = m - NP, b = r >> 6, t = r & 63, rg = t >> 5; q = t & 31; wid = (h & 3) * 2 + rg; slot0 = 256 + b * 2 + (h >> 2); R.t = t; R.st = a.in[4] + (size_t)b * 2 * CC; }
    R.m = m;
    const f32x4* p = (const f32x4*)(OP + ((size_t)(slot0 * 8 + wid) * 32 + q) * 128 + d0);
#pragma unroll
    for (int i = 0; i < 4; ++i) R.op[i] = p[i];
    { const u32x4* pu = (const u32x4*)(U + (size_t)m * CC + c0); R.u2[0] = pu[0]; R.u2[1] = pu[1]; }
    if (R.t >= 1) { const u32x4* pu = (const u32x4*)(U + (size_t)(m - 1) * CC + c0); R.u1[0] = pu[0]; R.u1[1] = pu[1]; }
    if (R.t >= 2) { const u32x4* pu = (const u32x4*)(U + (size_t)(m - 2) * CC + c0); R.u0[0] = pu[0]; R.u0[1] = pu[1]; }
    { const u32x4* pg = (const u32x4*)(GB + (size_t)m * CC + c0); R.gb[0] = pg[0]; R.gb[1] = pg[1]; }
}
__device__ __forceinline__ void unpack16(const u32x4 (&x)[2], float (&o)[16]) {
    const unsigned ww[8] = {x[0].x, x[0].y, x[0].z, x[0].w, x[1].x, x[1].y, x[1].z, x[1].w};
#pragma unroll
    for (int i = 0; i < 8; ++i) { o[2 * i] = bflo(ww[i]); o[2 * i + 1] = bfhi(ww[i]); }
}
__device__ __forceinline__ void mix_finish(const Args& a, const MixRow& R, const float (&ga16)[16], const float (&gc16)[16], const float (&w0c)[16], const float (&w1c)[16], const float (&w2c)[16], int lane) {
    bf16* MIX = (bf16*)(a.ws + WS_MIX);
    const int h = lane >> 3, d0 = (lane & 7) * 16, c0 = lane * 16, m = R.m;
    float s = 0.f;
#pragma unroll
    for (int i = 0; i < 4; ++i) s += (R.op[i][0] * R.op[i][0] + R.op[i][1] * R.op[i][1]) + (R.op[i][2] * R.op[i][2] + R.op[i][3] * R.op[i][3]);
    float rs = __builtin_amdgcn_rsqf(wave_sum(s) * (1.0f / AW) + EPS);
    { unsigned ww[8];
#pragma unroll
      for (int i = 0; i < 8; ++i) ww[i] = pk2(R.op[i >> 1][(2 * i) & 3] * rs * ga16[2 * i], R.op[i >> 1][(2 * i + 1) & 3] * rs * ga16[2 * i + 1]);
      u32x4 w0, w1; w0.x = ww[0]; w0.y = ww[1]; w0.z = ww[2]; w0.w = ww[3]; w1.x = ww[4]; w1.y = ww[5]; w1.z = ww[6]; w1.w = ww[7];
      u32x4* o = (u32x4*)(MIX + (size_t)m * DM + h * 128 + d0); o[0] = w0; o[1] = w1; }
    float u0[16], u1[16], u2[16], gbv[16];
    unpack16(R.u2, u2); unpack16(R.gb, gbv);
    if (R.t >= 1) unpack16(R.u1, u1); else {
#pragma unroll
        for (int i = 0; i < 16; ++i) u1[i] = R.st ? R.st[CC + c0 + i] : 0.f; }
    if (R.t >= 2) unpack16(R.u0, u0); else {
#pragma unroll
        for (int i = 0; i < 16; ++i) u0[i] = R.st ? R.st[(R.t == 0 ? 0 : CC) + c0 + i] : 0.f; }
    float oc[16]; float s2 = 0.f;
#pragma unroll
    for (int i = 0; i < 16; ++i) { oc[i] = gbv[i] * (w0c[i] * u0[i] + w1c[i] * u1[i] + w2c[i] * u2[i]); s2 += oc[i] * oc[i]; }
    rs = __builtin_amdgcn_rsqf(wave_sum(s2) * (1.0f / CC) + EPS);
    { unsigned ww[8];
#pragma unroll
      for (int i = 0; i < 8; ++i) ww[i] = pk2(oc[2 * i] * rs * gc16[2 * i], oc[2 * i + 1] * rs * gc16[2 * i + 1]);
      u32x4 w0, w1; w0.x = ww[0]; w0.y = ww[1]; w0.z = ww[2]; w0.w = ww[3]; w1.x = ww[4]; w1.y = ww[5]; w1.z = ww[6]; w1.w = ww[7];
      u32x4* o = (u32x4*)(MIX + (size_t)m * DM + AW + c0); o[0] = w0; o[1] = w1; }
}
__device__ __forceinline__ void mix_rows(const Args& a, int gw, int NGW, int lane) {
    const float* cw = a.in[9]; const float* ga = a.in[10]; const float* gc = a.in[11];
    const int h = lane >> 3, d0 = (lane & 7) * 16, c0 = lane * 16;
    float ga16[16], gc16[16], w0c[16], w1c[16], w2c[16];
#pragma unroll
    for (int i = 0; i < 4; ++i) {
        const f32x4 x0 = *(const f32x4*)(ga + h * 128 + d0 + 4 * i), x1 = *(const f32x4*)(gc + c0 + 4 * i), x2 = *(const f32x4*)(cw + c0 + 4 * i), x3 = *(const f32x4*)(cw + CC + c0 + 4 * i), x4 = *(const f32x4*)(cw + 2 * CC + c0 + 4 * i);
#pragma unroll
        for (int j = 0; j < 4; ++j) { ga16[4 * i + j] = x0[j]; gc16[4 * i + j] = x1[j]; w0c[4 * i + j] = x2[j]; w1c[4 * i + j] = x3[j]; w2c[4 * i + j] = x4[j]; }
    }
    for (int m = gw; m < MT; m += 2 * NGW) {
        MixRow A, B; const bool hasB = m + NGW < MT;
        mix_load(a, A, m, lane);
        if (hasB) mix_load(a, B, m + NGW, lane);
        mix_finish(a, A, ga16, gc16, w0c, w1c, w2c, lane);
        if (hasB) mix_finish(a, B, ga16, gc16, w0c, w1c, w2c, lane);
    }
}
#ifndef REP_P0
#define REP_P0 1
#endif
#ifndef REP_P1
#define REP_P1 1
#endif
#ifndef REP_P3
#define REP_P3 1
#endif
#ifndef REP_P4
#define REP_P4 1
#endif
#ifndef REP_P5
#define REP_P5 1
#endif
__global__ void __launch_bounds__(NWAVES * 64, 2) fwd_megakernel(Args args) {
    extern __shared__ __attribute__((aligned(16))) unsigned char lds_raw[];
    cg::grid_group grid = cg::this_grid();
    LAS unsigned char* lds = (LAS unsigned char*)lds_raw;
    const int G = gridDim.x, bx = blockIdx.x, NGW = G * NWAVES;
#define PHASE_IDS() int tid = threadIdx.x; asm volatile("" : "+v"(tid)); const int lane = tid & 63; const int wave = __builtin_amdgcn_readfirstlane(tid >> 6); const int gw = bx * NWAVES + wave; (void)lane; (void)gw
    unsigned char* ws = args.ws;
    unsigned* ctl = (unsigned*)(ws + WS_CTL);
    LAS float* red = (LAS float*)(lds + RED_OFF);
    volatile LAS int* misc = (volatile LAS int*)(lds + MISC_OFF);

    { PHASE_IDS(); if (bx == 0 && tid == 0) { ctl[0] = 0u; ctl[64] = 0u; for (int i = 0; i < 16; ++i) ctl[128 + i] = 0u; }
      if (bx == 0) for (int i = tid; i < XCD_BAR_WORDS; i += NWAVES * 64) ctl[4096 + i] = 0u;
      if (tid < 2) misc[8 + tid] = 0;
#ifndef NO_P0
    for (int rep_ = 0; rep_ < REP_P0; ++rep_) p0_prologue(args, lds, gw, NGW, lane, wave);
#endif
    }
    grid.sync();
    XcdBarrier xbar = xcd_barrier_post(ctl + 4096, (volatile LAS unsigned*)(lds + MISC_OFF) + 8);

#ifndef NO_P1
    for (int rep_ = 0; rep_ < REP_P1; ++rep_) {
        pg8::Gemm g{(const pg8::bf16_t*)(ws + WS_HN), (const pg8::bf16_t*)(ws + WS_WIN), MT, INC, DM}; typedef pg8::InProjOrder Ord; Ord S; S.init(G, bx);
        pg8::EpiIn E{(bf16*)(ws + WS_Q), (bf16*)(ws + WS_K), (bf16*)(ws + WS_V), (bf16*)(ws + WS_GB), (bf16*)(ws + WS_U), args.out, args.in[7], args.in[8], red,
                     1.4426950408889634f * 0.08838834764831845f, OFF_KP, OFF_VP, OFF_CP, OFF_KS, OFF_VS, OFF_CS};
        pg8::gemm_phase<pg8::EpiIn, Ord, true, true>(lds, g, S, E);
    }
#endif
    xcd_barrier(xbar);

#ifndef NO_P2
    {
        const int nitems = g_items.n;
        PHASE_IDS();
#ifdef DUP_P2
        for (int rep = 0; rep < 2; ++rep)
#else
        const int rep = 0;
#endif
        for (;;) {
            if (tid == 0) misc[0] = (int)atomicAdd(ctl + 64 * rep, 1u);
            __syncthreads();
            int it = misc[0];
            __syncthreads();
            if (it < 48) {
                pg8::Gemm g{(const pg8::bf16_t*)(ws + WS_HN), (const pg8::bf16_t*)(ws + WS_WIN), MT, INC, DM};
                pg8::OneUnit S1; S1.u0.pm = 30 + (it & 3); S1.u0.pn = 12 + (it >> 2); S1.u0.k0 = 0; S1.u0.nt = 32; S1.u0.split = 0; S1.u0.tu = 0; S1.u0.sp = 0;
                pg8::EpiIn E{(bf16*)(ws + WS_Q), (bf16*)(ws + WS_K), (bf16*)(ws + WS_V), (bf16*)(ws + WS_GB), (bf16*)(ws + WS_U), args.out, args.in[7], args.in[8], red,
                             1.4426950408889634f * 0.08838834764831845f, OFF_KP, OFF_VP, OFF_CP, OFF_KS, OFF_VS, OFF_CS};
                pg8::gemm_phase<pg8::EpiIn, pg8::OneUnit, true, true>(lds, g, S1, E);
                __syncthreads();
                continue;
            }
            it -= 48;
            if (it >= nitems) {
                const int ch = it - nitems; if (ch >= P0_LATE_CHUNKS) break;
                p0_run_range(args, (LAS float*)(lds + wave * 16384), P0_EARLY_ITEMS + ch * P0_CHUNK + wave * (P0_CHUNK / NWAVES), P0_CHUNK / NWAVES, lane);
                continue;
            }
            const int code = g_items.v[it];
#if defined(ONLY_S)
            attn_item<true>(args, lds, code);
#elif defined(ONLY_P)
            attn_item_p(args, lds, code);
#else
            if (code & 1) attn_item<true>(args, lds, code); else attn_item_p(args, lds, code);
#endif
        }
    }
#endif
    xcd_barrier(xbar);

#ifndef NO_P3
    for (int rep_ = 0; rep_ < REP_P3; ++rep_) { PHASE_IDS(); mix_rows(args, gw, NGW, lane); }
#endif
    xcd_barrier(xbar);

#ifndef NO_P4
    for (int rep_ = 0; rep_ < REP_P4; ++rep_) {
        pg8::Gemm g{(const pg8::bf16_t*)(ws + WS_MIX), (const pg8::bf16_t*)(ws + WS_WOUT), MT, DM, DM}; typedef pg8::TailOrderT<MT / 256, DM / 256, DM / 64, 8> Ord; Ord S; S.init(G, bx);
        pg8::EpiOut E{args.in[0], args.in[1], args.out + OFF_Y, (bf16*)(ws + WS_HN), (float*)(ws + WS_SSQ), red, (float*)(ws + WS_PART)};
        pg8::gemm_phase<pg8::EpiOut, Ord, true, true>(lds, g, S, E);
        if (S.rem > 0) {
            xcd_barrier(xbar);
            PHASE_IDS();
            for (int w = gw; w < S.rem * 256; w += NGW) {
                const int tu = w >> 8, r = w & 255; pg8::Unit u; Ord::SO::unit(S.full * G + tu, u);
                const size_t row = (size_t)u.pm * 256 + r; const int col = u.pn * 256 + 4 * lane;
                const float* xin = row < NP ? args.in[0] + row * DM : args.in[1] + (row - NP) * DM;
                f32x4 v = *(const f32x4*)(xin + col);
                const float* p = (const float*)(ws + WS_PART) + (size_t)(tu * 8) * 65536 + r * 256 + 4 * lane;
#pragma unroll
                for (int s = 0; s < 8; ++s) v += *(const f32x4*)(p + (size_t)s * 65536);
                *(f32x4*)(args.out + OFF_Y + row * DM + col) = v;
                u32x2 pk; pk.x = pk2(v[0], v[1]); pk.y = pk2(v[2], v[3]); *(u32x2*)((bf16*)(ws + WS_HN) + row * DM + col) = pk;
                const float ss = wave_sum((v[0] * v[0] + v[1] * v[1]) + (v[2] * v[2] + v[3] * v[3]));
                if (lane == 0) ((float*)(ws + WS_SSQ))[row * 8 + u.pn] = ss;
            }
        }
    }
#endif
    xcd_barrier(xbar);

#ifndef NO_P5
    for (int rep_ = 0; rep_ < REP_P5; ++rep_) {
        pg8::Gemm g{(const pg8::bf16_t*)(ws + WS_HN), (const pg8::bf16_t*)(ws + WS_WGU), MT, 2 * DFF, DM}; typedef pg8::StaticOrderT<MT / 256, 2 * DFF / 256, DM / 64> Ord; Ord S; S.init(G, bx);
        pg8::EpiGU E{(bf16*)(ws + WS_H), (const float*)(ws + WS_SSQ)};
        pg8::gemm_phase<pg8::EpiGU, Ord, true, true>(lds, g, S, E);
    }
#endif
    xcd_barrier(xbar);

#ifndef NO_P6
    {
        pg8::Gemm g{(const pg8::bf16_t*)(ws + WS_H), (const pg8::bf16_t*)(ws + WS_WDN), MT, DM, DFF};
        typedef pg8::TailOrderT<MT / 256, DM / 256, DFF / 64, 8> Ord; Ord S; S.init(G, bx);
        pg8::EpiDown E{args.out + OFF_Y, (float*)(ws + WS_PART), (const pg8::bf16_t*)(ws + WS_HN)};
        pg8::gemm_phase<pg8::EpiDown, Ord, true, true>(lds, g, S, E);
        if (S.rem > 0) {
            xcd_barrier(xbar);
            PHASE_IDS();
            for (int w = gw; w < S.rem * 256; w += NGW) {
                const int tu = w >> 8, r = w & 255; pg8::Unit u; Ord::SO::unit(S.full * G + tu, u);
                float* y = args.out + OFF_Y + ((size_t)u.pm * 256 + r) * DM + u.pn * 256 + 4 * lane;
                f32x4 v = *(const f32x4*)y;
                const float* p = (const float*)(ws + WS_PART) + (size_t)(tu * 8) * 65536 + r * 256 + 4 * lane;
#pragma unroll
                for (int s = 0; s < 8; ++s) v += *(const f32x4*)(p + (size_t)s * 65536);
                *(f32x4*)y = v;
            }
        }
    }
#endif
}

extern "C" void kernel_launch(void* const* d_in, const int* in_sizes, int n_in, void* d_out, int out_size, void* d_ws, size_t ws_size, hipStream_t stream) {
    static int grid = 0;
    if (grid == 0) {
        if (n_in != 17 || (size_t)out_size != OUT_TOTAL || ws_size < WS_END) { fprintf(stderr, "kernel_launch: unexpected shapes (n_in %d out %d ws %zu need %zu)\n", n_in, out_size, ws_size, (size_t)WS_END); grid = -1; return; }
        int dev = 0, cus = 0, per_cu = 0;
        hipGetDevice(&dev); hipDeviceGetAttribute(&cus, hipDeviceAttributeMultiprocessorCount, dev);
        hipFuncSetAttribute((const void*)fwd_megakernel, hipFuncAttributeMaxDynamicSharedMemorySize, LDS_BYTES);
        hipOccupancyMaxActiveBlocksPerMultiprocessor(&per_cu, (const void*)fwd_megakernel, NWAVES * 64, LDS_BYTES);
        if (per_cu < 1) { fprintf(stderr, "kernel_launch: occupancy query says %d blocks per CU\n", per_cu); per_cu = 1; }
        (void)hipGetLastError();
        grid = cus;
    }
    if (grid < 0) return;
    Args a{};
    for (int i = 0; i < 17; ++i) a.in[i] = (const float*)d_in[i];
    a.out = (float*)d_out; a.ws = (unsigned char*)d_ws;
    void* kargs[] = {&a};
    hipError_t e = hipLaunchCooperativeKernel((const void*)fwd_megakernel, dim3(grid), dim3(NWAVES * 64), kargs, LDS_BYTES, stream);
    if (e != hipSuccess) fprintf(stderr, "cooperative launch failed: %s (grid %d)\n", hipGetErrorString(e), grid);
}
```

```cpp
#include <hip/hip_runtime.h>
#include <hip/hip_cooperative_groups.h>
#include <cstdio>
#include <cstdint>
namespace cg = cooperative_groups;
namespace pg8 {
#define PG8_LAS __attribute__((address_space(3)))
typedef unsigned short bf16_t;
typedef short bf16x8 __attribute__((ext_vector_type(8)));
typedef float f32x4 __attribute__((ext_vector_type(4)));
typedef unsigned u32x4 __attribute__((ext_vector_type(4)));
constexpr int BM = 256, BK = 64, HALF = 128, HTB = HALF * BK * 2  , STAGE_BYTES = 8 * HTB, NXCD = 8, WGM = 8;

__host__ __device__ __forceinline__ int lds_byte(int r, int c) { const int st = (r >> 4) * 2 + (c >> 5), rr = r & 15, cc = c & 31, ob = rr * 64 + cc * 2; return st * 1024 + (ob ^ (((ob >> 9) & 1) << 5)); }
__host__ __device__ __forceinline__ void stage_rc(int b, int& R, int& C) { const int st = b / 1024, sb = b % 1024, swz = sb ^ (((sb >> 9) & 1) << 5); R = (st >> 1) * 16 + swz / 64; C = (st & 1) * 32 + (swz % 64) / 2; }
__host__ __device__ __forceinline__ int perm32(int rho) { const int n = rho >> 4, i = rho & 15; return 8 * (i >> 2) + 4 * n + (i & 3); }

struct Unit { int pm, pn, k0, nt, split, tu, sp; };
struct Gemm { const bf16_t* A; const bf16_t* Bt; int M, N, K; };

template <int NM, int NN, int NTK> struct StaticOrderT {
    static constexpr int nM = NM, nN = NN, nwg = NM * NN, ntk = NTK;
    int G, c;
    __host__ __device__ __forceinline__ void init(int G_, int c_) { G = G_; c = c_; }
    __host__ __device__ __forceinline__ bool next(int i, Unit& u) const { const int L = i * G + c; if (L >= nwg) return false; unit(L, u); return true; }
    __host__ __device__ __forceinline__ static void unit(int L, Unit& u) {
        int wgid = L; { constexpr int q = nwg / NXCD, r = nwg % NXCD; const int xcd = wgid % NXCD, off = wgid / NXCD; wgid = (xcd < r ? xcd * (q + 1) : r * (q + 1) + (xcd - r) * q) + off; }
        constexpr int nig = WGM * nN; const int gid = wgid / nig, fm = gid * WGM, gsz = (nM - fm) < WGM ? (nM - fm) : WGM;
        u.pm = fm + ((wgid % nig) % gsz); u.pn = (wgid % nig) / gsz; u.k0 = 0; u.nt = ntk; u.split = 0; u.tu = 0; u.sp = 0;
    }
    __device__ __forceinline__ void a_ready(const Unit&) const {}
    __device__ __forceinline__ void done(const Unit&) const {}
};
template <int NM, int NN, int NTK, int NSPLIT> struct TailOrderT {
    typedef StaticOrderT<NM, NN, NTK> SO;
    int G, c, full, rem;
    __host__ __device__ __forceinline__ void init(int G_, int c_) { G = G_; c = c_; full = SO::nwg / G; rem = SO::nwg - full * G; if (rem * NSPLIT > G || NTK < 2 * NSPLIT) { full = 1 << 24; rem = 0; } }
    __host__ __device__ __forceinline__ static int kstart(int s) { return s >= NSPLIT ? NTK : ((s * NTK / NSPLIT) & ~1); }
    __host__ __device__ __forceinline__ bool next(int i, Unit& u) const {
        if (i < full) { const int L = i * G + c; if (L >= SO::nwg) return false; SO::unit(L, u); return true; }
        if (i > full || c >= rem * NSPLIT) return false;
        const int tu = c / NSPLIT, sp = c % NSPLIT; SO::unit(full * G + tu, u); u.k0 = kstart(sp); u.nt = kstart(sp + 1) - u.k0; u.split = 1; u.tu = tu; u.sp = sp; return true;
    }
    __device__ __forceinline__ void a_ready(const Unit&) const {}
    __device__ __forceinline__ void done(const Unit&) const {}
};

struct InProjOrder {
    typedef StaticOrderT<30, 24, 32> SO;
    int G, c;
    __host__ __device__ __forceinline__ void init(int G_, int c_) { G = G_; c = c_; }
    __host__ __device__ __forceinline__ bool next(int i, Unit& u) const {
        const int L = i * G + c; if (L >= 768) return false;
        if (L < 720) { SO::unit(L, u); return true; }
        const int j = L - 720; u.pm = 30 + (j & 3); u.pn = j >> 2; u.k0 = 0; u.nt = 32; u.split = 0; u.tu = 0; u.sp = 0; return true;
    }
    __device__ __forceinline__ void a_ready(const Unit&) const {}
    __device__ __forceinline__ void done(const Unit&) const {}
};
struct OneUnit {
    Unit u0;
    __host__ __device__ __forceinline__ bool next(int i, Unit& u) const { if (i != 0) return false; u = u0; return true; }
    __device__ __forceinline__ void a_ready(const Unit&) const {}
    __device__ __forceinline__ void done(const Unit&) const {}
};

__device__ __forceinline__ unsigned cvt_pk_bf16(float lo, float hi) { unsigned r; asm volatile("v_cvt_pk_bf16_f32 %0, %1, %2" : "=v"(r) : "v"(lo), "v"(hi)); return r; }
typedef float f32x2 __attribute__((ext_vector_type(2)));
#define PG8_LBAR() asm volatile("s_waitcnt lgkmcnt(0)\n\ts_barrier" ::: "memory")
constexpr int NPROMPT = 8192;
__device__ __forceinline__ u32x4 pack8(const f32x4 a, const f32x4 b) { u32x4 w; w.x = cvt_pk_bf16(a[0], a[1]); w.y = cvt_pk_bf16(a[2], a[3]); w.z = cvt_pk_bf16(b[0], b[1]); w.w = cvt_pk_bf16(b[2], b[3]); return w; }


__device__ __forceinline__ void store_partial(float* part, int nsplit, const f32x4 (&acc)[2][2][4][2], const Unit& u, int wr, int wc, int fr, int fq) {
    float* pt = part + (size_t)(u.tu * nsplit + u.sp) * 65536; int rl0 = wr * 64 + fr, cw = wc * 32 + 8 * fq; asm volatile("" : "+v"(rl0), "+v"(cw));
#pragma unroll
    for (int ai = 0; ai < 2; ++ai)
#pragma unroll
        for (int m = 0; m < 4; ++m)
#pragma unroll
            for (int bj = 0; bj < 2; ++bj) { float* o = pt + (ai * HALF + rl0 + m * 16) * 256 + bj * HALF + cw; *(f32x4*)o = acc[ai][bj][m][0]; *(f32x4*)(o + 4) = acc[ai][bj][m][1]; }
}

struct EpiIn {
    static constexpr bool PERM = true, AFTER_DRAIN = false;
    bf16_t *Q, *Kb, *Vb, *GB, *U; float* out; const float *gq, *gk; PG8_LAS float* red; float qscale;
    size_t off_kp, off_vp, off_cp, off_ks, off_vs, off_cs;
    __device__ __forceinline__ void operator()(const f32x4 (&acc)[2][2][4][2], const Unit& u, int wr, int wc, int fr, int fq) const {
        int rl0 = wr * 64 + fr, cw = wc * 32 + 8 * fq; asm volatile("" : "+v"(rl0), "+v"(cw));
        const int pn = u.pn, rowt = u.pm * BM;
        const bool prompt = rowt < NPROMPT;
        if (pn < 8) {
            const bool isq = pn < 4;
#pragma unroll
            for (int ai = 0; ai < 2; ++ai)
#pragma unroll
                for (int m = 0; m < 4; ++m)
#pragma unroll
                    for (int bj = 0; bj < 2; ++bj) {
                        const f32x4 a = acc[ai][bj][m][0], b = acc[ai][bj][m][1];
                        float s = (a[0] * a[0] + a[1] * a[1]) + (a[2] * a[2] + a[3] * a[3]) + (b[0] * b[0] + b[1] * b[1]) + (b[2] * b[2] + b[3] * b[3]);
                        s += __shfl_xor(s, 16); s += __shfl_xor(s, 32);
                        if (fq == 0) red[((ai * HALF + rl0 + m * 16) * 2 + bj) * 4 + wc] = s;
                    }
            PG8_LBAR();
            const float* g = isq ? gq : gk;
            const f32x4 g0 = *(const f32x4*)(g + cw), g1 = *(const f32x4*)(g + cw + 4);
#pragma unroll
            for (int ai = 0; ai < 2; ++ai)
#pragma unroll
                for (int m = 0; m < 4; ++m) {
                    const int rl = ai * HALF + rl0 + m * 16; const size_t row = (size_t)(rowt + rl);
#pragma unroll
                    for (int bj = 0; bj < 2; ++bj) {
                        const f32x4 p = *(const PG8_LAS f32x4*)(red + (rl * 2 + bj) * 4);
                        float rs = __builtin_amdgcn_rsqf(((p[0] + p[1]) + (p[2] + p[3])) * (1.0f / 128.0f) + 1e-6f);
                        if (isq) rs *= qscale;
                        const f32x4 v0 = acc[ai][bj][m][0] * rs * g0, v1 = acc[ai][bj][m][1] * rs * g1;
                        if (isq) { *(u32x4*)(Q + row * 1024 + pn * 256 + bj * HALF + cw) = pack8(v0, v1); }
                        else {
                            const int col = (pn - 4) * 256 + bj * HALF + cw;
                            float* o = prompt ? out + off_kp + row * 1024 + col : out + off_ks + (row - NPROMPT) * 1024 + col;
                            *(f32x4*)o = v0; *(f32x4*)(o + 4) = v1;
                            if (prompt) *(u32x4*)(Kb + row * 1024 + col) = pack8(v0, v1);
                        }
                    }
                }
        } else if (pn < 12) {
#pragma unroll
            for (int ai = 0; ai < 2; ++ai)
#pragma unroll
                for (int m = 0; m < 4; ++m) {
                    const size_t row = (size_t)(rowt + ai * HALF + rl0 + m * 16);
#pragma unroll
                    for (int bj = 0; bj < 2; ++bj) {
                        const int col = (pn - 8) * 256 + bj * HALF + cw; const f32x4 v0 = acc[ai][bj][m][0], v1 = acc[ai][bj][m][1];
                        float* o = prompt ? out + off_vp + row * 1024 + col : out + off_vs + (row - NPROMPT) * 1024 + col;
                        *(f32x4*)o = v0; *(f32x4*)(o + 4) = v1;
                        if (prompt) *(u32x4*)(Vb + row * 1024 + col) = pack8(v0, v1);
                    }
                }
        } else if (pn < 16) {
#pragma unroll
            for (int ai = 0; ai < 2; ++ai)
#pragma unroll
                for (int m = 0; m < 4; ++m) {
                    const size_t row = (size_t)(rowt + ai * HALF + rl0 + m * 16);
#pragma unroll
                    for (int bj = 0; bj < 2; ++bj) *(u32x4*)(GB + row * 1024 + (pn - 12) * 256 + bj * HALF + cw) = pack8(acc[ai][bj][m][0], acc[ai][bj][m][1]);
                }
        } else {
#pragma unroll
            for (int ai = 0; ai < 2; ++ai)
#pragma unroll
                for (int m = 0; m < 4; ++m) {
                    const int rowi = rowt + ai * HALF + rl0 + m * 16; const int ch = (pn - 16) * HALF + cw;
                    const f32x4 v0 = acc[ai][0][m][0] * acc[ai][1][m][0], v1 = acc[ai][0][m][1] * acc[ai][1][m][1];
                    *(u32x4*)(U + (size_t)rowi * 1024 + ch) = pack8(v0, v1);
                    if (prompt) { const int t = rowi & 4095; if (t >= 4094) { float* o = out + off_cp + ((rowi >> 12) * 2 + (t - 4094)) * 1024 + ch; *(f32x4*)o = v0; *(f32x4*)(o + 4) = v1; } }
                    else { const int rs_ = rowi - NPROMPT, t = rs_ & 63; if (t >= 62) { float* o = out + off_cs + ((rs_ >> 6) * 2 + (t - 62)) * 1024 + ch; *(f32x4*)o = v0; *(f32x4*)(o + 4) = v1; } }
                }
        }
    }
};

struct EpiOut {
    static constexpr bool PERM = true, AFTER_DRAIN = false;
    const float *xp, *xs; float* Y; bf16_t* X1; float* ssq; PG8_LAS float* red; float* part;
    __device__ __forceinline__ void operator()(const f32x4 (&acc)[2][2][4][2], const Unit& u, int wr, int wc, int fr, int fq) const {
        if (u.split) { store_partial(part, 8, acc, u, wr, wc, fr, fq); return; }
        int rl0 = wr * 64 + fr, cw = wc * 32 + 8 * fq; asm volatile("" : "+v"(rl0), "+v"(cw));
        const int pn = u.pn, rowt = u.pm * BM;
        const float* xin = rowt < NPROMPT ? xp + (size_t)rowt * 2048 : xs + (size_t)(rowt - NPROMPT) * 2048;
#pragma unroll
        for (int ai = 0; ai < 2; ++ai) {
            f32x4 xv[4][2][2];
#pragma unroll
            for (int m = 0; m < 4; ++m)
#pragma unroll
                for (int bj = 0; bj < 2; ++bj) { const float* xi = xin + (size_t)(ai * HALF + rl0 + m * 16) * 2048 + pn * 256 + bj * HALF + cw; xv[m][bj][0] = *(const f32x4*)xi; xv[m][bj][1] = *(const f32x4*)(xi + 4); }
#pragma unroll
            for (int m = 0; m < 4; ++m) {
                const int rl = ai * HALF + rl0 + m * 16; float s = 0.f;
#pragma unroll
                for (int bj = 0; bj < 2; ++bj) {
                    const int col = pn * 256 + bj * HALF + cw;
                    const f32x4 v0 = xv[m][bj][0] + acc[ai][bj][m][0], v1 = xv[m][bj][1] + acc[ai][bj][m][1];
                    *(u32x4*)(X1 + (size_t)(rowt + rl) * 2048 + col) = pack8(v0, v1);
                    s += (v0[0] * v0[0] + v0[1] * v0[1]) + (v0[2] * v0[2] + v0[3] * v0[3]) + (v1[0] * v1[0] + v1[1] * v1[1]) + (v1[2] * v1[2] + v1[3] * v1[3]);
                }
                s += __shfl_xor(s, 16); s += __shfl_xor(s, 32);
                if (fq == 0) red[rl * 4 + wc] = s;
            }
            asm volatile("" ::: "memory");
        }
        PG8_LBAR();
        if (threadIdx.x < 256) { const f32x4 p = *(const PG8_LAS f32x4*)(red + threadIdx.x * 4); ssq[(size_t)(rowt + threadIdx.x) * 8 + pn] = (p[0] + p[1]) + (p[2] + p[3]); }
        PG8_LBAR();
    }
};

struct EpiGU {
    static constexpr bool PERM = true, AFTER_DRAIN = false;
    bf16_t* H; const float* ssq;
    __device__ __forceinline__ void operator()(const f32x4 (&acc)[2][2][4][2], const Unit& u, int wr, int wc, int fr, int fq) const {
        int rl0 = wr * 64 + fr, cw = wc * 32 + 8 * fq; asm volatile("" : "+v"(rl0), "+v"(cw));
        const int pn = u.pn, rowt = u.pm * BM;
        f32x4 pa[2][4], pb[2][4];
#pragma unroll
        for (int ai = 0; ai < 2; ++ai)
#pragma unroll
            for (int m = 0; m < 4; ++m) { const float* p = ssq + (size_t)(rowt + ai * HALF + rl0 + m * 16) * 8; pa[ai][m] = *(const f32x4*)p; pb[ai][m] = *(const f32x4*)(p + 4); }
#pragma unroll
        for (int ai = 0; ai < 2; ++ai)
#pragma unroll
            for (int m = 0; m < 4; ++m) {
                const size_t row = (size_t)(rowt + ai * HALF + rl0 + m * 16);
                const f32x4 p0 = pa[ai][m], p1 = pb[ai][m];
                const float rs = __builtin_amdgcn_rsqf((((p0[0] + p0[1]) + (p0[2] + p0[3])) + ((p1[0] + p1[1]) + (p1[2] + p1[3]))) * (1.0f / 2048.0f) + 1e-6f);
                f32x4 h[2];
#pragma unroll
                for (int n = 0; n < 2; ++n) {
                    const f32x4 g = acc[ai][0][m][n] * rs, up = acc[ai][1][m][n] * rs;
#pragma unroll
                    for (int j = 0; j < 4; ++j) h[n][j] = g[j] * __builtin_amdgcn_rcpf(1.0f + __builtin_amdgcn_exp2f(-1.4426950408889634f * g[j])) * up[j];
                }
                *(u32x4*)(H + row * 5632 + pn * HALF + cw) = pack8(h[0], h[1]);
            }
    }
};

struct EpiDown {
    static constexpr bool PERM = true, AFTER_DRAIN = false;
    float* Y; float* part; const bf16_t* X1;
    __device__ __forceinline__ void operator()(const f32x4 (&acc)[2][2][4][2], const Unit& u, int wr, int wc, int fr, int fq) const {
        if (u.split) { store_partial(part, 8, acc, u, wr, wc, fr, fq); return; }
        int rl0 = wr * 64 + fr, cw = wc * 32 + 8 * fq; asm volatile("" : "+v"(rl0), "+v"(cw));
        const int pn = u.pn, rowt = u.pm * BM;
        u32x4 xb[2][4][2];
#pragma unroll
        for (int ai = 0; ai < 2; ++ai)
#pragma unroll
            for (int m = 0; m < 4; ++m)
#pragma unroll
                for (int bj = 0; bj < 2; ++bj) xb[ai][m][bj] = *(const u32x4*)(X1 + (size_t)(rowt + ai * HALF + rl0 + m * 16) * 2048 + pn * 256 + bj * HALF + cw);
#pragma unroll
        for (int ai = 0; ai < 2; ++ai)
#pragma unroll
            for (int m = 0; m < 4; ++m)
#pragma unroll
                for (int bj = 0; bj < 2; ++bj) {
                    const size_t off = (size_t)(rowt + ai * HALF + rl0 + m * 16) * 2048 + pn * 256 + bj * HALF + cw;
                    const u32x4 x = xb[ai][m][bj];
                    f32x4 b0, b1; b0[0] = __builtin_bit_cast(float, x.x << 16); b0[1] = __builtin_bit_cast(float, x.x & 0xffff0000u); b0[2] = __builtin_bit_cast(float, x.y << 16); b0[3] = __builtin_bit_cast(float, x.y & 0xffff0000u);
                    b1[0] = __builtin_bit_cast(float, x.z << 16); b1[1] = __builtin_bit_cast(float, x.z & 0xffff0000u); b1[2] = __builtin_bit_cast(float, x.w << 16); b1[3] = __builtin_bit_cast(float, x.w & 0xffff0000u);
                    float* o = Y + off; *(f32x4*)o = b0 + acc[ai][bj][m][0]; *(f32x4*)(o + 4) = b1 + acc[ai][bj][m][1];
                }
    }
};

struct EpiNone {
    static constexpr bool PERM = true, AFTER_DRAIN = false;
    float* sink;
    __device__ __forceinline__ void operator()(const f32x4 (&acc)[2][2][4][2], const Unit& u, int wr, int wc, int fr, int fq) const {
        if (acc[0][0][0][0][0] == 12345.678f && acc[1][1][3][1][3] == -9876.5f) sink[0] = 1.f;
    }
};
template <class Epi, class Sched, bool ALIGN_EPI = false, bool SP2 = false>
__device__ __forceinline__ void gemm_phase(PG8_LAS unsigned char* lds, const Gemm g, const Sched& S, const Epi& E) {
    int tid_ = threadIdx.x; asm volatile("" : "+v"(tid_));
    const int tid = tid_, wid = __builtin_amdgcn_readfirstlane(tid >> 6), lane = tid & 63, wr = wid >> 2, wc = wid & 3, fr = lane & 15, fq = lane >> 4;
    const int K = g.K;
    unsigned voffA[2], voffB[2];
#pragma unroll
    for (int i = 0; i < 2; ++i) { int R, C; stage_rc(tid * 16 + i * 8192, R, C); const int Rb = Epi::PERM ? ((R & ~31) + perm32(R & 31)) : R;
        voffA[i] = (unsigned)(R * K + C) * 2u; voffB[i] = (unsigned)(Rb * K + C) * 2u; }
    const size_t kstep = (size_t)(BK * 2);
    const size_t hstep = (size_t)HALF * K * 2;
    const size_t tstep = 2 * hstep;
    const unsigned ldsw = (unsigned)wid * 1024u;
    const int aoff = lds_byte(wr * 64 + fr, fq * 8), boff = lds_byte(wc * 32 + fr, fq * 8);
#define PG8_SA(b, h) (((b) * 2 + (h)) * HTB)
#define PG8_SB(b, h) ((4 + (b) * 2 + (h)) * HTB)
#define PG8_STAGE(bufoff, gbase, voff) do { _Pragma("unroll") for (int _i = 0; _i < 2; ++_i) \
        __builtin_amdgcn_global_load_lds((const unsigned*)((const char*)(gbase) + (voff)[_i]), (PG8_LAS unsigned*)(lds + (bufoff) + ldsw + _i * 8192), 16, 0, 0); } while (0)
#define PG8_LDA(dst, b, h) do { _Pragma("unroll") for (int m = 0; m < 4; ++m) _Pragma("unroll") for (int k = 0; k < 2; ++k) dst[m][k] = *(const PG8_LAS bf16x8*)(lds + PG8_SA(b, h) + aoff + m * 2048 + k * 1024); } while (0)
#define PG8_LDB(dst, b, h) do { _Pragma("unroll") for (int n = 0; n < 2; ++n) _Pragma("unroll") for (int k = 0; k < 2; ++k) dst[n][k] = *(const PG8_LAS bf16x8*)(lds + PG8_SB(b, h) + boff + n * 2048 + k * 1024); } while (0)
#define PG8_MMA(ai, bj, At, Bt) do { __builtin_amdgcn_s_setprio(1); _Pragma("unroll") for (int m = 0; m < 4; ++m) _Pragma("unroll") for (int n = 0; n < 2; ++n) _Pragma("unroll") for (int k = 0; k < 2; ++k) \
        acc[ai][bj][m][n] = __builtin_amdgcn_mfma_f32_16x16x32_bf16(Bt[n][k], At[m][k], acc[ai][bj][m][n], 0, 0, 0); __builtin_amdgcn_s_setprio(0); } while (0)
#define PG8_WAIT_V(n) asm volatile("s_waitcnt vmcnt(" #n ")" ::: "memory")
#define PG8_WAIT_L(n) asm volatile("s_waitcnt lgkmcnt(" #n ")" ::: "memory")
#define PG8_BAR __builtin_amdgcn_s_barrier()
#define PG8_SCHED __builtin_amdgcn_sched_barrier(0)
    Unit cur, nxt; int ui = 0;
    if (!S.next(0, cur)) return;
    f32x4 acc[2][2][4][2];
#pragma unroll
    for (int a = 0; a < 2; ++a)
#pragma unroll
        for (int b = 0; b < 2; ++b)
#pragma unroll
            for (int m = 0; m < 4; ++m)
#pragma unroll
                for (int n = 0; n < 2; ++n) acc[a][b][m][n] = (f32x4){0.f, 0.f, 0.f, 0.f};
    bf16x8 At[4][2], B0[2][2], B1[2][2];
    const char* cA = (const char*)g.A + (size_t)cur.pm * tstep + (size_t)cur.k0 * kstep; const char* cB = (const char*)g.Bt + (size_t)cur.pn * tstep + (size_t)cur.k0 * kstep;
    S.a_ready(cur);
    if constexpr (SP2) {
        PG8_STAGE(PG8_SB(0, 0), cB, voffB); PG8_STAGE(PG8_SB(0, 1), cB + hstep, voffB); PG8_STAGE(PG8_SA(0, 0), cA, voffA); PG8_STAGE(PG8_SA(0, 1), cA + hstep, voffA);
        if (wr == 1) PG8_BAR;
        PG8_WAIT_V(2); PG8_BAR;
        PG8_STAGE(PG8_SB(1, 0), cB + kstep, voffB); PG8_STAGE(PG8_SA(1, 0), cA + kstep, voffA); PG8_STAGE(PG8_SB(1, 1), cB + hstep + kstep, voffB);
        PG8_WAIT_V(6); PG8_BAR;
    } else {
        PG8_STAGE(PG8_SB(0, 0), cB, voffB); PG8_STAGE(PG8_SA(0, 0), cA, voffA); PG8_STAGE(PG8_SB(0, 1), cB + hstep, voffB); PG8_STAGE(PG8_SA(0, 1), cA + hstep, voffA);
        if (wr == 1) PG8_BAR;
        PG8_WAIT_V(4); PG8_BAR;
        PG8_STAGE(PG8_SB(1, 0), cB + kstep, voffB); PG8_STAGE(PG8_SA(1, 0), cA + kstep, voffA); PG8_STAGE(PG8_SB(1, 1), cB + hstep + kstep, voffB);
        PG8_WAIT_V(6); PG8_BAR;
    }
    for (;;) {
        const bool has_next = S.next(ui + 1, nxt);
        const char* nA = has_next ? (const char*)g.A + (size_t)nxt.pm * tstep + (size_t)nxt.k0 * kstep : cA; const char* nB = has_next ? (const char*)g.Bt + (size_t)nxt.pn * tstep + (size_t)nxt.k0 * kstep : cB;
        const int nt = cur.nt;
        for (int t = 0; t < nt; t += 2) {
            const bool last = (t == nt - 2);
            const char* a1 = cA + (size_t)(t + 1) * kstep;
            const char* a2 = last ? nA : cA + (size_t)(t + 2) * kstep; const char* b2 = last ? nB : cB + (size_t)(t + 2) * kstep;
            const char* a3 = a2 + kstep; const char* b3 = b2 + kstep;
            if (last && has_next) S.a_ready(nxt);
            if constexpr (SP2) {
            PG8_LDB(B0, 0, 0); PG8_LDB(B1, 0, 1); PG8_SCHED; PG8_LDA(At, 0, 0); PG8_STAGE(PG8_SA(1, 1), a1 + hstep, voffA);
            PG8_WAIT_V(8); PG8_WAIT_L(0); PG8_BAR; PG8_MMA(0, 0, At, B0); PG8_MMA(0, 1, At, B1); PG8_BAR; PG8_SCHED;
            PG8_LDA(At, 0, 1); PG8_STAGE(PG8_SB(0, 0), b2, voffB); PG8_STAGE(PG8_SB(0, 1), b2 + hstep, voffB); PG8_STAGE(PG8_SA(0, 0), a2, voffA);
            PG8_WAIT_V(8); PG8_WAIT_L(0); PG8_BAR; PG8_MMA(1, 0, At, B0); PG8_MMA(1, 1, At, B1); PG8_BAR; PG8_SCHED;
            PG8_LDB(B0, 1, 0); PG8_LDB(B1, 1, 1); PG8_SCHED; PG8_LDA(At, 1, 0); PG8_STAGE(PG8_SA(0, 1), a2 + hstep, voffA);
            PG8_WAIT_V(8); PG8_WAIT_L(0); PG8_BAR; PG8_MMA(0, 0, At, B0); PG8_MMA(0, 1, At, B1); PG8_BAR; PG8_SCHED;
            PG8_LDA(At, 1, 1); PG8_STAGE(PG8_SB(1, 0), b3, voffB); PG8_STAGE(PG8_SB(1, 1), b3 + hstep, voffB); PG8_STAGE(PG8_SA(1, 0), a3, voffA);
            PG8_WAIT_V(8); PG8_WAIT_L(0); PG8_BAR; PG8_MMA(1, 0, At, B0); PG8_MMA(1, 1, At, B1); PG8_BAR; PG8_SCHED;
            } else {
            PG8_LDB(B0, 0, 0); PG8_SCHED; PG8_LDA(At, 0, 0); PG8_STAGE(PG8_SA(1, 1), a1 + hstep, voffA);
            PG8_WAIT_L(8); PG8_BAR; PG8_WAIT_L(0); PG8_MMA(0, 0, At, B0); PG8_BAR; PG8_SCHED;
            PG8_LDB(B1, 0, 1); PG8_STAGE(PG8_SB(0, 0), b2, voffB);
            PG8_BAR; PG8_WAIT_L(0); PG8_MMA(0, 1, At, B1); PG8_BAR;
            PG8_LDA(At, 0, 1); PG8_STAGE(PG8_SA(0, 0), a2, voffA);
            PG8_BAR; PG8_WAIT_L(0); PG8_MMA(1, 0, At, B0); PG8_BAR; PG8_SCHED;
            PG8_STAGE(PG8_SB(0, 1), b2 + hstep, voffB);
            PG8_WAIT_V(6); PG8_BAR; PG8_MMA(1, 1, At, B1); PG8_BAR;
            PG8_LDB(B0, 1, 0); PG8_SCHED; PG8_LDA(At, 1, 0); PG8_STAGE(PG8_SA(0, 1), a2 + hstep, voffA);
            PG8_WAIT_L(8); PG8_BAR; PG8_WAIT_L(0); PG8_MMA(0, 0, At, B0); PG8_BAR; PG8_SCHED;
            PG8_LDB(B1, 1, 1); PG8_STAGE(PG8_SB(1, 0), b3, voffB);
            PG8_BAR; PG8_WAIT_L(0); PG8_MMA(0, 1, At, B1); PG8_BAR;
            PG8_LDA(At, 1, 1); PG8_STAGE(PG8_SA(1, 0), a3, voffA);
            PG8_BAR; PG8_WAIT_L(0); PG8_MMA(1, 0, At, B0); PG8_BAR; PG8_SCHED;
            PG8_STAGE(PG8_SB(1, 1), b3 + hstep, voffB);
            PG8_WAIT_V(6); PG8_BAR; PG8_MMA(1, 1, At, B1); PG8_BAR;
            }
        }
        if constexpr (ALIGN_EPI) { if (wr == 0) PG8_BAR; }
        if constexpr (!Epi::AFTER_DRAIN) { E(acc, cur, wr, wc, fr, fq); S.done(cur); }
        if (!has_next) break;
#pragma unroll
        for (int a = 0; a < 2; ++a)
#pragma unroll
            for (int b = 0; b < 2; ++b)
#pragma unroll
                for (int m = 0; m < 4; ++m)
#pragma unroll
                    for (int n = 0; n < 2; ++n) acc[a][b][m][n] = (f32x4){0.f, 0.f, 0.f, 0.f};
        cur = nxt; cA = nA; cB = nB; ++ui;
        if constexpr (ALIGN_EPI) { if (wr == 1) PG8_BAR; }
    }
    PG8_WAIT_V(0);
    if constexpr (!ALIGN_EPI) { if (wr == 0) PG8_BAR; }
    PG8_BAR;
    if constexpr (Epi::AFTER_DRAIN) { E.fused(acc, cur, wr, wc, fr, fq, lds, wid, lane); S.done(cur); }
#undef PG8_SA
#undef PG8_SB
#undef PG8_STAGE
#undef PG8_LDA
#undef PG8_LDB
#undef PG8_MMA
#undef PG8_WAIT_V
#undef PG8_WAIT_L
#undef PG8_BAR
#undef PG8_SCHED
}
}
#define LAS __attribute__((address_space(3)))
typedef unsigned short bf16;
typedef float f32x4 __attribute__((ext_vector_type(4)));
typedef float f32x16 __attribute__((ext_vector_type(16)));
typedef short bf16x8 __attribute__((ext_vector_type(8)));
typedef short s16x4 __attribute__((ext_vector_type(4)));
typedef unsigned u32x4 __attribute__((ext_vector_type(4)));
typedef unsigned u32x2 __attribute__((ext_vector_type(2)));
constexpr int DM = 2048, SEQ = 4096, NP = 8192, NS = 512, MT = NP + NS, AW = 1024, CC = 1024, INC = 6144, DFF = 5632, PAST = 4096, DSEQ = 64;
constexpr float EPS = 1e-6f;
constexpr size_t OFF_Y = 0, OFF_KP = (size_t)MT * DM, OFF_VP = OFF_KP + (size_t)NP * AW, OFF_CP = OFF_VP + (size_t)NP * AW, OFF_KS = OFF_CP + 2 * 2 * CC,
                 OFF_VS = OFF_KS + (size_t)NS * AW, OFF_CS = OFF_VS + (size_t)NS * AW, OUT_TOTAL = OFF_CS + 8 * 2 * CC;
static_assert(OUT_TOTAL == 35672064, "output size");
constexpr size_t MiB = 1u << 20;
constexpr size_t WS_CTL = 0, WS_WIN = 1 * MiB, WS_WOUT = 25 * MiB, WS_WGU = 33 * MiB, WS_WDN = 77 * MiB, WS_HN = 99 * MiB, WS_Q = 133 * MiB, WS_K = 150 * MiB, WS_V = 166 * MiB,
                 WS_GB = 182 * MiB, WS_U = 199 * MiB, WS_MIX = 216 * MiB, WS_SSQ = 250 * MiB, WS_TP = 251 * MiB, WS_OP = 256 * MiB, WS_H = 256 * MiB, WS_PART = 133 * MiB  ;
constexpr int NSLOT = 256 + 16;
constexpr size_t WS_END = WS_OP + (size_t)NSLOT * 131072;
constexpr int RING_BYTES = 131072, RED_OFF = RING_BYTES, MISC_OFF = RED_OFF + 8192, LDS_BYTES = 147456;
constexpr int NWAVES = 8;

#define XB_TMO      128
#define XB_XCNT(j)  (256  + 64 * (j))
#define XB_XSUB(j)  (1280 + 64 * (j))
#define XB_XGEN(j)  (2304 + 64 * (j))
#define XB_TOP      3328
#define XB_TOPGEN   3392
#define XCD_BAR_WORDS 3456
#define XB_SPIN_CAP (1u << 18)

__device__ __forceinline__ unsigned xb_ld(unsigned* p)              { return __hip_atomic_load(p, __ATOMIC_RELAXED, __HIP_MEMORY_SCOPE_AGENT); }
__device__ __forceinline__ unsigned xb_add(unsigned* p, unsigned v) { return __hip_atomic_fetch_add(p, v, __ATOMIC_RELAXED, __HIP_MEMORY_SCOPE_AGENT); }
__device__ __forceinline__ unsigned xb_xcc_id() { return (unsigned)__builtin_amdgcn_s_getreg((3 << 11) | 20) & 0xFu; }
#define XB_SPIN(cond, bar) do { unsigned _sp = 0; while (cond) { __builtin_amdgcn_s_sleep(1); \
    if ((++_sp & 255u) == 0u) { if (xb_ld(&(bar)[XB_TMO])) break; if (_sp > XB_SPIN_CAP) { atomicAdd(&(bar)[XB_TMO], 1u); break; } } } } while (0)

struct XcdBarrier {
    unsigned* bar; unsigned x;
    volatile LAS unsigned* st;
};

__device__ __forceinline__ XcdBarrier xcd_barrier_post(unsigned* bar, volatile LAS unsigned* st) {
    XcdBarrier b; b.bar = bar; b.x = xb_xcc_id(); b.st = st;
    if (threadIdx.x == 0) (void)xb_add(&bar[XB_XCNT(b.x)], 1u);
    return b;
}
__device__ __forceinline__ void xcd_barrier_complete(unsigned* bar, unsigned x, unsigned& nloc, unsigned& nx) {
    const unsigned G = gridDim.x * gridDim.y * gridDim.z;
    unsigned sum, cnt, mine, sp = 0u;
    for (;;) {
        sum = 0u; cnt = 0u; mine = 0u;
#pragma unroll
        for (unsigned j = 0; j < 16; ++j) { const unsigned c = xb_ld(&bar[XB_XCNT(j)]); sum += c; cnt += (c > 0u) ? 1u : 0u; mine = (j == x) ? c : mine; }
        if (sum == G) break;
        __builtin_amdgcn_s_sleep(1);
        if ((++sp & 255u) == 0u) { if (xb_ld(&bar[XB_TMO])) break; if (sp > XB_SPIN_CAP) { atomicAdd(&bar[XB_TMO], 1u); break; } }
    }
    nloc = mine > 0u ? mine : 1u; nx = cnt > 0u ? cnt : 1u;
}

__device__ __forceinline__ void xcd_barrier(const XcdBarrier& b) {
    asm volatile("s_waitcnt vmcnt(0)" ::: "memory");
    __syncthreads();
    if (threadIdx.x == 0) {
        unsigned* bar = b.bar;
        __builtin_amdgcn_s_waitcnt(0);
        unsigned nloc = b.st[0], nx = b.st[1];
        if (nloc == 0u) { xcd_barrier_complete(bar, b.x, nloc, nx); b.st[0] = nloc; b.st[1] = nx; }
        const unsigned old = xb_add(&bar[XB_XSUB(b.x)], 1u);
        const unsigned gen = old / nloc;
        if (old + 1u == (gen + 1u) * nloc) {
            __builtin_amdgcn_fence(__ATOMIC_RELEASE, "agent");
            asm volatile("s_waitcnt vmcnt(0)" ::: "memory");
            const unsigned og = xb_add(&bar[XB_TOP], 1u);
            const unsigned tg = og / nx;
            if (og + 1u == (tg + 1u) * nx) xb_add(&bar[XB_TOPGEN], 1u);
            else XB_SPIN(xb_ld(&bar[XB_TOPGEN]) == tg, bar);
            __builtin_amdgcn_fence(__ATOMIC_ACQUIRE, "agent");
            xb_add(&bar[XB_XGEN(b.x)], 1u);
            asm volatile("s_waitcnt vmcnt(0)" ::: "memory");
        } else {
            XB_SPIN(xb_ld(&bar[XB_XGEN(b.x)]) == gen, bar);
            __builtin_amdgcn_fence(__ATOMIC_ACQUIRE, "agent");
            asm volatile("s_waitcnt vmcnt(0)" ::: "memory");
        }
    }
    __syncthreads();
}

struct ItemTab { int n; int v[272]; };
constexpr int p_nsteps(int qb, int c) { return 8 * (qb + 1); }
constexpr ItemTab make_items() {
    ItemTab t{}; t.n = 0;
    for (int b = 0; b < 8; ++b) for (int hg = 0; hg < 2; ++hg) t.v[t.n++] = 1 | (b << 1) | (hg << 4);
    for (int qb = 15; qb >= 0; --qb) for (int bh = 0; bh < 16; ++bh) t.v[t.n++] = (bh << 1) | (qb << 5);
    return t;
}
__device__ const ItemTab g_items = make_items();

__device__ __forceinline__ unsigned f2bf(float f) { unsigned u = __builtin_bit_cast(unsigned, f); return (u + 0x7fffu + ((u >> 16) & 1u)) >> 16; }
__device__ __forceinline__ unsigned pk2(float lo, float hi) { return pg8::cvt_pk_bf16(lo, hi); }
__device__ __forceinline__ float bflo(unsigned w) { return __builtin_bit_cast(float, w << 16); }
__device__ __forceinline__ float bfhi(unsigned w) { return __builtin_bit_cast(float, w & 0xffff0000u); }
__device__ __forceinline__ int crow(int r, int hi) { return (r & 3) + 8 * (r >> 2) + 4 * hi; }
__device__ __forceinline__ float wave_sum(float v) {
#pragma unroll
    for (int o = 1; o < 64; o <<= 1) v += __shfl_xor(v, o);
    return v;
}

struct Args { const float* in[17]; float* out; unsigned char* ws; };

struct P0Item { const float* src; const float* gk; bf16* dst; int N, K, k0; };
__device__ __forceinline__ P0Item p0_decode(const Args& a, int it) {
    constexpr int I_IN = 32 * 192, I_OUT = 32 * 64, I_G = 32 * 176;
    unsigned char* ws = a.ws; P0Item r; int n0, kb, drow; r.gk = nullptr;
    if (it < I_IN) { kb = it / 192; n0 = 32 * (it % 192); drow = n0;
        if (n0 >= 5120) { const int ch = n0 - 5120; drow = 4096 + (ch >> 7) * 256 + 128 + (ch & 127); } else if (n0 >= 4096) { const int ch = n0 - 4096; drow = 4096 + (ch >> 7) * 256 + (ch & 127); }
        r.src = a.in[6]; r.N = INC; r.K = DM; r.dst = (bf16*)(ws + WS_WIN); }
    else if ((it -= I_IN) < I_OUT) { kb = it / 64; n0 = 32 * (it % 64); drow = n0; r.src = a.in[12]; r.N = DM; r.K = DM; r.dst = (bf16*)(ws + WS_WOUT); }
    else if ((it -= I_OUT) < 2 * I_G) { const int up = it >= I_G; if (up) it -= I_G; kb = it / 176; n0 = 32 * (it % 176); drow = (n0 >> 7) * 256 + up * 128 + (n0 & 127);
        r.src = a.in[up ? 15 : 14]; r.N = DFF; r.K = DM; r.dst = (bf16*)(ws + WS_WGU); r.gk = a.in[13]; }
    else { it -= 2 * I_G; kb = it / 64; n0 = 32 * (it % 64); drow = n0; r.src = a.in[16]; r.N = DM; r.K = DFF; r.dst = (bf16*)(ws + WS_WDN); }
    r.k0 = 64 * kb; r.src += (size_t)r.k0 * r.N + n0; r.dst += (size_t)drow * r.K + r.k0;
    return r;
}
__device__ __forceinline__ void p0_load(const P0Item& p, f32x4 (&v)[8], int lane) {
#pragma unroll
    for (int j = 0; j < 8; ++j) v[j] = __builtin_nontemporal_load((const f32x4*)(p.src + (size_t)(8 * j + (lane >> 3)) * p.N + 4 * (lane & 7)));
}
__device__ __forceinline__ void p0_finish(const P0Item& p, const f32x4 (&v)[8], LAS float* scr, int lane) {
#pragma unroll
    for (int j = 0; j < 8; ++j) { const int kk = 8 * j + (lane >> 3); const float g = p.gk ? p.gk[p.k0 + kk] : 1.0f; LAS float* s = scr + kk * 33 + 4 * (lane & 7);
        s[0] = v[j][0] * g; s[1] = v[j][1] * g; s[2] = v[j][2] * g; s[3] = v[j][3] * g; }
    asm volatile("s_waitcnt lgkmcnt(0)" ::: "memory");
    const int c = lane & 7;
#pragma unroll
    for (int j = 0; j < 4; ++j) { const int n = (lane >> 3) + 8 * j; const LAS float* s = scr + (8 * c) * 33 + n;
        u32x4 o; o.x = pk2(s[0 * 33], s[1 * 33]); o.y = pk2(s[2 * 33], s[3 * 33]); o.z = pk2(s[4 * 33], s[5 * 33]); o.w = pk2(s[6 * 33], s[7 * 33]);
        *(u32x4*)(p.dst + (size_t)n * p.K + 8 * c) = o; }
    asm volatile("s_waitcnt lgkmcnt(0)" ::: "memory");
}
constexpr int P0_EARLY_ITEMS = 32 * 192 + 32 * 64, P0_ALL_ITEMS = 32 * 192 + 32 * 64 + 2 * 32 * 176 + 88 * 64, P0_CHUNK = 32, P0_LATE_CHUNKS = (P0_ALL_ITEMS - P0_EARLY_ITEMS) / P0_CHUNK;
static_assert((P0_ALL_ITEMS - P0_EARLY_ITEMS) % P0_CHUNK == 0, "late conversion items come in whole chunks");
__device__ __forceinline__ void p0_run_range(const Args& a, LAS float* scr, int first, int n, int lane) {
    f32x4 va[8], vb[8]; P0Item pa, pb;
    pa = p0_decode(a, first); p0_load(pa, va, lane);
    for (int i = 0; i < n; i += 2) {
        if (i + 1 < n) { pb = p0_decode(a, first + i + 1); p0_load(pb, vb, lane); }
        p0_finish(pa, va, scr, lane);
        if (i + 1 >= n) break;
        if (i + 2 < n) { pa = p0_decode(a, first + i + 2); p0_load(pa, va, lane); }
        p0_finish(pb, vb, scr, lane);
    }
}
__device__ __forceinline__ void p0_prologue(const Args& a, LAS unsigned char* lds, int gw, int NGW, int lane, int wave) {
    LAS float* scr = (LAS float*)(lds + wave * 16384);
    unsigned char* ws = a.ws;
    constexpr int NITEMS = P0_EARLY_ITEMS;
    {
        int it = gw; f32x4 va[8], vb[8]; P0Item pa, pb;
        if (it < NITEMS) { pa = p0_decode(a, it); p0_load(pa, va, lane); }
        while (it < NITEMS) {
            const int itb = it + NGW;
            if (itb < NITEMS) { pb = p0_decode(a, itb); p0_load(pb, vb, lane); }
            p0_finish(pa, va, scr, lane);
            it = itb + NGW;
            if (itb >= NITEMS) break;
            if (it < NITEMS) { pa = p0_decode(a, it); p0_load(pa, va, lane); }
            p0_finish(pb, vb, scr, lane);
        }
    }
    const float* g1 = a.in[5];
    f32x4 gv[8];
#pragma unroll
    for (int j = 0; j < 8; ++j) gv[j] = *((const f32x4*)g1 + 64 * j + lane);
    for (int m = gw; m < MT; m += 2 * NGW) {
        const int m2 = m + NGW; const bool has2 = m2 < MT;
        const float* xa = m < NP ? a.in[0] + (size_t)m * DM : a.in[1] + (size_t)(m - NP) * DM;
        const float* xb = has2 ? (m2 < NP ? a.in[0] + (size_t)m2 * DM : a.in[1] + (size_t)(m2 - NP) * DM) : xa;
        f32x4 va[8], vb[8];
#pragma unroll
        for (int j = 0; j < 8; ++j) va[j] = __builtin_nontemporal_load((const f32x4*)xa + 64 * j + lane);
        if (has2) {
#pragma unroll
            for (int j = 0; j < 8; ++j) vb[j] = __builtin_nontemporal_load((const f32x4*)xb + 64 * j + lane);
        }
        {
            float s = 0.f;
#pragma unroll
            for (int j = 0; j < 8; ++j) s += (va[j][0] * va[j][0] + va[j][1] * va[j][1]) + (va[j][2] * va[j][2] + va[j][3] * va[j][3]);
            const float rs = __builtin_amdgcn_rsqf(wave_sum(s) * (1.0f / DM) + EPS);
            u32x2* o = (u32x2*)((bf16*)(ws + WS_HN) + (size_t)m * DM) + lane;
#pragma unroll
            for (int j = 0; j < 8; ++j) { u32x2 w; w.x = pk2(va[j][0] * rs * gv[j][0], va[j][1] * rs * gv[j][1]); w.y = pk2(va[j][2] * rs * gv[j][2], va[j][3] * rs * gv[j][3]); o[64 * j] = w; }
        }
        if (has2) {
            float s = 0.f;
#pragma unroll
            for (int j = 0; j < 8; ++j) s += (vb[j][0] * vb[j][0] + vb[j][1] * vb[j][1]) + (vb[j][2] * vb[j][2] + vb[j][3] * vb[j][3]);
            const float rs = __builtin_amdgcn_rsqf(wave_sum(s) * (1.0f / DM) + EPS);
            u32x2* o = (u32x2*)((bf16*)(ws + WS_HN) + (size_t)m2 * DM) + lane;
#pragma unroll
            for (int j = 0; j < 8; ++j) { u32x2 w; w.x = pk2(vb[j][0] * rs * gv[j][0], vb[j][1] * rs * gv[j][1]); w.y = pk2(vb[j][2] * rs * gv[j][2], vb[j][3] * rs * gv[j][3]); o[64 * j] = w; }
        }
    }
}


template <int VS, bool QREG>
__device__ __forceinline__ void sb_block(f32x16 (&o)[4], float& R, const LAS unsigned char* kp, const LAS unsigned char* vp, const bf16x8 (&qreg)[8], const LAS unsigned char* qlp, int kb, int qw, int qpos, int hi) {
            f32x16 p;
#pragma unroll
            for (int r = 0; r < 16; ++r) p[r] = 0.f;
#pragma unroll
            for (int d0 = 0; d0 < 8; ++d0) { const bf16x8 kf = *(const LAS bf16x8*)(kp + d0 * 32); const bf16x8 qf = QREG ? qreg[d0] : *(const LAS bf16x8*)(qlp + d0 * 32); p = __builtin_amdgcn_mfma_f32_32x32x16_bf16(kf, qf, p, 0, 0, 0); }
            const bool need_mask = (kb + 31 >= qw);
            float e[16], sf[16];
#pragma unroll
            for (int r = 0; r < 16; ++r) {
                const float z = fminf(p[r], 100.f); float ee = __builtin_amdgcn_exp2f(z); float rr = __builtin_amdgcn_rcpf(1.0f + ee);
                if (need_mask) { const bool msk = (kb + crow(r, hi)) >= qpos; ee = msk ? 0.f : ee; rr = msk ? 1.f : rr; }
                e[r] = ee; sf[r] = rr;
            }
            float oth[4], PP[4];
#pragma unroll
            for (int g = 0; g < 4; ++g) { sf[4 * g + 2] *= sf[4 * g + 3]; sf[4 * g + 1] *= sf[4 * g + 2]; sf[4 * g] *= sf[4 * g + 1]; oth[g] = __shfl_xor(sf[4 * g], 32); PP[g] = sf[4 * g] * oth[g]; }
            const float SP3 = PP[3], SP2 = PP[2] * SP3, SP1 = PP[1] * SP2, SP0 = PP[0] * SP1;
            float A[4]; A[0] = R * SP1; A[1] = R * SP2; A[2] = R * SP3; A[3] = R;
#pragma unroll
            for (int g = 0; g < 4; ++g) A[g] = hi ? A[g] : A[g] * oth[g];
            R *= SP0;
            float w[16];
#pragma unroll
            for (int r = 0; r < 16; ++r) w[r] = (e[r] * sf[r]) * A[r >> 2];
#pragma unroll
            for (int s2 = 0; s2 < 2; ++s2) {
                u32x4 pw; pw.x = pk2(w[8 * s2 + 0], w[8 * s2 + 1]); pw.y = pk2(w[8 * s2 + 2], w[8 * s2 + 3]); pw.z = pk2(w[8 * s2 + 4], w[8 * s2 + 5]); pw.w = pk2(w[8 * s2 + 6], w[8 * s2 + 7]);
                const bf16x8 pa = __builtin_bit_cast(bf16x8, pw);
#pragma unroll
                for (int db = 0; db < 4; ++db) {
                    const s16x4 lo = __builtin_bit_cast(s16x4, __builtin_amdgcn_ds_read_tr16_b64_v4i16((LAS s16x4*)(vp + (16 * s2) * VS + db * 64)));
                    const s16x4 hh = __builtin_bit_cast(s16x4, __builtin_amdgcn_ds_read_tr16_b64_v4i16((LAS s16x4*)(vp + (16 * s2 + 8) * VS + db * 64)));
                    const bf16x8 vb = __builtin_shufflevector(lo, hh, 0, 1, 2, 3, 4, 5, 6, 7);
                    o[db] = __builtin_amdgcn_mfma_f32_32x32x16_bf16(pa, vb, o[db], 0, 0, 0);
                }
            }
}

template <bool SAMPLE>
__device__ __forceinline__ void attn_item(const Args& a, LAS unsigned char* lds, int code) {
    constexpr int NH = SAMPLE ? 4 : 1, KS = NH * 256 + 16, VS = NH * 256 + 32, K_OFF = 0, V_OFF = 32 * KS;
    int tid_ = threadIdx.x; asm volatile("" : "+v"(tid_));
    const int tid = tid_, lane = tid & 63, r32 = lane & 31, hi = lane >> 5; const int wid = __builtin_amdgcn_readfirstlane(tid >> 6);
    unsigned char* ws = a.ws;
    int slot, nsteps, kvpos0, qw, head, hl; size_t qrow;
    const bf16 *kgb = nullptr, *vgb = nullptr; const float *kgf = nullptr, *vgf = nullptr, *kgn = nullptr, *vgn = nullptr;
    if (SAMPLE) {
        const int b = (code >> 1) & 7, hg = (code >> 4) & 1;
        slot = 256 + b * 2 + hg; hl = wid >> 1; head = hg * 4 + hl; const int rg = wid & 1;
        qw = PAST + 32 * rg; qrow = (size_t)NP + b * DSEQ + 32 * rg + r32;
        nsteps = 130; kvpos0 = 0;
        kgf = a.in[2] + ((size_t)b * PAST + (tid >> 7)) * AW + hg * 512 + 4 * (tid & 127); vgf = a.in[3] + ((size_t)b * PAST + (tid >> 7)) * AW + hg * 512 + 4 * (tid & 127);
        kgn = a.out + OFF_KS + ((size_t)b * DSEQ + (tid >> 7)) * AW + hg * 512 + 4 * (tid & 127); vgn = a.out + OFF_VS + ((size_t)b * DSEQ + (tid >> 7)) * AW + hg * 512 + 4 * (tid & 127);
    } else {
        const int bh = (code >> 1) & 15, qb = (code >> 5) & 15, c = (code >> 9) & 3, b = bh >> 3;
        head = bh & 7; hl = 0; slot = bh * 16 + qb + 0 * c; nsteps = p_nsteps(qb, c); kvpos0 = 0;
        qw = qb * 256 + 32 * wid; qrow = (size_t)b * SEQ + qw + r32;
        kgb = (const bf16*)(ws + WS_K) + ((size_t)b * SEQ + kvpos0 + (tid >> 4)) * AW + head * 128 + (tid & 15) * 8;
        vgb = (const bf16*)(ws + WS_V) + ((size_t)b * SEQ + kvpos0 + (tid >> 4)) * AW + head * 128 + (tid & 15) * 8;
    }
    const int qpos = qw + r32;
    constexpr int Q_OFF = 67584, QS = 272;
    const LAS unsigned char* qlp = lds + Q_OFF + wid * (32 * QS) + r32 * QS + hi * 16;
    { const bf16* qp = (const bf16*)(ws + WS_Q) + qrow * AW + head * 128 + hi * 8;
#pragma unroll
      for (int d0 = 0; d0 < 8; ++d0) *(LAS bf16x8*)(lds + Q_OFF + wid * (32 * QS) + r32 * QS + hi * 16 + d0 * 32) = *(const bf16x8*)(qp + 16 * d0); }
    f32x16 o[4];
#pragma unroll
    for (int i = 0; i < 4; ++i)
#pragma unroll
        for (int r = 0; r < 16; ++r) o[i][r] = 0.f;
    float R = 1.f;
    u32x4 kreg, vreg; f32x4 kf4[8], vf4[8];
#define ATT_LOADK(s_) do { if (SAMPLE) { _Pragma("unroll") for (int i_ = 0; i_ < 8; ++i_) kf4[i_] = *(const f32x4*)(((s_) >= 128 ? kgn + (size_t)((s_) - 128) * 32 * AW : kgf + (size_t)(s_) * 32 * AW) + (size_t)i_ * 4 * AW); } \
        else { kreg = *(const u32x4*)(kgb + (size_t)(s_) * 32 * AW); } } while (0)
#define ATT_LOADV(s_) do { if (SAMPLE) { _Pragma("unroll") for (int i_ = 0; i_ < 8; ++i_) vf4[i_] = *(const f32x4*)(((s_) >= 128 ? vgn + (size_t)((s_) - 128) * 32 * AW : vgf + (size_t)(s_) * 32 * AW) + (size_t)i_ * 4 * AW); } \
        else { vreg = *(const u32x4*)(vgb + (size_t)(s_) * 32 * AW); } } while (0)
#define ATT_STOREK() do { if (SAMPLE) { _Pragma("unroll") for (int i_ = 0; i_ < 8; ++i_) { const int key_ = (tid >> 7) + 4 * i_, f4_ = tid & 127; \
            u32x2 kw_; kw_.x = pk2(kf4[i_][0], kf4[i_][1]); kw_.y = pk2(kf4[i_][2], kf4[i_][3]); *(LAS u32x2*)(lds + K_OFF + key_ * KS + f4_ * 8) = kw_; } } \
        else { *(LAS u32x4*)(lds + K_OFF + (tid >> 4) * KS + (tid & 15) * 16) = kreg; } } while (0)
#define ATT_STOREV() do { if (SAMPLE) { _Pragma("unroll") for (int i_ = 0; i_ < 8; ++i_) { const int key_ = (tid >> 7) + 4 * i_, f4_ = tid & 127; \
            u32x2 vw_; vw_.x = pk2(vf4[i_][0], vf4[i_][1]); vw_.y = pk2(vf4[i_][2], vf4[i_][3]); *(LAS u32x2*)(lds + V_OFF + key_ * VS + f4_ * 8) = vw_; } } \
        else { *(LAS u32x4*)(lds + V_OFF + (tid >> 4) * VS + (tid & 15) * 16) = vreg; } } while (0)
    volatile LAS int* flg = (volatile LAS int*)(lds + MISC_OFF + 64);
    ATT_LOADK(nsteps - 1); ATT_LOADV(nsteps - 1);
    ATT_STOREK(); ATT_STOREV();
    __syncthreads();
    const LAS unsigned char* kp = lds + K_OFF + r32 * KS + hl * 256 + hi * 16;
    const LAS unsigned char* vp = lds + V_OFF + (4 * hi + ((lane & 15) >> 2)) * VS + hl * 256 + (16 * ((lane >> 4) & 1) + 4 * (lane & 3)) * 2;
    for (int s = nsteps - 1; s >= 0; --s) {
        if (s > 0) { ATT_LOADK(s - 1); if (!SAMPLE) ATT_LOADV(s - 1); }
        const int kb = kvpos0 + 32 * s;
        if (kb < qw + 32 && !__all(R == 0.f)) { const bf16x8 qdummy[8] = {}; sb_block<VS, false>(o, R, kp, vp, qdummy, qlp, kb, qw, qpos, hi); }
        if (lane == 0) flg[wid] = __all(R == 0.f) ? 1 : 0;
        __syncthreads();
        const bool alldone = (flg[0] & flg[1] & flg[2] & flg[3] & flg[4] & flg[5] & flg[6] & flg[7]) != 0;
        if (alldone) { __syncthreads(); break; }
        if (s > 0) { ATT_STOREK(); if (SAMPLE) ATT_LOADV(s - 1); ATT_STOREV(); }
        __syncthreads();
    }
#undef ATT_LOADK
#undef ATT_LOADV
#undef ATT_STOREK
#undef ATT_STOREV
    float* op = (float*)(ws + WS_OP) + ((size_t)(slot * 8 + wid) * 32) * 128;
#pragma unroll
    for (int db = 0; db < 4; ++db)
#pragma unroll
        for (int r = 0; r < 16; ++r) op[crow(r, hi) * 128 + db * 32 + r32] = o[db][r];
    if (hi == 0) ((float*)(ws + WS_TP))[(slot * 8 + wid) * 32 + r32] = R;
}


__device__ __forceinline__ void attn_item_p(const Args& a, LAS unsigned char* lds, int code) {
    constexpr int KS = 272, VS = 288, TILE_K = 64 * KS, BUF = TILE_K + 64 * VS;
    int tid_ = threadIdx.x; asm volatile("" : "+v"(tid_));
    const int tid = tid_, lane = tid & 63, r32 = lane & 31, hi = lane >> 5; const int wid = __builtin_amdgcn_readfirstlane(tid >> 6);
    unsigned char* ws = a.ws;
    const int bh = (code >> 1) & 15, qb = (code >> 5) & 15, c = (code >> 9) & 3, b = bh >> 3, head = bh & 7;
    const int slot = bh * 16 + qb + 0 * c, nst = p_nsteps(qb, c) >> 1, kvpos0 = 0;
    const int qw = qb * 256 + 32 * wid, qpos = qw + r32; const size_t qrow = (size_t)b * SEQ + qpos;
    const bf16* kgb = (const bf16*)(ws + WS_K) + ((size_t)b * SEQ + kvpos0 + (tid >> 4)) * AW + head * 128 + (tid & 15) * 8;
    const bf16* vgb = (const bf16*)(ws + WS_V) + ((size_t)b * SEQ + kvpos0 + (tid >> 4)) * AW + head * 128 + (tid & 15) * 8;
    bf16x8 qf[8];
    { const bf16* qp = (const bf16*)(ws + WS_Q) + qrow * AW + head * 128 + hi * 8;
#pragma unroll
      for (int d0 = 0; d0 < 8; ++d0) qf[d0] = *(const bf16x8*)(qp + 16 * d0); }
    f32x16 o[4];
#pragma unroll
    for (int i = 0; i < 4; ++i)
#pragma unroll
        for (int r = 0; r < 16; ++r) o[i][r] = 0.f;
    float R = 1.f;
    u32x4 kreg[2], vreg[2];
#define PLOAD(s_) do { _Pragma("unroll") for (int i_ = 0; i_ < 2; ++i_) { kreg[i_] = *(const u32x4*)(kgb + (size_t)((s_) * 64 + 32 * i_) * AW); vreg[i_] = *(const u32x4*)(vgb + (size_t)((s_) * 64 + 32 * i_) * AW); } } while (0)
#define PSTORE(buf_) do { _Pragma("unroll") for (int i_ = 0; i_ < 2; ++i_) { *(LAS u32x4*)(lds + (buf_) * BUF + ((tid >> 4) + 32 * i_) * KS + (tid & 15) * 16) = kreg[i_]; \
        *(LAS u32x4*)(lds + (buf_) * BUF + TILE_K + ((tid >> 4) + 32 * i_) * VS + (tid & 15) * 16) = vreg[i_]; } } while (0)
    volatile LAS int* flg = (volatile LAS int*)(lds + MISC_OFF + 64);
    PLOAD(nst - 1);
    PSTORE(0);
    __syncthreads();
    const LAS unsigned char* kp = lds + r32 * KS + hi * 16;
    const LAS unsigned char* vp = lds + TILE_K + (4 * hi + ((lane & 15) >> 2)) * VS + (16 * ((lane >> 4) & 1) + 4 * (lane & 3)) * 2;
    int cur = 0;
    for (int s = nst - 1; s >= 0; --s) {
        if (s > 0) PLOAD(s - 1);
#pragma unroll
        for (int blk = 1; blk >= 0; --blk) {
            const int kb = kvpos0 + 64 * s + 32 * blk;
            if (kb < qw + 32 && !__all(R == 0.f)) sb_block<VS, true>(o, R, kp + cur * BUF + blk * 32 * KS, vp + cur * BUF + blk * 32 * VS, qf, kp, kb, qw, qpos, hi);
        }
        volatile LAS int* fl = flg + 8 * (s & 1);
        if (lane == 0) fl[wid] = __all(R == 0.f) ? 1 : 0;
        if (s > 0) PSTORE(cur ^ 1);
        __syncthreads();
        if ((fl[0] & fl[1] & fl[2] & fl[3] & fl[4] & fl[5] & fl[6] & fl[7]) != 0) break;
        cur ^= 1;
    }
#undef PLOAD
#undef PSTORE
    float* op = (float*)(ws + WS_OP) + ((size_t)(slot * 8 + wid) * 32) * 128;
#pragma unroll
    for (int db = 0; db < 4; ++db)
#pragma unroll
        for (int r = 0; r < 16; ++r) op[crow(r, hi) * 128 + db * 32 + r32] = o[db][r];
    if (hi == 0) ((float*)(ws + WS_TP))[(slot * 8 + wid) * 32 + r32] = R;
}

struct MixRow { int m, t; const float* st; f32x4 op[4]; u32x4 u2[2], u1[2], u0[2], gb[2]; };
__device__ __forceinline__ void mix_load(const Args& a, MixRow& R, int m, int lane) {
    unsigned char* ws = a.ws;
    const float* OP = (const float*)(ws + WS_OP); const bf16* U = (const bf16*)(ws + WS_U); const bf16* GB = (const bf16*)(ws + WS_GB);
    const int h = lane >> 3, d0 = (lane & 7) * 16, c0 = lane * 16;
    int slot0, wid, q;
    if (m < NP) { const int b = m >> 12, t = m & 4095, qb = t >> 8; wid = (t & 255) >> 5; q = t & 31; slot0 = (b * 8 + h) * 16 + qb; R.t = t; R.st = nullptr; }
    else { const int r = m - NP, b = r >> 6, t = r & 63, rg = t >> 5; q = t & 31; wid = (h & 3) * 2 + rg; slot0 = 256 + b * 2 + (h >> 2); R.t = t; R.st = a.in[4] + (size_t)b * 2 * CC; }
    R.m = m;
    const f32x4* p = (const f32x4*)(OP + ((size_t)(slot0 * 8 + wid) * 32 + q) * 128 + d0);
#pragma unroll
    for (int i = 0; i < 4; ++i) R.op[i] = p[i];
    { const u32x4* pu = (const u32x4*)(U + (size_t)m * CC + c0); R.u2[0] = pu[0]; R.u2[1] = pu[1]; }
    if (R.t >= 1) { const u32x4* pu = (const u32x4*)(U + (size_t)(m - 1) * CC + c0); R.u1[0] = pu[0]; R.u1[1] = pu[1]; }
    if (R.t >= 2) { const u32x4* pu = (const u32x4*)(U + (size_t)(m - 2) * CC + c0); R.u0[0] = pu[0]; R.u0[1] = pu[1]; }
    { const u32x4* pg = (const u32x4*)(GB + (size_t)m * CC + c0); R.gb[0] = pg[0]; R.gb[1] = pg[1]; }
}
__device__ __forceinline__ void unpack16(const u32x4 (&x)[2], float (&o)[16]) {
    const unsigned ww[8] = {x[0].x, x[0].y, x[0].z, x[0].w, x[1].x, x[1].y, x[1].z, x[1].w};
#pragma unroll
    for (int i = 0; i < 8; ++i) { o[2 * i] = bflo(ww[i]); o[2 * i + 1] = bfhi(ww[i]); }
}
__device__ __forceinline__ void mix_finish(const Args& a, const MixRow& R, const float (&ga16)[16], const float (&gc16)[16], const float (&w0c)[16], const float (&w1c)[16], const float (&w2c)[16], int lane) {
    bf16* MIX = (bf16*)(a.ws + WS_MIX);
    const int h = lane >> 3, d0 = (lane & 7) * 16, c0 = lane * 16, m = R.m;
    float s = 0.f;
#pragma unroll
    for (int i = 0; i < 4; ++i) s += (R.op[i][0] * R.op[i][0] + R.op[i][1] * R.op[i][1]) + (R.op[i][2] * R.op[i][2] + R.op[i][3] * R.op[i][3]);
    float rs = __builtin_amdgcn_rsqf(wave_sum(s) * (1.0f / AW) + EPS);
    { unsigned ww[8];
#pragma unroll
      for (int i = 0; i < 8; ++i) ww[i] = pk2(R.op[i >> 1][(2 * i) & 3] * rs * ga16[2 * i], R.op[i >> 1][(2 * i + 1) & 3] * rs * ga16[2 * i + 1]);
      u32x4 w0, w1; w0.x = ww[0]; w0.y = ww[1]; w0.z = ww[2]; w0.w = ww[3]; w1.x = ww[4]; w1.y = ww[5]; w1.z = ww[6]; w1.w = ww[7];
      u32x4* o = (u32x4*)(MIX + (size_t)m * DM + h * 128 + d0); o[0] = w0; o[1] = w1; }
    float u0[16], u1[16], u2[16], gbv[16];
    unpack16(R.u2, u2); unpack16(R.gb, gbv);
    if (R.t >= 1) unpack16(R.u1, u1); else {
#pragma unroll
        for (int i = 0; i < 16; ++i) u1[i] = R.st ? R.st[CC + c0 + i] : 0.f; }
    if (R.t >= 2) unpack16(R.u0, u0); else {
#pragma unroll
        for (int i = 0; i < 16; ++i) u0[i] = R.st ? R.st[(R.t == 0 ? 0 : CC) + c0 + i] : 0.f; }
    float oc[16]; float s2 = 0.f;
#pragma unroll
    for (int i = 0; i < 16; ++i) { oc[i] = gbv[i] * (w0c[i] * u0[i] + w1c[i] * u1[i] + w2c[i] * u2[i]); s2 += oc[i] * oc[i]; }
    rs = __builtin_amdgcn_rsqf(wave_sum(s2) * (1.0f / CC) + EPS);
    { unsigned ww[8];
#pragma unroll
      for (int i = 0; i < 8; ++i) ww[i] = pk2(oc[2 * i] * rs * gc16[2 * i], oc[2 * i + 1] * rs * gc16[2 * i + 1]);
      u32x4 w0, w1; w0.x = ww[0]; w0.y = ww[1]; w0.z = ww[2]; w0.w = ww[3]; w1.x = ww[4]; w1.y = ww[5]; w1.z = ww[6]; w1.w = ww[7];
      u32x4* o = (u32x4*)(MIX + (size_t)m * DM + AW + c0); o[0] = w0; o[1] = w1; }
}
__device__ __forceinline__ void mix_rows(const Args& a, int gw, int NGW, int lane) {
    const float* cw = a.in[9]; const float* ga = a.in[10]; const float* gc = a.in[11];
    const int h = lane >> 3, d0 = (lane & 7) * 16, c0 = lane * 16;
    float ga16[16], gc16[16], w0c[16], w1c[16], w2c[16];
#pragma unroll
    for (int i = 0; i < 4; ++i) {
        const f32x4 x0 = *(const f32x4*)(ga + h * 128 + d0 + 4 * i), x1 = *(const f32x4*)(gc + c0 + 4 * i), x2 = *(const f32x4*)(cw + c0 + 4 * i), x3 = *(const f32x4*)(cw + CC + c0 + 4 * i), x4 = *(const f32x4*)(cw + 2 * CC + c0 + 4 * i);
#pragma unroll
        for (int j = 0; j < 4; ++j) { ga16[4 * i + j] = x0[j]; gc16[4 * i + j] = x1[j]; w0c[4 * i + j] = x2[j]; w1c[4 * i + j] = x3[j]; w2c[4 * i + j] = x4[j]; }
    }
    for (int m = gw; m < MT; m += 2 * NGW) {
        MixRow A, B; const bool hasB = m + NGW < MT;
        mix_load(a, A, m, lane);
        if (hasB) mix_load(a, B, m + NGW, lane);
        mix_finish(a, A, ga16, gc16, w0c, w1c, w2c, lane);
        if (hasB) mix_finish(a, B, ga16, gc16, w0c, w1c, w2c, lane);
    }
}
#ifndef NCONV
#define NCONV 96
#endif
#ifndef REP_P0
#define REP_P0 1
#endif
#ifndef REP_P1
#define REP_P1 1
#endif
#ifndef REP_P3
#define REP_P3 1
#endif
#ifndef REP_P4
#define REP_P4 1
#endif
#ifndef REP_P5
#define REP_P5 1
#endif
__global__ void __launch_bounds__(NWAVES * 64, 2) fwd_megakernel(Args args) {
    extern __shared__ __attribute__((aligned(16))) unsigned char lds_raw[];
    cg::grid_group grid = cg::this_grid();
    LAS unsigned char* lds = (LAS unsigned char*)lds_raw;
    const int G = gridDim.x, bx = blockIdx.x, NGW = G * NWAVES;
#define PHASE_IDS() int tid = threadIdx.x; asm volatile("" : "+v"(tid)); const int lane = tid & 63; const int wave = __builtin_amdgcn_readfirstlane(tid >> 6); const int gw = bx * NWAVES + wave; (void)lane; (void)gw
    unsigned char* ws = args.ws;
    unsigned* ctl = (unsigned*)(ws + WS_CTL);
    LAS float* red = (LAS float*)(lds + RED_OFF);
    volatile LAS int* misc = (volatile LAS int*)(lds + MISC_OFF);

    { PHASE_IDS(); if (bx == 0 && tid == 0) { ctl[0] = 0u; ctl[64] = 0u; ctl[256] = 0u; }
      if (bx == 0) for (int i = tid; i < XCD_BAR_WORDS; i += NWAVES * 64) ctl[4096 + i] = 0u;
      if (tid < 2) misc[8 + tid] = 0;
#ifndef NO_P0
    for (int rep_ = 0; rep_ < REP_P0; ++rep_) p0_prologue(args, lds, gw, NGW, lane, wave);
#endif
    }
    grid.sync();
    XcdBarrier xbar = xcd_barrier_post(ctl + 4096, (volatile LAS unsigned*)(lds + MISC_OFF) + 8);

#ifndef NO_P1
    for (int rep_ = 0; rep_ < REP_P1; ++rep_) {
        pg8::Gemm g{(const pg8::bf16_t*)(ws + WS_HN), (const pg8::bf16_t*)(ws + WS_WIN), MT, INC, DM}; typedef pg8::InProjOrder Ord; Ord S; S.init(G, bx);
        pg8::EpiIn E{(bf16*)(ws + WS_Q), (bf16*)(ws + WS_K), (bf16*)(ws + WS_V), (bf16*)(ws + WS_GB), (bf16*)(ws + WS_U), args.out, args.in[7], args.in[8], red,
                     1.4426950408889634f * 0.08838834764831845f, OFF_KP, OFF_VP, OFF_CP, OFF_KS, OFF_VS, OFF_CS};
        pg8::gemm_phase<pg8::EpiIn, Ord, true, true>(lds, g, S, E);
    }
#endif
    xcd_barrier(xbar);

#ifndef NO_P2
    {
        const int nitems = g_items.n;
        PHASE_IDS();
#ifdef DUP_P2
        for (int rep = 0; rep < 2; ++rep)
#else
        const int rep = 0;
#endif
        for (;;) {
            if (tid == 0) misc[0] = (int)atomicAdd(ctl + 64 * rep, 1u);
            __syncthreads();
            int it = misc[0];
            __syncthreads();
            if (it < 48) {
                pg8::Gemm g{(const pg8::bf16_t*)(ws + WS_HN), (const pg8::bf16_t*)(ws + WS_WIN), MT, INC, DM};
                pg8::OneUnit S1; S1.u0.pm = 30 + (it & 3); S1.u0.pn = 12 + (it >> 2); S1.u0.k0 = 0; S1.u0.nt = 32; S1.u0.split = 0; S1.u0.tu = 0; S1.u0.sp = 0;
                pg8::EpiIn E{(bf16*)(ws + WS_Q), (bf16*)(ws + WS_K), (bf16*)(ws + WS_V), (bf16*)(ws + WS_GB), (bf16*)(ws + WS_U), args.out, args.in[7], args.in[8], red,
                             1.4426950408889634f * 0.08838834764831845f, OFF_KP, OFF_VP, OFF_CP, OFF_KS, OFF_VS, OFF_CS};
                pg8::gemm_phase<pg8::EpiIn, pg8::OneUnit, true, true>(lds, g, S1, E);
                __syncthreads();
                continue;
            }
            it -= 48;
            const bool token = it >= 16 && it < 16 + NCONV;
            if (token || it >= nitems + NCONV) {
                for (;;) {
                    if (tid == 0) misc[0] = (int)atomicAdd(ctl + 256, 1u);
                    __syncthreads();
                    const int ch = misc[0];
                    __syncthreads();
                    if (ch >= P0_LATE_CHUNKS) break;
                    p0_run_range(args, (LAS float*)(lds + wave * 16384), P0_EARLY_ITEMS + ch * P0_CHUNK + wave * (P0_CHUNK / NWAVES), P0_CHUNK / NWAVES, lane);
                }
                if (token) continue;
                break;
            }
            if (it >= 16) it -= NCONV;
            const int code = g_items.v[it];
#if defined(ONLY_S)
            attn_item<true>(args, lds, code);
#elif defined(ONLY_P)
            attn_item_p(args, lds, code);
#else
            if (code & 1) attn_item<true>(args, lds, code); else attn_item_p(args, lds, code);
#endif
        }
    }
#endif
    xcd_barrier(xbar);

#ifndef NO_P3
    for (int rep_ = 0; rep_ < REP_P3; ++rep_) { PHASE_IDS(); mix_rows(args, gw, NGW, lane); }
#endif
    xcd_barrier(xbar);

#ifndef NO_P4
    for (int rep_ = 0; rep_ < REP_P4; ++rep_) {
        pg8::Gemm g{(const pg8::bf16_t*)(ws + WS_MIX), (const pg8::bf16_t*)(ws + WS_WOUT), MT, DM, DM}; typedef pg8::TailOrderT<MT / 256, DM / 256, DM / 64, 8> Ord; Ord S; S.init(G, bx);
        pg8::EpiOut E{args.in[0], args.in[1], args.out + OFF_Y, (bf16*)(ws + WS_HN), (float*)(ws + WS_SSQ), red, (float*)(ws + WS_PART)};
        pg8::gemm_phase<pg8::EpiOut, Ord, true, true>(lds, g, S, E);
        if (S.rem > 0) {
            xcd_barrier(xbar);
            PHASE_IDS();
            for (int w = gw; w < S.rem * 256; w += NGW) {
                const int tu = w >> 8, r = w & 255; pg8::Unit u; Ord::SO::unit(S.full * G + tu, u);
                const size_t row = (size_t)u.pm * 256 + r; const int col = u.pn * 256 + 4 * lane;
                const float* xin = row < NP ? args.in[0] + row * DM : args.in[1] + (row - NP) * DM;
                f32x4 v = *(const f32x4*)(xin + col);
                const float* p = (const float*)(ws + WS_PART) + (size_t)(tu * 8) * 65536 + r * 256 + 4 * lane;
#pragma unroll
                for (int s = 0; s < 8; ++s) v += *(const f32x4*)(p + (size_t)s * 65536);
                *(f32x4*)(args.out + OFF_Y + row * DM + col) = v;
                u32x2 pk; pk.x = pk2(v[0], v[1]); pk.y = pk2(v[2], v[3]); *(u32x2*)((bf16*)(ws + WS_HN) + row * DM + col) = pk;
                const float ss = wave_sum((v[0] * v[0] + v[1] * v[1]) + (v[2] * v[2] + v[3] * v[3]));
                if (lane == 0) ((float*)(ws + WS_SSQ))[row * 8 + u.pn] = ss;
            }
        }
    }
#endif
    xcd_barrier(xbar);

#ifndef NO_P5
    for (int rep_ = 0; rep_ < REP_P5; ++rep_) {
        pg8::Gemm g{(const pg8::bf16_t*)(ws + WS_HN), (const pg8::bf16_t*)(ws + WS_WGU), MT, 2 * DFF, DM}; typedef pg8::StaticOrderT<MT / 256, 2 * DFF / 256, DM / 64> Ord; Ord S; S.init(G, bx);
        pg8::EpiGU E{(bf16*)(ws + WS_H), (const float*)(ws + WS_SSQ)};
        pg8::gemm_phase<pg8::EpiGU, Ord, true, true>(lds, g, S, E);
    }
#endif
    xcd_barrier(xbar);

#ifndef NO_P6
    {
        pg8::Gemm g{(const pg8::bf16_t*)(ws + WS_H), (const pg8::bf16_t*)(ws + WS_WDN), MT, DM, DFF};
        typedef pg8::TailOrderT<MT / 256, DM / 256, DFF / 64, 8> Ord; Ord S; S.init(G, bx);
        pg8::EpiDown E{args.out + OFF_Y, (float*)(ws + WS_PART), (const pg8::bf16_t*)(ws + WS_HN)};
        pg8::gemm_phase<pg8::EpiDown, Ord, true, true>(lds, g, S, E);
        if (S.rem > 0) {
            xcd_barrier(xbar);
            PHASE_IDS();
            for (int w = gw; w < S.rem * 256; w += NGW) {
                const int tu = w >> 8, r = w & 255; pg8::Unit u; Ord::SO::unit(S.full * G + tu, u);
                float* y = args.out + OFF_Y + ((size_t)u.pm * 256 + r) * DM + u.pn * 256 + 4 * lane;
                f32x4 v = *(const f32x4*)y;
                const float* p = (const float*)(ws + WS_PART) + (size_t)(tu * 8) * 65536 + r * 256 + 4 * lane;
#pragma unroll
                for (int s = 0; s < 8; ++s) v += *(const f32x4*)(p + (size_t)s * 65536);
                *(f32x4*)y = v;
            }
        }
    }
#endif
}

extern "C" void kernel_launch(void* const* d_in, const int* in_sizes, int n_in, void* d_out, int out_size, void* d_ws, size_t ws_size, hipStream_t stream) {
    static int grid = 0;
    if (grid == 0) {
        if (n_in != 17 || (size_t)out_size != OUT_TOTAL || ws_size < WS_END) { fprintf(stderr, "kernel_launch: unexpected shapes (n_in %d out %d ws %zu need %zu)\n", n_in, out_size, ws_size, (size_t)WS_END); grid = -1; return; }
        int dev = 0, cus = 0, per_cu = 0;
        hipGetDevice(&dev); hipDeviceGetAttribute(&cus, hipDeviceAttributeMultiprocessorCount, dev);
        hipFuncSetAttribute((const void*)fwd_megakernel, hipFuncAttributeMaxDynamicSharedMemorySize, LDS_BYTES);
        hipOccupancyMaxActiveBlocksPerMultiprocessor(&per_cu, (const void*)fwd_megakernel, NWAVES * 64, LDS_BYTES);
        if (per_cu < 1) { fprintf(stderr, "kernel_launch: occupancy query says %d blocks per CU\n", per_cu); per_cu = 1; }
        (void)hipGetLastError();
        grid = cus;
    }
    if (grid < 0) return;
    Args a{};
    for (int i = 0; i < 17; ++i) a.in[i] = (const float*)d_in[i];
    a.out = (float*)d_out; a.ws = (unsigned char*)d_ws;
    void* kargs[] = {&a};
    hipError_t e = hipLaunchCooperativeKernel((const void*)fwd_megakernel, dim3(grid), dim3(NWAVES * 64), kargs, LDS_BYTES, stream);
    if (e != hipSuccess) fprintf(stderr, "cooperative launch failed: %s (grid %d)\n", hipGetErrorString(e), grid);
}
```

```cpp
#include <hip/hip_runtime.h>
#include <hip/hip_cooperative_groups.h>
#include <cstdio>
#include <cstdint>
namespace cg = cooperative_groups;
namespace pg8 {
#define PG8_LAS __attribute__((address_space(3)))
typedef unsigned short bf16_t;
typedef short bf16x8 __attribute__((ext_vector_type(8)));
typedef float f32x4 __attribute__((ext_vector_type(4)));
typedef unsigned u32x4 __attribute__((ext_vector_type(4)));
constexpr int BM = 256, BK = 64, HALF = 128, HTB = HALF * BK * 2  , STAGE_BYTES = 8 * HTB, NXCD = 8, WGM = 8;

__host__ __device__ __forceinline__ int lds_byte(int r, int c) { const int st = (r >> 4) * 2 + (c >> 5), rr = r & 15, cc = c & 31, ob = rr * 64 + cc * 2; return st * 1024 + (ob ^ (((ob >> 9) & 1) << 5)); }
__host__ __device__ __forceinline__ void stage_rc(int b, int& R, int& C) { const int st = b / 1024, sb = b % 1024, swz = sb ^ (((sb >> 9) & 1) << 5); R = (st >> 1) * 16 + swz / 64; C = (st & 1) * 32 + (swz % 64) / 2; }
__host__ __device__ __forceinline__ int perm32(int rho) { const int n = rho >> 4, i = rho & 15; return 8 * (i >> 2) + 4 * n + (i & 3); }

struct Unit { int pm, pn, k0, nt, split, tu, sp; };
struct Gemm { const bf16_t* A; const bf16_t* Bt; int M, N, K; };

template <int NM, int NN, int NTK> struct StaticOrderT {
    static constexpr int nM = NM, nN = NN, nwg = NM * NN, ntk = NTK;
    int G, c;
    __host__ __device__ __forceinline__ void init(int G_, int c_) { G = G_; c = c_; }
    __host__ __device__ __forceinline__ bool next(int i, Unit& u) const { const int L = i * G + c; if (L >= nwg) return false; unit(L, u); return true; }
    __host__ __device__ __forceinline__ static void unit(int L, Unit& u) {
        int wgid = L; { constexpr int q = nwg / NXCD, r = nwg % NXCD; const int xcd = wgid % NXCD, off = wgid / NXCD; wgid = (xcd < r ? xcd * (q + 1) : r * (q + 1) + (xcd - r) * q) + off; }
        constexpr int nig = WGM * nN; const int gid = wgid / nig, fm = gid * WGM, gsz = (nM - fm) < WGM ? (nM - fm) : WGM;
        u.pm = fm + ((wgid % nig) % gsz); u.pn = (wgid % nig) / gsz; u.k0 = 0; u.nt = ntk; u.split = 0; u.tu = 0; u.sp = 0;
    }
    __device__ __forceinline__ void a_ready(const Unit&) const {}
    __device__ __forceinline__ void done(const Unit&) const {}
};
template <int NM, int NN, int NTK, int NSPLIT> struct TailOrderT {
    typedef StaticOrderT<NM, NN, NTK> SO;
    int G, c, full, rem;
    __host__ __device__ __forceinline__ void init(int G_, int c_) { G = G_; c = c_; full = SO::nwg / G; rem = SO::nwg - full * G; if (rem * NSPLIT > G || NTK < 2 * NSPLIT) { full = 1 << 24; rem = 0; } }
    __host__ __device__ __forceinline__ static int kstart(int s) { return s >= NSPLIT ? NTK : ((s * NTK / NSPLIT) & ~1); }
    __host__ __device__ __forceinline__ bool next(int i, Unit& u) const {
        if (i < full) { const int L = i * G + c; if (L >= SO::nwg) return false; SO::unit(L, u); return true; }
        if (i > full || c >= rem * NSPLIT) return false;
        const int tu = c / NSPLIT, sp = c % NSPLIT; SO::unit(full * G + tu, u); u.k0 = kstart(sp); u.nt = kstart(sp + 1) - u.k0; u.split = 1; u.tu = tu; u.sp = sp; return true;
    }
    __device__ __forceinline__ void a_ready(const Unit&) const {}
    __device__ __forceinline__ void done(const Unit&) const {}
};

struct InProjOrder {
    typedef StaticOrderT<30, 24, 32> SO;
    int G, c;
    __host__ __device__ __forceinline__ void init(int G_, int c_) { G = G_; c = c_; }
    __host__ __device__ __forceinline__ bool next(int i, Unit& u) const {
        const int L = i * G + c; if (L >= 768) return false;
        if (L < 720) { SO::unit(L, u); return true; }
        const int j = L - 720; u.pm = 30 + (j & 3); u.pn = j >> 2; u.k0 = 0; u.nt = 32; u.split = 0; u.tu = 0; u.sp = 0; return true;
    }
    __device__ __forceinline__ void a_ready(const Unit&) const {}
    __device__ __forceinline__ void done(const Unit&) const {}
};
struct OneUnit {
    Unit u0;
    __host__ __device__ __forceinline__ bool next(int i, Unit& u) const { if (i != 0) return false; u = u0; return true; }
    __device__ __forceinline__ void a_ready(const Unit&) const {}
    __device__ __forceinline__ void done(const Unit&) const {}
};

__device__ __forceinline__ unsigned cvt_pk_bf16(float lo, float hi) { unsigned r; asm volatile("v_cvt_pk_bf16_f32 %0, %1, %2" : "=v"(r) : "v"(lo), "v"(hi)); return r; }
typedef float f32x2 __attribute__((ext_vector_type(2)));
#define PG8_LBAR() asm volatile("s_waitcnt lgkmcnt(0)\n\ts_barrier" ::: "memory")
constexpr int NPROMPT = 8192;
__device__ __forceinline__ u32x4 pack8(const f32x4 a, const f32x4 b) { u32x4 w; w.x = cvt_pk_bf16(a[0], a[1]); w.y = cvt_pk_bf16(a[2], a[3]); w.z = cvt_pk_bf16(b[0], b[1]); w.w = cvt_pk_bf16(b[2], b[3]); return w; }


__device__ __forceinline__ void store_partial(float* part, int nsplit, const f32x4 (&acc)[2][2][4][2], const Unit& u, int wr, int wc, int fr, int fq) {
    float* pt = part + (size_t)(u.tu * nsplit + u.sp) * 65536; int rl0 = wr * 64 + fr, cw = wc * 32 + 8 * fq; asm volatile("" : "+v"(rl0), "+v"(cw));
#pragma unroll
    for (int ai = 0; ai < 2; ++ai)
#pragma unroll
        for (int m = 0; m < 4; ++m)
#pragma unroll
            for (int bj = 0; bj < 2; ++bj) { float* o = pt + (ai * HALF + rl0 + m * 16) * 256 + bj * HALF + cw; *(f32x4*)o = acc[ai][bj][m][0]; *(f32x4*)(o + 4) = acc[ai][bj][m][1]; }
}

struct EpiIn {
    static constexpr bool PERM = true, AFTER_DRAIN = false;
    bf16_t *Q, *Kb, *Vb, *GB, *U; float* out; const float *gq, *gk; PG8_LAS float* red; float qscale;
    size_t off_kp, off_vp, off_cp, off_ks, off_vs, off_cs;
    __device__ __forceinline__ void operator()(const f32x4 (&acc)[2][2][4][2], const Unit& u, int wr, int wc, int fr, int fq) const {
        int rl0 = wr * 64 + fr, cw = wc * 32 + 8 * fq; asm volatile("" : "+v"(rl0), "+v"(cw));
        const int pn = u.pn, rowt = u.pm * BM;
        const bool prompt = rowt < NPROMPT;
        if (pn < 8) {
            const bool isq = pn < 4;
#pragma unroll
            for (int ai = 0; ai < 2; ++ai)
#pragma unroll
                for (int m = 0; m < 4; ++m)
#pragma unroll
                    for (int bj = 0; bj < 2; ++bj) {
                        const f32x4 a = acc[ai][bj][m][0], b = acc[ai][bj][m][1];
                        float s = (a[0] * a[0] + a[1] * a[1]) + (a[2] * a[2] + a[3] * a[3]) + (b[0] * b[0] + b[1] * b[1]) + (b[2] * b[2] + b[3] * b[3]);
                        s += __shfl_xor(s, 16); s += __shfl_xor(s, 32);
                        if (fq == 0) red[((ai * HALF + rl0 + m * 16) * 2 + bj) * 4 + wc] = s;
                    }
            PG8_LBAR();
            const float* g = isq ? gq : gk;
            const f32x4 g0 = *(const f32x4*)(g + cw), g1 = *(const f32x4*)(g + cw + 4);
#pragma unroll
            for (int ai = 0; ai < 2; ++ai)
#pragma unroll
                for (int m = 0; m < 4; ++m) {
                    const int rl = ai * HALF + rl0 + m * 16; const size_t row = (size_t)(rowt + rl);
#pragma unroll
                    for (int bj = 0; bj < 2; ++bj) {
                        const f32x4 p = *(const PG8_LAS f32x4*)(red + (rl * 2 + bj) * 4);
                        float rs = __builtin_amdgcn_rsqf(((p[0] + p[1]) + (p[2] + p[3])) * (1.0f / 128.0f) + 1e-6f);
                        if (isq) rs *= qscale;
                        const f32x4 v0 = acc[ai][bj][m][0] * rs * g0, v1 = acc[ai][bj][m][1] * rs * g1;
                        if (isq) { *(u32x4*)(Q + row * 1024 + pn * 256 + bj * HALF + cw) = pack8(v0, v1); }
                        else {
                            const int col = (pn - 4) * 256 + bj * HALF + cw;
                            float* o = prompt ? out + off_kp + row * 1024 + col : out + off_ks + (row - NPROMPT) * 1024 + col;
                            *(f32x4*)o = v0; *(f32x4*)(o + 4) = v1;
                            if (prompt) *(u32x4*)(Kb + row * 1024 + col) = pack8(v0, v1);
                        }
                    }
                }
        } else if (pn < 12) {
#pragma unroll
            for (int ai = 0; ai < 2; ++ai)
#pragma unroll
                for (int m = 0; m < 4; ++m) {
                    const size_t row = (size_t)(rowt + ai * HALF + rl0 + m * 16);
#pragma unroll
                    for (int bj = 0; bj < 2; ++bj) {
                        const int col = (pn - 8) * 256 + bj * HALF + cw; const f32x4 v0 = acc[ai][bj][m][0], v1 = acc[ai][bj][m][1];
                        float* o = prompt ? out + off_vp + row * 1024 + col : out + off_vs + (row - NPROMPT) * 1024 + col;
                        *(f32x4*)o = v0; *(f32x4*)(o + 4) = v1;
                        if (prompt) *(u32x4*)(Vb + row * 1024 + col) = pack8(v0, v1);
                    }
                }
        } else if (pn < 16) {
#pragma unroll
            for (int ai = 0; ai < 2; ++ai)
#pragma unroll
                for (int m = 0; m < 4; ++m) {
                    const size_t row = (size_t)(rowt + ai * HALF + rl0 + m * 16);
#pragma unroll
                    for (int bj = 0; bj < 2; ++bj) *(u32x4*)(GB + row * 1024 + (pn - 12) * 256 + bj * HALF + cw) = pack8(acc[ai][bj][m][0], acc[ai][bj][m][1]);
                }
        } else {
#pragma unroll
            for (int ai = 0; ai < 2; ++ai)
#pragma unroll
                for (int m = 0; m < 4; ++m) {
                    const int rowi = rowt + ai * HALF + rl0 + m * 16; const int ch = (pn - 16) * HALF + cw;
                    const f32x4 v0 = acc[ai][0][m][0] * acc[ai][1][m][0], v1 = acc[ai][0][m][1] * acc[ai][1][m][1];
                    *(u32x4*)(U + (size_t)rowi * 1024 + ch) = pack8(v0, v1);
                    if (prompt) { const int t = rowi & 4095; if (t >= 4094) { float* o = out + off_cp + ((rowi >> 12) * 2 + (t - 4094)) * 1024 + ch; *(f32x4*)o = v0; *(f32x4*)(o + 4) = v1; } }
                    else { const int rs_ = rowi - NPROMPT, t = rs_ & 63; if (t >= 62) { float* o = out + off_cs + ((rs_ >> 6) * 2 + (t - 62)) * 1024 + ch; *(f32x4*)o = v0; *(f32x4*)(o + 4) = v1; } }
                }
        }
    }
};

struct EpiOut {
    static constexpr bool PERM = true, AFTER_DRAIN = false;
    const float *xp, *xs; float* Y; bf16_t* X1; float* ssq; PG8_LAS float* red; float* part;
    __device__ __forceinline__ void operator()(const f32x4 (&acc)[2][2][4][2], const Unit& u, int wr, int wc, int fr, int fq) const {
        if (u.split) { store_partial(part, 8, acc, u, wr, wc, fr, fq); return; }
        int rl0 = wr * 64 + fr, cw = wc * 32 + 8 * fq; asm volatile("" : "+v"(rl0), "+v"(cw));
        const int pn = u.pn, rowt = u.pm * BM;
        const float* xin = rowt < NPROMPT ? xp + (size_t)rowt * 2048 : xs + (size_t)(rowt - NPROMPT) * 2048;
#pragma unroll
        for (int ai = 0; ai < 2; ++ai) {
            f32x4 xv[4][2][2];
#pragma unroll
            for (int m = 0; m < 4; ++m)
#pragma unroll
                for (int bj = 0; bj < 2; ++bj) { const float* xi = xin + (size_t)(ai * HALF + rl0 + m * 16) * 2048 + pn * 256 + bj * HALF + cw; xv[m][bj][0] = *(const f32x4*)xi; xv[m][bj][1] = *(const f32x4*)(xi + 4); }
#pragma unroll
            for (int m = 0; m < 4; ++m) {
                const int rl = ai * HALF + rl0 + m * 16; float s = 0.f;
#pragma unroll
                for (int bj = 0; bj < 2; ++bj) {
                    const int col = pn * 256 + bj * HALF + cw;
                    const f32x4 v0 = xv[m][bj][0] + acc[ai][bj][m][0], v1 = xv[m][bj][1] + acc[ai][bj][m][1];
                    *(u32x4*)(X1 + (size_t)(rowt + rl) * 2048 + col) = pack8(v0, v1);
                    s += (v0[0] * v0[0] + v0[1] * v0[1]) + (v0[2] * v0[2] + v0[3] * v0[3]) + (v1[0] * v1[0] + v1[1] * v1[1]) + (v1[2] * v1[2] + v1[3] * v1[3]);
                }
                s += __shfl_xor(s, 16); s += __shfl_xor(s, 32);
                if (fq == 0) red[rl * 4 + wc] = s;
            }
            asm volatile("" ::: "memory");
        }
        PG8_LBAR();
        if (threadIdx.x < 256) { const f32x4 p = *(const PG8_LAS f32x4*)(red + threadIdx.x * 4); ssq[(size_t)(rowt + threadIdx.x) * 8 + pn] = (p[0] + p[1]) + (p[2] + p[3]); }
        PG8_LBAR();
    }
};

struct EpiGU {
    static constexpr bool PERM = true, AFTER_DRAIN = false;
    bf16_t* H; const float* ssq;
    __device__ __forceinline__ void operator()(const f32x4 (&acc)[2][2][4][2], const Unit& u, int wr, int wc, int fr, int fq) const {
        int rl0 = wr * 64 + fr, cw = wc * 32 + 8 * fq; asm volatile("" : "+v"(rl0), "+v"(cw));
        const int pn = u.pn, rowt = u.pm * BM;
        f32x4 pa[2][4], pb[2][4];
#pragma unroll
        for (int ai = 0; ai < 2; ++ai)
#pragma unroll
            for (int m = 0; m < 4; ++m) { const float* p = ssq + (size_t)(rowt + ai * HALF + rl0 + m * 16) * 8; pa[ai][m] = *(const f32x4*)p; pb[ai][m] = *(const f32x4*)(p + 4); }
#pragma unroll
        for (int ai = 0; ai < 2; ++ai)
#pragma unroll
            for (int m = 0; m < 4; ++m) {
                const size_t row = (size_t)(rowt + ai * HALF + rl0 + m * 16);
                const f32x4 p0 = pa[ai][m], p1 = pb[ai][m];
                const float rs = __builtin_amdgcn_rsqf((((p0[0] + p0[1]) + (p0[2] + p0[3])) + ((p1[0] + p1[1]) + (p1[2] + p1[3]))) * (1.0f / 2048.0f) + 1e-6f);
                f32x4 h[2];
#pragma unroll
                for (int n = 0; n < 2; ++n) {
                    const f32x4 g = acc[ai][0][m][n] * rs, up = acc[ai][1][m][n] * rs;
#pragma unroll
                    for (int j = 0; j < 4; ++j) h[n][j] = g[j] * __builtin_amdgcn_rcpf(1.0f + __builtin_amdgcn_exp2f(-1.4426950408889634f * g[j])) * up[j];
                }
                *(u32x4*)(H + row * 5632 + pn * HALF + cw) = pack8(h[0], h[1]);
            }
    }
};

struct EpiDown {
    static constexpr bool PERM = true, AFTER_DRAIN = false;
    float* Y; float* part; const bf16_t* X1;
    __device__ __forceinline__ void operator()(const f32x4 (&acc)[2][2][4][2], const Unit& u, int wr, int wc, int fr, int fq) const {
        if (u.split) { store_partial(part, 8, acc, u, wr, wc, fr, fq); return; }
        int rl0 = wr * 64 + fr, cw = wc * 32 + 8 * fq; asm volatile("" : "+v"(rl0), "+v"(cw));
        const int pn = u.pn, rowt = u.pm * BM;
        u32x4 xb[2][4][2];
#pragma unroll
        for (int ai = 0; ai < 2; ++ai)
#pragma unroll
            for (int m = 0; m < 4; ++m)
#pragma unroll
                for (int bj = 0; bj < 2; ++bj) xb[ai][m][bj] = *(const u32x4*)(X1 + (size_t)(rowt + ai * HALF + rl0 + m * 16) * 2048 + pn * 256 + bj * HALF + cw);
#pragma unroll
        for (int ai = 0; ai < 2; ++ai)
#pragma unroll
            for (int m = 0; m < 4; ++m)
#pragma unroll
                for (int bj = 0; bj < 2; ++bj) {
                    const size_t off = (size_t)(rowt + ai * HALF + rl0 + m * 16) * 2048 + pn * 256 + bj * HALF + cw;
                    const u32x4 x = xb[ai][m][bj];
                    f32x4 b0, b1; b0[0] = __builtin_bit_cast(float, x.x << 16); b0[1] = __builtin_bit_cast(float, x.x & 0xffff0000u); b0[2] = __builtin_bit_cast(float, x.y << 16); b0[3] = __builtin_bit_cast(float, x.y & 0xffff0000u);
                    b1[0] = __builtin_bit_cast(float, x.z << 16); b1[1] = __builtin_bit_cast(float, x.z & 0xffff0000u); b1[2] = __builtin_bit_cast(float, x.w << 16); b1[3] = __builtin_bit_cast(float, x.w & 0xffff0000u);
                    float* o = Y + off; *(f32x4*)o = b0 + acc[ai][bj][m][0]; *(f32x4*)(o + 4) = b1 + acc[ai][bj][m][1];
                }
    }
};

struct EpiNone {
    static constexpr bool PERM = true, AFTER_DRAIN = false;
    float* sink;
    __device__ __forceinline__ void operator()(const f32x4 (&acc)[2][2][4][2], const Unit& u, int wr, int wc, int fr, int fq) const {
        if (acc[0][0][0][0][0] == 12345.678f && acc[1][1][3][1][3] == -9876.5f) sink[0] = 1.f;
    }
};
template <class Epi, class Sched, bool ALIGN_EPI = false, bool SP2 = false>
__device__ __forceinline__ void gemm_phase(PG8_LAS unsigned char* lds, const Gemm g, const Sched& S, const Epi& E) {
    int tid_ = threadIdx.x; asm volatile("" : "+v"(tid_));
    const int tid = tid_, wid = __builtin_amdgcn_readfirstlane(tid >> 6), lane = tid & 63, wr = wid >> 2, wc = wid & 3, fr = lane & 15, fq = lane >> 4;
    const int K = g.K;
    unsigned voffA[2], voffB[2];
#pragma unroll
    for (int i = 0; i < 2; ++i) { int R, C; stage_rc(tid * 16 + i * 8192, R, C); const int Rb = Epi::PERM ? ((R & ~31) + perm32(R & 31)) : R;
        voffA[i] = (unsigned)(R * K + C) * 2u; voffB[i] = (unsigned)(Rb * K + C) * 2u; }
    const size_t kstep = (size_t)(BK * 2);
    const size_t hstep = (size_t)HALF * K * 2;
    const size_t tstep = 2 * hstep;
    const unsigned ldsw = (unsigned)wid * 1024u;
    const int aoff = lds_byte(wr * 64 + fr, fq * 8), boff = lds_byte(wc * 32 + fr, fq * 8);
#define PG8_SA(b, h) (((b) * 2 + (h)) * HTB)
#define PG8_SB(b, h) ((4 + (b) * 2 + (h)) * HTB)
#define PG8_STAGE(bufoff, gbase, voff) do { _Pragma("unroll") for (int _i = 0; _i < 2; ++_i) \
        __builtin_amdgcn_global_load_lds((const unsigned*)((const char*)(gbase) + (voff)[_i]), (PG8_LAS unsigned*)(lds + (bufoff) + ldsw + _i * 8192), 16, 0, 0); } while (0)
#define PG8_LDA(dst, b, h) do { _Pragma("unroll") for (int m = 0; m < 4; ++m) _Pragma("unroll") for (int k = 0; k < 2; ++k) dst[m][k] = *(const PG8_LAS bf16x8*)(lds + PG8_SA(b, h) + aoff + m * 2048 + k * 1024); } while (0)
#define PG8_LDB(dst, b, h) do { _Pragma("unroll") for (int n = 0; n < 2; ++n) _Pragma("unroll") for (int k = 0; k < 2; ++k) dst[n][k] = *(const PG8_LAS bf16x8*)(lds + PG8_SB(b, h) + boff + n * 2048 + k * 1024); } while (0)
#define PG8_MMA(ai, bj, At, Bt) do { __builtin_amdgcn_s_setprio(1); _Pragma("unroll") for (int m = 0; m < 4; ++m) _Pragma("unroll") for (int n = 0; n < 2; ++n) _Pragma("unroll") for (int k = 0; k < 2; ++k) \
        acc[ai][bj][m][n] = __builtin_amdgcn_mfma_f32_16x16x32_bf16(Bt[n][k], At[m][k], acc[ai][bj][m][n], 0, 0, 0); __builtin_amdgcn_s_setprio(0); } while (0)
#define PG8_WAIT_V(n) asm volatile("s_waitcnt vmcnt(" #n ")" ::: "memory")
#define PG8_WAIT_L(n) asm volatile("s_waitcnt lgkmcnt(" #n ")" ::: "memory")
#define PG8_BAR __builtin_amdgcn_s_barrier()
#define PG8_SCHED __builtin_amdgcn_sched_barrier(0)
    Unit cur, nxt; int ui = 0;
    if (!S.next(0, cur)) return;
    f32x4 acc[2][2][4][2];
#pragma unroll
    for (int a = 0; a < 2; ++a)
#pragma unroll
        for (int b = 0; b < 2; ++b)
#pragma unroll
            for (int m = 0; m < 4; ++m)
#pragma unroll
                for (int n = 0; n < 2; ++n) acc[a][b][m][n] = (f32x4){0.f, 0.f, 0.f, 0.f};
    bf16x8 At[4][2], B0[2][2], B1[2][2];
    const char* cA = (const char*)g.A + (size_t)cur.pm * tstep + (size_t)cur.k0 * kstep; const char* cB = (const char*)g.Bt + (size_t)cur.pn * tstep + (size_t)cur.k0 * kstep;
    S.a_ready(cur);
    if constexpr (SP2) {
        PG8_STAGE(PG8_SB(0, 0), cB, voffB); PG8_STAGE(PG8_SB(0, 1), cB + hstep, voffB); PG8_STAGE(PG8_SA(0, 0), cA, voffA); PG8_STAGE(PG8_SA(0, 1), cA + hstep, voffA);
        if (wr == 1) PG8_BAR;
        PG8_WAIT_V(2); PG8_BAR;
        PG8_STAGE(PG8_SB(1, 0), cB + kstep, voffB); PG8_STAGE(PG8_SA(1, 0), cA + kstep, voffA); PG8_STAGE(PG8_SB(1, 1), cB + hstep + kstep, voffB);
        PG8_WAIT_V(6); PG8_BAR;
    } else {
        PG8_STAGE(PG8_SB(0, 0), cB, voffB); PG8_STAGE(PG8_SA(0, 0), cA, voffA); PG8_STAGE(PG8_SB(0, 1), cB + hstep, voffB); PG8_STAGE(PG8_SA(0, 1), cA + hstep, voffA);
        if (wr == 1) PG8_BAR;
        PG8_WAIT_V(4); PG8_BAR;
        PG8_STAGE(PG8_SB(1, 0), cB + kstep, voffB); PG8_STAGE(PG8_SA(1, 0), cA + kstep, voffA); PG8_STAGE(PG8_SB(1, 1), cB + hstep + kstep, voffB);
        PG8_WAIT_V(6); PG8_BAR;
    }
    for (;;) {
        const bool has_next = S.next(ui + 1, nxt);
        const char* nA = has_next ? (const char*)g.A + (size_t)nxt.pm * tstep + (size_t)nxt.k0 * kstep : cA; const char* nB = has_next ? (const char*)g.Bt + (size_t)nxt.pn * tstep + (size_t)nxt.k0 * kstep : cB;
        const int nt = cur.nt;
        for (int t = 0; t < nt; t += 2) {
            const bool last = (t == nt - 2);
            const char* a1 = cA + (size_t)(t + 1) * kstep;
            const char* a2 = last ? nA : cA + (size_t)(t + 2) * kstep; const char* b2 = last ? nB : cB + (size_t)(t + 2) * kstep;
            const char* a3 = a2 + kstep; const char* b3 = b2 + kstep;
            if (last && has_next) S.a_ready(nxt);
            if constexpr (SP2) {
            PG8_LDB(B0, 0, 0); PG8_LDB(B1, 0, 1); PG8_SCHED; PG8_LDA(At, 0, 0); PG8_STAGE(PG8_SA(1, 1), a1 + hstep, voffA);
            PG8_WAIT_V(8); PG8_WAIT_L(0); PG8_BAR; PG8_MMA(0, 0, At, B0); PG8_MMA(0, 1, At, B1); PG8_BAR; PG8_SCHED;
            PG8_LDA(At, 0, 1); PG8_STAGE(PG8_SB(0, 0), b2, voffB); PG8_STAGE(PG8_SB(0, 1), b2 + hstep, voffB); PG8_STAGE(PG8_SA(0, 0), a2, voffA);
            PG8_WAIT_V(8); PG8_WAIT_L(0); PG8_BAR; PG8_MMA(1, 0, At, B0); PG8_MMA(1, 1, At, B1); PG8_BAR; PG8_SCHED;
            PG8_LDB(B0, 1, 0); PG8_LDB(B1, 1, 1); PG8_SCHED; PG8_LDA(At, 1, 0); PG8_STAGE(PG8_SA(0, 1), a2 + hstep, voffA);
            PG8_WAIT_V(8); PG8_WAIT_L(0); PG8_BAR; PG8_MMA(0, 0, At, B0); PG8_MMA(0, 1, At, B1); PG8_BAR; PG8_SCHED;
            PG8_LDA(At, 1, 1); PG8_STAGE(PG8_SB(1, 0), b3, voffB); PG8_STAGE(PG8_SB(1, 1), b3 + hstep, voffB); PG8_STAGE(PG8_SA(1, 0), a3, voffA);
            PG8_WAIT_V(8); PG8_WAIT_L(0); PG8_BAR; PG8_MMA(1, 0, At, B0); PG8_MMA(1, 1, At, B1); PG8_BAR; PG8_SCHED;
            } else {
            PG8_LDB(B0, 0, 0); PG8_SCHED; PG8_LDA(At, 0, 0); PG8_STAGE(PG8_SA(1, 1), a1 + hstep, voffA);
            PG8_WAIT_L(8); PG8_BAR; PG8_WAIT_L(0); PG8_MMA(0, 0, At, B0); PG8_BAR; PG8_SCHED;
            PG8_LDB(B1, 0, 1); PG8_STAGE(PG8_SB(0, 0), b2, voffB);
            PG8_BAR; PG8_WAIT_L(0); PG8_MMA(0, 1, At, B1); PG8_BAR;
            PG8_LDA(At, 0, 1); PG8_STAGE(PG8_SA(0, 0), a2, voffA);
            PG8_BAR; PG8_WAIT_L(0); PG8_MMA(1, 0, At, B0); PG8_BAR; PG8_SCHED;
            PG8_STAGE(PG8_SB(0, 1), b2 + hstep, voffB);
            PG8_WAIT_V(6); PG8_BAR; PG8_MMA(1, 1, At, B1); PG8_BAR;
            PG8_LDB(B0, 1, 0); PG8_SCHED; PG8_LDA(At, 1, 0); PG8_STAGE(PG8_SA(0, 1), a2 + hstep, voffA);
            PG8_WAIT_L(8); PG8_BAR; PG8_WAIT_L(0); PG8_MMA(0, 0, At, B0); PG8_BAR; PG8_SCHED;
            PG8_LDB(B1, 1, 1); PG8_STAGE(PG8_SB(1, 0), b3, voffB);
            PG8_BAR; PG8_WAIT_L(0); PG8_MMA(0, 1, At, B1); PG8_BAR;
            PG8_LDA(At, 1, 1); PG8_STAGE(PG8_SA(1, 0), a3, voffA);
            PG8_BAR; PG8_WAIT_L(0); PG8_MMA(1, 0, At, B0); PG8_BAR; PG8_SCHED;
            PG8_STAGE(PG8_SB(1, 1), b3 + hstep, voffB);
            PG8_WAIT_V(6); PG8_BAR; PG8_MMA(1, 1, At, B1); PG8_BAR;
            }
        }
        if constexpr (ALIGN_EPI) { if (wr == 0) PG8_BAR; }
        if constexpr (!Epi::AFTER_DRAIN) { E(acc, cur, wr, wc, fr, fq); S.done(cur); }
        if (!has_next) break;
#pragma unroll
        for (int a = 0; a < 2; ++a)
#pragma unroll
            for (int b = 0; b < 2; ++b)
#pragma unroll
                for (int m = 0; m < 4; ++m)
#pragma unroll
                    for (int n = 0; n < 2; ++n) acc[a][b][m][n] = (f32x4){0.f, 0.f, 0.f, 0.f};
        cur = nxt; cA = nA; cB = nB; ++ui;
        if constexpr (ALIGN_EPI) { if (wr == 1) PG8_BAR; }
    }
    PG8_WAIT_V(0);
    if constexpr (!ALIGN_EPI) { if (wr == 0) PG8_BAR; }
    PG8_BAR;
    if constexpr (Epi::AFTER_DRAIN) { E.fused(acc, cur, wr, wc, fr, fq, lds, wid, lane); S.done(cur); }
#undef PG8_SA
#undef PG8_SB
#undef PG8_STAGE
#undef PG8_LDA
#undef PG8_LDB
#undef PG8_MMA
#undef PG8_WAIT_V
#undef PG8_WAIT_L
#undef PG8_BAR
#undef PG8_SCHED
}
}
#define LAS __attribute__((address_space(3)))
typedef unsigned short bf16;
typedef float f32x4 __attribute__((ext_vector_type(4)));
typedef float f32x16 __attribute__((ext_vector_type(16)));
typedef short bf16x8 __attribute__((ext_vector_type(8)));
typedef short s16x4 __attribute__((ext_vector_type(4)));
typedef unsigned u32x4 __attribute__((ext_vector_type(4)));
typedef unsigned u32x2 __attribute__((ext_vector_type(2)));
constexpr int DM = 2048, SEQ = 4096, NP = 8192, NS = 512, MT = NP + NS, AW = 1024, CC = 1024, INC = 6144, DFF = 5632, PAST = 4096, DSEQ = 64;
constexpr float EPS = 1e-6f;
constexpr size_t OFF_Y = 0, OFF_KP = (size_t)MT * DM, OFF_VP = OFF_KP + (size_t)NP * AW, OFF_CP = OFF_VP + (size_t)NP * AW, OFF_KS = OFF_CP + 2 * 2 * CC,
                 OFF_VS = OFF_KS + (size_t)NS * AW, OFF_CS = OFF_VS + (size_t)NS * AW, OUT_TOTAL = OFF_CS + 8 * 2 * CC;
static_assert(OUT_TOTAL == 35672064, "output size");
constexpr size_t MiB = 1u << 20;
constexpr size_t WS_CTL = 0, WS_WIN = 1 * MiB, WS_WOUT = 25 * MiB, WS_WGU = 33 * MiB, WS_WDN = 77 * MiB, WS_HN = 99 * MiB, WS_Q = 133 * MiB, WS_K = 150 * MiB, WS_V = 166 * MiB,
                 WS_GB = 182 * MiB, WS_U = 199 * MiB, WS_MIX = 216 * MiB, WS_SSQ = 250 * MiB, WS_TP = 251 * MiB, WS_OP = 256 * MiB, WS_H = 256 * MiB, WS_PART = 133 * MiB  ;
constexpr int NSLOT = 256 + 16;
constexpr size_t WS_END = WS_OP + (size_t)NSLOT * 131072;
constexpr int RING_BYTES = 131072, RED_OFF = RING_BYTES, MISC_OFF = RED_OFF + 8192, LDS_BYTES = 147456;
constexpr int NWAVES = 8;

#define XB_TMO      128
#define XB_XCNT(j)  (256  + 64 * (j))
#define XB_XSUB(j)  (1280 + 64 * (j))
#define XB_XGEN(j)  (2304 + 64 * (j))
#define XB_TOP      3328
#define XB_TOPGEN   3392
#define XCD_BAR_WORDS 3456
#define XB_SPIN_CAP (1u << 18)

__device__ __forceinline__ unsigned xb_ld(unsigned* p)              { return __hip_atomic_load(p, __ATOMIC_RELAXED, __HIP_MEMORY_SCOPE_AGENT); }
__device__ __forceinline__ unsigned xb_add(unsigned* p, unsigned v) { return __hip_atomic_fetch_add(p, v, __ATOMIC_RELAXED, __HIP_MEMORY_SCOPE_AGENT); }
__device__ __forceinline__ unsigned xb_xcc_id() { return (unsigned)__builtin_amdgcn_s_getreg((3 << 11) | 20) & 0xFu; }
#define XB_SPIN(cond, bar) do { unsigned _sp = 0; while (cond) { __builtin_amdgcn_s_sleep(1); \
    if ((++_sp & 255u) == 0u) { if (xb_ld(&(bar)[XB_TMO])) break; if (_sp > XB_SPIN_CAP) { atomicAdd(&(bar)[XB_TMO], 1u); break; } } } } while (0)

struct XcdBarrier {
    unsigned* bar; unsigned x;
    volatile LAS unsigned* st;
};

__device__ __forceinline__ XcdBarrier xcd_barrier_post(unsigned* bar, volatile LAS unsigned* st) {
    XcdBarrier b; b.bar = bar; b.x = xb_xcc_id(); b.st = st;
    if (threadIdx.x == 0) (void)xb_add(&bar[XB_XCNT(b.x)], 1u);
    return b;
}
__device__ __forceinline__ void xcd_barrier_complete(unsigned* bar, unsigned x, unsigned& nloc, unsigned& nx) {
    const unsigned G = gridDim.x * gridDim.y * gridDim.z;
    unsigned sum, cnt, mine, sp = 0u;
    for (;;) {
        sum = 0u; cnt = 0u; mine = 0u;
#pragma unroll
        for (unsigned j = 0; j < 16; ++j) { const unsigned c = xb_ld(&bar[XB_XCNT(j)]); sum += c; cnt += (c > 0u) ? 1u : 0u; mine = (j == x) ? c : mine; }
        if (sum == G) break;
        __builtin_amdgcn_s_sleep(1);
        if ((++sp & 255u) == 0u) { if (xb_ld(&bar[XB_TMO])) break; if (sp > XB_SPIN_CAP) { atomicAdd(&bar[XB_TMO], 1u); break; } }
    }
    nloc = mine > 0u ? mine : 1u; nx = cnt > 0u ? cnt : 1u;
}

__device__ __forceinline__ void xcd_barrier(const XcdBarrier& b) {
    asm volatile("s_waitcnt vmcnt(0)" ::: "memory");
    __syncthreads();
    if (threadIdx.x == 0) {
        unsigned* bar = b.bar;
        __builtin_amdgcn_s_waitcnt(0);
        unsigned nloc = b.st[0], nx = b.st[1];
        if (nloc == 0u) { xcd_barrier_complete(bar, b.x, nloc, nx); b.st[0] = nloc; b.st[1] = nx; }
        const unsigned old = xb_add(&bar[XB_XSUB(b.x)], 1u);
        const unsigned gen = old / nloc;
        if (old + 1u == (gen + 1u) * nloc) {
            __builtin_amdgcn_fence(__ATOMIC_RELEASE, "agent");
            asm volatile("s_waitcnt vmcnt(0)" ::: "memory");
            const unsigned og = xb_add(&bar[XB_TOP], 1u);
            const unsigned tg = og / nx;
            if (og + 1u == (tg + 1u) * nx) xb_add(&bar[XB_TOPGEN], 1u);
            else XB_SPIN(xb_ld(&bar[XB_TOPGEN]) == tg, bar);
            __builtin_amdgcn_fence(__ATOMIC_ACQUIRE, "agent");
            xb_add(&bar[XB_XGEN(b.x)], 1u);
            asm volatile("s_waitcnt vmcnt(0)" ::: "memory");
        } else {
            XB_SPIN(xb_ld(&bar[XB_XGEN(b.x)]) == gen, bar);
            __builtin_amdgcn_fence(__ATOMIC_ACQUIRE, "agent");
            asm volatile("s_waitcnt vmcnt(0)" ::: "memory");
        }
    }
    __syncthreads();
}

struct ItemTab { int n; int v[272]; };
constexpr int p_nsteps(int qb, int c) { return 8 * (qb + 1); }
constexpr ItemTab make_items() {
    ItemTab t{}; t.n = 0;
    for (int b = 0; b < 8; ++b) for (int hg = 0; hg < 2; ++hg) t.v[t.n++] = 1 | (b << 1) | (hg << 4);
    for (int qb = 15; qb >= 0; --qb) for (int bh = 0; bh < 16; ++bh) t.v[t.n++] = (bh << 1) | (qb << 5);
    return t;
}
__device__ const ItemTab g_items = make_items();

__device__ __forceinline__ unsigned f2bf(float f) { unsigned u = __builtin_bit_cast(unsigned, f); return (u + 0x7fffu + ((u >> 16) & 1u)) >> 16; }
__device__ __forceinline__ unsigned pk2(float lo, float hi) { return pg8::cvt_pk_bf16(lo, hi); }
__device__ __forceinline__ float bflo(unsigned w) { return __builtin_bit_cast(float, w << 16); }
__device__ __forceinline__ float bfhi(unsigned w) { return __builtin_bit_cast(float, w & 0xffff0000u); }
__device__ __forceinline__ int crow(int r, int hi) { return (r & 3) + 8 * (r >> 2) + 4 * hi; }
__device__ __forceinline__ float wave_sum(float v) {
#pragma unroll
    for (int o = 1; o < 64; o <<= 1) v += __shfl_xor(v, o);
    return v;
}

struct Args { const float* in[17]; float* out; unsigned char* ws; };

struct P0Item { const float* src; const float* gk; bf16* dst; int N, K, k0; };
__device__ __forceinline__ P0Item p0_decode(const Args& a, int it) {
    constexpr int I_IN = 32 * 192, I_OUT = 32 * 64, I_G = 32 * 176;
    unsigned char* ws = a.ws; P0Item r; int n0, kb, drow; r.gk = nullptr;
    if (it < I_IN) { kb = it / 192; n0 = 32 * (it % 192); drow = n0;
        if (n0 >= 5120) { const int ch = n0 - 5120; drow = 4096 + (ch >> 7) * 256 + 128 + (ch & 127); } else if (n0 >= 4096) { const int ch = n0 - 4096; drow = 4096 + (ch >> 7) * 256 + (ch & 127); }
        r.src = a.in[6]; r.N = INC; r.K = DM; r.dst = (bf16*)(ws + WS_WIN); }
    else if ((it -= I_IN) < I_OUT) { kb = it / 64; n0 = 32 * (it % 64); drow = n0; r.src = a.in[12]; r.N = DM; r.K = DM; r.dst = (bf16*)(ws + WS_WOUT); }
    else if ((it -= I_OUT) < 2 * I_G) { const int up = it >= I_G; if (up) it -= I_G; kb = it / 176; n0 = 32 * (it % 176); drow = (n0 >> 7) * 256 + up * 128 + (n0 & 127);
        r.src = a.in[up ? 15 : 14]; r.N = DFF; r.K = DM; r.dst = (bf16*)(ws + WS_WGU); r.gk = a.in[13]; }
    else { it -= 2 * I_G; kb = it / 64; n0 = 32 * (it % 64); drow = n0; r.src = a.in[16]; r.N = DM; r.K = DFF; r.dst = (bf16*)(ws + WS_WDN); }
    r.k0 = 64 * kb; r.src += (size_t)r.k0 * r.N + n0; r.dst += (size_t)drow * r.K + r.k0;
    return r;
}
__device__ __forceinline__ void p0_load(const P0Item& p, f32x4 (&v)[8], int lane) {
#pragma unroll
    for (int j = 0; j < 8; ++j) v[j] = __builtin_nontemporal_load((const f32x4*)(p.src + (size_t)(8 * j + (lane >> 3)) * p.N + 4 * (lane & 7)));
}
__device__ __forceinline__ void p0_finish(const P0Item& p, const f32x4 (&v)[8], LAS float* scr, int lane) {
#pragma unroll
    for (int j = 0; j < 8; ++j) { const int kk = 8 * j + (lane >> 3); const float g = p.gk ? p.gk[p.k0 + kk] : 1.0f; LAS float* s = scr + kk * 33 + 4 * (lane & 7);
        s[0] = v[j][0] * g; s[1] = v[j][1] * g; s[2] = v[j][2] * g; s[3] = v[j][3] * g; }
    asm volatile("s_waitcnt lgkmcnt(0)" ::: "memory");
    const int c = lane & 7;
#pragma unroll
    for (int j = 0; j < 4; ++j) { const int n = (lane >> 3) + 8 * j; const LAS float* s = scr + (8 * c) * 33 + n;
        u32x4 o; o.x = pk2(s[0 * 33], s[1 * 33]); o.y = pk2(s[2 * 33], s[3 * 33]); o.z = pk2(s[4 * 33], s[5 * 33]); o.w = pk2(s[6 * 33], s[7 * 33]);
        *(u32x4*)(p.dst + (size_t)n * p.K + 8 * c) = o; }
    asm volatile("s_waitcnt lgkmcnt(0)" ::: "memory");
}
constexpr int P0_EARLY_ITEMS = 32 * 192 + 32 * 64, P0_ALL_ITEMS = 32 * 192 + 32 * 64 + 2 * 32 * 176 + 88 * 64, P0_CHUNK = 32, P0_LATE_CHUNKS = (P0_ALL_ITEMS - P0_EARLY_ITEMS) / P0_CHUNK;
static_assert((P0_ALL_ITEMS - P0_EARLY_ITEMS) % P0_CHUNK == 0, "late conversion items come in whole chunks");
__device__ __forceinline__ void p0_run_range(const Args& a, LAS float* scr, int first, int n, int lane) {
    f32x4 va[8], vb[8]; P0Item pa, pb;
    pa = p0_decode(a, first); p0_load(pa, va, lane);
    for (int i = 0; i < n; i += 2) {
        if (i + 1 < n) { pb = p0_decode(a, first + i + 1); p0_load(pb, vb, lane); }
        p0_finish(pa, va, scr, lane);
        if (i + 1 >= n) break;
        if (i + 2 < n) { pa = p0_decode(a, first + i + 2); p0_load(pa, va, lane); }
        p0_finish(pb, vb, scr, lane);
    }
}
__device__ __forceinline__ void p0_prologue(const Args& a, LAS unsigned char* lds, int gw, int NGW, int lane, int wave) {
    LAS float* scr = (LAS float*)(lds + wave * 16384);
    unsigned char* ws = a.ws;
    constexpr int NITEMS = P0_EARLY_ITEMS;
    {
        int it = gw; f32x4 va[8], vb[8]; P0Item pa, pb;
        if (it < NITEMS) { pa = p0_decode(a, it); p0_load(pa, va, lane); }
        while (it < NITEMS) {
            const int itb = it + NGW;
            if (itb < NITEMS) { pb = p0_decode(a, itb); p0_load(pb, vb, lane); }
            p0_finish(pa, va, scr, lane);
            it = itb + NGW;
            if (itb >= NITEMS) break;
            if (it < NITEMS) { pa = p0_decode(a, it); p0_load(pa, va, lane); }
            p0_finish(pb, vb, scr, lane);
        }
    }
    const float* g1 = a.in[5];
    f32x4 gv[8];
#pragma unroll
    for (int j = 0; j < 8; ++j) gv[j] = *((const f32x4*)g1 + 64 * j + lane);
    for (int m = gw; m < MT; m += 2 * NGW) {
        const int m2 = m + NGW; const bool has2 = m2 < MT;
        const float* xa = m < NP ? a.in[0] + (size_t)m * DM : a.in[1] + (size_t)(m - NP) * DM;
        const float* xb = has2 ? (m2 < NP ? a.in[0] + (size_t)m2 * DM : a.in[1] + (size_t)(m2 - NP) * DM) : xa;
        f32x4 va[8], vb[8];
#pragma unroll
        for (int j = 0; j < 8; ++j) va[j] = __builtin_nontemporal_load((const f32x4*)xa + 64 * j + lane);
        if (has2) {
#pragma unroll
            for (int j = 0; j < 8; ++j) vb[j] = __builtin_nontemporal_load((const f32x4*)xb + 64 * j + lane);
        }
        {
            float s = 0.f;
#pragma unroll
            for (int j = 0; j < 8; ++j) s += (va[j][0] * va[j][0] + va[j][1] * va[j][1]) + (va[j][2] * va[j][2] + va[j][3] * va[j][3]);
            const float rs = __builtin_amdgcn_rsqf(wave_sum(s) * (1.0f / DM) + EPS);
            u32x2* o = (u32x2*)((bf16*)(ws + WS_HN) + (size_t)m * DM) + lane;
#pragma unroll
            for (int j = 0; j < 8; ++j) { u32x2 w; w.x = pk2(va[j][0] * rs * gv[j][0], va[j][1] * rs * gv[j][1]); w.y = pk2(va[j][2] * rs * gv[j][2], va[j][3] * rs * gv[j][3]); o[64 * j] = w; }
        }
        if (has2) {
            float s = 0.f;
#pragma unroll
            for (int j = 0; j < 8; ++j) s += (vb[j][0] * vb[j][0] + vb[j][1] * vb[j][1]) + (vb[j][2] * vb[j][2] + vb[j][3] * vb[j][3]);
            const float rs = __builtin_amdgcn_rsqf(wave_sum(s) * (1.0f / DM) + EPS);
            u32x2* o = (u32x2*)((bf16*)(ws + WS_HN) + (size_t)m2 * DM) + lane;
#pragma unroll
            for (int j = 0; j < 8; ++j) { u32x2 w; w.x = pk2(vb[j][0] * rs * gv[j][0], vb[j][1] * rs * gv[j][1]); w.y = pk2(vb[j][2] * rs * gv[j][2], vb[j][3] * rs * gv[j][3]); o[64 * j] = w; }
        }
    }
}


template <int VS, bool QREG>
__device__ __forceinline__ void sb_block(f32x16 (&o)[4], float& R, const LAS unsigned char* kp, const LAS unsigned char* vp, const bf16x8 (&qreg)[8], const LAS unsigned char* qlp, int kb, int qw, int qpos, int hi) {
            f32x16 p;
#pragma unroll
            for (int r = 0; r < 16; ++r) p[r] = 0.f;
#pragma unroll
            for (int d0 = 0; d0 < 8; ++d0) { const bf16x8 kf = *(const LAS bf16x8*)(kp + d0 * 32); const bf16x8 qf = QREG ? qreg[d0] : *(const LAS bf16x8*)(qlp + d0 * 32); p = __builtin_amdgcn_mfma_f32_32x32x16_bf16(kf, qf, p, 0, 0, 0); }
            const bool need_mask = (kb + 31 >= qw);
            float e[16], sf[16];
#pragma unroll
            for (int r = 0; r < 16; ++r) {
                const float z = fminf(p[r], 100.f); float ee = __builtin_amdgcn_exp2f(z); float rr = __builtin_amdgcn_rcpf(1.0f + ee);
                if (need_mask) { const bool msk = (kb + crow(r, hi)) >= qpos; ee = msk ? 0.f : ee; rr = msk ? 1.f : rr; }
                e[r] = ee; sf[r] = rr;
            }
            float oth[4], PP[4];
#pragma unroll
            for (int g = 0; g < 4; ++g) { sf[4 * g + 2] *= sf[4 * g + 3]; sf[4 * g + 1] *= sf[4 * g + 2]; sf[4 * g] *= sf[4 * g + 1]; oth[g] = __shfl_xor(sf[4 * g], 32); PP[g] = sf[4 * g] * oth[g]; }
            const float SP3 = PP[3], SP2 = PP[2] * SP3, SP1 = PP[1] * SP2, SP0 = PP[0] * SP1;
            float A[4]; A[0] = R * SP1; A[1] = R * SP2; A[2] = R * SP3; A[3] = R;
#pragma unroll
            for (int g = 0; g < 4; ++g) A[g] = hi ? A[g] : A[g] * oth[g];
            R *= SP0;
            float w[16];
#pragma unroll
            for (int r = 0; r < 16; ++r) w[r] = (e[r] * sf[r]) * A[r >> 2];
#pragma unroll
            for (int s2 = 0; s2 < 2; ++s2) {
                u32x4 pw; pw.x = pk2(w[8 * s2 + 0], w[8 * s2 + 1]); pw.y = pk2(w[8 * s2 + 2], w[8 * s2 + 3]); pw.z = pk2(w[8 * s2 + 4], w[8 * s2 + 5]); pw.w = pk2(w[8 * s2 + 6], w[8 * s2 + 7]);
                const bf16x8 pa = __builtin_bit_cast(bf16x8, pw);
#pragma unroll
                for (int db = 0; db < 4; ++db) {
                    const s16x4 lo = __builtin_bit_cast(s16x4, __builtin_amdgcn_ds_read_tr16_b64_v4i16((LAS s16x4*)(vp + (16 * s2) * VS + db * 64)));
                    const s16x4 hh = __builtin_bit_cast(s16x4, __builtin_amdgcn_ds_read_tr16_b64_v4i16((LAS s16x4*)(vp + (16 * s2 + 8) * VS + db * 64)));
                    const bf16x8 vb = __builtin_shufflevector(lo, hh, 0, 1, 2, 3, 4, 5, 6, 7);
                    o[db] = __builtin_amdgcn_mfma_f32_32x32x16_bf16(pa, vb, o[db], 0, 0, 0);
                }
            }
}

template <bool SAMPLE>
__device__ __forceinline__ void attn_item(const Args& a, LAS unsigned char* lds, int code) {
    constexpr int NH = SAMPLE ? 4 : 1, KS = NH * 256 + 16, VS = NH * 256 + 32, K_OFF = 0, V_OFF = 32 * KS;
    int tid_ = threadIdx.x; asm volatile("" : "+v"(tid_));
    const int tid = tid_, lane = tid & 63, r32 = lane & 31, hi = lane >> 5; const int wid = __builtin_amdgcn_readfirstlane(tid >> 6);
    unsigned char* ws = a.ws;
    int slot, nsteps, kvpos0, qw, head, hl; size_t qrow;
    const bf16 *kgb = nullptr, *vgb = nullptr; const float *kgf = nullptr, *vgf = nullptr, *kgn = nullptr, *vgn = nullptr;
    if (SAMPLE) {
        const int b = (code >> 1) & 7, hg = (code >> 4) & 1;
        slot = 256 + b * 2 + hg; hl = wid >> 1; head = hg * 4 + hl; const int rg = wid & 1;
        qw = PAST + 32 * rg; qrow = (size_t)NP + b * DSEQ + 32 * rg + r32;
        nsteps = 130; kvpos0 = 0;
        kgf = a.in[2] + ((size_t)b * PAST + (tid >> 7)) * AW + hg * 512 + 4 * (tid & 127); vgf = a.in[3] + ((size_t)b * PAST + (tid >> 7)) * AW + hg * 512 + 4 * (tid & 127);
        kgn = a.out + OFF_KS + ((size_t)b * DSEQ + (tid >> 7)) * AW + hg * 512 + 4 * (tid & 127); vgn = a.out + OFF_VS + ((size_t)b * DSEQ + (tid >> 7)) * AW + hg * 512 + 4 * (tid & 127);
    } else {
        const int bh = (code >> 1) & 15, qb = (code >> 5) & 15, c = (code >> 9) & 3, b = bh >> 3;
        head = bh & 7; hl = 0; slot = bh * 16 + qb + 0 * c; nsteps = p_nsteps(qb, c); kvpos0 = 0;
        qw = qb * 256 + 32 * wid; qrow = (size_t)b * SEQ + qw + r32;
        kgb = (const bf16*)(ws + WS_K) + ((size_t)b * SEQ + kvpos0 + (tid >> 4)) * AW + head * 128 + (tid & 15) * 8;
        vgb = (const bf16*)(ws + WS_V) + ((size_t)b * SEQ + kvpos0 + (tid >> 4)) * AW + head * 128 + (tid & 15) * 8;
    }
    const int qpos = qw + r32;
    constexpr int Q_OFF = 67584, QS = 272;
    const LAS unsigned char* qlp = lds + Q_OFF + wid * (32 * QS) + r32 * QS + hi * 16;
    { const bf16* qp = (const bf16*)(ws + WS_Q) + qrow * AW + head * 128 + hi * 8;
#pragma unroll
      for (int d0 = 0; d0 < 8; ++d0) *(LAS bf16x8*)(lds + Q_OFF + wid * (32 * QS) + r32 * QS + hi * 16 + d0 * 32) = *(const bf16x8*)(qp + 16 * d0); }
    f32x16 o[4];
#pragma unroll
    for (int i = 0; i < 4; ++i)
#pragma unroll
        for (int r = 0; r < 16; ++r) o[i][r] = 0.f;
    float R = 1.f;
    u32x4 kreg, vreg; f32x4 kf4[8], vf4[8];
#define ATT_LOADK(s_) do { if (SAMPLE) { _Pragma("unroll") for (int i_ = 0; i_ < 8; ++i_) kf4[i_] = *(const f32x4*)(((s_) >= 128 ? kgn + (size_t)((s_) - 128) * 32 * AW : kgf + (size_t)(s_) * 32 * AW) + (size_t)i_ * 4 * AW); } \
        else { kreg = *(const u32x4*)(kgb + (size_t)(s_) * 32 * AW); } } while (0)
#define ATT_LOADV(s_) do { if (SAMPLE) { _Pragma("unroll") for (int i_ = 0; i_ < 8; ++i_) vf4[i_] = *(const f32x4*)(((s_) >= 128 ? vgn + (size_t)((s_) - 128) * 32 * AW : vgf + (size_t)(s_) * 32 * AW) + (size_t)i_ * 4 * AW); } \
        else { vreg = *(const u32x4*)(vgb + (size_t)(s_) * 32 * AW); } } while (0)
#define ATT_STOREK() do { if (SAMPLE) { _Pragma("unroll") for (int i_ = 0; i_ < 8; ++i_) { const int key_ = (tid >> 7) + 4 * i_, f4_ = tid & 127; \
            u32x2 kw_; kw_.x = pk2(kf4[i_][0], kf4[i_][1]); kw_.y = pk2(kf4[i_][2], kf4[i_][3]); *(LAS u32x2*)(lds + K_OFF + key_ * KS + f4_ * 8) = kw_; } } \
        else { *(LAS u32x4*)(lds + K_OFF + (tid >> 4) * KS + (tid & 15) * 16) = kreg; } } while (0)
#define ATT_STOREV() do { if (SAMPLE) { _Pragma("unroll") for (int i_ = 0; i_ < 8; ++i_) { const int key_ = (tid >> 7) + 4 * i_, f4_ = tid & 127; \
            u32x2 vw_; vw_.x = pk2(vf4[i_][0], vf4[i_][1]); vw_.y = pk2(vf4[i_][2], vf4[i_][3]); *(LAS u32x2*)(lds + V_OFF + key_ * VS + f4_ * 8) = vw_; } } \
        else { *(LAS u32x4*)(lds + V_OFF + (tid >> 4) * VS + (tid & 15) * 16) = vreg; } } while (0)
    volatile LAS int* flg = (volatile LAS int*)(lds + MISC_OFF + 64);
    ATT_LOADK(nsteps - 1); ATT_LOADV(nsteps - 1);
    ATT_STOREK(); ATT_STOREV();
    __syncthreads();
    const LAS unsigned char* kp = lds + K_OFF + r32 * KS + hl * 256 + hi * 16;
    const LAS unsigned char* vp = lds + V_OFF + (4 * hi + ((lane & 15) >> 2)) * VS + hl * 256 + (16 * ((lane >> 4) & 1) + 4 * (lane & 3)) * 2;
    for (int s = nsteps - 1; s >= 0; --s) {
        if (s > 0) { ATT_LOADK(s - 1); if (!SAMPLE) ATT_LOADV(s - 1); }
        const int kb = kvpos0 + 32 * s;
        if (kb < qw + 32 && !__all(R == 0.f)) { const bf16x8 qdummy[8] = {}; sb_block<VS, false>(o, R, kp, vp, qdummy, qlp, kb, qw, qpos, hi); }
        if (lane == 0) flg[wid] = __all(R == 0.f) ? 1 : 0;
        __syncthreads();
        const bool alldone = (flg[0] & flg[1] & flg[2] & flg[3] & flg[4] & flg[5] & flg[6] & flg[7]) != 0;
        if (alldone) { __syncthreads(); break; }
        if (s > 0) { ATT_STOREK(); if (SAMPLE) ATT_LOADV(s - 1); ATT_STOREV(); }
        __syncthreads();
    }
#undef ATT_LOADK
#undef ATT_LOADV
#undef ATT_STOREK
#undef ATT_STOREV
    float* op = (float*)(ws + WS_OP) + ((size_t)(slot * 8 + wid) * 32) * 128;
#pragma unroll
    for (int db = 0; db < 4; ++db)
#pragma unroll
        for (int r = 0; r < 16; ++r) op[crow(r, hi) * 128 + db * 32 + r32] = o[db][r];
    if (hi == 0) ((float*)(ws + WS_TP))[(slot * 8 + wid) * 32 + r32] = R;
}


__device__ __forceinline__ void attn_item_p(const Args& a, LAS unsigned char* lds, int code) {
    constexpr int KS = 272, VS = 288, TILE_K = 64 * KS, BUF = TILE_K + 64 * VS;
    int tid_ = threadIdx.x; asm volatile("" : "+v"(tid_));
    const int tid = tid_, lane = tid & 63, r32 = lane & 31, hi = lane >> 5; const int wid = __builtin_amdgcn_readfirstlane(tid >> 6);
    unsigned char* ws = a.ws;
    const int bh = (code >> 1) & 15, qb = (code >> 5) & 15, c = (code >> 9) & 3, b = bh >> 3, head = bh & 7;
    const int slot = bh * 16 + qb + 0 * c, nst = p_nsteps(qb, c) >> 1, kvpos0 = 0;
    const int qw = qb * 256 + 32 * wid, qpos = qw + r32; const size_t qrow = (size_t)b * SEQ + qpos;
    const bf16* kgb = (const bf16*)(ws + WS_K) + ((size_t)b * SEQ + kvpos0 + (tid >> 4)) * AW + head * 128 + (tid & 15) * 8;
    const bf16* vgb = (const bf16*)(ws + WS_V) + ((size_t)b * SEQ + kvpos0 + (tid >> 4)) * AW + head * 128 + (tid & 15) * 8;
    bf16x8 qf[8];
    { const bf16* qp = (const bf16*)(ws + WS_Q) + qrow * AW + head * 128 + hi * 8;
#pragma unroll
      for (int d0 = 0; d0 < 8; ++d0) qf[d0] = *(const bf16x8*)(qp + 16 * d0); }
    f32x16 o[4];
#pragma unroll
    for (int i = 0; i < 4; ++i)
#pragma unroll
        for (int r = 0; r < 16; ++r) o[i][r] = 0.f;
    float R = 1.f;
    u32x4 kreg[2], vreg[2];
#define PLOAD(s_) do { _Pragma("unroll") for (int i_ = 0; i_ < 2; ++i_) { kreg[i_] = *(const u32x4*)(kgb + (size_t)((s_) * 64 + 32 * i_) * AW); vreg[i_] = *(const u32x4*)(vgb + (size_t)((s_) * 64 + 32 * i_) * AW); } } while (0)
#define PSTORE(buf_) do { _Pragma("unroll") for (int i_ = 0; i_ < 2; ++i_) { *(LAS u32x4*)(lds + (buf_) * BUF + ((tid >> 4) + 32 * i_) * KS + (tid & 15) * 16) = kreg[i_]; \
        *(LAS u32x4*)(lds + (buf_) * BUF + TILE_K + ((tid >> 4) + 32 * i_) * VS + (tid & 15) * 16) = vreg[i_]; } } while (0)
    volatile LAS int* flg = (volatile LAS int*)(lds + MISC_OFF + 64);
    PLOAD(nst - 1);
    PSTORE(0);
    __syncthreads();
    const LAS unsigned char* kp = lds + r32 * KS + hi * 16;
    const LAS unsigned char* vp = lds + TILE_K + (4 * hi + ((lane & 15) >> 2)) * VS + (16 * ((lane >> 4) & 1) + 4 * (lane & 3)) * 2;
    int cur = 0;
    for (int s = nst - 1; s >= 0; --s) {
        if (s > 0) PLOAD(s - 1);
#pragma unroll
        for (int blk = 1; blk >= 0; --blk) {
            const int kb = kvpos0 + 64 * s + 32 * blk;
            if (kb < qw + 32 && !__all(R == 0.f)) sb_block<VS, true>(o, R, kp + cur * BUF + blk * 32 * KS, vp + cur * BUF + blk * 32 * VS, qf, kp, kb, qw, qpos, hi);
        }
        volatile LAS int* fl = flg + 8 * (s & 1);
        if (lane == 0) fl[wid] = __all(R == 0.f) ? 1 : 0;
        if (s > 0) PSTORE(cur ^ 1);
        __syncthreads();
        if ((fl[0] & fl[1] & fl[2] & fl[3] & fl[4] & fl[5] & fl[6] & fl[7]) != 0) break;
        cur ^= 1;
    }
#undef PLOAD
#undef PSTORE
    float* op = (float*)(ws + WS_OP) + ((size_t)(slot * 8 + wid) * 32) * 128;
#pragma unroll
    for (int db = 0; db < 4; ++db)
#pragma unroll
        for (int r = 0; r < 16; ++r) op[crow(r, hi) * 128 + db * 32 + r32] = o[db][r];
    if (hi == 0) ((float*)(ws + WS_TP))[(slot * 8 + wid) * 32 + r32] = R;
}

struct MixRow { int m, t; const float* st; f32x4 op[4]; u32x4 u2[2], u1[2], u0[2], gb[2]; };
__device__ __forceinline__ void mix_load(const Args& a, MixRow& R, int m, int lane) {
    unsigned char* ws = a.ws;
    const float* OP = (const float*)(ws + WS_OP); const bf16* U = (const bf16*)(ws + WS_U); const bf16* GB = (const bf16*)(ws + WS_GB);
    const int h = lane >> 3, d0 = (lane & 7) * 16, c0 = lane * 16;
    int slot0, wid, q;
    if (m < NP) { const int b = m >> 12, t = m & 4095, qb = t >> 8; wid = (t & 255) >> 5; q = t & 31; slot0 = (b * 8 + h) * 16 + qb; R.t = t; R.st = nullptr; }
    else { const int r = m - NP, b = r >> 6, t = r & 63, rg = t >> 5; q = t & 31; wid = (h & 3) * 2 + rg; slot0 = 256 + b * 2 + (h >> 2); R.t = t; R.st = a.in[4] + (size_t)b * 2 * CC; }
    R.m = m;
    const f32x4* p = (const f32x4*)(OP + ((size_t)(slot0 * 8 + wid) * 32 + q) * 128 + d0);
#pragma unroll
    for (int i = 0; i < 4; ++i) R.op[i] = p[i];
    { const u32x4* pu = (const u32x4*)(U + (size_t)m * CC + c0); R.u2[0] = pu[0]; R.u2[1] = pu[1]; }
    if (R.t >= 1) { const u32x4* pu = (const u32x4*)(U + (size_t)(m - 1) * CC + c0); R.u1[0] = pu[0]; R.u1[1] = pu[1]; }
    if (R.t >= 2) { const u32x4* pu = (const u32x4*)(U + (size_t)(m - 2) * CC + c0); R.u0[0] = pu[0]; R.u0[1] = pu[1]; }
    { const u32x4* pg = (const u32x4*)(GB + (size_t)m * CC + c0); R.gb[0] = pg[0]; R.gb[1] = pg[1]; }
}
__device__ __forceinline__ void unpack16(const u32x4 (&x)[2], float (&o)[16]) {
    const unsigned ww[8] = {x[0].x, x[0].y, x[0].z, x[0].w, x[1].x, x[1].y, x[1].z, x[1].w};
#pragma unroll
    for (int i = 0; i < 8; ++i) { o[2 * i] = bflo(ww[i]); o[2 * i + 1] = bfhi(ww[i]); }
}
__device__ __forceinline__ void mix_finish(const Args& a, const MixRow& R, const float (&ga16)[16], const float (&gc16)[16], const float (&w0c)[16], const float (&w1c)[16], const float (&w2c)[16], int lane) {
    bf16* MIX = (bf16*)(a.ws + WS_MIX);
    const int h = lane >> 3, d0 = (lane & 7) * 16, c0 = lane * 16, m = R.m;
    float s = 0.f;
#pragma unroll
    for (int i = 0; i < 4; ++i) s += (R.op[i][0] * R.op[i][0] + R.op[i][1] * R.op[i][1]) + (R.op[i][2] * R.op[i][2] + R.op[i][3] * R.op[i][3]);
    float rs = __builtin_amdgcn_rsqf(wave_sum(s) * (1.0f / AW) + EPS);
    { unsigned ww[8];
#pragma unroll
      for (int i = 0; i < 8; ++i) ww[i] = pk2(R.op[i >> 1][(2 * i) & 3] * rs * ga16[2 * i], R.op[i >> 1][(2 * i + 1) & 3] * rs * ga16[2 * i + 1]);
      u32x4 w0, w1; w0.x = ww[0]; w0.y = ww[1]; w0.z = ww[2]; w0.w = ww[3]; w1.x = ww[4]; w1.y = ww[5]; w1.z = ww[6]; w1.w = ww[7];
      u32x4* o = (u32x4*)(MIX + (size_t)m * DM + h * 128 + d0); o[0] = w0; o[1] = w1; }
    float u0[16], u1[16], u2[16], gbv[16];
    unpack16(R.u2, u2); unpack16(R.gb, gbv);
    if (R.t >= 1) unpack16(R.u1, u1); else {
#pragma unroll
        for (int i = 0; i < 16; ++i) u1[i] = R.st ? R.st[CC + c0 + i] : 0.f; }
    if (R.t >= 2) unpack16(R.u0, u0); else {
#pragma unroll
        for (int i = 0; i < 16; ++i) u0[i] = R.st ? R.st[(R.t == 0 ? 0 : CC) + c0 + i] : 0.f; }
    float oc[16]; float s2 = 0.f;
#pragma unroll
    for (int i = 0; i < 16; ++i) { oc[i] = gbv[i] * (w0c[i] * u0[i] + w1c[i] * u1[i] + w2c[i] * u2[i]); s2 += oc[i] * oc[i]; }
    rs = __builtin_amdgcn_rsqf(wave_sum(s2) * (1.0f / CC) + EPS);
    { unsigned ww[8];
#pragma unroll
      for (int i = 0; i < 8; ++i) ww[i] = pk2(oc[2 * i] * rs * gc16[2 * i], oc[2 * i + 1] * rs * gc16[2 * i + 1]);
      u32x4 w0, w1; w0.x = ww[0]; w0.y = ww[1]; w0.z = ww[2]; w0.w = ww[3]; w1.x = ww[4]; w1.y = ww[5]; w1.z = ww[6]; w1.w = ww[7];
      u32x4* o = (u32x4*)(MIX + (size_t)m * DM + AW + c0); o[0] = w0; o[1] = w1; }
}
__device__ __forceinline__ void mix_rows(const Args& a, int gw, int NGW, int lane) {
    const float* cw = a.in[9]; const float* ga = a.in[10]; const float* gc = a.in[11];
    const int h = lane >> 3, d0 = (lane & 7) * 16, c0 = lane * 16;
    float ga16[16], gc16[16], w0c[16], w1c[16], w2c[16];
#pragma unroll
    for (int i = 0; i < 4; ++i) {
        const f32x4 x0 = *(const f32x4*)(ga + h * 128 + d0 + 4 * i), x1 = *(const f32x4*)(gc + c0 + 4 * i), x2 = *(const f32x4*)(cw + c0 + 4 * i), x3 = *(const f32x4*)(cw + CC + c0 + 4 * i), x4 = *(const f32x4*)(cw + 2 * CC + c0 + 4 * i);
#pragma unroll
        for (int j = 0; j < 4; ++j) { ga16[4 * i + j] = x0[j]; gc16[4 * i + j] = x1[j]; w0c[4 * i + j] = x2[j]; w1c[4 * i + j] = x3[j]; w2c[4 * i + j] = x4[j]; }
    }
    for (int m = gw; m < MT; m += 2 * NGW) {
        MixRow A, B; const bool hasB = m + NGW < MT;
        mix_load(a, A, m, lane);
        if (hasB) mix_load(a, B, m + NGW, lane);
        mix_finish(a, A, ga16, gc16, w0c, w1c, w2c, lane);
        if (hasB) mix_finish(a, B, ga16, gc16, w0c, w1c, w2c, lane);
    }
}
#ifndef NCONV
#define NCONV 96
#endif
#ifndef REP_P0
#define REP_P0 1
#endif
#ifndef REP_P1
#define REP_P1 1
#endif
#ifndef REP_P3
#define REP_P3 1
#endif
#ifndef REP_P4
#define REP_P4 1
#endif
#ifndef REP_P5
#define REP_P5 1
#endif
__global__ void __launch_bounds__(NWAVES * 64, 2) fwd_megakernel(Args args) {
    extern __shared__ __attribute__((aligned(16))) unsigned char lds_raw[];
    cg::grid_group grid = cg::this_grid();
    LAS unsigned char* lds = (LAS unsigned char*)lds_raw;
    const int G = gridDim.x, bx = blockIdx.x, NGW = G * NWAVES;
#define PHASE_IDS() int tid = threadIdx.x; asm volatile("" : "+v"(tid)); const int lane = tid & 63; const int wave = __builtin_amdgcn_readfirstlane(tid >> 6); const int gw = bx * NWAVES + wave; (void)lane; (void)gw
    unsigned char* ws = args.ws;
    unsigned* ctl = (unsigned*)(ws + WS_CTL);
    LAS float* red = (LAS float*)(lds + RED_OFF);
    volatile LAS int* misc = (volatile LAS int*)(lds + MISC_OFF);

    { PHASE_IDS(); if (bx == 0 && tid == 0) { ctl[0] = 0u; ctl[64] = 0u; ctl[256] = 0u; for (int i = 0; i < 16; ++i) ctl[1024 + 64 * i] = 0u; }
      if (bx == 0) for (int i = tid; i < XCD_BAR_WORDS; i += NWAVES * 64) ctl[4096 + i] = 0u;
      if (tid < 2) misc[8 + tid] = 0;
#ifndef NO_P0
    for (int rep_ = 0; rep_ < REP_P0; ++rep_) p0_prologue(args, lds, gw, NGW, lane, wave);
#endif
    }
    grid.sync();
    XcdBarrier xbar = xcd_barrier_post(ctl + 4096, (volatile LAS unsigned*)(lds + MISC_OFF) + 8);
    int vid = bx;
    if (G == 256) {
        if (threadIdx.x == 0) { const unsigned xcc = xb_xcc_id() & 7u; const unsigned r = atomicAdd(ctl + 1024 + 64 * xcc, 1u); misc[1] = (r < 32u) ? (int)(r * 8u + xcc) : -1; }
        __syncthreads();
        const int v = misc[1];
        __syncthreads();
        if (v >= 0) vid = v;
    }

#ifndef NO_P1
    for (int rep_ = 0; rep_ < REP_P1; ++rep_) {
        pg8::Gemm g{(const pg8::bf16_t*)(ws + WS_HN), (const pg8::bf16_t*)(ws + WS_WIN), MT, INC, DM}; typedef pg8::InProjOrder Ord; Ord S; S.init(G, vid);
        pg8::EpiIn E{(bf16*)(ws + WS_Q), (bf16*)(ws + WS_K), (bf16*)(ws + WS_V), (bf16*)(ws + WS_GB), (bf16*)(ws + WS_U), args.out, args.in[7], args.in[8], red,
                     1.4426950408889634f * 0.08838834764831845f, OFF_KP, OFF_VP, OFF_CP, OFF_KS, OFF_VS, OFF_CS};
        pg8::gemm_phase<pg8::EpiIn, Ord, true, true>(lds, g, S, E);
    }
#endif
    xcd_barrier(xbar);

#ifndef NO_P2
    {
        const int nitems = g_items.n;
        PHASE_IDS();
#ifdef DUP_P2
        for (int rep = 0; rep < 2; ++rep)
#else
        const int rep = 0;
#endif
        for (;;) {
            if (tid == 0) misc[0] = (int)atomicAdd(ctl + 64 * rep, 1u);
            __syncthreads();
            int it = misc[0];
            __syncthreads();
            if (it < 48) {
                pg8::Gemm g{(const pg8::bf16_t*)(ws + WS_HN), (const pg8::bf16_t*)(ws + WS_WIN), MT, INC, DM};
                pg8::OneUnit S1; S1.u0.pm = 30 + (it & 3); S1.u0.pn = 12 + (it >> 2); S1.u0.k0 = 0; S1.u0.nt = 32; S1.u0.split = 0; S1.u0.tu = 0; S1.u0.sp = 0;
                pg8::EpiIn E{(bf16*)(ws + WS_Q), (bf16*)(ws + WS_K), (bf16*)(ws + WS_V), (bf16*)(ws + WS_GB), (bf16*)(ws + WS_U), args.out, args.in[7], args.in[8], red,
                             1.4426950408889634f * 0.08838834764831845f, OFF_KP, OFF_VP, OFF_CP, OFF_KS, OFF_VS, OFF_CS};
                pg8::gemm_phase<pg8::EpiIn, pg8::OneUnit, true, true>(lds, g, S1, E);
                __syncthreads();
                continue;
            }
            it -= 48;
            const bool token = it >= 16 && it < 16 + NCONV;
            if (token || it >= nitems + NCONV) {
                for (;;) {
                    if (tid == 0) misc[0] = (int)atomicAdd(ctl + 256, 1u);
                    __syncthreads();
                    const int ch = misc[0];
                    __syncthreads();
                    if (ch >= P0_LATE_CHUNKS) break;
                    p0_run_range(args, (LAS float*)(lds + wave * 16384), P0_EARLY_ITEMS + ch * P0_CHUNK + wave * (P0_CHUNK / NWAVES), P0_CHUNK / NWAVES, lane);
                }
                if (token) continue;
                break;
            }
            if (it >= 16) it -= NCONV;
            const int code = g_items.v[it];
#if defined(ONLY_S)
            attn_item<true>(args, lds, code);
#elif defined(ONLY_P)
            attn_item_p(args, lds, code);
#else
            if (code & 1) attn_item<true>(args, lds, code); else attn_item_p(args, lds, code);
#endif
        }
    }
#endif
    xcd_barrier(xbar);

#ifndef NO_P3
    for (int rep_ = 0; rep_ < REP_P3; ++rep_) { PHASE_IDS(); mix_rows(args, gw, NGW, lane); }
#endif
    xcd_barrier(xbar);

#ifndef NO_P4
    for (int rep_ = 0; rep_ < REP_P4; ++rep_) {
        pg8::Gemm g{(const pg8::bf16_t*)(ws + WS_MIX), (const pg8::bf16_t*)(ws + WS_WOUT), MT, DM, DM}; typedef pg8::TailOrderT<MT / 256, DM / 256, DM / 64, 8> Ord; Ord S; S.init(G, vid);
        pg8::EpiOut E{args.in[0], args.in[1], args.out + OFF_Y, (bf16*)(ws + WS_HN), (float*)(ws + WS_SSQ), red, (float*)(ws + WS_PART)};
        pg8::gemm_phase<pg8::EpiOut, Ord, true, true>(lds, g, S, E);
        if (S.rem > 0) {
            xcd_barrier(xbar);
            PHASE_IDS();
            for (int w = gw; w < S.rem * 256; w += NGW) {
                const int tu = w >> 8, r = w & 255; pg8::Unit u; Ord::SO::unit(S.full * G + tu, u);
                const size_t row = (size_t)u.pm * 256 + r; const int col = u.pn * 256 + 4 * lane;
                const float* xin = row < NP ? args.in[0] + row * DM : args.in[1] + (row - NP) * DM;
                f32x4 v = *(const f32x4*)(xin + col);
                const float* p = (const float*)(ws + WS_PART) + (size_t)(tu * 8) * 65536 + r * 256 + 4 * lane;
#pragma unroll
                for (int s = 0; s < 8; ++s) v += *(const f32x4*)(p + (size_t)s * 65536);
                *(f32x4*)(args.out + OFF_Y + row * DM + col) = v;
                u32x2 pk; pk.x = pk2(v[0], v[1]); pk.y = pk2(v[2], v[3]); *(u32x2*)((bf16*)(ws + WS_HN) + row * DM + col) = pk;
                const float ss = wave_sum((v[0] * v[0] + v[1] * v[1]) + (v[2] * v[2] + v[3] * v[3]));
                if (lane == 0) ((float*)(ws + WS_SSQ))[row * 8 + u.pn] = ss;
            }
        }
    }
#endif
    xcd_barrier(xbar);

#ifndef NO_P5
    for (int rep_ = 0; rep_ < REP_P5; ++rep_) {
        pg8::Gemm g{(const pg8::bf16_t*)(ws + WS_HN), (const pg8::bf16_t*)(ws + WS_WGU), MT, 2 * DFF, DM}; typedef pg8::StaticOrderT<MT / 256, 2 * DFF / 256, DM / 64> Ord; Ord S; S.init(G, vid);
        pg8::EpiGU E{(bf16*)(ws + WS_H), (const float*)(ws + WS_SSQ)};
        pg8::gemm_phase<pg8::EpiGU, Ord, true, true>(lds, g, S, E);
    }
#endif
    xcd_barrier(xbar);

#ifndef NO_P6
    {
        pg8::Gemm g{(const pg8::bf16_t*)(ws + WS_H), (const pg8::bf16_t*)(ws + WS_WDN), MT, DM, DFF};
        typedef pg8::TailOrderT<MT / 256, DM / 256, DFF / 64, 8> Ord; Ord S; S.init(G, vid);
        pg8::EpiDown E{args.out + OFF_Y, (float*)(ws + WS_PART), (const pg8::bf16_t*)(ws + WS_HN)};
        pg8::gemm_phase<pg8::EpiDown, Ord, true, true>(lds, g, S, E);
        if (S.rem > 0) {
            xcd_barrier(xbar);
            PHASE_IDS();
            for (int w = gw; w < S.rem * 256; w += NGW) {
                const int tu = w >> 8, r = w & 255; pg8::Unit u; Ord::SO::unit(S.full * G + tu, u);
                float* y = args.out + OFF_Y + ((size_t)u.pm * 256 + r) * DM + u.pn * 256 + 4 * lane;
                f32x4 v = *(const f32x4*)y;
                const float* p = (const float*)(ws + WS_PART) + (size_t)(tu * 8) * 65536 + r * 256 + 4 * lane;
#pragma unroll
                for (int s = 0; s < 8; ++s) v += *(const f32x4*)(p + (size_t)s * 65536);
                *(f32x4*)y = v;
            }
        }
    }
#endif
}

extern "C" void kernel_launch(void* const* d_in, const int* in_sizes, int n_in, void* d_out, int out_size, void* d_ws, size_t ws_size, hipStream_t stream) {
    static int grid = 0;
    if (grid == 0) {
        if (n_in != 17 || (size_t)out_size != OUT_TOTAL || ws_size < WS_END) { fprintf(stderr, "kernel_launch: unexpected shapes (n_in %d out %d ws %zu need %zu)\n", n_in, out_size, ws_size, (size_t)WS_END); grid = -1; return; }
        int dev = 0, cus = 0, per_cu = 0;
        hipGetDevice(&dev); hipDeviceGetAttribute(&cus, hipDeviceAttributeMultiprocessorCount, dev);
        hipFuncSetAttribute((const void*)fwd_megakernel, hipFuncAttributeMaxDynamicSharedMemorySize, LDS_BYTES);
        hipOccupancyMaxActiveBlocksPerMultiprocessor(&per_cu, (const void*)fwd_megakernel, NWAVES * 64, LDS_BYTES);
        if (per_cu < 1) { fprintf(stderr, "kernel_launch: occupancy query says %d blocks per CU\n", per_cu); per_cu = 1; }
        (void)hipGetLastError();
        grid = cus;
    }
    if (grid < 0) return;
    Args a{};
    for (int i = 0; i < 17; ++i) a.in[i] = (const float*)d_in[i];
    a.out = (float*)d_out; a.ws = (unsigned char*)d_ws;
    void* kargs[] = {&a};
    hipError_t e = hipLaunchCooperativeKernel((const void*)fwd_megakernel, dim3(grid), dim3(NWAVES * 64), kargs, LDS_BYTES, stream);
    if (e != hipSuccess) fprintf(stderr, "cooperative launch failed: %s (grid %d)\n", hipGetErrorString(e), grid);
}
```

```cpp
#include <hip/hip_runtime.h>
#include <hip/hip_cooperative_groups.h>
#include <cstdio>
#include <cstdint>
namespace cg = cooperative_groups;
namespace pg8 {
#define PG8_LAS __attribute__((address_space(3)))
typedef unsigned short bf16_t;
typedef short bf16x8 __attribute__((ext_vector_type(8)));
typedef float f32x4 __attribute__((ext_vector_type(4)));
typedef unsigned u32x4 __attribute__((ext_vector_type(4)));
constexpr int BM = 256, BK = 64, HALF = 128, HTB = HALF * BK * 2  , STAGE_BYTES = 8 * HTB, NXCD = 8, WGM = 8;

__host__ __device__ __forceinline__ int lds_byte(int r, int c) { const int st = (r >> 4) * 2 + (c >> 5), rr = r & 15, cc = c & 31, ob = rr * 64 + cc * 2; return st * 1024 + (ob ^ (((ob >> 9) & 1) << 5)); }
__host__ __device__ __forceinline__ void stage_rc(int b, int& R, int& C) { const int st = b / 1024, sb = b % 1024, swz = sb ^ (((sb >> 9) & 1) << 5); R = (st >> 1) * 16 + swz / 64; C = (st & 1) * 32 + (swz % 64) / 2; }
__host__ __device__ __forceinline__ int perm32(int rho) { const int n = rho >> 4, i = rho & 15; return 8 * (i >> 2) + 4 * n + (i & 3); }

struct Unit { int pm, pn, k0, nt, split, tu, sp; };
struct Gemm { const bf16_t* A; const bf16_t* Bt; int M, N, K; };

template <int NM, int NN, int NTK> struct StaticOrderT {
    static constexpr int nM = NM, nN = NN, nwg = NM * NN, ntk = NTK;
    int G, c;
    __host__ __device__ __forceinline__ void init(int G_, int c_) { G = G_; c = c_; }
    __host__ __device__ __forceinline__ bool next(int i, Unit& u) const { const int L = i * G + c; if (L >= nwg) return false; unit(L, u); return true; }
    __host__ __device__ __forceinline__ static void unit(int L, Unit& u) {
        int wgid = L; { constexpr int q = nwg / NXCD, r = nwg % NXCD; const int xcd = wgid % NXCD, off = wgid / NXCD; wgid = (xcd < r ? xcd * (q + 1) : r * (q + 1) + (xcd - r) * q) + off; }
        constexpr int nig = WGM * nN; const int gid = wgid / nig, fm = gid * WGM, gsz = (nM - fm) < WGM ? (nM - fm) : WGM;
        u.pm = fm + ((wgid % nig) % gsz); u.pn = (wgid % nig) / gsz; u.k0 = 0; u.nt = ntk; u.split = 0; u.tu = 0; u.sp = 0;
    }
    __device__ __forceinline__ void a_ready(const Unit&) const {}
    __device__ __forceinline__ void done(const Unit&) const {}
};
template <int NM, int NN, int NTK, int NSPLIT> struct TailOrderT {
    typedef StaticOrderT<NM, NN, NTK> SO;
    int G, c, full, rem;
    __host__ __device__ __forceinline__ void init(int G_, int c_) { G = G_; c = c_; full = SO::nwg / G; rem = SO::nwg - full * G; if (rem * NSPLIT > G || NTK < 2 * NSPLIT) { full = 1 << 24; rem = 0; } }
    __host__ __device__ __forceinline__ static int kstart(int s) { return s >= NSPLIT ? NTK : ((s * NTK / NSPLIT) & ~1); }
    __host__ __device__ __forceinline__ bool next(int i, Unit& u) const {
        if (i < full) { const int L = i * G + c; if (L >= SO::nwg) return false; SO::unit(L, u); return true; }
        if (i > full || c >= rem * NSPLIT) return false;
        const int tu = c / NSPLIT, sp = c % NSPLIT; SO::unit(full * G + tu, u); u.k0 = kstart(sp); u.nt = kstart(sp + 1) - u.k0; u.split = 1; u.tu = tu; u.sp = sp; return true;
    }
    __device__ __forceinline__ void a_ready(const Unit&) const {}
    __device__ __forceinline__ void done(const Unit&) const {}
};

struct InProjOrder {
    typedef StaticOrderT<30, 24, 32> SO;
    int G, c;
    __host__ __device__ __forceinline__ void init(int G_, int c_) { G = G_; c = c_; }
    __host__ __device__ __forceinline__ bool next(int i, Unit& u) const {
        const int L = i * G + c; if (L >= 768) return false;
        if (L < 720) { SO::unit(L, u); return true; }
        const int j = L - 720; u.pm = 30 + (j & 3); u.pn = j >> 2; u.k0 = 0; u.nt = 32; u.split = 0; u.tu = 0; u.sp = 0; return true;
    }
    __device__ __forceinline__ void a_ready(const Unit&) const {}
    __device__ __forceinline__ void done(const Unit&) const {}
};
struct OneUnit {
    Unit u0;
    __host__ __device__ __forceinline__ bool next(int i, Unit& u) const { if (i != 0) return false; u = u0; return true; }
    __device__ __forceinline__ void a_ready(const Unit&) const {}
    __device__ __forceinline__ void done(const Unit&) const {}
};

__device__ __forceinline__ unsigned cvt_pk_bf16(float lo, float hi) { unsigned r; asm volatile("v_cvt_pk_bf16_f32 %0, %1, %2" : "=v"(r) : "v"(lo), "v"(hi)); return r; }
typedef float f32x2 __attribute__((ext_vector_type(2)));
#define PG8_LBAR() asm volatile("s_waitcnt lgkmcnt(0)\n\ts_barrier" ::: "memory")
constexpr int NPROMPT = 8192;
__device__ __forceinline__ u32x4 pack8(const f32x4 a, const f32x4 b) { u32x4 w; w.x = cvt_pk_bf16(a[0], a[1]); w.y = cvt_pk_bf16(a[2], a[3]); w.z = cvt_pk_bf16(b[0], b[1]); w.w = cvt_pk_bf16(b[2], b[3]); return w; }


__device__ __forceinline__ void store_partial(float* part, int nsplit, const f32x4 (&acc)[2][2][4][2], const Unit& u, int wr, int wc, int fr, int fq) {
    bf16_t* pt = (bf16_t*)part + (size_t)(u.tu * nsplit + u.sp) * 65536; int rl0 = wr * 64 + fr, cw = wc * 32 + 8 * fq; asm volatile("" : "+v"(rl0), "+v"(cw));
#pragma unroll
    for (int ai = 0; ai < 2; ++ai)
#pragma unroll
        for (int m = 0; m < 4; ++m)
#pragma unroll
            for (int bj = 0; bj < 2; ++bj) *(u32x4*)(pt + (ai * HALF + rl0 + m * 16) * 256 + bj * HALF + cw) = pack8(acc[ai][bj][m][0], acc[ai][bj][m][1]);
}

struct EpiIn {
    static constexpr bool PERM = true, AFTER_DRAIN = false;
    bf16_t *Q, *Kb, *Vb, *GB, *U; float* out; const float *gq, *gk; PG8_LAS float* red; float qscale;
    size_t off_kp, off_vp, off_cp, off_ks, off_vs, off_cs;
    __device__ __forceinline__ void operator()(const f32x4 (&acc)[2][2][4][2], const Unit& u, int wr, int wc, int fr, int fq) const {
        int rl0 = wr * 64 + fr, cw = wc * 32 + 8 * fq; asm volatile("" : "+v"(rl0), "+v"(cw));
        const int pn = u.pn, rowt = u.pm * BM;
        const bool prompt = rowt < NPROMPT;
        if (pn < 8) {
            const bool isq = pn < 4;
#pragma unroll
            for (int ai = 0; ai < 2; ++ai)
#pragma unroll
                for (int m = 0; m < 4; ++m)
#pragma unroll
                    for (int bj = 0; bj < 2; ++bj) {
                        const f32x4 a = acc[ai][bj][m][0], b = acc[ai][bj][m][1];
                        float s = (a[0] * a[0] + a[1] * a[1]) + (a[2] * a[2] + a[3] * a[3]) + (b[0] * b[0] + b[1] * b[1]) + (b[2] * b[2] + b[3] * b[3]);
                        s += __shfl_xor(s, 16); s += __shfl_xor(s, 32);
                        if (fq == 0) red[((ai * HALF + rl0 + m * 16) * 2 + bj) * 4 + wc] = s;
                    }
            PG8_LBAR();
            const float* g = isq ? gq : gk;
            const f32x4 g0 = *(const f32x4*)(g + cw), g1 = *(const f32x4*)(g + cw + 4);
#pragma unroll
            for (int ai = 0; ai < 2; ++ai)
#pragma unroll
                for (int m = 0; m < 4; ++m) {
                    const int rl = ai * HALF + rl0 + m * 16; const size_t row = (size_t)(rowt + rl);
#pragma unroll
                    for (int bj = 0; bj < 2; ++bj) {
                        const f32x4 p = *(const PG8_LAS f32x4*)(red + (rl * 2 + bj) * 4);
                        float rs = __builtin_amdgcn_rsqf(((p[0] + p[1]) + (p[2] + p[3])) * (1.0f / 128.0f) + 1e-6f);
                        if (isq) rs *= qscale;
                        const f32x4 v0 = acc[ai][bj][m][0] * rs * g0, v1 = acc[ai][bj][m][1] * rs * g1;
                        if (isq) { *(u32x4*)(Q + row * 1024 + pn * 256 + bj * HALF + cw) = pack8(v0, v1); }
                        else {
                            const int col = (pn - 4) * 256 + bj * HALF + cw;
                            float* o = prompt ? out + off_kp + row * 1024 + col : out + off_ks + (row - NPROMPT) * 1024 + col;
                            *(f32x4*)o = v0; *(f32x4*)(o + 4) = v1;
                            if (prompt) *(u32x4*)(Kb + row * 1024 + col) = pack8(v0, v1);
                        }
                    }
                }
        } else if (pn < 12) {
#pragma unroll
            for (int ai = 0; ai < 2; ++ai)
#pragma unroll
                for (int m = 0; m < 4; ++m) {
                    const size_t row = (size_t)(rowt + ai * HALF + rl0 + m * 16);
#pragma unroll
                    for (int bj = 0; bj < 2; ++bj) {
                        const int col = (pn - 8) * 256 + bj * HALF + cw; const f32x4 v0 = acc[ai][bj][m][0], v1 = acc[ai][bj][m][1];
                        float* o = prompt ? out + off_vp + row * 1024 + col : out + off_vs + (row - NPROMPT) * 1024 + col;
                        *(f32x4*)o = v0; *(f32x4*)(o + 4) = v1;
                        if (prompt) *(u32x4*)(Vb + row * 1024 + col) = pack8(v0, v1);
                    }
                }
        } else if (pn < 16) {
#pragma unroll
            for (int ai = 0; ai < 2; ++ai)
#pragma unroll
                for (int m = 0; m < 4; ++m) {
                    const size_t row = (size_t)(rowt + ai * HALF + rl0 + m * 16);
#pragma unroll
                    for (int bj = 0; bj < 2; ++bj) *(u32x4*)(GB + row * 1024 + (pn - 12) * 256 + bj * HALF + cw) = pack8(acc[ai][bj][m][0], acc[ai][bj][m][1]);
                }
        } else {
#pragma unroll
            for (int ai = 0; ai < 2; ++ai)
#pragma unroll
                for (int m = 0; m < 4; ++m) {
                    const int rowi = rowt + ai * HALF + rl0 + m * 16; const int ch = (pn - 16) * HALF + cw;
                    const f32x4 v0 = acc[ai][0][m][0] * acc[ai][1][m][0], v1 = acc[ai][0][m][1] * acc[ai][1][m][1];
                    *(u32x4*)(U + (size_t)rowi * 1024 + ch) = pack8(v0, v1);
                    if (prompt) { const int t = rowi & 4095; if (t >= 4094) { float* o = out + off_cp + ((rowi >> 12) * 2 + (t - 4094)) * 1024 + ch; *(f32x4*)o = v0; *(f32x4*)(o + 4) = v1; } }
                    else { const int rs_ = rowi - NPROMPT, t = rs_ & 63; if (t >= 62) { float* o = out + off_cs + ((rs_ >> 6) * 2 + (t - 62)) * 1024 + ch; *(f32x4*)o = v0; *(f32x4*)(o + 4) = v1; } }
                }
        }
    }
};

struct EpiOut {
    static constexpr bool PERM = true, AFTER_DRAIN = false;
    const float *xp, *xs; float* Y; bf16_t* X1; float* ssq; PG8_LAS float* red; float* part;
    __device__ __forceinline__ void operator()(const f32x4 (&acc)[2][2][4][2], const Unit& u, int wr, int wc, int fr, int fq) const {
        if (u.split) { store_partial(part, 8, acc, u, wr, wc, fr, fq); return; }
        int rl0 = wr * 64 + fr, cw = wc * 32 + 8 * fq; asm volatile("" : "+v"(rl0), "+v"(cw));
        const int pn = u.pn, rowt = u.pm * BM;
        const float* xin = rowt < NPROMPT ? xp + (size_t)rowt * 2048 : xs + (size_t)(rowt - NPROMPT) * 2048;
#pragma unroll
        for (int ai = 0; ai < 2; ++ai) {
            f32x4 xv[4][2][2];
#pragma unroll
            for (int m = 0; m < 4; ++m)
#pragma unroll
                for (int bj = 0; bj < 2; ++bj) { const float* xi = xin + (size_t)(ai * HALF + rl0 + m * 16) * 2048 + pn * 256 + bj * HALF + cw; xv[m][bj][0] = *(const f32x4*)xi; xv[m][bj][1] = *(const f32x4*)(xi + 4); }
#pragma unroll
            for (int m = 0; m < 4; ++m) {
                const int rl = ai * HALF + rl0 + m * 16; float s = 0.f;
#pragma unroll
                for (int bj = 0; bj < 2; ++bj) {
                    const int col = pn * 256 + bj * HALF + cw;
                    const f32x4 v0 = xv[m][bj][0] + acc[ai][bj][m][0], v1 = xv[m][bj][1] + acc[ai][bj][m][1];
                    *(u32x4*)(X1 + (size_t)(rowt + rl) * 2048 + col) = pack8(v0, v1);
                    s += (v0[0] * v0[0] + v0[1] * v0[1]) + (v0[2] * v0[2] + v0[3] * v0[3]) + (v1[0] * v1[0] + v1[1] * v1[1]) + (v1[2] * v1[2] + v1[3] * v1[3]);
                }
                s += __shfl_xor(s, 16); s += __shfl_xor(s, 32);
                if (fq == 0) red[rl * 4 + wc] = s;
            }
            asm volatile("" ::: "memory");
        }
        PG8_LBAR();
        if (threadIdx.x < 256) { const f32x4 p = *(const PG8_LAS f32x4*)(red + threadIdx.x * 4); ssq[(size_t)(rowt + threadIdx.x) * 8 + pn] = (p[0] + p[1]) + (p[2] + p[3]); }
        PG8_LBAR();
    }
};

struct EpiGU {
    static constexpr bool PERM = true, AFTER_DRAIN = false;
    bf16_t* H; const float* ssq;
    __device__ __forceinline__ void operator()(const f32x4 (&acc)[2][2][4][2], const Unit& u, int wr, int wc, int fr, int fq) const {
        int rl0 = wr * 64 + fr, cw = wc * 32 + 8 * fq; asm volatile("" : "+v"(rl0), "+v"(cw));
        const int pn = u.pn, rowt = u.pm * BM;
        f32x4 pa[2][4], pb[2][4];
#pragma unroll
        for (int ai = 0; ai < 2; ++ai)
#pragma unroll
            for (int m = 0; m < 4; ++m) { const float* p = ssq + (size_t)(rowt + ai * HALF + rl0 + m * 16) * 8; pa[ai][m] = *(const f32x4*)p; pb[ai][m] = *(const f32x4*)(p + 4); }
#pragma unroll
        for (int ai = 0; ai < 2; ++ai)
#pragma unroll
            for (int m = 0; m < 4; ++m) {
                const size_t row = (size_t)(rowt + ai * HALF + rl0 + m * 16);
                const f32x4 p0 = pa[ai][m], p1 = pb[ai][m];
                const float rs = __builtin_amdgcn_rsqf((((p0[0] + p0[1]) + (p0[2] + p0[3])) + ((p1[0] + p1[1]) + (p1[2] + p1[3]))) * (1.0f / 2048.0f) + 1e-6f);
                f32x4 h[2];
#pragma unroll
                for (int n = 0; n < 2; ++n) {
                    const f32x4 g = acc[ai][0][m][n] * rs, up = acc[ai][1][m][n] * rs;
#pragma unroll
                    for (int j = 0; j < 4; ++j) h[n][j] = g[j] * __builtin_amdgcn_rcpf(1.0f + __builtin_amdgcn_exp2f(-1.4426950408889634f * g[j])) * up[j];
                }
                *(u32x4*)(H + row * 5632 + pn * HALF + cw) = pack8(h[0], h[1]);
            }
    }
};

struct EpiDown {
    static constexpr bool PERM = true, AFTER_DRAIN = false;
    float* Y; float* part; const bf16_t* X1;
    __device__ __forceinline__ void operator()(const f32x4 (&acc)[2][2][4][2], const Unit& u, int wr, int wc, int fr, int fq) const {
        if (u.split) { store_partial(part, 8, acc, u, wr, wc, fr, fq); return; }
        int rl0 = wr * 64 + fr, cw = wc * 32 + 8 * fq; asm volatile("" : "+v"(rl0), "+v"(cw));
        const int pn = u.pn, rowt = u.pm * BM;
        u32x4 xb[2][4][2];
#pragma unroll
        for (int ai = 0; ai < 2; ++ai)
#pragma unroll
            for (int m = 0; m < 4; ++m)
#pragma unroll
                for (int bj = 0; bj < 2; ++bj) xb[ai][m][bj] = *(const u32x4*)(X1 + (size_t)(rowt + ai * HALF + rl0 + m * 16) * 2048 + pn * 256 + bj * HALF + cw);
#pragma unroll
        for (int ai = 0; ai < 2; ++ai)
#pragma unroll
            for (int m = 0; m < 4; ++m)
#pragma unroll
                for (int bj = 0; bj < 2; ++bj) {
                    const size_t off = (size_t)(rowt + ai * HALF + rl0 + m * 16) * 2048 + pn * 256 + bj * HALF + cw;
                    const u32x4 x = xb[ai][m][bj];
                    f32x4 b0, b1; b0[0] = __builtin_bit_cast(float, x.x << 16); b0[1] = __builtin_bit_cast(float, x.x & 0xffff0000u); b0[2] = __builtin_bit_cast(float, x.y << 16); b0[3] = __builtin_bit_cast(float, x.y & 0xffff0000u);
                    b1[0] = __builtin_bit_cast(float, x.z << 16); b1[1] = __builtin_bit_cast(float, x.z & 0xffff0000u); b1[2] = __builtin_bit_cast(float, x.w << 16); b1[3] = __builtin_bit_cast(float, x.w & 0xffff0000u);
                    float* o = Y + off; *(f32x4*)o = b0 + acc[ai][bj][m][0]; *(f32x4*)(o + 4) = b1 + acc[ai][bj][m][1];
                }
    }
};

struct EpiNone {
    static constexpr bool PERM = true, AFTER_DRAIN = false;
    float* sink;
    __device__ __forceinline__ void operator()(const f32x4 (&acc)[2][2][4][2], const Unit& u, int wr, int wc, int fr, int fq) const {
        if (acc[0][0][0][0][0] == 12345.678f && acc[1][1][3][1][3] == -9876.5f) sink[0] = 1.f;
    }
};
template <class Epi, class Sched, bool ALIGN_EPI = false, bool SP2 = false>
__device__ __forceinline__ void gemm_phase(PG8_LAS unsigned char* lds, const Gemm g, const Sched& S, const Epi& E) {
    int tid_ = threadIdx.x; asm volatile("" : "+v"(tid_));
    const int tid = tid_, wid = __builtin_amdgcn_readfirstlane(tid >> 6), lane = tid & 63, wr = wid >> 2, wc = wid & 3, fr = lane & 15, fq = lane >> 4;
    const int K = g.K;
    unsigned voffA[2], voffB[2];
#pragma unroll
    for (int i = 0; i < 2; ++i) { int R, C; stage_rc(tid * 16 + i * 8192, R, C); const int Rb = Epi::PERM ? ((R & ~31) + perm32(R & 31)) : R;
        voffA[i] = (unsigned)(R * K + C) * 2u; voffB[i] = (unsigned)(Rb * K + C) * 2u; }
    const size_t kstep = (size_t)(BK * 2);
    const size_t hstep = (size_t)HALF * K * 2;
    const size_t tstep = 2 * hstep;
    const unsigned ldsw = (unsigned)wid * 1024u;
    const int aoff = lds_byte(wr * 64 + fr, fq * 8), boff = lds_byte(wc * 32 + fr, fq * 8);
#define PG8_SA(b, h) (((b) * 2 + (h)) * HTB)
#define PG8_SB(b, h) ((4 + (b) * 2 + (h)) * HTB)
#define PG8_STAGE(bufoff, gbase, voff) do { _Pragma("unroll") for (int _i = 0; _i < 2; ++_i) \
        __builtin_amdgcn_global_load_lds((const unsigned*)((const char*)(gbase) + (voff)[_i]), (PG8_LAS unsigned*)(lds + (bufoff) + ldsw + _i * 8192), 16, 0, 0); } while (0)
#define PG8_LDA(dst, b, h) do { _Pragma("unroll") for (int m = 0; m < 4; ++m) _Pragma("unroll") for (int k = 0; k < 2; ++k) dst[m][k] = *(const PG8_LAS bf16x8*)(lds + PG8_SA(b, h) + aoff + m * 2048 + k * 1024); } while (0)
#define PG8_LDB(dst, b, h) do { _Pragma("unroll") for (int n = 0; n < 2; ++n) _Pragma("unroll") for (int k = 0; k < 2; ++k) dst[n][k] = *(const PG8_LAS bf16x8*)(lds + PG8_SB(b, h) + boff + n * 2048 + k * 1024); } while (0)
#define PG8_MMA(ai, bj, At, Bt) do { __builtin_amdgcn_s_setprio(1); _Pragma("unroll") for (int m = 0; m < 4; ++m) _Pragma("unroll") for (int n = 0; n < 2; ++n) _Pragma("unroll") for (int k = 0; k < 2; ++k) \
        acc[ai][bj][m][n] = __builtin_amdgcn_mfma_f32_16x16x32_bf16(Bt[n][k], At[m][k], acc[ai][bj][m][n], 0, 0, 0); __builtin_amdgcn_s_setprio(0); } while (0)
#define PG8_WAIT_V(n) asm volatile("s_waitcnt vmcnt(" #n ")" ::: "memory")
#define PG8_WAIT_L(n) asm volatile("s_waitcnt lgkmcnt(" #n ")" ::: "memory")
#define PG8_BAR __builtin_amdgcn_s_barrier()
#define PG8_SCHED __builtin_amdgcn_sched_barrier(0)
    Unit cur, nxt; int ui = 0;
    if (!S.next(0, cur)) return;
    f32x4 acc[2][2][4][2];
#pragma unroll
    for (int a = 0; a < 2; ++a)
#pragma unroll
        for (int b = 0; b < 2; ++b)
#pragma unroll
            for (int m = 0; m < 4; ++m)
#pragma unroll
                for (int n = 0; n < 2; ++n) acc[a][b][m][n] = (f32x4){0.f, 0.f, 0.f, 0.f};
    bf16x8 At[4][2], B0[2][2], B1[2][2];
    const char* cA = (const char*)g.A + (size_t)cur.pm * tstep + (size_t)cur.k0 * kstep; const char* cB = (const char*)g.Bt + (size_t)cur.pn * tstep + (size_t)cur.k0 * kstep;
    S.a_ready(cur);
    if constexpr (SP2) {
        PG8_STAGE(PG8_SB(0, 0), cB, voffB); PG8_STAGE(PG8_SB(0, 1), cB + hstep, voffB); PG8_STAGE(PG8_SA(0, 0), cA, voffA); PG8_STAGE(PG8_SA(0, 1), cA + hstep, voffA);
        if (wr == 1) PG8_BAR;
        PG8_WAIT_V(2); PG8_BAR;
        PG8_STAGE(PG8_SB(1, 0), cB + kstep, voffB); PG8_STAGE(PG8_SA(1, 0), cA + kstep, voffA); PG8_STAGE(PG8_SB(1, 1), cB + hstep + kstep, voffB);
        PG8_WAIT_V(6); PG8_BAR;
    } else {
        PG8_STAGE(PG8_SB(0, 0), cB, voffB); PG8_STAGE(PG8_SA(0, 0), cA, voffA); PG8_STAGE(PG8_SB(0, 1), cB + hstep, voffB); PG8_STAGE(PG8_SA(0, 1), cA + hstep, voffA);
        if (wr == 1) PG8_BAR;
        PG8_WAIT_V(4); PG8_BAR;
        PG8_STAGE(PG8_SB(1, 0), cB + kstep, voffB); PG8_STAGE(PG8_SA(1, 0), cA + kstep, voffA); PG8_STAGE(PG8_SB(1, 1), cB + hstep + kstep, voffB);
        PG8_WAIT_V(6); PG8_BAR;
    }
    for (;;) {
        const bool has_next = S.next(ui + 1, nxt);
        const char* nA = has_next ? (const char*)g.A + (size_t)nxt.pm * tstep + (size_t)nxt.k0 * kstep : cA; const char* nB = has_next ? (const char*)g.Bt + (size_t)nxt.pn * tstep + (size_t)nxt.k0 * kstep : cB;
        const int nt = cur.nt;
        for (int t = 0; t < nt; t += 2) {
            const bool last = (t == nt - 2);
            const char* a1 = cA + (size_t)(t + 1) * kstep;
            const char* a2 = last ? nA : cA + (size_t)(t + 2) * kstep; const char* b2 = last ? nB : cB + (size_t)(t + 2) * kstep;
            const char* a3 = a2 + kstep; const char* b3 = b2 + kstep;
            if (last && has_next) S.a_ready(nxt);
            if constexpr (SP2) {
            PG8_LDB(B0, 0, 0); PG8_LDB(B1, 0, 1); PG8_SCHED; PG8_LDA(At, 0, 0); PG8_STAGE(PG8_SA(1, 1), a1 + hstep, voffA);
            PG8_WAIT_V(8); PG8_WAIT_L(0); PG8_BAR; PG8_MMA(0, 0, At, B0); PG8_MMA(0, 1, At, B1); PG8_BAR; PG8_SCHED;
            PG8_LDA(At, 0, 1); PG8_STAGE(PG8_SB(0, 0), b2, voffB); PG8_STAGE(PG8_SB(0, 1), b2 + hstep, voffB); PG8_STAGE(PG8_SA(0, 0), a2, voffA);
            PG8_WAIT_V(8); PG8_WAIT_L(0); PG8_BAR; PG8_MMA(1, 0, At, B0); PG8_MMA(1, 1, At, B1); PG8_BAR; PG8_SCHED;
            PG8_LDB(B0, 1, 0); PG8_LDB(B1, 1, 1); PG8_SCHED; PG8_LDA(At, 1, 0); PG8_STAGE(PG8_SA(0, 1), a2 + hstep, voffA);
            PG8_WAIT_V(8); PG8_WAIT_L(0); PG8_BAR; PG8_MMA(0, 0, At, B0); PG8_MMA(0, 1, At, B1); PG8_BAR; PG8_SCHED;
            PG8_LDA(At, 1, 1); PG8_STAGE(PG8_SB(1, 0), b3, voffB); PG8_STAGE(PG8_SB(1, 1), b3 + hstep, voffB); PG8_STAGE(PG8_SA(1, 0), a3, voffA);
            PG8_WAIT_V(8); PG8_WAIT_L(0); PG8_BAR; PG8_MMA(1, 0, At, B0); PG8_MMA(1, 1, At, B1); PG8_BAR; PG8_SCHED;
            } else {
            PG8_LDB(B0, 0, 0); PG8_SCHED; PG8_LDA(At, 0, 0); PG8_STAGE(PG8_SA(1, 1), a1 + hstep, voffA);
            PG8_WAIT_L(8); PG8_BAR; PG8_WAIT_L(0); PG8_MMA(0, 0, At, B0); PG8_BAR; PG8_SCHED;
            PG8_LDB(B1, 0, 1); PG8_STAGE(PG8_SB(0, 0), b2, voffB);
            PG8_BAR; PG8_WAIT_L(0); PG8_MMA(0, 1, At, B1); PG8_BAR;
            PG8_LDA(At, 0, 1); PG8_STAGE(PG8_SA(0, 0), a2, voffA);
            PG8_BAR; PG8_WAIT_L(0); PG8_MMA(1, 0, At, B0); PG8_BAR; PG8_SCHED;
            PG8_STAGE(PG8_SB(0, 1), b2 + hstep, voffB);
            PG8_WAIT_V(6); PG8_BAR; PG8_MMA(1, 1, At, B1); PG8_BAR;
            PG8_LDB(B0, 1, 0); PG8_SCHED; PG8_LDA(At, 1, 0); PG8_STAGE(PG8_SA(0, 1), a2 + hstep, voffA);
            PG8_WAIT_L(8); PG8_BAR; PG8_WAIT_L(0); PG8_MMA(0, 0, At, B0); PG8_BAR; PG8_SCHED;
            PG8_LDB(B1, 1, 1); PG8_STAGE(PG8_SB(1, 0), b3, voffB);
            PG8_BAR; PG8_WAIT_L(0); PG8_MMA(0, 1, At, B1); PG8_BAR;
            PG8_LDA(At, 1, 1); PG8_STAGE(PG8_SA(1, 0), a3, voffA);
            PG8_BAR; PG8_WAIT_L(0); PG8_MMA(1, 0, At, B0); PG8_BAR; PG8_SCHED;
            PG8_STAGE(PG8_SB(1, 1), b3 + hstep, voffB);
            PG8_WAIT_V(6); PG8_BAR; PG8_MMA(1, 1, At, B1); PG8_BAR;
            }
        }
        if constexpr (ALIGN_EPI) { if (wr == 0) PG8_BAR; }
        if constexpr (!Epi::AFTER_DRAIN) { E(acc, cur, wr, wc, fr, fq); S.done(cur); }
        if (!has_next) break;
#pragma unroll
        for (int a = 0; a < 2; ++a)
#pragma unroll
            for (int b = 0; b < 2; ++b)
#pragma unroll
                for (int m = 0; m < 4; ++m)
#pragma unroll
                    for (int n = 0; n < 2; ++n) acc[a][b][m][n] = (f32x4){0.f, 0.f, 0.f, 0.f};
        cur = nxt; cA = nA; cB = nB; ++ui;
        if constexpr (ALIGN_EPI) { if (wr == 1) PG8_BAR; }
    }
    PG8_WAIT_V(0);
    if constexpr (!ALIGN_EPI) { if (wr == 0) PG8_BAR; }
    PG8_BAR;
    if constexpr (Epi::AFTER_DRAIN) { E.fused(acc, cur, wr, wc, fr, fq, lds, wid, lane); S.done(cur); }
#undef PG8_SA
#undef PG8_SB
#undef PG8_STAGE
#undef PG8_LDA
#undef PG8_LDB
#undef PG8_MMA
#undef PG8_WAIT_V
#undef PG8_WAIT_L
#undef PG8_BAR
#undef PG8_SCHED
}
}
#define LAS __attribute__((address_space(3)))
typedef unsigned short bf16;
typedef float f32x4 __attribute__((ext_vector_type(4)));
typedef float f32x16 __attribute__((ext_vector_type(16)));
typedef short bf16x8 __attribute__((ext_vector_type(8)));
typedef short s16x4 __attribute__((ext_vector_type(4)));
typedef unsigned u32x4 __attribute__((ext_vector_type(4)));
typedef unsigned u32x2 __attribute__((ext_vector_type(2)));
constexpr int DM = 2048, SEQ = 4096, NP = 8192, NS = 512, MT = NP + NS, AW = 1024, CC = 1024, INC = 6144, DFF = 5632, PAST = 4096, DSEQ = 64;
constexpr float EPS = 1e-6f;
constexpr size_t OFF_Y = 0, OFF_KP = (size_t)MT * DM, OFF_VP = OFF_KP + (size_t)NP * AW, OFF_CP = OFF_VP + (size_t)NP * AW, OFF_KS = OFF_CP + 2 * 2 * CC,
                 OFF_VS = OFF_KS + (size_t)NS * AW, OFF_CS = OFF_VS + (size_t)NS * AW, OUT_TOTAL = OFF_CS + 8 * 2 * CC;
static_assert(OUT_TOTAL == 35672064, "output size");
constexpr size_t MiB = 1u << 20;
constexpr size_t WS_CTL = 0, WS_WIN = 1 * MiB, WS_WOUT = 25 * MiB, WS_WGU = 33 * MiB, WS_WDN = 77 * MiB, WS_HN = 99 * MiB, WS_Q = 133 * MiB, WS_K = 150 * MiB, WS_V = 166 * MiB,
                 WS_GB = 182 * MiB, WS_U = 199 * MiB, WS_MIX = 216 * MiB, WS_SSQ = 250 * MiB, WS_TP = 251 * MiB, WS_OP = 256 * MiB, WS_H = 256 * MiB, WS_PART = 133 * MiB  ;
constexpr int NSLOT = 256 + 16;
constexpr size_t WS_END = WS_OP + (size_t)NSLOT * 131072;
constexpr int RING_BYTES = 131072, RED_OFF = RING_BYTES, MISC_OFF = RED_OFF + 8192, LDS_BYTES = 147456;
constexpr int NWAVES = 8;

#define XB_TMO      128
#define XB_XCNT(j)  (256  + 64 * (j))
#define XB_XSUB(j)  (1280 + 64 * (j))
#define XB_XGEN(j)  (2304 + 64 * (j))
#define XB_TOP      3328
#define XB_TOPGEN   3392
#define XCD_BAR_WORDS 3456
#define XB_SPIN_CAP (1u << 18)

__device__ __forceinline__ unsigned xb_ld(unsigned* p)              { return __hip_atomic_load(p, __ATOMIC_RELAXED, __HIP_MEMORY_SCOPE_AGENT); }
__device__ __forceinline__ unsigned xb_add(unsigned* p, unsigned v) { return __hip_atomic_fetch_add(p, v, __ATOMIC_RELAXED, __HIP_MEMORY_SCOPE_AGENT); }
__device__ __forceinline__ unsigned xb_xcc_id() { return (unsigned)__builtin_amdgcn_s_getreg((3 << 11) | 20) & 0xFu; }
#define XB_SPIN(cond, bar) do { unsigned _sp = 0; while (cond) { __builtin_amdgcn_s_sleep(1); \
    if ((++_sp & 255u) == 0u) { if (xb_ld(&(bar)[XB_TMO])) break; if (_sp > XB_SPIN_CAP) { atomicAdd(&(bar)[XB_TMO], 1u); break; } } } } while (0)

struct XcdBarrier {
    unsigned* bar; unsigned x;
    volatile LAS unsigned* st;
};

__device__ __forceinline__ XcdBarrier xcd_barrier_post(unsigned* bar, volatile LAS unsigned* st) {
    XcdBarrier b; b.bar = bar; b.x = xb_xcc_id(); b.st = st;
    if (threadIdx.x == 0) (void)xb_add(&bar[XB_XCNT(b.x)], 1u);
    return b;
}
__device__ __forceinline__ void xcd_barrier_complete(unsigned* bar, unsigned x, unsigned& nloc, unsigned& nx) {
    const unsigned G = gridDim.x * gridDim.y * gridDim.z;
    unsigned sum, cnt, mine, sp = 0u;
    for (;;) {
        sum = 0u; cnt = 0u; mine = 0u;
#pragma unroll
        for (unsigned j = 0; j < 16; ++j) { const unsigned c = xb_ld(&bar[XB_XCNT(j)]); sum += c; cnt += (c > 0u) ? 1u : 0u; mine = (j == x) ? c : mine; }
        if (sum == G) break;
        __builtin_amdgcn_s_sleep(1);
        if ((++sp & 255u) == 0u) { if (xb_ld(&bar[XB_TMO])) break; if (sp > XB_SPIN_CAP) { atomicAdd(&bar[XB_TMO], 1u); break; } }
    }
    nloc = mine > 0u ? mine : 1u; nx = cnt > 0u ? cnt : 1u;
}

__device__ __forceinline__ void xcd_barrier(const XcdBarrier& b) {
    asm volatile("s_waitcnt vmcnt(0)" ::: "memory");
    __syncthreads();
    if (threadIdx.x == 0) {
        unsigned* bar = b.bar;
        __builtin_amdgcn_s_waitcnt(0);
        unsigned nloc = b.st[0], nx = b.st[1];
        if (nloc == 0u) { xcd_barrier_complete(bar, b.x, nloc, nx); b.st[0] = nloc; b.st[1] = nx; }
        const unsigned old = xb_add(&bar[XB_XSUB(b.x)], 1u);
        const unsigned gen = old / nloc;
        if (old + 1u == (gen + 1u) * nloc) {
            __builtin_amdgcn_fence(__ATOMIC_RELEASE, "agent");
            asm volatile("s_waitcnt vmcnt(0)" ::: "memory");
            const unsigned og = xb_add(&bar[XB_TOP], 1u);
            const unsigned tg = og / nx;
            if (og + 1u == (tg + 1u) * nx) xb_add(&bar[XB_TOPGEN], 1u);
            else XB_SPIN(xb_ld(&bar[XB_TOPGEN]) == tg, bar);
            __builtin_amdgcn_fence(__ATOMIC_ACQUIRE, "agent");
            xb_add(&bar[XB_XGEN(b.x)], 1u);
            asm volatile("s_waitcnt vmcnt(0)" ::: "memory");
        } else {
            XB_SPIN(xb_ld(&bar[XB_XGEN(b.x)]) == gen, bar);
            __builtin_amdgcn_fence(__ATOMIC_ACQUIRE, "agent");
            asm volatile("s_waitcnt vmcnt(0)" ::: "memory");
        }
    }
    __syncthreads();
}

struct ItemTab { int n; int v[272]; };
constexpr int p_nsteps(int qb, int c) { return 8 * (qb + 1); }
constexpr ItemTab make_items() {
    ItemTab t{}; t.n = 0;
    for (int b = 0; b < 8; ++b) for (int hg = 0; hg < 2; ++hg) t.v[t.n++] = 1 | (b << 1) | (hg << 4);
    for (int qb = 15; qb >= 0; --qb) for (int bh = 0; bh < 16; ++bh) t.v[t.n++] = (bh << 1) | (qb << 5);
    return t;
}
__device__ const ItemTab g_items = make_items();

__device__ __forceinline__ unsigned f2bf(float f) { unsigned u = __builtin_bit_cast(unsigned, f); return (u + 0x7fffu + ((u >> 16) & 1u)) >> 16; }
__device__ __forceinline__ unsigned pk2(float lo, float hi) { return pg8::cvt_pk_bf16(lo, hi); }
__device__ __forceinline__ float bflo(unsigned w) { return __builtin_bit_cast(float, w << 16); }
__device__ __forceinline__ float bfhi(unsigned w) { return __builtin_bit_cast(float, w & 0xffff0000u); }
__device__ __forceinline__ int crow(int r, int hi) { return (r & 3) + 8 * (r >> 2) + 4 * hi; }
__device__ __forceinline__ float wave_sum(float v) {
#pragma unroll
    for (int o = 1; o < 64; o <<= 1) v += __shfl_xor(v, o);
    return v;
}

struct Args { const float* in[17]; float* out; unsigned char* ws; };

struct P0Item { const float* src; const float* gk; bf16* dst; int N, K, k0; };
__device__ __forceinline__ P0Item p0_decode(const Args& a, int it) {
    constexpr int I_IN = 32 * 192, I_OUT = 32 * 64, I_G = 32 * 176;
    unsigned char* ws = a.ws; P0Item r; int n0, kb, drow; r.gk = nullptr;
    if (it < I_IN) { kb = it / 192; n0 = 32 * (it % 192); drow = n0;
        if (n0 >= 5120) { const int ch = n0 - 5120; drow = 4096 + (ch >> 7) * 256 + 128 + (ch & 127); } else if (n0 >= 4096) { const int ch = n0 - 4096; drow = 4096 + (ch >> 7) * 256 + (ch & 127); }
        r.src = a.in[6]; r.N = INC; r.K = DM; r.dst = (bf16*)(ws + WS_WIN); }
    else if ((it -= I_IN) < I_OUT) { kb = it / 64; n0 = 32 * (it % 64); drow = n0; r.src = a.in[12]; r.N = DM; r.K = DM; r.dst = (bf16*)(ws + WS_WOUT); }
    else if ((it -= I_OUT) < 2 * I_G) { const int up = it >= I_G; if (up) it -= I_G; kb = it / 176; n0 = 32 * (it % 176); drow = (n0 >> 7) * 256 + up * 128 + (n0 & 127);
        r.src = a.in[up ? 15 : 14]; r.N = DFF; r.K = DM; r.dst = (bf16*)(ws + WS_WGU); r.gk = a.in[13]; }
    else { it -= 2 * I_G; kb = it / 64; n0 = 32 * (it % 64); drow = n0; r.src = a.in[16]; r.N = DM; r.K = DFF; r.dst = (bf16*)(ws + WS_WDN); }
    r.k0 = 64 * kb; r.src += (size_t)r.k0 * r.N + n0; r.dst += (size_t)drow * r.K + r.k0;
    return r;
}
__device__ __forceinline__ void p0_load(const P0Item& p, f32x4 (&v)[8], int lane) {
#pragma unroll
    for (int j = 0; j < 8; ++j) v[j] = __builtin_nontemporal_load((const f32x4*)(p.src + (size_t)(8 * j + (lane >> 3)) * p.N + 4 * (lane & 7)));
}
__device__ __forceinline__ void p0_finish(const P0Item& p, const f32x4 (&v)[8], LAS float* scr, int lane) {
#pragma unroll
    for (int j = 0; j < 8; ++j) { const int kk = 8 * j + (lane >> 3); const float g = p.gk ? p.gk[p.k0 + kk] : 1.0f; LAS float* s = scr + kk * 33 + 4 * (lane & 7);
        s[0] = v[j][0] * g; s[1] = v[j][1] * g; s[2] = v[j][2] * g; s[3] = v[j][3] * g; }
    asm volatile("s_waitcnt lgkmcnt(0)" ::: "memory");
    const int c = lane & 7;
#pragma unroll
    for (int j = 0; j < 4; ++j) { const int n = (lane >> 3) + 8 * j; const LAS float* s = scr + (8 * c) * 33 + n;
        u32x4 o; o.x = pk2(s[0 * 33], s[1 * 33]); o.y = pk2(s[2 * 33], s[3 * 33]); o.z = pk2(s[4 * 33], s[5 * 33]); o.w = pk2(s[6 * 33], s[7 * 33]);
        *(u32x4*)(p.dst + (size_t)n * p.K + 8 * c) = o; }
    asm volatile("s_waitcnt lgkmcnt(0)" ::: "memory");
}
constexpr int P0_EARLY_ITEMS = 32 * 192 + 32 * 64, P0_ALL_ITEMS = 32 * 192 + 32 * 64 + 2 * 32 * 176 + 88 * 64, P0_CHUNK = 32, P0_LATE_CHUNKS = (P0_ALL_ITEMS - P0_EARLY_ITEMS) / P0_CHUNK;
static_assert((P0_ALL_ITEMS - P0_EARLY_ITEMS) % P0_CHUNK == 0, "late conversion items come in whole chunks");
__device__ __forceinline__ void p0_run_range(const Args& a, LAS float* scr, int first, int n, int lane) {
    f32x4 va[8], vb[8]; P0Item pa, pb;
    pa = p0_decode(a, first); p0_load(pa, va, lane);
    for (int i = 0; i < n; i += 2) {
        if (i + 1 < n) { pb = p0_decode(a, first + i + 1); p0_load(pb, vb, lane); }
        p0_finish(pa, va, scr, lane);
        if (i + 1 >= n) break;
        if (i + 2 < n) { pa = p0_decode(a, first + i + 2); p0_load(pa, va, lane); }
        p0_finish(pb, vb, scr, lane);
    }
}
__device__ __forceinline__ void p0_prologue(const Args& a, LAS unsigned char* lds, int gw, int NGW, int lane, int wave) {
    LAS float* scr = (LAS float*)(lds + wave * 16384);
    unsigned char* ws = a.ws;
    constexpr int NITEMS = P0_EARLY_ITEMS;
    {
        int it = gw; f32x4 va[8], vb[8]; P0Item pa, pb;
        if (it < NITEMS) { pa = p0_decode(a, it); p0_load(pa, va, lane); }
        while (it < NITEMS) {
            const int itb = it + NGW;
            if (itb < NITEMS) { pb = p0_decode(a, itb); p0_load(pb, vb, lane); }
            p0_finish(pa, va, scr, lane);
            it = itb + NGW;
            if (itb >= NITEMS) break;
            if (it < NITEMS) { pa = p0_decode(a, it); p0_load(pa, va, lane); }
            p0_finish(pb, vb, scr, lane);
        }
    }
    const float* g1 = a.in[5];
    f32x4 gv[8];
#pragma unroll
    for (int j = 0; j < 8; ++j) gv[j] = *((const f32x4*)g1 + 64 * j + lane);
    for (int m = gw; m < MT; m += 2 * NGW) {
        const int m2 = m + NGW; const bool has2 = m2 < MT;
        const float* xa = m < NP ? a.in[0] + (size_t)m * DM : a.in[1] + (size_t)(m - NP) * DM;
        const float* xb = has2 ? (m2 < NP ? a.in[0] + (size_t)m2 * DM : a.in[1] + (size_t)(m2 - NP) * DM) : xa;
        f32x4 va[8], vb[8];
#pragma unroll
        for (int j = 0; j < 8; ++j) va[j] = __builtin_nontemporal_load((const f32x4*)xa + 64 * j + lane);
        if (has2) {
#pragma unroll
            for (int j = 0; j < 8; ++j) vb[j] = __builtin_nontemporal_load((const f32x4*)xb + 64 * j + lane);
        }
        {
            float s = 0.f;
#pragma unroll
            for (int j = 0; j < 8; ++j) s += (va[j][0] * va[j][0] + va[j][1] * va[j][1]) + (va[j][2] * va[j][2] + va[j][3] * va[j][3]);
            const float rs = __builtin_amdgcn_rsqf(wave_sum(s) * (1.0f / DM) + EPS);
            u32x2* o = (u32x2*)((bf16*)(ws + WS_HN) + (size_t)m * DM) + lane;
#pragma unroll
            for (int j = 0; j < 8; ++j) { u32x2 w; w.x = pk2(va[j][0] * rs * gv[j][0], va[j][1] * rs * gv[j][1]); w.y = pk2(va[j][2] * rs * gv[j][2], va[j][3] * rs * gv[j][3]); o[64 * j] = w; }
        }
        if (has2) {
            float s = 0.f;
#pragma unroll
            for (int j = 0; j < 8; ++j) s += (vb[j][0] * vb[j][0] + vb[j][1] * vb[j][1]) + (vb[j][2] * vb[j][2] + vb[j][3] * vb[j][3]);
            const float rs = __builtin_amdgcn_rsqf(wave_sum(s) * (1.0f / DM) + EPS);
            u32x2* o = (u32x2*)((bf16*)(ws + WS_HN) + (size_t)m2 * DM) + lane;
#pragma unroll
            for (int j = 0; j < 8; ++j) { u32x2 w; w.x = pk2(vb[j][0] * rs * gv[j][0], vb[j][1] * rs * gv[j][1]); w.y = pk2(vb[j][2] * rs * gv[j][2], vb[j][3] * rs * gv[j][3]); o[64 * j] = w; }
        }
    }
}


template <int VS, bool QREG>
__device__ __forceinline__ void sb_block(f32x16 (&o)[4], float& R, const LAS unsigned char* kp, const LAS unsigned char* vp, const bf16x8 (&qreg)[8], const LAS unsigned char* qlp, int kb, int qw, int qpos, int hi) {
            f32x16 p;
#pragma unroll
            for (int r = 0; r < 16; ++r) p[r] = 0.f;
#pragma unroll
            for (int d0 = 0; d0 < 8; ++d0) { const bf16x8 kf = *(const LAS bf16x8*)(kp + d0 * 32); const bf16x8 qf = QREG ? qreg[d0] : *(const LAS bf16x8*)(qlp + d0 * 32); p = __builtin_amdgcn_mfma_f32_32x32x16_bf16(kf, qf, p, 0, 0, 0); }
            const bool need_mask = (kb + 31 >= qw);
            float e[16], sf[16];
#pragma unroll
            for (int r = 0; r < 16; ++r) {
                const float z = fminf(p[r], 100.f); float ee = __builtin_amdgcn_exp2f(z); float rr = __builtin_amdgcn_rcpf(1.0f + ee);
                if (need_mask) { const bool msk = (kb + crow(r, hi)) >= qpos; ee = msk ? 0.f : ee; rr = msk ? 1.f : rr; }
                e[r] = ee; sf[r] = rr;
            }
            float oth[4], PP[4];
#pragma unroll
            for (int g = 0; g < 4; ++g) { sf[4 * g + 2] *= sf[4 * g + 3]; sf[4 * g + 1] *= sf[4 * g + 2]; sf[4 * g] *= sf[4 * g + 1]; oth[g] = __shfl_xor(sf[4 * g], 32); PP[g] = sf[4 * g] * oth[g]; }
            const float SP3 = PP[3], SP2 = PP[2] * SP3, SP1 = PP[1] * SP2, SP0 = PP[0] * SP1;
            float A[4]; A[0] = R * SP1; A[1] = R * SP2; A[2] = R * SP3; A[3] = R;
#pragma unroll
            for (int g = 0; g < 4; ++g) A[g] = hi ? A[g] : A[g] * oth[g];
            R *= SP0;
            float w[16];
#pragma unroll
            for (int r = 0; r < 16; ++r) w[r] = (e[r] * sf[r]) * A[r >> 2];
#pragma unroll
            for (int s2 = 0; s2 < 2; ++s2) {
                u32x4 pw; pw.x = pk2(w[8 * s2 + 0], w[8 * s2 + 1]); pw.y = pk2(w[8 * s2 + 2], w[8 * s2 + 3]); pw.z = pk2(w[8 * s2 + 4], w[8 * s2 + 5]); pw.w = pk2(w[8 * s2 + 6], w[8 * s2 + 7]);
                const bf16x8 pa = __builtin_bit_cast(bf16x8, pw);
#pragma unroll
                for (int db = 0; db < 4; ++db) {
                    const s16x4 lo = __builtin_bit_cast(s16x4, __builtin_amdgcn_ds_read_tr16_b64_v4i16((LAS s16x4*)(vp + (16 * s2) * VS + db * 64)));
                    const s16x4 hh = __builtin_bit_cast(s16x4, __builtin_amdgcn_ds_read_tr16_b64_v4i16((LAS s16x4*)(vp + (16 * s2 + 8) * VS + db * 64)));
                    const bf16x8 vb = __builtin_shufflevector(lo, hh, 0, 1, 2, 3, 4, 5, 6, 7);
                    o[db] = __builtin_amdgcn_mfma_f32_32x32x16_bf16(pa, vb, o[db], 0, 0, 0);
                }
            }
}

template <bool SAMPLE>
__device__ __forceinline__ void attn_item(const Args& a, LAS unsigned char* lds, int code) {
    constexpr int NH = SAMPLE ? 4 : 1, KS = NH * 256 + 16, VS = NH * 256 + 32, K_OFF = 0, V_OFF = 32 * KS;
    int tid_ = threadIdx.x; asm volatile("" : "+v"(tid_));
    const int tid = tid_, lane = tid & 63, r32 = lane & 31, hi = lane >> 5; const int wid = __builtin_amdgcn_readfirstlane(tid >> 6);
    unsigned char* ws = a.ws;
    int slot, nsteps, kvpos0, qw, head, hl; size_t qrow;
    const bf16 *kgb = nullptr, *vgb = nullptr; const float *kgf = nullptr, *vgf = nullptr, *kgn = nullptr, *vgn = nullptr;
    if (SAMPLE) {
        const int b = (code >> 1) & 7, hg = (code >> 4) & 1;
        slot = 256 + b * 2 + hg; hl = wid >> 1; head = hg * 4 + hl; const int rg = wid & 1;
        qw = PAST + 32 * rg; qrow = (size_t)NP + b * DSEQ + 32 * rg + r32;
        nsteps = 130; kvpos0 = 0;
        kgf = a.in[2] + ((size_t)b * PAST + (tid >> 7)) * AW + hg * 512 + 4 * (tid & 127); vgf = a.in[3] + ((size_t)b * PAST + (tid >> 7)) * AW + hg * 512 + 4 * (tid & 127);
        kgn = a.out + OFF_KS + ((size_t)b * DSEQ + (tid >> 7)) * AW + hg * 512 + 4 * (tid & 127); vgn = a.out + OFF_VS + ((size_t)b * DSEQ + (tid >> 7)) * AW + hg * 512 + 4 * (tid & 127);
    } else {
        const int bh = (code >> 1) & 15, qb = (code >> 5) & 15, c = (code >> 9) & 3, b = bh >> 3;
        head = bh & 7; hl = 0; slot = bh * 16 + qb + 0 * c; nsteps = p_nsteps(qb, c); kvpos0 = 0;
        qw = qb * 256 + 32 * wid; qrow = (size_t)b * SEQ + qw + r32;
        kgb = (const bf16*)(ws + WS_K) + ((size_t)b * SEQ + kvpos0 + (tid >> 4)) * AW + head * 128 + (tid & 15) * 8;
        vgb = (const bf16*)(ws + WS_V) + ((size_t)b * SEQ + kvpos0 + (tid >> 4)) * AW + head * 128 + (tid & 15) * 8;
    }
    const int qpos = qw + r32;
    constexpr int Q_OFF = 67584, QS = 272;
    const LAS unsigned char* qlp = lds + Q_OFF + wid * (32 * QS) + r32 * QS + hi * 16;
    { const bf16* qp = (const bf16*)(ws + WS_Q) + qrow * AW + head * 128 + hi * 8;
#pragma unroll
      for (int d0 = 0; d0 < 8; ++d0) *(LAS bf16x8*)(lds + Q_OFF + wid * (32 * QS) + r32 * QS + hi * 16 + d0 * 32) = *(const bf16x8*)(qp + 16 * d0); }
    f32x16 o[4];
#pragma unroll
    for (int i = 0; i < 4; ++i)
#pragma unroll
        for (int r = 0; r < 16; ++r) o[i][r] = 0.f;
    float R = 1.f;
    u32x4 kreg, vreg; f32x4 kf4[8], vf4[8];
#define ATT_LOADK(s_) do { if (SAMPLE) { _Pragma("unroll") for (int i_ = 0; i_ < 8; ++i_) kf4[i_] = *(const f32x4*)(((s_) >= 128 ? kgn + (size_t)((s_) - 128) * 32 * AW : kgf + (size_t)(s_) * 32 * AW) + (size_t)i_ * 4 * AW); } \
        else { kreg = *(const u32x4*)(kgb + (size_t)(s_) * 32 * AW); } } while (0)
#define ATT_LOADV(s_) do { if (SAMPLE) { _Pragma("unroll") for (int i_ = 0; i_ < 8; ++i_) vf4[i_] = *(const f32x4*)(((s_) >= 128 ? vgn + (size_t)((s_) - 128) * 32 * AW : vgf + (size_t)(s_) * 32 * AW) + (size_t)i_ * 4 * AW); } \
        else { vreg = *(const u32x4*)(vgb + (size_t)(s_) * 32 * AW); } } while (0)
#define ATT_STOREK() do { if (SAMPLE) { _Pragma("unroll") for (int i_ = 0; i_ < 8; ++i_) { const int key_ = (tid >> 7) + 4 * i_, f4_ = tid & 127; \
            u32x2 kw_; kw_.x = pk2(kf4[i_][0], kf4[i_][1]); kw_.y = pk2(kf4[i_][2], kf4[i_][3]); *(LAS u32x2*)(lds + K_OFF + key_ * KS + f4_ * 8) = kw_; } } \
        else { *(LAS u32x4*)(lds + K_OFF + (tid >> 4) * KS + (tid & 15) * 16) = kreg; } } while (0)
#define ATT_STOREV() do { if (SAMPLE) { _Pragma("unroll") for (int i_ = 0; i_ < 8; ++i_) { const int key_ = (tid >> 7) + 4 * i_, f4_ = tid & 127; \
            u32x2 vw_; vw_.x = pk2(vf4[i_][0], vf4[i_][1]); vw_.y = pk2(vf4[i_][2], vf4[i_][3]); *(LAS u32x2*)(lds + V_OFF + key_ * VS + f4_ * 8) = vw_; } } \
        else { *(LAS u32x4*)(lds + V_OFF + (tid >> 4) * VS + (tid & 15) * 16) = vreg; } } while (0)
    volatile LAS int* flg = (volatile LAS int*)(lds + MISC_OFF + 64);
    ATT_LOADK(nsteps - 1); ATT_LOADV(nsteps - 1);
    ATT_STOREK(); ATT_STOREV();
    __syncthreads();
    const LAS unsigned char* kp = lds + K_OFF + r32 * KS + hl * 256 + hi * 16;
    const LAS unsigned char* vp = lds + V_OFF + (4 * hi + ((lane & 15) >> 2)) * VS + hl * 256 + (16 * ((lane >> 4) & 1) + 4 * (lane & 3)) * 2;
    for (int s = nsteps - 1; s >= 0; --s) {
        if (s > 0) { ATT_LOADK(s - 1); if (!SAMPLE) ATT_LOADV(s - 1); }
        const int kb = kvpos0 + 32 * s;
        if (kb < qw + 32 && !__all(R == 0.f)) { const bf16x8 qdummy[8] = {}; sb_block<VS, false>(o, R, kp, vp, qdummy, qlp, kb, qw, qpos, hi); }
        if (lane == 0) flg[wid] = __all(R == 0.f) ? 1 : 0;
        __syncthreads();
        const bool alldone = (flg[0] & flg[1] & flg[2] & flg[3] & flg[4] & flg[5] & flg[6] & flg[7]) != 0;
        if (alldone) { __syncthreads(); break; }
        if (s > 0) { ATT_STOREK(); if (SAMPLE) ATT_LOADV(s - 1); ATT_STOREV(); }
        __syncthreads();
    }
#undef ATT_LOADK
#undef ATT_LOADV
#undef ATT_STOREK
#undef ATT_STOREV
    float* op = (float*)(ws + WS_OP) + ((size_t)(slot * 8 + wid) * 32) * 128;
#pragma unroll
    for (int db = 0; db < 4; ++db)
#pragma unroll
        for (int r = 0; r < 16; ++r) op[crow(r, hi) * 128 + db * 32 + r32] = o[db][r];
    if (hi == 0) ((float*)(ws + WS_TP))[(slot * 8 + wid) * 32 + r32] = R;
}


__device__ __forceinline__ void attn_item_p(const Args& a, LAS unsigned char* lds, int code) {
    constexpr int KS = 272, VS = 288, TILE_K = 64 * KS, BUF = TILE_K + 64 * VS;
    int tid_ = threadIdx.x; asm volatile("" : "+v"(tid_));
    const int tid = tid_, lane = tid & 63, r32 = lane & 31, hi = lane >> 5; const int wid = __builtin_amdgcn_readfirstlane(tid >> 6);
    unsigned char* ws = a.ws;
    const int bh = (code >> 1) & 15, qb = (code >> 5) & 15, c = (code >> 9) & 3, b = bh >> 3, head = bh & 7;
    const int slot = bh * 16 + qb + 0 * c, nst = p_nsteps(qb, c) >> 1, kvpos0 = 0;
    const int qw = qb * 256 + 32 * wid, qpos = qw + r32; const size_t qrow = (size_t)b * SEQ + qpos;
    const bf16* kgb = (const bf16*)(ws + WS_K) + ((size_t)b * SEQ + kvpos0 + (tid >> 4)) * AW + head * 128 + (tid & 15) * 8;
    const bf16* vgb = (const bf16*)(ws + WS_V) + ((size_t)b * SEQ + kvpos0 + (tid >> 4)) * AW + head * 128 + (tid & 15) * 8;
    bf16x8 qf[8];
    { const bf16* qp = (const bf16*)(ws + WS_Q) + qrow * AW + head * 128 + hi * 8;
#pragma unroll
      for (int d0 = 0; d0 < 8; ++d0) qf[d0] = *(const bf16x8*)(qp + 16 * d0); }
    f32x16 o[4];
#pragma unroll
    for (int i = 0; i < 4; ++i)
#pragma unroll
        for (int r = 0; r < 16; ++r) o[i][r] = 0.f;
    float R = 1.f;
    u32x4 kreg[2], vreg[2];
#define PLOAD(s_) do { _Pragma("unroll") for (int i_ = 0; i_ < 2; ++i_) { kreg[i_] = *(const u32x4*)(kgb + (size_t)((s_) * 64 + 32 * i_) * AW); vreg[i_] = *(const u32x4*)(vgb + (size_t)((s_) * 64 + 32 * i_) * AW); } } while (0)
#define PSTORE(buf_) do { _Pragma("unroll") for (int i_ = 0; i_ < 2; ++i_) { *(LAS u32x4*)(lds + (buf_) * BUF + ((tid >> 4) + 32 * i_) * KS + (tid & 15) * 16) = kreg[i_]; \
        *(LAS u32x4*)(lds + (buf_) * BUF + TILE_K + ((tid >> 4) + 32 * i_) * VS + (tid & 15) * 16) = vreg[i_]; } } while (0)
    volatile LAS int* flg = (volatile LAS int*)(lds + MISC_OFF + 64);
    PLOAD(nst - 1);
    PSTORE(0);
    __syncthreads();
    const LAS unsigned char* kp = lds + r32 * KS + hi * 16;
    const LAS unsigned char* vp = lds + TILE_K + (4 * hi + ((lane & 15) >> 2)) * VS + (16 * ((lane >> 4) & 1) + 4 * (lane & 3)) * 2;
    int cur = 0;
    for (int s = nst - 1; s >= 0; --s) {
        if (s > 0) PLOAD(s - 1);
#pragma unroll
        for (int blk = 1; blk >= 0; --blk) {
            const int kb = kvpos0 + 64 * s + 32 * blk;
            if (kb < qw + 32 && !__all(R == 0.f)) sb_block<VS, true>(o, R, kp + cur * BUF + blk * 32 * KS, vp + cur * BUF + blk * 32 * VS, qf, kp, kb, qw, qpos, hi);
        }
        volatile LAS int* fl = flg + 8 * (s & 1);
        if (lane == 0) fl[wid] = __all(R == 0.f) ? 1 : 0;
        if (s > 0) PSTORE(cur ^ 1);
        __syncthreads();
        if ((fl[0] & fl[1] & fl[2] & fl[3] & fl[4] & fl[5] & fl[6] & fl[7]) != 0) break;
        cur ^= 1;
    }
#undef PLOAD
#undef PSTORE
    float* op = (float*)(ws + WS_OP) + ((size_t)(slot * 8 + wid) * 32) * 128;
#pragma unroll
    for (int db = 0; db < 4; ++db)
#pragma unroll
        for (int r = 0; r < 16; ++r) op[crow(r, hi) * 128 + db * 32 + r32] = o[db][r];
    if (hi == 0) ((float*)(ws + WS_TP))[(slot * 8 + wid) * 32 + r32] = R;
}

struct MixRow { int m, t; const float* st; f32x4 op[4]; u32x4 u2[2], u1[2], u0[2], gb[2]; };
__device__ __forceinline__ void mix_load(const Args& a, MixRow& R, int m, int lane) {
    unsigned char* ws = a.ws;
    const float* OP = (const float*)(ws + WS_OP); const bf16* U = (const bf16*)(ws + WS_U); const bf16* GB = (const bf16*)(ws + WS_GB);
    const int h = lane >> 3, d0 = (lane & 7) * 16, c0 = lane * 16;
    int slot0, wid, q;
    if (m < NP) { const int b = m >> 12, t = m & 4095, qb = t >> 8; wid = (t & 255) >> 5; q = t & 31; slot0 = (b * 8 + h) * 16 + qb; R.t = t; R.st = nullptr; }
    else { const int r = m - NP, b = r >> 6, t = r & 63, rg = t >> 5; q = t & 31; wid = (h & 3) * 2 + rg; slot0 = 256 + b * 2 + (h >> 2); R.t = t; R.st = a.in[4] + (size_t)b * 2 * CC; }
    R.m = m;
    const f32x4* p = (const f32x4*)(OP + ((size_t)(slot0 * 8 + wid) * 32 + q) * 128 + d0);
#pragma unroll
    for (int i = 0; i < 4; ++i) R.op[i] = p[i];
    { const u32x4* pu = (const u32x4*)(U + (size_t)m * CC + c0); R.u2[0] = pu[0]; R.u2[1] = pu[1]; }
    if (R.t >= 1) { const u32x4* pu = (const u32x4*)(U + (size_t)(m - 1) * CC + c0); R.u1[0] = pu[0]; R.u1[1] = pu[1]; }
    if (R.t >= 2) { const u32x4* pu = (const u32x4*)(U + (size_t)(m - 2) * CC + c0); R.u0[0] = pu[0]; R.u0[1] = pu[1]; }
    { const u32x4* pg = (const u32x4*)(GB + (size_t)m * CC + c0); R.gb[0] = pg[0]; R.gb[1] = pg[1]; }
}
__device__ __forceinline__ void unpack16(const u32x4 (&x)[2], float (&o)[16]) {
    const unsigned ww[8] = {x[0].x, x[0].y, x[0].z, x[0].w, x[1].x, x[1].y, x[1].z, x[1].w};
#pragma unroll
    for (int i = 0; i < 8; ++i) { o[2 * i] = bflo(ww[i]); o[2 * i + 1] = bfhi(ww[i]); }
}
__device__ __forceinline__ void mix_finish(const Args& a, const MixRow& R, const float (&ga16)[16], const float (&gc16)[16], const float (&w0c)[16], const float (&w1c)[16], const float (&w2c)[16], int lane) {
    bf16* MIX = (bf16*)(a.ws + WS_MIX);
    const int h = lane >> 3, d0 = (lane & 7) * 16, c0 = lane * 16, m = R.m;
    float s = 0.f;
#pragma unroll
    for (int i = 0; i < 4; ++i) s += (R.op[i][0] * R.op[i][0] + R.op[i][1] * R.op[i][1]) + (R.op[i][2] * R.op[i][2] + R.op[i][3] * R.op[i][3]);
    float rs = __builtin_amdgcn_rsqf(wave_sum(s) * (1.0f / AW) + EPS);
    { unsigned ww[8];
#pragma unroll
      for (int i = 0; i < 8; ++i) ww[i] = pk2(R.op[i >> 1][(2 * i) & 3] * rs * ga16[2 * i], R.op[i >> 1][(2 * i + 1) & 3] * rs * ga16[2 * i + 1]);
      u32x4 w0, w1; w0.x = ww[0]; w0.y = ww[1]; w0.z = ww[2]; w0.w = ww[3]; w1.x = ww[4]; w1.y = ww[5]; w1.z = ww[6]; w1.w = ww[7];
      u32x4* o = (u32x4*)(MIX + (size_t)m * DM + h * 128 + d0); o[0] = w0; o[1] = w1; }
    float u0[16], u1[16], u2[16], gbv[16];
    unpack16(R.u2, u2); unpack16(R.gb, gbv);
    if (R.t >= 1) unpack16(R.u1, u1); else {
#pragma unroll
        for (int i = 0; i < 16; ++i) u1[i] = R.st ? R.st[CC + c0 + i] : 0.f; }
    if (R.t >= 2) unpack16(R.u0, u0); else {
#pragma unroll
        for (int i = 0; i < 16; ++i) u0[i] = R.st ? R.st[(R.t == 0 ? 0 : CC) + c0 + i] : 0.f; }
    float oc[16]; float s2 = 0.f;
#pragma unroll
    for (int i = 0; i < 16; ++i) { oc[i] = gbv[i] * (w0c[i] * u0[i] + w1c[i] * u1[i] + w2c[i] * u2[i]); s2 += oc[i] * oc[i]; }
    rs = __builtin_amdgcn_rsqf(wave_sum(s2) * (1.0f / CC) + EPS);
    { unsigned ww[8];
#pragma unroll
      for (int i = 0; i < 8; ++i) ww[i] = pk2(oc[2 * i] * rs * gc16[2 * i], oc[2 * i + 1] * rs * gc16[2 * i + 1]);
      u32x4 w0, w1; w0.x = ww[0]; w0.y = ww[1]; w0.z = ww[2]; w0.w = ww[3]; w1.x = ww[4]; w1.y = ww[5]; w1.z = ww[6]; w1.w = ww[7];
      u32x4* o = (u32x4*)(MIX + (size_t)m * DM + AW + c0); o[0] = w0; o[1] = w1; }
}
__device__ __forceinline__ void mix_rows(const Args& a, int gw, int NGW, int lane) {
    const float* cw = a.in[9]; const float* ga = a.in[10]; const float* gc = a.in[11];
    const int h = lane >> 3, d0 = (lane & 7) * 16, c0 = lane * 16;
    float ga16[16], gc16[16], w0c[16], w1c[16], w2c[16];
#pragma unroll
    for (int i = 0; i < 4; ++i) {
        const f32x4 x0 = *(const f32x4*)(ga + h * 128 + d0 + 4 * i), x1 = *(const f32x4*)(gc + c0 + 4 * i), x2 = *(const f32x4*)(cw + c0 + 4 * i), x3 = *(const f32x4*)(cw + CC + c0 + 4 * i), x4 = *(const f32x4*)(cw + 2 * CC + c0 + 4 * i);
#pragma unroll
        for (int j = 0; j < 4; ++j) { ga16[4 * i + j] = x0[j]; gc16[4 * i + j] = x1[j]; w0c[4 * i + j] = x2[j]; w1c[4 * i + j] = x3[j]; w2c[4 * i + j] = x4[j]; }
    }
    for (int m = gw; m < MT; m += 2 * NGW) {
        MixRow A, B; const bool hasB = m + NGW < MT;
        mix_load(a, A, m, lane);
        if (hasB) mix_load(a, B, m + NGW, lane);
        mix_finish(a, A, ga16, gc16, w0c, w1c, w2c, lane);
        if (hasB) mix_finish(a, B, ga16, gc16, w0c, w1c, w2c, lane);
    }
}
#ifndef NCONV
#define NCONV 96
#endif
#ifndef REP_P0
#define REP_P0 1
#endif
#ifndef REP_P1
#define REP_P1 1
#endif
#ifndef REP_P3
#define REP_P3 1
#endif
#ifndef REP_P4
#define REP_P4 1
#endif
#ifndef REP_P5
#define REP_P5 1
#endif
__global__ void __launch_bounds__(NWAVES * 64, 2) fwd_megakernel(Args args) {
    extern __shared__ __attribute__((aligned(16))) unsigned char lds_raw[];
    cg::grid_group grid = cg::this_grid();
    LAS unsigned char* lds = (LAS unsigned char*)lds_raw;
    const int G = gridDim.x, bx = blockIdx.x, NGW = G * NWAVES;
#define PHASE_IDS() int tid = threadIdx.x; asm volatile("" : "+v"(tid)); const int lane = tid & 63; const int wave = __builtin_amdgcn_readfirstlane(tid >> 6); const int gw = bx * NWAVES + wave; (void)lane; (void)gw
    unsigned char* ws = args.ws;
    unsigned* ctl = (unsigned*)(ws + WS_CTL);
    LAS float* red = (LAS float*)(lds + RED_OFF);
    volatile LAS int* misc = (volatile LAS int*)(lds + MISC_OFF);

    { PHASE_IDS(); if (bx == 0 && tid == 0) { ctl[0] = 0u; ctl[64] = 0u; ctl[256] = 0u; }
      if (bx == 0) for (int i = tid; i < XCD_BAR_WORDS; i += NWAVES * 64) ctl[4096 + i] = 0u;
      if (tid < 2) misc[8 + tid] = 0;
#ifndef NO_P0
    for (int rep_ = 0; rep_ < REP_P0; ++rep_) p0_prologue(args, lds, gw, NGW, lane, wave);
#endif
    }
    grid.sync();
    XcdBarrier xbar = xcd_barrier_post(ctl + 4096, (volatile LAS unsigned*)(lds + MISC_OFF) + 8);

#ifndef NO_P1
    for (int rep_ = 0; rep_ < REP_P1; ++rep_) {
        pg8::Gemm g{(const pg8::bf16_t*)(ws + WS_HN), (const pg8::bf16_t*)(ws + WS_WIN), MT, INC, DM}; typedef pg8::InProjOrder Ord; Ord S; S.init(G, bx);
        pg8::EpiIn E{(bf16*)(ws + WS_Q), (bf16*)(ws + WS_K), (bf16*)(ws + WS_V), (bf16*)(ws + WS_GB), (bf16*)(ws + WS_U), args.out, args.in[7], args.in[8], red,
                     1.4426950408889634f * 0.08838834764831845f, OFF_KP, OFF_VP, OFF_CP, OFF_KS, OFF_VS, OFF_CS};
        pg8::gemm_phase<pg8::EpiIn, Ord, true, true>(lds, g, S, E);
    }
#endif
    xcd_barrier(xbar);

#ifndef NO_P2
    {
        const int nitems = g_items.n;
        PHASE_IDS();
#ifdef DUP_P2
        for (int rep = 0; rep < 2; ++rep)
#else
        const int rep = 0;
#endif
        for (;;) {
            if (tid == 0) misc[0] = (int)atomicAdd(ctl + 64 * rep, 1u);
            __syncthreads();
            int it = misc[0];
            __syncthreads();
            if (it < 48) {
                pg8::Gemm g{(const pg8::bf16_t*)(ws + WS_HN), (const pg8::bf16_t*)(ws + WS_WIN), MT, INC, DM};
                pg8::OneUnit S1; S1.u0.pm = 30 + (it & 3); S1.u0.pn = 12 + (it >> 2); S1.u0.k0 = 0; S1.u0.nt = 32; S1.u0.split = 0; S1.u0.tu = 0; S1.u0.sp = 0;
                pg8::EpiIn E{(bf16*)(ws + WS_Q), (bf16*)(ws + WS_K), (bf16*)(ws + WS_V), (bf16*)(ws + WS_GB), (bf16*)(ws + WS_U), args.out, args.in[7], args.in[8], red,
                             1.4426950408889634f * 0.08838834764831845f, OFF_KP, OFF_VP, OFF_CP, OFF_KS, OFF_VS, OFF_CS};
                pg8::gemm_phase<pg8::EpiIn, pg8::OneUnit, true, true>(lds, g, S1, E);
                __syncthreads();
                continue;
            }
            it -= 48;
            const bool token = it >= 16 && it < 16 + NCONV;
            if (token || it >= nitems + NCONV) {
                for (;;) {
                    if (tid == 0) misc[0] = (int)atomicAdd(ctl + 256, 1u);
                    __syncthreads();
                    const int ch = misc[0];
                    __syncthreads();
                    if (ch >= P0_LATE_CHUNKS) break;
                    p0_run_range(args, (LAS float*)(lds + wave * 16384), P0_EARLY_ITEMS + ch * P0_CHUNK + wave * (P0_CHUNK / NWAVES), P0_CHUNK / NWAVES, lane);
                }
                if (token) continue;
                break;
            }
            if (it >= 16) it -= NCONV;
            const int code = g_items.v[it];
#if defined(ONLY_S)
            attn_item<true>(args, lds, code);
#elif defined(ONLY_P)
            attn_item_p(args, lds, code);
#else
            if (code & 1) attn_item<true>(args, lds, code); else attn_item_p(args, lds, code);
#endif
        }
    }
#endif
    xcd_barrier(xbar);

#ifndef NO_P3
    for (int rep_ = 0; rep_ < REP_P3; ++rep_) { PHASE_IDS(); mix_rows(args, gw, NGW, lane); }
#endif
    xcd_barrier(xbar);

#ifndef NO_P4
    for (int rep_ = 0; rep_ < REP_P4; ++rep_) {
        pg8::Gemm g{(const pg8::bf16_t*)(ws + WS_MIX), (const pg8::bf16_t*)(ws + WS_WOUT), MT, DM, DM}; typedef pg8::TailOrderT<MT / 256, DM / 256, DM / 64, 8> Ord; Ord S; S.init(G, bx);
        pg8::EpiOut E{args.in[0], args.in[1], args.out + OFF_Y, (bf16*)(ws + WS_HN), (float*)(ws + WS_SSQ), red, (float*)(ws + WS_PART)};
        pg8::gemm_phase<pg8::EpiOut, Ord, true, true>(lds, g, S, E);
        if (S.rem > 0) {
            xcd_barrier(xbar);
            PHASE_IDS();
            for (int w = gw; w < S.rem * 256; w += NGW) {
                const int tu = w >> 8, r = w & 255; pg8::Unit u; Ord::SO::unit(S.full * G + tu, u);
                const size_t row = (size_t)u.pm * 256 + r; const int col = u.pn * 256 + 4 * lane;
                const float* xin = row < NP ? args.in[0] + row * DM : args.in[1] + (row - NP) * DM;
                f32x4 v = *(const f32x4*)(xin + col);
                const bf16* p = (const bf16*)(ws + WS_PART) + (size_t)(tu * 8) * 65536 + r * 256 + 4 * lane;
                u32x2 sl[8];
#pragma unroll
                for (int s = 0; s < 8; ++s) sl[s] = *(const u32x2*)(p + (size_t)s * 65536);
#pragma unroll
                for (int s = 0; s < 8; ++s) { v[0] += bflo(sl[s].x); v[1] += bfhi(sl[s].x); v[2] += bflo(sl[s].y); v[3] += bfhi(sl[s].y); }
                *(f32x4*)(args.out + OFF_Y + row * DM + col) = v;
                u32x2 pk; pk.x = pk2(v[0], v[1]); pk.y = pk2(v[2], v[3]); *(u32x2*)((bf16*)(ws + WS_HN) + row * DM + col) = pk;
                const float ss = wave_sum((v[0] * v[0] + v[1] * v[1]) + (v[2] * v[2] + v[3] * v[3]));
                if (lane == 0) ((float*)(ws + WS_SSQ))[row * 8 + u.pn] = ss;
            }
        }
    }
#endif
    xcd_barrier(xbar);

#ifndef NO_P5
    for (int rep_ = 0; rep_ < REP_P5; ++rep_) {
        pg8::Gemm g{(const pg8::bf16_t*)(ws + WS_HN), (const pg8::bf16_t*)(ws + WS_WGU), MT, 2 * DFF, DM}; typedef pg8::StaticOrderT<MT / 256, 2 * DFF / 256, DM / 64> Ord; Ord S; S.init(G, bx);
        pg8::EpiGU E{(bf16*)(ws + WS_H), (const float*)(ws + WS_SSQ)};
        pg8::gemm_phase<pg8::EpiGU, Ord, true, true>(lds, g, S, E);
    }
#endif
    xcd_barrier(xbar);

#ifndef NO_P6
    {
        pg8::Gemm g{(const pg8::bf16_t*)(ws + WS_H), (const pg8::bf16_t*)(ws + WS_WDN), MT, DM, DFF};
        typedef pg8::TailOrderT<MT / 256, DM / 256, DFF / 64, 8> Ord; Ord S; S.init(G, bx);
        pg8::EpiDown E{args.out + OFF_Y, (float*)(ws + WS_PART), (const pg8::bf16_t*)(ws + WS_HN)};
        pg8::gemm_phase<pg8::EpiDown, Ord, true, true>(lds, g, S, E);
        if (S.rem > 0) {
            xcd_barrier(xbar);
            PHASE_IDS();
            for (int w = gw; w < S.rem * 256; w += NGW) {
                const int tu = w >> 8, r = w & 255; pg8::Unit u; Ord::SO::unit(S.full * G + tu, u);
                float* y = args.out + OFF_Y + ((size_t)u.pm * 256 + r) * DM + u.pn * 256 + 4 * lane;
                f32x4 v = *(const f32x4*)y;
                const bf16* p = (const bf16*)(ws + WS_PART) + (size_t)(tu * 8) * 65536 + r * 256 + 4 * lane;
                u32x2 sl[8];
#pragma unroll
                for (int s = 0; s < 8; ++s) sl[s] = *(const u32x2*)(p + (size_t)s * 65536);
#pragma unroll
                for (int s = 0; s < 8; ++s) { v[0] += bflo(sl[s].x); v[1] += bfhi(sl[s].x); v[2] += bflo(sl[s].y); v[3] += bfhi(sl[s].y); }
                *(f32x4*)y = v;
            }
        }
    }
#endif
}

extern "C" void kernel_launch(void* const* d_in, const int* in_sizes, int n_in, void* d_out, int out_size, void* d_ws, size_t ws_size, hipStream_t stream) {
    static int grid = 0;
    if (grid == 0) {
        if (n_in != 17 || (size_t)out_size != OUT_TOTAL || ws_size < WS_END) { fprintf(stderr, "kernel_launch: unexpected shapes (n_in %d out %d ws %zu need %zu)\n", n_in, out_size, ws_size, (size_t)WS_END); grid = -1; return; }
        int dev = 0, cus = 0, per_cu = 0;
        hipGetDevice(&dev); hipDeviceGetAttribute(&cus, hipDeviceAttributeMultiprocessorCount, dev);
        hipFuncSetAttribute((const void*)fwd_megakernel, hipFuncAttributeMaxDynamicSharedMemorySize, LDS_BYTES);
        hipOccupancyMaxActiveBlocksPerMultiprocessor(&per_cu, (const void*)fwd_megakernel, NWAVES * 64, LDS_BYTES);
        if (per_cu < 1) { fprintf(stderr, "kernel_launch: occupancy query says %d blocks per CU\n", per_cu); per_cu = 1; }
        (void)hipGetLastError();
        grid = cus;
    }
    if (grid < 0) return;
    Args a{};
    for (int i = 0; i < 17; ++i) a.in[i] = (const float*)d_in[i];
    a.out = (float*)d_out; a.ws = (unsigned char*)d_ws;
    void* kargs[] = {&a};
    hipError_t e = hipLaunchCooperativeKernel((const void*)fwd_megakernel, dim3(grid), dim3(NWAVES * 64), kargs, LDS_BYTES, stream);
    if (e != hipSuccess) fprintf(stderr, "cooperative launch failed: %s (grid %d)\n", hipGetErrorString(e), grid);
}
```

```cpp
#include <hip/hip_runtime.h>
#include <hip/hip_cooperative_groups.h>
#include <cstdio>
#include <cstdint>
namespace cg = cooperative_groups;
namespace pg8 {
#define PG8_LAS __attribute__((address_space(3)))
typedef unsigned short bf16_t;
typedef short bf16x8 __attribute__((ext_vector_type(8)));
typedef float f32x4 __attribute__((ext_vector_type(4)));
typedef unsigned u32x4 __attribute__((ext_vector_type(4)));
constexpr int BM = 256, BK = 64, HALF = 128, HTB = HALF * BK * 2  , STAGE_BYTES = 8 * HTB, NXCD = 8, WGM = 8;

__host__ __device__ __forceinline__ int lds_byte(int r, int c) { const int st = (r >> 4) * 2 + (c >> 5), rr = r & 15, cc = c & 31, ob = rr * 64 + cc * 2; return st * 1024 + (ob ^ (((ob >> 9) & 1) << 5)); }
__host__ __device__ __forceinline__ void stage_rc(int b, int& R, int& C) { const int st = b / 1024, sb = b % 1024, swz = sb ^ (((sb >> 9) & 1) << 5); R = (st >> 1) * 16 + swz / 64; C = (st & 1) * 32 + (swz % 64) / 2; }
__host__ __device__ __forceinline__ int perm32(int rho) { const int n = rho >> 4, i = rho & 15; return 8 * (i >> 2) + 4 * n + (i & 3); }

struct Unit { int pm, pn, k0, nt, split, tu, sp; };
struct Gemm { const bf16_t* A; const bf16_t* Bt; int M, N, K; };

template <int NM, int NN, int NTK> struct StaticOrderT {
    static constexpr int nM = NM, nN = NN, nwg = NM * NN, ntk = NTK;
    int G, c;
    __host__ __device__ __forceinline__ void init(int G_, int c_) { G = G_; c = c_; }
    __host__ __device__ __forceinline__ bool next(int i, Unit& u) const { const int L = i * G + c; if (L >= nwg) return false; unit(L, u); return true; }
    __host__ __device__ __forceinline__ static void unit(int L, Unit& u) {
        int wgid = L; { constexpr int q = nwg / NXCD, r = nwg % NXCD; const int xcd = wgid % NXCD, off = wgid / NXCD; wgid = (xcd < r ? xcd * (q + 1) : r * (q + 1) + (xcd - r) * q) + off; }
        constexpr int nig = WGM * nN; const int gid = wgid / nig, fm = gid * WGM, gsz = (nM - fm) < WGM ? (nM - fm) : WGM;
        u.pm = fm + ((wgid % nig) % gsz); u.pn = (wgid % nig) / gsz; u.k0 = 0; u.nt = ntk; u.split = 0; u.tu = 0; u.sp = 0;
    }
    __device__ __forceinline__ void a_ready(const Unit&) const {}
    __device__ __forceinline__ void done(const Unit&) const {}
};
template <int NM, int NN, int NTK, int NSPLIT> struct TailOrderT {
    typedef StaticOrderT<NM, NN, NTK> SO;
    int G, c, full, rem;
    __host__ __device__ __forceinline__ void init(int G_, int c_) { G = G_; c = c_; full = SO::nwg / G; rem = SO::nwg - full * G; if (rem * NSPLIT > G || NTK < 2 * NSPLIT) { full = 1 << 24; rem = 0; } }
    __host__ __device__ __forceinline__ static int kstart(int s) { return s >= NSPLIT ? NTK : ((s * NTK / NSPLIT) & ~1); }
    __host__ __device__ __forceinline__ bool next(int i, Unit& u) const {
        if (i < full) { const int L = i * G + c; if (L >= SO::nwg) return false; SO::unit(L, u); return true; }
        if (i > full || c >= rem * NSPLIT) return false;
        const int tu = c / NSPLIT, sp = c % NSPLIT; SO::unit(full * G + tu, u); u.k0 = kstart(sp); u.nt = kstart(sp + 1) - u.k0; u.split = 1; u.tu = tu; u.sp = sp; return true;
    }
    __device__ __forceinline__ void a_ready(const Unit&) const {}
    __device__ __forceinline__ void done(const Unit&) const {}
};

struct InProjOrder {
    typedef StaticOrderT<30, 24, 32> SO;
    int G, c;
    __host__ __device__ __forceinline__ void init(int G_, int c_) { G = G_; c = c_; }
    __host__ __device__ __forceinline__ bool next(int i, Unit& u) const {
        const int L = i * G + c; if (L >= 768) return false;
        if (L < 720) { SO::unit(L, u); return true; }
        const int j = L - 720; u.pm = 30 + (j & 3); u.pn = j >> 2; u.k0 = 0; u.nt = 32; u.split = 0; u.tu = 0; u.sp = 0; return true;
    }
    __device__ __forceinline__ void a_ready(const Unit&) const {}
    __device__ __forceinline__ void done(const Unit&) const {}
};
struct OneUnit {
    Unit u0;
    __host__ __device__ __forceinline__ bool next(int i, Unit& u) const { if (i != 0) return false; u = u0; return true; }
    __device__ __forceinline__ void a_ready(const Unit&) const {}
    __device__ __forceinline__ void done(const Unit&) const {}
};

__device__ __forceinline__ unsigned cvt_pk_bf16(float lo, float hi) { unsigned r; asm volatile("v_cvt_pk_bf16_f32 %0, %1, %2" : "=v"(r) : "v"(lo), "v"(hi)); return r; }
typedef float f32x2 __attribute__((ext_vector_type(2)));
#define PG8_LBAR() asm volatile("s_waitcnt lgkmcnt(0)\n\ts_barrier" ::: "memory")
constexpr int NPROMPT = 8192;
__device__ __forceinline__ u32x4 pack8(const f32x4 a, const f32x4 b) { u32x4 w; w.x = cvt_pk_bf16(a[0], a[1]); w.y = cvt_pk_bf16(a[2], a[3]); w.z = cvt_pk_bf16(b[0], b[1]); w.w = cvt_pk_bf16(b[2], b[3]); return w; }


__device__ __forceinline__ void store_partial(float* part, int nsplit, const f32x4 (&acc)[2][2][4][2], const Unit& u, int wr, int wc, int fr, int fq) {
    bf16_t* pt = (bf16_t*)part + (size_t)(u.tu * nsplit + u.sp) * 65536; int rl0 = wr * 64 + fr, cw = wc * 32 + 8 * fq; asm volatile("" : "+v"(rl0), "+v"(cw));
#pragma unroll
    for (int ai = 0; ai < 2; ++ai)
#pragma unroll
        for (int m = 0; m < 4; ++m)
#pragma unroll
            for (int bj = 0; bj < 2; ++bj) *(u32x4*)(pt + (ai * HALF + rl0 + m * 16) * 256 + bj * HALF + cw) = pack8(acc[ai][bj][m][0], acc[ai][bj][m][1]);
}

struct EpiIn {
    static constexpr bool PERM = true, AFTER_DRAIN = false;
    bf16_t *Q, *Kb, *Vb, *GB, *U; float* out; const float *gq, *gk; PG8_LAS float* red; float qscale;
    size_t off_kp, off_vp, off_cp, off_ks, off_vs, off_cs;
    __device__ __forceinline__ void operator()(const f32x4 (&acc)[2][2][4][2], const Unit& u, int wr, int wc, int fr, int fq) const {
        int rl0 = wr * 64 + fr, cw = wc * 32 + 8 * fq; asm volatile("" : "+v"(rl0), "+v"(cw));
        const int pn = u.pn, rowt = u.pm * BM;
        const bool prompt = rowt < NPROMPT;
        if (pn < 8) {
            const bool isq = pn < 4;
#pragma unroll
            for (int ai = 0; ai < 2; ++ai)
#pragma unroll
                for (int m = 0; m < 4; ++m)
#pragma unroll
                    for (int bj = 0; bj < 2; ++bj) {
                        const f32x4 a = acc[ai][bj][m][0], b = acc[ai][bj][m][1];
                        float s = (a[0] * a[0] + a[1] * a[1]) + (a[2] * a[2] + a[3] * a[3]) + (b[0] * b[0] + b[1] * b[1]) + (b[2] * b[2] + b[3] * b[3]);
                        s += __shfl_xor(s, 16); s += __shfl_xor(s, 32);
                        if (fq == 0) red[((ai * HALF + rl0 + m * 16) * 2 + bj) * 4 + wc] = s;
                    }
            PG8_LBAR();
            const float* g = isq ? gq : gk;
            const f32x4 g0 = *(const f32x4*)(g + cw), g1 = *(const f32x4*)(g + cw + 4);
#pragma unroll
            for (int ai = 0; ai < 2; ++ai)
#pragma unroll
                for (int m = 0; m < 4; ++m) {
                    const int rl = ai * HALF + rl0 + m * 16; const size_t row = (size_t)(rowt + rl);
#pragma unroll
                    for (int bj = 0; bj < 2; ++bj) {
                        const f32x4 p = *(const PG8_LAS f32x4*)(red + (rl * 2 + bj) * 4);
                        float rs = __builtin_amdgcn_rsqf(((p[0] + p[1]) + (p[2] + p[3])) * (1.0f / 128.0f) + 1e-6f);
                        if (isq) rs *= qscale;
                        const f32x4 v0 = acc[ai][bj][m][0] * rs * g0, v1 = acc[ai][bj][m][1] * rs * g1;
                        if (isq) { *(u32x4*)(Q + row * 1024 + pn * 256 + bj * HALF + cw) = pack8(v0, v1); }
                        else {
                            const int col = (pn - 4) * 256 + bj * HALF + cw;
                            float* o = prompt ? out + off_kp + row * 1024 + col : out + off_ks + (row - NPROMPT) * 1024 + col;
                            *(f32x4*)o = v0; *(f32x4*)(o + 4) = v1;
                            if (prompt) *(u32x4*)(Kb + row * 1024 + col) = pack8(v0, v1);
                        }
                    }
                }
        } else if (pn < 12) {
#pragma unroll
            for (int ai = 0; ai < 2; ++ai)
#pragma unroll
                for (int m = 0; m < 4; ++m) {
                    const size_t row = (size_t)(rowt + ai * HALF + rl0 + m * 16);
#pragma unroll
                    for (int bj = 0; bj < 2; ++bj) {
                        const int col = (pn - 8) * 256 + bj * HALF + cw; const f32x4 v0 = acc[ai][bj][m][0], v1 = acc[ai][bj][m][1];
                        float* o = prompt ? out + off_vp + row * 1024 + col : out + off_vs + (row - NPROMPT) * 1024 + col;
                        *(f32x4*)o = v0; *(f32x4*)(o + 4) = v1;
                        if (prompt) *(u32x4*)(Vb + row * 1024 + col) = pack8(v0, v1);
                    }
                }
        } else if (pn < 16) {
#pragma unroll
            for (int ai = 0; ai < 2; ++ai)
#pragma unroll
                for (int m = 0; m < 4; ++m) {
                    const size_t row = (size_t)(rowt + ai * HALF + rl0 + m * 16);
#pragma unroll
                    for (int bj = 0; bj < 2; ++bj) *(u32x4*)(GB + row * 1024 + (pn - 12) * 256 + bj * HALF + cw) = pack8(acc[ai][bj][m][0], acc[ai][bj][m][1]);
                }
        } else {
#pragma unroll
            for (int ai = 0; ai < 2; ++ai)
#pragma unroll
                for (int m = 0; m < 4; ++m) {
                    const int rowi = rowt + ai * HALF + rl0 + m * 16; const int ch = (pn - 16) * HALF + cw;
                    const f32x4 v0 = acc[ai][0][m][0] * acc[ai][1][m][0], v1 = acc[ai][0][m][1] * acc[ai][1][m][1];
                    *(u32x4*)(U + (size_t)rowi * 1024 + ch) = pack8(v0, v1);
                    if (prompt) { const int t = rowi & 4095; if (t >= 4094) { float* o = out + off_cp + ((rowi >> 12) * 2 + (t - 4094)) * 1024 + ch; *(f32x4*)o = v0; *(f32x4*)(o + 4) = v1; } }
                    else { const int rs_ = rowi - NPROMPT, t = rs_ & 63; if (t >= 62) { float* o = out + off_cs + ((rs_ >> 6) * 2 + (t - 62)) * 1024 + ch; *(f32x4*)o = v0; *(f32x4*)(o + 4) = v1; } }
                }
        }
    }
};

struct EpiOut {
    static constexpr bool PERM = true, AFTER_DRAIN = false;
    const float *xp, *xs; float* Y; bf16_t* X1; float* ssq; PG8_LAS float* red; float* part;
    __device__ __forceinline__ void operator()(const f32x4 (&acc)[2][2][4][2], const Unit& u, int wr, int wc, int fr, int fq) const {
        if (u.split) { store_partial(part, 8, acc, u, wr, wc, fr, fq); return; }
        int rl0 = wr * 64 + fr, cw = wc * 32 + 8 * fq; asm volatile("" : "+v"(rl0), "+v"(cw));
        const int pn = u.pn, rowt = u.pm * BM;
        const float* xin = rowt < NPROMPT ? xp + (size_t)rowt * 2048 : xs + (size_t)(rowt - NPROMPT) * 2048;
#pragma unroll
        for (int ai = 0; ai < 2; ++ai) {
            f32x4 xv[4][2][2];
#pragma unroll
            for (int m = 0; m < 4; ++m)
#pragma unroll
                for (int bj = 0; bj < 2; ++bj) { const float* xi = xin + (size_t)(ai * HALF + rl0 + m * 16) * 2048 + pn * 256 + bj * HALF + cw; xv[m][bj][0] = *(const f32x4*)xi; xv[m][bj][1] = *(const f32x4*)(xi + 4); }
#pragma unroll
            for (int m = 0; m < 4; ++m) {
                const int rl = ai * HALF + rl0 + m * 16; float s = 0.f;
#pragma unroll
                for (int bj = 0; bj < 2; ++bj) {
                    const int col = pn * 256 + bj * HALF + cw;
                    const f32x4 v0 = xv[m][bj][0] + acc[ai][bj][m][0], v1 = xv[m][bj][1] + acc[ai][bj][m][1];
                    *(u32x4*)(X1 + (size_t)(rowt + rl) * 2048 + col) = pack8(v0, v1);
                    s += (v0[0] * v0[0] + v0[1] * v0[1]) + (v0[2] * v0[2] + v0[3] * v0[3]) + (v1[0] * v1[0] + v1[1] * v1[1]) + (v1[2] * v1[2] + v1[3] * v1[3]);
                }
                s += __shfl_xor(s, 16); s += __shfl_xor(s, 32);
                if (fq == 0) red[rl * 4 + wc] = s;
            }
            asm volatile("" ::: "memory");
        }
        PG8_LBAR();
        if (threadIdx.x < 256) { const f32x4 p = *(const PG8_LAS f32x4*)(red + threadIdx.x * 4); ssq[(size_t)(rowt + threadIdx.x) * 8 + pn] = (p[0] + p[1]) + (p[2] + p[3]); }
        PG8_LBAR();
    }
};

struct EpiGU {
    static constexpr bool PERM = true, AFTER_DRAIN = false;
    bf16_t* H; const float* ssq;
    __device__ __forceinline__ void operator()(const f32x4 (&acc)[2][2][4][2], const Unit& u, int wr, int wc, int fr, int fq) const {
        int rl0 = wr * 64 + fr, cw = wc * 32 + 8 * fq; asm volatile("" : "+v"(rl0), "+v"(cw));
        const int pn = u.pn, rowt = u.pm * BM;
        f32x4 pa[2][4], pb[2][4];
#pragma unroll
        for (int ai = 0; ai < 2; ++ai)
#pragma unroll
            for (int m = 0; m < 4; ++m) { const float* p = ssq + (size_t)(rowt + ai * HALF + rl0 + m * 16) * 8; pa[ai][m] = *(const f32x4*)p; pb[ai][m] = *(const f32x4*)(p + 4); }
#pragma unroll
        for (int ai = 0; ai < 2; ++ai)
#pragma unroll
            for (int m = 0; m < 4; ++m) {
                const size_t row = (size_t)(rowt + ai * HALF + rl0 + m * 16);
                const f32x4 p0 = pa[ai][m], p1 = pb[ai][m];
                const float rs = __builtin_amdgcn_rsqf((((p0[0] + p0[1]) + (p0[2] + p0[3])) + ((p1[0] + p1[1]) + (p1[2] + p1[3]))) * (1.0f / 2048.0f) + 1e-6f);
                f32x4 h[2];
#pragma unroll
                for (int n = 0; n < 2; ++n) {
                    const f32x4 g = acc[ai][0][m][n] * rs, up = acc[ai][1][m][n] * rs;
#pragma unroll
                    for (int j = 0; j < 4; ++j) h[n][j] = g[j] * __builtin_amdgcn_rcpf(1.0f + __builtin_amdgcn_exp2f(-1.4426950408889634f * g[j])) * up[j];
                }
                *(u32x4*)(H + row * 5632 + pn * HALF + cw) = pack8(h[0], h[1]);
            }
    }
};

struct EpiDown {
    static constexpr bool PERM = true, AFTER_DRAIN = false;
    float* Y; float* part; const bf16_t* X1;
    __device__ __forceinline__ void operator()(const f32x4 (&acc)[2][2][4][2], const Unit& u, int wr, int wc, int fr, int fq) const {
        if (u.split) { store_partial(part, 8, acc, u, wr, wc, fr, fq); return; }
        int rl0 = wr * 64 + fr, cw = wc * 32 + 8 * fq; asm volatile("" : "+v"(rl0), "+v"(cw));
        const int pn = u.pn, rowt = u.pm * BM;
        u32x4 xb[2][4][2];
#pragma unroll
        for (int ai = 0; ai < 2; ++ai)
#pragma unroll
            for (int m = 0; m < 4; ++m)
#pragma unroll
                for (int bj = 0; bj < 2; ++bj) xb[ai][m][bj] = *(const u32x4*)(X1 + (size_t)(rowt + ai * HALF + rl0 + m * 16) * 2048 + pn * 256 + bj * HALF + cw);
#pragma unroll
        for (int ai = 0; ai < 2; ++ai)
#pragma unroll
            for (int m = 0; m < 4; ++m)
#pragma unroll
                for (int bj = 0; bj < 2; ++bj) {
                    const size_t off = (size_t)(rowt + ai * HALF + rl0 + m * 16) * 2048 + pn * 256 + bj * HALF + cw;
                    const u32x4 x = xb[ai][m][bj];
                    f32x4 b0, b1; b0[0] = __builtin_bit_cast(float, x.x << 16); b0[1] = __builtin_bit_cast(float, x.x & 0xffff0000u); b0[2] = __builtin_bit_cast(float, x.y << 16); b0[3] = __builtin_bit_cast(float, x.y & 0xffff0000u);
                    b1[0] = __builtin_bit_cast(float, x.z << 16); b1[1] = __builtin_bit_cast(float, x.z & 0xffff0000u); b1[2] = __builtin_bit_cast(float, x.w << 16); b1[3] = __builtin_bit_cast(float, x.w & 0xffff0000u);
                    float* o = Y + off; *(f32x4*)o = b0 + acc[ai][bj][m][0]; *(f32x4*)(o + 4) = b1 + acc[ai][bj][m][1];
                }
    }
};

struct EpiNone {
    static constexpr bool PERM = true, AFTER_DRAIN = false;
    float* sink;
    __device__ __forceinline__ void operator()(const f32x4 (&acc)[2][2][4][2], const Unit& u, int wr, int wc, int fr, int fq) const {
        if (acc[0][0][0][0][0] == 12345.678f && acc[1][1][3][1][3] == -9876.5f) sink[0] = 1.f;
    }
};
template <class Epi, class Sched, bool ALIGN_EPI = false, bool SP2 = false>
__device__ __forceinline__ void gemm_phase(PG8_LAS unsigned char* lds, const Gemm g, const Sched& S, const Epi& E) {
    int tid_ = threadIdx.x; asm volatile("" : "+v"(tid_));
    const int tid = tid_, wid = __builtin_amdgcn_readfirstlane(tid >> 6), lane = tid & 63, wr = wid >> 2, wc = wid & 3, fr = lane & 15, fq = lane >> 4;
    const int K = g.K;
    unsigned voffA[2], voffB[2];
#pragma unroll
    for (int i = 0; i < 2; ++i) { int R, C; stage_rc(tid * 16 + i * 8192, R, C); const int Rb = Epi::PERM ? ((R & ~31) + perm32(R & 31)) : R;
        voffA[i] = (unsigned)(R * K + C) * 2u; voffB[i] = (unsigned)(Rb * K + C) * 2u; }
    const size_t kstep = (size_t)(BK * 2);
    const size_t hstep = (size_t)HALF * K * 2;
    const size_t tstep = 2 * hstep;
    const unsigned ldsw = (unsigned)wid * 1024u;
    const int aoff = lds_byte(wr * 64 + fr, fq * 8), boff = lds_byte(wc * 32 + fr, fq * 8);
#define PG8_SA(b, h) (((b) * 2 + (h)) * HTB)
#define PG8_SB(b, h) ((4 + (b) * 2 + (h)) * HTB)
#define PG8_STAGE(bufoff, gbase, voff) do { _Pragma("unroll") for (int _i = 0; _i < 2; ++_i) \
        __builtin_amdgcn_global_load_lds((const unsigned*)((const char*)(gbase) + (voff)[_i]), (PG8_LAS unsigned*)(lds + (bufoff) + ldsw + _i * 8192), 16, 0, 0); } while (0)
#define PG8_LDA(dst, b, h) do { _Pragma("unroll") for (int m = 0; m < 4; ++m) _Pragma("unroll") for (int k = 0; k < 2; ++k) dst[m][k] = *(const PG8_LAS bf16x8*)(lds + PG8_SA(b, h) + aoff + m * 2048 + k * 1024); } while (0)
#define PG8_LDB(dst, b, h) do { _Pragma("unroll") for (int n = 0; n < 2; ++n) _Pragma("unroll") for (int k = 0; k < 2; ++k) dst[n][k] = *(const PG8_LAS bf16x8*)(lds + PG8_SB(b, h) + boff + n * 2048 + k * 1024); } while (0)
#define PG8_MMA(ai, bj, At, Bt) do { __builtin_amdgcn_s_setprio(1); _Pragma("unroll") for (int m = 0; m < 4; ++m) _Pragma("unroll") for (int n = 0; n < 2; ++n) _Pragma("unroll") for (int k = 0; k < 2; ++k) \
        acc[ai][bj][m][n] = __builtin_amdgcn_mfma_f32_16x16x32_bf16(Bt[n][k], At[m][k], acc[ai][bj][m][n], 0, 0, 0); __builtin_amdgcn_s_setprio(0); } while (0)
#define PG8_WAIT_V(n) asm volatile("s_waitcnt vmcnt(" #n ")" ::: "memory")
#define PG8_WAIT_L(n) asm volatile("s_waitcnt lgkmcnt(" #n ")" ::: "memory")
#define PG8_BAR __builtin_amdgcn_s_barrier()
#define PG8_SCHED __builtin_amdgcn_sched_barrier(0)
    Unit cur, nxt; int ui = 0;
    if (!S.next(0, cur)) return;
    f32x4 acc[2][2][4][2];
#pragma unroll
    for (int a = 0; a < 2; ++a)
#pragma unroll
        for (int b = 0; b < 2; ++b)
#pragma unroll
            for (int m = 0; m < 4; ++m)
#pragma unroll
                for (int n = 0; n < 2; ++n) acc[a][b][m][n] = (f32x4){0.f, 0.f, 0.f, 0.f};
    bf16x8 At[4][2], B0[2][2], B1[2][2];
    const char* cA = (const char*)g.A + (size_t)cur.pm * tstep + (size_t)cur.k0 * kstep; const char* cB = (const char*)g.Bt + (size_t)cur.pn * tstep + (size_t)cur.k0 * kstep;
    S.a_ready(cur);
    if constexpr (SP2) {
        PG8_STAGE(PG8_SB(0, 0), cB, voffB); PG8_STAGE(PG8_SB(0, 1), cB + hstep, voffB); PG8_STAGE(PG8_SA(0, 0), cA, voffA); PG8_STAGE(PG8_SA(0, 1), cA + hstep, voffA);
        if (wr == 1) PG8_BAR;
        PG8_WAIT_V(2); PG8_BAR;
        PG8_STAGE(PG8_SB(1, 0), cB + kstep, voffB); PG8_STAGE(PG8_SA(1, 0), cA + kstep, voffA); PG8_STAGE(PG8_SB(1, 1), cB + hstep + kstep, voffB);
        PG8_WAIT_V(6); PG8_BAR;
    } else {
        PG8_STAGE(PG8_SB(0, 0), cB, voffB); PG8_STAGE(PG8_SA(0, 0), cA, voffA); PG8_STAGE(PG8_SB(0, 1), cB + hstep, voffB); PG8_STAGE(PG8_SA(0, 1), cA + hstep, voffA);
        if (wr == 1) PG8_BAR;
        PG8_WAIT_V(4); PG8_BAR;
        PG8_STAGE(PG8_SB(1, 0), cB + kstep, voffB); PG8_STAGE(PG8_SA(1, 0), cA + kstep, voffA); PG8_STAGE(PG8_SB(1, 1), cB + hstep + kstep, voffB);
        PG8_WAIT_V(6); PG8_BAR;
    }
    for (;;) {
        const bool has_next = S.next(ui + 1, nxt);
        const char* nA = has_next ? (const char*)g.A + (size_t)nxt.pm * tstep + (size_t)nxt.k0 * kstep : cA; const char* nB = has_next ? (const char*)g.Bt + (size_t)nxt.pn * tstep + (size_t)nxt.k0 * kstep : cB;
        const int nt = cur.nt;
        for (int t = 0; t < nt; t += 2) {
            const bool last = (t == nt - 2);
            const char* a1 = cA + (size_t)(t + 1) * kstep;
            const char* a2 = last ? nA : cA + (size_t)(t + 2) * kstep; const char* b2 = last ? nB : cB + (size_t)(t + 2) * kstep;
            const char* a3 = a2 + kstep; const char* b3 = b2 + kstep;
            if (last && has_next) S.a_ready(nxt);
            if constexpr (SP2) {
            PG8_LDB(B0, 0, 0); PG8_LDB(B1, 0, 1); PG8_SCHED; PG8_LDA(At, 0, 0); PG8_STAGE(PG8_SA(1, 1), a1 + hstep, voffA);
            PG8_WAIT_V(8); PG8_WAIT_L(0); PG8_BAR; PG8_MMA(0, 0, At, B0); PG8_MMA(0, 1, At, B1); PG8_BAR; PG8_SCHED;
            PG8_LDA(At, 0, 1); PG8_STAGE(PG8_SB(0, 0), b2, voffB); PG8_STAGE(PG8_SB(0, 1), b2 + hstep, voffB); PG8_STAGE(PG8_SA(0, 0), a2, voffA);
            PG8_WAIT_V(8); PG8_WAIT_L(0); PG8_BAR; PG8_MMA(1, 0, At, B0); PG8_MMA(1, 1, At, B1); PG8_BAR; PG8_SCHED;
            PG8_LDB(B0, 1, 0); PG8_LDB(B1, 1, 1); PG8_SCHED; PG8_LDA(At, 1, 0); PG8_STAGE(PG8_SA(0, 1), a2 + hstep, voffA);
            PG8_WAIT_V(8); PG8_WAIT_L(0); PG8_BAR; PG8_MMA(0, 0, At, B0); PG8_MMA(0, 1, At, B1); PG8_BAR; PG8_SCHED;
            PG8_LDA(At, 1, 1); PG8_STAGE(PG8_SB(1, 0), b3, voffB); PG8_STAGE(PG8_SB(1, 1), b3 + hstep, voffB); PG8_STAGE(PG8_SA(1, 0), a3, voffA);
            PG8_WAIT_V(8); PG8_WAIT_L(0); PG8_BAR; PG8_MMA(1, 0, At, B0); PG8_MMA(1, 1, At, B1); PG8_BAR; PG8_SCHED;
            } else {
            PG8_LDB(B0, 0, 0); PG8_SCHED; PG8_LDA(At, 0, 0); PG8_STAGE(PG8_SA(1, 1), a1 + hstep, voffA);
            PG8_WAIT_L(8); PG8_BAR; PG8_WAIT_L(0); PG8_MMA(0, 0, At, B0); PG8_BAR; PG8_SCHED;
            PG8_LDB(B1, 0, 1); PG8_STAGE(PG8_SB(0, 0), b2, voffB);
            PG8_BAR; PG8_WAIT_L(0); PG8_MMA(0, 1, At, B1); PG8_BAR;
            PG8_LDA(At, 0, 1); PG8_STAGE(PG8_SA(0, 0), a2, voffA);
            PG8_BAR; PG8_WAIT_L(0); PG8_MMA(1, 0, At, B0); PG8_BAR; PG8_SCHED;
            PG8_STAGE(PG8_SB(0, 1), b2 + hstep, voffB);
            PG8_WAIT_V(6); PG8_BAR; PG8_MMA(1, 1, At, B1); PG8_BAR;
            PG8_LDB(B0, 1, 0); PG8_SCHED; PG8_LDA(At, 1, 0); PG8_STAGE(PG8_SA(0, 1), a2 + hstep, voffA);
            PG8_WAIT_L(8); PG8_BAR; PG8_WAIT_L(0); PG8_MMA(0, 0, At, B0); PG8_BAR; PG8_SCHED;
            PG8_LDB(B1, 1, 1); PG8_STAGE(PG8_SB(1, 0), b3, voffB);
            PG8_BAR; PG8_WAIT_L(0); PG8_MMA(0, 1, At, B1); PG8_BAR;
            PG8_LDA(At, 1, 1); PG8_STAGE(PG8_SA(1, 0), a3, voffA);
            PG8_BAR; PG8_WAIT_L(0); PG8_MMA(1, 0, At, B0); PG8_BAR; PG8_SCHED;
            PG8_STAGE(PG8_SB(1, 1), b3 + hstep, voffB);
            PG8_WAIT_V(6); PG8_BAR; PG8_MMA(1, 1, At, B1); PG8_BAR;
            }
        }
        if constexpr (ALIGN_EPI) { if (wr == 0) PG8_BAR; }
        if constexpr (!Epi::AFTER_DRAIN) { E(acc, cur, wr, wc, fr, fq); S.done(cur); }
        if (!has_next) break;
#pragma unroll
        for (int a = 0; a < 2; ++a)
#pragma unroll
            for (int b = 0; b < 2; ++b)
#pragma unroll
                for (int m = 0; m < 4; ++m)
#pragma unroll
                    for (int n = 0; n < 2; ++n) acc[a][b][m][n] = (f32x4){0.f, 0.f, 0.f, 0.f};
        cur = nxt; cA = nA; cB = nB; ++ui;
        if constexpr (ALIGN_EPI) { if (wr == 1) PG8_BAR; }
    }
    PG8_WAIT_V(0);
    if constexpr (!ALIGN_EPI) { if (wr == 0) PG8_BAR; }
    PG8_BAR;
    if constexpr (Epi::AFTER_DRAIN) { E.fused(acc, cur, wr, wc, fr, fq, lds, wid, lane); S.done(cur); }
#undef PG8_SA
#undef PG8_SB
#undef PG8_STAGE
#undef PG8_LDA
#undef PG8_LDB
#undef PG8_MMA
#undef PG8_WAIT_V
#undef PG8_WAIT_L
#undef PG8_BAR
#undef PG8_SCHED
}
}
#define LAS __attribute__((address_space(3)))
typedef unsigned short bf16;
typedef float f32x4 __attribute__((ext_vector_type(4)));
typedef float f32x16 __attribute__((ext_vector_type(16)));
typedef short bf16x8 __attribute__((ext_vector_type(8)));
typedef short s16x4 __attribute__((ext_vector_type(4)));
typedef unsigned u32x4 __attribute__((ext_vector_type(4)));
typedef unsigned u32x2 __attribute__((ext_vector_type(2)));
constexpr int DM = 2048, SEQ = 4096, NP = 8192, NS = 512, MT = NP + NS, AW = 1024, CC = 1024, INC = 6144, DFF = 5632, PAST = 4096, DSEQ = 64;
constexpr float EPS = 1e-6f;
constexpr size_t OFF_Y = 0, OFF_KP = (size_t)MT * DM, OFF_VP = OFF_KP + (size_t)NP * AW, OFF_CP = OFF_VP + (size_t)NP * AW, OFF_KS = OFF_CP + 2 * 2 * CC,
                 OFF_VS = OFF_KS + (size_t)NS * AW, OFF_CS = OFF_VS + (size_t)NS * AW, OUT_TOTAL = OFF_CS + 8 * 2 * CC;
static_assert(OUT_TOTAL == 35672064, "output size");
constexpr size_t MiB = 1u << 20;
constexpr size_t WS_CTL = 0, WS_WIN = 1 * MiB, WS_WOUT = 25 * MiB, WS_WGU = 33 * MiB, WS_WDN = 77 * MiB, WS_HN = 99 * MiB, WS_Q = 133 * MiB, WS_K = 150 * MiB, WS_V = 166 * MiB,
                 WS_GB = 182 * MiB, WS_U = 199 * MiB, WS_MIX = 216 * MiB, WS_SSQ = 250 * MiB, WS_TP = 251 * MiB, WS_OP = 256 * MiB, WS_H = 256 * MiB, WS_PART = 133 * MiB  ;
constexpr int NSLOT = 256 + 16;
constexpr size_t WS_END = WS_OP + (size_t)NSLOT * 131072;
constexpr int RING_BYTES = 131072, RED_OFF = RING_BYTES, MISC_OFF = RED_OFF + 8192, LDS_BYTES = 147456;
constexpr int NWAVES = 8;

#define XB_TMO      128
#define XB_XCNT(j)  (256  + 64 * (j))
#define XB_XSUB(j)  (1280 + 64 * (j))
#define XB_XGEN(j)  (2304 + 64 * (j))
#define XB_TOP      3328
#define XB_TOPGEN   3392
#define XCD_BAR_WORDS 3456
#define XB_SPIN_CAP (1u << 18)

__device__ __forceinline__ unsigned xb_ld(unsigned* p)              { return __hip_atomic_load(p, __ATOMIC_RELAXED, __HIP_MEMORY_SCOPE_AGENT); }
__device__ __forceinline__ unsigned xb_add(unsigned* p, unsigned v) { return __hip_atomic_fetch_add(p, v, __ATOMIC_RELAXED, __HIP_MEMORY_SCOPE_AGENT); }
__device__ __forceinline__ unsigned xb_xcc_id() { return (unsigned)__builtin_amdgcn_s_getreg((3 << 11) | 20) & 0xFu; }
#define XB_SPIN(cond, bar) do { unsigned _sp = 0; while (cond) { __builtin_amdgcn_s_sleep(1); \
    if ((++_sp & 255u) == 0u) { if (xb_ld(&(bar)[XB_TMO])) break; if (_sp > XB_SPIN_CAP) { atomicAdd(&(bar)[XB_TMO], 1u); break; } } } } while (0)

struct XcdBarrier {
    unsigned* bar; unsigned x;
    volatile LAS unsigned* st;
};

__device__ __forceinline__ XcdBarrier xcd_barrier_post(unsigned* bar, volatile LAS unsigned* st) {
    XcdBarrier b; b.bar = bar; b.x = xb_xcc_id(); b.st = st;
    if (threadIdx.x == 0) (void)xb_add(&bar[XB_XCNT(b.x)], 1u);
    return b;
}
__device__ __forceinline__ void xcd_barrier_complete(unsigned* bar, unsigned x, unsigned& nloc, unsigned& nx) {
    const unsigned G = gridDim.x * gridDim.y * gridDim.z;
    unsigned sum, cnt, mine, sp = 0u;
    for (;;) {
        sum = 0u; cnt = 0u; mine = 0u;
#pragma unroll
        for (unsigned j = 0; j < 16; ++j) { const unsigned c = xb_ld(&bar[XB_XCNT(j)]); sum += c; cnt += (c > 0u) ? 1u : 0u; mine = (j == x) ? c : mine; }
        if (sum == G) break;
        __builtin_amdgcn_s_sleep(1);
        if ((++sp & 255u) == 0u) { if (xb_ld(&bar[XB_TMO])) break; if (sp > XB_SPIN_CAP) { atomicAdd(&bar[XB_TMO], 1u); break; } }
    }
    nloc = mine > 0u ? mine : 1u; nx = cnt > 0u ? cnt : 1u;
}

__device__ __forceinline__ void xcd_barrier(const XcdBarrier& b) {
    asm volatile("s_waitcnt vmcnt(0)" ::: "memory");
    __syncthreads();
    if (threadIdx.x == 0) {
        unsigned* bar = b.bar;
        __builtin_amdgcn_s_waitcnt(0);
        unsigned nloc = b.st[0], nx = b.st[1];
        if (nloc == 0u) { xcd_barrier_complete(bar, b.x, nloc, nx); b.st[0] = nloc; b.st[1] = nx; }
        const unsigned old = xb_add(&bar[XB_XSUB(b.x)], 1u);
        const unsigned gen = old / nloc;
        if (old + 1u == (gen + 1u) * nloc) {
            __builtin_amdgcn_fence(__ATOMIC_RELEASE, "agent");
            asm volatile("s_waitcnt vmcnt(0)" ::: "memory");
            const unsigned og = xb_add(&bar[XB_TOP], 1u);
            const unsigned tg = og / nx;
            if (og + 1u == (tg + 1u) * nx) xb_add(&bar[XB_TOPGEN], 1u);
            else XB_SPIN(xb_ld(&bar[XB_TOPGEN]) == tg, bar);
            __builtin_amdgcn_fence(__ATOMIC_ACQUIRE, "agent");
            xb_add(&bar[XB_XGEN(b.x)], 1u);
            asm volatile("s_waitcnt vmcnt(0)" ::: "memory");
        } else {
            XB_SPIN(xb_ld(&bar[XB_XGEN(b.x)]) == gen, bar);
            __builtin_amdgcn_fence(__ATOMIC_ACQUIRE, "agent");
            asm volatile("s_waitcnt vmcnt(0)" ::: "memory");
        }
    }
    __syncthreads();
}

struct ItemTab { int n; int v[272]; };
constexpr int p_nsteps(int qb, int c) { return 8 * (qb + 1); }
constexpr ItemTab make_items() {
    ItemTab t{}; t.n = 0;
    for (int b = 0; b < 8; ++b) for (int hg = 0; hg < 2; ++hg) t.v[t.n++] = 1 | (b << 1) | (hg << 4);
    for (int qb = 15; qb >= 0; --qb) for (int bh = 0; bh < 16; ++bh) t.v[t.n++] = (bh << 1) | (qb << 5);
    return t;
}
__device__ const ItemTab g_items = make_items();

__device__ __forceinline__ unsigned f2bf(float f) { unsigned u = __builtin_bit_cast(unsigned, f); return (u + 0x7fffu + ((u >> 16) & 1u)) >> 16; }
__device__ __forceinline__ unsigned pk2(float lo, float hi) { return pg8::cvt_pk_bf16(lo, hi); }
__device__ __forceinline__ float bflo(unsigned w) { return __builtin_bit_cast(float, w << 16); }
__device__ __forceinline__ float bfhi(unsigned w) { return __builtin_bit_cast(float, w & 0xffff0000u); }
__device__ __forceinline__ int crow(int r, int hi) { return (r & 3) + 8 * (r >> 2) + 4 * hi; }
__device__ __forceinline__ float wave_sum(float v) {
#pragma unroll
    for (int o = 1; o < 64; o <<= 1) v += __shfl_xor(v, o);
    return v;
}

struct Args { const float* in[17]; float* out; unsigned char* ws; };

struct P0Item { const float* src; const float* gk; bf16* dst; int N, K, k0; };
__device__ __forceinline__ P0Item p0_decode(const Args& a, int it) {
    constexpr int I_IN = 32 * 192, I_OUT = 32 * 64, I_G = 32 * 176;
    unsigned char* ws = a.ws; P0Item r; int n0, kb, drow; r.gk = nullptr;
    if (it < I_IN) { kb = it / 192; n0 = 32 * (it % 192); drow = n0;
        if (n0 >= 5120) { const int ch = n0 - 5120; drow = 4096 + (ch >> 7) * 256 + 128 + (ch & 127); } else if (n0 >= 4096) { const int ch = n0 - 4096; drow = 4096 + (ch >> 7) * 256 + (ch & 127); }
        r.src = a.in[6]; r.N = INC; r.K = DM; r.dst = (bf16*)(ws + WS_WIN); }
    else if ((it -= I_IN) < I_OUT) { kb = it / 64; n0 = 32 * (it % 64); drow = n0; r.src = a.in[12]; r.N = DM; r.K = DM; r.dst = (bf16*)(ws + WS_WOUT); }
    else if ((it -= I_OUT) < 2 * I_G) { const int up = it >= I_G; if (up) it -= I_G; kb = it / 176; n0 = 32 * (it % 176); drow = (n0 >> 7) * 256 + up * 128 + (n0 & 127);
        r.src = a.in[up ? 15 : 14]; r.N = DFF; r.K = DM; r.dst = (bf16*)(ws + WS_WGU); r.gk = a.in[13]; }
    else { it -= 2 * I_G; kb = it / 64; n0 = 32 * (it % 64); drow = n0; r.src = a.in[16]; r.N = DM; r.K = DFF; r.dst = (bf16*)(ws + WS_WDN); }
    r.k0 = 64 * kb; r.src += (size_t)r.k0 * r.N + n0; r.dst += (size_t)drow * r.K + r.k0;
    return r;
}
__device__ __forceinline__ void p0_load(const P0Item& p, f32x4 (&v)[8], int lane) {
#pragma unroll
    for (int j = 0; j < 8; ++j) v[j] = __builtin_nontemporal_load((const f32x4*)(p.src + (size_t)(8 * j + (lane >> 3)) * p.N + 4 * (lane & 7)));
}
__device__ __forceinline__ void p0_finish(const P0Item& p, const f32x4 (&v)[8], LAS float* scr, int lane) {
#pragma unroll
    for (int j = 0; j < 8; ++j) { const int kk = 8 * j + (lane >> 3); const float g = p.gk ? p.gk[p.k0 + kk] : 1.0f; LAS float* s = scr + kk * 33 + 4 * (lane & 7);
        s[0] = v[j][0] * g; s[1] = v[j][1] * g; s[2] = v[j][2] * g; s[3] = v[j][3] * g; }
    asm volatile("s_waitcnt lgkmcnt(0)" ::: "memory");
    const int c = lane & 7;
#pragma unroll
    for (int j = 0; j < 4; ++j) { const int n = (lane >> 3) + 8 * j; const LAS float* s = scr + (8 * c) * 33 + n;
        u32x4 o; o.x = pk2(s[0 * 33], s[1 * 33]); o.y = pk2(s[2 * 33], s[3 * 33]); o.z = pk2(s[4 * 33], s[5 * 33]); o.w = pk2(s[6 * 33], s[7 * 33]);
        *(u32x4*)(p.dst + (size_t)n * p.K + 8 * c) = o; }
    asm volatile("s_waitcnt lgkmcnt(0)" ::: "memory");
}
constexpr int P0_EARLY_ITEMS = 32 * 192 + 32 * 64, P0_ALL_ITEMS = 32 * 192 + 32 * 64 + 2 * 32 * 176 + 88 * 64, P0_CHUNK = 32, P0_LATE_CHUNKS = (P0_ALL_ITEMS - P0_EARLY_ITEMS) / P0_CHUNK;
static_assert((P0_ALL_ITEMS - P0_EARLY_ITEMS) % P0_CHUNK == 0, "late conversion items come in whole chunks");
__device__ __forceinline__ void p0_run_range(const Args& a, LAS float* scr, int first, int n, int lane) {
    f32x4 va[8], vb[8]; P0Item pa, pb;
    pa = p0_decode(a, first); p0_load(pa, va, lane);
    for (int i = 0; i < n; i += 2) {
        if (i + 1 < n) { pb = p0_decode(a, first + i + 1); p0_load(pb, vb, lane); }
        p0_finish(pa, va, scr, lane);
        if (i + 1 >= n) break;
        if (i + 2 < n) { pa = p0_decode(a, first + i + 2); p0_load(pa, va, lane); }
        p0_finish(pb, vb, scr, lane);
    }
}
__device__ __forceinline__ void p0_prologue(const Args& a, LAS unsigned char* lds, int gw, int NGW, int lane, int wave) {
    LAS float* scr = (LAS float*)(lds + wave * 16384);
    unsigned char* ws = a.ws;
    constexpr int NITEMS = P0_EARLY_ITEMS;
    {
        int it = gw; f32x4 va[8], vb[8]; P0Item pa, pb;
        if (it < NITEMS) { pa = p0_decode(a, it); p0_load(pa, va, lane); }
        while (it < NITEMS) {
            const int itb = it + NGW;
            if (itb < NITEMS) { pb = p0_decode(a, itb); p0_load(pb, vb, lane); }
            p0_finish(pa, va, scr, lane);
            it = itb + NGW;
            if (itb >= NITEMS) break;
            if (it < NITEMS) { pa = p0_decode(a, it); p0_load(pa, va, lane); }
            p0_finish(pb, vb, scr, lane);
        }
    }
    const float* g1 = a.in[5];
    f32x4 gv[8];
#pragma unroll
    for (int j = 0; j < 8; ++j) gv[j] = *((const f32x4*)g1 + 64 * j + lane);
    for (int m = gw; m < MT; m += 2 * NGW) {
        const int m2 = m + NGW; const bool has2 = m2 < MT;
        const float* xa = m < NP ? a.in[0] + (size_t)m * DM : a.in[1] + (size_t)(m - NP) * DM;
        const float* xb = has2 ? (m2 < NP ? a.in[0] + (size_t)m2 * DM : a.in[1] + (size_t)(m2 - NP) * DM) : xa;
        f32x4 va[8], vb[8];
#pragma unroll
        for (int j = 0; j < 8; ++j) va[j] = __builtin_nontemporal_load((const f32x4*)xa + 64 * j + lane);
        if (has2) {
#pragma unroll
            for (int j = 0; j < 8; ++j) vb[j] = __builtin_nontemporal_load((const f32x4*)xb + 64 * j + lane);
        }
        {
            float s = 0.f;
#pragma unroll
            for (int j = 0; j < 8; ++j) s += (va[j][0] * va[j][0] + va[j][1] * va[j][1]) + (va[j][2] * va[j][2] + va[j][3] * va[j][3]);
            const float rs = __builtin_amdgcn_rsqf(wave_sum(s) * (1.0f / DM) + EPS);
            u32x2* o = (u32x2*)((bf16*)(ws + WS_HN) + (size_t)m * DM) + lane;
#pragma unroll
            for (int j = 0; j < 8; ++j) { u32x2 w; w.x = pk2(va[j][0] * rs * gv[j][0], va[j][1] * rs * gv[j][1]); w.y = pk2(va[j][2] * rs * gv[j][2], va[j][3] * rs * gv[j][3]); o[64 * j] = w; }
        }
        if (has2) {
            float s = 0.f;
#pragma unroll
            for (int j = 0; j < 8; ++j) s += (vb[j][0] * vb[j][0] + vb[j][1] * vb[j][1]) + (vb[j][2] * vb[j][2] + vb[j][3] * vb[j][3]);
            const float rs = __builtin_amdgcn_rsqf(wave_sum(s) * (1.0f / DM) + EPS);
            u32x2* o = (u32x2*)((bf16*)(ws + WS_HN) + (size_t)m2 * DM) + lane;
#pragma unroll
            for (int j = 0; j < 8; ++j) { u32x2 w; w.x = pk2(vb[j][0] * rs * gv[j][0], vb[j][1] * rs * gv[j][1]); w.y = pk2(vb[j][2] * rs * gv[j][2], vb[j][3] * rs * gv[j][3]); o[64 * j] = w; }
        }
    }
}


template <int VS, bool QREG>
__device__ __forceinline__ void sb_block(f32x16 (&o)[4], float& R, const LAS unsigned char* kp, const LAS unsigned char* vp, const bf16x8 (&qreg)[8], const LAS unsigned char* qlp, int kb, int qw, int qpos, int hi) {
            f32x16 p;
#pragma unroll
            for (int r = 0; r < 16; ++r) p[r] = 0.f;
#pragma unroll
            for (int d0 = 0; d0 < 8; ++d0) { const bf16x8 kf = *(const LAS bf16x8*)(kp + d0 * 32); const bf16x8 qf = QREG ? qreg[d0] : *(const LAS bf16x8*)(qlp + d0 * 32); p = __builtin_amdgcn_mfma_f32_32x32x16_bf16(kf, qf, p, 0, 0, 0); }
            const bool need_mask = (kb + 31 >= qw);
            float e[16], sf[16];
#pragma unroll
            for (int r = 0; r < 16; ++r) {
                const float z = fminf(p[r], 100.f); float ee = __builtin_amdgcn_exp2f(z); float rr = __builtin_amdgcn_rcpf(1.0f + ee);
                if (need_mask) { const bool msk = (kb + crow(r, hi)) >= qpos; ee = msk ? 0.f : ee; rr = msk ? 1.f : rr; }
                e[r] = ee; sf[r] = rr;
            }
            float oth[4], PP[4];
#pragma unroll
            for (int g = 0; g < 4; ++g) { sf[4 * g + 2] *= sf[4 * g + 3]; sf[4 * g + 1] *= sf[4 * g + 2]; sf[4 * g] *= sf[4 * g + 1]; oth[g] = __shfl_xor(sf[4 * g], 32); PP[g] = sf[4 * g] * oth[g]; }
            const float SP3 = PP[3], SP2 = PP[2] * SP3, SP1 = PP[1] * SP2, SP0 = PP[0] * SP1;
            float A[4]; A[0] = R * SP1; A[1] = R * SP2; A[2] = R * SP3; A[3] = R;
#pragma unroll
            for (int g = 0; g < 4; ++g) A[g] = hi ? A[g] : A[g] * oth[g];
            R *= SP0;
            float w[16];
#pragma unroll
            for (int r = 0; r < 16; ++r) w[r] = (e[r] * sf[r]) * A[r >> 2];
#pragma unroll
            for (int s2 = 0; s2 < 2; ++s2) {
                u32x4 pw; pw.x = pk2(w[8 * s2 + 0], w[8 * s2 + 1]); pw.y = pk2(w[8 * s2 + 2], w[8 * s2 + 3]); pw.z = pk2(w[8 * s2 + 4], w[8 * s2 + 5]); pw.w = pk2(w[8 * s2 + 6], w[8 * s2 + 7]);
                const bf16x8 pa = __builtin_bit_cast(bf16x8, pw);
#pragma unroll
                for (int db = 0; db < 4; ++db) {
                    const s16x4 lo = __builtin_bit_cast(s16x4, __builtin_amdgcn_ds_read_tr16_b64_v4i16((LAS s16x4*)(vp + (16 * s2) * VS + db * 64)));
                    const s16x4 hh = __builtin_bit_cast(s16x4, __builtin_amdgcn_ds_read_tr16_b64_v4i16((LAS s16x4*)(vp + (16 * s2 + 8) * VS + db * 64)));
                    const bf16x8 vb = __builtin_shufflevector(lo, hh, 0, 1, 2, 3, 4, 5, 6, 7);
                    o[db] = __builtin_amdgcn_mfma_f32_32x32x16_bf16(pa, vb, o[db], 0, 0, 0);
                }
            }
}

template <bool SAMPLE>
__device__ __forceinline__ void attn_item(const Args& a, LAS unsigned char* lds, int code) {
    constexpr int NH = SAMPLE ? 4 : 1, KS = NH * 256 + 16, VS = NH * 256 + 32, K_OFF = 0, V_OFF = 32 * KS;
    int tid_ = threadIdx.x; asm volatile("" : "+v"(tid_));
    const int tid = tid_, lane = tid & 63, r32 = lane & 31, hi = lane >> 5; const int wid = __builtin_amdgcn_readfirstlane(tid >> 6);
    unsigned char* ws = a.ws;
    int slot, nsteps, kvpos0, qw, head, hl; size_t qrow;
    const bf16 *kgb = nullptr, *vgb = nullptr; const float *kgf = nullptr, *vgf = nullptr, *kgn = nullptr, *vgn = nullptr;
    if (SAMPLE) {
        const int b = (code >> 1) & 7, hg = (code >> 4) & 1;
        slot = 256 + b * 2 + hg; hl = wid >> 1; head = hg * 4 + hl; const int rg = wid & 1;
        qw = PAST + 32 * rg; qrow = (size_t)NP + b * DSEQ + 32 * rg + r32;
        nsteps = 130; kvpos0 = 0;
        kgf = a.in[2] + ((size_t)b * PAST + (tid >> 7)) * AW + hg * 512 + 4 * (tid & 127); vgf = a.in[3] + ((size_t)b * PAST + (tid >> 7)) * AW + hg * 512 + 4 * (tid & 127);
        kgn = a.out + OFF_KS + ((size_t)b * DSEQ + (tid >> 7)) * AW + hg * 512 + 4 * (tid & 127); vgn = a.out + OFF_VS + ((size_t)b * DSEQ + (tid >> 7)) * AW + hg * 512 + 4 * (tid & 127);
    } else {
        const int bh = (code >> 1) & 15, qb = (code >> 5) & 15, c = (code >> 9) & 3, b = bh >> 3;
        head = bh & 7; hl = 0; slot = bh * 16 + qb + 0 * c; nsteps = p_nsteps(qb, c); kvpos0 = 0;
        qw = qb * 256 + 32 * wid; qrow = (size_t)b * SEQ + qw + r32;
        kgb = (const bf16*)(ws + WS_K) + ((size_t)b * SEQ + kvpos0 + (tid >> 4)) * AW + head * 128 + (tid & 15) * 8;
        vgb = (const bf16*)(ws + WS_V) + ((size_t)b * SEQ + kvpos0 + (tid >> 4)) * AW + head * 128 + (tid & 15) * 8;
    }
    const int qpos = qw + r32;
    constexpr int Q_OFF = 67584, QS = 272;
    const LAS unsigned char* qlp = lds + Q_OFF + wid * (32 * QS) + r32 * QS + hi * 16;
    { const bf16* qp = (const bf16*)(ws + WS_Q) + qrow * AW + head * 128 + hi * 8;
#pragma unroll
      for (int d0 = 0; d0 < 8; ++d0) *(LAS bf16x8*)(lds + Q_OFF + wid * (32 * QS) + r32 * QS + hi * 16 + d0 * 32) = *(const bf16x8*)(qp + 16 * d0); }
    f32x16 o[4];
#pragma unroll
    for (int i = 0; i < 4; ++i)
#pragma unroll
        for (int r = 0; r < 16; ++r) o[i][r] = 0.f;
    float R = 1.f;
    u32x4 kreg, vreg; f32x4 kf4[8], vf4[8];
#define ATT_LOADK(s_) do { if (SAMPLE) { _Pragma("unroll") for (int i_ = 0; i_ < 8; ++i_) kf4[i_] = *(const f32x4*)(((s_) >= 128 ? kgn + (size_t)((s_) - 128) * 32 * AW : kgf + (size_t)(s_) * 32 * AW) + (size_t)i_ * 4 * AW); } \
        else { kreg = *(const u32x4*)(kgb + (size_t)(s_) * 32 * AW); } } while (0)
#define ATT_LOADV(s_) do { if (SAMPLE) { _Pragma("unroll") for (int i_ = 0; i_ < 8; ++i_) vf4[i_] = *(const f32x4*)(((s_) >= 128 ? vgn + (size_t)((s_) - 128) * 32 * AW : vgf + (size_t)(s_) * 32 * AW) + (size_t)i_ * 4 * AW); } \
        else { vreg = *(const u32x4*)(vgb + (size_t)(s_) * 32 * AW); } } while (0)
#define ATT_STOREK() do { if (SAMPLE) { _Pragma("unroll") for (int i_ = 0; i_ < 8; ++i_) { const int key_ = (tid >> 7) + 4 * i_, f4_ = tid & 127; \
            u32x2 kw_; kw_.x = pk2(kf4[i_][0], kf4[i_][1]); kw_.y = pk2(kf4[i_][2], kf4[i_][3]); *(LAS u32x2*)(lds + K_OFF + key_ * KS + f4_ * 8) = kw_; } } \
        else { *(LAS u32x4*)(lds + K_OFF + (tid >> 4) * KS + (tid & 15) * 16) = kreg; } } while (0)
#define ATT_STOREV() do { if (SAMPLE) { _Pragma("unroll") for (int i_ = 0; i_ < 8; ++i_) { const int key_ = (tid >> 7) + 4 * i_, f4_ = tid & 127; \
            u32x2 vw_; vw_.x = pk2(vf4[i_][0], vf4[i_][1]); vw_.y = pk2(vf4[i_][2], vf4[i_][3]); *(LAS u32x2*)(lds + V_OFF + key_ * VS + f4_ * 8) = vw_; } } \
        else { *(LAS u32x4*)(lds + V_OFF + (tid >> 4) * VS + (tid & 15) * 16) = vreg; } } while (0)
    volatile LAS int* flg = (volatile LAS int*)(lds + MISC_OFF + 64);
    ATT_LOADK(nsteps - 1); ATT_LOADV(nsteps - 1);
    ATT_STOREK(); ATT_STOREV();
    __syncthreads();
    const LAS unsigned char* kp = lds + K_OFF + r32 * KS + hl * 256 + hi * 16;
    const LAS unsigned char* vp = lds + V_OFF + (4 * hi + ((lane & 15) >> 2)) * VS + hl * 256 + (16 * ((lane >> 4) & 1) + 4 * (lane & 3)) * 2;
    for (int s = nsteps - 1; s >= 0; --s) {
        if (s > 0) { ATT_LOADK(s - 1); if (!SAMPLE) ATT_LOADV(s - 1); }
        const int kb = kvpos0 + 32 * s;
        if (kb < qw + 32 && !__all(R == 0.f)) { const bf16x8 qdummy[8] = {}; sb_block<VS, false>(o, R, kp, vp, qdummy, qlp, kb, qw, qpos, hi); }
        if (lane == 0) flg[wid] = __all(R == 0.f) ? 1 : 0;
        __syncthreads();
        const bool alldone = (flg[0] & flg[1] & flg[2] & flg[3] & flg[4] & flg[5] & flg[6] & flg[7]) != 0;
        if (alldone) { __syncthreads(); break; }
        if (s > 0) { ATT_STOREK(); if (SAMPLE) ATT_LOADV(s - 1); ATT_STOREV(); }
        __syncthreads();
    }
#undef ATT_LOADK
#undef ATT_LOADV
#undef ATT_STOREK
#undef ATT_STOREV
    bf16* op = (bf16*)(ws + WS_OP) + ((size_t)(slot * 8 + wid) * 32) * 128;
#pragma unroll
    for (int db = 0; db < 4; ++db)
#pragma unroll
        for (int r = 0; r < 16; ++r) op[crow(r, hi) * 128 + db * 32 + r32] = (bf16)f2bf(o[db][r]);
    if (hi == 0) ((float*)(ws + WS_TP))[(slot * 8 + wid) * 32 + r32] = R;
}


__device__ __forceinline__ void attn_item_p(const Args& a, LAS unsigned char* lds, int code) {
    constexpr int KS = 272, VS = 288, TILE_K = 64 * KS, BUF = TILE_K + 64 * VS;
    int tid_ = threadIdx.x; asm volatile("" : "+v"(tid_));
    const int tid = tid_, lane = tid & 63, r32 = lane & 31, hi = lane >> 5; const int wid = __builtin_amdgcn_readfirstlane(tid >> 6);
    unsigned char* ws = a.ws;
    const int bh = (code >> 1) & 15, qb = (code >> 5) & 15, c = (code >> 9) & 3, b = bh >> 3, head = bh & 7;
    const int slot = bh * 16 + qb + 0 * c, nst = p_nsteps(qb, c) >> 1, kvpos0 = 0;
    const int qw = qb * 256 + 32 * wid, qpos = qw + r32; const size_t qrow = (size_t)b * SEQ + qpos;
    const bf16* kgb = (const bf16*)(ws + WS_K) + ((size_t)b * SEQ + kvpos0 + (tid >> 4)) * AW + head * 128 + (tid & 15) * 8;
    const bf16* vgb = (const bf16*)(ws + WS_V) + ((size_t)b * SEQ + kvpos0 + (tid >> 4)) * AW + head * 128 + (tid & 15) * 8;
    bf16x8 qf[8];
    { const bf16* qp = (const bf16*)(ws + WS_Q) + qrow * AW + head * 128 + hi * 8;
#pragma unroll
      for (int d0 = 0; d0 < 8; ++d0) qf[d0] = *(const bf16x8*)(qp + 16 * d0); }
    f32x16 o[4];
#pragma unroll
    for (int i = 0; i < 4; ++i)
#pragma unroll
        for (int r = 0; r < 16; ++r) o[i][r] = 0.f;
    float R = 1.f;
    u32x4 kreg[2], vreg[2];
#define PLOAD(s_) do { _Pragma("unroll") for (int i_ = 0; i_ < 2; ++i_) { kreg[i_] = *(const u32x4*)(kgb + (size_t)((s_) * 64 + 32 * i_) * AW); vreg[i_] = *(const u32x4*)(vgb + (size_t)((s_) * 64 + 32 * i_) * AW); } } while (0)
#define PSTORE(buf_) do { _Pragma("unroll") for (int i_ = 0; i_ < 2; ++i_) { *(LAS u32x4*)(lds + (buf_) * BUF + ((tid >> 4) + 32 * i_) * KS + (tid & 15) * 16) = kreg[i_]; \
        *(LAS u32x4*)(lds + (buf_) * BUF + TILE_K + ((tid >> 4) + 32 * i_) * VS + (tid & 15) * 16) = vreg[i_]; } } while (0)
    volatile LAS int* flg = (volatile LAS int*)(lds + MISC_OFF + 64);
    PLOAD(nst - 1);
    PSTORE(0);
    __syncthreads();
    const LAS unsigned char* kp = lds + r32 * KS + hi * 16;
    const LAS unsigned char* vp = lds + TILE_K + (4 * hi + ((lane & 15) >> 2)) * VS + (16 * ((lane >> 4) & 1) + 4 * (lane & 3)) * 2;
    int cur = 0;
    for (int s = nst - 1; s >= 0; --s) {
        if (s > 0) PLOAD(s - 1);
#pragma unroll
        for (int blk = 1; blk >= 0; --blk) {
            const int kb = kvpos0 + 64 * s + 32 * blk;
            if (kb < qw + 32 && !__all(R == 0.f)) sb_block<VS, true>(o, R, kp + cur * BUF + blk * 32 * KS, vp + cur * BUF + blk * 32 * VS, qf, kp, kb, qw, qpos, hi);
        }
        volatile LAS int* fl = flg + 8 * (s & 1);
        if (lane == 0) fl[wid] = __all(R == 0.f) ? 1 : 0;
        if (s > 0) PSTORE(cur ^ 1);
        __syncthreads();
        if ((fl[0] & fl[1] & fl[2] & fl[3] & fl[4] & fl[5] & fl[6] & fl[7]) != 0) break;
        cur ^= 1;
    }
#undef PLOAD
#undef PSTORE
    bf16* op = (bf16*)(ws + WS_OP) + ((size_t)(slot * 8 + wid) * 32) * 128;
#pragma unroll
    for (int db = 0; db < 4; ++db)
#pragma unroll
        for (int r = 0; r < 16; ++r) op[crow(r, hi) * 128 + db * 32 + r32] = (bf16)f2bf(o[db][r]);
    if (hi == 0) ((float*)(ws + WS_TP))[(slot * 8 + wid) * 32 + r32] = R;
}

struct MixRow { int m, t; const float* st; u32x4 opb[2]; u32x4 u2[2], u1[2], u0[2], gb[2]; };
__device__ __forceinline__ void mix_load(const Args& a, MixRow& R, int m, int lane) {
    unsigned char* ws = a.ws;
    const float* OP = (const float*)(ws + WS_OP); const bf16* U = (const bf16*)(ws + WS_U); const bf16* GB = (const bf16*)(ws + WS_GB);
    const int h = lane >> 3, d0 = (lane & 7) * 16, c0 = lane * 16;
    int slot0, wid, q;
    if (m < NP) { const int b = m >> 12, t = m & 4095, qb = t >> 8; wid = (t & 255) >> 5; q = t & 31; slot0 = (b * 8 + h) * 16 + qb; R.t = t; R.st = nullptr; }
    else { const int r = m - NP, b = r >> 6, t = r & 63, rg = t >> 5; q = t & 31; wid = (h & 3) * 2 + rg; slot0 = 256 + b * 2 + (h >> 2); R.t = t; R.st = a.in[4] + (size_t)b * 2 * CC; }
    R.m = m;
    { const u32x4* p = (const u32x4*)((const bf16*)OP + ((size_t)(slot0 * 8 + wid) * 32 + q) * 128 + d0); R.opb[0] = p[0]; R.opb[1] = p[1]; }
    { const u32x4* pu = (const u32x4*)(U + (size_t)m * CC + c0); R.u2[0] = pu[0]; R.u2[1] = pu[1]; }
    if (R.t >= 1) { const u32x4* pu = (const u32x4*)(U + (size_t)(m - 1) * CC + c0); R.u1[0] = pu[0]; R.u1[1] = pu[1]; }
    if (R.t >= 2) { const u32x4* pu = (const u32x4*)(U + (size_t)(m - 2) * CC + c0); R.u0[0] = pu[0]; R.u0[1] = pu[1]; }
    { const u32x4* pg = (const u32x4*)(GB + (size_t)m * CC + c0); R.gb[0] = pg[0]; R.gb[1] = pg[1]; }
}
__device__ __forceinline__ void unpack16(const u32x4 (&x)[2], float (&o)[16]) {
    const unsigned ww[8] = {x[0].x, x[0].y, x[0].z, x[0].w, x[1].x, x[1].y, x[1].z, x[1].w};
#pragma unroll
    for (int i = 0; i < 8; ++i) { o[2 * i] = bflo(ww[i]); o[2 * i + 1] = bfhi(ww[i]); }
}
__device__ __forceinline__ void mix_finish(const Args& a, const MixRow& R, const float (&ga16)[16], const float (&gc16)[16], const float (&w0c)[16], const float (&w1c)[16], const float (&w2c)[16], int lane) {
    bf16* MIX = (bf16*)(a.ws + WS_MIX);
    const int h = lane >> 3, d0 = (lane & 7) * 16, c0 = lane * 16, m = R.m;
    float oa[16]; unpack16(R.opb, oa);
    float s = 0.f;
#pragma unroll
    for (int i = 0; i < 16; ++i) s += oa[i] * oa[i];
    float rs = __builtin_amdgcn_rsqf(wave_sum(s) * (1.0f / AW) + EPS);
    { unsigned ww[8];
#pragma unroll
      for (int i = 0; i < 8; ++i) ww[i] = pk2(oa[2 * i] * rs * ga16[2 * i], oa[2 * i + 1] * rs * ga16[2 * i + 1]);
      u32x4 w0, w1; w0.x = ww[0]; w0.y = ww[1]; w0.z = ww[2]; w0.w = ww[3]; w1.x = ww[4]; w1.y = ww[5]; w1.z = ww[6]; w1.w = ww[7];
      u32x4* o = (u32x4*)(MIX + (size_t)m * DM + h * 128 + d0); o[0] = w0; o[1] = w1; }
    float u0[16], u1[16], u2[16], gbv[16];
    unpack16(R.u2, u2); unpack16(R.gb, gbv);
    if (R.t >= 1) unpack16(R.u1, u1); else {
#pragma unroll
        for (int i = 0; i < 16; ++i) u1[i] = R.st ? R.st[CC + c0 + i] : 0.f; }
    if (R.t >= 2) unpack16(R.u0, u0); else {
#pragma unroll
        for (int i = 0; i < 16; ++i) u0[i] = R.st ? R.st[(R.t == 0 ? 0 : CC) + c0 + i] : 0.f; }
    float oc[16]; float s2 = 0.f;
#pragma unroll
    for (int i = 0; i < 16; ++i) { oc[i] = gbv[i] * (w0c[i] * u0[i] + w1c[i] * u1[i] + w2c[i] * u2[i]); s2 += oc[i] * oc[i]; }
    rs = __builtin_amdgcn_rsqf(wave_sum(s2) * (1.0f / CC) + EPS);
    { unsigned ww[8];
#pragma unroll
      for (int i = 0; i < 8; ++i) ww[i] = pk2(oc[2 * i] * rs * gc16[2 * i], oc[2 * i + 1] * rs * gc16[2 * i + 1]);
      u32x4 w0, w1; w0.x = ww[0]; w0.y = ww[1]; w0.z = ww[2]; w0.w = ww[3]; w1.x = ww[4]; w1.y = ww[5]; w1.z = ww[6]; w1.w = ww[7];
      u32x4* o = (u32x4*)(MIX + (size_t)m * DM + AW + c0); o[0] = w0; o[1] = w1; }
}
__device__ __forceinline__ void mix_rows(const Args& a, int gw, int NGW, int lane) {
    const float* cw = a.in[9]; const float* ga = a.in[10]; const float* gc = a.in[11];
    const int h = lane >> 3, d0 = (lane & 7) * 16, c0 = lane * 16;
    float ga16[16], gc16[16], w0c[16], w1c[16], w2c[16];
#pragma unroll
    for (int i = 0; i < 4; ++i) {
        const f32x4 x0 = *(const f32x4*)(ga + h * 128 + d0 + 4 * i), x1 = *(const f32x4*)(gc + c0 + 4 * i), x2 = *(const f32x4*)(cw + c0 + 4 * i), x3 = *(const f32x4*)(cw + CC + c0 + 4 * i), x4 = *(const f32x4*)(cw + 2 * CC + c0 + 4 * i);
#pragma unroll
        for (int j = 0; j < 4; ++j) { ga16[4 * i + j] = x0[j]; gc16[4 * i + j] = x1[j]; w0c[4 * i + j] = x2[j]; w1c[4 * i + j] = x3[j]; w2c[4 * i + j] = x4[j]; }
    }
    for (int m = gw; m < MT; m += 2 * NGW) {
        MixRow A, B; const bool hasB = m + NGW < MT;
        mix_load(a, A, m, lane);
        if (hasB) mix_load(a, B, m + NGW, lane);
        mix_finish(a, A, ga16, gc16, w0c, w1c, w2c, lane);
        if (hasB) mix_finish(a, B, ga16, gc16, w0c, w1c, w2c, lane);
    }
}
#ifndef NCONV
#define NCONV 96
#endif
#ifndef REP_P0
#define REP_P0 1
#endif
#ifndef REP_P1
#define REP_P1 1
#endif
#ifndef REP_P3
#define REP_P3 1
#endif
#ifndef REP_P4
#define REP_P4 1
#endif
#ifndef REP_P5
#define REP_P5 1
#endif
__global__ void __launch_bounds__(NWAVES * 64, 2) fwd_megakernel(Args args) {
    extern __shared__ __attribute__((aligned(16))) unsigned char lds_raw[];
    cg::grid_group grid = cg::this_grid();
    LAS unsigned char* lds = (LAS unsigned char*)lds_raw;
    const int G = gridDim.x, bx = blockIdx.x, NGW = G * NWAVES;
#define PHASE_IDS() int tid = threadIdx.x; asm volatile("" : "+v"(tid)); const int lane = tid & 63; const int wave = __builtin_amdgcn_readfirstlane(tid >> 6); const int gw = bx * NWAVES + wave; (void)lane; (void)gw
    unsigned char* ws = args.ws;
    unsigned* ctl = (unsigned*)(ws + WS_CTL);
    LAS float* red = (LAS float*)(lds + RED_OFF);
    volatile LAS int* misc = (volatile LAS int*)(lds + MISC_OFF);

    { PHASE_IDS(); if (bx == 0 && tid == 0) { ctl[0] = 0u; ctl[64] = 0u; ctl[256] = 0u; }
      if (bx == 0) for (int i = tid; i < XCD_BAR_WORDS; i += NWAVES * 64) ctl[4096 + i] = 0u;
      if (tid < 2) misc[8 + tid] = 0;
#ifndef NO_P0
    for (int rep_ = 0; rep_ < REP_P0; ++rep_) p0_prologue(args, lds, gw, NGW, lane, wave);
#endif
    }
    grid.sync();
    XcdBarrier xbar = xcd_barrier_post(ctl + 4096, (volatile LAS unsigned*)(lds + MISC_OFF) + 8);

#ifndef NO_P1
    for (int rep_ = 0; rep_ < REP_P1; ++rep_) {
        pg8::Gemm g{(const pg8::bf16_t*)(ws + WS_HN), (const pg8::bf16_t*)(ws + WS_WIN), MT, INC, DM}; typedef pg8::InProjOrder Ord; Ord S; S.init(G, bx);
        pg8::EpiIn E{(bf16*)(ws + WS_Q), (bf16*)(ws + WS_K), (bf16*)(ws + WS_V), (bf16*)(ws + WS_GB), (bf16*)(ws + WS_U), args.out, args.in[7], args.in[8], red,
                     1.4426950408889634f * 0.08838834764831845f, OFF_KP, OFF_VP, OFF_CP, OFF_KS, OFF_VS, OFF_CS};
        pg8::gemm_phase<pg8::EpiIn, Ord, true, true>(lds, g, S, E);
    }
#endif
    xcd_barrier(xbar);

#ifndef NO_P2
    {
        const int nitems = g_items.n;
        PHASE_IDS();
#ifdef DUP_P2
        for (int rep = 0; rep < 2; ++rep)
#else
        const int rep = 0;
#endif
        for (;;) {
            if (tid == 0) misc[0] = (int)atomicAdd(ctl + 64 * rep, 1u);
            __syncthreads();
            int it = misc[0];
            __syncthreads();
            if (it < 48) {
                pg8::Gemm g{(const pg8::bf16_t*)(ws + WS_HN), (const pg8::bf16_t*)(ws + WS_WIN), MT, INC, DM};
                pg8::OneUnit S1; S1.u0.pm = 30 + (it & 3); S1.u0.pn = 12 + (it >> 2); S1.u0.k0 = 0; S1.u0.nt = 32; S1.u0.split = 0; S1.u0.tu = 0; S1.u0.sp = 0;
                pg8::EpiIn E{(bf16*)(ws + WS_Q), (bf16*)(ws + WS_K), (bf16*)(ws + WS_V), (bf16*)(ws + WS_GB), (bf16*)(ws + WS_U), args.out, args.in[7], args.in[8], red,
                             1.4426950408889634f * 0.08838834764831845f, OFF_KP, OFF_VP, OFF_CP, OFF_KS, OFF_VS, OFF_CS};
                pg8::gemm_phase<pg8::EpiIn, pg8::OneUnit, true, true>(lds, g, S1, E);
                __syncthreads();
                continue;
            }
            it -= 48;
            const bool token = it >= 16 && it < 16 + NCONV;
            if (token || it >= nitems + NCONV) {
                for (;;) {
                    if (tid == 0) misc[0] = (int)atomicAdd(ctl + 256, 1u);
                    __syncthreads();
                    const int ch = misc[0];
                    __syncthreads();
                    if (ch >= P0_LATE_CHUNKS) break;
                    p0_run_range(args, (LAS float*)(lds + wave * 16384), P0_EARLY_ITEMS + ch * P0_CHUNK + wave * (P0_CHUNK / NWAVES), P0_CHUNK / NWAVES, lane);
                }
                if (token) continue;
                break;
            }
            if (it >= 16) it -= NCONV;
            const int code = g_items.v[it];
#if defined(ONLY_S)
            attn_item<true>(args, lds, code);
#elif defined(ONLY_P)
            attn_item_p(args, lds, code);
#else
            if (code & 1) attn_item<true>(args, lds, code); else attn_item_p(args, lds, code);
#endif
        }
    }
#endif
    xcd_barrier(xbar);

#ifndef NO_P3
    for (int rep_ = 0; rep_ < REP_P3; ++rep_) { PHASE_IDS(); mix_rows(args, gw, NGW, lane); }
#endif
    xcd_barrier(xbar);

#ifndef NO_P4
    for (int rep_ = 0; rep_ < REP_P4; ++rep_) {
        pg8::Gemm g{(const pg8::bf16_t*)(ws + WS_MIX), (const pg8::bf16_t*)(ws + WS_WOUT), MT, DM, DM}; typedef pg8::TailOrderT<MT / 256, DM / 256, DM / 64, 8> Ord; Ord S; S.init(G, bx);
        pg8::EpiOut E{args.in[0], args.in[1], args.out + OFF_Y, (bf16*)(ws + WS_HN), (float*)(ws + WS_SSQ), red, (float*)(ws + WS_PART)};
        pg8::gemm_phase<pg8::EpiOut, Ord, true, true>(lds, g, S, E);
        if (S.rem > 0) {
            xcd_barrier(xbar);
            PHASE_IDS();
            for (int w = gw; w < S.rem * 256; w += NGW) {
                const int tu = w >> 8, r = w & 255; pg8::Unit u; Ord::SO::unit(S.full * G + tu, u);
                const size_t row = (size_t)u.pm * 256 + r; const int col = u.pn * 256 + 4 * lane;
                const float* xin = row < NP ? args.in[0] + row * DM : args.in[1] + (row - NP) * DM;
                f32x4 v = *(const f32x4*)(xin + col);
                const bf16* p = (const bf16*)(ws + WS_PART) + (size_t)(tu * 8) * 65536 + r * 256 + 4 * lane;
                u32x2 sl[8];
#pragma unroll
                for (int s = 0; s < 8; ++s) sl[s] = *(const u32x2*)(p + (size_t)s * 65536);
#pragma unroll
                for (int s = 0; s < 8; ++s) { v[0] += bflo(sl[s].x); v[1] += bfhi(sl[s].x); v[2] += bflo(sl[s].y); v[3] += bfhi(sl[s].y); }
                *(f32x4*)(args.out + OFF_Y + row * DM + col) = v;
                u32x2 pk; pk.x = pk2(v[0], v[1]); pk.y = pk2(v[2], v[3]); *(u32x2*)((bf16*)(ws + WS_HN) + row * DM + col) = pk;
                const float ss = wave_sum((v[0] * v[0] + v[1] * v[1]) + (v[2] * v[2] + v[3] * v[3]));
                if (lane == 0) ((float*)(ws + WS_SSQ))[row * 8 + u.pn] = ss;
            }
        }
    }
#endif
    xcd_barrier(xbar);

#ifndef NO_P5
    for (int rep_ = 0; rep_ < REP_P5; ++rep_) {
        pg8::Gemm g{(const pg8::bf16_t*)(ws + WS_HN), (const pg8::bf16_t*)(ws + WS_WGU), MT, 2 * DFF, DM}; typedef pg8::StaticOrderT<MT / 256, 2 * DFF / 256, DM / 64> Ord; Ord S; S.init(G, bx);
        pg8::EpiGU E{(bf16*)(ws + WS_H), (const float*)(ws + WS_SSQ)};
        pg8::gemm_phase<pg8::EpiGU, Ord, true, true>(lds, g, S, E);
    }
#endif
    xcd_barrier(xbar);

#ifndef NO_P6
    {
        pg8::Gemm g{(const pg8::bf16_t*)(ws + WS_H), (const pg8::bf16_t*)(ws + WS_WDN), MT, DM, DFF};
        typedef pg8::TailOrderT<MT / 256, DM / 256, DFF / 64, 8> Ord; Ord S; S.init(G, bx);
        pg8::EpiDown E{args.out + OFF_Y, (float*)(ws + WS_PART), (const pg8::bf16_t*)(ws + WS_HN)};
        pg8::gemm_phase<pg8::EpiDown, Ord, true, true>(lds, g, S, E);
        if (S.rem > 0) {
            xcd_barrier(xbar);
            PHASE_IDS();
            for (int w = gw; w < S.rem * 256; w += NGW) {
                const int tu = w >> 8, r = w & 255; pg8::Unit u; Ord::SO::unit(S.full * G + tu, u);
                float* y = args.out + OFF_Y + ((size_t)u.pm * 256 + r) * DM + u.pn * 256 + 4 * lane;
                f32x4 v = *(const f32x4*)y;
                const bf16* p = (const bf16*)(ws + WS_PART) + (size_t)(tu * 8) * 65536 + r * 256 + 4 * lane;
                u32x2 sl[8];
#pragma unroll
                for (int s = 0; s < 8; ++s) sl[s] = *(const u32x2*)(p + (size_t)s * 65536);
#pragma unroll
                for (int s = 0; s < 8; ++s) { v[0] += bflo(sl[s].x); v[1] += bfhi(sl[s].x); v[2] += bflo(sl[s].y); v[3] += bfhi(sl[s].y); }
                *(f32x4*)y = v;
            }
        }
    }
#endif
}

extern "C" void kernel_launch(void* const* d_in, const int* in_sizes, int n_in, void* d_out, int out_size, void* d_ws, size_t ws_size, hipStream_t stream) {
    static int grid = 0;
    if (grid == 0) {
        if (n_in != 17 || (size_t)out_size != OUT_TOTAL || ws_size < WS_END) { fprintf(stderr, "kernel_launch: unexpected shapes (n_in %d out %d ws %zu need %zu)\n", n_in, out_size, ws_size, (size_t)WS_END); grid = -1; return; }
        int dev = 0, cus = 0, per_cu = 0;
        hipGetDevice(&dev); hipDeviceGetAttribute(&cus, hipDeviceAttributeMultiprocessorCount, dev);
        hipFuncSetAttribute((const void*)fwd_megakernel, hipFuncAttributeMaxDynamicSharedMemorySize, LDS_BYTES);
        hipOccupancyMaxActiveBlocksPerMultiprocessor(&per_cu, (const void*)fwd_megakernel, NWAVES * 64, LDS_BYTES);
        if (per_cu < 1) { fprintf(stderr, "kernel_launch: occupancy query says %d blocks per CU\n", per_cu); per_cu = 1; }
        (void)hipGetLastError();
        grid = cus;
    }
    if (grid < 0) return;
    Args a{};
    for (int i = 0; i < 17; ++i) a.in[i] = (const float*)d_in[i];
    a.out = (float*)d_out; a.ws = (unsigned char*)d_ws;
    void* kargs[] = {&a};
    hipError_t e = hipLaunchCooperativeKernel((const void*)fwd_megakernel, dim3(grid), dim3(NWAVES * 64), kargs, LDS_BYTES, stream);
    if (e != hipSuccess) fprintf(stderr, "cooperative launch failed: %s (grid %d)\n", hipGetErrorString(e), grid);
}
```

```cpp
#include <hip/hip_runtime.h>
#include <hip/hip_cooperative_groups.h>
#include <cstdio>
#include <cstdint>
namespace cg = cooperative_groups;
namespace pg8 {
#define PG8_LAS __attribute__((address_space(3)))
typedef unsigned short bf16_t;
typedef short bf16x8 __attribute__((ext_vector_type(8)));
typedef float f32x4 __attribute__((ext_vector_type(4)));
typedef unsigned u32x4 __attribute__((ext_vector_type(4)));
constexpr int BM = 256, BK = 64, HALF = 128, HTB = HALF * BK * 2  , STAGE_BYTES = 8 * HTB, NXCD = 8, WGM = 8;

__host__ __device__ __forceinline__ int lds_byte(int r, int c) { const int st = (r >> 4) * 2 + (c >> 5), rr = r & 15, cc = c & 31, ob = rr * 64 + cc * 2; return st * 1024 + (ob ^ (((ob >> 9) & 1) << 5)); }
__host__ __device__ __forceinline__ void stage_rc(int b, int& R, int& C) { const int st = b / 1024, sb = b % 1024, swz = sb ^ (((sb >> 9) & 1) << 5); R = (st >> 1) * 16 + swz / 64; C = (st & 1) * 32 + (swz % 64) / 2; }
__host__ __device__ __forceinline__ int perm32(int rho) { const int n = rho >> 4, i = rho & 15; return 8 * (i >> 2) + 4 * n + (i & 3); }

struct Unit { int pm, pn, k0, nt, split, tu, sp; };
struct Gemm { const bf16_t* A; const bf16_t* Bt; int M, N, K; };

template <int NM, int NN, int NTK> struct StaticOrderT {
    static constexpr int nM = NM, nN = NN, nwg = NM * NN, ntk = NTK;
    int G, c;
    __host__ __device__ __forceinline__ void init(int G_, int c_) { G = G_; c = c_; }
    __host__ __device__ __forceinline__ bool next(int i, Unit& u) const { const int L = i * G + c; if (L >= nwg) return false; unit(L, u); return true; }
    __host__ __device__ __forceinline__ static void unit(int L, Unit& u) {
        int wgid = L; { constexpr int q = nwg / NXCD, r = nwg % NXCD; const int xcd = wgid % NXCD, off = wgid / NXCD; wgid = (xcd < r ? xcd * (q + 1) : r * (q + 1) + (xcd - r) * q) + off; }
        constexpr int nig = WGM * nN; const int gid = wgid / nig, fm = gid * WGM, gsz = (nM - fm) < WGM ? (nM - fm) : WGM;
        u.pm = fm + ((wgid % nig) % gsz); u.pn = (wgid % nig) / gsz; u.k0 = 0; u.nt = ntk; u.split = 0; u.tu = 0; u.sp = 0;
    }
    __device__ __forceinline__ void a_ready(const Unit&) const {}
    __device__ __forceinline__ void done(const Unit&) const {}
};
template <int NM, int NN, int NTK, int NSPLIT> struct TailOrderT {
    typedef StaticOrderT<NM, NN, NTK> SO;
    int G, c, full, rem;
    __host__ __device__ __forceinline__ void init(int G_, int c_) { G = G_; c = c_; full = SO::nwg / G; rem = SO::nwg - full * G; if (rem * NSPLIT > G || NTK < 2 * NSPLIT) { full = 1 << 24; rem = 0; } }
    __host__ __device__ __forceinline__ static int kstart(int s) { return s >= NSPLIT ? NTK : ((s * NTK / NSPLIT) & ~1); }
    __host__ __device__ __forceinline__ bool next(int i, Unit& u) const {
        if (i < full) { const int L = i * G + c; if (L >= SO::nwg) return false; SO::unit(L, u); return true; }
        if (i > full || c >= rem * NSPLIT) return false;
        const int tu = c / NSPLIT, sp = c % NSPLIT; SO::unit(full * G + tu, u); u.k0 = kstart(sp); u.nt = kstart(sp + 1) - u.k0; u.split = 1; u.tu = tu; u.sp = sp; return true;
    }
    __device__ __forceinline__ void a_ready(const Unit&) const {}
    __device__ __forceinline__ void done(const Unit&) const {}
};

struct InProjOrder {
    typedef StaticOrderT<30, 24, 32> SO;
    int G, c;
    __host__ __device__ __forceinline__ void init(int G_, int c_) { G = G_; c = c_; }
    __host__ __device__ __forceinline__ bool next(int i, Unit& u) const {
        const int L = i * G + c; if (L >= 768) return false;
        if (L < 720) { SO::unit(L, u); return true; }
        const int j = L - 720; u.pm = 30 + (j & 3); u.pn = j >> 2; u.k0 = 0; u.nt = 32; u.split = 0; u.tu = 0; u.sp = 0; return true;
    }
    __device__ __forceinline__ void a_ready(const Unit&) const {}
    __device__ __forceinline__ void done(const Unit&) const {}
};
struct OneUnit {
    Unit u0;
    __host__ __device__ __forceinline__ bool next(int i, Unit& u) const { if (i != 0) return false; u = u0; return true; }
    __device__ __forceinline__ void a_ready(const Unit&) const {}
    __device__ __forceinline__ void done(const Unit&) const {}
};

__device__ __forceinline__ unsigned cvt_pk_bf16(float lo, float hi) { unsigned r; asm volatile("v_cvt_pk_bf16_f32 %0, %1, %2" : "=v"(r) : "v"(lo), "v"(hi)); return r; }
typedef float f32x2 __attribute__((ext_vector_type(2)));
#define PG8_LBAR() asm volatile("s_waitcnt lgkmcnt(0)\n\ts_barrier" ::: "memory")
constexpr int NPROMPT = 8192;
__device__ __forceinline__ u32x4 pack8(const f32x4 a, const f32x4 b) { u32x4 w; w.x = cvt_pk_bf16(a[0], a[1]); w.y = cvt_pk_bf16(a[2], a[3]); w.z = cvt_pk_bf16(b[0], b[1]); w.w = cvt_pk_bf16(b[2], b[3]); return w; }


__device__ __forceinline__ void store_partial(float* part, int nsplit, const f32x4 (&acc)[2][2][4][2], const Unit& u, int wr, int wc, int fr, int fq) {
    bf16_t* pt = (bf16_t*)part + (size_t)(u.tu * nsplit + u.sp) * 65536; int rl0 = wr * 64 + fr, cw = wc * 32 + 8 * fq; asm volatile("" : "+v"(rl0), "+v"(cw));
#pragma unroll
    for (int ai = 0; ai < 2; ++ai)
#pragma unroll
        for (int m = 0; m < 4; ++m)
#pragma unroll
            for (int bj = 0; bj < 2; ++bj) *(u32x4*)(pt + (ai * HALF + rl0 + m * 16) * 256 + bj * HALF + cw) = pack8(acc[ai][bj][m][0], acc[ai][bj][m][1]);
}

struct EpiIn {
    static constexpr bool PERM = true, AFTER_DRAIN = false;
    bf16_t *Q, *Kb, *Vb, *GB, *U; float* out; const float *gq, *gk; PG8_LAS float* red; float qscale;
    size_t off_kp, off_vp, off_cp, off_ks, off_vs, off_cs;
    __device__ __forceinline__ void operator()(const f32x4 (&acc)[2][2][4][2], const Unit& u, int wr, int wc, int fr, int fq) const {
        int rl0 = wr * 64 + fr, cw = wc * 32 + 8 * fq; asm volatile("" : "+v"(rl0), "+v"(cw));
        const int pn = u.pn, rowt = u.pm * BM;
        const bool prompt = rowt < NPROMPT;
        if (pn < 8) {
            const bool isq = pn < 4;
#pragma unroll
            for (int ai = 0; ai < 2; ++ai)
#pragma unroll
                for (int m = 0; m < 4; ++m)
#pragma unroll
                    for (int bj = 0; bj < 2; ++bj) {
                        const f32x4 a = acc[ai][bj][m][0], b = acc[ai][bj][m][1];
                        float s = (a[0] * a[0] + a[1] * a[1]) + (a[2] * a[2] + a[3] * a[3]) + (b[0] * b[0] + b[1] * b[1]) + (b[2] * b[2] + b[3] * b[3]);
                        s += __shfl_xor(s, 16); s += __shfl_xor(s, 32);
                        if (fq == 0) red[((ai * HALF + rl0 + m * 16) * 2 + bj) * 4 + wc] = s;
                    }
            PG8_LBAR();
            const float* g = isq ? gq : gk;
            const f32x4 g0 = *(const f32x4*)(g + cw), g1 = *(const f32x4*)(g + cw + 4);
#pragma unroll
            for (int ai = 0; ai < 2; ++ai)
#pragma unroll
                for (int m = 0; m < 4; ++m) {
                    const int rl = ai * HALF + rl0 + m * 16; const size_t row = (size_t)(rowt + rl);
#pragma unroll
                    for (int bj = 0; bj < 2; ++bj) {
                        const f32x4 p = *(const PG8_LAS f32x4*)(red + (rl * 2 + bj) * 4);
                        float rs = __builtin_amdgcn_rsqf(((p[0] + p[1]) + (p[2] + p[3])) * (1.0f / 128.0f) + 1e-6f);
                        if (isq) rs *= qscale;
                        const f32x4 v0 = acc[ai][bj][m][0] * rs * g0, v1 = acc[ai][bj][m][1] * rs * g1;
                        if (isq) { *(u32x4*)(Q + row * 1024 + pn * 256 + bj * HALF + cw) = pack8(v0, v1); }
                        else {
                            const int col = (pn - 4) * 256 + bj * HALF + cw;
                            float* o = prompt ? out + off_kp + row * 1024 + col : out + off_ks + (row - NPROMPT) * 1024 + col;
                            *(f32x4*)o = v0; *(f32x4*)(o + 4) = v1;
                            if (prompt) *(u32x4*)(Kb + row * 1024 + col) = pack8(v0, v1);
                        }
                    }
                }
        } else if (pn < 12) {
#pragma unroll
            for (int ai = 0; ai < 2; ++ai)
#pragma unroll
                for (int m = 0; m < 4; ++m) {
                    const size_t row = (size_t)(rowt + ai * HALF + rl0 + m * 16);
#pragma unroll
                    for (int bj = 0; bj < 2; ++bj) {
                        const int col = (pn - 8) * 256 + bj * HALF + cw; const f32x4 v0 = acc[ai][bj][m][0], v1 = acc[ai][bj][m][1];
                        float* o = prompt ? out + off_vp + row * 1024 + col : out + off_vs + (row - NPROMPT) * 1024 + col;
                        *(f32x4*)o = v0; *(f32x4*)(o + 4) = v1;
                        if (prompt) *(u32x4*)(Vb + row * 1024 + col) = pack8(v0, v1);
                    }
                }
        } else if (pn < 16) {
#pragma unroll
            for (int ai = 0; ai < 2; ++ai)
#pragma unroll
                for (int m = 0; m < 4; ++m) {
                    const size_t row = (size_t)(rowt + ai * HALF + rl0 + m * 16);
#pragma unroll
                    for (int bj = 0; bj < 2; ++bj) *(u32x4*)(GB + row * 1024 + (pn - 12) * 256 + bj * HALF + cw) = pack8(acc[ai][bj][m][0], acc[ai][bj][m][1]);
                }
        } else {
#pragma unroll
            for (int ai = 0; ai < 2; ++ai)
#pragma unroll
                for (int m = 0; m < 4; ++m) {
                    const int rowi = rowt + ai * HALF + rl0 + m * 16; const int ch = (pn - 16) * HALF + cw;
                    const f32x4 v0 = acc[ai][0][m][0] * acc[ai][1][m][0], v1 = acc[ai][0][m][1] * acc[ai][1][m][1];
                    *(u32x4*)(U + (size_t)rowi * 1024 + ch) = pack8(v0, v1);
                    if (prompt) { const int t = rowi & 4095; if (t >= 4094) { float* o = out + off_cp + ((rowi >> 12) * 2 + (t - 4094)) * 1024 + ch; *(f32x4*)o = v0; *(f32x4*)(o + 4) = v1; } }
                    else { const int rs_ = rowi - NPROMPT, t = rs_ & 63; if (t >= 62) { float* o = out + off_cs + ((rs_ >> 6) * 2 + (t - 62)) * 1024 + ch; *(f32x4*)o = v0; *(f32x4*)(o + 4) = v1; } }
                }
        }
    }
};

struct EpiOut {
    static constexpr bool PERM = true, AFTER_DRAIN = false;
    const float *xp, *xs; float* Y; bf16_t* X1; float* ssq; PG8_LAS float* red; float* part;
    __device__ __forceinline__ void operator()(const f32x4 (&acc)[2][2][4][2], const Unit& u, int wr, int wc, int fr, int fq) const {
        if (u.split) { store_partial(part, 8, acc, u, wr, wc, fr, fq); return; }
        int rl0 = wr * 64 + fr, cw = wc * 32 + 8 * fq; asm volatile("" : "+v"(rl0), "+v"(cw));
        const int pn = u.pn, rowt = u.pm * BM;
        const float* xin = rowt < NPROMPT ? xp + (size_t)rowt * 2048 : xs + (size_t)(rowt - NPROMPT) * 2048;
#pragma unroll
        for (int ai = 0; ai < 2; ++ai) {
            f32x4 xv[4][2][2];
#pragma unroll
            for (int m = 0; m < 4; ++m)
#pragma unroll
                for (int bj = 0; bj < 2; ++bj) { const float* xi = xin + (size_t)(ai * HALF + rl0 + m * 16) * 2048 + pn * 256 + bj * HALF + cw; xv[m][bj][0] = __builtin_nontemporal_load((const f32x4*)xi); xv[m][bj][1] = __builtin_nontemporal_load((const f32x4*)(xi + 4)); }
#pragma unroll
            for (int m = 0; m < 4; ++m) {
                const int rl = ai * HALF + rl0 + m * 16; float s = 0.f;
#pragma unroll
                for (int bj = 0; bj < 2; ++bj) {
                    const int col = pn * 256 + bj * HALF + cw;
                    const f32x4 v0 = xv[m][bj][0] + acc[ai][bj][m][0], v1 = xv[m][bj][1] + acc[ai][bj][m][1];
                    *(u32x4*)(X1 + (size_t)(rowt + rl) * 2048 + col) = pack8(v0, v1);
                    s += (v0[0] * v0[0] + v0[1] * v0[1]) + (v0[2] * v0[2] + v0[3] * v0[3]) + (v1[0] * v1[0] + v1[1] * v1[1]) + (v1[2] * v1[2] + v1[3] * v1[3]);
                }
                s += __shfl_xor(s, 16); s += __shfl_xor(s, 32);
                if (fq == 0) red[rl * 4 + wc] = s;
            }
            asm volatile("" ::: "memory");
        }
        PG8_LBAR();
        if (threadIdx.x < 256) { const f32x4 p = *(const PG8_LAS f32x4*)(red + threadIdx.x * 4); ssq[(size_t)(rowt + threadIdx.x) * 8 + pn] = (p[0] + p[1]) + (p[2] + p[3]); }
        PG8_LBAR();
    }
};

struct EpiGU {
    static constexpr bool PERM = true, AFTER_DRAIN = false;
    bf16_t* H; const float* ssq;
    __device__ __forceinline__ void operator()(const f32x4 (&acc)[2][2][4][2], const Unit& u, int wr, int wc, int fr, int fq) const {
        int rl0 = wr * 64 + fr, cw = wc * 32 + 8 * fq; asm volatile("" : "+v"(rl0), "+v"(cw));
        const int pn = u.pn, rowt = u.pm * BM;
        f32x4 pa[2][4], pb[2][4];
#pragma unroll
        for (int ai = 0; ai < 2; ++ai)
#pragma unroll
            for (int m = 0; m < 4; ++m) { const float* p = ssq + (size_t)(rowt + ai * HALF + rl0 + m * 16) * 8; pa[ai][m] = *(const f32x4*)p; pb[ai][m] = *(const f32x4*)(p + 4); }
#pragma unroll
        for (int ai = 0; ai < 2; ++ai)
#pragma unroll
            for (int m = 0; m < 4; ++m) {
                const size_t row = (size_t)(rowt + ai * HALF + rl0 + m * 16);
                const f32x4 p0 = pa[ai][m], p1 = pb[ai][m];
                const float rs = __builtin_amdgcn_rsqf((((p0[0] + p0[1]) + (p0[2] + p0[3])) + ((p1[0] + p1[1]) + (p1[2] + p1[3]))) * (1.0f / 2048.0f) + 1e-6f);
                f32x4 h[2];
#pragma unroll
                for (int n = 0; n < 2; ++n) {
                    const f32x4 g = acc[ai][0][m][n] * rs, up = acc[ai][1][m][n] * rs;
#pragma unroll
                    for (int j = 0; j < 4; ++j) h[n][j] = g[j] * __builtin_amdgcn_rcpf(1.0f + __builtin_amdgcn_exp2f(-1.4426950408889634f * g[j])) * up[j];
                }
                *(u32x4*)(H + row * 5632 + pn * HALF + cw) = pack8(h[0], h[1]);
            }
    }
};

struct EpiDown {
    static constexpr bool PERM = true, AFTER_DRAIN = false;
    float* Y; float* part; const bf16_t* X1;
    __device__ __forceinline__ void operator()(const f32x4 (&acc)[2][2][4][2], const Unit& u, int wr, int wc, int fr, int fq) const {
        if (u.split) { store_partial(part, 8, acc, u, wr, wc, fr, fq); return; }
        int rl0 = wr * 64 + fr, cw = wc * 32 + 8 * fq; asm volatile("" : "+v"(rl0), "+v"(cw));
        const int pn = u.pn, rowt = u.pm * BM;
        u32x4 xb[2][4][2];
#pragma unroll
        for (int ai = 0; ai < 2; ++ai)
#pragma unroll
            for (int m = 0; m < 4; ++m)
#pragma unroll
                for (int bj = 0; bj < 2; ++bj) xb[ai][m][bj] = __builtin_nontemporal_load((const u32x4*)(X1 + (size_t)(rowt + ai * HALF + rl0 + m * 16) * 2048 + pn * 256 + bj * HALF + cw));
#pragma unroll
        for (int ai = 0; ai < 2; ++ai)
#pragma unroll
            for (int m = 0; m < 4; ++m)
#pragma unroll
                for (int bj = 0; bj < 2; ++bj) {
                    const size_t off = (size_t)(rowt + ai * HALF + rl0 + m * 16) * 2048 + pn * 256 + bj * HALF + cw;
                    const u32x4 x = xb[ai][m][bj];
                    f32x4 b0, b1; b0[0] = __builtin_bit_cast(float, x.x << 16); b0[1] = __builtin_bit_cast(float, x.x & 0xffff0000u); b0[2] = __builtin_bit_cast(float, x.y << 16); b0[3] = __builtin_bit_cast(float, x.y & 0xffff0000u);
                    b1[0] = __builtin_bit_cast(float, x.z << 16); b1[1] = __builtin_bit_cast(float, x.z & 0xffff0000u); b1[2] = __builtin_bit_cast(float, x.w << 16); b1[3] = __builtin_bit_cast(float, x.w & 0xffff0000u);
                    float* o = Y + off; *(f32x4*)o = b0 + acc[ai][bj][m][0]; *(f32x4*)(o + 4) = b1 + acc[ai][bj][m][1];
                }
    }
};

struct EpiNone {
    static constexpr bool PERM = true, AFTER_DRAIN = false;
    float* sink;
    __device__ __forceinline__ void operator()(const f32x4 (&acc)[2][2][4][2], const Unit& u, int wr, int wc, int fr, int fq) const {
        if (acc[0][0][0][0][0] == 12345.678f && acc[1][1][3][1][3] == -9876.5f) sink[0] = 1.f;
    }
};
template <class Epi, class Sched, bool ALIGN_EPI = false, bool SP2 = false>
__device__ __forceinline__ void gemm_phase(PG8_LAS unsigned char* lds, const Gemm g, const Sched& S, const Epi& E) {
    int tid_ = threadIdx.x; asm volatile("" : "+v"(tid_));
    const int tid = tid_, wid = __builtin_amdgcn_readfirstlane(tid >> 6), lane = tid & 63, wr = wid >> 2, wc = wid & 3, fr = lane & 15, fq = lane >> 4;
    const int K = g.K;
    unsigned voffA[2], voffB[2];
#pragma unroll
    for (int i = 0; i < 2; ++i) { int R, C; stage_rc(tid * 16 + i * 8192, R, C); const int Rb = Epi::PERM ? ((R & ~31) + perm32(R & 31)) : R;
        voffA[i] = (unsigned)(R * K + C) * 2u; voffB[i] = (unsigned)(Rb * K + C) * 2u; }
    const size_t kstep = (size_t)(BK * 2);
    const size_t hstep = (size_t)HALF * K * 2;
    const size_t tstep = 2 * hstep;
    const unsigned ldsw = (unsigned)wid * 1024u;
    const int aoff = lds_byte(wr * 64 + fr, fq * 8), boff = lds_byte(wc * 32 + fr, fq * 8);
#define PG8_SA(b, h) (((b) * 2 + (h)) * HTB)
#define PG8_SB(b, h) ((4 + (b) * 2 + (h)) * HTB)
#define PG8_STAGE(bufoff, gbase, voff) do { _Pragma("unroll") for (int _i = 0; _i < 2; ++_i) \
        __builtin_amdgcn_global_load_lds((const unsigned*)((const char*)(gbase) + (voff)[_i]), (PG8_LAS unsigned*)(lds + (bufoff) + ldsw + _i * 8192), 16, 0, 0); } while (0)
#define PG8_LDA(dst, b, h) do { _Pragma("unroll") for (int m = 0; m < 4; ++m) _Pragma("unroll") for (int k = 0; k < 2; ++k) dst[m][k] = *(const PG8_LAS bf16x8*)(lds + PG8_SA(b, h) + aoff + m * 2048 + k * 1024); } while (0)
#define PG8_LDB(dst, b, h) do { _Pragma("unroll") for (int n = 0; n < 2; ++n) _Pragma("unroll") for (int k = 0; k < 2; ++k) dst[n][k] = *(const PG8_LAS bf16x8*)(lds + PG8_SB(b, h) + boff + n * 2048 + k * 1024); } while (0)
#define PG8_MMA(ai, bj, At, Bt) do { __builtin_amdgcn_s_setprio(1); _Pragma("unroll") for (int m = 0; m < 4; ++m) _Pragma("unroll") for (int n = 0; n < 2; ++n) _Pragma("unroll") for (int k = 0; k < 2; ++k) \
        acc[ai][bj][m][n] = __builtin_amdgcn_mfma_f32_16x16x32_bf16(Bt[n][k], At[m][k], acc[ai][bj][m][n], 0, 0, 0); __builtin_amdgcn_s_setprio(0); } while (0)
#define PG8_WAIT_V(n) asm volatile("s_waitcnt vmcnt(" #n ")" ::: "memory")
#define PG8_WAIT_L(n) asm volatile("s_waitcnt lgkmcnt(" #n ")" ::: "memory")
#define PG8_BAR __builtin_amdgcn_s_barrier()
#define PG8_SCHED __builtin_amdgcn_sched_barrier(0)
    Unit cur, nxt; int ui = 0;
    if (!S.next(0, cur)) return;
    f32x4 acc[2][2][4][2];
#pragma unroll
    for (int a = 0; a < 2; ++a)
#pragma unroll
        for (int b = 0; b < 2; ++b)
#pragma unroll
            for (int m = 0; m < 4; ++m)
#pragma unroll
                for (int n = 0; n < 2; ++n) acc[a][b][m][n] = (f32x4){0.f, 0.f, 0.f, 0.f};
    bf16x8 At[4][2], B0[2][2], B1[2][2];
    const char* cA = (const char*)g.A + (size_t)cur.pm * tstep + (size_t)cur.k0 * kstep; const char* cB = (const char*)g.Bt + (size_t)cur.pn * tstep + (size_t)cur.k0 * kstep;
    S.a_ready(cur);
    if constexpr (SP2) {
        PG8_STAGE(PG8_SB(0, 0), cB, voffB); PG8_STAGE(PG8_SB(0, 1), cB + hstep, voffB); PG8_STAGE(PG8_SA(0, 0), cA, voffA); PG8_STAGE(PG8_SA(0, 1), cA + hstep, voffA);
        if (wr == 1) PG8_BAR;
        PG8_WAIT_V(2); PG8_BAR;
        PG8_STAGE(PG8_SB(1, 0), cB + kstep, voffB); PG8_STAGE(PG8_SA(1, 0), cA + kstep, voffA); PG8_STAGE(PG8_SB(1, 1), cB + hstep + kstep, voffB);
        PG8_WAIT_V(6); PG8_BAR;
    } else {
        PG8_STAGE(PG8_SB(0, 0), cB, voffB); PG8_STAGE(PG8_SA(0, 0), cA, voffA); PG8_STAGE(PG8_SB(0, 1), cB + hstep, voffB); PG8_STAGE(PG8_SA(0, 1), cA + hstep, voffA);
        if (wr == 1) PG8_BAR;
        PG8_WAIT_V(4); PG8_BAR;
        PG8_STAGE(PG8_SB(1, 0), cB + kstep, voffB); PG8_STAGE(PG8_SA(1, 0), cA + kstep, voffA); PG8_STAGE(PG8_SB(1, 1), cB + hstep + kstep, voffB);
        PG8_WAIT_V(6); PG8_BAR;
    }
    for (;;) {
        const bool has_next = S.next(ui + 1, nxt);
        const char* nA = has_next ? (const char*)g.A + (size_t)nxt.pm * tstep + (size_t)nxt.k0 * kstep : cA; const char* nB = has_next ? (const char*)g.Bt + (size_t)nxt.pn * tstep + (size_t)nxt.k0 * kstep : cB;
        const int nt = cur.nt;
        for (int t = 0; t < nt; t += 2) {
            const bool last = (t == nt - 2);
            const char* a1 = cA + (size_t)(t + 1) * kstep;
            const char* a2 = last ? nA : cA + (size_t)(t + 2) * kstep; const char* b2 = last ? nB : cB + (size_t)(t + 2) * kstep;
            const char* a3 = a2 + kstep; const char* b3 = b2 + kstep;
            if (last && has_next) S.a_ready(nxt);
            if constexpr (SP2) {
            PG8_LDB(B0, 0, 0); PG8_LDB(B1, 0, 1); PG8_SCHED; PG8_LDA(At, 0, 0); PG8_STAGE(PG8_SA(1, 1), a1 + hstep, voffA);
            PG8_WAIT_V(8); PG8_WAIT_L(0); PG8_BAR; PG8_MMA(0, 0, At, B0); PG8_MMA(0, 1, At, B1); PG8_BAR; PG8_SCHED;
            PG8_LDA(At, 0, 1); PG8_STAGE(PG8_SB(0, 0), b2, voffB); PG8_STAGE(PG8_SB(0, 1), b2 + hstep, voffB); PG8_STAGE(PG8_SA(0, 0), a2, voffA);
            PG8_WAIT_V(8); PG8_WAIT_L(0); PG8_BAR; PG8_MMA(1, 0, At, B0); PG8_MMA(1, 1, At, B1); PG8_BAR; PG8_SCHED;
            PG8_LDB(B0, 1, 0); PG8_LDB(B1, 1, 1); PG8_SCHED; PG8_LDA(At, 1, 0); PG8_STAGE(PG8_SA(0, 1), a2 + hstep, voffA);
            PG8_WAIT_V(8); PG8_WAIT_L(0); PG8_BAR; PG8_MMA(0, 0, At, B0); PG8_MMA(0, 1, At, B1); PG8_BAR; PG8_SCHED;
            PG8_LDA(At, 1, 1); PG8_STAGE(PG8_SB(1, 0), b3, voffB); PG8_STAGE(PG8_SB(1, 1), b3 + hstep, voffB); PG8_STAGE(PG8_SA(1, 0), a3, voffA);
            PG8_WAIT_V(8); PG8_WAIT_L(0); PG8_BAR; PG8_MMA(1, 0, At, B0); PG8_MMA(1, 1, At, B1); PG8_BAR; PG8_SCHED;
            } else {
            PG8_LDB(B0, 0, 0); PG8_SCHED; PG8_LDA(At, 0, 0); PG8_STAGE(PG8_SA(1, 1), a1 + hstep, voffA);
            PG8_WAIT_L(8); PG8_BAR; PG8_WAIT_L(0); PG8_MMA(0, 0, At, B0); PG8_BAR; PG8_SCHED;
            PG8_LDB(B1, 0, 1); PG8_STAGE(PG8_SB(0, 0), b2, voffB);
            PG8_BAR; PG8_WAIT_L(0); PG8_MMA(0, 1, At, B1); PG8_BAR;
            PG8_LDA(At, 0, 1); PG8_STAGE(PG8_SA(0, 0), a2, voffA);
            PG8_BAR; PG8_WAIT_L(0); PG8_MMA(1, 0, At, B0); PG8_BAR; PG8_SCHED;
            PG8_STAGE(PG8_SB(0, 1), b2 + hstep, voffB);
            PG8_WAIT_V(6); PG8_BAR; PG8_MMA(1, 1, At, B1); PG8_BAR;
            PG8_LDB(B0, 1, 0); PG8_SCHED; PG8_LDA(At, 1, 0); PG8_STAGE(PG8_SA(0, 1), a2 + hstep, voffA);
            PG8_WAIT_L(8); PG8_BAR; PG8_WAIT_L(0); PG8_MMA(0, 0, At, B0); PG8_BAR; PG8_SCHED;
            PG8_LDB(B1, 1, 1); PG8_STAGE(PG8_SB(1, 0), b3, voffB);
            PG8_BAR; PG8_WAIT_L(0); PG8_MMA(0, 1, At, B1); PG8_BAR;
            PG8_LDA(At, 1, 1); PG8_STAGE(PG8_SA(1, 0), a3, voffA);
            PG8_BAR; PG8_WAIT_L(0); PG8_MMA(1, 0, At, B0); PG8_BAR; PG8_SCHED;
            PG8_STAGE(PG8_SB(1, 1), b3 + hstep, voffB);
            PG8_WAIT_V(6); PG8_BAR; PG8_MMA(1, 1, At, B1); PG8_BAR;
            }
        }
        if constexpr (ALIGN_EPI) { if (wr == 0) PG8_BAR; }
        if constexpr (!Epi::AFTER_DRAIN) { E(acc, cur, wr, wc, fr, fq); S.done(cur); }
        if (!has_next) break;
#pragma unroll
        for (int a = 0; a < 2; ++a)
#pragma unroll
            for (int b = 0; b < 2; ++b)
#pragma unroll
                for (int m = 0; m < 4; ++m)
#pragma unroll
                    for (int n = 0; n < 2; ++n) acc[a][b][m][n] = (f32x4){0.f, 0.f, 0.f, 0.f};
        cur = nxt; cA = nA; cB = nB; ++ui;
        if constexpr (ALIGN_EPI) { if (wr == 1) PG8_BAR; }
    }
    PG8_WAIT_V(0);
    if constexpr (!ALIGN_EPI) { if (wr == 0) PG8_BAR; }
    PG8_BAR;
    if constexpr (Epi::AFTER_DRAIN) { E.fused(acc, cur, wr, wc, fr, fq, lds, wid, lane); S.done(cur); }
#undef PG8_SA
#undef PG8_SB
#undef PG8_STAGE
#undef PG8_LDA
#undef PG8_LDB
#undef PG8_MMA
#undef PG8_WAIT_V
#undef PG8_WAIT_L
#undef PG8_BAR
#undef PG8_SCHED
}
}
#define LAS __attribute__((address_space(3)))
typedef unsigned short bf16;
typedef float f32x4 __attribute__((ext_vector_type(4)));
typedef float f32x16 __attribute__((ext_vector_type(16)));
typedef short bf16x8 __attribute__((ext_vector_type(8)));
typedef short s16x4 __attribute__((ext_vector_type(4)));
typedef unsigned u32x4 __attribute__((ext_vector_type(4)));
typedef unsigned u32x2 __attribute__((ext_vector_type(2)));
constexpr int DM = 2048, SEQ = 4096, NP = 8192, NS = 512, MT = NP + NS, AW = 1024, CC = 1024, INC = 6144, DFF = 5632, PAST = 4096, DSEQ = 64;
constexpr float EPS = 1e-6f;
constexpr size_t OFF_Y = 0, OFF_KP = (size_t)MT * DM, OFF_VP = OFF_KP + (size_t)NP * AW, OFF_CP = OFF_VP + (size_t)NP * AW, OFF_KS = OFF_CP + 2 * 2 * CC,
                 OFF_VS = OFF_KS + (size_t)NS * AW, OFF_CS = OFF_VS + (size_t)NS * AW, OUT_TOTAL = OFF_CS + 8 * 2 * CC;
static_assert(OUT_TOTAL == 35672064, "output size");
constexpr size_t MiB = 1u << 20;
constexpr size_t WS_CTL = 0, WS_WIN = 1 * MiB, WS_WOUT = 25 * MiB, WS_WGU = 33 * MiB, WS_WDN = 77 * MiB, WS_HN = 99 * MiB, WS_Q = 133 * MiB, WS_K = 150 * MiB, WS_V = 166 * MiB,
                 WS_GB = 182 * MiB, WS_U = 199 * MiB, WS_MIX = 216 * MiB, WS_SSQ = 250 * MiB, WS_TP = 251 * MiB, WS_OP = 256 * MiB, WS_H = 256 * MiB, WS_PART = 133 * MiB  ;
constexpr int NSLOT = 256 + 16;
constexpr size_t WS_END = WS_OP + (size_t)NSLOT * 131072;
constexpr int RING_BYTES = 131072, RED_OFF = RING_BYTES, MISC_OFF = RED_OFF + 8192, LDS_BYTES = 147456;
constexpr int NWAVES = 8;

#define XB_TMO      128
#define XB_XCNT(j)  (256  + 64 * (j))
#define XB_XSUB(j)  (1280 + 64 * (j))
#define XB_XGEN(j)  (2304 + 64 * (j))
#define XB_TOP      3328
#define XB_TOPGEN   3392
#define XCD_BAR_WORDS 3456
#define XB_SPIN_CAP (1u << 18)

__device__ __forceinline__ unsigned xb_ld(unsigned* p)              { return __hip_atomic_load(p, __ATOMIC_RELAXED, __HIP_MEMORY_SCOPE_AGENT); }
__device__ __forceinline__ unsigned xb_add(unsigned* p, unsigned v) { return __hip_atomic_fetch_add(p, v, __ATOMIC_RELAXED, __HIP_MEMORY_SCOPE_AGENT); }
__device__ __forceinline__ unsigned xb_xcc_id() { return (unsigned)__builtin_amdgcn_s_getreg((3 << 11) | 20) & 0xFu; }
#define XB_SPIN(cond, bar) do { unsigned _sp = 0; while (cond) { __builtin_amdgcn_s_sleep(1); \
    if ((++_sp & 255u) == 0u) { if (xb_ld(&(bar)[XB_TMO])) break; if (_sp > XB_SPIN_CAP) { atomicAdd(&(bar)[XB_TMO], 1u); break; } } } } while (0)

struct XcdBarrier {
    unsigned* bar; unsigned x;
    volatile LAS unsigned* st;
};

__device__ __forceinline__ XcdBarrier xcd_barrier_post(unsigned* bar, volatile LAS unsigned* st) {
    XcdBarrier b; b.bar = bar; b.x = xb_xcc_id(); b.st = st;
    if (threadIdx.x == 0) (void)xb_add(&bar[XB_XCNT(b.x)], 1u);
    return b;
}
__device__ __forceinline__ void xcd_barrier_complete(unsigned* bar, unsigned x, unsigned& nloc, unsigned& nx) {
    const unsigned G = gridDim.x * gridDim.y * gridDim.z;
    unsigned sum, cnt, mine, sp = 0u;
    for (;;) {
        sum = 0u; cnt = 0u; mine = 0u;
#pragma unroll
        for (unsigned j = 0; j < 16; ++j) { const unsigned c = xb_ld(&bar[XB_XCNT(j)]); sum += c; cnt += (c > 0u) ? 1u : 0u; mine = (j == x) ? c : mine; }
        if (sum == G) break;
        __builtin_amdgcn_s_sleep(1);
        if ((++sp & 255u) == 0u) { if (xb_ld(&bar[XB_TMO])) break; if (sp > XB_SPIN_CAP) { atomicAdd(&bar[XB_TMO], 1u); break; } }
    }
    nloc = mine > 0u ? mine : 1u; nx = cnt > 0u ? cnt : 1u;
}

__device__ __forceinline__ void xcd_barrier(const XcdBarrier& b) {
    asm volatile("s_waitcnt vmcnt(0)" ::: "memory");
    __syncthreads();
    if (threadIdx.x == 0) {
        unsigned* bar = b.bar;
        __builtin_amdgcn_s_waitcnt(0);
        unsigned nloc = b.st[0], nx = b.st[1];
        if (nloc == 0u) { xcd_barrier_complete(bar, b.x, nloc, nx); b.st[0] = nloc; b.st[1] = nx; }
        const unsigned old = xb_add(&bar[XB_XSUB(b.x)], 1u);
        const unsigned gen = old / nloc;
        if (old + 1u == (gen + 1u) * nloc) {
            __builtin_amdgcn_fence(__ATOMIC_RELEASE, "agent");
            asm volatile("s_waitcnt vmcnt(0)" ::: "memory");
            const unsigned og = xb_add(&bar[XB_TOP], 1u);
            const unsigned tg = og / nx;
            if (og + 1u == (tg + 1u) * nx) xb_add(&bar[XB_TOPGEN], 1u);
            else XB_SPIN(xb_ld(&bar[XB_TOPGEN]) == tg, bar);
            __builtin_amdgcn_fence(__ATOMIC_ACQUIRE, "agent");
            xb_add(&bar[XB_XGEN(b.x)], 1u);
            asm volatile("s_waitcnt vmcnt(0)" ::: "memory");
        } else {
            XB_SPIN(xb_ld(&bar[XB_XGEN(b.x)]) == gen, bar);
            __builtin_amdgcn_fence(__ATOMIC_ACQUIRE, "agent");
            asm volatile("s_waitcnt vmcnt(0)" ::: "memory");
        }
    }
    __syncthreads();
}

struct ItemTab { int n; int v[272]; };
constexpr int p_nsteps(int qb, int c) { return 8 * (qb + 1); }
constexpr ItemTab make_items() {
    ItemTab t{}; t.n = 0;
    for (int b = 0; b < 8; ++b) for (int hg = 0; hg < 2; ++hg) t.v[t.n++] = 1 | (b << 1) | (hg << 4);
    for (int qb = 15; qb >= 0; --qb) for (int bh = 0; bh < 16; ++bh) t.v[t.n++] = (bh << 1) | (qb << 5);
    return t;
}
__device__ const ItemTab g_items = make_items();

__device__ __forceinline__ unsigned f2bf(float f) { unsigned u = __builtin_bit_cast(unsigned, f); return (u + 0x7fffu + ((u >> 16) & 1u)) >> 16; }
__device__ __forceinline__ unsigned pk2(float lo, float hi) { return pg8::cvt_pk_bf16(lo, hi); }
__device__ __forceinline__ float bflo(unsigned w) { return __builtin_bit_cast(float, w << 16); }
__device__ __forceinline__ float bfhi(unsigned w) { return __builtin_bit_cast(float, w & 0xffff0000u); }
__device__ __forceinline__ int crow(int r, int hi) { return (r & 3) + 8 * (r >> 2) + 4 * hi; }
__device__ __forceinline__ float wave_sum(float v) {
#pragma unroll
    for (int o = 1; o < 64; o <<= 1) v += __shfl_xor(v, o);
    return v;
}

struct Args { const float* in[17]; float* out; unsigned char* ws; };

struct P0Item { const float* src; const float* gk; bf16* dst; int N, K, k0; };
__device__ __forceinline__ P0Item p0_decode(const Args& a, int it) {
    constexpr int I_IN = 32 * 192, I_OUT = 32 * 64, I_G = 32 * 176;
    unsigned char* ws = a.ws; P0Item r; int n0, kb, drow; r.gk = nullptr;
    if (it < I_IN) { kb = it / 192; n0 = 32 * (it % 192); drow = n0;
        if (n0 >= 5120) { const int ch = n0 - 5120; drow = 4096 + (ch >> 7) * 256 + 128 + (ch & 127); } else if (n0 >= 4096) { const int ch = n0 - 4096; drow = 4096 + (ch >> 7) * 256 + (ch & 127); }
        r.src = a.in[6]; r.N = INC; r.K = DM; r.dst = (bf16*)(ws + WS_WIN); }
    else if ((it -= I_IN) < I_OUT) { kb = it / 64; n0 = 32 * (it % 64); drow = n0; r.src = a.in[12]; r.N = DM; r.K = DM; r.dst = (bf16*)(ws + WS_WOUT); }
    else if ((it -= I_OUT) < 2 * I_G) { const int up = it >= I_G; if (up) it -= I_G; kb = it / 176; n0 = 32 * (it % 176); drow = (n0 >> 7) * 256 + up * 128 + (n0 & 127);
        r.src = a.in[up ? 15 : 14]; r.N = DFF; r.K = DM; r.dst = (bf16*)(ws + WS_WGU); r.gk = a.in[13]; }
    else { it -= 2 * I_G; kb = it / 64; n0 = 32 * (it % 64); drow = n0; r.src = a.in[16]; r.N = DM; r.K = DFF; r.dst = (bf16*)(ws + WS_WDN); }
    r.k0 = 64 * kb; r.src += (size_t)r.k0 * r.N + n0; r.dst += (size_t)drow * r.K + r.k0;
    return r;
}
__device__ __forceinline__ void p0_load(const P0Item& p, f32x4 (&v)[8], int lane) {
#pragma unroll
    for (int j = 0; j < 8; ++j) v[j] = __builtin_nontemporal_load((const f32x4*)(p.src + (size_t)(8 * j + (lane >> 3)) * p.N + 4 * (lane & 7)));
}
__device__ __forceinline__ void p0_finish(const P0Item& p, const f32x4 (&v)[8], LAS float* scr, int lane) {
#pragma unroll
    for (int j = 0; j < 8; ++j) { const int kk = 8 * j + (lane >> 3); const float g = p.gk ? p.gk[p.k0 + kk] : 1.0f; LAS float* s = scr + kk * 33 + 4 * (lane & 7);
        s[0] = v[j][0] * g; s[1] = v[j][1] * g; s[2] = v[j][2] * g; s[3] = v[j][3] * g; }
    asm volatile("s_waitcnt lgkmcnt(0)" ::: "memory");
    const int c = lane & 7;
#pragma unroll
    for (int j = 0; j < 4; ++j) { const int n = (lane >> 3) + 8 * j; const LAS float* s = scr + (8 * c) * 33 + n;
        u32x4 o; o.x = pk2(s[0 * 33], s[1 * 33]); o.y = pk2(s[2 * 33], s[3 * 33]); o.z = pk2(s[4 * 33], s[5 * 33]); o.w = pk2(s[6 * 33], s[7 * 33]);
        *(u32x4*)(p.dst + (size_t)n * p.K + 8 * c) = o; }
    asm volatile("s_waitcnt lgkmcnt(0)" ::: "memory");
}
constexpr int P0_EARLY_ITEMS = 32 * 192 + 32 * 64, P0_ALL_ITEMS = 32 * 192 + 32 * 64 + 2 * 32 * 176 + 88 * 64, P0_CHUNK = 32, P0_LATE_CHUNKS = (P0_ALL_ITEMS - P0_EARLY_ITEMS) / P0_CHUNK;
static_assert((P0_ALL_ITEMS - P0_EARLY_ITEMS) % P0_CHUNK == 0, "late conversion items come in whole chunks");
__device__ __forceinline__ void p0_run_range(const Args& a, LAS float* scr, int first, int n, int lane) {
    f32x4 va[8], vb[8]; P0Item pa, pb;
    pa = p0_decode(a, first); p0_load(pa, va, lane);
    for (int i = 0; i < n; i += 2) {
        if (i + 1 < n) { pb = p0_decode(a, first + i + 1); p0_load(pb, vb, lane); }
        p0_finish(pa, va, scr, lane);
        if (i + 1 >= n) break;
        if (i + 2 < n) { pa = p0_decode(a, first + i + 2); p0_load(pa, va, lane); }
        p0_finish(pb, vb, scr, lane);
    }
}
__device__ __forceinline__ void p0_prologue(const Args& a, LAS unsigned char* lds, int gw, int NGW, int lane, int wave) {
    LAS float* scr = (LAS float*)(lds + wave * 16384);
    unsigned char* ws = a.ws;
    constexpr int NITEMS = P0_EARLY_ITEMS;
    {
        int it = gw; f32x4 va[8], vb[8]; P0Item pa, pb;
        if (it < NITEMS) { pa = p0_decode(a, it); p0_load(pa, va, lane); }
        while (it < NITEMS) {
            const int itb = it + NGW;
            if (itb < NITEMS) { pb = p0_decode(a, itb); p0_load(pb, vb, lane); }
            p0_finish(pa, va, scr, lane);
            it = itb + NGW;
            if (itb >= NITEMS) break;
            if (it < NITEMS) { pa = p0_decode(a, it); p0_load(pa, va, lane); }
            p0_finish(pb, vb, scr, lane);
        }
    }
    const float* g1 = a.in[5];
    f32x4 gv[8];
#pragma unroll
    for (int j = 0; j < 8; ++j) gv[j] = *((const f32x4*)g1 + 64 * j + lane);
    for (int m = gw; m < MT; m += 2 * NGW) {
        const int m2 = m + NGW; const bool has2 = m2 < MT;
        const float* xa = m < NP ? a.in[0] + (size_t)m * DM : a.in[1] + (size_t)(m - NP) * DM;
        const float* xb = has2 ? (m2 < NP ? a.in[0] + (size_t)m2 * DM : a.in[1] + (size_t)(m2 - NP) * DM) : xa;
        f32x4 va[8], vb[8];
#pragma unroll
        for (int j = 0; j < 8; ++j) va[j] = __builtin_nontemporal_load((const f32x4*)xa + 64 * j + lane);
        if (has2) {
#pragma unroll
            for (int j = 0; j < 8; ++j) vb[j] = __builtin_nontemporal_load((const f32x4*)xb + 64 * j + lane);
        }
        {
            float s = 0.f;
#pragma unroll
            for (int j = 0; j < 8; ++j) s += (va[j][0] * va[j][0] + va[j][1] * va[j][1]) + (va[j][2] * va[j][2] + va[j][3] * va[j][3]);
            const float rs = __builtin_amdgcn_rsqf(wave_sum(s) * (1.0f / DM) + EPS);
            u32x2* o = (u32x2*)((bf16*)(ws + WS_HN) + (size_t)m * DM) + lane;
#pragma unroll
            for (int j = 0; j < 8; ++j) { u32x2 w; w.x = pk2(va[j][0] * rs * gv[j][0], va[j][1] * rs * gv[j][1]); w.y = pk2(va[j][2] * rs * gv[j][2], va[j][3] * rs * gv[j][3]); o[64 * j] = w; }
        }
        if (has2) {
            float s = 0.f;
#pragma unroll
            for (int j = 0; j < 8; ++j) s += (vb[j][0] * vb[j][0] + vb[j][1] * vb[j][1]) + (vb[j][2] * vb[j][2] + vb[j][3] * vb[j][3]);
            const float rs = __builtin_amdgcn_rsqf(wave_sum(s) * (1.0f / DM) + EPS);
            u32x2* o = (u32x2*)((bf16*)(ws + WS_HN) + (size_t)m2 * DM) + lane;
#pragma unroll
            for (int j = 0; j < 8; ++j) { u32x2 w; w.x = pk2(vb[j][0] * rs * gv[j][0], vb[j][1] * rs * gv[j][1]); w.y = pk2(vb[j][2] * rs * gv[j][2], vb[j][3] * rs * gv[j][3]); o[64 * j] = w; }
        }
    }
}


template <int VS, bool QREG>
__device__ __forceinline__ void sb_block(f32x16 (&o)[4], float& R, const LAS unsigned char* kp, const LAS unsigned char* vp, const bf16x8 (&qreg)[8], const LAS unsigned char* qlp, int kb, int qw, int qpos, int hi) {
            f32x16 p;
#pragma unroll
            for (int r = 0; r < 16; ++r) p[r] = 0.f;
#pragma unroll
            for (int d0 = 0; d0 < 8; ++d0) { const bf16x8 kf = *(const LAS bf16x8*)(kp + d0 * 32); const bf16x8 qf = QREG ? qreg[d0] : *(const LAS bf16x8*)(qlp + d0 * 32); p = __builtin_amdgcn_mfma_f32_32x32x16_bf16(kf, qf, p, 0, 0, 0); }
            const bool need_mask = (kb + 31 >= qw);
            float e[16], sf[16];
#pragma unroll
            for (int r = 0; r < 16; ++r) {
                const float z = fminf(p[r], 100.f); float ee = __builtin_amdgcn_exp2f(z); float rr = __builtin_amdgcn_rcpf(1.0f + ee);
                if (need_mask) { const bool msk = (kb + crow(r, hi)) >= qpos; ee = msk ? 0.f : ee; rr = msk ? 1.f : rr; }
                e[r] = ee; sf[r] = rr;
            }
            float oth[4], PP[4];
#pragma unroll
            for (int g = 0; g < 4; ++g) { sf[4 * g + 2] *= sf[4 * g + 3]; sf[4 * g + 1] *= sf[4 * g + 2]; sf[4 * g] *= sf[4 * g + 1]; oth[g] = __shfl_xor(sf[4 * g], 32); PP[g] = sf[4 * g] * oth[g]; }
            const float SP3 = PP[3], SP2 = PP[2] * SP3, SP1 = PP[1] * SP2, SP0 = PP[0] * SP1;
            float A[4]; A[0] = R * SP1; A[1] = R * SP2; A[2] = R * SP3; A[3] = R;
#pragma unroll
            for (int g = 0; g < 4; ++g) A[g] = hi ? A[g] : A[g] * oth[g];
            R *= SP0;
            float w[16];
#pragma unroll
            for (int r = 0; r < 16; ++r) w[r] = (e[r] * sf[r]) * A[r >> 2];
#pragma unroll
            for (int s2 = 0; s2 < 2; ++s2) {
                u32x4 pw; pw.x = pk2(w[8 * s2 + 0], w[8 * s2 + 1]); pw.y = pk2(w[8 * s2 + 2], w[8 * s2 + 3]); pw.z = pk2(w[8 * s2 + 4], w[8 * s2 + 5]); pw.w = pk2(w[8 * s2 + 6], w[8 * s2 + 7]);
                const bf16x8 pa = __builtin_bit_cast(bf16x8, pw);
#pragma unroll
                for (int db = 0; db < 4; ++db) {
                    const s16x4 lo = __builtin_bit_cast(s16x4, __builtin_amdgcn_ds_read_tr16_b64_v4i16((LAS s16x4*)(vp + (16 * s2) * VS + db * 64)));
                    const s16x4 hh = __builtin_bit_cast(s16x4, __builtin_amdgcn_ds_read_tr16_b64_v4i16((LAS s16x4*)(vp + (16 * s2 + 8) * VS + db * 64)));
                    const bf16x8 vb = __builtin_shufflevector(lo, hh, 0, 1, 2, 3, 4, 5, 6, 7);
                    o[db] = __builtin_amdgcn_mfma_f32_32x32x16_bf16(pa, vb, o[db], 0, 0, 0);
                }
            }
}

template <bool SAMPLE>
__device__ __forceinline__ void attn_item(const Args& a, LAS unsigned char* lds, int code) {
    constexpr int NH = SAMPLE ? 4 : 1, KS = NH * 256 + 16, VS = NH * 256 + 32, K_OFF = 0, V_OFF = 32 * KS;
    int tid_ = threadIdx.x; asm volatile("" : "+v"(tid_));
    const int tid = tid_, lane = tid & 63, r32 = lane & 31, hi = lane >> 5; const int wid = __builtin_amdgcn_readfirstlane(tid >> 6);
    unsigned char* ws = a.ws;
    int slot, nsteps, kvpos0, qw, head, hl; size_t qrow;
    const bf16 *kgb = nullptr, *vgb = nullptr; const float *kgf = nullptr, *vgf = nullptr, *kgn = nullptr, *vgn = nullptr;
    if (SAMPLE) {
        const int b = (code >> 1) & 7, hg = (code >> 4) & 1;
        slot = 256 + b * 2 + hg; hl = wid >> 1; head = hg * 4 + hl; const int rg = wid & 1;
        qw = PAST + 32 * rg; qrow = (size_t)NP + b * DSEQ + 32 * rg + r32;
        nsteps = 130; kvpos0 = 0;
        kgf = a.in[2] + ((size_t)b * PAST + (tid >> 7)) * AW + hg * 512 + 4 * (tid & 127); vgf = a.in[3] + ((size_t)b * PAST + (tid >> 7)) * AW + hg * 512 + 4 * (tid & 127);
        kgn = a.out + OFF_KS + ((size_t)b * DSEQ + (tid >> 7)) * AW + hg * 512 + 4 * (tid & 127); vgn = a.out + OFF_VS + ((size_t)b * DSEQ + (tid >> 7)) * AW + hg * 512 + 4 * (tid & 127);
    } else {
        const int bh = (code >> 1) & 15, qb = (code >> 5) & 15, c = (code >> 9) & 3, b = bh >> 3;
        head = bh & 7; hl = 0; slot = bh * 16 + qb + 0 * c; nsteps = p_nsteps(qb, c); kvpos0 = 0;
        qw = qb * 256 + 32 * wid; qrow = (size_t)b * SEQ + qw + r32;
        kgb = (const bf16*)(ws + WS_K) + ((size_t)b * SEQ + kvpos0 + (tid >> 4)) * AW + head * 128 + (tid & 15) * 8;
        vgb = (const bf16*)(ws + WS_V) + ((size_t)b * SEQ + kvpos0 + (tid >> 4)) * AW + head * 128 + (tid & 15) * 8;
    }
    const int qpos = qw + r32;
    constexpr int Q_OFF = 67584, QS = 272;
    const LAS unsigned char* qlp = lds + Q_OFF + wid * (32 * QS) + r32 * QS + hi * 16;
    { const bf16* qp = (const bf16*)(ws + WS_Q) + qrow * AW + head * 128 + hi * 8;
#pragma unroll
      for (int d0 = 0; d0 < 8; ++d0) *(LAS bf16x8*)(lds + Q_OFF + wid * (32 * QS) + r32 * QS + hi * 16 + d0 * 32) = *(const bf16x8*)(qp + 16 * d0); }
    f32x16 o[4];
#pragma unroll
    for (int i = 0; i < 4; ++i)
#pragma unroll
        for (int r = 0; r < 16; ++r) o[i][r] = 0.f;
    float R = 1.f;
    u32x4 kreg, vreg; f32x4 kf4[8], vf4[8];
#define ATT_LOADK(s_) do { if (SAMPLE) { _Pragma("unroll") for (int i_ = 0; i_ < 8; ++i_) kf4[i_] = *(const f32x4*)(((s_) >= 128 ? kgn + (size_t)((s_) - 128) * 32 * AW : kgf + (size_t)(s_) * 32 * AW) + (size_t)i_ * 4 * AW); } \
        else { kreg = *(const u32x4*)(kgb + (size_t)(s_) * 32 * AW); } } while (0)
#define ATT_LOADV(s_) do { if (SAMPLE) { _Pragma("unroll") for (int i_ = 0; i_ < 8; ++i_) vf4[i_] = *(const f32x4*)(((s_) >= 128 ? vgn + (size_t)((s_) - 128) * 32 * AW : vgf + (size_t)(s_) * 32 * AW) + (size_t)i_ * 4 * AW); } \
        else { vreg = *(const u32x4*)(vgb + (size_t)(s_) * 32 * AW); } } while (0)
#define ATT_STOREK() do { if (SAMPLE) { _Pragma("unroll") for (int i_ = 0; i_ < 8; ++i_) { const int key_ = (tid >> 7) + 4 * i_, f4_ = tid & 127; \
            u32x2 kw_; kw_.x = pk2(kf4[i_][0], kf4[i_][1]); kw_.y = pk2(kf4[i_][2], kf4[i_][3]); *(LAS u32x2*)(lds + K_OFF + key_ * KS + f4_ * 8) = kw_; } } \
        else { *(LAS u32x4*)(lds + K_OFF + (tid >> 4) * KS + (tid & 15) * 16) = kreg; } } while (0)
#define ATT_STOREV() do { if (SAMPLE) { _Pragma("unroll") for (int i_ = 0; i_ < 8; ++i_) { const int key_ = (tid >> 7) + 4 * i_, f4_ = tid & 127; \
            u32x2 vw_; vw_.x = pk2(vf4[i_][0], vf4[i_][1]); vw_.y = pk2(vf4[i_][2], vf4[i_][3]); *(LAS u32x2*)(lds + V_OFF + key_ * VS + f4_ * 8) = vw_; } } \
        else { *(LAS u32x4*)(lds + V_OFF + (tid >> 4) * VS + (tid & 15) * 16) = vreg; } } while (0)
    volatile LAS int* flg = (volatile LAS int*)(lds + MISC_OFF + 64);
    ATT_LOADK(nsteps - 1); ATT_LOADV(nsteps - 1);
    ATT_STOREK(); ATT_STOREV();
    __syncthreads();
    const LAS unsigned char* kp = lds + K_OFF + r32 * KS + hl * 256 + hi * 16;
    const LAS unsigned char* vp = lds + V_OFF + (4 * hi + ((lane & 15) >> 2)) * VS + hl * 256 + (16 * ((lane >> 4) & 1) + 4 * (lane & 3)) * 2;
    for (int s = nsteps - 1; s >= 0; --s) {
        if (s > 0) { ATT_LOADK(s - 1); if (!SAMPLE) ATT_LOADV(s - 1); }
        const int kb = kvpos0 + 32 * s;
        if (kb < qw + 32 && !__all(R == 0.f)) { const bf16x8 qdummy[8] = {}; sb_block<VS, false>(o, R, kp, vp, qdummy, qlp, kb, qw, qpos, hi); }
        if (lane == 0) flg[wid] = __all(R == 0.f) ? 1 : 0;
        __syncthreads();
        const bool alldone = (flg[0] & flg[1] & flg[2] & flg[3] & flg[4] & flg[5] & flg[6] & flg[7]) != 0;
        if (alldone) { __syncthreads(); break; }
        if (s > 0) { ATT_STOREK(); if (SAMPLE) ATT_LOADV(s - 1); ATT_STOREV(); }
        __syncthreads();
    }
#undef ATT_LOADK
#undef ATT_LOADV
#undef ATT_STOREK
#undef ATT_STOREV
    bf16* op = (bf16*)(ws + WS_OP) + ((size_t)(slot * 8 + wid) * 32) * 128;
#pragma unroll
    for (int db = 0; db < 4; ++db)
#pragma unroll
        for (int r = 0; r < 16; ++r) op[crow(r, hi) * 128 + db * 32 + r32] = (bf16)f2bf(o[db][r]);
    if (hi == 0) ((float*)(ws + WS_TP))[(slot * 8 + wid) * 32 + r32] = R;
}


__device__ __forceinline__ void attn_item_p(const Args& a, LAS unsigned char* lds, int code) {
    constexpr int KS = 272, VS = 288, TILE_K = 64 * KS, BUF = TILE_K + 64 * VS;
    int tid_ = threadIdx.x; asm volatile("" : "+v"(tid_));
    const int tid = tid_, lane = tid & 63, r32 = lane & 31, hi = lane >> 5; const int wid = __builtin_amdgcn_readfirstlane(tid >> 6);
    unsigned char* ws = a.ws;
    const int bh = (code >> 1) & 15, qb = (code >> 5) & 15, c = (code >> 9) & 3, b = bh >> 3, head = bh & 7;
    const int slot = bh * 16 + qb + 0 * c, nst = p_nsteps(qb, c) >> 1, kvpos0 = 0;
    const int qw = qb * 256 + 32 * wid, qpos = qw + r32; const size_t qrow = (size_t)b * SEQ + qpos;
    const bf16* kgb = (const bf16*)(ws + WS_K) + ((size_t)b * SEQ + kvpos0 + (tid >> 4)) * AW + head * 128 + (tid & 15) * 8;
    const bf16* vgb = (const bf16*)(ws + WS_V) + ((size_t)b * SEQ + kvpos0 + (tid >> 4)) * AW + head * 128 + (tid & 15) * 8;
    bf16x8 qf[8];
    { const bf16* qp = (const bf16*)(ws + WS_Q) + qrow * AW + head * 128 + hi * 8;
#pragma unroll
      for (int d0 = 0; d0 < 8; ++d0) qf[d0] = *(const bf16x8*)(qp + 16 * d0); }
    f32x16 o[4];
#pragma unroll
    for (int i = 0; i < 4; ++i)
#pragma unroll
        for (int r = 0; r < 16; ++r) o[i][r] = 0.f;
    float R = 1.f;
    u32x4 kreg[2], vreg[2];
#define PLOAD(s_) do { _Pragma("unroll") for (int i_ = 0; i_ < 2; ++i_) { kreg[i_] = *(const u32x4*)(kgb + (size_t)((s_) * 64 + 32 * i_) * AW); vreg[i_] = *(const u32x4*)(vgb + (size_t)((s_) * 64 + 32 * i_) * AW); } } while (0)
#define PSTORE(buf_) do { _Pragma("unroll") for (int i_ = 0; i_ < 2; ++i_) { *(LAS u32x4*)(lds + (buf_) * BUF + ((tid >> 4) + 32 * i_) * KS + (tid & 15) * 16) = kreg[i_]; \
        *(LAS u32x4*)(lds + (buf_) * BUF + TILE_K + ((tid >> 4) + 32 * i_) * VS + (tid & 15) * 16) = vreg[i_]; } } while (0)
    volatile LAS int* flg = (volatile LAS int*)(lds + MISC_OFF + 64);
    PLOAD(nst - 1);
    PSTORE(0);
    __syncthreads();
    const LAS unsigned char* kp = lds + r32 * KS + hi * 16;
    const LAS unsigned char* vp = lds + TILE_K + (4 * hi + ((lane & 15) >> 2)) * VS + (16 * ((lane >> 4) & 1) + 4 * (lane & 3)) * 2;
    int cur = 0;
    for (int s = nst - 1; s >= 0; --s) {
        if (s > 0) PLOAD(s - 1);
#pragma unroll
        for (int blk = 1; blk >= 0; --blk) {
            const int kb = kvpos0 + 64 * s + 32 * blk;
            if (kb < qw + 32 && !__all(R == 0.f)) sb_block<VS, true>(o, R, kp + cur * BUF + blk * 32 * KS, vp + cur * BUF + blk * 32 * VS, qf, kp, kb, qw, qpos, hi);
        }
        volatile LAS int* fl = flg + 8 * (s & 1);
        if (lane == 0) fl[wid] = __all(R == 0.f) ? 1 : 0;
        if (s > 0) PSTORE(cur ^ 1);
        __syncthreads();
        if ((fl[0] & fl[1] & fl[2] & fl[3] & fl[4] & fl[5] & fl[6] & fl[7]) != 0) break;
        cur ^= 1;
    }
#undef PLOAD
#undef PSTORE
    bf16* op = (bf16*)(ws + WS_OP) + ((size_t)(slot * 8 + wid) * 32) * 128;
#pragma unroll
    for (int db = 0; db < 4; ++db)
#pragma unroll
        for (int r = 0; r < 16; ++r) op[crow(r, hi) * 128 + db * 32 + r32] = (bf16)f2bf(o[db][r]);
    if (hi == 0) ((float*)(ws + WS_TP))[(slot * 8 + wid) * 32 + r32] = R;
}

struct MixRow { int m, t; const float* st; u32x4 opb[2]; u32x4 u2[2], u1[2], u0[2], gb[2]; };
__device__ __forceinline__ void mix_load(const Args& a, MixRow& R, int m, int lane) {
    unsigned char* ws = a.ws;
    const float* OP = (const float*)(ws + WS_OP); const bf16* U = (const bf16*)(ws + WS_U); const bf16* GB = (const bf16*)(ws + WS_GB);
    const int h = lane >> 3, d0 = (lane & 7) * 16, c0 = lane * 16;
    int slot0, wid, q;
    if (m < NP) { const int b = m >> 12, t = m & 4095, qb = t >> 8; wid = (t & 255) >> 5; q = t & 31; slot0 = (b * 8 + h) * 16 + qb; R.t = t; R.st = nullptr; }
    else { const int r = m - NP, b = r >> 6, t = r & 63, rg = t >> 5; q = t & 31; wid = (h & 3) * 2 + rg; slot0 = 256 + b * 2 + (h >> 2); R.t = t; R.st = a.in[4] + (size_t)b * 2 * CC; }
    R.m = m;
    { const u32x4* p = (const u32x4*)((const bf16*)OP + ((size_t)(slot0 * 8 + wid) * 32 + q) * 128 + d0); R.opb[0] = p[0]; R.opb[1] = p[1]; }
    { const u32x4* pu = (const u32x4*)(U + (size_t)m * CC + c0); R.u2[0] = pu[0]; R.u2[1] = pu[1]; }
    if (R.t >= 1) { const u32x4* pu = (const u32x4*)(U + (size_t)(m - 1) * CC + c0); R.u1[0] = pu[0]; R.u1[1] = pu[1]; }
    if (R.t >= 2) { const u32x4* pu = (const u32x4*)(U + (size_t)(m - 2) * CC + c0); R.u0[0] = pu[0]; R.u0[1] = pu[1]; }
    { const u32x4* pg = (const u32x4*)(GB + (size_t)m * CC + c0); R.gb[0] = pg[0]; R.gb[1] = pg[1]; }
}
__device__ __forceinline__ void unpack16(const u32x4 (&x)[2], float (&o)[16]) {
    const unsigned ww[8] = {x[0].x, x[0].y, x[0].z, x[0].w, x[1].x, x[1].y, x[1].z, x[1].w};
#pragma unroll
    for (int i = 0; i < 8; ++i) { o[2 * i] = bflo(ww[i]); o[2 * i + 1] = bfhi(ww[i]); }
}
__device__ __forceinline__ void mix_finish(const Args& a, const MixRow& R, const float (&ga16)[16], const float (&gc16)[16], const float (&w0c)[16], const float (&w1c)[16], const float (&w2c)[16], int lane) {
    bf16* MIX = (bf16*)(a.ws + WS_MIX);
    const int h = lane >> 3, d0 = (lane & 7) * 16, c0 = lane * 16, m = R.m;
    float oa[16]; unpack16(R.opb, oa);
    float s = 0.f;
#pragma unroll
    for (int i = 0; i < 16; ++i) s += oa[i] * oa[i];
    float rs = __builtin_amdgcn_rsqf(wave_sum(s) * (1.0f / AW) + EPS);
    { unsigned ww[8];
#pragma unroll
      for (int i = 0; i < 8; ++i) ww[i] = pk2(oa[2 * i] * rs * ga16[2 * i], oa[2 * i + 1] * rs * ga16[2 * i + 1]);
      u32x4 w0, w1; w0.x = ww[0]; w0.y = ww[1]; w0.z = ww[2]; w0.w = ww[3]; w1.x = ww[4]; w1.y = ww[5]; w1.z = ww[6]; w1.w = ww[7];
      u32x4* o = (u32x4*)(MIX + (size_t)m * DM + h * 128 + d0); o[0] = w0; o[1] = w1; }
    float u0[16], u1[16], u2[16], gbv[16];
    unpack16(R.u2, u2); unpack16(R.gb, gbv);
    if (R.t >= 1) unpack16(R.u1, u1); else {
#pragma unroll
        for (int i = 0; i < 16; ++i) u1[i] = R.st ? R.st[CC + c0 + i] : 0.f; }
    if (R.t >= 2) unpack16(R.u0, u0); else {
#pragma unroll
        for (int i = 0; i < 16; ++i) u0[i] = R.st ? R.st[(R.t == 0 ? 0 : CC) + c0 + i] : 0.f; }
    float oc[16]; float s2 = 0.f;
#pragma unroll
    for (int i = 0; i < 16; ++i) { oc[i] = gbv[i] * (w0c[i] * u0[i] + w1c[i] * u1[i] + w2c[i] * u2[i]); s2 += oc[i] * oc[i]; }
    rs = __builtin_amdgcn_rsqf(wave_sum(s2) * (1.0f / CC) + EPS);
    { unsigned ww[8];
#pragma unroll
      for (int i = 0; i < 8; ++i) ww[i] = pk2(oc[2 * i] * rs * gc16[2 * i], oc[2 * i + 1] * rs * gc16[2 * i + 1]);
      u32x4 w0, w1; w0.x = ww[0]; w0.y = ww[1]; w0.z = ww[2]; w0.w = ww[3]; w1.x = ww[4]; w1.y = ww[5]; w1.z = ww[6]; w1.w = ww[7];
      u32x4* o = (u32x4*)(MIX + (size_t)m * DM + AW + c0); o[0] = w0; o[1] = w1; }
}
__device__ __forceinline__ void mix_rows(const Args& a, int gw, int NGW, int lane) {
    const float* cw = a.in[9]; const float* ga = a.in[10]; const float* gc = a.in[11];
    const int h = lane >> 3, d0 = (lane & 7) * 16, c0 = lane * 16;
    float ga16[16], gc16[16], w0c[16], w1c[16], w2c[16];
#pragma unroll
    for (int i = 0; i < 4; ++i) {
        const f32x4 x0 = *(const f32x4*)(ga + h * 128 + d0 + 4 * i), x1 = *(const f32x4*)(gc + c0 + 4 * i), x2 = *(const f32x4*)(cw + c0 + 4 * i), x3 = *(const f32x4*)(cw + CC + c0 + 4 * i), x4 = *(const f32x4*)(cw + 2 * CC + c0 + 4 * i);
#pragma unroll
        for (int j = 0; j < 4; ++j) { ga16[4 * i + j] = x0[j]; gc16[4 * i + j] = x1[j]; w0c[4 * i + j] = x2[j]; w1c[4 * i + j] = x3[j]; w2c[4 * i + j] = x4[j]; }
    }
    for (int m = gw; m < MT; m += 2 * NGW) {
        MixRow A, B; const bool hasB = m + NGW < MT;
        mix_load(a, A, m, lane);
        if (hasB) mix_load(a, B, m + NGW, lane);
        mix_finish(a, A, ga16, gc16, w0c, w1c, w2c, lane);
        if (hasB) mix_finish(a, B, ga16, gc16, w0c, w1c, w2c, lane);
    }
}
#ifndef NCONV
#define NCONV 96
#endif
#ifndef REP_P0
#define REP_P0 1
#endif
#ifndef REP_P1
#define REP_P1 1
#endif
#ifndef REP_P3
#define REP_P3 1
#endif
#ifndef REP_P4
#define REP_P4 1
#endif
#ifndef REP_P5
#define REP_P5 1
#endif
__global__ void __launch_bounds__(NWAVES * 64, 2) fwd_megakernel(Args args) {
    extern __shared__ __attribute__((aligned(16))) unsigned char lds_raw[];
    cg::grid_group grid = cg::this_grid();
    LAS unsigned char* lds = (LAS unsigned char*)lds_raw;
    const int G = gridDim.x, bx = blockIdx.x, NGW = G * NWAVES;
#define PHASE_IDS() int tid = threadIdx.x; asm volatile("" : "+v"(tid)); const int lane = tid & 63; const int wave = __builtin_amdgcn_readfirstlane(tid >> 6); const int gw = bx * NWAVES + wave; (void)lane; (void)gw
    unsigned char* ws = args.ws;
    unsigned* ctl = (unsigned*)(ws + WS_CTL);
    LAS float* red = (LAS float*)(lds + RED_OFF);
    volatile LAS int* misc = (volatile LAS int*)(lds + MISC_OFF);

    { PHASE_IDS(); if (bx == 0 && tid == 0) { ctl[0] = 0u; ctl[64] = 0u; ctl[256] = 0u; }
      if (bx == 0) for (int i = tid; i < XCD_BAR_WORDS; i += NWAVES * 64) ctl[4096 + i] = 0u;
      if (tid < 2) misc[8 + tid] = 0;
#ifndef NO_P0
    for (int rep_ = 0; rep_ < REP_P0; ++rep_) p0_prologue(args, lds, gw, NGW, lane, wave);
#endif
    }
    grid.sync();
    XcdBarrier xbar = xcd_barrier_post(ctl + 4096, (volatile LAS unsigned*)(lds + MISC_OFF) + 8);

#ifndef NO_P1
    for (int rep_ = 0; rep_ < REP_P1; ++rep_) {
        pg8::Gemm g{(const pg8::bf16_t*)(ws + WS_HN), (const pg8::bf16_t*)(ws + WS_WIN), MT, INC, DM}; typedef pg8::InProjOrder Ord; Ord S; S.init(G, bx);
        pg8::EpiIn E{(bf16*)(ws + WS_Q), (bf16*)(ws + WS_K), (bf16*)(ws + WS_V), (bf16*)(ws + WS_GB), (bf16*)(ws + WS_U), args.out, args.in[7], args.in[8], red,
                     1.4426950408889634f * 0.08838834764831845f, OFF_KP, OFF_VP, OFF_CP, OFF_KS, OFF_VS, OFF_CS};
        pg8::gemm_phase<pg8::EpiIn, Ord, true, true>(lds, g, S, E);
    }
#endif
    xcd_barrier(xbar);

#ifndef NO_P2
    {
        const int nitems = g_items.n;
        PHASE_IDS();
#ifdef DUP_P2
        for (int rep = 0; rep < 2; ++rep)
#else
        const int rep = 0;
#endif
        for (;;) {
            if (tid == 0) misc[0] = (int)atomicAdd(ctl + 64 * rep, 1u);
            __syncthreads();
            int it = misc[0];
            __syncthreads();
            if (it < 48) {
                pg8::Gemm g{(const pg8::bf16_t*)(ws + WS_HN), (const pg8::bf16_t*)(ws + WS_WIN), MT, INC, DM};
                pg8::OneUnit S1; S1.u0.pm = 30 + (it & 3); S1.u0.pn = 12 + (it >> 2); S1.u0.k0 = 0; S1.u0.nt = 32; S1.u0.split = 0; S1.u0.tu = 0; S1.u0.sp = 0;
                pg8::EpiIn E{(bf16*)(ws + WS_Q), (bf16*)(ws + WS_K), (bf16*)(ws + WS_V), (bf16*)(ws + WS_GB), (bf16*)(ws + WS_U), args.out, args.in[7], args.in[8], red,
                             1.4426950408889634f * 0.08838834764831845f, OFF_KP, OFF_VP, OFF_CP, OFF_KS, OFF_VS, OFF_CS};
                pg8::gemm_phase<pg8::EpiIn, pg8::OneUnit, true, true>(lds, g, S1, E);
                __syncthreads();
                continue;
            }
            it -= 48;
            const bool token = it >= 16 && it < 16 + NCONV;
            if (token || it >= nitems + NCONV) {
                for (;;) {
                    if (tid == 0) misc[0] = (int)atomicAdd(ctl + 256, 1u);
                    __syncthreads();
                    const int ch = misc[0];
                    __syncthreads();
                    if (ch >= P0_LATE_CHUNKS) break;
                    p0_run_range(args, (LAS float*)(lds + wave * 16384), P0_EARLY_ITEMS + ch * P0_CHUNK + wave * (P0_CHUNK / NWAVES), P0_CHUNK / NWAVES, lane);
                }
                if (token) continue;
                break;
            }
            if (it >= 16) it -= NCONV;
            const int code = g_items.v[it];
#if defined(ONLY_S)
            attn_item<true>(args, lds, code);
#elif defined(ONLY_P)
            attn_item_p(args, lds, code);
#else
            if (code & 1) attn_item<true>(args, lds, code); else attn_item_p(args, lds, code);
#endif
        }
    }
#endif
    xcd_barrier(xbar);

#ifndef NO_P3
    for (int rep_ = 0; rep_ < REP_P3; ++rep_) { PHASE_IDS(); mix_rows(args, gw, NGW, lane); }
#endif
    xcd_barrier(xbar);

#ifndef NO_P4
    for (int rep_ = 0; rep_ < REP_P4; ++rep_) {
        pg8::Gemm g{(const pg8::bf16_t*)(ws + WS_MIX), (const pg8::bf16_t*)(ws + WS_WOUT), MT, DM, DM}; typedef pg8::TailOrderT<MT / 256, DM / 256, DM / 64, 8> Ord; Ord S; S.init(G, bx);
        pg8::EpiOut E{args.in[0], args.in[1], args.out + OFF_Y, (bf16*)(ws + WS_HN), (float*)(ws + WS_SSQ), red, (float*)(ws + WS_PART)};
        pg8::gemm_phase<pg8::EpiOut, Ord, true, true>(lds, g, S, E);
        if (S.rem > 0) {
            xcd_barrier(xbar);
            PHASE_IDS();
            for (int w = gw; w < S.rem * 256; w += NGW) {
                const int tu = w >> 8, r = w & 255; pg8::Unit u; Ord::SO::unit(S.full * G + tu, u);
                const size_t row = (size_t)u.pm * 256 + r; const int col = u.pn * 256 + 4 * lane;
                const float* xin = row < NP ? args.in[0] + row * DM : args.in[1] + (row - NP) * DM;
                f32x4 v = *(const f32x4*)(xin + col);
                const bf16* p = (const bf16*)(ws + WS_PART) + (size_t)(tu * 8) * 65536 + r * 256 + 4 * lane;
                u32x2 sl[8];
#pragma unroll
                for (int s = 0; s < 8; ++s) sl[s] = *(const u32x2*)(p + (size_t)s * 65536);
#pragma unroll
                for (int s = 0; s < 8; ++s) { v[0] += bflo(sl[s].x); v[1] += bfhi(sl[s].x); v[2] += bflo(sl[s].y); v[3] += bfhi(sl[s].y); }
                *(f32x4*)(args.out + OFF_Y + row * DM + col) = v;
                u32x2 pk; pk.x = pk2(v[0], v[1]); pk.y = pk2(v[2], v[3]); *(u32x2*)((bf16*)(ws + WS_HN) + row * DM + col) = pk;
                const float ss = wave_sum((v[0] * v[0] + v[1] * v[1]) + (v[2] * v[2] + v[3] * v[3]));
                if (lane == 0) ((float*)(ws + WS_SSQ))[row * 8 + u.pn] = ss;
            }
        }
    }
#endif
    xcd_barrier(xbar);

#ifndef NO_P5
    for (int rep_ = 0; rep_ < REP_P5; ++rep_) {
        pg8::Gemm g{(const pg8::bf16_t*)(ws + WS_HN), (const pg8::bf16_t*)(ws + WS_WGU), MT, 2 * DFF, DM}; typedef pg8::StaticOrderT<MT / 256, 2 * DFF / 256, DM / 64> Ord; Ord S; S.init(G, bx);
        pg8::EpiGU E{(bf16*)(ws + WS_H), (const float*)(ws + WS_SSQ)};
        pg8::gemm_phase<pg8::EpiGU, Ord, true, true>(lds, g, S, E);
    }
#endif
    xcd_barrier(xbar);

#ifndef NO_P6
    {
        pg8::Gemm g{(const pg8::bf16_t*)(ws + WS_H), (const pg8::bf16_t*)(ws + WS_WDN), MT, DM, DFF};
        typedef pg8::TailOrderT<MT / 256, DM / 256, DFF / 64, 8> Ord; Ord S; S.init(G, bx);
        pg8::EpiDown E{args.out + OFF_Y, (float*)(ws + WS_PART), (const pg8::bf16_t*)(ws + WS_HN)};
        pg8::gemm_phase<pg8::EpiDown, Ord, true, true>(lds, g, S, E);
        if (S.rem > 0) {
            xcd_barrier(xbar);
            PHASE_IDS();
            for (int w = gw; w < S.rem * 256; w += NGW) {
                const int tu = w >> 8, r = w & 255; pg8::Unit u; Ord::SO::unit(S.full * G + tu, u);
                float* y = args.out + OFF_Y + ((size_t)u.pm * 256 + r) * DM + u.pn * 256 + 4 * lane;
                f32x4 v = *(const f32x4*)y;
                const bf16* p = (const bf16*)(ws + WS_PART) + (size_t)(tu * 8) * 65536 + r * 256 + 4 * lane;
                u32x2 sl[8];
#pragma unroll
                for (int s = 0; s < 8; ++s) sl[s] = *(const u32x2*)(p + (size_t)s * 65536);
#pragma unroll
                for (int s = 0; s < 8; ++s) { v[0] += bflo(sl[s].x); v[1] += bfhi(sl[s].x); v[2] += bflo(sl[s].y); v[3] += bfhi(sl[s].y); }
                *(f32x4*)y = v;
            }
        }
    }
#endif
}

extern "C" void kernel_launch(void* const* d_in, const int* in_sizes, int n_in, void* d_out, int out_size, void* d_ws, size_t ws_size, hipStream_t stream) {
    static int grid = 0;
    if (grid == 0) {
        if (n_in != 17 || (size_t)out_size != OUT_TOTAL || ws_size < WS_END) { fprintf(stderr, "kernel_launch: unexpected shapes (n_in %d out %d ws %zu need %zu)\n", n_in, out_size, ws_size, (size_t)WS_END); grid = -1; return; }
        int dev = 0, cus = 0, per_cu = 0;
        hipGetDevice(&dev); hipDeviceGetAttribute(&cus, hipDeviceAttributeMultiprocessorCount, dev);
        hipFuncSetAttribute((const void*)fwd_megakernel, hipFuncAttributeMaxDynamicSharedMemorySize, LDS_BYTES);
        hipOccupancyMaxActiveBlocksPerMultiprocessor(&per_cu, (const void*)fwd_megakernel, NWAVES * 64, LDS_BYTES);
        if (per_cu < 1) { fprintf(stderr, "kernel_launch: occupancy query says %d blocks per CU\n", per_cu); per_cu = 1; }
        (void)hipGetLastError();
        grid = cus;
    }
    if (grid < 0) return;
    Args a{};
    for (int i = 0; i < 17; ++i) a.in[i] = (const float*)d_in[i];
    a.out = (float*)d_out; a.ws = (unsigned char*)d_ws;
    void* kargs[] = {&a};
    hipError_t e = hipLaunchCooperativeKernel((const void*)fwd_megakernel, dim3(grid), dim3(NWAVES * 64), kargs, LDS_BYTES, stream);
    if (e != hipSuccess) fprintf(stderr, "cooperative launch failed: %s (grid %d)\n", hipGetErrorString(e), grid);
}
```

```cpp
#include <hip/hip_runtime.h>
#include <hip/hip_cooperative_groups.h>
#include <cstdio>
#include <cstdint>
namespace cg = cooperative_groups;
namespace pg8 {
#define PG8_LAS __attribute__((address_space(3)))
typedef unsigned short bf16_t;
typedef short bf16x8 __attribute__((ext_vector_type(8)));
typedef float f32x4 __attribute__((ext_vector_type(4)));
typedef unsigned u32x4 __attribute__((ext_vector_type(4)));
constexpr int BM = 256, BK = 64, HALF = 128, HTB = HALF * BK * 2  , STAGE_BYTES = 8 * HTB, NXCD = 8, WGM = 6;

__host__ __device__ __forceinline__ int lds_byte(int r, int c) { const int st = (r >> 4) * 2 + (c >> 5), rr = r & 15, cc = c & 31, ob = rr * 64 + cc * 2; return st * 1024 + (ob ^ (((ob >> 9) & 1) << 5)); }
__host__ __device__ __forceinline__ void stage_rc(int b, int& R, int& C) { const int st = b / 1024, sb = b % 1024, swz = sb ^ (((sb >> 9) & 1) << 5); R = (st >> 1) * 16 + swz / 64; C = (st & 1) * 32 + (swz % 64) / 2; }
__host__ __device__ __forceinline__ int perm32(int rho) { const int n = rho >> 4, i = rho & 15; return 8 * (i >> 2) + 4 * n + (i & 3); }

struct Unit { int pm, pn, k0, nt, split, tu, sp; };
struct Gemm { const bf16_t* A; const bf16_t* Bt; int M, N, K; };

template <int NM, int NN, int NTK> struct StaticOrderT {
    static constexpr int nM = NM, nN = NN, nwg = NM * NN, ntk = NTK;
    int G, c;
    __host__ __device__ __forceinline__ void init(int G_, int c_) { G = G_; c = c_; }
    __host__ __device__ __forceinline__ bool next(int i, Unit& u) const { const int L = i * G + c; if (L >= nwg) return false; unit(L, u); return true; }
    __host__ __device__ __forceinline__ static void unit(int L, Unit& u) {
        int wgid = L; { constexpr int q = nwg / NXCD, r = nwg % NXCD; const int xcd = wgid % NXCD, off = wgid / NXCD; wgid = (xcd < r ? xcd * (q + 1) : r * (q + 1) + (xcd - r) * q) + off; }
        constexpr int nig = WGM * nN; const int gid = wgid / nig, fm = gid * WGM, gsz = (nM - fm) < WGM ? (nM - fm) : WGM;
        u.pm = fm + ((wgid % nig) % gsz); u.pn = (wgid % nig) / gsz; u.k0 = 0; u.nt = ntk; u.split = 0; u.tu = 0; u.sp = 0;
    }
    __device__ __forceinline__ void a_ready(const Unit&) const {}
    __device__ __forceinline__ void done(const Unit&) const {}
};
template <int NM, int NN, int NTK, int NSPLIT> struct TailOrderT {
    typedef StaticOrderT<NM, NN, NTK> SO;
    int G, c, full, rem;
    __host__ __device__ __forceinline__ void init(int G_, int c_) { G = G_; c = c_; full = SO::nwg / G; rem = SO::nwg - full * G; if (rem * NSPLIT > G || NTK < 2 * NSPLIT) { full = 1 << 24; rem = 0; } }
    __host__ __device__ __forceinline__ static int kstart(int s) { return s >= NSPLIT ? NTK : ((s * NTK / NSPLIT) & ~1); }
    __host__ __device__ __forceinline__ bool next(int i, Unit& u) const {
        if (i < full) { const int L = i * G + c; if (L >= SO::nwg) return false; SO::unit(L, u); return true; }
        if (i > full || c >= rem * NSPLIT) return false;
        const int tu = c / NSPLIT, sp = c % NSPLIT; SO::unit(full * G + tu, u); u.k0 = kstart(sp); u.nt = kstart(sp + 1) - u.k0; u.split = 1; u.tu = tu; u.sp = sp; return true;
    }
    __device__ __forceinline__ void a_ready(const Unit&) const {}
    __device__ __forceinline__ void done(const Unit&) const {}
};

struct InProjOrder {
    typedef StaticOrderT<30, 24, 32> SO;
    int G, c;
    __host__ __device__ __forceinline__ void init(int G_, int c_) { G = G_; c = c_; }
    __host__ __device__ __forceinline__ bool next(int i, Unit& u) const {
        const int L = i * G + c; if (L >= 768) return false;
        if (L < 720) { SO::unit(L, u); return true; }
        const int j = L - 720; u.pm = 30 + (j & 3); u.pn = j >> 2; u.k0 = 0; u.nt = 32; u.split = 0; u.tu = 0; u.sp = 0; return true;
    }
    __device__ __forceinline__ void a_ready(const Unit&) const {}
    __device__ __forceinline__ void done(const Unit&) const {}
};
struct OneUnit {
    Unit u0;
    __host__ __device__ __forceinline__ bool next(int i, Unit& u) const { if (i != 0) return false; u = u0; return true; }
    __device__ __forceinline__ void a_ready(const Unit&) const {}
    __device__ __forceinline__ void done(const Unit&) const {}
};

__device__ __forceinline__ unsigned cvt_pk_bf16(float lo, float hi) { unsigned r; asm volatile("v_cvt_pk_bf16_f32 %0, %1, %2" : "=v"(r) : "v"(lo), "v"(hi)); return r; }
typedef float f32x2 __attribute__((ext_vector_type(2)));
#define PG8_LBAR() asm volatile("s_waitcnt lgkmcnt(0)\n\ts_barrier" ::: "memory")
constexpr int NPROMPT = 8192;
__device__ __forceinline__ u32x4 pack8(const f32x4 a, const f32x4 b) { u32x4 w; w.x = cvt_pk_bf16(a[0], a[1]); w.y = cvt_pk_bf16(a[2], a[3]); w.z = cvt_pk_bf16(b[0], b[1]); w.w = cvt_pk_bf16(b[2], b[3]); return w; }


__device__ __forceinline__ void store_partial(float* part, int nsplit, const f32x4 (&acc)[2][2][4][2], const Unit& u, int wr, int wc, int fr, int fq) {
    bf16_t* pt = (bf16_t*)part + (size_t)(u.tu * nsplit + u.sp) * 65536; int rl0 = wr * 64 + fr, cw = wc * 32 + 8 * fq; asm volatile("" : "+v"(rl0), "+v"(cw));
#pragma unroll
    for (int ai = 0; ai < 2; ++ai)
#pragma unroll
        for (int m = 0; m < 4; ++m)
#pragma unroll
            for (int bj = 0; bj < 2; ++bj) *(u32x4*)(pt + (ai * HALF + rl0 + m * 16) * 256 + bj * HALF + cw) = pack8(acc[ai][bj][m][0], acc[ai][bj][m][1]);
}

struct EpiIn {
    static constexpr bool PERM = true, AFTER_DRAIN = false;
    bf16_t *Q, *Kb, *Vb, *GB, *U; float* out; const float *gq, *gk; PG8_LAS float* red; float qscale;
    size_t off_kp, off_vp, off_cp, off_ks, off_vs, off_cs;
    __device__ __forceinline__ void operator()(const f32x4 (&acc)[2][2][4][2], const Unit& u, int wr, int wc, int fr, int fq) const {
        int rl0 = wr * 64 + fr, cw = wc * 32 + 8 * fq; asm volatile("" : "+v"(rl0), "+v"(cw));
        const int pn = u.pn, rowt = u.pm * BM;
        const bool prompt = rowt < NPROMPT;
        if (pn < 8) {
            const bool isq = pn < 4;
#pragma unroll
            for (int ai = 0; ai < 2; ++ai)
#pragma unroll
                for (int m = 0; m < 4; ++m)
#pragma unroll
                    for (int bj = 0; bj < 2; ++bj) {
                        const f32x4 a = acc[ai][bj][m][0], b = acc[ai][bj][m][1];
                        float s = (a[0] * a[0] + a[1] * a[1]) + (a[2] * a[2] + a[3] * a[3]) + (b[0] * b[0] + b[1] * b[1]) + (b[2] * b[2] + b[3] * b[3]);
                        s += __shfl_xor(s, 16); s += __shfl_xor(s, 32);
                        if (fq == 0) red[((ai * HALF + rl0 + m * 16) * 2 + bj) * 4 + wc] = s;
                    }
            PG8_LBAR();
            const float* g = isq ? gq : gk;
            const f32x4 g0 = *(const f32x4*)(g + cw), g1 = *(const f32x4*)(g + cw + 4);
#pragma unroll
            for (int ai = 0; ai < 2; ++ai)
#pragma unroll
                for (int m = 0; m < 4; ++m) {
                    const int rl = ai * HALF + rl0 + m * 16; const size_t row = (size_t)(rowt + rl);
#pragma unroll
                    for (int bj = 0; bj < 2; ++bj) {
                        const f32x4 p = *(const PG8_LAS f32x4*)(red + (rl * 2 + bj) * 4);
                        float rs = __builtin_amdgcn_rsqf(((p[0] + p[1]) + (p[2] + p[3])) * (1.0f / 128.0f) + 1e-6f);
                        if (isq) rs *= qscale;
                        const f32x4 v0 = acc[ai][bj][m][0] * rs * g0, v1 = acc[ai][bj][m][1] * rs * g1;
                        if (isq) { *(u32x4*)(Q + row * 1024 + pn * 256 + bj * HALF + cw) = pack8(v0, v1); }
                        else {
                            const int col = (pn - 4) * 256 + bj * HALF + cw;
                            float* o = prompt ? out + off_kp + row * 1024 + col : out + off_ks + (row - NPROMPT) * 1024 + col;
                            *(f32x4*)o = v0; *(f32x4*)(o + 4) = v1;
                            if (prompt) *(u32x4*)(Kb + row * 1024 + col) = pack8(v0, v1);
                        }
                    }
                }
        } else if (pn < 12) {
#pragma unroll
            for (int ai = 0; ai < 2; ++ai)
#pragma unroll
                for (int m = 0; m < 4; ++m) {
                    const size_t row = (size_t)(rowt + ai * HALF + rl0 + m * 16);
#pragma unroll
                    for (int bj = 0; bj < 2; ++bj) {
                        const int col = (pn - 8) * 256 + bj * HALF + cw; const f32x4 v0 = acc[ai][bj][m][0], v1 = acc[ai][bj][m][1];
                        float* o = prompt ? out + off_vp + row * 1024 + col : out + off_vs + (row - NPROMPT) * 1024 + col;
                        *(f32x4*)o = v0; *(f32x4*)(o + 4) = v1;
                        if (prompt) *(u32x4*)(Vb + row * 1024 + col) = pack8(v0, v1);
                    }
                }
        } else if (pn < 16) {
#pragma unroll
            for (int ai = 0; ai < 2; ++ai)
#pragma unroll
                for (int m = 0; m < 4; ++m) {
                    const size_t row = (size_t)(rowt + ai * HALF + rl0 + m * 16);
#pragma unroll
                    for (int bj = 0; bj < 2; ++bj) *(u32x4*)(GB + row * 1024 + (pn - 12) * 256 + bj * HALF + cw) = pack8(acc[ai][bj][m][0], acc[ai][bj][m][1]);
                }
        } else {
#pragma unroll
            for (int ai = 0; ai < 2; ++ai)
#pragma unroll
                for (int m = 0; m < 4; ++m) {
                    const int rowi = rowt + ai * HALF + rl0 + m * 16; const int ch = (pn - 16) * HALF + cw;
                    const f32x4 v0 = acc[ai][0][m][0] * acc[ai][1][m][0], v1 = acc[ai][0][m][1] * acc[ai][1][m][1];
                    *(u32x4*)(U + (size_t)rowi * 1024 + ch) = pack8(v0, v1);
                    if (prompt) { const int t = rowi & 4095; if (t >= 4094) { float* o = out + off_cp + ((rowi >> 12) * 2 + (t - 4094)) * 1024 + ch; *(f32x4*)o = v0; *(f32x4*)(o + 4) = v1; } }
                    else { const int rs_ = rowi - NPROMPT, t = rs_ & 63; if (t >= 62) { float* o = out + off_cs + ((rs_ >> 6) * 2 + (t - 62)) * 1024 + ch; *(f32x4*)o = v0; *(f32x4*)(o + 4) = v1; } }
                }
        }
    }
};

struct EpiOut {
    static constexpr bool PERM = true, AFTER_DRAIN = false;
    const float *xp, *xs; float* Y; bf16_t* X1; float* ssq; PG8_LAS float* red; float* part;
    __device__ __forceinline__ void operator()(const f32x4 (&acc)[2][2][4][2], const Unit& u, int wr, int wc, int fr, int fq) const {
        if (u.split) { store_partial(part, 8, acc, u, wr, wc, fr, fq); return; }
        int rl0 = wr * 64 + fr, cw = wc * 32 + 8 * fq; asm volatile("" : "+v"(rl0), "+v"(cw));
        const int pn = u.pn, rowt = u.pm * BM;
        const float* xin = rowt < NPROMPT ? xp + (size_t)rowt * 2048 : xs + (size_t)(rowt - NPROMPT) * 2048;
#pragma unroll
        for (int ai = 0; ai < 2; ++ai) {
            f32x4 xv[4][2][2];
#pragma unroll
            for (int m = 0; m < 4; ++m)
#pragma unroll
                for (int bj = 0; bj < 2; ++bj) { const float* xi = xin + (size_t)(ai * HALF + rl0 + m * 16) * 2048 + pn * 256 + bj * HALF + cw; xv[m][bj][0] = __builtin_nontemporal_load((const f32x4*)xi); xv[m][bj][1] = __builtin_nontemporal_load((const f32x4*)(xi + 4)); }
#pragma unroll
            for (int m = 0; m < 4; ++m) {
                const int rl = ai * HALF + rl0 + m * 16; float s = 0.f;
#pragma unroll
                for (int bj = 0; bj < 2; ++bj) {
                    const int col = pn * 256 + bj * HALF + cw;
                    const f32x4 v0 = xv[m][bj][0] + acc[ai][bj][m][0], v1 = xv[m][bj][1] + acc[ai][bj][m][1];
                    *(u32x4*)(X1 + (size_t)(rowt + rl) * 2048 + col) = pack8(v0, v1);
                    s += (v0[0] * v0[0] + v0[1] * v0[1]) + (v0[2] * v0[2] + v0[3] * v0[3]) + (v1[0] * v1[0] + v1[1] * v1[1]) + (v1[2] * v1[2] + v1[3] * v1[3]);
                }
                s += __shfl_xor(s, 16); s += __shfl_xor(s, 32);
                if (fq == 0) red[rl * 4 + wc] = s;
            }
            asm volatile("" ::: "memory");
        }
        PG8_LBAR();
        if (threadIdx.x < 256) { const f32x4 p = *(const PG8_LAS f32x4*)(red + threadIdx.x * 4); ssq[(size_t)(rowt + threadIdx.x) * 8 + pn] = (p[0] + p[1]) + (p[2] + p[3]); }
        PG8_LBAR();
    }
};

struct EpiGU {
    static constexpr bool PERM = true, AFTER_DRAIN = false;
    bf16_t* H; const float* ssq;
    __device__ __forceinline__ void operator()(const f32x4 (&acc)[2][2][4][2], const Unit& u, int wr, int wc, int fr, int fq) const {
        int rl0 = wr * 64 + fr, cw = wc * 32 + 8 * fq; asm volatile("" : "+v"(rl0), "+v"(cw));
        const int pn = u.pn, rowt = u.pm * BM;
        f32x4 pa[2][4], pb[2][4];
#pragma unroll
        for (int ai = 0; ai < 2; ++ai)
#pragma unroll
            for (int m = 0; m < 4; ++m) { const float* p = ssq + (size_t)(rowt + ai * HALF + rl0 + m * 16) * 8; pa[ai][m] = *(const f32x4*)p; pb[ai][m] = *(const f32x4*)(p + 4); }
#pragma unroll
        for (int ai = 0; ai < 2; ++ai)
#pragma unroll
            for (int m = 0; m < 4; ++m) {
                const size_t row = (size_t)(rowt + ai * HALF + rl0 + m * 16);
                const f32x4 p0 = pa[ai][m], p1 = pb[ai][m];
                const float rs = __builtin_amdgcn_rsqf((((p0[0] + p0[1]) + (p0[2] + p0[3])) + ((p1[0] + p1[1]) + (p1[2] + p1[3]))) * (1.0f / 2048.0f) + 1e-6f);
                f32x4 h[2];
#pragma unroll
                for (int n = 0; n < 2; ++n) {
                    const f32x4 g = acc[ai][0][m][n] * rs, up = acc[ai][1][m][n] * rs;
#pragma unroll
                    for (int j = 0; j < 4; ++j) h[n][j] = g[j] * __builtin_amdgcn_rcpf(1.0f + __builtin_amdgcn_exp2f(-1.4426950408889634f * g[j])) * up[j];
                }
                *(u32x4*)(H + row * 5632 + pn * HALF + cw) = pack8(h[0], h[1]);
            }
    }
};

struct EpiDown {
    static constexpr bool PERM = true, AFTER_DRAIN = false;
    float* Y; float* part; const bf16_t* X1;
    __device__ __forceinline__ void operator()(const f32x4 (&acc)[2][2][4][2], const Unit& u, int wr, int wc, int fr, int fq) const {
        if (u.split) { store_partial(part, 8, acc, u, wr, wc, fr, fq); return; }
        int rl0 = wr * 64 + fr, cw = wc * 32 + 8 * fq; asm volatile("" : "+v"(rl0), "+v"(cw));
        const int pn = u.pn, rowt = u.pm * BM;
        u32x4 xb[2][4][2];
#pragma unroll
        for (int ai = 0; ai < 2; ++ai)
#pragma unroll
            for (int m = 0; m < 4; ++m)
#pragma unroll
                for (int bj = 0; bj < 2; ++bj) xb[ai][m][bj] = __builtin_nontemporal_load((const u32x4*)(X1 + (size_t)(rowt + ai * HALF + rl0 + m * 16) * 2048 + pn * 256 + bj * HALF + cw));
#pragma unroll
        for (int ai = 0; ai < 2; ++ai)
#pragma unroll
            for (int m = 0; m < 4; ++m)
#pragma unroll
                for (int bj = 0; bj < 2; ++bj) {
                    const size_t off = (size_t)(rowt + ai * HALF + rl0 + m * 16) * 2048 + pn * 256 + bj * HALF + cw;
                    const u32x4 x = xb[ai][m][bj];
                    f32x4 b0, b1; b0[0] = __builtin_bit_cast(float, x.x << 16); b0[1] = __builtin_bit_cast(float, x.x & 0xffff0000u); b0[2] = __builtin_bit_cast(float, x.y << 16); b0[3] = __builtin_bit_cast(float, x.y & 0xffff0000u);
                    b1[0] = __builtin_bit_cast(float, x.z << 16); b1[1] = __builtin_bit_cast(float, x.z & 0xffff0000u); b1[2] = __builtin_bit_cast(float, x.w << 16); b1[3] = __builtin_bit_cast(float, x.w & 0xffff0000u);
                    float* o = Y + off; *(f32x4*)o = b0 + acc[ai][bj][m][0]; *(f32x4*)(o + 4) = b1 + acc[ai][bj][m][1];
                }
    }
};

struct EpiNone {
    static constexpr bool PERM = true, AFTER_DRAIN = false;
    float* sink;
    __device__ __forceinline__ void operator()(const f32x4 (&acc)[2][2][4][2], const Unit& u, int wr, int wc, int fr, int fq) const {
        if (acc[0][0][0][0][0] == 12345.678f && acc[1][1][3][1][3] == -9876.5f) sink[0] = 1.f;
    }
};
template <class Epi, class Sched, bool ALIGN_EPI = false, bool SP2 = false>
__device__ __forceinline__ void gemm_phase(PG8_LAS unsigned char* lds, const Gemm g, const Sched& S, const Epi& E) {
    int tid_ = threadIdx.x; asm volatile("" : "+v"(tid_));
    const int tid = tid_, wid = __builtin_amdgcn_readfirstlane(tid >> 6), lane = tid & 63, wr = wid >> 2, wc = wid & 3, fr = lane & 15, fq = lane >> 4;
    const int K = g.K;
    unsigned voffA[2], voffB[2];
#pragma unroll
    for (int i = 0; i < 2; ++i) { int R, C; stage_rc(tid * 16 + i * 8192, R, C); const int Rb = Epi::PERM ? ((R & ~31) + perm32(R & 31)) : R;
        voffA[i] = (unsigned)(R * K + C) * 2u; voffB[i] = (unsigned)(Rb * K + C) * 2u; }
    const size_t kstep = (size_t)(BK * 2);
    const size_t hstep = (size_t)HALF * K * 2;
    const size_t tstep = 2 * hstep;
    const unsigned ldsw = (unsigned)wid * 1024u;
    const int aoff = lds_byte(wr * 64 + fr, fq * 8), boff = lds_byte(wc * 32 + fr, fq * 8);
#define PG8_SA(b, h) (((b) * 2 + (h)) * HTB)
#define PG8_SB(b, h) ((4 + (b) * 2 + (h)) * HTB)
#define PG8_STAGE(bufoff, gbase, voff) do { _Pragma("unroll") for (int _i = 0; _i < 2; ++_i) \
        __builtin_amdgcn_global_load_lds((const unsigned*)((const char*)(gbase) + (voff)[_i]), (PG8_LAS unsigned*)(lds + (bufoff) + ldsw + _i * 8192), 16, 0, 0); } while (0)
#define PG8_LDA(dst, b, h) do { _Pragma("unroll") for (int m = 0; m < 4; ++m) _Pragma("unroll") for (int k = 0; k < 2; ++k) dst[m][k] = *(const PG8_LAS bf16x8*)(lds + PG8_SA(b, h) + aoff + m * 2048 + k * 1024); } while (0)
#define PG8_LDB(dst, b, h) do { _Pragma("unroll") for (int n = 0; n < 2; ++n) _Pragma("unroll") for (int k = 0; k < 2; ++k) dst[n][k] = *(const PG8_LAS bf16x8*)(lds + PG8_SB(b, h) + boff + n * 2048 + k * 1024); } while (0)
#define PG8_MMA(ai, bj, At, Bt) do { __builtin_amdgcn_s_setprio(1); _Pragma("unroll") for (int m = 0; m < 4; ++m) _Pragma("unroll") for (int n = 0; n < 2; ++n) _Pragma("unroll") for (int k = 0; k < 2; ++k) \
        acc[ai][bj][m][n] = __builtin_amdgcn_mfma_f32_16x16x32_bf16(Bt[n][k], At[m][k], acc[ai][bj][m][n], 0, 0, 0); __builtin_amdgcn_s_setprio(0); } while (0)
#define PG8_WAIT_V(n) asm volatile("s_waitcnt vmcnt(" #n ")" ::: "memory")
#define PG8_WAIT_L(n) asm volatile("s_waitcnt lgkmcnt(" #n ")" ::: "memory")
#define PG8_BAR __builtin_amdgcn_s_barrier()
#define PG8_SCHED __builtin_amdgcn_sched_barrier(0)
    Unit cur, nxt; int ui = 0;
    if (!S.next(0, cur)) return;
    f32x4 acc[2][2][4][2];
#pragma unroll
    for (int a = 0; a < 2; ++a)
#pragma unroll
        for (int b = 0; b < 2; ++b)
#pragma unroll
            for (int m = 0; m < 4; ++m)
#pragma unroll
                for (int n = 0; n < 2; ++n) acc[a][b][m][n] = (f32x4){0.f, 0.f, 0.f, 0.f};
    bf16x8 At[4][2], B0[2][2], B1[2][2];
    const char* cA = (const char*)g.A + (size_t)cur.pm * tstep + (size_t)cur.k0 * kstep; const char* cB = (const char*)g.Bt + (size_t)cur.pn * tstep + (size_t)cur.k0 * kstep;
    S.a_ready(cur);
    if constexpr (SP2) {
        PG8_STAGE(PG8_SB(0, 0), cB, voffB); PG8_STAGE(PG8_SB(0, 1), cB + hstep, voffB); PG8_STAGE(PG8_SA(0, 0), cA, voffA); PG8_STAGE(PG8_SA(0, 1), cA + hstep, voffA);
        if (wr == 1) PG8_BAR;
        PG8_WAIT_V(2); PG8_BAR;
        PG8_STAGE(PG8_SB(1, 0), cB + kstep, voffB); PG8_STAGE(PG8_SA(1, 0), cA + kstep, voffA); PG8_STAGE(PG8_SB(1, 1), cB + hstep + kstep, voffB);
        PG8_WAIT_V(6); PG8_BAR;
    } else {
        PG8_STAGE(PG8_SB(0, 0), cB, voffB); PG8_STAGE(PG8_SA(0, 0), cA, voffA); PG8_STAGE(PG8_SB(0, 1), cB + hstep, voffB); PG8_STAGE(PG8_SA(0, 1), cA + hstep, voffA);
        if (wr == 1) PG8_BAR;
        PG8_WAIT_V(4); PG8_BAR;
        PG8_STAGE(PG8_SB(1, 0), cB + kstep, voffB); PG8_STAGE(PG8_SA(1, 0), cA + kstep, voffA); PG8_STAGE(PG8_SB(1, 1), cB + hstep + kstep, voffB);
        PG8_WAIT_V(6); PG8_BAR;
    }
    for (;;) {
        const bool has_next = S.next(ui + 1, nxt);
        const char* nA = has_next ? (const char*)g.A + (size_t)nxt.pm * tstep + (size_t)nxt.k0 * kstep : cA; const char* nB = has_next ? (const char*)g.Bt + (size_t)nxt.pn * tstep + (size_t)nxt.k0 * kstep : cB;
        const int nt = cur.nt;
        for (int t = 0; t < nt; t += 2) {
            const bool last = (t == nt - 2);
            const char* a1 = cA + (size_t)(t + 1) * kstep;
            const char* a2 = last ? nA : cA + (size_t)(t + 2) * kstep; const char* b2 = last ? nB : cB + (size_t)(t + 2) * kstep;
            const char* a3 = a2 + kstep; const char* b3 = b2 + kstep;
            if (last && has_next) S.a_ready(nxt);
            if constexpr (SP2) {
            PG8_LDB(B0, 0, 0); PG8_LDB(B1, 0, 1); PG8_SCHED; PG8_LDA(At, 0, 0); PG8_STAGE(PG8_SA(1, 1), a1 + hstep, voffA);
            PG8_WAIT_V(8); PG8_WAIT_L(0); PG8_BAR; PG8_MMA(0, 0, At, B0); PG8_MMA(0, 1, At, B1); PG8_BAR; PG8_SCHED;
            PG8_LDA(At, 0, 1); PG8_STAGE(PG8_SB(0, 0), b2, voffB); PG8_STAGE(PG8_SB(0, 1), b2 + hstep, voffB); PG8_STAGE(PG8_SA(0, 0), a2, voffA);
            PG8_WAIT_V(8); PG8_WAIT_L(0); PG8_BAR; PG8_MMA(1, 0, At, B0); PG8_MMA(1, 1, At, B1); PG8_BAR; PG8_SCHED;
            PG8_LDB(B0, 1, 0); PG8_LDB(B1, 1, 1); PG8_SCHED; PG8_LDA(At, 1, 0); PG8_STAGE(PG8_SA(0, 1), a2 + hstep, voffA);
            PG8_WAIT_V(8); PG8_WAIT_L(0); PG8_BAR; PG8_MMA(0, 0, At, B0); PG8_MMA(0, 1, At, B1); PG8_BAR; PG8_SCHED;
            PG8_LDA(At, 1, 1); PG8_STAGE(PG8_SB(1, 0), b3, voffB); PG8_STAGE(PG8_SB(1, 1), b3 + hstep, voffB); PG8_STAGE(PG8_SA(1, 0), a3, voffA);
            PG8_WAIT_V(8); PG8_WAIT_L(0); PG8_BAR; PG8_MMA(1, 0, At, B0); PG8_MMA(1, 1, At, B1); PG8_BAR; PG8_SCHED;
            } else {
            PG8_LDB(B0, 0, 0); PG8_SCHED; PG8_LDA(At, 0, 0); PG8_STAGE(PG8_SA(1, 1), a1 + hstep, voffA);
            PG8_WAIT_L(8); PG8_BAR; PG8_WAIT_L(0); PG8_MMA(0, 0, At, B0); PG8_BAR; PG8_SCHED;
            PG8_LDB(B1, 0, 1); PG8_STAGE(PG8_SB(0, 0), b2, voffB);
            PG8_BAR; PG8_WAIT_L(0); PG8_MMA(0, 1, At, B1); PG8_BAR;
            PG8_LDA(At, 0, 1); PG8_STAGE(PG8_SA(0, 0), a2, voffA);
            PG8_BAR; PG8_WAIT_L(0); PG8_MMA(1, 0, At, B0); PG8_BAR; PG8_SCHED;
            PG8_STAGE(PG8_SB(0, 1), b2 + hstep, voffB);
            PG8_WAIT_V(6); PG8_BAR; PG8_MMA(1, 1, At, B1); PG8_BAR;
            PG8_LDB(B0, 1, 0); PG8_SCHED; PG8_LDA(At, 1, 0); PG8_STAGE(PG8_SA(0, 1), a2 + hstep, voffA);
            PG8_WAIT_L(8); PG8_BAR; PG8_WAIT_L(0); PG8_MMA(0, 0, At, B0); PG8_BAR; PG8_SCHED;
            PG8_LDB(B1, 1, 1); PG8_STAGE(PG8_SB(1, 0), b3, voffB);
            PG8_BAR; PG8_WAIT_L(0); PG8_MMA(0, 1, At, B1); PG8_BAR;
            PG8_LDA(At, 1, 1); PG8_STAGE(PG8_SA(1, 0), a3, voffA);
            PG8_BAR; PG8_WAIT_L(0); PG8_MMA(1, 0, At, B0); PG8_BAR; PG8_SCHED;
            PG8_STAGE(PG8_SB(1, 1), b3 + hstep, voffB);
            PG8_WAIT_V(6); PG8_BAR; PG8_MMA(1, 1, At, B1); PG8_BAR;
            }
        }
        if constexpr (ALIGN_EPI) { if (wr == 0) PG8_BAR; }
        if constexpr (!Epi::AFTER_DRAIN) { E(acc, cur, wr, wc, fr, fq); S.done(cur); }
        if (!has_next) break;
#pragma unroll
        for (int a = 0; a < 2; ++a)
#pragma unroll
            for (int b = 0; b < 2; ++b)
#pragma unroll
                for (int m = 0; m < 4; ++m)
#pragma unroll
                    for (int n = 0; n < 2; ++n) acc[a][b][m][n] = (f32x4){0.f, 0.f, 0.f, 0.f};
        cur = nxt; cA = nA; cB = nB; ++ui;
        if constexpr (ALIGN_EPI) { if (wr == 1) PG8_BAR; }
    }
    PG8_WAIT_V(0);
    if constexpr (!ALIGN_EPI) { if (wr == 0) PG8_BAR; }
    PG8_BAR;
    if constexpr (Epi::AFTER_DRAIN) { E.fused(acc, cur, wr, wc, fr, fq, lds, wid, lane); S.done(cur); }
#undef PG8_SA
#undef PG8_SB
#undef PG8_STAGE
#undef PG8_LDA
#undef PG8_LDB
#undef PG8_MMA
#undef PG8_WAIT_V
#undef PG8_WAIT_L
#undef PG8_BAR
#undef PG8_SCHED
}
}
#define LAS __attribute__((address_space(3)))
typedef unsigned short bf16;
typedef float f32x4 __attribute__((ext_vector_type(4)));
typedef float f32x16 __attribute__((ext_vector_type(16)));
typedef short bf16x8 __attribute__((ext_vector_type(8)));
typedef short s16x4 __attribute__((ext_vector_type(4)));
typedef unsigned u32x4 __attribute__((ext_vector_type(4)));
typedef unsigned u32x2 __attribute__((ext_vector_type(2)));
constexpr int DM = 2048, SEQ = 4096, NP = 8192, NS = 512, MT = NP + NS, AW = 1024, CC = 1024, INC = 6144, DFF = 5632, PAST = 4096, DSEQ = 64;
constexpr float EPS = 1e-6f;
constexpr size_t OFF_Y = 0, OFF_KP = (size_t)MT * DM, OFF_VP = OFF_KP + (size_t)NP * AW, OFF_CP = OFF_VP + (size_t)NP * AW, OFF_KS = OFF_CP + 2 * 2 * CC,
                 OFF_VS = OFF_KS + (size_t)NS * AW, OFF_CS = OFF_VS + (size_t)NS * AW, OUT_TOTAL = OFF_CS + 8 * 2 * CC;
static_assert(OUT_TOTAL == 35672064, "output size");
constexpr size_t MiB = 1u << 20;
constexpr size_t WS_CTL = 0, WS_WIN = 1 * MiB, WS_WOUT = 25 * MiB, WS_WGU = 33 * MiB, WS_WDN = 77 * MiB, WS_HN = 99 * MiB, WS_Q = 133 * MiB, WS_K = 150 * MiB, WS_V = 166 * MiB,
                 WS_GB = 182 * MiB, WS_U = 199 * MiB, WS_MIX = 216 * MiB, WS_SSQ = 250 * MiB, WS_TP = 251 * MiB, WS_OP = 256 * MiB, WS_H = 256 * MiB, WS_PART = 133 * MiB  ;
constexpr int NSLOT = 256 + 16;
constexpr size_t WS_END = WS_OP + (size_t)NSLOT * 131072;
constexpr int RING_BYTES = 131072, RED_OFF = RING_BYTES, MISC_OFF = RED_OFF + 8192, LDS_BYTES = 147456;
constexpr int NWAVES = 8;

#define XB_TMO      128
#define XB_XCNT(j)  (256  + 64 * (j))
#define XB_XSUB(j)  (1280 + 64 * (j))
#define XB_XGEN(j)  (2304 + 64 * (j))
#define XB_TOP      3328
#define XB_TOPGEN   3392
#define XCD_BAR_WORDS 3456
#define XB_SPIN_CAP (1u << 18)

__device__ __forceinline__ unsigned xb_ld(unsigned* p)              { return __hip_atomic_load(p, __ATOMIC_RELAXED, __HIP_MEMORY_SCOPE_AGENT); }
__device__ __forceinline__ unsigned xb_add(unsigned* p, unsigned v) { return __hip_atomic_fetch_add(p, v, __ATOMIC_RELAXED, __HIP_MEMORY_SCOPE_AGENT); }
__device__ __forceinline__ unsigned xb_xcc_id() { return (unsigned)__builtin_amdgcn_s_getreg((3 << 11) | 20) & 0xFu; }
#define XB_SPIN(cond, bar) do { unsigned _sp = 0; while (cond) { __builtin_amdgcn_s_sleep(1); \
    if ((++_sp & 255u) == 0u) { if (xb_ld(&(bar)[XB_TMO])) break; if (_sp > XB_SPIN_CAP) { atomicAdd(&(bar)[XB_TMO], 1u); break; } } } } while (0)

struct XcdBarrier {
    unsigned* bar; unsigned x;
    volatile LAS unsigned* st;
};

__device__ __forceinline__ XcdBarrier xcd_barrier_post(unsigned* bar, volatile LAS unsigned* st) {
    XcdBarrier b; b.bar = bar; b.x = xb_xcc_id(); b.st = st;
    if (threadIdx.x == 0) (void)xb_add(&bar[XB_XCNT(b.x)], 1u);
    return b;
}
__device__ __forceinline__ void xcd_barrier_complete(unsigned* bar, unsigned x, unsigned& nloc, unsigned& nx) {
    const unsigned G = gridDim.x * gridDim.y * gridDim.z;
    unsigned sum, cnt, mine, sp = 0u;
    for (;;) {
        sum = 0u; cnt = 0u; mine = 0u;
#pragma unroll
        for (unsigned j = 0; j < 16; ++j) { const unsigned c = xb_ld(&bar[XB_XCNT(j)]); sum += c; cnt += (c > 0u) ? 1u : 0u; mine = (j == x) ? c : mine; }
        if (sum == G) break;
        __builtin_amdgcn_s_sleep(1);
        if ((++sp & 255u) == 0u) { if (xb_ld(&bar[XB_TMO])) break; if (sp > XB_SPIN_CAP) { atomicAdd(&bar[XB_TMO], 1u); break; } }
    }
    nloc = mine > 0u ? mine : 1u; nx = cnt > 0u ? cnt : 1u;
}

__device__ __forceinline__ void xcd_barrier(const XcdBarrier& b) {
    asm volatile("s_waitcnt vmcnt(0)" ::: "memory");
    __syncthreads();
    if (threadIdx.x == 0) {
        unsigned* bar = b.bar;
        __builtin_amdgcn_s_waitcnt(0);
        unsigned nloc = b.st[0], nx = b.st[1];
        if (nloc == 0u) { xcd_barrier_complete(bar, b.x, nloc, nx); b.st[0] = nloc; b.st[1] = nx; }
        const unsigned old = xb_add(&bar[XB_XSUB(b.x)], 1u);
        const unsigned gen = old / nloc;
        if (old + 1u == (gen + 1u) * nloc) {
            __builtin_amdgcn_fence(__ATOMIC_RELEASE, "agent");
            asm volatile("s_waitcnt vmcnt(0)" ::: "memory");
            const unsigned og = xb_add(&bar[XB_TOP], 1u);
            const unsigned tg = og / nx;
            if (og + 1u == (tg + 1u) * nx) xb_add(&bar[XB_TOPGEN], 1u);
            else XB_SPIN(xb_ld(&bar[XB_TOPGEN]) == tg, bar);
            __builtin_amdgcn_fence(__ATOMIC_ACQUIRE, "agent");
            xb_add(&bar[XB_XGEN(b.x)], 1u);
            asm volatile("s_waitcnt vmcnt(0)" ::: "memory");
        } else {
            XB_SPIN(xb_ld(&bar[XB_XGEN(b.x)]) == gen, bar);
            __builtin_amdgcn_fence(__ATOMIC_ACQUIRE, "agent");
            asm volatile("s_waitcnt vmcnt(0)" ::: "memory");
        }
    }
    __syncthreads();
}

struct ItemTab { int n; int v[272]; };
constexpr int p_nsteps(int qb, int c) { return 8 * (qb + 1); }
constexpr ItemTab make_items() {
    ItemTab t{}; t.n = 0;
    for (int b = 0; b < 8; ++b) for (int hg = 0; hg < 2; ++hg) t.v[t.n++] = 1 | (b << 1) | (hg << 4);
    for (int qb = 15; qb >= 0; --qb) for (int bh = 0; bh < 16; ++bh) t.v[t.n++] = (bh << 1) | (qb << 5);
    return t;
}
__device__ const ItemTab g_items = make_items();

__device__ __forceinline__ unsigned f2bf(float f) { unsigned u = __builtin_bit_cast(unsigned, f); return (u + 0x7fffu + ((u >> 16) & 1u)) >> 16; }
__device__ __forceinline__ unsigned pk2(float lo, float hi) { return pg8::cvt_pk_bf16(lo, hi); }
__device__ __forceinline__ float bflo(unsigned w) { return __builtin_bit_cast(float, w << 16); }
__device__ __forceinline__ float bfhi(unsigned w) { return __builtin_bit_cast(float, w & 0xffff0000u); }
__device__ __forceinline__ int crow(int r, int hi) { return (r & 3) + 8 * (r >> 2) + 4 * hi; }
__device__ __forceinline__ float wave_sum(float v) {
#pragma unroll
    for (int o = 1; o < 64; o <<= 1) v += __shfl_xor(v, o);
    return v;
}

struct Args { const float* in[17]; float* out; unsigned char* ws; };

struct P0Item { const float* src; const float* gk; bf16* dst; int N, K, k0; };
__device__ __forceinline__ P0Item p0_decode(const Args& a, int it) {
    constexpr int I_IN = 32 * 192, I_OUT = 32 * 64, I_G = 32 * 176;
    unsigned char* ws = a.ws; P0Item r; int n0, kb, drow; r.gk = nullptr;
    if (it < I_IN) { kb = it / 192; n0 = 32 * (it % 192); drow = n0;
        if (n0 >= 5120) { const int ch = n0 - 5120; drow = 4096 + (ch >> 7) * 256 + 128 + (ch & 127); } else if (n0 >= 4096) { const int ch = n0 - 4096; drow = 4096 + (ch >> 7) * 256 + (ch & 127); }
        r.src = a.in[6]; r.N = INC; r.K = DM; r.dst = (bf16*)(ws + WS_WIN); }
    else if ((it -= I_IN) < I_OUT) { kb = it / 64; n0 = 32 * (it % 64); drow = n0; r.src = a.in[12]; r.N = DM; r.K = DM; r.dst = (bf16*)(ws + WS_WOUT); }
    else if ((it -= I_OUT) < 2 * I_G) { const int up = it >= I_G; if (up) it -= I_G; kb = it / 176; n0 = 32 * (it % 176); drow = (n0 >> 7) * 256 + up * 128 + (n0 & 127);
        r.src = a.in[up ? 15 : 14]; r.N = DFF; r.K = DM; r.dst = (bf16*)(ws + WS_WGU); r.gk = a.in[13]; }
    else { it -= 2 * I_G; kb = it / 64; n0 = 32 * (it % 64); drow = n0; r.src = a.in[16]; r.N = DM; r.K = DFF; r.dst = (bf16*)(ws + WS_WDN); }
    r.k0 = 64 * kb; r.src += (size_t)r.k0 * r.N + n0; r.dst += (size_t)drow * r.K + r.k0;
    return r;
}
__device__ __forceinline__ void p0_load(const P0Item& p, f32x4 (&v)[8], int lane) {
#pragma unroll
    for (int j = 0; j < 8; ++j) v[j] = __builtin_nontemporal_load((const f32x4*)(p.src + (size_t)(8 * j + (lane >> 3)) * p.N + 4 * (lane & 7)));
}
__device__ __forceinline__ void p0_finish(const P0Item& p, const f32x4 (&v)[8], LAS float* scr, int lane) {
#pragma unroll
    for (int j = 0; j < 8; ++j) { const int kk = 8 * j + (lane >> 3); const float g = p.gk ? p.gk[p.k0 + kk] : 1.0f; LAS float* s = scr + kk * 33 + 4 * (lane & 7);
        s[0] = v[j][0] * g; s[1] = v[j][1] * g; s[2] = v[j][2] * g; s[3] = v[j][3] * g; }
    asm volatile("s_waitcnt lgkmcnt(0)" ::: "memory");
    const int c = lane & 7;
#pragma unroll
    for (int j = 0; j < 4; ++j) { const int n = (lane >> 3) + 8 * j; const LAS float* s = scr + (8 * c) * 33 + n;
        u32x4 o; o.x = pk2(s[0 * 33], s[1 * 33]); o.y = pk2(s[2 * 33], s[3 * 33]); o.z = pk2(s[4 * 33], s[5 * 33]); o.w = pk2(s[6 * 33], s[7 * 33]);
        *(u32x4*)(p.dst + (size_t)n * p.K + 8 * c) = o; }
    asm volatile("s_waitcnt lgkmcnt(0)" ::: "memory");
}
constexpr int P0_EARLY_ITEMS = 32 * 192 + 32 * 64, P0_ALL_ITEMS = 32 * 192 + 32 * 64 + 2 * 32 * 176 + 88 * 64, P0_CHUNK = 32, P0_LATE_CHUNKS = (P0_ALL_ITEMS - P0_EARLY_ITEMS) / P0_CHUNK;
static_assert((P0_ALL_ITEMS - P0_EARLY_ITEMS) % P0_CHUNK == 0, "late conversion items come in whole chunks");
__device__ __forceinline__ void p0_run_range(const Args& a, LAS float* scr, int first, int n, int lane) {
    f32x4 va[8], vb[8]; P0Item pa, pb;
    pa = p0_decode(a, first); p0_load(pa, va, lane);
    for (int i = 0; i < n; i += 2) {
        if (i + 1 < n) { pb = p0_decode(a, first + i + 1); p0_load(pb, vb, lane); }
        p0_finish(pa, va, scr, lane);
        if (i + 1 >= n) break;
        if (i + 2 < n) { pa = p0_decode(a, first + i + 2); p0_load(pa, va, lane); }
        p0_finish(pb, vb, scr, lane);
    }
}
__device__ __forceinline__ void p0_prologue(const Args& a, LAS unsigned char* lds, int gw, int NGW, int lane, int wave) {
    LAS float* scr = (LAS float*)(lds + wave * 16384);
    unsigned char* ws = a.ws;
    constexpr int NITEMS = P0_EARLY_ITEMS;
    {
        int it = gw; f32x4 va[8], vb[8]; P0Item pa, pb;
        if (it < NITEMS) { pa = p0_decode(a, it); p0_load(pa, va, lane); }
        while (it < NITEMS) {
            const int itb = it + NGW;
            if (itb < NITEMS) { pb = p0_decode(a, itb); p0_load(pb, vb, lane); }
            p0_finish(pa, va, scr, lane);
            it = itb + NGW;
            if (itb >= NITEMS) break;
            if (it < NITEMS) { pa = p0_decode(a, it); p0_load(pa, va, lane); }
            p0_finish(pb, vb, scr, lane);
        }
    }
    const float* g1 = a.in[5];
    f32x4 gv[8];
#pragma unroll
    for (int j = 0; j < 8; ++j) gv[j] = *((const f32x4*)g1 + 64 * j + lane);
    for (int m = gw; m < MT; m += 2 * NGW) {
        const int m2 = m + NGW; const bool has2 = m2 < MT;
        const float* xa = m < NP ? a.in[0] + (size_t)m * DM : a.in[1] + (size_t)(m - NP) * DM;
        const float* xb = has2 ? (m2 < NP ? a.in[0] + (size_t)m2 * DM : a.in[1] + (size_t)(m2 - NP) * DM) : xa;
        f32x4 va[8], vb[8];
#pragma unroll
        for (int j = 0; j < 8; ++j) va[j] = __builtin_nontemporal_load((const f32x4*)xa + 64 * j + lane);
        if (has2) {
#pragma unroll
            for (int j = 0; j < 8; ++j) vb[j] = __builtin_nontemporal_load((const f32x4*)xb + 64 * j + lane);
        }
        {
            float s = 0.f;
#pragma unroll
            for (int j = 0; j < 8; ++j) s += (va[j][0] * va[j][0] + va[j][1] * va[j][1]) + (va[j][2] * va[j][2] + va[j][3] * va[j][3]);
            const float rs = __builtin_amdgcn_rsqf(wave_sum(s) * (1.0f / DM) + EPS);
            u32x2* o = (u32x2*)((bf16*)(ws + WS_HN) + (size_t)m * DM) + lane;
#pragma unroll
            for (int j = 0; j < 8; ++j) { u32x2 w; w.x = pk2(va[j][0] * rs * gv[j][0], va[j][1] * rs * gv[j][1]); w.y = pk2(va[j][2] * rs * gv[j][2], va[j][3] * rs * gv[j][3]); o[64 * j] = w; }
        }
        if (has2) {
            float s = 0.f;
#pragma unroll
            for (int j = 0; j < 8; ++j) s += (vb[j][0] * vb[j][0] + vb[j][1] * vb[j][1]) + (vb[j][2] * vb[j][2] + vb[j][3] * vb[j][3]);
            const float rs = __builtin_amdgcn_rsqf(wave_sum(s) * (1.0f / DM) + EPS);
            u32x2* o = (u32x2*)((bf16*)(ws + WS_HN) + (size_t)m2 * DM) + lane;
#pragma unroll
            for (int j = 0; j < 8; ++j) { u32x2 w; w.x = pk2(vb[j][0] * rs * gv[j][0], vb[j][1] * rs * gv[j][1]); w.y = pk2(vb[j][2] * rs * gv[j][2], vb[j][3] * rs * gv[j][3]); o[64 * j] = w; }
        }
    }
}


template <int VS, bool QREG>
__device__ __forceinline__ void sb_block(f32x16 (&o)[4], float& R, const LAS unsigned char* kp, const LAS unsigned char* vp, const bf16x8 (&qreg)[8], const LAS unsigned char* qlp, int kb, int qw, int qpos, int hi) {
            f32x16 p;
#pragma unroll
            for (int r = 0; r < 16; ++r) p[r] = 0.f;
#pragma unroll
            for (int d0 = 0; d0 < 8; ++d0) { const bf16x8 kf = *(const LAS bf16x8*)(kp + d0 * 32); const bf16x8 qf = QREG ? qreg[d0] : *(const LAS bf16x8*)(qlp + d0 * 32); p = __builtin_amdgcn_mfma_f32_32x32x16_bf16(kf, qf, p, 0, 0, 0); }
            const bool need_mask = (kb + 31 >= qw);
            float e[16], sf[16];
#pragma unroll
            for (int r = 0; r < 16; ++r) {
                const float z = fminf(p[r], 100.f); float ee = __builtin_amdgcn_exp2f(z); float rr = __builtin_amdgcn_rcpf(1.0f + ee);
                if (need_mask) { const bool msk = (kb + crow(r, hi)) >= qpos; ee = msk ? 0.f : ee; rr = msk ? 1.f : rr; }
                e[r] = ee; sf[r] = rr;
            }
            float oth[4], PP[4];
#pragma unroll
            for (int g = 0; g < 4; ++g) { sf[4 * g + 2] *= sf[4 * g + 3]; sf[4 * g + 1] *= sf[4 * g + 2]; sf[4 * g] *= sf[4 * g + 1]; oth[g] = __shfl_xor(sf[4 * g], 32); PP[g] = sf[4 * g] * oth[g]; }
            const float SP3 = PP[3], SP2 = PP[2] * SP3, SP1 = PP[1] * SP2, SP0 = PP[0] * SP1;
            float A[4]; A[0] = R * SP1; A[1] = R * SP2; A[2] = R * SP3; A[3] = R;
#pragma unroll
            for (int g = 0; g < 4; ++g) A[g] = hi ? A[g] : A[g] * oth[g];
            R *= SP0;
            float w[16];
#pragma unroll
            for (int r = 0; r < 16; ++r) w[r] = (e[r] * sf[r]) * A[r >> 2];
#pragma unroll
            for (int s2 = 0; s2 < 2; ++s2) {
                u32x4 pw; pw.x = pk2(w[8 * s2 + 0], w[8 * s2 + 1]); pw.y = pk2(w[8 * s2 + 2], w[8 * s2 + 3]); pw.z = pk2(w[8 * s2 + 4], w[8 * s2 + 5]); pw.w = pk2(w[8 * s2 + 6], w[8 * s2 + 7]);
                const bf16x8 pa = __builtin_bit_cast(bf16x8, pw);
#pragma unroll
                for (int db = 0; db < 4; ++db) {
                    const s16x4 lo = __builtin_bit_cast(s16x4, __builtin_amdgcn_ds_read_tr16_b64_v4i16((LAS s16x4*)(vp + (16 * s2) * VS + db * 64)));
                    const s16x4 hh = __builtin_bit_cast(s16x4, __builtin_amdgcn_ds_read_tr16_b64_v4i16((LAS s16x4*)(vp + (16 * s2 + 8) * VS + db * 64)));
                    const bf16x8 vb = __builtin_shufflevector(lo, hh, 0, 1, 2, 3, 4, 5, 6, 7);
                    o[db] = __builtin_amdgcn_mfma_f32_32x32x16_bf16(pa, vb, o[db], 0, 0, 0);
                }
            }
}

template <bool SAMPLE>
__device__ __forceinline__ void attn_item(const Args& a, LAS unsigned char* lds, int code) {
    constexpr int NH = SAMPLE ? 4 : 1, KS = NH * 256 + 16, VS = NH * 256 + 32, K_OFF = 0, V_OFF = 32 * KS;
    int tid_ = threadIdx.x; asm volatile("" : "+v"(tid_));
    const int tid = tid_, lane = tid & 63, r32 = lane & 31, hi = lane >> 5; const int wid = __builtin_amdgcn_readfirstlane(tid >> 6);
    unsigned char* ws = a.ws;
    int slot, nsteps, kvpos0, qw, head, hl; size_t qrow;
    const bf16 *kgb = nullptr, *vgb = nullptr; const float *kgf = nullptr, *vgf = nullptr, *kgn = nullptr, *vgn = nullptr;
    if (SAMPLE) {
        const int b = (code >> 1) & 7, hg = (code >> 4) & 1;
        slot = 256 + b * 2 + hg; hl = wid >> 1; head = hg * 4 + hl; const int rg = wid & 1;
        qw = PAST + 32 * rg; qrow = (size_t)NP + b * DSEQ + 32 * rg + r32;
        nsteps = 130; kvpos0 = 0;
        kgf = a.in[2] + ((size_t)b * PAST + (tid >> 7)) * AW + hg * 512 + 4 * (tid & 127); vgf = a.in[3] + ((size_t)b * PAST + (tid >> 7)) * AW + hg * 512 + 4 * (tid & 127);
        kgn = a.out + OFF_KS + ((size_t)b * DSEQ + (tid >> 7)) * AW + hg * 512 + 4 * (tid & 127); vgn = a.out + OFF_VS + ((size_t)b * DSEQ + (tid >> 7)) * AW + hg * 512 + 4 * (tid & 127);
    } else {
        const int bh = (code >> 1) & 15, qb = (code >> 5) & 15, c = (code >> 9) & 3, b = bh >> 3;
        head = bh & 7; hl = 0; slot = bh * 16 + qb + 0 * c; nsteps = p_nsteps(qb, c); kvpos0 = 0;
        qw = qb * 256 + 32 * wid; qrow = (size_t)b * SEQ + qw + r32;
        kgb = (const bf16*)(ws + WS_K) + ((size_t)b * SEQ + kvpos0 + (tid >> 4)) * AW + head * 128 + (tid & 15) * 8;
        vgb = (const bf16*)(ws + WS_V) + ((size_t)b * SEQ + kvpos0 + (tid >> 4)) * AW + head * 128 + (tid & 15) * 8;
    }
    const int qpos = qw + r32;
    constexpr int Q_OFF = 67584, QS = 272;
    const LAS unsigned char* qlp = lds + Q_OFF + wid * (32 * QS) + r32 * QS + hi * 16;
    { const bf16* qp = (const bf16*)(ws + WS_Q) + qrow * AW + head * 128 + hi * 8;
#pragma unroll
      for (int d0 = 0; d0 < 8; ++d0) *(LAS bf16x8*)(lds + Q_OFF + wid * (32 * QS) + r32 * QS + hi * 16 + d0 * 32) = *(const bf16x8*)(qp + 16 * d0); }
    f32x16 o[4];
#pragma unroll
    for (int i = 0; i < 4; ++i)
#pragma unroll
        for (int r = 0; r < 16; ++r) o[i][r] = 0.f;
    float R = 1.f;
    u32x4 kreg, vreg; f32x4 kf4[8], vf4[8];
#define ATT_LOADK(s_) do { if (SAMPLE) { _Pragma("unroll") for (int i_ = 0; i_ < 8; ++i_) kf4[i_] = *(const f32x4*)(((s_) >= 128 ? kgn + (size_t)((s_) - 128) * 32 * AW : kgf + (size_t)(s_) * 32 * AW) + (size_t)i_ * 4 * AW); } \
        else { kreg = *(const u32x4*)(kgb + (size_t)(s_) * 32 * AW); } } while (0)
#define ATT_LOADV(s_) do { if (SAMPLE) { _Pragma("unroll") for (int i_ = 0; i_ < 8; ++i_) vf4[i_] = *(const f32x4*)(((s_) >= 128 ? vgn + (size_t)((s_) - 128) * 32 * AW : vgf + (size_t)(s_) * 32 * AW) + (size_t)i_ * 4 * AW); } \
        else { vreg = *(const u32x4*)(vgb + (size_t)(s_) * 32 * AW); } } while (0)
#define ATT_STOREK() do { if (SAMPLE) { _Pragma("unroll") for (int i_ = 0; i_ < 8; ++i_) { const int key_ = (tid >> 7) + 4 * i_, f4_ = tid & 127; \
            u32x2 kw_; kw_.x = pk2(kf4[i_][0], kf4[i_][1]); kw_.y = pk2(kf4[i_][2], kf4[i_][3]); *(LAS u32x2*)(lds + K_OFF + key_ * KS + f4_ * 8) = kw_; } } \
        else { *(LAS u32x4*)(lds + K_OFF + (tid >> 4) * KS + (tid & 15) * 16) = kreg; } } while (0)
#define ATT_STOREV() do { if (SAMPLE) { _Pragma("unroll") for (int i_ = 0; i_ < 8; ++i_) { const int key_ = (tid >> 7) + 4 * i_, f4_ = tid & 127; \
            u32x2 vw_; vw_.x = pk2(vf4[i_][0], vf4[i_][1]); vw_.y = pk2(vf4[i_][2], vf4[i_][3]); *(LAS u32x2*)(lds + V_OFF + key_ * VS + f4_ * 8) = vw_; } } \
        else { *(LAS u32x4*)(lds + V_OFF + (tid >> 4) * VS + (tid & 15) * 16) = vreg; } } while (0)
    volatile LAS int* flg = (volatile LAS int*)(lds + MISC_OFF + 64);
    ATT_LOADK(nsteps - 1); ATT_LOADV(nsteps - 1);
    ATT_STOREK(); ATT_STOREV();
    __syncthreads();
    const LAS unsigned char* kp = lds + K_OFF + r32 * KS + hl * 256 + hi * 16;
    const LAS unsigned char* vp = lds + V_OFF + (4 * hi + ((lane & 15) >> 2)) * VS + hl * 256 + (16 * ((lane >> 4) & 1) + 4 * (lane & 3)) * 2;
    for (int s = nsteps - 1; s >= 0; --s) {
        if (s > 0) { ATT_LOADK(s - 1); if (!SAMPLE) ATT_LOADV(s - 1); }
        const int kb = kvpos0 + 32 * s;
        if (kb < qw + 32 && !__all(R == 0.f)) { const bf16x8 qdummy[8] = {}; sb_block<VS, false>(o, R, kp, vp, qdummy, qlp, kb, qw, qpos, hi); }
        if (lane == 0) flg[wid] = __all(R == 0.f) ? 1 : 0;
        __syncthreads();
        const bool alldone = (flg[0] & flg[1] & flg[2] & flg[3] & flg[4] & flg[5] & flg[6] & flg[7]) != 0;
        if (alldone) { __syncthreads(); break; }
        if (s > 0) { ATT_STOREK(); if (SAMPLE) ATT_LOADV(s - 1); ATT_STOREV(); }
        __syncthreads();
    }
#undef ATT_LOADK
#undef ATT_LOADV
#undef ATT_STOREK
#undef ATT_STOREV
    bf16* op = (bf16*)(ws + WS_OP) + ((size_t)(slot * 8 + wid) * 32) * 128;
#pragma unroll
    for (int db = 0; db < 4; ++db)
#pragma unroll
        for (int r = 0; r < 16; ++r) op[crow(r, hi) * 128 + db * 32 + r32] = (bf16)f2bf(o[db][r]);
    if (hi == 0) ((float*)(ws + WS_TP))[(slot * 8 + wid) * 32 + r32] = R;
}


__device__ __forceinline__ void attn_item_p(const Args& a, LAS unsigned char* lds, int code) {
    constexpr int KS = 272, VS = 288, TILE_K = 64 * KS, BUF = TILE_K + 64 * VS;
    int tid_ = threadIdx.x; asm volatile("" : "+v"(tid_));
    const int tid = tid_, lane = tid & 63, r32 = lane & 31, hi = lane >> 5; const int wid = __builtin_amdgcn_readfirstlane(tid >> 6);
    unsigned char* ws = a.ws;
    const int bh = (code >> 1) & 15, qb = (code >> 5) & 15, c = (code >> 9) & 3, b = bh >> 3, head = bh & 7;
    const int slot = bh * 16 + qb + 0 * c, nst = p_nsteps(qb, c) >> 1, kvpos0 = 0;
    const int qw = qb * 256 + 32 * wid, qpos = qw + r32; const size_t qrow = (size_t)b * SEQ + qpos;
    const bf16* kgb = (const bf16*)(ws + WS_K) + ((size_t)b * SEQ + kvpos0 + (tid >> 4)) * AW + head * 128 + (tid & 15) * 8;
    const bf16* vgb = (const bf16*)(ws + WS_V) + ((size_t)b * SEQ + kvpos0 + (tid >> 4)) * AW + head * 128 + (tid & 15) * 8;
    bf16x8 qf[8];
    { const bf16* qp = (const bf16*)(ws + WS_Q) + qrow * AW + head * 128 + hi * 8;
#pragma unroll
      for (int d0 = 0; d0 < 8; ++d0) qf[d0] = *(const bf16x8*)(qp + 16 * d0); }
    f32x16 o[4];
#pragma unroll
    for (int i = 0; i < 4; ++i)
#pragma unroll
        for (int r = 0; r < 16; ++r) o[i][r] = 0.f;
    float R = 1.f;
    u32x4 kreg[2], vreg[2];
#define PLOAD(s_) do { _Pragma("unroll") for (int i_ = 0; i_ < 2; ++i_) { kreg[i_] = *(const u32x4*)(kgb + (size_t)((s_) * 64 + 32 * i_) * AW); vreg[i_] = *(const u32x4*)(vgb + (size_t)((s_) * 64 + 32 * i_) * AW); } } while (0)
#define PSTORE(buf_) do { _Pragma("unroll") for (int i_ = 0; i_ < 2; ++i_) { *(LAS u32x4*)(lds + (buf_) * BUF + ((tid >> 4) + 32 * i_) * KS + (tid & 15) * 16) = kreg[i_]; \
        *(LAS u32x4*)(lds + (buf_) * BUF + TILE_K + ((tid >> 4) + 32 * i_) * VS + (tid & 15) * 16) = vreg[i_]; } } while (0)
    volatile LAS int* flg = (volatile LAS int*)(lds + MISC_OFF + 64);
    PLOAD(nst - 1);
    PSTORE(0);
    __syncthreads();
    const LAS unsigned char* kp = lds + r32 * KS + hi * 16;
    const LAS unsigned char* vp = lds + TILE_K + (4 * hi + ((lane & 15) >> 2)) * VS + (16 * ((lane >> 4) & 1) + 4 * (lane & 3)) * 2;
    int cur = 0;
    for (int s = nst - 1; s >= 0; --s) {
        if (s > 0) PLOAD(s - 1);
#pragma unroll
        for (int blk = 1; blk >= 0; --blk) {
            const int kb = kvpos0 + 64 * s + 32 * blk;
            if (kb < qw + 32 && !__all(R == 0.f)) sb_block<VS, true>(o, R, kp + cur * BUF + blk * 32 * KS, vp + cur * BUF + blk * 32 * VS, qf, kp, kb, qw, qpos, hi);
        }
        volatile LAS int* fl = flg + 8 * (s & 1);
        if (lane == 0) fl[wid] = __all(R == 0.f) ? 1 : 0;
        if (s > 0) PSTORE(cur ^ 1);
        __syncthreads();
        if ((fl[0] & fl[1] & fl[2] & fl[3] & fl[4] & fl[5] & fl[6] & fl[7]) != 0) break;
        cur ^= 1;
    }
#undef PLOAD
#undef PSTORE
    bf16* op = (bf16*)(ws + WS_OP) + ((size_t)(slot * 8 + wid) * 32) * 128;
#pragma unroll
    for (int db = 0; db < 4; ++db)
#pragma unroll
        for (int r = 0; r < 16; ++r) op[crow(r, hi) * 128 + db * 32 + r32] = (bf16)f2bf(o[db][r]);
    if (hi == 0) ((float*)(ws + WS_TP))[(slot * 8 + wid) * 32 + r32] = R;
}

struct MixRow { int m, t; const float* st; u32x4 opb[2]; u32x4 u2[2], u1[2], u0[2], gb[2]; };
__device__ __forceinline__ void mix_load(const Args& a, MixRow& R, int m, int lane) {
    unsigned char* ws = a.ws;
    const float* OP = (const float*)(ws + WS_OP); const bf16* U = (const bf16*)(ws + WS_U); const bf16* GB = (const bf16*)(ws + WS_GB);
    const int h = lane >> 3, d0 = (lane & 7) * 16, c0 = lane * 16;
    int slot0, wid, q;
    if (m < NP) { const int b = m >> 12, t = m & 4095, qb = t >> 8; wid = (t & 255) >> 5; q = t & 31; slot0 = (b * 8 + h) * 16 + qb; R.t = t; R.st = nullptr; }
    else { const int r = m - NP, b = r >> 6, t = r & 63, rg = t >> 5; q = t & 31; wid = (h & 3) * 2 + rg; slot0 = 256 + b * 2 + (h >> 2); R.t = t; R.st = a.in[4] + (size_t)b * 2 * CC; }
    R.m = m;
    { const u32x4* p = (const u32x4*)((const bf16*)OP + ((size_t)(slot0 * 8 + wid) * 32 + q) * 128 + d0); R.opb[0] = p[0]; R.opb[1] = p[1]; }
    { const u32x4* pu = (const u32x4*)(U + (size_t)m * CC + c0); R.u2[0] = pu[0]; R.u2[1] = pu[1]; }
    if (R.t >= 1) { const u32x4* pu = (const u32x4*)(U + (size_t)(m - 1) * CC + c0); R.u1[0] = pu[0]; R.u1[1] = pu[1]; }
    if (R.t >= 2) { const u32x4* pu = (const u32x4*)(U + (size_t)(m - 2) * CC + c0); R.u0[0] = pu[0]; R.u0[1] = pu[1]; }
    { const u32x4* pg = (const u32x4*)(GB + (size_t)m * CC + c0); R.gb[0] = pg[0]; R.gb[1] = pg[1]; }
}
__device__ __forceinline__ void unpack16(const u32x4 (&x)[2], float (&o)[16]) {
    const unsigned ww[8] = {x[0].x, x[0].y, x[0].z, x[0].w, x[1].x, x[1].y, x[1].z, x[1].w};
#pragma unroll
    for (int i = 0; i < 8; ++i) { o[2 * i] = bflo(ww[i]); o[2 * i + 1] = bfhi(ww[i]); }
}
__device__ __forceinline__ void mix_finish(const Args& a, const MixRow& R, const float (&ga16)[16], const float (&gc16)[16], const float (&w0c)[16], const float (&w1c)[16], const float (&w2c)[16], int lane) {
    bf16* MIX = (bf16*)(a.ws + WS_MIX);
    const int h = lane >> 3, d0 = (lane & 7) * 16, c0 = lane * 16, m = R.m;
    float oa[16]; unpack16(R.opb, oa);
    float s = 0.f;
#pragma unroll
    for (int i = 0; i < 16; ++i) s += oa[i] * oa[i];
    float rs = __builtin_amdgcn_rsqf(wave_sum(s) * (1.0f / AW) + EPS);
    { unsigned ww[8];
#pragma unroll
      for (int i = 0; i < 8; ++i) ww[i] = pk2(oa[2 * i] * rs * ga16[2 * i], oa[2 * i + 1] * rs * ga16[2 * i + 1]);
      u32x4 w0, w1; w0.x = ww[0]; w0.y = ww[1]; w0.z = ww[2]; w0.w = ww[3]; w1.x = ww[4]; w1.y = ww[5]; w1.z = ww[6]; w1.w = ww[7];
      u32x4* o = (u32x4*)(MIX + (size_t)m * DM + h * 128 + d0); o[0] = w0; o[1] = w1; }
    float u0[16], u1[16], u2[16], gbv[16];
    unpack16(R.u2, u2); unpack16(R.gb, gbv);
    if (R.t >= 1) unpack16(R.u1, u1); else {
#pragma unroll
        for (int i = 0; i < 16; ++i) u1[i] = R.st ? R.st[CC + c0 + i] : 0.f; }
    if (R.t >= 2) unpack16(R.u0, u0); else {
#pragma unroll
        for (int i = 0; i < 16; ++i) u0[i] = R.st ? R.st[(R.t == 0 ? 0 : CC) + c0 + i] : 0.f; }
    float oc[16]; float s2 = 0.f;
#pragma unroll
    for (int i = 0; i < 16; ++i) { oc[i] = gbv[i] * (w0c[i] * u0[i] + w1c[i] * u1[i] + w2c[i] * u2[i]); s2 += oc[i] * oc[i]; }
    rs = __builtin_amdgcn_rsqf(wave_sum(s2) * (1.0f / CC) + EPS);
    { unsigned ww[8];
#pragma unroll
      for (int i = 0; i < 8; ++i) ww[i] = pk2(oc[2 * i] * rs * gc16[2 * i], oc[2 * i + 1] * rs * gc16[2 * i + 1]);
      u32x4 w0, w1; w0.x = ww[0]; w0.y = ww[1]; w0.z = ww[2]; w0.w = ww[3]; w1.x = ww[4]; w1.y = ww[5]; w1.z = ww[6]; w1.w = ww[7];
      u32x4* o = (u32x4*)(MIX + (size_t)m * DM + AW + c0); o[0] = w0; o[1] = w1; }
}
__device__ __forceinline__ void mix_rows(const Args& a, int gw, int NGW, int lane) {
    const float* cw = a.in[9]; const float* ga = a.in[10]; const float* gc = a.in[11];
    const int h = lane >> 3, d0 = (lane & 7) * 16, c0 = lane * 16;
    float ga16[16], gc16[16], w0c[16], w1c[16], w2c[16];
#pragma unroll
    for (int i = 0; i < 4; ++i) {
        const f32x4 x0 = *(const f32x4*)(ga + h * 128 + d0 + 4 * i), x1 = *(const f32x4*)(gc + c0 + 4 * i), x2 = *(const f32x4*)(cw + c0 + 4 * i), x3 = *(const f32x4*)(cw + CC + c0 + 4 * i), x4 = *(const f32x4*)(cw + 2 * CC + c0 + 4 * i);
#pragma unroll
        for (int j = 0; j < 4; ++j) { ga16[4 * i + j] = x0[j]; gc16[4 * i + j] = x1[j]; w0c[4 * i + j] = x2[j]; w1c[4 * i + j] = x3[j]; w2c[4 * i + j] = x4[j]; }
    }
    for (int m = gw; m < MT; m += 2 * NGW) {
        MixRow A, B; const bool hasB = m + NGW < MT;
        mix_load(a, A, m, lane);
        if (hasB) mix_load(a, B, m + NGW, lane);
        mix_finish(a, A, ga16, gc16, w0c, w1c, w2c, lane);
        if (hasB) mix_finish(a, B, ga16, gc16, w0c, w1c, w2c, lane);
    }
}
#ifndef NCONV
#define NCONV 96
#endif
#ifndef REP_P0
#define REP_P0 1
#endif
#ifndef REP_P1
#define REP_P1 1
#endif
#ifndef REP_P3
#define REP_P3 1
#endif
#ifndef REP_P4
#define REP_P4 1
#endif
#ifndef REP_P5
#define REP_P5 1
#endif
__global__ void __launch_bounds__(NWAVES * 64, 2) fwd_megakernel(Args args) {
    extern __shared__ __attribute__((aligned(16))) unsigned char lds_raw[];
    cg::grid_group grid = cg::this_grid();
    LAS unsigned char* lds = (LAS unsigned char*)lds_raw;
    const int G = gridDim.x, bx = blockIdx.x, NGW = G * NWAVES;
#define PHASE_IDS() int tid = threadIdx.x; asm volatile("" : "+v"(tid)); const int lane = tid & 63; const int wave = __builtin_amdgcn_readfirstlane(tid >> 6); const int gw = bx * NWAVES + wave; (void)lane; (void)gw
    unsigned char* ws = args.ws;
    unsigned* ctl = (unsigned*)(ws + WS_CTL);
    LAS float* red = (LAS float*)(lds + RED_OFF);
    volatile LAS int* misc = (volatile LAS int*)(lds + MISC_OFF);

    { PHASE_IDS(); if (bx == 0 && tid == 0) { ctl[0] = 0u; ctl[64] = 0u; ctl[256] = 0u; }
      if (bx == 0) for (int i = tid; i < XCD_BAR_WORDS; i += NWAVES * 64) ctl[4096 + i] = 0u;
      if (tid < 2) misc[8 + tid] = 0;
#ifndef NO_P0
    for (int rep_ = 0; rep_ < REP_P0; ++rep_) p0_prologue(args, lds, gw, NGW, lane, wave);
#endif
    }
    grid.sync();
    XcdBarrier xbar = xcd_barrier_post(ctl + 4096, (volatile LAS unsigned*)(lds + MISC_OFF) + 8);

#ifndef NO_P1
    for (int rep_ = 0; rep_ < REP_P1; ++rep_) {
        pg8::Gemm g{(const pg8::bf16_t*)(ws + WS_HN), (const pg8::bf16_t*)(ws + WS_WIN), MT, INC, DM}; typedef pg8::InProjOrder Ord; Ord S; S.init(G, bx);
        pg8::EpiIn E{(bf16*)(ws + WS_Q), (bf16*)(ws + WS_K), (bf16*)(ws + WS_V), (bf16*)(ws + WS_GB), (bf16*)(ws + WS_U), args.out, args.in[7], args.in[8], red,
                     1.4426950408889634f * 0.08838834764831845f, OFF_KP, OFF_VP, OFF_CP, OFF_KS, OFF_VS, OFF_CS};
        pg8::gemm_phase<pg8::EpiIn, Ord, true, true>(lds, g, S, E);
    }
#endif
    xcd_barrier(xbar);

#ifndef NO_P2
    {
        const int nitems = g_items.n;
        PHASE_IDS();
#ifdef DUP_P2
        for (int rep = 0; rep < 2; ++rep)
#else
        const int rep = 0;
#endif
        for (;;) {
            if (tid == 0) misc[0] = (int)atomicAdd(ctl + 64 * rep, 1u);
            __syncthreads();
            int it = misc[0];
            __syncthreads();
            if (it < 48) {
                pg8::Gemm g{(const pg8::bf16_t*)(ws + WS_HN), (const pg8::bf16_t*)(ws + WS_WIN), MT, INC, DM};
                pg8::OneUnit S1; S1.u0.pm = 30 + (it & 3); S1.u0.pn = 12 + (it >> 2); S1.u0.k0 = 0; S1.u0.nt = 32; S1.u0.split = 0; S1.u0.tu = 0; S1.u0.sp = 0;
                pg8::EpiIn E{(bf16*)(ws + WS_Q), (bf16*)(ws + WS_K), (bf16*)(ws + WS_V), (bf16*)(ws + WS_GB), (bf16*)(ws + WS_U), args.out, args.in[7], args.in[8], red,
                             1.4426950408889634f * 0.08838834764831845f, OFF_KP, OFF_VP, OFF_CP, OFF_KS, OFF_VS, OFF_CS};
                pg8::gemm_phase<pg8::EpiIn, pg8::OneUnit, true, true>(lds, g, S1, E);
                __syncthreads();
                continue;
            }
            it -= 48;
            const bool token = it >= 16 && it < 16 + NCONV;
            if (token || it >= nitems + NCONV) {
                for (;;) {
                    if (tid == 0) misc[0] = (int)atomicAdd(ctl + 256, 1u);
                    __syncthreads();
                    const int ch = misc[0];
                    __syncthreads();
                    if (ch >= P0_LATE_CHUNKS) break;
                    p0_run_range(args, (LAS float*)(lds + wave * 16384), P0_EARLY_ITEMS + ch * P0_CHUNK + wave * (P0_CHUNK / NWAVES), P0_CHUNK / NWAVES, lane);
                }
                if (token) continue;
                break;
            }
            if (it >= 16) it -= NCONV;
            const int code = g_items.v[it];
#if defined(ONLY_S)
            attn_item<true>(args, lds, code);
#elif defined(ONLY_P)
            attn_item_p(args, lds, code);
#else
            if (code & 1) attn_item<true>(args, lds, code); else attn_item_p(args, lds, code);
#endif
        }
    }
#endif
    xcd_barrier(xbar);

#ifndef NO_P3
    for (int rep_ = 0; rep_ < REP_P3; ++rep_) { PHASE_IDS(); mix_rows(args, gw, NGW, lane); }
#endif
    xcd_barrier(xbar);

#ifndef NO_P4
    for (int rep_ = 0; rep_ < REP_P4; ++rep_) {
        pg8::Gemm g{(const pg8::bf16_t*)(ws + WS_MIX), (const pg8::bf16_t*)(ws + WS_WOUT), MT, DM, DM}; typedef pg8::TailOrderT<MT / 256, DM / 256, DM / 64, 8> Ord; Ord S; S.init(G, bx);
        pg8::EpiOut E{args.in[0], args.in[1], args.out + OFF_Y, (bf16*)(ws + WS_HN), (float*)(ws + WS_SSQ), red, (float*)(ws + WS_PART)};
        pg8::gemm_phase<pg8::EpiOut, Ord, true, true>(lds, g, S, E);
        if (S.rem > 0) {
            xcd_barrier(xbar);
            PHASE_IDS();
            for (int w = gw; w < S.rem * 256; w += NGW) {
                const int tu = w >> 8, r = w & 255; pg8::Unit u; Ord::SO::unit(S.full * G + tu, u);
                const size_t row = (size_t)u.pm * 256 + r; const int col = u.pn * 256 + 4 * lane;
                const float* xin = row < NP ? args.in[0] + row * DM : args.in[1] + (row - NP) * DM;
                f32x4 v = *(const f32x4*)(xin + col);
                const bf16* p = (const bf16*)(ws + WS_PART) + (size_t)(tu * 8) * 65536 + r * 256 + 4 * lane;
                u32x2 sl[8];
#pragma unroll
                for (int s = 0; s < 8; ++s) sl[s] = *(const u32x2*)(p + (size_t)s * 65536);
#pragma unroll
                for (int s = 0; s < 8; ++s) { v[0] += bflo(sl[s].x); v[1] += bfhi(sl[s].x); v[2] += bflo(sl[s].y); v[3] += bfhi(sl[s].y); }
                *(f32x4*)(args.out + OFF_Y + row * DM + col) = v;
                u32x2 pk; pk.x = pk2(v[0], v[1]); pk.y = pk2(v[2], v[3]); *(u32x2*)((bf16*)(ws + WS_HN) + row * DM + col) = pk;
                const float ss = wave_sum((v[0] * v[0] + v[1] * v[1]) + (v[2] * v[2] + v[3] * v[3]));
                if (lane == 0) ((float*)(ws + WS_SSQ))[row * 8 + u.pn] = ss;
            }
        }
    }
#endif
    xcd_barrier(xbar);

#ifndef NO_P5
    for (int rep_ = 0; rep_ < REP_P5; ++rep_) {
        pg8::Gemm g{(const pg8::bf16_t*)(ws + WS_HN), (const pg8::bf16_t*)(ws + WS_WGU), MT, 2 * DFF, DM}; typedef pg8::StaticOrderT<MT / 256, 2 * DFF / 256, DM / 64> Ord; Ord S; S.init(G, bx);
        pg8::EpiGU E{(bf16*)(ws + WS_H), (const float*)(ws + WS_SSQ)};
        pg8::gemm_phase<pg8::EpiGU, Ord, true, true>(lds, g, S, E);
    }
#endif
    xcd_barrier(xbar);

#ifndef NO_P6
    {
        pg8::Gemm g{(const pg8::bf16_t*)(ws + WS_H), (const pg8::bf16_t*)(ws + WS_WDN), MT, DM, DFF};
        typedef pg8::TailOrderT<MT / 256, DM / 256, DFF / 64, 8> Ord; Ord S; S.init(G, bx);
        pg8::EpiDown E{args.out + OFF_Y, (float*)(ws + WS_PART), (const pg8::bf16_t*)(ws + WS_HN)};
        pg8::gemm_phase<pg8::EpiDown, Ord, true, true>(lds, g, S, E);
        if (S.rem > 0) {
            xcd_barrier(xbar);
            PHASE_IDS();
            for (int w = gw; w < S.rem * 256; w += NGW) {
                const int tu = w >> 8, r = w & 255; pg8::Unit u; Ord::SO::unit(S.full * G + tu, u);
                float* y = args.out + OFF_Y + ((size_t)u.pm * 256 + r) * DM + u.pn * 256 + 4 * lane;
                f32x4 v = *(const f32x4*)y;
                const bf16* p = (const bf16*)(ws + WS_PART) + (size_t)(tu * 8) * 65536 + r * 256 + 4 * lane;
                u32x2 sl[8];
#pragma unroll
                for (int s = 0; s < 8; ++s) sl[s] = *(const u32x2*)(p + (size_t)s * 65536);
#pragma unroll
                for (int s = 0; s < 8; ++s) { v[0] += bflo(sl[s].x); v[1] += bfhi(sl[s].x); v[2] += bflo(sl[s].y); v[3] += bfhi(sl[s].y); }
                *(f32x4*)y = v;
            }
        }
    }
#endif
}

extern "C" void kernel_launch(void* const* d_in, const int* in_sizes, int n_in, void* d_out, int out_size, void* d_ws, size_t ws_size, hipStream_t stream) {
    static int grid = 0;
    if (grid == 0) {
        if (n_in != 17 || (size_t)out_size != OUT_TOTAL || ws_size < WS_END) { fprintf(stderr, "kernel_launch: unexpected shapes (n_in %d out %d ws %zu need %zu)\n", n_in, out_size, ws_size, (size_t)WS_END); grid = -1; return; }
        int dev = 0, cus = 0, per_cu = 0;
        hipGetDevice(&dev); hipDeviceGetAttribute(&cus, hipDeviceAttributeMultiprocessorCount, dev);
        hipFuncSetAttribute((const void*)fwd_megakernel, hipFuncAttributeMaxDynamicSharedMemorySize, LDS_BYTES);
        hipOccupancyMaxActiveBlocksPerMultiprocessor(&per_cu, (const void*)fwd_megakernel, NWAVES * 64, LDS_BYTES);
        if (per_cu < 1) { fprintf(stderr, "kernel_launch: occupancy query says %d blocks per CU\n", per_cu); per_cu = 1; }
        (void)hipGetLastError();
        grid = cus;
    }
    if (grid < 0) return;
    Args a{};
    for (int i = 0; i < 17; ++i) a.in[i] = (const float*)d_in[i];
    a.out = (float*)d_out; a.ws = (unsigned char*)d_ws;
    void* kargs[] = {&a};
    hipError_t e = hipLaunchCooperativeKernel((const void*)fwd_megakernel, dim3(grid), dim3(NWAVES * 64), kargs, LDS_BYTES, stream);
    if (e != hipSuccess) fprintf(stderr, "cooperative launch failed: %s (grid %d)\n", hipGetErrorString(e), grid);
}
```
